# Optimizing an MI355X kernel written in HIP

```python
import math
import jax, jax.numpy as jnp
from jax import lax
import numpy as np

D_MODEL = 1024
BATCH = 8
SEQ = 4096
DEPTH = 4

HEAD_DIM = 64
GRID_W = 64
NA_HEADS = 4
NA_KH = 8
NA_KW = 16
NA_QC = 16
DIL_GROUPS = ((128, 1), (512, 4), (2048, 16))
DIL_HEADS_PER_GROUP = 2
DIL_HEADS = 6
DIL_QB = 64
DIFF_HEADS = 4
DIFF_DIM = 48
DIFF_QB = 128
A_W = NA_HEADS * HEAD_DIM
B_W = DIL_HEADS * HEAD_DIM
B_OUT = DIL_HEADS_PER_GROUP * HEAD_DIM
C_W = DIFF_HEADS * 2 * DIFF_DIM
N_BRANCH = 3
IN_COLS = 3 * A_W + 3 * B_W + 3 * C_W + N_BRANCH * D_MODEL
N_EXPERTS = 32
TOP_K = 4
D_EXPERT = 1024
SWIGLU_ALPHA = 1.702
SWIGLU_LIMIT = 7.0
ROPE_THETA = 10000.0
LN_EPS = 1e-5
NEG_INF = -1e30
DEEPNORM_ALPHA = (2 * DEPTH) ** 0.25
DEEPNORM_BETA = (8 * DEPTH) ** -0.25

kernel_name = "hybrid_natten_dilated_diffattn_moe_encoder"

F32 = jnp.float32


def rope_tables(seq, dim):
    inv = 1.0 / (ROPE_THETA ** (jnp.arange(0, dim, 2, dtype=F32) / dim))
    ang = jnp.arange(seq, dtype=F32)[:, None] * inv[None, :]
    return jnp.cos(ang), jnp.sin(ang)


def apply_rope(x, cos, sin):
    x1, x2 = jnp.split(x, 2, axis=-1)
    c = cos.astype(x.dtype)
    s = sin.astype(x.dtype)
    return jnp.concatenate([x1 * c - x2 * s, x2 * c + x1 * s], axis=-1)


def layer_norm(x, g, b):
    xf = x.astype(F32)
    mu = jnp.mean(xf, axis=-1, keepdims=True)
    var = jnp.mean(jnp.square(xf - mu), axis=-1, keepdims=True)
    y = (xf - mu) * lax.rsqrt(var + LN_EPS) * g.astype(F32) + b.astype(F32)
    return y.astype(x.dtype)


def neighborhood_attention(q, k, v, rpb):
    B, H, S, hd = q.shape
    rows = S // GRID_W
    kh = min(NA_KH, rows)
    ncb = GRID_W // NA_QC
    kbw = NA_QC + NA_KW
    r = np.arange(rows)
    row_idx = np.clip(r - kh // 2, 0, rows - kh)[:, None] + np.arange(kh)[None, :]
    cb = np.arange(ncb)
    col_idx = np.clip(cb * NA_QC - NA_KW // 2, 0, GRID_W - kbw)[:, None] + np.arange(kbw)[None, :]
    q_col = cb[:, None] * NA_QC + np.arange(NA_QC)[None, :]
    c_start = np.clip(q_col - NA_KW // 2, 0, GRID_W - NA_KW)
    kc = col_idx[:, None, :]
    col_ok = (kc >= c_start[:, :, None]) & (kc < c_start[:, :, None] + NA_KW)
    row_off = row_idx - r[:, None] + NA_KH - 1
    col_off = np.clip(kc - q_col[:, :, None] + NA_KW - 1, 0, 2 * NA_KW - 2)
    bias = rpb[:, row_off[:, None, None, :, None], col_off[None, :, :, None, :]]
    qg = q.reshape(B, H, rows, ncb, NA_QC, hd)
    ridx = row_idx[:, :, None, None]
    cidx = col_idx[None, None, :, :]
    kg = k.reshape(B, H, rows, GRID_W, hd)[:, :, ridx, cidx]
    vg = v.reshape(B, H, rows, GRID_W, hd)[:, :, ridx, cidx]
    s = jnp.einsum('bhrnqd,bhrinkd->bhrnqik', qg, kg, preferred_element_type=F32) * (hd ** -0.5)
    s = s + bias.astype(F32)
    s = jnp.where(col_ok[:, :, None, :], s, NEG_INF)
    p = jax.nn.softmax(s.reshape(s.shape[:-2] + (kh * kbw,)), axis=-1).reshape(s.shape)
    o = jnp.einsum('bhrnqik,bhrinkd->bhrnqd', p.astype(v.dtype), vg)
    return o.reshape(B, H, S, hd)


def dilated_window_attention(q, k, v, window, dil):
    B, H, S, hd = q.shape
    n = window // (2 * dil)
    L = S // dil
    qb = min(DIL_QB, L)
    nb = -(-L // qb)
    Lp = nb * qb
    kbw = qb + 2 * n

    def to_res(t):
        return t.reshape(B, H, L, dil, hd).transpose(0, 1, 3, 2, 4)

    qr = jnp.pad(to_res(q), ((0, 0), (0, 0), (0, 0), (0, Lp - L), (0, 0)))
    kv_pad = ((0, 0), (0, 0), (0, 0), (n, n + Lp - L), (0, 0))
    kr = jnp.pad(to_res(k), kv_pad)
    vr = jnp.pad(to_res(v), kv_pad)
    idx = np.arange(nb)[:, None] * qb + np.arange(kbw)[None, :]
    kb = kr[:, :, :, idx]
    vb = vr[:, :, :, idx]
    qs = qr.reshape(B, H, dil, nb, qb, hd)
    s = jnp.einsum('bhrnqd,bhrnkd->bhrnqk', qs, kb, preferred_element_type=F32) * (hd ** -0.5)
    m_q = np.arange(nb)[:, None] * qb + np.arange(qb)[None, :]
    m_k = (idx - n)[:, None, :]
    valid = (np.abs(m_k - m_q[:, :, None]) <= n) & (m_k >= 0) & (m_k < L)
    s = jnp.where(valid, s, NEG_INF)
    mx = jnp.max(s, axis=-1, keepdims=True)
    e = jnp.exp(s - mx)
    den = jnp.sum(e, axis=-1, keepdims=True)
    o = jnp.einsum('bhrnqk,bhrnkd->bhrnqd', (e / den).astype(v.dtype), vb)
    lse = (mx + jnp.log(den))[..., 0]
    o = o.reshape(B, H, dil, Lp, hd)[:, :, :, :L].transpose(0, 1, 3, 2, 4).reshape(B, H, S, hd)
    lse = lse.reshape(B, H, dil, Lp)[..., :L].transpose(0, 1, 3, 2).reshape(B, H, S)
    return o, lse


def dilated_mixture(q, k, v):
    outs, lses = [], []
    for g, (window, dil) in enumerate(DIL_GROUPS):
        sl = slice(g * DIL_HEADS_PER_GROUP, (g + 1) * DIL_HEADS_PER_GROUP)
        o, lse = dilated_window_attention(q[:, sl], k[:, sl], v[:, sl], window, dil)
        outs.append(o)
        lses.append(lse)
    w = jax.nn.softmax(jnp.stack(lses), axis=0)
    o = jnp.stack(outs)
    return jnp.sum(w[..., None].astype(o.dtype) * o, axis=0)


def diff_attention(q, k, v, lam, lam_init, norm_g):
    B, H, _, S, d = q.shape
    qb = min(DIFF_QB, S)
    nq = S // qb
    qs = q.reshape(B, H, 2, nq, qb, d).transpose(3, 0, 1, 2, 4, 5)

    def block(qblk):
        s = jnp.einsum('bhcqd,bhckd->bhcqk', qblk, k, preferred_element_type=F32) * (d ** -0.5)
        p = jax.nn.softmax(s, axis=-1)
        a = p[:, :, 0] - lam * p[:, :, 1]
        return jnp.einsum('bhqk,bhke->bhqe', a.astype(v.dtype), v)

    o = lax.map(block, qs)
    o = o.transpose(1, 2, 0, 3, 4).reshape(B, H, S, 2 * d)
    of = o.astype(F32)
    of = of * lax.rsqrt(jnp.mean(jnp.square(of), axis=-1, keepdims=True) + LN_EPS) * norm_g.astype(F32)
    return (of * (1.0 - lam_init)).astype(o.dtype)


def token_mixer(x, lam_init, w_in, b_gates, w_proj_a, w_proj_b, w_proj_c, w_out, rpb, lam_vec, norm_g, rope64, rope_c):
    B, S, D = x.shape
    h = x @ w_in
    sizes = [A_W, A_W, A_W, B_W, B_W, B_W, C_W, C_W, C_W]
    splits = [int(v) for v in np.cumsum(sizes)]
    qa, ka, va, qb, kb, vb, qc, kc, vc, gp = jnp.split(h, splits, axis=-1)

    def heads(t, nh):
        return t.reshape(B, S, nh, -1).transpose(0, 2, 1, 3)

    ya = neighborhood_attention(heads(qa, NA_HEADS), heads(ka, NA_HEADS), heads(va, NA_HEADS), rpb)
    ya = ya.transpose(0, 2, 1, 3).reshape(B, S, A_W)
    cos64, sin64 = rope64
    yb = dilated_mixture(apply_rope(heads(qb, DIL_HEADS), cos64, sin64),
                         apply_rope(heads(kb, DIL_HEADS), cos64, sin64),
                         heads(vb, DIL_HEADS))
    yb = yb.transpose(0, 2, 1, 3).reshape(B, S, B_OUT)
    cosc, sinc = rope_c

    def diff_heads(t):
        return t.reshape(B, S, DIFF_HEADS, 2, DIFF_DIM).transpose(0, 2, 3, 1, 4)

    lv = lam_vec.astype(F32)
    lam = jnp.exp(jnp.sum(lv[0] * lv[1])) - jnp.exp(jnp.sum(lv[2] * lv[3])) + lam_init
    yc = diff_attention(apply_rope(diff_heads(qc), cosc, sinc), apply_rope(diff_heads(kc), cosc, sinc),
                        heads(vc, DIFF_HEADS), lam, lam_init, norm_g)
    yc = yc.transpose(0, 2, 1, 3).reshape(B, S, C_W)
    gates = jax.nn.sigmoid((gp + b_gates).reshape(B, S, N_BRANCH, D))
    merged = gates[:, :, 0] * (ya @ w_proj_a) + gates[:, :, 1] * (yb @ w_proj_b) + gates[:, :, 2] * (yc @ w_proj_c)
    return merged @ w_out


def moe_ffn(x, w_router, b_router, w_gate, b_gate, w_up, b_up, w_down, b_down):
    B, S, D = x.shape
    xt = x.reshape(B * S, D)
    logits = (xt @ w_router).astype(F32) + b_router.astype(F32)
    top_v, top_i = lax.top_k(logits, TOP_K)
    top_w = jax.nn.softmax(top_v, axis=-1)
    gates = jnp.sum(jax.nn.one_hot(top_i, N_EXPERTS, dtype=F32) * top_w[..., None], axis=1).astype(xt.dtype)
    y = jnp.zeros_like(xt)
    for e in range(N_EXPERTS):
        hg = jnp.minimum(xt @ w_gate[e] + b_gate[e], SWIGLU_LIMIT)
        hu = jnp.clip(xt @ w_up[e] + b_up[e], -SWIGLU_LIMIT, SWIGLU_LIMIT)
        hh = hg * jax.nn.sigmoid(SWIGLU_ALPHA * hg) * (hu + 1.0)
        y = y + gates[:, e:e + 1] * (hh @ w_down[e] + b_down[e])
    return y.reshape(B, S, D)


def setup_inputs(seed: int = 0) -> dict:
    key = jax.random.key(seed)
    ks = jax.random.split(key, 24)

    def nrm(k, shape, scale):
        return jax.random.normal(k, shape, F32) * scale

    Lr = DEPTH
    return {
        'x': nrm(ks[0], (BATCH, SEQ, D_MODEL), 1.0),
        'w_in': nrm(ks[1], (Lr, D_MODEL, IN_COLS), D_MODEL ** -0.5),
        'b_gates': nrm(ks[2], (Lr, N_BRANCH * D_MODEL), 0.02),
        'w_proj_a': nrm(ks[3], (Lr, A_W, D_MODEL), A_W ** -0.5),
        'w_proj_b': nrm(ks[4], (Lr, B_OUT, D_MODEL), B_OUT ** -0.5),
        'w_proj_c': nrm(ks[5], (Lr, C_W, D_MODEL), C_W ** -0.5),
        'w_out': nrm(ks[6], (Lr, D_MODEL, D_MODEL), DEEPNORM_BETA * D_MODEL ** -0.5),
        'na_rpb': nrm(ks[7], (Lr, NA_HEADS, 2 * NA_KH - 1, 2 * NA_KW - 1), 0.02),
        'diff_lambda': nrm(ks[8], (Lr, 4, DIFF_DIM), 0.1),
        'diff_norm_g': 1.0 + nrm(ks[9], (Lr, 2 * DIFF_DIM), 0.02),
        'ln1_g': 1.0 + nrm(ks[10], (Lr, D_MODEL), 0.02),
        'ln1_b': nrm(ks[11], (Lr, D_MODEL), 0.02),
        'w_router': nrm(ks[12], (Lr, D_MODEL, N_EXPERTS), D_MODEL ** -0.5),
        'b_router': nrm(ks[13], (Lr, N_EXPERTS), 0.01),
        'w_exp_gate': nrm(ks[14], (Lr, N_EXPERTS, D_MODEL, D_EXPERT), D_MODEL ** -0.5),
        'b_exp_gate': nrm(ks[15], (Lr, N_EXPERTS, D_EXPERT), 0.02),
        'w_exp_up': nrm(ks[16], (Lr, N_EXPERTS, D_MODEL, D_EXPERT), D_MODEL ** -0.5),
        'b_exp_up': nrm(ks[17], (Lr, N_EXPERTS, D_EXPERT), 0.02),
        'w_exp_down': nrm(ks[18], (Lr, N_EXPERTS, D_EXPERT, D_MODEL), DEEPNORM_BETA * D_EXPERT ** -0.5),
        'b_exp_down': nrm(ks[19], (Lr, N_EXPERTS, D_MODEL), 0.02),
        'ln2_g': 1.0 + nrm(ks[20], (Lr, D_MODEL), 0.02),
        'ln2_b': nrm(ks[21], (Lr, D_MODEL), 0.02),
    }


def reference(x, w_in, b_gates, w_proj_a, w_proj_b, w_proj_c, w_out, na_rpb, diff_lambda, diff_norm_g,
              ln1_g, ln1_b, w_router, b_router, w_exp_gate, b_exp_gate, w_exp_up, b_exp_up,
              w_exp_down, b_exp_down, ln2_g, ln2_b):
    S = x.shape[1]
    rope64 = rope_tables(S, HEAD_DIM)
    rope_c = rope_tables(S, DIFF_DIM)
    for l in range(DEPTH):
        lam_init = 0.8 - 0.6 * math.exp(-0.3 * l)
        mix = token_mixer(x, lam_init, w_in[l], b_gates[l], w_proj_a[l], w_proj_b[l], w_proj_c[l], w_out[l],
                          na_rpb[l], diff_lambda[l], diff_norm_g[l], rope64, rope_c)
        x = layer_norm(DEEPNORM_ALPHA * x + mix, ln1_g[l], ln1_b[l])
        ffn = moe_ffn(x, w_router[l], b_router[l], w_exp_gate[l], b_exp_gate[l], w_exp_up[l], b_exp_up[l],
                      w_exp_down[l], b_exp_down[l])
        x = layer_norm(DEEPNORM_ALPHA * x + ffn, ln2_g[l], ln2_b[l])
    return x
```

```cpp
#include <hip/hip_runtime.h>
#include <cstdio>
#include <cstdint>
#include <cmath>

#ifndef REP_AB
#define REP_AB 1
#endif
#ifndef REP_C
#define REP_C 1
#endif
#ifndef REP_G
#define REP_G 1
#endif
#ifndef REP_G1
#define REP_G1 REP_G
#endif
#ifndef REP_G3
#define REP_G3 REP_G
#endif
#ifndef REP_G4
#define REP_G4 REP_G
#endif
#ifndef REP_G6
#define REP_G6 REP_G
#endif
#ifndef REP_G7
#define REP_G7 REP_G
#endif
#ifndef REP_T
#define REP_T 1
#endif
#ifndef DRY_P5
#define DRY_P5 0
#endif
#ifndef DRY_P8
#define DRY_P8 0
#endif
#ifndef C_ANTIPHASE
#define C_ANTIPHASE 0
#endif
#ifndef MK_ONE_LAUNCH
#define MK_ONE_LAUNCH 1
#endif

#define GAS __attribute__((address_space(1)))
#define LAS __attribute__((address_space(3)))
typedef unsigned short bf16;
typedef unsigned v4u __attribute__((ext_vector_type(4)));
typedef unsigned v2u __attribute__((ext_vector_type(2)));
typedef float f32x4 __attribute__((ext_vector_type(4)));
typedef float f32x2 __attribute__((ext_vector_type(2)));
typedef short bf16x8 __attribute__((ext_vector_type(8)));

constexpr int NTOK = 32768, SEQ = 4096, D = 1024, DEPTH = 4, INC = 6144, NEXP = 32, TOPK = 4;
constexpr int C_QA = 0, C_KA = 256, C_VA = 512, C_QB = 768, C_KB = 1152, C_VB = 1536, C_QC = 1920, C_KC = 2304, C_VC = 2688, C_GP = 3072;
constexpr int YLD = 768, Y_A = 0, Y_B = 256, Y_C = 384;
constexpr int WPK = 896;
constexpr int MAXT = 544;
constexpr float LN_EPS = 1e-5f;
constexpr float DN_ALPHA = 1.681792830507429f;

constexpr size_t MiB = 1u << 20;
constexpr size_t WS_CTL = 0, CTL_ZERO_BYTES = 1 * MiB;
constexpr size_t WS_ROPE64 = 1 * MiB;
constexpr size_t WS_ROPE48 = 2 * MiB;
constexpr size_t WS_TOPE = 3 * MiB;
constexpr size_t WS_TOPW = 3 * MiB + 512 * 1024;
constexpr size_t WS_POS = 4 * MiB;
constexpr size_t WS_WIN = 8 * MiB;
constexpr size_t WS_WPROJ = 56 * MiB;
constexpr size_t WS_WOUT = 64 * MiB;
constexpr size_t WS_WGU = 72 * MiB;
constexpr size_t WS_WDN = 584 * MiB;
constexpr size_t WS_XB = 840 * MiB;
constexpr size_t WS_Y = 904 * MiB;
constexpr size_t WS_M = 952 * MiB;
constexpr size_t WS_H = 1016 * MiB;
constexpr size_t WS_HH = 1400 * MiB;
constexpr size_t WS_WRT = 5 * MiB;
constexpr size_t WS_RANK = 6 * MiB;
constexpr size_t WS_SRC = 1672 * MiB;
constexpr size_t WS_XB8 = 1676 * MiB;
constexpr size_t WS_WIN8 = 1708 * MiB;
constexpr size_t WS_END = 1720 * MiB;
constexpr int CW_BAR = 4096;
constexpr int CW_CNT = 8192;
constexpr int CW_CUR = 8192 + 4 * 64;

constexpr int RING_BYTES = 131072;
constexpr int LDSCTL_OFF = RING_BYTES;
constexpr int L_MISC = LDSCTL_OFF;
constexpr int L_OFFT = LDSCTL_OFF + 256;
constexpr int L_HIST = LDSCTL_OFF + 512;
constexpr int L_BASE = LDSCTL_OFF + 768;
constexpr int L_CNT = LDSCTL_OFF + 896;
constexpr int L_TILE = LDSCTL_OFF + 1024;
constexpr int L_PPOS = LDSCTL_OFF + 4096;
constexpr int L_PTOK = LDSCTL_OFF + 6144;
constexpr int LDS_BYTES = 147456;
static_assert(L_PTOK + 2048 <= LDS_BYTES, "LDS map");

#define RLX_AGENT __ATOMIC_RELAXED, __HIP_MEMORY_SCOPE_AGENT
#define LDS_WAIT() asm volatile("s_waitcnt lgkmcnt(0)" ::: "memory")
#define VM_WAIT() asm volatile("s_waitcnt vmcnt(0)" ::: "memory")

__device__ __forceinline__ float bf2f(unsigned short b) { return __uint_as_float(((unsigned)b) << 16); }
__device__ __forceinline__ float bflo(unsigned u) { return __uint_as_float(u << 16); }
__device__ __forceinline__ float bfhi(unsigned u) { return __uint_as_float(u & 0xffff0000u); }
__device__ __forceinline__ unsigned f2bf(float f) { unsigned u = __builtin_bit_cast(unsigned, f); return (u + 0x7fffu + ((u >> 16) & 1u)) >> 16; }
__device__ __forceinline__ unsigned pk2(float lo, float hi) { return f2bf(lo) | (f2bf(hi) << 16); }
__device__ __forceinline__ float wave_sum(float v) {
#pragma unroll
    for (int o = 1; o < 64; o <<= 1) v += __shfl_xor(v, o);
    return v;
}
__device__ __forceinline__ int opaque_tid() { int t; asm volatile("v_mov_b32 %0, %1" : "=v"(t) : "v"(threadIdx.x)); return t; }
__device__ __forceinline__ unsigned pk4_fp8(float a, float b, float c, float d, float sc) {
    a = fminf(fmaxf(a * sc, -448.f), 448.f); b = fminf(fmaxf(b * sc, -448.f), 448.f); c = fminf(fmaxf(c * sc, -448.f), 448.f); d = fminf(fmaxf(d * sc, -448.f), 448.f);
    int p = __builtin_amdgcn_cvt_pk_fp8_f32(a, b, 0, false); p = __builtin_amdgcn_cvt_pk_fp8_f32(c, d, p, true); return (unsigned)p; }
__device__ __forceinline__ float fast_sigmoid(float x) { return __builtin_amdgcn_rcpf(1.0f + __builtin_amdgcn_exp2f(-1.4426950408889634f * x)); }

namespace pg8 {
#define PG8_LAS __attribute__((address_space(3)))
typedef unsigned short bf16_t;
typedef unsigned u32x4 __attribute__((ext_vector_type(4)));
constexpr int BM = 256, BK = 64, HALF = 128, HTB = HALF * BK * 2, STAGE_BYTES = 8 * HTB, NXCD = 8, WGM = 8;

__host__ __device__ __forceinline__ int lds_byte(int r, int c) { const int st = (r >> 4) * 2 + (c >> 5), rr = r & 15, cc = c & 31, ob = rr * 64 + cc * 2; return st * 1024 + (ob ^ (((ob >> 9) & 1) << 5)); }
__host__ __device__ __forceinline__ void stage_rc(int b, int& R, int& C) { const int st = b / 1024, sb = b % 1024, swz = sb ^ (((sb >> 9) & 1) << 5); R = (st >> 1) * 16 + swz / 64; C = (st & 1) * 32 + (swz % 64) / 2; }
__host__ __device__ __forceinline__ int perm32(int rho) { const int n = rho >> 4, i = rho & 15; return 8 * (i >> 2) + 4 * n + (i & 3); }

struct Unit { const char* A; const char* B; int nt; int pm, pn, aux; };

__device__ __forceinline__ void tile_of(int L, int nM, int nN, int& pm, int& pn) {
    const int nwg = nM * nN;
    int wgid = L; { const int q = nwg / NXCD, r = nwg % NXCD, xcd = wgid % NXCD, off = wgid / NXCD; wgid = (xcd < r ? xcd * (q + 1) : r * (q + 1) + (xcd - r) * q) + off; }
    const int nig = WGM * nN, gid = wgid / nig, fm = gid * WGM, gsz = (nM - fm) < WGM ? (nM - fm) : WGM;
    pm = fm + ((wgid % nig) % gsz); pn = (wgid % nig) / gsz;
}

__device__ __forceinline__ unsigned cvt_pk_bf16(float lo, float hi) { unsigned r; asm volatile("v_cvt_pk_bf16_f32 %0, %1, %2" : "=v"(r) : "v"(lo), "v"(hi)); return r; }
typedef int v8i32 __attribute__((ext_vector_type(8)));
typedef short s16x16 __attribute__((ext_vector_type(16)));
typedef int v4i32 __attribute__((ext_vector_type(4)));
__device__ __forceinline__ v8i32 cat8(bf16x8 lo, bf16x8 hi) { const v4i32 a = __builtin_bit_cast(v4i32, lo), b = __builtin_bit_cast(v4i32, hi); return __builtin_shufflevector(a, b, 0, 1, 2, 3, 4, 5, 6, 7); }

template <class Epi, class Sched, bool ALIGN_EPI, bool SP2, bool FP8 = false>
__device__ __forceinline__ void gemm_phase(PG8_LAS unsigned char* lds, const int lda, const int ldb, const Sched& S, const Epi& E, const int sclW = 0x7f7f7f7f, const int sclX = 0x7f7f7f7f) {
    constexpr int EB = FP8 ? 1 : 2;
    const int tid = opaque_tid(), wid = __builtin_amdgcn_readfirstlane(tid >> 6), lane = tid & 63, wr = wid >> 2, wc = wid & 3, fr = lane & 15, fq = lane >> 4;
    unsigned voffA[2], voffB[2];
#pragma unroll
    for (int i = 0; i < 2; ++i) { int R, C; stage_rc(tid * 16 + i * 8192, R, C); const int Rb = Epi::PERM ? ((R & ~31) + perm32(R & 31)) : R;
        voffA[i] = (unsigned)(R * lda * EB + C * 2); voffB[i] = (unsigned)(Rb * ldb * EB + C * 2); }
    const size_t kstep = (size_t)(BK * 2);
    const size_t hA = (size_t)HALF * lda * EB, hB = (size_t)HALF * ldb * EB;
    const unsigned ldsw = (unsigned)wid * 1024u;
    const int fcol = FP8 ? (32 * (fq >> 1) + 16 * (fq & 1)) : fq * 8;
    const int aoff = lds_byte(wr * 64 + fr, fcol), boff = lds_byte(wc * 32 + fr, fcol);
#define PG8_SA(b, h) (((b) * 2 + (h)) * HTB)
#define PG8_SB(b, h) ((4 + (b) * 2 + (h)) * HTB)
#define PG8_STAGE(bufoff, gbase, voff) do { _Pragma("unroll") for (int _i = 0; _i < 2; ++_i) \
        __builtin_amdgcn_global_load_lds((const unsigned*)((const char*)(gbase) + (voff)[_i]), (PG8_LAS unsigned*)(lds + (bufoff) + ldsw + _i * 8192), 16, 0, 0); } while (0)
#define PG8_LDA(dst, b, h) do { if constexpr (FP8) { _Pragma("unroll") for (int m = 0; m < 4; ++m) dst##8[m] = cat8(*(const PG8_LAS bf16x8*)(lds + PG8_SA(b, h) + aoff + m * 2048), *(const PG8_LAS bf16x8*)(lds + PG8_SA(b, h) + aoff + m * 2048 + 16)); } else { \
        _Pragma("unroll") for (int m = 0; m < 4; ++m) _Pragma("unroll") for (int k = 0; k < 2; ++k) dst[m][k] = *(const PG8_LAS bf16x8*)(lds + PG8_SA(b, h) + aoff + m * 2048 + k * 1024); } } while (0)
#define PG8_LDB(dst, b, h) do { if constexpr (FP8) { _Pragma("unroll") for (int n = 0; n < 2; ++n) dst##8[n] = cat8(*(const PG8_LAS bf16x8*)(lds + PG8_SB(b, h) + boff + n * 2048), *(const PG8_LAS bf16x8*)(lds + PG8_SB(b, h) + boff + n * 2048 + 16)); } else { \
        _Pragma("unroll") for (int n = 0; n < 2; ++n) _Pragma("unroll") for (int k = 0; k < 2; ++k) dst[n][k] = *(const PG8_LAS bf16x8*)(lds + PG8_SB(b, h) + boff + n * 2048 + k * 1024); } } while (0)
#define PG8_MMA(ai, bj, At, Bt) do { __builtin_amdgcn_s_setprio(1); if constexpr (FP8) { _Pragma("unroll") for (int m = 0; m < 4; ++m) _Pragma("unroll") for (int n = 0; n < 2; ++n) \
        asm volatile("v_mfma_f32_16x16x128_f8f6f4 %0, %1, %2, %0" : "+v"(acc[ai][bj][m][n]) : "v"(Bt##8[n]), "v"(At##8[m])); } else { \
        _Pragma("unroll") for (int m = 0; m < 4; ++m) _Pragma("unroll") for (int n = 0; n < 2; ++n) _Pragma("unroll") for (int k = 0; k < 2; ++k) \
        acc[ai][bj][m][n] = __builtin_amdgcn_mfma_f32_16x16x32_bf16(Bt[n][k], At[m][k], acc[ai][bj][m][n], 0, 0, 0); } __builtin_amdgcn_s_setprio(0); } while (0)
#define PG8_WAIT_V(n) asm volatile("s_waitcnt vmcnt(" #n ")" ::: "memory")
#define PG8_WAIT_L(n) asm volatile("s_waitcnt lgkmcnt(" #n ")" ::: "memory")
#define PG8_BAR __builtin_amdgcn_s_barrier()
#define PG8_SCHED __builtin_amdgcn_sched_barrier(0)
    Unit cur, nxt; int ui = 0;
    if (!S.next(0, cur)) return;
    f32x4 acc[2][2][4][2];
#pragma unroll
    for (int a = 0; a < 2; ++a)
#pragma unroll
        for (int b = 0; b < 2; ++b)
#pragma unroll
            for (int m = 0; m < 4; ++m)
#pragma unroll
                for (int n = 0; n < 2; ++n) acc[a][b][m][n] = (f32x4){0.f, 0.f, 0.f, 0.f};
    bf16x8 At[4][2], B0[2][2], B1[2][2]; v8i32 At8[4], B08[2], B18[2];
    const char* cA = cur.A; const char* cB = cur.B;
    if constexpr (SP2) {
        PG8_STAGE(PG8_SB(0, 0), cB, voffB); PG8_STAGE(PG8_SB(0, 1), cB + hB, voffB); PG8_STAGE(PG8_SA(0, 0), cA, voffA); PG8_STAGE(PG8_SA(0, 1), cA + hA, voffA);
        if (wr == 1) PG8_BAR;
        PG8_WAIT_V(2); PG8_BAR;
        PG8_STAGE(PG8_SB(1, 0), cB + kstep, voffB); PG8_STAGE(PG8_SA(1, 0), cA + kstep, voffA); PG8_STAGE(PG8_SB(1, 1), cB + hB + kstep, voffB);
        PG8_WAIT_V(6); PG8_BAR;
    } else {
        PG8_STAGE(PG8_SB(0, 0), cB, voffB); PG8_STAGE(PG8_SA(0, 0), cA, voffA); PG8_STAGE(PG8_SB(0, 1), cB + hB, voffB); PG8_STAGE(PG8_SA(0, 1), cA + hA, voffA);
        if (wr == 1) PG8_BAR;
        PG8_WAIT_V(4); PG8_BAR;
        PG8_STAGE(PG8_SB(1, 0), cB + kstep, voffB); PG8_STAGE(PG8_SA(1, 0), cA + kstep, voffA); PG8_STAGE(PG8_SB(1, 1), cB + hB + kstep, voffB);
        PG8_WAIT_V(6); PG8_BAR;
    }
    for (;;) {
        const bool has_next = S.next(ui + 1, nxt);
        const char* nA = has_next ? nxt.A : cA; const char* nB = has_next ? nxt.B : cB;
        const int nt = cur.nt;
        for (int t = 0; t < nt; t += 2) {
            const bool last = (t == nt - 2);
            const char* a1 = cA + (size_t)(t + 1) * kstep;
            const char* a2 = last ? nA : cA + (size_t)(t + 2) * kstep; const char* b2 = last ? nB : cB + (size_t)(t + 2) * kstep;
            const char* a3 = a2 + kstep; const char* b3 = b2 + kstep;
            if constexpr (SP2) {
            PG8_LDB(B0, 0, 0); PG8_LDB(B1, 0, 1); PG8_SCHED; PG8_LDA(At, 0, 0); PG8_STAGE(PG8_SA(1, 1), a1 + hA, voffA);
            PG8_WAIT_V(8); PG8_WAIT_L(0); PG8_BAR; PG8_MMA(0, 0, At, B0); PG8_MMA(0, 1, At, B1); PG8_BAR; PG8_SCHED;
            PG8_LDA(At, 0, 1); PG8_STAGE(PG8_SB(0, 0), b2, voffB); PG8_STAGE(PG8_SB(0, 1), b2 + hB, voffB); PG8_STAGE(PG8_SA(0, 0), a2, voffA);
            PG8_WAIT_V(8); PG8_WAIT_L(0); PG8_BAR; PG8_MMA(1, 0, At, B0); PG8_MMA(1, 1, At, B1); PG8_BAR; PG8_SCHED;
            PG8_LDB(B0, 1, 0); PG8_LDB(B1, 1, 1); PG8_SCHED; PG8_LDA(At, 1, 0); PG8_STAGE(PG8_SA(0, 1), a2 + hA, voffA);
            PG8_WAIT_V(8); PG8_WAIT_L(0); PG8_BAR; PG8_MMA(0, 0, At, B0); PG8_MMA(0, 1, At, B1); PG8_BAR; PG8_SCHED;
            PG8_LDA(At, 1, 1); PG8_STAGE(PG8_SB(1, 0), b3, voffB); PG8_STAGE(PG8_SB(1, 1), b3 + hB, voffB); PG8_STAGE(PG8_SA(1, 0), a3, voffA);
            PG8_WAIT_V(8); PG8_WAIT_L(0); PG8_BAR; PG8_MMA(1, 0, At, B0); PG8_MMA(1, 1, At, B1); PG8_BAR; PG8_SCHED;
            } else {
            PG8_LDB(B0, 0, 0); PG8_SCHED; PG8_LDA(At, 0, 0); PG8_STAGE(PG8_SA(1, 1), a1 + hA, voffA);
            PG8_WAIT_L(8); PG8_BAR; PG8_WAIT_L(0); PG8_MMA(0, 0, At, B0); PG8_BAR; PG8_SCHED;
            PG8_LDB(B1, 0, 1); PG8_STAGE(PG8_SB(0, 0), b2, voffB);
            PG8_BAR; PG8_WAIT_L(0); PG8_MMA(0, 1, At, B1); PG8_BAR;
            PG8_LDA(At, 0, 1); PG8_STAGE(PG8_SA(0, 0), a2, voffA);
            PG8_BAR; PG8_WAIT_L(0); PG8_MMA(1, 0, At, B0); PG8_BAR; PG8_SCHED;
            PG8_STAGE(PG8_SB(0, 1), b2 + hB, voffB);
            PG8_WAIT_V(6); PG8_BAR; PG8_MMA(1, 1, At, B1); PG8_BAR;
            PG8_LDB(B0, 1, 0); PG8_SCHED; PG8_LDA(At, 1, 0); PG8_STAGE(PG8_SA(0, 1), a2 + hA, voffA);
            PG8_WAIT_L(8); PG8_BAR; PG8_WAIT_L(0); PG8_MMA(0, 0, At, B0); PG8_BAR; PG8_SCHED;
            PG8_LDB(B1, 1, 1); PG8_STAGE(PG8_SB(1, 0), b3, voffB);
            PG8_BAR; PG8_WAIT_L(0); PG8_MMA(0, 1, At, B1); PG8_BAR;
            PG8_LDA(At, 1, 1); PG8_STAGE(PG8_SA(1, 0), a3, voffA);
            PG8_BAR; PG8_WAIT_L(0); PG8_MMA(1, 0, At, B0); PG8_BAR; PG8_SCHED;
            PG8_STAGE(PG8_SB(1, 1), b3 + hB, voffB);
            PG8_WAIT_V(6); PG8_BAR; PG8_MMA(1, 1, At, B1); PG8_BAR;
            }
        }
        if constexpr (ALIGN_EPI) { if (wr == 0) PG8_BAR; }
        if constexpr (FP8) asm volatile("s_nop 15\n\ts_nop 15\n\ts_nop 15" ::: "memory");
        E(acc, cur, wr, wc, fr, fq);
        if (!has_next) break;
        if (!(Epi::KEEP && cur.aux != 2)) {
#pragma unroll
        for (int a = 0; a < 2; ++a)
#pragma unroll
            for (int b = 0; b < 2; ++b)
#pragma unroll
                for (int m = 0; m < 4; ++m)
#pragma unroll
                    for (int n = 0; n < 2; ++n) acc[a][b][m][n] = (f32x4){0.f, 0.f, 0.f, 0.f};
        }
        cur = nxt; cA = nA; cB = nB; ++ui;
        if constexpr (ALIGN_EPI) { if (wr == 1) PG8_BAR; }
    }
    PG8_WAIT_V(0);
    if constexpr (!ALIGN_EPI) { if (wr == 0) PG8_BAR; }
    PG8_BAR;
#undef PG8_SA
#undef PG8_SB
#undef PG8_STAGE
#undef PG8_LDA
#undef PG8_LDB
#undef PG8_MMA
#undef PG8_WAIT_V
#undef PG8_WAIT_L
#undef PG8_BAR
#undef PG8_SCHED
}

template <class Epi, class Sched, bool FP8 = false>
__device__ __forceinline__ void gemm_phase_gather(PG8_LAS unsigned char* lds, const char* Abase, const int lda, const int ldb, const Sched& S, const Epi& E, const int sclW = 0x7f7f7f7f, const int sclX = 0x7f7f7f7f) {
    constexpr int EB = FP8 ? 1 : 2;
    const int tid = opaque_tid(), wid = __builtin_amdgcn_readfirstlane(tid >> 6), lane = tid & 63, wr = wid >> 2, wc = wid & 3, fr = lane & 15, fq = lane >> 4;
    unsigned voffB[2]; int Rr[2]; unsigned Cc[2];
#pragma unroll
    for (int i = 0; i < 2; ++i) { int R, C; stage_rc(tid * 16 + i * 8192, R, C); const int Rb = Epi::PERM ? ((R & ~31) + perm32(R & 31)) : R;
        Rr[i] = R; Cc[i] = (unsigned)C * 2u; voffB[i] = (unsigned)(Rb * ldb * EB + C * 2); }
    const size_t kstep = (size_t)(BK * 2);
    const size_t hB = (size_t)HALF * ldb * EB;
    const unsigned ldsw = (unsigned)wid * 1024u;
    const int fcol = FP8 ? (32 * (fq >> 1) + 16 * (fq & 1)) : fq * 8;
    const int aoff = lds_byte(wr * 64 + fr, fcol), boff = lds_byte(wc * 32 + fr, fcol);
#define PG8_SA(b, h) (((b) * 2 + (h)) * HTB)
#define PG8_SB(b, h) ((4 + (b) * 2 + (h)) * HTB)
#define PG8_STAGE(bufoff, gbase, voff) do { _Pragma("unroll") for (int _i = 0; _i < 2; ++_i) \
        __builtin_amdgcn_global_load_lds((const unsigned*)((const char*)(gbase) + (voff)[_i]), (PG8_LAS unsigned*)(lds + (bufoff) + ldsw + _i * 8192), 16, 0, 0); } while (0)
#define PG8_LDA(dst, b, h) do { if constexpr (FP8) { _Pragma("unroll") for (int m = 0; m < 4; ++m) dst##8[m] = cat8(*(const PG8_LAS bf16x8*)(lds + PG8_SA(b, h) + aoff + m * 2048), *(const PG8_LAS bf16x8*)(lds + PG8_SA(b, h) + aoff + m * 2048 + 16)); } else { \
        _Pragma("unroll") for (int m = 0; m < 4; ++m) _Pragma("unroll") for (int k = 0; k < 2; ++k) dst[m][k] = *(const PG8_LAS bf16x8*)(lds + PG8_SA(b, h) + aoff + m * 2048 + k * 1024); } } while (0)
#define PG8_LDB(dst, b, h) do { if constexpr (FP8) { _Pragma("unroll") for (int n = 0; n < 2; ++n) dst##8[n] = cat8(*(const PG8_LAS bf16x8*)(lds + PG8_SB(b, h) + boff + n * 2048), *(const PG8_LAS bf16x8*)(lds + PG8_SB(b, h) + boff + n * 2048 + 16)); } else { \
        _Pragma("unroll") for (int n = 0; n < 2; ++n) _Pragma("unroll") for (int k = 0; k < 2; ++k) dst[n][k] = *(const PG8_LAS bf16x8*)(lds + PG8_SB(b, h) + boff + n * 2048 + k * 1024); } } while (0)
#define PG8_MMA(ai, bj, At, Bt) do { __builtin_amdgcn_s_setprio(1); if constexpr (FP8) { _Pragma("unroll") for (int m = 0; m < 4; ++m) _Pragma("unroll") for (int n = 0; n < 2; ++n) \
        asm volatile("v_mfma_f32_16x16x128_f8f6f4 %0, %1, %2, %0" : "+v"(acc[ai][bj][m][n]) : "v"(Bt##8[n]), "v"(At##8[m])); } else { \
        _Pragma("unroll") for (int m = 0; m < 4; ++m) _Pragma("unroll") for (int n = 0; n < 2; ++n) _Pragma("unroll") for (int k = 0; k < 2; ++k) \
        acc[ai][bj][m][n] = __builtin_amdgcn_mfma_f32_16x16x32_bf16(Bt[n][k], At[m][k], acc[ai][bj][m][n], 0, 0, 0); } __builtin_amdgcn_s_setprio(0); } while (0)
#define PG8_WAIT_V(n) asm volatile("s_waitcnt vmcnt(" #n ")" ::: "memory")
#define PG8_WAIT_L(n) asm volatile("s_waitcnt lgkmcnt(" #n ")" ::: "memory")
#define PG8_BAR __builtin_amdgcn_s_barrier()
#define PG8_SCHED __builtin_amdgcn_sched_barrier(0)
#define PG8_ROWOFF(u, vo) do { _Pragma("unroll") for (int _h = 0; _h < 2; ++_h) _Pragma("unroll") for (int _i = 0; _i < 2; ++_i) \
        (vo)[_h][_i] = (unsigned)S.rowtok((u), 128 * _h + Rr[_i]) * (unsigned)(lda * EB) + Cc[_i]; } while (0)
    Unit cur, nxt, nn; int ui = 0;
    if (!S.next(0, cur)) return;
    bool has_next = S.next(1, nxt);
    unsigned cv[2][2], nv[2][2], tv[2][2];
    PG8_ROWOFF(cur, cv);
    if (has_next) PG8_ROWOFF(nxt, nv); else { _Pragma("unroll") for (int h = 0; h < 2; ++h) _Pragma("unroll") for (int i = 0; i < 2; ++i) nv[h][i] = cv[h][i]; }
    f32x4 acc[2][2][4][2];
#pragma unroll
    for (int a = 0; a < 2; ++a)
#pragma unroll
        for (int b = 0; b < 2; ++b)
#pragma unroll
            for (int m = 0; m < 4; ++m)
#pragma unroll
                for (int n = 0; n < 2; ++n) acc[a][b][m][n] = (f32x4){0.f, 0.f, 0.f, 0.f};
    bf16x8 At[4][2], B0[2][2], B1[2][2]; v8i32 At8[4], B08[2], B18[2];
    const char* cB = cur.B;
    PG8_STAGE(PG8_SB(0, 0), cB, voffB); PG8_STAGE(PG8_SB(0, 1), cB + hB, voffB); PG8_STAGE(PG8_SA(0, 0), Abase, cv[0]); PG8_STAGE(PG8_SA(0, 1), Abase, cv[1]);
    if (wr == 1) PG8_BAR;
    PG8_WAIT_V(2); PG8_BAR;
    PG8_STAGE(PG8_SB(1, 0), cB + kstep, voffB); PG8_STAGE(PG8_SA(1, 0), Abase + kstep, cv[0]); PG8_STAGE(PG8_SB(1, 1), cB + hB + kstep, voffB);
    PG8_WAIT_V(6); PG8_BAR;
    for (;;) {
        const char* nB = has_next ? nxt.B : cB;
        const int nt = cur.nt;
        for (int t = 0; t < nt; t += 2) {
            const bool last = (t == nt - 2);
            const char* a1 = Abase + (size_t)(t + 1) * kstep;
            const char* a2 = last ? Abase : Abase + (size_t)(t + 2) * kstep; const char* b2 = last ? nB : cB + (size_t)(t + 2) * kstep;
            const char* a3 = a2 + kstep; const char* b3 = b2 + kstep;
            unsigned s0[2], s1[2];
#pragma unroll
            for (int i = 0; i < 2; ++i) { s0[i] = last ? nv[0][i] : cv[0][i]; s1[i] = last ? nv[1][i] : cv[1][i]; }
            PG8_LDB(B0, 0, 0); PG8_LDB(B1, 0, 1); PG8_SCHED; PG8_LDA(At, 0, 0); PG8_STAGE(PG8_SA(1, 1), a1, cv[1]);
            PG8_WAIT_V(8); PG8_WAIT_L(0); PG8_BAR; PG8_MMA(0, 0, At, B0); PG8_MMA(0, 1, At, B1); PG8_BAR; PG8_SCHED;
            PG8_LDA(At, 0, 1); PG8_STAGE(PG8_SB(0, 0), b2, voffB); PG8_STAGE(PG8_SB(0, 1), b2 + hB, voffB); PG8_STAGE(PG8_SA(0, 0), a2, s0);
            PG8_WAIT_V(8); PG8_WAIT_L(0); PG8_BAR; PG8_MMA(1, 0, At, B0); PG8_MMA(1, 1, At, B1); PG8_BAR; PG8_SCHED;
            PG8_LDB(B0, 1, 0); PG8_LDB(B1, 1, 1); PG8_SCHED; PG8_LDA(At, 1, 0); PG8_STAGE(PG8_SA(0, 1), a2, s1);
            PG8_WAIT_V(8); PG8_WAIT_L(0); PG8_BAR; PG8_MMA(0, 0, At, B0); PG8_MMA(0, 1, At, B1); PG8_BAR; PG8_SCHED;
            PG8_LDA(At, 1, 1); PG8_STAGE(PG8_SB(1, 0), b3, voffB); PG8_STAGE(PG8_SB(1, 1), b3 + hB, voffB); PG8_STAGE(PG8_SA(1, 0), a3, s0);
            PG8_WAIT_V(8); PG8_WAIT_L(0); PG8_BAR; PG8_MMA(1, 0, At, B0); PG8_MMA(1, 1, At, B1); PG8_BAR; PG8_SCHED;
        }
        if (wr == 0) PG8_BAR;
        if constexpr (FP8) asm volatile("s_nop 15\n\ts_nop 15\n\ts_nop 15" ::: "memory");
        const bool has_nn = has_next && S.next(ui + 2, nn);
        if (has_nn) PG8_ROWOFF(nn, tv);
        E(acc, cur, wr, wc, fr, fq);
        if (!has_next) break;
#pragma unroll
        for (int a = 0; a < 2; ++a)
#pragma unroll
            for (int b = 0; b < 2; ++b)
#pragma unroll
                for (int m = 0; m < 4; ++m)
#pragma unroll
                    for (int n = 0; n < 2; ++n) acc[a][b][m][n] = (f32x4){0.f, 0.f, 0.f, 0.f};
        cur = nxt; cB = nB; ++ui;
#pragma unroll
        for (int h = 0; h < 2; ++h)
#pragma unroll
            for (int i = 0; i < 2; ++i) { cv[h][i] = nv[h][i]; if (has_nn) nv[h][i] = tv[h][i]; }
        asm volatile("" : "+v"(nv[0][0]), "+v"(nv[0][1]), "+v"(nv[1][0]), "+v"(nv[1][1]));
        nxt = nn; has_next = has_nn;
        if (wr == 1) PG8_BAR;
    }
    PG8_WAIT_V(0);
    PG8_BAR;
#undef PG8_SA
#undef PG8_SB
#undef PG8_STAGE
#undef PG8_LDA
#undef PG8_LDB
#undef PG8_MMA
#undef PG8_WAIT_V
#undef PG8_WAIT_L
#undef PG8_BAR
#undef PG8_SCHED
#undef PG8_ROWOFF
}

struct DenseOrder {
    const char* A; const char* B; size_t a_tile, b_tile; int nt, nM, nN, G, c; int pn_off = 0;
    __device__ __forceinline__ bool next(int i, Unit& u) const {
        const long L = (long)i * G + c; if (L >= (long)nM * nN) return false;
        int pm, pn; tile_of((int)L, nM, nN, pm, pn);
        u.pm = pm; u.pn = pn + pn_off; u.aux = 0; u.nt = nt; u.A = A + (size_t)pm * a_tile; u.B = B + (size_t)pn * b_tile; return true;
    }
};
struct ProjOrder {
    const char* Y; const char* W; int nM, nN, G, c;
    __device__ __forceinline__ bool next(int i, Unit& u) const {
        const int ti = i / 3, br = i - 3 * ti;
        const long L = (long)ti * G + c; if (L >= (long)nM * nN) return false;
        int pm, pn; tile_of((int)L, nM, nN, pm, pn);
        u.pm = pm; u.pn = pn; u.aux = br; u.nt = (br == 2) ? 6 : 4;
        const int acol = (br == 0) ? 0 : (br == 1 ? 256 : 384), bcol = (br == 0) ? 0 : (br == 1 ? 256 : 512);
        u.A = Y + ((size_t)pm * 256 * YLD + acol) * 2; u.B = W + ((size_t)pn * 256 * WPK + bcol) * 2; return true;
    }
};
struct MoeOrder {
    const char* A; const char* W; size_t estride, atile, btile; int nt; const LAS int* tile_e; const LAS int* offT; const LAS int* cnt; const int* SRC; int T, nN, G, c;
    __device__ __forceinline__ bool next(int i, Unit& u) const {
        const long L = (long)i * G + c; if (L >= (long)T * nN) return false;
        int pm, pn; tile_of((int)L, T, nN, pm, pn);
        const int e = __builtin_amdgcn_readfirstlane(tile_e[pm]);
        u.pm = pm; u.pn = pn; u.aux = e; u.nt = nt; u.A = A + (size_t)pm * atile; u.B = W + (size_t)e * estride + (size_t)pn * btile; return true;
    }
    __device__ __forceinline__ int rowtok(const Unit& u, int r) const {
        const int e = u.aux, rank = (u.pm - offT[e]) * 256 + r, last = cnt[e] - 1;
        return SRC[e * NTOK + (rank < last ? rank : last)];
    }
};

struct EpiInProj {
    static constexpr bool PERM = true, KEEP = false;
    bf16_t* H; const float* bg; const f32x2* r64; const f32x2* r48; float gscale;
    __device__ __forceinline__ void operator()(f32x4 (&acc)[2][2][4][2], const Unit& u, int wr, int wc, int fr, int fq) const {
        const int row0 = u.pm * BM + wr * 64 + fr, pn = u.pn, t0 = wc * 32 + 8 * fq;
        if (pn >= 3 && pn < 9) {
            int dst, hstep, tw, dd0; const f32x2* tab;
            if (pn < 6) { dst = 768 + (4 * (pn - 3) + wc) * 64 + 8 * fq; hstep = 32; tw = 32; dd0 = 8 * fq; tab = r64; }
            else { const int p0 = 128 * (pn - 6) + t0, slot = p0 / 24; dd0 = p0 - slot * 24; dst = 1920 + slot * 48 + dd0; hstep = 24; tw = 24; tab = r48; }
#pragma unroll
            for (int ai = 0; ai < 2; ++ai)
#pragma unroll
                for (int m = 0; m < 4; ++m) { const int row = row0 + ai * HALF + m * 16; const f32x2* tp = tab + (size_t)(row & (SEQ - 1)) * tw + dd0;
                    f32x4 y1[2], y2[2];
#pragma unroll
                    for (int n = 0; n < 2; ++n) { const f32x4 cs0 = *(const f32x4*)(tp + 4 * n), cs1 = *(const f32x4*)(tp + 4 * n + 2);
                        const f32x4 x1 = acc[ai][0][m][n], x2 = acc[ai][1][m][n];
                        y1[n][0] = x1[0] * cs0[0] - x2[0] * cs0[1]; y2[n][0] = x2[0] * cs0[0] + x1[0] * cs0[1];
                        y1[n][1] = x1[1] * cs0[2] - x2[1] * cs0[3]; y2[n][1] = x2[1] * cs0[2] + x1[1] * cs0[3];
                        y1[n][2] = x1[2] * cs1[0] - x2[2] * cs1[1]; y2[n][2] = x2[2] * cs1[0] + x1[2] * cs1[1];
                        y1[n][3] = x1[3] * cs1[2] - x2[3] * cs1[3]; y2[n][3] = x2[3] * cs1[2] + x1[3] * cs1[3]; }
                    bf16_t* rowp = H + (size_t)row * INC + dst;
                    u32x4 w; w.x = cvt_pk_bf16(y1[0][0], y1[0][1]); w.y = cvt_pk_bf16(y1[0][2], y1[0][3]); w.z = cvt_pk_bf16(y1[1][0], y1[1][1]); w.w = cvt_pk_bf16(y1[1][2], y1[1][3]);
                    *(u32x4*)rowp = w;
                    w.x = cvt_pk_bf16(y2[0][0], y2[0][1]); w.y = cvt_pk_bf16(y2[0][2], y2[0][3]); w.z = cvt_pk_bf16(y2[1][0], y2[1][1]); w.w = cvt_pk_bf16(y2[1][2], y2[1][3]);
                    *(u32x4*)(rowp + hstep) = w; }
            return;
        }
        const bool gate = pn >= 12;
        int dcol[2];
#pragma unroll
        for (int bj = 0; bj < 2; ++bj) { const int x = pn * BM + bj * HALF + t0;
            if (pn >= 9 && pn < 12) { const int xx = x - 2304; dcol[bj] = xx < 384 ? 1536 + xx : 2688 + (xx - 384); } else dcol[bj] = x; }
        f32x4 bv[2][2];
#pragma unroll
        for (int bj = 0; bj < 2; ++bj)
#pragma unroll
            for (int n = 0; n < 2; ++n) bv[bj][n] = gate ? *(const f32x4*)(bg + (dcol[bj] - C_GP) + 4 * n) : (f32x4){0.f, 0.f, 0.f, 0.f};
#pragma unroll
        for (int ai = 0; ai < 2; ++ai)
#pragma unroll
            for (int m = 0; m < 4; ++m) { bf16_t* rowp = H + (size_t)(row0 + ai * HALF + m * 16) * INC;
#pragma unroll
                for (int bj = 0; bj < 2; ++bj) { f32x4 v0 = acc[ai][bj][m][0], v1 = acc[ai][bj][m][1];
                    if (gate) { v0 = v0 * gscale + bv[bj][0]; v1 = v1 * gscale + bv[bj][1];
#pragma unroll
                        for (int q = 0; q < 4; ++q) { v0[q] = fast_sigmoid(v0[q]); v1[q] = fast_sigmoid(v1[q]); } }
                    u32x4 w; w.x = cvt_pk_bf16(v0[0], v0[1]); w.y = cvt_pk_bf16(v0[2], v0[3]); w.z = cvt_pk_bf16(v1[0], v1[1]); w.w = cvt_pk_bf16(v1[2], v1[3]);
                    *(u32x4*)(rowp + dcol[bj]) = w; } }
    }
};
struct EpiProj {
    static constexpr bool PERM = false, KEEP = true;
    const bf16_t* H; bf16_t* Mg;
    __device__ __forceinline__ void operator()(f32x4 (&acc)[2][2][4][2], const Unit& u, int wr, int wc, int fr, int fq) const {
        const int row0 = u.pm * BM + wr * 64 + fr, col0 = u.pn * BM + wc * 32 + 4 * fq, br = u.aux;
#pragma unroll
        for (int ai = 0; ai < 2; ++ai)
#pragma unroll
            for (int m = 0; m < 4; ++m) { const size_t row = (size_t)(row0 + ai * HALF + m * 16);
#pragma unroll
                for (int bj = 0; bj < 2; ++bj)
#pragma unroll
                    for (int n = 0; n < 2; ++n) { const int c = col0 + bj * HALF + n * 16;
                        const bf16_t* gp = H + row * INC + C_GP + br * 1024 + c;
                        const v2u gw = *(const v2u*)gp;
                        f32x4 g = (f32x4){fmaxf(bflo(gw.x), 1e-6f), fmaxf(bfhi(gw.x), 1e-6f), fmaxf(bflo(gw.y), 1e-6f), fmaxf(bfhi(gw.y), 1e-6f)};
                        if (br < 2) { const v2u nw = *(const v2u*)(gp + 1024);
                            g[0] *= __builtin_amdgcn_rcpf(fmaxf(bflo(nw.x), 1e-6f)); g[1] *= __builtin_amdgcn_rcpf(fmaxf(bfhi(nw.x), 1e-6f));
                            g[2] *= __builtin_amdgcn_rcpf(fmaxf(bflo(nw.y), 1e-6f)); g[3] *= __builtin_amdgcn_rcpf(fmaxf(bfhi(nw.y), 1e-6f));
                            acc[ai][bj][m][n] = acc[ai][bj][m][n] * g; }
                        else { const f32x4 t = acc[ai][bj][m][n] * g; v2u o; o.x = cvt_pk_bf16(t[0], t[1]); o.y = cvt_pk_bf16(t[2], t[3]); *(v2u*)(Mg + row * 1024 + c) = o; } } }
    }
};
struct EpiOut {
    static constexpr bool PERM = false, KEEP = false;
    const float* X; float* P;
    __device__ __forceinline__ void operator()(f32x4 (&acc)[2][2][4][2], const Unit& u, int wr, int wc, int fr, int fq) const {
        const int row0 = u.pm * BM + wr * 64 + fr, col0 = u.pn * BM + wc * 32 + 4 * fq;
#pragma unroll
        for (int ai = 0; ai < 2; ++ai)
#pragma unroll
            for (int m = 0; m < 4; ++m) { const size_t ro = (size_t)(row0 + ai * HALF + m * 16) * 1024 + col0;
#pragma unroll
                for (int bj = 0; bj < 2; ++bj)
#pragma unroll
                    for (int n = 0; n < 2; ++n) { const f32x4 xv = *(const f32x4*)(X + ro + bj * HALF + n * 16);
                        *(f32x4*)(P + ro + bj * HALF + n * 16) = xv * DN_ALPHA + acc[ai][bj][m][n]; } }
    }
};
struct EpiSwiglu {
    static constexpr bool PERM = true, KEEP = false;
    unsigned char* HH; const float* bgate; const float* bup; float ascale;
    __device__ __forceinline__ void operator()(f32x4 (&acc)[2][2][4][2], const Unit& u, int wr, int wc, int fr, int fq) const {
        const int row0 = u.pm * BM + wr * 64 + fr, j0 = u.pn * HALF + wc * 32 + 8 * fq, e = u.aux;
        f32x4 bg[2], bu[2];
#pragma unroll
        for (int n = 0; n < 2; ++n) { bg[n] = *(const f32x4*)(bgate + e * 1024 + j0 + 4 * n); bu[n] = *(const f32x4*)(bup + e * 1024 + j0 + 4 * n); }
#pragma unroll
        for (int ai = 0; ai < 2; ++ai)
#pragma unroll
            for (int m = 0; m < 4; ++m) { unsigned char* rowp = HH + (size_t)(row0 + ai * HALF + m * 16) * 1024 + j0;
                f32x4 o[2];
#pragma unroll
                for (int n = 0; n < 2; ++n) { f32x4 g = acc[ai][0][m][n] * ascale + bg[n], uu = acc[ai][1][m][n] * ascale + bu[n];
#pragma unroll
                    for (int q = 0; q < 4; ++q) { const float hg = fminf(g[q], 7.0f), hu = fminf(fmaxf(uu[q], -7.0f), 7.0f);
                        o[n][q] = hg * fast_sigmoid(1.702f * hg) * (hu + 1.0f); } }
                v2u w; w.x = pk4_fp8(o[0][0], o[0][1], o[0][2], o[0][3], 4.0f); w.y = pk4_fp8(o[1][0], o[1][1], o[1][2], o[1][3], 4.0f);
                *(v2u*)rowp = w; }
    }
};
struct EpiDown {
    static constexpr bool PERM = true, KEEP = false;
    bf16_t* YS; const float* bd; float ascale;
    __device__ __forceinline__ void operator()(f32x4 (&acc)[2][2][4][2], const Unit& u, int wr, int wc, int fr, int fq) const {
        const int row0 = u.pm * BM + wr * 64 + fr, col0 = u.pn * BM + wc * 32 + 8 * fq, e = u.aux;
        f32x4 bv[2][2];
#pragma unroll
        for (int bj = 0; bj < 2; ++bj)
#pragma unroll
            for (int n = 0; n < 2; ++n) bv[bj][n] = *(const f32x4*)(bd + e * 1024 + col0 + bj * HALF + 4 * n);
#pragma unroll
        for (int ai = 0; ai < 2; ++ai)
#pragma unroll
            for (int m = 0; m < 4; ++m) { bf16_t* rowp = YS + (size_t)(row0 + ai * HALF + m * 16) * 1024 + col0;
#pragma unroll
                for (int bj = 0; bj < 2; ++bj) { const f32x4 v0 = acc[ai][bj][m][0] * ascale + bv[bj][0], v1 = acc[ai][bj][m][1] * ascale + bv[bj][1];
                    u32x4 w; w.x = cvt_pk_bf16(v0[0], v0[1]); w.y = cvt_pk_bf16(v0[2], v0[3]); w.z = cvt_pk_bf16(v1[0], v1[1]); w.w = cvt_pk_bf16(v1[2], v1[3]);
                    *(u32x4*)(rowp + bj * HALF) = w; } }
    }
};
}

#define XB_TMO      128
#define XB_XCNT(j)  (256  + 64 * (j))
#define XB_XSUB(j)  (1280 + 64 * (j))
#define XB_XGEN(j)  (2304 + 64 * (j))
#define XB_TOP      3328
#define XB_TOPGEN   3392
#define XCD_BAR_WORDS 3456
#define XB_SPIN_CAP (1u << 18)

__device__ __forceinline__ unsigned xb_ld(unsigned* p)              { return __hip_atomic_load(p, __ATOMIC_RELAXED, __HIP_MEMORY_SCOPE_AGENT); }
__device__ __forceinline__ unsigned xb_add(unsigned* p, unsigned v) { return __hip_atomic_fetch_add(p, v, __ATOMIC_RELAXED, __HIP_MEMORY_SCOPE_AGENT); }
__device__ __forceinline__ unsigned xb_xcc_id() { return (unsigned)__builtin_amdgcn_s_getreg((3 << 11) | 20) & 0xFu; }
#define XB_SPIN(cond, bar) do { unsigned _sp = 0; while (cond) { __builtin_amdgcn_s_sleep(1); \
    if ((++_sp & 255u) == 0u) { if (xb_ld(&(bar)[XB_TMO])) break; if (_sp > XB_SPIN_CAP) { atomicAdd(&(bar)[XB_TMO], 1u); break; } } } } while (0)

struct XcdBarrier { unsigned* bar; unsigned x; volatile LAS unsigned* st; };

__device__ __forceinline__ XcdBarrier xcd_barrier_post(unsigned* bar, volatile LAS unsigned* st) {
    XcdBarrier b; b.bar = bar; b.x = xb_xcc_id(); b.st = st;
    if (threadIdx.x == 0) (void)xb_add(&bar[XB_XCNT(b.x)], 1u);
    return b;
}
__device__ __forceinline__ void xcd_barrier_complete(unsigned* bar, unsigned x, unsigned& nloc, unsigned& nx) {
    const unsigned G = gridDim.x * gridDim.y * gridDim.z;
    unsigned sum, cnt, mine, sp = 0u;
    for (;;) {
        sum = 0u; cnt = 0u; mine = 0u;
#pragma unroll
        for (unsigned j = 0; j < 16; ++j) { const unsigned c = xb_ld(&bar[XB_XCNT(j)]); sum += c; cnt += (c > 0u) ? 1u : 0u; mine = (j == x) ? c : mine; }
        if (sum == G) break;
        __builtin_amdgcn_s_sleep(1);
        if ((++sp & 255u) == 0u) { if (xb_ld(&bar[XB_TMO])) break; if (sp > XB_SPIN_CAP) { atomicAdd(&bar[XB_TMO], 1u); break; } }
    }
    nloc = mine > 0u ? mine : 1u; nx = cnt > 0u ? cnt : 1u;
}
__device__ __forceinline__ void xcd_barrier(const XcdBarrier& b) {
    asm volatile("s_waitcnt vmcnt(0)" ::: "memory");
    __syncthreads();
    if (threadIdx.x == 0) {
        unsigned* bar = b.bar;
        __builtin_amdgcn_s_waitcnt(0);
        unsigned nloc = b.st[0], nx = b.st[1];
        if (nloc == 0u) { xcd_barrier_complete(bar, b.x, nloc, nx); b.st[0] = nloc; b.st[1] = nx; }
        const unsigned old = xb_add(&bar[XB_XSUB(b.x)], 1u);
        const unsigned gen = old / nloc;
        if (old + 1u == (gen + 1u) * nloc) {
            __builtin_amdgcn_fence(__ATOMIC_RELEASE, "agent");
            asm volatile("s_waitcnt vmcnt(0)" ::: "memory");
            const unsigned og = xb_add(&bar[XB_TOP], 1u);
            const unsigned tg = og / nx;
            if (og + 1u == (tg + 1u) * nx) xb_add(&bar[XB_TOPGEN], 1u);
            else XB_SPIN(xb_ld(&bar[XB_TOPGEN]) == tg, bar);
            __builtin_amdgcn_fence(__ATOMIC_ACQUIRE, "agent");
            xb_add(&bar[XB_XGEN(b.x)], 1u);
            asm volatile("s_waitcnt vmcnt(0)" ::: "memory");
        } else {
            XB_SPIN(xb_ld(&bar[XB_XGEN(b.x)]) == gen, bar);
            __builtin_amdgcn_fence(__ATOMIC_ACQUIRE, "agent");
            asm volatile("s_waitcnt vmcnt(0)" ::: "memory");
        }
    }
    __syncthreads();
}

struct Frame {
    LAS unsigned char* lds;
    unsigned* ctl;
    unsigned char* ws;
    int tid, lane, wave, G, bid;
};

__host__ __device__ __forceinline__ int inproj_phys(int nl) {
    if (nl < 768) return nl;
    if (nl < 1536) { const int x = nl - 768, slot = x >> 6, d = x & 63; return 768 + (slot >> 2) * 256 + (d >> 5) * 128 + (slot & 3) * 32 + (d & 31); }
    if (nl < 1920) return 2304 + (nl - 1536);
    if (nl < 2688) { const int x = nl - 1920, slot = x / 48, d = x - slot * 48, hf = d >= 24 ? 1 : 0, p = slot * 24 + d - 24 * hf; return 1536 + (p >> 7) * 256 + hf * 128 + (p & 127); }
    if (nl < 3072) return 2304 + 384 + (nl - 2688);
    return nl;
}
template <class RowMap>
__device__ __forceinline__ void transpose_item(const float* W, int N, bf16* dst, int ldd, int k0, int n0, const RowMap rowmap, LAS float* scr, int lane) {
#pragma unroll 8
    for (int i = 0; i < 32; ++i) { const int kk = 2 * i + (lane >> 5); scr[kk * 33 + (lane & 31)] = W[(size_t)(k0 + kk) * N + n0 + (lane & 31)]; }
    LDS_WAIT(); asm volatile("" ::: "memory");
    const int c = lane & 7;
#pragma unroll
    for (int j = 0; j < 4; ++j) { const int n = (lane >> 3) + 8 * j; const LAS float* sp = scr + (8 * c) * 33 + n;
        v4u o; o.x = pk2(sp[0 * 33], sp[1 * 33]); o.y = pk2(sp[2 * 33], sp[3 * 33]); o.z = pk2(sp[4 * 33], sp[5 * 33]); o.w = pk2(sp[6 * 33], sp[7 * 33]);
        *(v4u*)(dst + (size_t)rowmap(n0 + n) * ldd + k0 + 8 * c) = o; }
    LDS_WAIT(); asm volatile("" ::: "memory");
}

template <class RowMap>
__device__ __forceinline__ void transpose_item_fp8(const float* W, int N, unsigned char* dst, int ldd, int k0, int n0, const RowMap rowmap, LAS float* scr, int lane, float qs) {
#pragma unroll 8
    for (int i = 0; i < 32; ++i) { const int kk = 2 * i + (lane >> 5); scr[kk * 33 + (lane & 31)] = W[(size_t)(k0 + kk) * N + n0 + (lane & 31)]; }
    LDS_WAIT(); asm volatile("" ::: "memory");
    const int c = lane & 7;
#pragma unroll
    for (int j = 0; j < 4; ++j) { const int n = (lane >> 3) + 8 * j; const LAS float* sp = scr + (8 * c) * 33 + n;
        v2u o; o.x = pk4_fp8(sp[0 * 33], sp[1 * 33], sp[2 * 33], sp[3 * 33], qs); o.y = pk4_fp8(sp[4 * 33], sp[5 * 33], sp[6 * 33], sp[7 * 33], qs);
        *(v2u*)(dst + (size_t)rowmap(n0 + n) * ldd + k0 + 8 * c) = o; }
    LDS_WAIT(); asm volatile("" ::: "memory");
}

struct Args { const float* in[22]; float* out; unsigned char* ws; int ph_lo, ph_hi; float lam_init[4]; };

__device__ __forceinline__ void p_prologue(Frame& F, const Args& a) {
    LAS float* scr = (LAS float*)(F.lds + F.wave * 16384);
    const int gw = F.bid * 8 + F.wave, NGW = F.G * 8;
    constexpr int PER_LAYER = 3072 + 128 + 64 + 192 + 512 + 32 * 1536;
    for (int it = gw; it < DEPTH * PER_LAYER; it += NGW) {
        const int l = it / PER_LAYER; int r = it - l * PER_LAYER;
        if (r < 3072) { const int kb = r / 192, nb = r % 192;
            if (nb < 96) transpose_item(a.in[1] + (size_t)l * 1024 * INC, INC, (bf16*)(F.ws + WS_WIN) + (size_t)l * INC * 1024, 1024, kb * 64, nb * 32, [](int n) { return inproj_phys(n); }, scr, F.lane);
            else transpose_item_fp8(a.in[1] + (size_t)l * 1024 * INC, INC, (unsigned char*)(F.ws + WS_WIN8) + (size_t)l * 3072 * 1024, 1024, kb * 64, nb * 32, [](int n) { return n - 3072; }, scr, F.lane, 32.f);
            continue; }
        r -= 3072;
        if (r < 128) { const int kb = r / 32, nb = r % 32;
            transpose_item(a.in[3] + (size_t)l * 256 * 1024, 1024, (bf16*)(F.ws + WS_WPROJ) + (size_t)l * 1024 * WPK + 0, WPK, kb * 64, nb * 32, [](int n) { return n; }, scr, F.lane); continue; }
        r -= 128;
        if (r < 64) { const int kb = r / 32, nb = r % 32;
            transpose_item(a.in[4] + (size_t)l * 128 * 1024, 1024, (bf16*)(F.ws + WS_WPROJ) + (size_t)l * 1024 * WPK + 256, WPK, kb * 64, nb * 32, [](int n) { return n; }, scr, F.lane); continue; }
        r -= 64;
        if (r < 192) { const int kb = r / 32, nb = r % 32;
            transpose_item(a.in[5] + (size_t)l * 384 * 1024, 1024, (bf16*)(F.ws + WS_WPROJ) + (size_t)l * 1024 * WPK + 512, WPK, kb * 64, nb * 32, [](int n) { return n; }, scr, F.lane); continue; }
        r -= 192;
        if (r < 512) { const int kb = r / 32, nb = r % 32;
            transpose_item(a.in[6] + (size_t)l * 1024 * 1024, 1024, (bf16*)(F.ws + WS_WOUT) + (size_t)l * 1024 * 1024, 1024, kb * 64, nb * 32, [](int n) { return n; }, scr, F.lane); continue; }
        r -= 512;
        { const int e = r / 1536, r2 = r % 1536, mtx = r2 / 512, r3 = r2 % 512, kb = r3 / 32, nb = r3 % 32;
          const size_t eoff = ((size_t)l * NEXP + e) * 1024 * 1024;
          if (mtx == 0) transpose_item_fp8(a.in[14] + eoff, 1024, (unsigned char*)(F.ws + WS_WGU) + 2 * eoff, 1024, kb * 64, nb * 32, [](int n) { return (n >> 7) * 256 + (n & 127); }, scr, F.lane, 32.f);
          else if (mtx == 1) transpose_item_fp8(a.in[16] + eoff, 1024, (unsigned char*)(F.ws + WS_WGU) + 2 * eoff, 1024, kb * 64, nb * 32, [](int n) { return (n >> 7) * 256 + 128 + (n & 127); }, scr, F.lane, 32.f);
          else transpose_item_fp8(a.in[18] + eoff, 1024, (unsigned char*)(F.ws + WS_WDN) + eoff, 1024, kb * 64, nb * 32, [](int n) { return n; }, scr, F.lane, 64.f); }
    }
    { const int gt = F.bid * 512 + F.tid, NT = F.G * 512;
      for (int i = gt; i < DEPTH * 1024 * 16; i += NT) { const int row = i >> 4, ch = i & 15;
          *(v4u*)((bf16*)(F.ws + WS_WPROJ) + (size_t)row * WPK + 384 + ch * 8) = (v4u){0u, 0u, 0u, 0u}; }
      for (int i = gt; i < SEQ * 32; i += NT) { const int pos = i >> 5, j = i & 31;
          const float inv = 1.0f / powf(10000.0f, (float)(2 * j) / 64.0f); const float ang = (float)pos * inv; float s, c; sincosf(ang, &s, &c);
          ((f32x2*)(F.ws + WS_ROPE64))[i] = (f32x2){c, s}; }
      for (int i = gt; i < SEQ * 24; i += NT) { const int pos = i / 24, j = i - pos * 24;
          const float inv = 1.0f / powf(10000.0f, (float)(2 * j) / 48.0f); const float ang = (float)pos * inv; float s, c; sincosf(ang, &s, &c);
          ((f32x2*)(F.ws + WS_ROPE48))[i] = (f32x2){c, s}; }
      for (int i = gt; i < DEPTH * 32 * 1024; i += NT) { const int l = i >> 15, e = (i >> 10) & 31, k = i & 1023;
          const float wv = a.in[12][((size_t)l * 1024 + k) * 32 + e]; const unsigned hi = f2bf(wv); const unsigned lo = f2bf(wv - __uint_as_float(hi << 16));
          bf16* wt = (bf16*)(F.ws + WS_WRT) + (size_t)l * 2 * 32 * 1024; wt[e * 1024 + k] = (bf16)hi; wt[32 * 1024 + e * 1024 + k] = (bf16)lo; }
      const f32x4* x4 = (const f32x4*)a.in[0]; v2u* xb = (v2u*)(F.ws + WS_XB);
      unsigned* xb8 = (unsigned*)(F.ws + WS_XB8);
      for (int i = gt; i < NTOK * 256; i += NT) { const f32x4 v = x4[i]; xb[i] = (v2u){pk2(v[0], v[1]), pk2(v[2], v[3])}; xb8[i] = pk4_fp8(v[0], v[1], v[2], v[3], 1.0f); }
    }
}

typedef float f32x16 __attribute__((ext_vector_type(16)));
typedef short s16x4 __attribute__((ext_vector_type(4)));
typedef float f32x2_t __attribute__((ext_vector_type(2)));
typedef __bf16 bf16x2_t __attribute__((ext_vector_type(2)));
__device__ __forceinline__ unsigned cvtpk(float lo, float hi) { const f32x2_t v = {lo, hi}; const bf16x2_t b = __builtin_convertvector(v, bf16x2_t); return __builtin_bit_cast(unsigned, b); }
__device__ __forceinline__ int kperm(int r) { return (r & ~12) | ((r & 4) << 1) | ((r & 8) >> 1); }
__device__ __forceinline__ s16x4 ds_tr16(const LAS unsigned char* p) { return __builtin_bit_cast(s16x4, __builtin_amdgcn_ds_read_tr16_b64_v4i16((LAS s16x4*)p)); }

__device__ __forceinline__ float fmax_nc(float a, float b) { return __builtin_amdgcn_fmed3f(a, b, __builtin_inff()); }
__device__ __forceinline__ void glds16(const void* gsrc, unsigned lds_dst) { unsigned keep;
    asm volatile("s_mov_b32 %0, m0\n\ts_mov_b32 m0, %2\n\ts_nop 0\n\tglobal_load_lds_dwordx4 %1, off\n\ts_mov_b32 m0, %0" : "=&s"(keep) : "v"(gsrc), "s"(lds_dst) : "memory"); }
__device__ __forceinline__ void attnC_pipe(Frame& F, const float* lamv, const float* ng, float lam_init) {
    const bf16* H = (const bf16*)(F.ws + WS_H); bf16* Y = (bf16*)(F.ws + WS_Y);
    const int lane = F.lane, w = F.wave, n = lane & 31, hh = lane >> 5;
    float l01 = 0.f, l23 = 0.f;
    if (lane < 48) { l01 = lamv[lane] * lamv[48 + lane]; l23 = lamv[96 + lane] * lamv[144 + lane]; }
    l01 = wave_sum(l01); l23 = wave_sum(l23);
    const float lam = expf(l01) - expf(l23) + lam_init;
    const float post = 1.0f - lam_init;
    constexpr int KST = 208, VST = 192, KBYTES = 64 * KST, STAGE = KBYTES + 64 * VST, NT = SEQ / 64;
    constexpr float CS = 0.14433756729740643f * 1.4426950408889634f;
    constexpr float PMAX = 256.0f;
    unsigned goff[4], loff[4];
#pragma unroll
    for (int j = 0; j < 4; ++j) { const int I = w + 8 * j;
        if (I < 13) { const int cid = I * 64 + lane, row = cid / 13; int col = cid - row * 13; if (col == 12) col = 0;
            goff[j] = (unsigned)(row * INC + C_KC + col * 8) * 2u; loff[j] = (unsigned)(I * 1024); }
        else { const int cid = (I - 13) * 64 + lane, row = cid / 12, col = cid - row * 12;
            goff[j] = (unsigned)(row * INC + C_VC + col * 8) * 2u; loff[j] = (unsigned)(KBYTES + (I - 13) * 1024); } }
    const int koff = kperm(n) * KST + hh * 16;
    const int g = lane >> 4, i16 = lane & 15;
    const int voff = KBYTES + (8 * (g >> 1) + (i16 >> 2)) * VST + (16 * (g & 1) + 4 * (i16 & 3)) * 2;
#define C_ISSUE(tt) do { const char* gb_ = gbase + (size_t)(tt) * (64 * INC * 2); const int so_ = ((tt) & 3) * STAGE; _Pragma("unroll") for (int j_ = 0; j_ < 4; ++j_) if (w + 8 * j_ < 25) \
        glds16(gb_ + goff[j_], (unsigned)__builtin_amdgcn_readfirstlane((int)(unsigned)(size_t)(F.lds + so_ + loff[j_]))); } while (0)
#define C_RDV(slotV, kbV, s2v) do { _Pragma("unroll") for (int d_ = 0; d_ < 3; ++d_) { const LAS unsigned char* vp_ = (slotV) + voff + ((kbV) * 32 + 16 * (s2v)) * VST + d_ * 64; \
            const s16x4 v0_ = ds_tr16(vp_), v1_ = ds_tr16(vp_ + 4 * VST); vf[d_] = (bf16x8){v0_[0], v0_[1], v0_[2], v0_[3], v1_[0], v1_[1], v1_[2], v1_[3]}; } } while (0)
#define C_RD(slotK, kbK, cK, slotV, kbV) do { C_RDV(slotV, kbV, 0); } while (0)
#define C_MM(dst, slotK, kbK, cK, cV, pf, slotV, kbV) do { \
        _Pragma("unroll") for (int s_ = 0; s_ < 3; ++s_) kf[s_] = *(const LAS bf16x8*)((slotK) + (kbK) * 32 * KST + koff + ((cK) * 6 + 2 * s_) * 16); \
        _Pragma("unroll") for (int d_ = 0; d_ < 3; ++d_) O[cV][d_] = __builtin_amdgcn_mfma_f32_32x32x16_bf16(vf[d_], pf[0], O[cV][d_], 0, 0, 0); \
        C_FENCE; C_RDV(slotV, kbV, 1); \
        dst = __builtin_amdgcn_mfma_f32_32x32x16_bf16(kf[0], qf[cK][0], NEGR[cK], 0, 0, 0); dst = __builtin_amdgcn_mfma_f32_32x32x16_bf16(kf[1], qf[cK][1], dst, 0, 0, 0); dst = __builtin_amdgcn_mfma_f32_32x32x16_bf16(kf[2], qf[cK][2], dst, 0, 0, 0); \
        C_FENCE; \
        _Pragma("unroll") for (int d_ = 0; d_ < 3; ++d_) O[cV][d_] = __builtin_amdgcn_mfma_f32_32x32x16_bf16(vf[d_], pf[1], O[cV][d_], 0, 0, 0); } while (0)
#define C_QK0(dst, slotbase) do { { const bf16x8 kf_ = *(const LAS bf16x8*)((slotbase) + koff); dst = __builtin_amdgcn_mfma_f32_32x32x16_bf16(kf_, qf[0][0], NEGR[0], 0, 0, 0); } \
        _Pragma("unroll") for (int s_ = 1; s_ < 3; ++s_) { const bf16x8 kf_ = *(const LAS bf16x8*)((slotbase) + koff + (2 * s_) * 16); dst = __builtin_amdgcn_mfma_f32_32x32x16_bf16(kf_, qf[0][s_], dst, 0, 0, 0); } } while (0)
#define C_SM(Sx, c, pf, slotK, kbK) do { _Pragma("unroll") for (int r_ = 0; r_ < 16; ++r_) Sx[r_] = __builtin_amdgcn_exp2f(Sx[r_]); \
        float pm_ = fmaxf(fmaxf(Sx[0], Sx[1]), Sx[2]); _Pragma("unroll") for (int r_ = 3; r_ < 15; r_ += 2) pm_ = fmaxf(fmaxf(pm_, Sx[r_]), Sx[r_ + 1]); pm_ = fmaxf(pm_, Sx[15]); \
        pm_ = fmaxf(pm_, __shfl_xor(pm_, 32)); \
        if (__any(pm_ > PMAX) || first) { \
            { const bf16x8 k0_ = *(const LAS bf16x8*)((slotK) + (kbK) * 32 * KST + koff + ((c) * 6 + 0) * 16), k1_ = *(const LAS bf16x8*)((slotK) + (kbK) * 32 * KST + koff + ((c) * 6 + 2) * 16), k2_ = *(const LAS bf16x8*)((slotK) + (kbK) * 32 * KST + koff + ((c) * 6 + 4) * 16); \
              Sx = __builtin_amdgcn_mfma_f32_32x32x16_bf16(k0_, qf[c][0], NEGR[c], 0, 0, 0); Sx = __builtin_amdgcn_mfma_f32_32x32x16_bf16(k1_, qf[c][1], Sx, 0, 0, 0); Sx = __builtin_amdgcn_mfma_f32_32x32x16_bf16(k2_, qf[c][2], Sx, 0, 0, 0); } \
            float mx_ = fmax_nc(Sx[0], Sx[1]); _Pragma("unroll") for (int r_ = 2; r_ < 16; ++r_) mx_ = fmax_nc(mx_, Sx[r_]); mx_ = fmaxf(mx_, __shfl_xor(mx_, 32)); \
            const float dl_ = (pm_ > PMAX || first) ? mx_ : 0.0f, al_ = __builtin_amdgcn_exp2f(-dl_); \
            _Pragma("unroll") for (int d_ = 0; d_ < 3; ++d_) _Pragma("unroll") for (int r_ = 0; r_ < 16; ++r_) O[c][d_][r_] *= al_; l[c] *= al_; \
            _Pragma("unroll") for (int r_ = 0; r_ < 16; ++r_) { NEGR[c][r_] -= dl_; Sx[r_] = __builtin_amdgcn_exp2f(Sx[r_] - dl_); } } \
        _Pragma("unroll") for (int r_ = 0; r_ < 16; ++r_) l[c] += Sx[r_]; \
        _Pragma("unroll") for (int s2_ = 0; s2_ < 2; ++s2_) { v4u pw_; pw_.x = cvtpk(Sx[8 * s2_ + 0], Sx[8 * s2_ + 1]); pw_.y = cvtpk(Sx[8 * s2_ + 2], Sx[8 * s2_ + 3]); \
            pw_.z = cvtpk(Sx[8 * s2_ + 4], Sx[8 * s2_ + 5]); pw_.w = cvtpk(Sx[8 * s2_ + 6], Sx[8 * s2_ + 7]); pf[s2_] = __builtin_bit_cast(bf16x8, pw_); } } while (0)
#define C_FENCE __builtin_amdgcn_sched_barrier(0)
    for (int unit = F.bid; unit < 512; unit += F.G) {
        const int b = unit >> 6, h = (unit >> 4) & 3, qb = unit & 15;
        const int tok = b * SEQ + qb * 256 + w * 32 + n;
        const char* gbase = (const char*)(H + (size_t)(b * SEQ) * INC + h * 96);
        C_ISSUE(0); C_ISSUE(1);
        bf16x8 qf[2][3];
        { const bf16* qp = H + (size_t)tok * INC + C_QC + h * 96 + 8 * hh;
#pragma unroll
          for (int c = 0; c < 2; ++c)
#pragma unroll
              for (int s = 0; s < 3; ++s) { const v4u qw = *(const v4u*)(qp + c * 48 + 16 * s);
                  v4u qs; qs.x = cvtpk(bflo(qw.x) * CS, bfhi(qw.x) * CS); qs.y = cvtpk(bflo(qw.y) * CS, bfhi(qw.y) * CS); qs.z = cvtpk(bflo(qw.z) * CS, bfhi(qw.z) * CS); qs.w = cvtpk(bflo(qw.w) * CS, bfhi(qw.w) * CS);
                  qf[c][s] = __builtin_bit_cast(bf16x8, qs); } }
        f32x16 O[2][3];
#pragma unroll
        for (int c = 0; c < 2; ++c)
#pragma unroll
            for (int d = 0; d < 3; ++d)
#pragma unroll
                for (int r = 0; r < 16; ++r) O[c][d][r] = 0.f;
        float l[2] = {0.f, 0.f};
        f32x16 NEGR[2];
#pragma unroll
        for (int c = 0; c < 2; ++c)
#pragma unroll
            for (int r = 0; r < 16; ++r) NEGR[c][r] = 0.f;
        f32x16 Sa, Sb; bf16x8 pf[2], kf[3], vf[3];
        {
            for (int t = 0; t < NT; ++t) {
                asm volatile("s_waitcnt vmcnt(0)" ::: "memory"); __builtin_amdgcn_s_barrier(); asm volatile("" ::: "memory");
                if (t + 2 < NT) C_ISSUE(t + 2);
                const LAS unsigned char* cur = F.lds + (t & 3) * STAGE;
                const LAS unsigned char* nxt = F.lds + ((t + 1 < NT ? t + 1 : t) & 3) * STAGE;
                if (t == 0) C_QK0(Sa, cur);
                { const bool first = (t == 0);
                C_RD(cur, 0, 1, cur, 0); C_FENCE; C_SM(Sa, 0, pf, cur, 0); C_FENCE; C_MM(Sb, cur, 0, 1, 0, pf, cur, 0); C_FENCE;
                C_RD(cur, 1, 0, cur, 0); C_FENCE; C_SM(Sb, 1, pf, cur, 0); C_FENCE; C_MM(Sa, cur, 1, 0, 1, pf, cur, 0); C_FENCE; }
                { const bool first = false;
                C_RD(cur, 1, 1, cur, 1); C_FENCE; C_SM(Sa, 0, pf, cur, 1); C_FENCE; C_MM(Sb, cur, 1, 1, 0, pf, cur, 1); C_FENCE;
                C_RD(nxt, 0, 0, cur, 1); C_FENCE; C_SM(Sb, 1, pf, cur, 1); C_FENCE; C_MM(Sa, nxt, 0, 0, 1, pf, cur, 1); C_FENCE; }
            }
        }
        const float l0 = l[0] + __shfl_xor(l[0], 32), l1 = l[1] + __shfl_xor(l[1], 32);
        const float i0 = 1.0f / l0, i1 = lam / l1;
        float ss = 0.f;
#pragma unroll
        for (int d = 0; d < 3; ++d)
#pragma unroll
            for (int r = 0; r < 16; ++r) { const float o = O[0][d][r] * i0 - O[1][d][r] * i1; O[0][d][r] = o; ss += o * o; }
        ss += __shfl_xor(ss, 32);
        const float rs = rsqrtf(ss * (1.0f / 96.0f) + LN_EPS) * post;
        bf16* yp = Y + (size_t)tok * YLD + Y_C + h * 96 + 4 * hh;
#pragma unroll
        for (int d = 0; d < 3; ++d)
#pragma unroll
            for (int rg = 0; rg < 4; ++rg) { const f32x4 gv = *(const f32x4*)(ng + d * 32 + 8 * rg + 4 * hh);
                v2u o; o.x = pk2(O[0][d][4 * rg + 0] * rs * gv[0], O[0][d][4 * rg + 1] * rs * gv[1]); o.y = pk2(O[0][d][4 * rg + 2] * rs * gv[2], O[0][d][4 * rg + 3] * rs * gv[3]);
                *(v2u*)(yp + d * 32 + 8 * rg) = o; }
        asm volatile("s_waitcnt vmcnt(0)" ::: "memory"); __builtin_amdgcn_s_barrier(); asm volatile("" ::: "memory");
    }
#undef C_ISSUE
#undef C_RD
#undef C_RDV
#undef C_MM
#undef C_QK0
#undef C_SM
#undef C_FENCE
}

constexpr int AB_VST = 192, AB_VREG = 32 * AB_VST;
constexpr int L_RPB = 51200;

__device__ __forceinline__ void sm_block64(f32x16& t, float& m, float& l, f32x16 (&O)[2], bf16x8 (&pf)[2]) {
    float mx = fmaxf(t[0], t[1]);
#pragma unroll
    for (int r = 2; r < 16; ++r) mx = fmaxf(mx, t[r]);
    mx = fmaxf(mx, __shfl_xor(mx, 32));
    if (__any(mx > m)) {
        const float mn = fmaxf(m, mx), alpha = __builtin_amdgcn_exp2f(m - mn);
#pragma unroll
        for (int d = 0; d < 2; ++d)
#pragma unroll
            for (int r = 0; r < 16; ++r) O[d][r] *= alpha;
        l *= alpha; m = mn;
    }
#pragma unroll
    for (int r = 0; r < 16; ++r) { t[r] = __builtin_amdgcn_exp2f(t[r] - m); l += t[r]; }
#pragma unroll
    for (int s2 = 0; s2 < 2; ++s2) { v4u pw; pw.x = cvtpk(t[8 * s2 + 0], t[8 * s2 + 1]); pw.y = cvtpk(t[8 * s2 + 2], t[8 * s2 + 3]);
        pw.z = cvtpk(t[8 * s2 + 4], t[8 * s2 + 5]); pw.w = cvtpk(t[8 * s2 + 6], t[8 * s2 + 7]); pf[s2] = __builtin_bit_cast(bf16x8, pw); }
}
template <class TokOf, class MaskT>
__device__ __forceinline__ void attn_run_blocks(const bf16* H, const int kcol, const int vcol, const int nb, const TokOf tok_of, const MaskT mask,
                                                const bf16x8 (&qf)[4], LAS unsigned char* vl, const int lane, f32x16 (&O)[2], float& m, float& l) {
    const int n = lane & 31, hh = lane >> 5, krow = kperm(n), g = lane >> 4, i16 = lane & 15;
    const int vrd = (8 * (g >> 1) + (i16 >> 2)) * AB_VST + (16 * (g & 1) + 4 * (i16 & 3)) * 2;
    bf16x8 kf[4]; v4u vc[4];
    { const bf16* kp = H + (size_t)tok_of(0, krow) * INC + kcol + 8 * hh;
#pragma unroll
      for (int s = 0; s < 4; ++s) kf[s] = *(const bf16x8*)(kp + 16 * s);
#pragma unroll
      for (int i = 0; i < 4; ++i) vc[i] = *(const v4u*)(H + (size_t)tok_of(0, (lane >> 3) + 8 * i) * INC + vcol + (lane & 7) * 8); }
#pragma unroll
    for (int i = 0; i < 4; ++i) *(LAS v4u*)(vl + ((lane >> 3) + 8 * i) * AB_VST + (lane & 7) * 16) = vc[i];
    for (int j = 0; j < nb; ++j) {
        const int jn = (j + 1 < nb) ? j + 1 : j;
        bf16x8 kn[4];
        { const bf16* kp = H + (size_t)tok_of(jn, krow) * INC + kcol + 8 * hh;
#pragma unroll
          for (int s = 0; s < 4; ++s) kn[s] = *(const bf16x8*)(kp + 16 * s);
#pragma unroll
          for (int i = 0; i < 4; ++i) vc[i] = *(const v4u*)(H + (size_t)tok_of(jn, (lane >> 3) + 8 * i) * INC + vcol + (lane & 7) * 8); }
        f32x16 S;
#pragma unroll
        for (int r = 0; r < 16; ++r) S[r] = 0.f;
#pragma unroll
        for (int s = 0; s < 4; ++s) S = __builtin_amdgcn_mfma_f32_32x32x16_bf16(kf[s], qf[s], S, 0, 0, 0);
        mask(j, S);
        bf16x8 pf[2];
        sm_block64(S, m, l, O, pf);
        LDS_WAIT();
#pragma unroll
        for (int s2 = 0; s2 < 2; ++s2)
#pragma unroll
            for (int d = 0; d < 2; ++d) { const LAS unsigned char* vp = vl + vrd + 16 * s2 * AB_VST + d * 64;
                const s16x4 v0 = ds_tr16(vp), v1 = ds_tr16(vp + 4 * AB_VST);
                const bf16x8 vf = (bf16x8){v0[0], v0[1], v0[2], v0[3], v1[0], v1[1], v1[2], v1[3]};
                O[d] = __builtin_amdgcn_mfma_f32_32x32x16_bf16(vf, pf[s2], O[d], 0, 0, 0); }
        LDS_WAIT(); asm volatile("" ::: "memory");
#pragma unroll
        for (int i = 0; i < 4; ++i) *(LAS v4u*)(vl + ((lane >> 3) + 8 * i) * AB_VST + (lane & 7) * 16) = vc[i];
#pragma unroll
        for (int s = 0; s < 4; ++s) kf[s] = kn[s];
    }
    LDS_WAIT(); asm volatile("" ::: "memory");
}
__device__ __forceinline__ void attn_store64(bf16* yrow, const f32x16 (&O)[2], float l, int hh) {
    const float lt = l + __shfl_xor(l, 32), inv = 1.0f / lt;
#pragma unroll
    for (int d = 0; d < 2; ++d)
#pragma unroll
        for (int rg = 0; rg < 4; ++rg) { v2u o; o.x = pk2(O[d][4 * rg + 0] * inv, O[d][4 * rg + 1] * inv); o.y = pk2(O[d][4 * rg + 2] * inv, O[d][4 * rg + 3] * inv);
            *(v2u*)(yrow + d * 32 + 8 * rg + 4 * hh) = o; }
}

__device__ __forceinline__ void attnA_mfma(Frame& F, const float* rpb  ) {
    const bf16* H = (const bf16*)(F.ws + WS_H); bf16* Y = (bf16*)(F.ws + WS_Y);
    LAS float* T = (LAS float*)(F.lds + L_RPB);
    for (int i = F.tid; i < 4 * 17 * 64; i += 512) { const int h = i / (17 * 64), rem = i - h * 17 * 64, ro = rem >> 6, co = rem & 63;
        const int rr = ro - 1, cc = co - 16; T[i] = (rr >= 0 && rr < 15 && cc >= 0 && cc < 31) ? rpb[(h * 15 + rr) * 31 + cc] * 1.4426950408889634f : 0.f; }
    __syncthreads();
    const int lane = F.lane, n = lane & 31, hh = lane >> 5;
    LAS unsigned char* vl = F.lds + F.wave * AB_VREG;
    const int gw = F.bid * 8 + F.wave, NGW = F.G * 8;
    for (int item = gw; item < 4096; item += NGW) {
        const int cb = item & 3, rp = (item >> 2) & 31, h = (item >> 7) & 3, b = item >> 9;
        const int r = 2 * rp + (n >> 4), c = 16 * cb + (n & 15);
        const int r0 = min(max(r - 4, 0), 56), c0 = min(max(c - 8, 0), 48);
        const int cw = min(max(16 * cb - 8, 0), 32);
        const int kr_lo = min(max(2 * rp - 4, 0), 56), kr_hi = min(max(2 * rp + 1 - 4, 0), 56) + 7;
        const int tokq = b * SEQ + r * 64 + c;
        bf16x8 qf[4];
        { const bf16* qp = H + (size_t)tokq * INC + C_QA + h * 64 + 8 * hh;
#pragma unroll
          for (int s = 0; s < 4; ++s) qf[s] = *(const bf16x8*)(qp + 16 * s); }
        f32x16 O[2];
#pragma unroll
        for (int d = 0; d < 2; ++d)
#pragma unroll
            for (int rr = 0; rr < 16; ++rr) O[d][rr] = 0.f;
        float m = -1e30f, l = 0.f;
        const int tok0 = b * SEQ + kr_lo * 64 + cw;
        auto tok_of = [=](int j, int kk) { return tok0 + j * 64 + kk; };
        const int colb = cw - c0 + 8 * hh;
        const int tb0 = (h * 17 + (kr_lo - r + 8)) * 64 + (cw - c + 31) + 8 * hh;
        const int rb = kr_lo - r0;
        auto mask = [=](int j, f32x16& S) {
            const bool rowok = (unsigned)(rb + j) < 8u; const LAS float* tp = T + tb0 + j * 64;
#pragma unroll
            for (int rr = 0; rr < 16; ++rr) { const int e = (rr & 7) + 16 * (rr >> 3);
                const bool ok = rowok && ((unsigned)(colb + e) < 16u);
                S[rr] = ok ? (S[rr] * (0.125f * 1.4426950408889634f) + tp[e]) : -INFINITY; }
        };
        attn_run_blocks(H, C_KA + h * 64, C_VA + h * 64, kr_hi - kr_lo + 1, tok_of, mask, qf, vl, lane, O, m, l);
        attn_store64(Y + (size_t)tokq * YLD + Y_A + h * 64, O, l, hh);
    }
}
__device__ __forceinline__ void attnB_mfma(Frame& F) {
    const bf16* H = (const bf16*)(F.ws + WS_H); bf16* Y = (bf16*)(F.ws + WS_Y);
    const int lane = F.lane, n = lane & 31, hh = lane >> 5;
    LAS unsigned char* vl = F.lds + F.wave * AB_VREG;
    const int gw = F.bid * 8 + F.wave, NGW = F.G * 8;
    for (int item = gw; item < 2048; item += NGW) {
        const int mblk = item & 7, r = (item >> 3) & 15, hg = (item >> 7) & 1, b = item >> 8;
        const int sq = r + 16 * (mblk * 32 + n), tokq = b * SEQ + sq;
        f32x16 O[2];
#pragma unroll
        for (int d = 0; d < 2; ++d)
#pragma unroll
            for (int rr = 0; rr < 16; ++rr) O[d][rr] = 0.f;
        float m = -1e30f, l = 0.f;
#pragma unroll 1
        for (int g = 0; g < 3; ++g) {
            const int sh = 2 * g, dil = 1 << sh, head = 2 * g + hg, L = SEQ >> sh, a = 16 >> sh, cls = r & (dil - 1);
            const int pq0 = (r >> sh) + a * (mblk * 32), pq = pq0 + a * n;
            const int pks = pq0 - 64, nb = (31 * a + 129 + 31) >> 5;
            bf16x8 qf[4];
            { const bf16* qp = H + (size_t)tokq * INC + C_QB + head * 64 + 8 * hh;
#pragma unroll
              for (int s = 0; s < 4; ++s) qf[s] = *(const bf16x8*)(qp + 16 * s); }
            const int tokb = b * SEQ + cls;
            auto tok_of = [=](int j, int kk) { const int pk = min(max(pks + 32 * j + kk, 0), L - 1); return tokb + (pk << sh); };
            const int b1 = pks - pq + 64 + 8 * hh, b2 = pks + 8 * hh;
            auto mask = [=](int j, f32x16& S) {
#pragma unroll
                for (int rr = 0; rr < 16; ++rr) { const int e = (rr & 7) + 16 * (rr >> 3) + 32 * j;
                    const bool ok = ((unsigned)(b1 + e) <= 128u) && ((unsigned)(b2 + e) < (unsigned)L);
                    S[rr] = ok ? S[rr] * (0.125f * 1.4426950408889634f) : -INFINITY; }
            };
            attn_run_blocks(H, C_KB + head * 64, C_VB + head * 64, nb, tok_of, mask, qf, vl, lane, O, m, l);
        }
        attn_store64(Y + (size_t)tokq * YLD + Y_B + hg * 64, O, l, hh);
    }
}

__device__ __forceinline__ void p_ln_router(Frame& F, const Args& a, int layer, bool dry = false) {
    const float* PRE = (const float*)(F.ws + WS_HH); float* XF = dry ? (float*)(F.ws + WS_H) : a.out; unsigned* XB8 = dry ? (unsigned*)(F.ws + WS_H + 160 * MiB) : (unsigned*)(F.ws + WS_XB8);
    const float* g1 = a.in[10] + layer * 1024; const float* b1 = a.in[11] + layer * 1024; const float* br = a.in[13] + layer * 32;
    const bf16* WT = (const bf16*)(F.ws + WS_WRT) + (size_t)layer * 2 * 32 * 1024;
    int* TOPE = (int*)(F.ws + (dry ? WS_H + 200 * MiB : WS_TOPE)); float* TOPW = (float*)(F.ws + (dry ? WS_H + 201 * MiB : WS_TOPW)); int* RANK = (int*)(F.ws + (dry ? WS_H + 202 * MiB : WS_RANK));
    const int cnt_off = dry ? CW_CUR : CW_CNT; int* SRCp = (int*)(F.ws + (dry ? WS_H + 204 * MiB : WS_SRC));
    LAS int* hist = (LAS int*)(F.lds + L_HIST); LAS int* base = (LAS int*)(F.lds + L_BASE);
    const int lane = F.lane;
    for (int chunk = F.bid; chunk < NTOK / 128; chunk += F.G) {
        if (F.tid < 32) hist[F.tid] = 0;
        __syncthreads();
        const int tok0 = chunk * 128 + F.wave * 16;
        {   f32x4 gv[4], bv[4];
#pragma unroll
            for (int j = 0; j < 4; ++j) { gv[j] = *(const f32x4*)(g1 + 4 * lane + 256 * j); bv[j] = *(const f32x4*)(b1 + 4 * lane + 256 * j); }
#pragma unroll 1
            for (int q = 0; q < 4; ++q) {
                f32x4 v[4][4]; float s[4], s2[4];
#pragma unroll
                for (int t = 0; t < 4; ++t) { const f32x4* pr = (const f32x4*)(PRE + (size_t)(tok0 + 4 * q + t) * 1024) + lane;
#pragma unroll
                    for (int j = 0; j < 4; ++j) v[t][j] = pr[64 * j]; }
#pragma unroll
                for (int t = 0; t < 4; ++t) { s[t] = 0.f;
#pragma unroll
                    for (int j = 0; j < 4; ++j) s[t] += (v[t][j][0] + v[t][j][1]) + (v[t][j][2] + v[t][j][3]); }
#pragma unroll
                for (int o = 1; o < 64; o <<= 1) {
#pragma unroll
                    for (int t = 0; t < 4; ++t) s[t] += __shfl_xor(s[t], o); }
#pragma unroll
                for (int t = 0; t < 4; ++t) { const float mean = s[t] * (1.f / 1024.f); s2[t] = 0.f;
#pragma unroll
                    for (int j = 0; j < 4; ++j) { v[t][j] = v[t][j] - mean; s2[t] += (v[t][j][0] * v[t][j][0] + v[t][j][1] * v[t][j][1]) + (v[t][j][2] * v[t][j][2] + v[t][j][3] * v[t][j][3]); } }
#pragma unroll
                for (int o = 1; o < 64; o <<= 1) {
#pragma unroll
                    for (int t = 0; t < 4; ++t) s2[t] += __shfl_xor(s2[t], o); }
#pragma unroll
                for (int t = 0; t < 4; ++t) { const float rstd = rsqrtf(s2[t] * (1.f / 1024.f) + LN_EPS);
                    f32x4* xo = (f32x4*)(XF + (size_t)(tok0 + 4 * q + t) * 1024) + lane; unsigned* xb = XB8 + (size_t)(tok0 + 4 * q + t) * 256 + lane;
#pragma unroll
                    for (int j = 0; j < 4; ++j) { const f32x4 y = v[t][j] * rstd * gv[j] + bv[j]; xo[64 * j] = y; xb[64 * j] = pk4_fp8(y[0], y[1], y[2], y[3], 1.0f); } }
            }
        }
        VM_WAIT(); asm volatile("" ::: "memory");
        const int tk = lane & 15, kq = lane >> 4;
        f32x4 acc[2] = {(f32x4){0.f, 0.f, 0.f, 0.f}, (f32x4){0.f, 0.f, 0.f, 0.f}};
        {   const float* xf = XF + (size_t)(tok0 + tk) * 1024 + 8 * kq;
            const bf16* w0 = WT + (size_t)tk * 1024 + 8 * kq;
#pragma unroll 4
            for (int st = 0; st < 32; ++st) {
                const f32x4 x0 = *(const f32x4*)(xf + 32 * st), x1 = *(const f32x4*)(xf + 32 * st + 4);
                v4u xhw; xhw.x = pk2(x0[0], x0[1]); xhw.y = pk2(x0[2], x0[3]); xhw.z = pk2(x1[0], x1[1]); xhw.w = pk2(x1[2], x1[3]);
                v4u xlw; xlw.x = pk2(x0[0] - bflo(xhw.x), x0[1] - bfhi(xhw.x)); xlw.y = pk2(x0[2] - bflo(xhw.y), x0[3] - bfhi(xhw.y));
                xlw.z = pk2(x1[0] - bflo(xhw.z), x1[1] - bfhi(xhw.z)); xlw.w = pk2(x1[2] - bflo(xhw.w), x1[3] - bfhi(xhw.w));
                const bf16x8 xh = __builtin_bit_cast(bf16x8, xhw), xl = __builtin_bit_cast(bf16x8, xlw);
#pragma unroll
                for (int mb = 0; mb < 2; ++mb) { const bf16x8 wh = *(const bf16x8*)(w0 + (size_t)mb * 16 * 1024 + 32 * st), wl = *(const bf16x8*)(w0 + (size_t)(32 + mb * 16) * 1024 + 32 * st);
                    acc[mb] = __builtin_amdgcn_mfma_f32_16x16x32_bf16(wh, xh, acc[mb], 0, 0, 0);
                    acc[mb] = __builtin_amdgcn_mfma_f32_16x16x32_bf16(wh, xl, acc[mb], 0, 0, 0);
                    acc[mb] = __builtin_amdgcn_mfma_f32_16x16x32_bf16(wl, xh, acc[mb], 0, 0, 0); }
            }
        }
        float v8[8];
#pragma unroll
        for (int mb = 0; mb < 2; ++mb)
#pragma unroll
            for (int i = 0; i < 4; ++i) v8[mb * 4 + i] = acc[mb][i] + br[16 * mb + 4 * kq + i];
        int se[4]; float sv[4];
#pragma unroll
        for (int r = 0; r < 4; ++r) {
            float bvv = v8[0]; int bi = 4 * kq;
#pragma unroll
            for (int sl = 1; sl < 8; ++sl) { const int eid = 16 * (sl >> 2) + 4 * kq + (sl & 3); if (v8[sl] > bvv) { bvv = v8[sl]; bi = eid; } }
#pragma unroll
            for (int o = 16; o < 64; o <<= 1) { const float ov = __shfl_xor(bvv, o); const int oi = __shfl_xor(bi, o);
                if (ov > bvv || (ov == bvv && oi < bi)) { bvv = ov; bi = oi; } }
            se[r] = bi; sv[r] = bvv;
#pragma unroll
            for (int sl = 0; sl < 8; ++sl) { const int eid = 16 * (sl >> 2) + 4 * kq + (sl & 3); if (eid == bi) v8[sl] = -3.0e38f; }
        }
        const float p1 = __expf(sv[1] - sv[0]), p2 = __expf(sv[2] - sv[0]), p3 = __expf(sv[3] - sv[0]);
        const float inv = 1.0f / (1.0f + p1 + p2 + p3);
        int lr[4] = {0, 0, 0, 0};
        if (lane < 16) { const int tok = tok0 + tk;
            *(int4*)(TOPE + tok * 4) = make_int4(se[0], se[1], se[2], se[3]);
            *(f32x4*)(TOPW + tok * 4) = (f32x4){inv, p1 * inv, p2 * inv, p3 * inv};
#pragma unroll
            for (int k = 0; k < 4; ++k) lr[k] = __hip_atomic_fetch_add(&hist[se[k]], 1, __ATOMIC_RELAXED, __HIP_MEMORY_SCOPE_WORKGROUP); }
        __syncthreads();
        if (F.tid < 32) { const int c = hist[F.tid]; base[F.tid] = c ? (int)__hip_atomic_fetch_add(F.ctl + cnt_off + layer * 64 + F.tid, (unsigned)c, RLX_AGENT) : 0; }
        __syncthreads();
        if (lane < 16) { const int tok = tok0 + tk;
            const int r0 = base[se[0]] + lr[0], r1 = base[se[1]] + lr[1], r2 = base[se[2]] + lr[2], r3 = base[se[3]] + lr[3];
            *(int4*)(RANK + tok * 4) = make_int4(r0, r1, r2, r3);
            int* SRC = SRCp; SRC[se[0] * NTOK + r0] = tok; SRC[se[1] * NTOK + r1] = tok; SRC[se[2] * NTOK + r2] = tok; SRC[se[3] * NTOK + r3] = tok; }
        __syncthreads();
    }
}

__device__ __forceinline__ int moe_build(Frame& F, int layer) {
    LAS int* offT = (LAS int*)(F.lds + L_OFFT); LAS int* tile_e = (LAS int*)(F.lds + L_TILE);
    __syncthreads();
    if (F.tid < 64) {
        const int c = (F.lane < 32) ? (int)__hip_atomic_load(F.ctl + CW_CNT + layer * 64 + F.lane, RLX_AGENT) : 0;
        const int ntile = (c + 255) >> 8; int x = ntile;
#pragma unroll
        for (int d = 1; d < 32; d <<= 1) { const int v = __shfl_up(x, d); if (F.lane >= d) x += v; }
        if (F.lane < 32) { offT[F.lane] = x - ntile; ((LAS int*)(F.lds + L_CNT))[F.lane] = c; }
        if (F.lane == 31) offT[32] = x;
    }
    __syncthreads();
    int T = __builtin_amdgcn_readfirstlane(offT[32]); if (T > MAXT) T = MAXT;
    for (int mt = F.tid; mt < T; mt += 512) { int e = 0;
#pragma unroll 1
        for (int j = 1; j < 32; ++j) if (offT[j] <= mt) e = j;
        tile_e[mt] = e; }
    __syncthreads();
    return T;
}

__device__ __forceinline__ void p_combine_ln(Frame& F, const Args& a, int layer, bool dry = false) {
    float* XF = a.out; float* XFo = dry ? (float*)(F.ws + WS_HH) : a.out; bf16* XB = (bf16*)(F.ws + (dry ? WS_M : WS_XB)); const bf16* YS = (const bf16*)(F.ws + WS_H);
    const int* TOPE = (const int*)(F.ws + WS_TOPE); const int* RANK = (const int*)(F.ws + WS_RANK); const float* TOPW = (const float*)(F.ws + WS_TOPW);
    const LAS int* offT = (const LAS int*)(F.lds + L_OFFT);
    const float* g2 = a.in[20] + layer * 1024; const float* b2 = a.in[21] + layer * 1024;
    const int gw = F.bid * 8 + F.wave, NGW = F.G * 8, lane = F.lane;
    f32x4 gv[4], bv[4];
#pragma unroll
    for (int j = 0; j < 4; ++j) { gv[j] = *(const f32x4*)(g2 + 4 * lane + 256 * j); bv[j] = *(const f32x4*)(b2 + 4 * lane + 256 * j); }
    for (int tp = gw; tp < NTOK / 2; tp += NGW) {
        f32x4 v[2][4]; v2u yw[2][4][4]; f32x4 tw[2];
#pragma unroll
        for (int u = 0; u < 2; ++u) { const int tok = tp * 2 + u;
            const int4 te = *(const int4*)(TOPE + tok * 4), rk = *(const int4*)(RANK + tok * 4); tw[u] = *(const f32x4*)(TOPW + tok * 4);
            const f32x4* xr = (const f32x4*)(XF + (size_t)tok * 1024) + lane;
#pragma unroll
            for (int j = 0; j < 4; ++j) v[u][j] = xr[64 * j];
            const int pk[4] = {offT[te.x] * 256 + rk.x, offT[te.y] * 256 + rk.y, offT[te.z] * 256 + rk.z, offT[te.w] * 256 + rk.w};
#pragma unroll
            for (int k = 0; k < 4; ++k) { const v2u* yr = (const v2u*)(YS + (size_t)pk[k] * 1024) + lane;
#pragma unroll
                for (int j = 0; j < 4; ++j) yw[u][k][j] = yr[64 * j]; } }
        float s[2], s2[2];
#pragma unroll
        for (int u = 0; u < 2; ++u) {
#pragma unroll
            for (int j = 0; j < 4; ++j) { v[u][j] = v[u][j] * DN_ALPHA;
#pragma unroll
                for (int k = 0; k < 4; ++k) { const v2u y = yw[u][k][j]; v[u][j] = v[u][j] + tw[u][k] * (f32x4){bflo(y.x), bfhi(y.x), bflo(y.y), bfhi(y.y)}; } }
            s[u] = 0.f;
#pragma unroll
            for (int j = 0; j < 4; ++j) s[u] += (v[u][j][0] + v[u][j][1]) + (v[u][j][2] + v[u][j][3]); }
#pragma unroll
        for (int o = 1; o < 64; o <<= 1) { s[0] += __shfl_xor(s[0], o); s[1] += __shfl_xor(s[1], o); }
#pragma unroll
        for (int u = 0; u < 2; ++u) { const float mean = s[u] * (1.f / 1024.f); s2[u] = 0.f;
#pragma unroll
            for (int j = 0; j < 4; ++j) { v[u][j] = v[u][j] - mean; s2[u] += (v[u][j][0] * v[u][j][0] + v[u][j][1] * v[u][j][1]) + (v[u][j][2] * v[u][j][2] + v[u][j][3] * v[u][j][3]); } }
#pragma unroll
        for (int o = 1; o < 64; o <<= 1) { s2[0] += __shfl_xor(s2[0], o); s2[1] += __shfl_xor(s2[1], o); }
#pragma unroll
        for (int u = 0; u < 2; ++u) { const int tok = tp * 2 + u; const float rstd = rsqrtf(s2[u] * (1.f / 1024.f) + LN_EPS);
            f32x4* xo = (f32x4*)(XFo + (size_t)tok * 1024) + lane; v2u* xb = (v2u*)(XB + (size_t)tok * 1024) + lane; unsigned* x8 = (unsigned*)(F.ws + (dry ? WS_M + 32 * MiB : WS_XB8)) + (size_t)tok * 256 + lane;
#pragma unroll
            for (int j = 0; j < 4; ++j) { const f32x4 y = v[u][j] * rstd * gv[j] + bv[j]; xo[64 * j] = y; xb[64 * j] = (v2u){pk2(y[0], y[1]), pk2(y[2], y[3])}; x8[64 * j] = pk4_fp8(y[0], y[1], y[2], y[3], 1.0f); } }
    }
}

__device__ __forceinline__ const Args* fresh_args() { unsigned long long p = (unsigned long long)__builtin_amdgcn_kernarg_segment_ptr(); asm volatile("" : "+s"(p)); return (const Args*)(const __attribute__((address_space(4))) void*)p; }
constexpr int PH_PER_LAYER = 10, N_PHASES = 1 + DEPTH * PH_PER_LAYER;
__global__ void __launch_bounds__(512, 2) mk_fwd(Args args) {
    extern __shared__ __attribute__((aligned(16))) unsigned char lds[];
    Frame F;
    F.lds = (LAS unsigned char*)lds; F.tid = threadIdx.x; F.lane = F.tid & 63; F.wave = __builtin_amdgcn_readfirstlane(F.tid >> 6);
    F.G = gridDim.x; F.bid = blockIdx.x; F.ws = fresh_args()->ws; F.ctl = (unsigned*)(F.ws + WS_CTL);
    for (int u = F.tid; u < (LDS_BYTES - LDSCTL_OFF) / 4; u += 512) ((LAS unsigned*)(F.lds + LDSCTL_OFF))[u] = 0u;
    __syncthreads();
    const int lo = fresh_args()->ph_lo, hi = fresh_args()->ph_hi;
    XcdBarrier bar; bar.bar = F.ctl + CW_BAR; bar.x = 0; bar.st = nullptr;
    if (hi - lo > 1) bar = xcd_barrier_post(F.ctl + CW_BAR, (volatile LAS unsigned*)(F.lds + L_MISC) + 8);
#define IN(k) (lo <= (k) && (k) < hi)
#define REFRESH() do { F.tid = opaque_tid(); F.lane = F.tid & 63; F.wave = __builtin_amdgcn_readfirstlane(F.tid >> 6); asm volatile("" : "+s"(F.bid), "+s"(F.G)); } while (0)
#define SEAM(k) do { if ((k) + 1 < hi) xcd_barrier(bar); } while (0)

#ifndef NO_P0
    if (IN(0)) { _Pragma("unroll") for (int rep = 0; rep < REP_T; ++rep) p_prologue(F, *fresh_args()); SEAM(0); }
#endif

    for (int l = 0; l < DEPTH; ++l) {
        const int pb = 1 + l * PH_PER_LAYER;
#ifndef NO_P1
        if (IN(pb + 0)) {
            REFRESH();
            {
                pg8::DenseOrder S{(const char*)(F.ws + WS_XB), (const char*)(F.ws + WS_WIN) + (size_t)l * INC * 1024 * 2, (size_t)256 * 1024 * 2, (size_t)256 * 1024 * 2, 16, NTOK / 256, 12, F.G, F.bid};
                pg8::EpiInProj E{(bf16*)(F.ws + WS_H), fresh_args()->in[2] + l * 3072, (const f32x2*)(F.ws + WS_ROPE64), (const f32x2*)(F.ws + WS_ROPE48), 1.0f};
                _Pragma("unroll") for (int rep = 0; rep < REP_G1; ++rep) pg8::gemm_phase<pg8::EpiInProj, pg8::DenseOrder, true, true>(F.lds, 1024, 1024, S, E);
            }
            {
                REFRESH();
                pg8::DenseOrder S{(const char*)(F.ws + WS_XB8), (const char*)(F.ws + WS_WIN8) + (size_t)l * 3072 * 1024, (size_t)256 * 1024, (size_t)256 * 1024, 8, NTOK / 256, 12, F.G, F.bid, 12};
                pg8::EpiInProj E{(bf16*)(F.ws + WS_H), fresh_args()->in[2] + l * 3072, (const f32x2*)(F.ws + WS_ROPE64), (const f32x2*)(F.ws + WS_ROPE48), 1.0f / 32.0f};
                _Pragma("unroll") for (int rep = 0; rep < REP_G1; ++rep) pg8::gemm_phase<pg8::EpiInProj, pg8::DenseOrder, true, true, true>(F.lds, 1024, 1024, S, E);
            }
            if (pb + 2 < hi) xcd_barrier(bar);
        }
#endif
#ifndef NO_P1B
#endif
        if (IN(pb + 2)) {
            REFRESH();
#ifndef NO_PC
            _Pragma("unroll") for (int rep = 0; rep < REP_C; ++rep) attnC_pipe(F, fresh_args()->in[8] + l * 4 * 48, fresh_args()->in[9] + l * 96, fresh_args()->lam_init[l]);
#endif
#ifndef NO_PA
            REFRESH();
            _Pragma("unroll") for (int rep = 0; rep < REP_AB; ++rep) attnA_mfma(F, fresh_args()->in[7] + l * 4 * 15 * 31);
#endif
#ifndef NO_PB
            REFRESH();
            _Pragma("unroll") for (int rep = 0; rep < REP_AB; ++rep) attnB_mfma(F);
#endif
            SEAM(pb + 2);
        }
#ifndef NO_P3
        if (IN(pb + 3)) {
            REFRESH();
            pg8::ProjOrder S{(const char*)(F.ws + WS_Y), (const char*)(F.ws + WS_WPROJ) + (size_t)l * 1024 * WPK * 2, NTOK / 256, 4, F.G, F.bid};
            pg8::EpiProj E{(const bf16*)(F.ws + WS_H), (bf16*)(F.ws + WS_M)};
            _Pragma("unroll") for (int rep = 0; rep < REP_G3; ++rep) pg8::gemm_phase<pg8::EpiProj, pg8::ProjOrder, true, true>(F.lds, YLD, WPK, S, E);
            SEAM(pb + 3);
        }
#endif
#ifndef NO_P4
        if (IN(pb + 4)) {
            REFRESH();
            pg8::DenseOrder S{(const char*)(F.ws + WS_M), (const char*)(F.ws + WS_WOUT) + (size_t)l * 1024 * 1024 * 2, (size_t)256 * 1024 * 2, (size_t)256 * 1024 * 2, 16, NTOK / 256, 4, F.G, F.bid};
            pg8::EpiOut E{l == 0 ? fresh_args()->in[0] : (const float*)fresh_args()->out, (float*)(F.ws + WS_HH)};
            _Pragma("unroll") for (int rep = 0; rep < REP_G4; ++rep) pg8::gemm_phase<pg8::EpiOut, pg8::DenseOrder, true, true>(F.lds, 1024, 1024, S, E);
            SEAM(pb + 4);
        }
#endif
#ifndef NO_P5
        if (IN(pb + 5)) { REFRESH(); if (DRY_P5) p_ln_router(F, *fresh_args(), l, true); p_ln_router(F, *fresh_args(), l); if (pb + 7 < hi) xcd_barrier(bar); }
#endif
#ifndef NO_P5B
#endif
#ifndef NO_P6
        if (IN(pb + 7)) {
            REFRESH(); const int T = moe_build(F, l);
            pg8::MoeOrder S{(const char*)(F.ws + WS_XB8), (const char*)(F.ws + WS_WGU) + (size_t)l * NEXP * 2048 * 1024, (size_t)2048 * 1024, (size_t)256 * 1024, (size_t)256 * 1024, 8,
                            (const LAS int*)(F.lds + L_TILE), (const LAS int*)(F.lds + L_OFFT), (const LAS int*)(F.lds + L_CNT), (const int*)(F.ws + WS_SRC), T, 8, F.G, F.bid};
            pg8::EpiSwiglu E{(unsigned char*)(F.ws + WS_HH), fresh_args()->in[15] + (size_t)l * NEXP * 1024, fresh_args()->in[17] + (size_t)l * NEXP * 1024, 1.0f / 32.0f};
            _Pragma("unroll") for (int rep = 0; rep < REP_G6; ++rep) pg8::gemm_phase_gather<pg8::EpiSwiglu, pg8::MoeOrder, true>(F.lds, (const char*)(F.ws + WS_XB8), 1024, 1024, S, E);
            SEAM(pb + 7);
        }
#endif
#ifndef NO_P7
        if (IN(pb + 8)) {
            REFRESH(); const int T = moe_build(F, l);
            pg8::MoeOrder S{(const char*)(F.ws + WS_HH), (const char*)(F.ws + WS_WDN) + (size_t)l * NEXP * 1024 * 1024, (size_t)1024 * 1024, (size_t)256 * 1024, (size_t)256 * 1024, 8,
                            (const LAS int*)(F.lds + L_TILE), (const LAS int*)(F.lds + L_OFFT), (const LAS int*)(F.lds + L_CNT), (const int*)(F.ws + WS_SRC), T, 4, F.G, F.bid};
            pg8::EpiDown E{(bf16*)(F.ws + WS_H), fresh_args()->in[19] + (size_t)l * NEXP * 1024, 1.0f / 256.0f};
            _Pragma("unroll") for (int rep = 0; rep < REP_G7; ++rep) pg8::gemm_phase<pg8::EpiDown, pg8::MoeOrder, true, true, true>(F.lds, 1024, 1024, S, E);
            SEAM(pb + 8);
        }
#endif
#ifndef NO_P8
        if (IN(pb + 9)) { REFRESH(); (void)moe_build(F, l); if (DRY_P8) p_combine_ln(F, *fresh_args(), l, true); p_combine_ln(F, *fresh_args(), l); SEAM(pb + 9); }
#endif
    }
#undef IN
#undef SEAM
}

extern "C" void kernel_launch(void* const* d_in, const int* in_sizes, int n_in, void* d_out, int out_size, void* d_ws, size_t ws_size, hipStream_t stream) {
    static int grid = 0;
    if (grid == 0) {
        if (n_in != 22 || in_sizes[0] != NTOK * D || out_size != NTOK * D || ws_size < WS_END) {
            fprintf(stderr, "kernel_launch: unexpected shapes (n_in %d, in0 %d, out %d, ws %zu); nothing launched\n", n_in, n_in > 0 ? in_sizes[0] : -1, out_size, ws_size); grid = -1; return; }
        int dev = 0, cus = 0, per_cu = 0;
        if (hipGetDevice(&dev) != hipSuccess || hipDeviceGetAttribute(&cus, hipDeviceAttributeMultiprocessorCount, dev) != hipSuccess) { grid = -1; return; }
        if (hipFuncSetAttribute((const void*)mk_fwd, hipFuncAttributeMaxDynamicSharedMemorySize, LDS_BYTES) != hipSuccess) { fprintf(stderr, "kernel_launch: hipFuncSetAttribute failed\n"); grid = -1; return; }
        if (hipOccupancyMaxActiveBlocksPerMultiprocessor(&per_cu, (const void*)mk_fwd, 512, LDS_BYTES) != hipSuccess || per_cu < 1)
            fprintf(stderr, "kernel_launch: note: occupancy query reports %d workgroups per CU\n", per_cu);
        (void)hipGetLastError();
        grid = cus;
    }
    if (grid < 0) return;
    if (hipMemsetAsync((char*)d_ws + WS_CTL, 0, CTL_ZERO_BYTES, stream) != hipSuccess) { fprintf(stderr, "kernel_launch: memset failed\n"); return; }
    Args a{};
    for (int i = 0; i < 22; ++i) a.in[i] = (const float*)d_in[i];
    a.out = (float*)d_out; a.ws = (unsigned char*)d_ws;
    for (int l = 0; l < DEPTH; ++l) a.lam_init[l] = (float)(0.8 - 0.6 * exp(-0.3 * (double)l));
#if MK_ONE_LAUNCH
    a.ph_lo = 0; a.ph_hi = N_PHASES;
    hipLaunchKernelGGL(mk_fwd, dim3(grid), dim3(512), LDS_BYTES, stream, a);
#else
    for (int p = 0; p < N_PHASES; ++p) {
        a.ph_lo = p; a.ph_hi = p + 1;
        hipLaunchKernelGGL(mk_fwd, dim3(grid), dim3(512), LDS_BYTES, stream, a);
    }
#endif
    const hipError_t le = hipPeekAtLastError();
    if (le != hipSuccess) fprintf(stderr, "kernel_launch: launch failed: %s\n", hipGetErrorName(le));
}
```

```cpp
#include <hip/hip_runtime.h>
#include <cstdio>
#include <cstdint>
#include <cmath>

#ifndef REP_AB
#define REP_AB 1
#endif
#ifndef REP_C
#define REP_C 1
#endif
#ifndef REP_G
#define REP_G 1
#endif
#ifndef REP_G1
#define REP_G1 REP_G
#endif
#ifndef REP_G3
#define REP_G3 REP_G
#endif
#ifndef REP_G4
#define REP_G4 REP_G
#endif
#ifndef REP_G6
#define REP_G6 REP_G
#endif
#ifndef REP_G7
#define REP_G7 REP_G
#endif
#ifndef REP_T
#define REP_T 1
#endif
#ifndef DRY_P5
#define DRY_P5 0
#endif
#ifndef DRY_P8
#define DRY_P8 0
#endif
#ifndef C_ANTIPHASE
#define C_ANTIPHASE 0
#endif
#ifndef MK_ONE_LAUNCH
#define MK_ONE_LAUNCH 1
#endif

#define GAS __attribute__((address_space(1)))
#define LAS __attribute__((address_space(3)))
typedef unsigned short bf16;
typedef unsigned v4u __attribute__((ext_vector_type(4)));
typedef unsigned v2u __attribute__((ext_vector_type(2)));
typedef float f32x4 __attribute__((ext_vector_type(4)));
typedef float f32x2 __attribute__((ext_vector_type(2)));
typedef short bf16x8 __attribute__((ext_vector_type(8)));

constexpr int NTOK = 32768, SEQ = 4096, D = 1024, DEPTH = 4, INC = 6144, NEXP = 32, TOPK = 4;
constexpr int C_QA = 0, C_KA = 256, C_VA = 512, C_QB = 768, C_KB = 1152, C_VB = 1536, C_QC = 1920, C_KC = 2304, C_VC = 2688, C_GP = 3072;
constexpr int YLD = 768, Y_A = 0, Y_B = 256, Y_C = 384;
constexpr int WPK = 896;
constexpr int MAXT = 544;
constexpr float LN_EPS = 1e-5f;
constexpr float DN_ALPHA = 1.681792830507429f;

constexpr size_t MiB = 1u << 20;
constexpr size_t WS_CTL = 0, CTL_ZERO_BYTES = 1 * MiB;
constexpr size_t WS_ROPE64 = 1 * MiB;
constexpr size_t WS_ROPE48 = 2 * MiB;
constexpr size_t WS_TOPE = 3 * MiB;
constexpr size_t WS_TOPW = 3 * MiB + 512 * 1024;
constexpr size_t WS_POS = 4 * MiB;
constexpr size_t WS_WIN = 8 * MiB;
constexpr size_t WS_WPROJ = 56 * MiB;
constexpr size_t WS_WOUT = 64 * MiB;
constexpr size_t WS_WGU = 72 * MiB;
constexpr size_t WS_WDN = 584 * MiB;
constexpr size_t WS_XB = 840 * MiB;
constexpr size_t WS_Y = 904 * MiB;
constexpr size_t WS_M = 952 * MiB;
constexpr size_t WS_H = 1016 * MiB;
constexpr size_t WS_HH = 1400 * MiB;
constexpr size_t WS_WRT = 5 * MiB;
constexpr size_t WS_RANK = 6 * MiB;
constexpr size_t WS_SRC = 1672 * MiB;
constexpr size_t WS_XB8 = 1676 * MiB;
constexpr size_t WS_WIN8 = 1708 * MiB;
constexpr size_t WS_G8 = 1720 * MiB;
constexpr size_t WS_END = 1816 * MiB;
constexpr int CW_BAR = 4096;
constexpr int CW_CNT = 8192;
constexpr int CW_CUR = 8192 + 4 * 64;

constexpr int RING_BYTES = 131072;
constexpr int LDSCTL_OFF = RING_BYTES;
constexpr int L_MISC = LDSCTL_OFF;
constexpr int L_OFFT = LDSCTL_OFF + 256;
constexpr int L_HIST = LDSCTL_OFF + 512;
constexpr int L_BASE = LDSCTL_OFF + 768;
constexpr int L_CNT = LDSCTL_OFF + 896;
constexpr int L_TILE = LDSCTL_OFF + 1024;
constexpr int L_PPOS = LDSCTL_OFF + 4096;
constexpr int L_PTOK = LDSCTL_OFF + 6144;
constexpr int LDS_BYTES = 147456;
static_assert(L_PTOK + 2048 <= LDS_BYTES, "LDS map");

#define RLX_AGENT __ATOMIC_RELAXED, __HIP_MEMORY_SCOPE_AGENT
#define LDS_WAIT() asm volatile("s_waitcnt lgkmcnt(0)" ::: "memory")
#define VM_WAIT() asm volatile("s_waitcnt vmcnt(0)" ::: "memory")

__device__ __forceinline__ float bf2f(unsigned short b) { return __uint_as_float(((unsigned)b) << 16); }
__device__ __forceinline__ float bflo(unsigned u) { return __uint_as_float(u << 16); }
__device__ __forceinline__ float bfhi(unsigned u) { return __uint_as_float(u & 0xffff0000u); }
__device__ __forceinline__ unsigned f2bf(float f) { unsigned u = __builtin_bit_cast(unsigned, f); return (u + 0x7fffu + ((u >> 16) & 1u)) >> 16; }
__device__ __forceinline__ unsigned pk2(float lo, float hi) { return f2bf(lo) | (f2bf(hi) << 16); }
__device__ __forceinline__ float wave_sum(float v) {
#pragma unroll
    for (int o = 1; o < 64; o <<= 1) v += __shfl_xor(v, o);
    return v;
}
__device__ __forceinline__ int opaque_tid() { int t; asm volatile("v_mov_b32 %0, %1" : "=v"(t) : "v"(threadIdx.x)); return t; }
__device__ __forceinline__ unsigned pk4_fp8(float a, float b, float c, float d, float sc) {
    a = fminf(fmaxf(a * sc, -448.f), 448.f); b = fminf(fmaxf(b * sc, -448.f), 448.f); c = fminf(fmaxf(c * sc, -448.f), 448.f); d = fminf(fmaxf(d * sc, -448.f), 448.f);
    int p = __builtin_amdgcn_cvt_pk_fp8_f32(a, b, 0, false); p = __builtin_amdgcn_cvt_pk_fp8_f32(c, d, p, true); return (unsigned)p; }
__device__ __forceinline__ float fast_sigmoid(float x) { return __builtin_amdgcn_rcpf(1.0f + __builtin_amdgcn_exp2f(-1.4426950408889634f * x)); }

namespace pg8 {
#define PG8_LAS __attribute__((address_space(3)))
typedef unsigned short bf16_t;
typedef unsigned u32x4 __attribute__((ext_vector_type(4)));
constexpr int BM = 256, BK = 64, HALF = 128, HTB = HALF * BK * 2, STAGE_BYTES = 8 * HTB, NXCD = 8, WGM = 8;

__host__ __device__ __forceinline__ int lds_byte(int r, int c) { const int st = (r >> 4) * 2 + (c >> 5), rr = r & 15, cc = c & 31, ob = rr * 64 + cc * 2; return st * 1024 + (ob ^ (((ob >> 9) & 1) << 5)); }
__host__ __device__ __forceinline__ void stage_rc(int b, int& R, int& C) { const int st = b / 1024, sb = b % 1024, swz = sb ^ (((sb >> 9) & 1) << 5); R = (st >> 1) * 16 + swz / 64; C = (st & 1) * 32 + (swz % 64) / 2; }
__host__ __device__ __forceinline__ int perm32(int rho) { const int n = rho >> 4, i = rho & 15; return 8 * (i >> 2) + 4 * n + (i & 3); }

struct Unit { const char* A; const char* B; int nt; int pm, pn, aux; };

__device__ __forceinline__ void tile_of(int L, int nM, int nN, int& pm, int& pn) {
    const int nwg = nM * nN;
    int wgid = L; { const int q = nwg / NXCD, r = nwg % NXCD, xcd = wgid % NXCD, off = wgid / NXCD; wgid = (xcd < r ? xcd * (q + 1) : r * (q + 1) + (xcd - r) * q) + off; }
    const int nig = WGM * nN, gid = wgid / nig, fm = gid * WGM, gsz = (nM - fm) < WGM ? (nM - fm) : WGM;
    pm = fm + ((wgid % nig) % gsz); pn = (wgid % nig) / gsz;
}

__device__ __forceinline__ unsigned cvt_pk_bf16(float lo, float hi) { unsigned r; asm volatile("v_cvt_pk_bf16_f32 %0, %1, %2" : "=v"(r) : "v"(lo), "v"(hi)); return r; }
typedef int v8i32 __attribute__((ext_vector_type(8)));
typedef short s16x16 __attribute__((ext_vector_type(16)));
typedef int v4i32 __attribute__((ext_vector_type(4)));
__device__ __forceinline__ v8i32 cat8(bf16x8 lo, bf16x8 hi) { const v4i32 a = __builtin_bit_cast(v4i32, lo), b = __builtin_bit_cast(v4i32, hi); return __builtin_shufflevector(a, b, 0, 1, 2, 3, 4, 5, 6, 7); }

template <class Epi, class Sched, bool ALIGN_EPI, bool SP2, bool FP8 = false>
__device__ __forceinline__ void gemm_phase(PG8_LAS unsigned char* lds, const int lda, const int ldb, const Sched& S, const Epi& E, const int sclW = 0x7f7f7f7f, const int sclX = 0x7f7f7f7f) {
    constexpr int EB = FP8 ? 1 : 2;
    const int tid = opaque_tid(), wid = __builtin_amdgcn_readfirstlane(tid >> 6), lane = tid & 63, wr = wid >> 2, wc = wid & 3, fr = lane & 15, fq = lane >> 4;
    unsigned voffA[2], voffB[2];
#pragma unroll
    for (int i = 0; i < 2; ++i) { int R, C; stage_rc(tid * 16 + i * 8192, R, C); const int Rb = Epi::PERM ? ((R & ~31) + perm32(R & 31)) : R;
        voffA[i] = (unsigned)(R * lda * EB + C * 2); voffB[i] = (unsigned)(Rb * ldb * EB + C * 2); }
    const size_t kstep = (size_t)(BK * 2);
    const size_t hA = (size_t)HALF * lda * EB, hB = (size_t)HALF * ldb * EB;
    const unsigned ldsw = (unsigned)wid * 1024u;
    const int fcol = FP8 ? (32 * (fq >> 1) + 16 * (fq & 1)) : fq * 8;
    const int aoff = lds_byte(wr * 64 + fr, fcol), boff = lds_byte(wc * 32 + fr, fcol);
#define PG8_SA(b, h) (((b) * 2 + (h)) * HTB)
#define PG8_SB(b, h) ((4 + (b) * 2 + (h)) * HTB)
#define PG8_STAGE(bufoff, gbase, voff) do { _Pragma("unroll") for (int _i = 0; _i < 2; ++_i) \
        __builtin_amdgcn_global_load_lds((const unsigned*)((const char*)(gbase) + (voff)[_i]), (PG8_LAS unsigned*)(lds + (bufoff) + ldsw + _i * 8192), 16, 0, 0); } while (0)
#define PG8_LDA(dst, b, h) do { if constexpr (FP8) { _Pragma("unroll") for (int m = 0; m < 4; ++m) dst##8[m] = cat8(*(const PG8_LAS bf16x8*)(lds + PG8_SA(b, h) + aoff + m * 2048), *(const PG8_LAS bf16x8*)(lds + PG8_SA(b, h) + aoff + m * 2048 + 16)); } else { \
        _Pragma("unroll") for (int m = 0; m < 4; ++m) _Pragma("unroll") for (int k = 0; k < 2; ++k) dst[m][k] = *(const PG8_LAS bf16x8*)(lds + PG8_SA(b, h) + aoff + m * 2048 + k * 1024); } } while (0)
#define PG8_LDB(dst, b, h) do { if constexpr (FP8) { _Pragma("unroll") for (int n = 0; n < 2; ++n) dst##8[n] = cat8(*(const PG8_LAS bf16x8*)(lds + PG8_SB(b, h) + boff + n * 2048), *(const PG8_LAS bf16x8*)(lds + PG8_SB(b, h) + boff + n * 2048 + 16)); } else { \
        _Pragma("unroll") for (int n = 0; n < 2; ++n) _Pragma("unroll") for (int k = 0; k < 2; ++k) dst[n][k] = *(const PG8_LAS bf16x8*)(lds + PG8_SB(b, h) + boff + n * 2048 + k * 1024); } } while (0)
#define PG8_MMA(ai, bj, At, Bt) do { __builtin_amdgcn_s_setprio(1); if constexpr (FP8) { _Pragma("unroll") for (int m = 0; m < 4; ++m) _Pragma("unroll") for (int n = 0; n < 2; ++n) \
        asm volatile("v_mfma_f32_16x16x128_f8f6f4 %0, %1, %2, %0" : "+v"(acc[ai][bj][m][n]) : "v"(Bt##8[n]), "v"(At##8[m])); } else { \
        _Pragma("unroll") for (int m = 0; m < 4; ++m) _Pragma("unroll") for (int n = 0; n < 2; ++n) _Pragma("unroll") for (int k = 0; k < 2; ++k) \
        acc[ai][bj][m][n] = __builtin_amdgcn_mfma_f32_16x16x32_bf16(Bt[n][k], At[m][k], acc[ai][bj][m][n], 0, 0, 0); } __builtin_amdgcn_s_setprio(0); } while (0)
#define PG8_WAIT_V(n) asm volatile("s_waitcnt vmcnt(" #n ")" ::: "memory")
#define PG8_WAIT_L(n) asm volatile("s_waitcnt lgkmcnt(" #n ")" ::: "memory")
#define PG8_BAR __builtin_amdgcn_s_barrier()
#define PG8_SCHED __builtin_amdgcn_sched_barrier(0)
    Unit cur, nxt; int ui = 0;
    if (!S.next(0, cur)) return;
    f32x4 acc[2][2][4][2];
#pragma unroll
    for (int a = 0; a < 2; ++a)
#pragma unroll
        for (int b = 0; b < 2; ++b)
#pragma unroll
            for (int m = 0; m < 4; ++m)
#pragma unroll
                for (int n = 0; n < 2; ++n) acc[a][b][m][n] = (f32x4){0.f, 0.f, 0.f, 0.f};
    bf16x8 At[4][2], B0[2][2], B1[2][2]; v8i32 At8[4], B08[2], B18[2];
    const char* cA = cur.A; const char* cB = cur.B;
    if constexpr (SP2) {
        PG8_STAGE(PG8_SB(0, 0), cB, voffB); PG8_STAGE(PG8_SB(0, 1), cB + hB, voffB); PG8_STAGE(PG8_SA(0, 0), cA, voffA); PG8_STAGE(PG8_SA(0, 1), cA + hA, voffA);
        if (wr == 1) PG8_BAR;
        PG8_WAIT_V(2); PG8_BAR;
        PG8_STAGE(PG8_SB(1, 0), cB + kstep, voffB); PG8_STAGE(PG8_SA(1, 0), cA + kstep, voffA); PG8_STAGE(PG8_SB(1, 1), cB + hB + kstep, voffB);
        PG8_WAIT_V(6); PG8_BAR;
    } else {
        PG8_STAGE(PG8_SB(0, 0), cB, voffB); PG8_STAGE(PG8_SA(0, 0), cA, voffA); PG8_STAGE(PG8_SB(0, 1), cB + hB, voffB); PG8_STAGE(PG8_SA(0, 1), cA + hA, voffA);
        if (wr == 1) PG8_BAR;
        PG8_WAIT_V(4); PG8_BAR;
        PG8_STAGE(PG8_SB(1, 0), cB + kstep, voffB); PG8_STAGE(PG8_SA(1, 0), cA + kstep, voffA); PG8_STAGE(PG8_SB(1, 1), cB + hB + kstep, voffB);
        PG8_WAIT_V(6); PG8_BAR;
    }
    for (;;) {
        const bool has_next = S.next(ui + 1, nxt);
        const char* nA = has_next ? nxt.A : cA; const char* nB = has_next ? nxt.B : cB;
        const int nt = cur.nt;
        for (int t = 0; t < nt; t += 2) {
            const bool last = (t == nt - 2);
            const char* a1 = cA + (size_t)(t + 1) * kstep;
            const char* a2 = last ? nA : cA + (size_t)(t + 2) * kstep; const char* b2 = last ? nB : cB + (size_t)(t + 2) * kstep;
            const char* a3 = a2 + kstep; const char* b3 = b2 + kstep;
            if constexpr (SP2) {
            PG8_LDB(B0, 0, 0); PG8_LDB(B1, 0, 1); PG8_SCHED; PG8_LDA(At, 0, 0); PG8_STAGE(PG8_SA(1, 1), a1 + hA, voffA);
            PG8_WAIT_V(8); PG8_WAIT_L(0); PG8_BAR; PG8_MMA(0, 0, At, B0); PG8_MMA(0, 1, At, B1); PG8_BAR; PG8_SCHED;
            PG8_LDA(At, 0, 1); PG8_STAGE(PG8_SB(0, 0), b2, voffB); PG8_STAGE(PG8_SB(0, 1), b2 + hB, voffB); PG8_STAGE(PG8_SA(0, 0), a2, voffA);
            PG8_WAIT_V(8); PG8_WAIT_L(0); PG8_BAR; PG8_MMA(1, 0, At, B0); PG8_MMA(1, 1, At, B1); PG8_BAR; PG8_SCHED;
            PG8_LDB(B0, 1, 0); PG8_LDB(B1, 1, 1); PG8_SCHED; PG8_LDA(At, 1, 0); PG8_STAGE(PG8_SA(0, 1), a2 + hA, voffA);
            PG8_WAIT_V(8); PG8_WAIT_L(0); PG8_BAR; PG8_MMA(0, 0, At, B0); PG8_MMA(0, 1, At, B1); PG8_BAR; PG8_SCHED;
            PG8_LDA(At, 1, 1); PG8_STAGE(PG8_SB(1, 0), b3, voffB); PG8_STAGE(PG8_SB(1, 1), b3 + hB, voffB); PG8_STAGE(PG8_SA(1, 0), a3, voffA);
            PG8_WAIT_V(8); PG8_WAIT_L(0); PG8_BAR; PG8_MMA(1, 0, At, B0); PG8_MMA(1, 1, At, B1); PG8_BAR; PG8_SCHED;
            } else {
            PG8_LDB(B0, 0, 0); PG8_SCHED; PG8_LDA(At, 0, 0); PG8_STAGE(PG8_SA(1, 1), a1 + hA, voffA);
            PG8_WAIT_L(8); PG8_BAR; PG8_WAIT_L(0); PG8_MMA(0, 0, At, B0); PG8_BAR; PG8_SCHED;
            PG8_LDB(B1, 0, 1); PG8_STAGE(PG8_SB(0, 0), b2, voffB);
            PG8_BAR; PG8_WAIT_L(0); PG8_MMA(0, 1, At, B1); PG8_BAR;
            PG8_LDA(At, 0, 1); PG8_STAGE(PG8_SA(0, 0), a2, voffA);
            PG8_BAR; PG8_WAIT_L(0); PG8_MMA(1, 0, At, B0); PG8_BAR; PG8_SCHED;
            PG8_STAGE(PG8_SB(0, 1), b2 + hB, voffB);
            PG8_WAIT_V(6); PG8_BAR; PG8_MMA(1, 1, At, B1); PG8_BAR;
            PG8_LDB(B0, 1, 0); PG8_SCHED; PG8_LDA(At, 1, 0); PG8_STAGE(PG8_SA(0, 1), a2 + hA, voffA);
            PG8_WAIT_L(8); PG8_BAR; PG8_WAIT_L(0); PG8_MMA(0, 0, At, B0); PG8_BAR; PG8_SCHED;
            PG8_LDB(B1, 1, 1); PG8_STAGE(PG8_SB(1, 0), b3, voffB);
            PG8_BAR; PG8_WAIT_L(0); PG8_MMA(0, 1, At, B1); PG8_BAR;
            PG8_LDA(At, 1, 1); PG8_STAGE(PG8_SA(1, 0), a3, voffA);
            PG8_BAR; PG8_WAIT_L(0); PG8_MMA(1, 0, At, B0); PG8_BAR; PG8_SCHED;
            PG8_STAGE(PG8_SB(1, 1), b3 + hB, voffB);
            PG8_WAIT_V(6); PG8_BAR; PG8_MMA(1, 1, At, B1); PG8_BAR;
            }
        }
        if constexpr (ALIGN_EPI) { if (wr == 0) PG8_BAR; }
        if constexpr (FP8) asm volatile("s_nop 15\n\ts_nop 15\n\ts_nop 15" ::: "memory");
        E(acc, cur, wr, wc, fr, fq);
        if (!has_next) break;
        if (!(Epi::KEEP && cur.aux != 2)) {
#pragma unroll
        for (int a = 0; a < 2; ++a)
#pragma unroll
            for (int b = 0; b < 2; ++b)
#pragma unroll
                for (int m = 0; m < 4; ++m)
#pragma unroll
                    for (int n = 0; n < 2; ++n) acc[a][b][m][n] = (f32x4){0.f, 0.f, 0.f, 0.f};
        }
        cur = nxt; cA = nA; cB = nB; ++ui;
        if constexpr (ALIGN_EPI) { if (wr == 1) PG8_BAR; }
    }
    PG8_WAIT_V(0);
    if constexpr (!ALIGN_EPI) { if (wr == 0) PG8_BAR; }
    PG8_BAR;
#undef PG8_SA
#undef PG8_SB
#undef PG8_STAGE
#undef PG8_LDA
#undef PG8_LDB
#undef PG8_MMA
#undef PG8_WAIT_V
#undef PG8_WAIT_L
#undef PG8_BAR
#undef PG8_SCHED
}

template <class Epi, class Sched, bool FP8 = false>
__device__ __forceinline__ void gemm_phase_gather(PG8_LAS unsigned char* lds, const char* Abase, const int lda, const int ldb, const Sched& S, const Epi& E, const int sclW = 0x7f7f7f7f, const int sclX = 0x7f7f7f7f) {
    constexpr int EB = FP8 ? 1 : 2;
    const int tid = opaque_tid(), wid = __builtin_amdgcn_readfirstlane(tid >> 6), lane = tid & 63, wr = wid >> 2, wc = wid & 3, fr = lane & 15, fq = lane >> 4;
    unsigned voffB[2]; int Rr[2]; unsigned Cc[2];
#pragma unroll
    for (int i = 0; i < 2; ++i) { int R, C; stage_rc(tid * 16 + i * 8192, R, C); const int Rb = Epi::PERM ? ((R & ~31) + perm32(R & 31)) : R;
        Rr[i] = R; Cc[i] = (unsigned)C * 2u; voffB[i] = (unsigned)(Rb * ldb * EB + C * 2); }
    const size_t kstep = (size_t)(BK * 2);
    const size_t hB = (size_t)HALF * ldb * EB;
    const unsigned ldsw = (unsigned)wid * 1024u;
    const int fcol = FP8 ? (32 * (fq >> 1) + 16 * (fq & 1)) : fq * 8;
    const int aoff = lds_byte(wr * 64 + fr, fcol), boff = lds_byte(wc * 32 + fr, fcol);
#define PG8_SA(b, h) (((b) * 2 + (h)) * HTB)
#define PG8_SB(b, h) ((4 + (b) * 2 + (h)) * HTB)
#define PG8_STAGE(bufoff, gbase, voff) do { _Pragma("unroll") for (int _i = 0; _i < 2; ++_i) \
        __builtin_amdgcn_global_load_lds((const unsigned*)((const char*)(gbase) + (voff)[_i]), (PG8_LAS unsigned*)(lds + (bufoff) + ldsw + _i * 8192), 16, 0, 0); } while (0)
#define PG8_LDA(dst, b, h) do { if constexpr (FP8) { _Pragma("unroll") for (int m = 0; m < 4; ++m) dst##8[m] = cat8(*(const PG8_LAS bf16x8*)(lds + PG8_SA(b, h) + aoff + m * 2048), *(const PG8_LAS bf16x8*)(lds + PG8_SA(b, h) + aoff + m * 2048 + 16)); } else { \
        _Pragma("unroll") for (int m = 0; m < 4; ++m) _Pragma("unroll") for (int k = 0; k < 2; ++k) dst[m][k] = *(const PG8_LAS bf16x8*)(lds + PG8_SA(b, h) + aoff + m * 2048 + k * 1024); } } while (0)
#define PG8_LDB(dst, b, h) do { if constexpr (FP8) { _Pragma("unroll") for (int n = 0; n < 2; ++n) dst##8[n] = cat8(*(const PG8_LAS bf16x8*)(lds + PG8_SB(b, h) + boff + n * 2048), *(const PG8_LAS bf16x8*)(lds + PG8_SB(b, h) + boff + n * 2048 + 16)); } else { \
        _Pragma("unroll") for (int n = 0; n < 2; ++n) _Pragma("unroll") for (int k = 0; k < 2; ++k) dst[n][k] = *(const PG8_LAS bf16x8*)(lds + PG8_SB(b, h) + boff + n * 2048 + k * 1024); } } while (0)
#define PG8_MMA(ai, bj, At, Bt) do { __builtin_amdgcn_s_setprio(1); if constexpr (FP8) { _Pragma("unroll") for (int m = 0; m < 4; ++m) _Pragma("unroll") for (int n = 0; n < 2; ++n) \
        asm volatile("v_mfma_f32_16x16x128_f8f6f4 %0, %1, %2, %0" : "+v"(acc[ai][bj][m][n]) : "v"(Bt##8[n]), "v"(At##8[m])); } else { \
        _Pragma("unroll") for (int m = 0; m < 4; ++m) _Pragma("unroll") for (int n = 0; n < 2; ++n) _Pragma("unroll") for (int k = 0; k < 2; ++k) \
        acc[ai][bj][m][n] = __builtin_amdgcn_mfma_f32_16x16x32_bf16(Bt[n][k], At[m][k], acc[ai][bj][m][n], 0, 0, 0); } __builtin_amdgcn_s_setprio(0); } while (0)
#define PG8_WAIT_V(n) asm volatile("s_waitcnt vmcnt(" #n ")" ::: "memory")
#define PG8_WAIT_L(n) asm volatile("s_waitcnt lgkmcnt(" #n ")" ::: "memory")
#define PG8_BAR __builtin_amdgcn_s_barrier()
#define PG8_SCHED __builtin_amdgcn_sched_barrier(0)
#define PG8_ROWOFF(u, vo) do { _Pragma("unroll") for (int _h = 0; _h < 2; ++_h) _Pragma("unroll") for (int _i = 0; _i < 2; ++_i) \
        (vo)[_h][_i] = (unsigned)S.rowtok((u), 128 * _h + Rr[_i]) * (unsigned)(lda * EB) + Cc[_i]; } while (0)
    Unit cur, nxt, nn; int ui = 0;
    if (!S.next(0, cur)) return;
    bool has_next = S.next(1, nxt);
    unsigned cv[2][2], nv[2][2], tv[2][2];
    PG8_ROWOFF(cur, cv);
    if (has_next) PG8_ROWOFF(nxt, nv); else { _Pragma("unroll") for (int h = 0; h < 2; ++h) _Pragma("unroll") for (int i = 0; i < 2; ++i) nv[h][i] = cv[h][i]; }
    f32x4 acc[2][2][4][2];
#pragma unroll
    for (int a = 0; a < 2; ++a)
#pragma unroll
        for (int b = 0; b < 2; ++b)
#pragma unroll
            for (int m = 0; m < 4; ++m)
#pragma unroll
                for (int n = 0; n < 2; ++n) acc[a][b][m][n] = (f32x4){0.f, 0.f, 0.f, 0.f};
    bf16x8 At[4][2], B0[2][2], B1[2][2]; v8i32 At8[4], B08[2], B18[2];
    const char* cB = cur.B;
    PG8_STAGE(PG8_SB(0, 0), cB, voffB); PG8_STAGE(PG8_SB(0, 1), cB + hB, voffB); PG8_STAGE(PG8_SA(0, 0), Abase, cv[0]); PG8_STAGE(PG8_SA(0, 1), Abase, cv[1]);
    if (wr == 1) PG8_BAR;
    PG8_WAIT_V(2); PG8_BAR;
    PG8_STAGE(PG8_SB(1, 0), cB + kstep, voffB); PG8_STAGE(PG8_SA(1, 0), Abase + kstep, cv[0]); PG8_STAGE(PG8_SB(1, 1), cB + hB + kstep, voffB);
    PG8_WAIT_V(6); PG8_BAR;
    for (;;) {
        const char* nB = has_next ? nxt.B : cB;
        const int nt = cur.nt;
        for (int t = 0; t < nt; t += 2) {
            const bool last = (t == nt - 2);
            const char* a1 = Abase + (size_t)(t + 1) * kstep;
            const char* a2 = last ? Abase : Abase + (size_t)(t + 2) * kstep; const char* b2 = last ? nB : cB + (size_t)(t + 2) * kstep;
            const char* a3 = a2 + kstep; const char* b3 = b2 + kstep;
            unsigned s0[2], s1[2];
#pragma unroll
            for (int i = 0; i < 2; ++i) { s0[i] = last ? nv[0][i] : cv[0][i]; s1[i] = last ? nv[1][i] : cv[1][i]; }
            PG8_LDB(B0, 0, 0); PG8_LDB(B1, 0, 1); PG8_SCHED; PG8_LDA(At, 0, 0); PG8_STAGE(PG8_SA(1, 1), a1, cv[1]);
            PG8_WAIT_V(8); PG8_WAIT_L(0); PG8_BAR; PG8_MMA(0, 0, At, B0); PG8_MMA(0, 1, At, B1); PG8_BAR; PG8_SCHED;
            PG8_LDA(At, 0, 1); PG8_STAGE(PG8_SB(0, 0), b2, voffB); PG8_STAGE(PG8_SB(0, 1), b2 + hB, voffB); PG8_STAGE(PG8_SA(0, 0), a2, s0);
            PG8_WAIT_V(8); PG8_WAIT_L(0); PG8_BAR; PG8_MMA(1, 0, At, B0); PG8_MMA(1, 1, At, B1); PG8_BAR; PG8_SCHED;
            PG8_LDB(B0, 1, 0); PG8_LDB(B1, 1, 1); PG8_SCHED; PG8_LDA(At, 1, 0); PG8_STAGE(PG8_SA(0, 1), a2, s1);
            PG8_WAIT_V(8); PG8_WAIT_L(0); PG8_BAR; PG8_MMA(0, 0, At, B0); PG8_MMA(0, 1, At, B1); PG8_BAR; PG8_SCHED;
            PG8_LDA(At, 1, 1); PG8_STAGE(PG8_SB(1, 0), b3, voffB); PG8_STAGE(PG8_SB(1, 1), b3 + hB, voffB); PG8_STAGE(PG8_SA(1, 0), a3, s0);
            PG8_WAIT_V(8); PG8_WAIT_L(0); PG8_BAR; PG8_MMA(1, 0, At, B0); PG8_MMA(1, 1, At, B1); PG8_BAR; PG8_SCHED;
        }
        if (wr == 0) PG8_BAR;
        if constexpr (FP8) asm volatile("s_nop 15\n\ts_nop 15\n\ts_nop 15" ::: "memory");
        const bool has_nn = has_next && S.next(ui + 2, nn);
        if (has_nn) PG8_ROWOFF(nn, tv);
        E(acc, cur, wr, wc, fr, fq);
        if (!has_next) break;
#pragma unroll
        for (int a = 0; a < 2; ++a)
#pragma unroll
            for (int b = 0; b < 2; ++b)
#pragma unroll
                for (int m = 0; m < 4; ++m)
#pragma unroll
                    for (int n = 0; n < 2; ++n) acc[a][b][m][n] = (f32x4){0.f, 0.f, 0.f, 0.f};
        cur = nxt; cB = nB; ++ui;
#pragma unroll
        for (int h = 0; h < 2; ++h)
#pragma unroll
            for (int i = 0; i < 2; ++i) { cv[h][i] = nv[h][i]; if (has_nn) nv[h][i] = tv[h][i]; }
        asm volatile("" : "+v"(nv[0][0]), "+v"(nv[0][1]), "+v"(nv[1][0]), "+v"(nv[1][1]));
        nxt = nn; has_next = has_nn;
        if (wr == 1) PG8_BAR;
    }
    PG8_WAIT_V(0);
    PG8_BAR;
#undef PG8_SA
#undef PG8_SB
#undef PG8_STAGE
#undef PG8_LDA
#undef PG8_LDB
#undef PG8_MMA
#undef PG8_WAIT_V
#undef PG8_WAIT_L
#undef PG8_BAR
#undef PG8_SCHED
#undef PG8_ROWOFF
}

struct DenseOrder {
    const char* A; const char* B; size_t a_tile, b_tile; int nt, nM, nN, G, c; int pn_off = 0;
    __device__ __forceinline__ bool next(int i, Unit& u) const {
        const long L = (long)i * G + c; if (L >= (long)nM * nN) return false;
        int pm, pn; tile_of((int)L, nM, nN, pm, pn);
        u.pm = pm; u.pn = pn + pn_off; u.aux = 0; u.nt = nt; u.A = A + (size_t)pm * a_tile; u.B = B + (size_t)pn * b_tile; return true;
    }
};
struct ProjOrder {
    const char* Y; const char* W; int nM, nN, G, c;
    __device__ __forceinline__ bool next(int i, Unit& u) const {
        const int ti = i / 3, br = i - 3 * ti;
        const long L = (long)ti * G + c; if (L >= (long)nM * nN) return false;
        int pm, pn; tile_of((int)L, nM, nN, pm, pn);
        u.pm = pm; u.pn = pn; u.aux = br; u.nt = (br == 2) ? 6 : 4;
        const int acol = (br == 0) ? 0 : (br == 1 ? 256 : 384), bcol = (br == 0) ? 0 : (br == 1 ? 256 : 512);
        u.A = Y + ((size_t)pm * 256 * YLD + acol) * 2; u.B = W + ((size_t)pn * 256 * WPK + bcol) * 2; return true;
    }
};
struct MoeOrder {
    const char* A; const char* W; size_t estride, atile, btile; int nt; const LAS int* tile_e; const LAS int* offT; const LAS int* cnt; const int* SRC; int T, nN, G, c;
    __device__ __forceinline__ bool next(int i, Unit& u) const {
        const long L = (long)i * G + c; if (L >= (long)T * nN) return false;
        int pm, pn; tile_of((int)L, T, nN, pm, pn);
        const int e = __builtin_amdgcn_readfirstlane(tile_e[pm]);
        u.pm = pm; u.pn = pn; u.aux = e; u.nt = nt; u.A = A + (size_t)pm * atile; u.B = W + (size_t)e * estride + (size_t)pn * btile; return true;
    }
    __device__ __forceinline__ int rowtok(const Unit& u, int r) const {
        const int e = u.aux, rank = (u.pm - offT[e]) * 256 + r, last = cnt[e] - 1;
        return SRC[e * NTOK + (rank < last ? rank : last)];
    }
};

struct EpiInProj {
    static constexpr bool PERM = true, KEEP = false;
    bf16_t* H; const float* bg; const f32x2* r64; const f32x2* r48; float gscale; unsigned char* G8;
    __device__ __forceinline__ void operator()(f32x4 (&acc)[2][2][4][2], const Unit& u, int wr, int wc, int fr, int fq) const {
        const int row0 = u.pm * BM + wr * 64 + fr, pn = u.pn, t0 = wc * 32 + 8 * fq;
        const float gs = gscale; unsigned char* const g8 = G8;
        if (pn >= 3 && pn < 9) {
            int dst, hstep, tw, dd0; const f32x2* tab;
            if (pn < 6) { dst = 768 + (4 * (pn - 3) + wc) * 64 + 8 * fq; hstep = 32; tw = 32; dd0 = 8 * fq; tab = r64; }
            else { const int p0 = 128 * (pn - 6) + t0, slot = p0 / 24; dd0 = p0 - slot * 24; dst = 1920 + slot * 48 + dd0; hstep = 24; tw = 24; tab = r48; }
#pragma unroll
            for (int ai = 0; ai < 2; ++ai)
#pragma unroll
                for (int m = 0; m < 4; ++m) { const int row = row0 + ai * HALF + m * 16; const f32x2* tp = tab + (size_t)(row & (SEQ - 1)) * tw + dd0;
                    f32x4 y1[2], y2[2];
#pragma unroll
                    for (int n = 0; n < 2; ++n) { const f32x4 cs0 = *(const f32x4*)(tp + 4 * n), cs1 = *(const f32x4*)(tp + 4 * n + 2);
                        const f32x4 x1 = acc[ai][0][m][n], x2 = acc[ai][1][m][n];
                        y1[n][0] = x1[0] * cs0[0] - x2[0] * cs0[1]; y2[n][0] = x2[0] * cs0[0] + x1[0] * cs0[1];
                        y1[n][1] = x1[1] * cs0[2] - x2[1] * cs0[3]; y2[n][1] = x2[1] * cs0[2] + x1[1] * cs0[3];
                        y1[n][2] = x1[2] * cs1[0] - x2[2] * cs1[1]; y2[n][2] = x2[2] * cs1[0] + x1[2] * cs1[1];
                        y1[n][3] = x1[3] * cs1[2] - x2[3] * cs1[3]; y2[n][3] = x2[3] * cs1[2] + x1[3] * cs1[3]; }
                    bf16_t* rowp = H + (size_t)row * INC + dst;
                    u32x4 w; w.x = cvt_pk_bf16(y1[0][0], y1[0][1]); w.y = cvt_pk_bf16(y1[0][2], y1[0][3]); w.z = cvt_pk_bf16(y1[1][0], y1[1][1]); w.w = cvt_pk_bf16(y1[1][2], y1[1][3]);
                    *(u32x4*)rowp = w;
                    w.x = cvt_pk_bf16(y2[0][0], y2[0][1]); w.y = cvt_pk_bf16(y2[0][2], y2[0][3]); w.z = cvt_pk_bf16(y2[1][0], y2[1][1]); w.w = cvt_pk_bf16(y2[1][2], y2[1][3]);
                    *(u32x4*)(rowp + hstep) = w; }
            return;
        }
        const bool gate = pn >= 12;
        int dcol[2];
#pragma unroll
        for (int bj = 0; bj < 2; ++bj) { const int x = pn * BM + bj * HALF + t0;
            if (pn >= 9 && pn < 12) { const int xx = x - 2304; dcol[bj] = xx < 384 ? 1536 + xx : 2688 + (xx - 384); } else dcol[bj] = x; }
        f32x4 bv[2][2];
#pragma unroll
        for (int bj = 0; bj < 2; ++bj)
#pragma unroll
            for (int n = 0; n < 2; ++n) bv[bj][n] = gate ? *(const f32x4*)(bg + (dcol[bj] - C_GP) + 4 * n) : (f32x4){0.f, 0.f, 0.f, 0.f};
#pragma unroll
        for (int ai = 0; ai < 2; ++ai)
#pragma unroll
            for (int m = 0; m < 4; ++m) { bf16_t* rowp = H + (size_t)(row0 + ai * HALF + m * 16) * INC;
#pragma unroll
                for (int bj = 0; bj < 2; ++bj) { f32x4 v0 = acc[ai][bj][m][0], v1 = acc[ai][bj][m][1];
                    if (gate) {
#pragma unroll
                        for (int q = 0; q < 4; ++q) { v0[q] = v0[q] * gs + bv[bj][0][q]; v1[q] = v1[q] * gs + bv[bj][1][q]; }
                        const unsigned b0 = (unsigned)(fast_sigmoid(v0[0]) * 255.0f + 0.5f) | ((unsigned)(fast_sigmoid(v0[1]) * 255.0f + 0.5f) << 8) | ((unsigned)(fast_sigmoid(v0[2]) * 255.0f + 0.5f) << 16) | ((unsigned)(fast_sigmoid(v0[3]) * 255.0f + 0.5f) << 24);
                        const unsigned b1 = (unsigned)(fast_sigmoid(v1[0]) * 255.0f + 0.5f) | ((unsigned)(fast_sigmoid(v1[1]) * 255.0f + 0.5f) << 8) | ((unsigned)(fast_sigmoid(v1[2]) * 255.0f + 0.5f) << 16) | ((unsigned)(fast_sigmoid(v1[3]) * 255.0f + 0.5f) << 24);
                        *(v2u*)(g8 + (size_t)(row0 + ai * HALF + m * 16) * 3072 + (dcol[bj] - C_GP)) = (v2u){b0, b1};
                    } else {
                        u32x4 w; w.x = cvt_pk_bf16(v0[0], v0[1]); w.y = cvt_pk_bf16(v0[2], v0[3]); w.z = cvt_pk_bf16(v1[0], v1[1]); w.w = cvt_pk_bf16(v1[2], v1[3]);
                        *(u32x4*)(rowp + dcol[bj]) = w; } } }
    }
};
struct EpiProj {
    static constexpr bool PERM = false, KEEP = true;
    const unsigned char* G8; bf16_t* Mg;
    __device__ __forceinline__ void operator()(f32x4 (&acc)[2][2][4][2], const Unit& u, int wr, int wc, int fr, int fq) const {
        const int row0 = u.pm * BM + wr * 64 + fr, col0 = u.pn * BM + wc * 32 + 4 * fq, br = u.aux;
#pragma unroll
        for (int ai = 0; ai < 2; ++ai)
#pragma unroll
            for (int m = 0; m < 4; ++m) { const size_t row = (size_t)(row0 + ai * HALF + m * 16);
#pragma unroll
                for (int bj = 0; bj < 2; ++bj)
#pragma unroll
                    for (int n = 0; n < 2; ++n) { const int c = col0 + bj * HALF + n * 16;
                        const unsigned char* gp = G8 + row * 3072 + br * 1024 + c;
                        const unsigned gw = *(const unsigned*)gp;
                        f32x4 g = (f32x4){fmaxf((float)(gw & 255u) * (1.0f / 255.0f), 1e-6f), fmaxf((float)((gw >> 8) & 255u) * (1.0f / 255.0f), 1e-6f), fmaxf((float)((gw >> 16) & 255u) * (1.0f / 255.0f), 1e-6f), fmaxf((float)(gw >> 24) * (1.0f / 255.0f), 1e-6f)};
                        if (br < 2) { const unsigned nw = *(const unsigned*)(gp + 1024);
                            g[0] *= __builtin_amdgcn_rcpf(fmaxf((float)(nw & 255u) * (1.0f / 255.0f), 1e-6f)); g[1] *= __builtin_amdgcn_rcpf(fmaxf((float)((nw >> 8) & 255u) * (1.0f / 255.0f), 1e-6f));
                            g[2] *= __builtin_amdgcn_rcpf(fmaxf((float)((nw >> 16) & 255u) * (1.0f / 255.0f), 1e-6f)); g[3] *= __builtin_amdgcn_rcpf(fmaxf((float)(nw >> 24) * (1.0f / 255.0f), 1e-6f));
                            acc[ai][bj][m][n] = acc[ai][bj][m][n] * g; }
                        else { const f32x4 t = acc[ai][bj][m][n] * g; v2u o; o.x = cvt_pk_bf16(t[0], t[1]); o.y = cvt_pk_bf16(t[2], t[3]); *(v2u*)(Mg + row * 1024 + c) = o; } } }
    }
};
struct EpiOut {
    static constexpr bool PERM = false, KEEP = false;
    const float* X; float* P;
    __device__ __forceinline__ void operator()(f32x4 (&acc)[2][2][4][2], const Unit& u, int wr, int wc, int fr, int fq) const {
        const int row0 = u.pm * BM + wr * 64 + fr, col0 = u.pn * BM + wc * 32 + 4 * fq;
#pragma unroll
        for (int ai = 0; ai < 2; ++ai)
#pragma unroll
            for (int m = 0; m < 4; ++m) { const size_t ro = (size_t)(row0 + ai * HALF + m * 16) * 1024 + col0;
#pragma unroll
                for (int bj = 0; bj < 2; ++bj)
#pragma unroll
                    for (int n = 0; n < 2; ++n) { const f32x4 xv = *(const f32x4*)(X + ro + bj * HALF + n * 16);
                        *(f32x4*)(P + ro + bj * HALF + n * 16) = xv * DN_ALPHA + acc[ai][bj][m][n]; } }
    }
};
struct EpiSwiglu {
    static constexpr bool PERM = true, KEEP = false;
    unsigned char* HH; const float* bgate; const float* bup; float ascale;
    __device__ __forceinline__ void operator()(f32x4 (&acc)[2][2][4][2], const Unit& u, int wr, int wc, int fr, int fq) const {
        const int row0 = u.pm * BM + wr * 64 + fr, j0 = u.pn * HALF + wc * 32 + 8 * fq, e = u.aux;
        f32x4 bg[2], bu[2];
#pragma unroll
        for (int n = 0; n < 2; ++n) { bg[n] = *(const f32x4*)(bgate + e * 1024 + j0 + 4 * n); bu[n] = *(const f32x4*)(bup + e * 1024 + j0 + 4 * n); }
#pragma unroll
        for (int ai = 0; ai < 2; ++ai)
#pragma unroll
            for (int m = 0; m < 4; ++m) { unsigned char* rowp = HH + (size_t)(row0 + ai * HALF + m * 16) * 1024 + j0;
                f32x4 o[2];
#pragma unroll
                for (int n = 0; n < 2; ++n) { f32x4 g = acc[ai][0][m][n] * ascale + bg[n], uu = acc[ai][1][m][n] * ascale + bu[n];
#pragma unroll
                    for (int q = 0; q < 4; ++q) { const float hg = fminf(g[q], 7.0f), hu = fminf(fmaxf(uu[q], -7.0f), 7.0f);
                        o[n][q] = hg * fast_sigmoid(1.702f * hg) * (hu + 1.0f); } }
                v2u w; w.x = pk4_fp8(o[0][0], o[0][1], o[0][2], o[0][3], 4.0f); w.y = pk4_fp8(o[1][0], o[1][1], o[1][2], o[1][3], 4.0f);
                *(v2u*)rowp = w; }
    }
};
struct EpiDown {
    static constexpr bool PERM = true, KEEP = false;
    bf16_t* YS; const float* bd; float ascale;
    __device__ __forceinline__ void operator()(f32x4 (&acc)[2][2][4][2], const Unit& u, int wr, int wc, int fr, int fq) const {
        const int row0 = u.pm * BM + wr * 64 + fr, col0 = u.pn * BM + wc * 32 + 8 * fq, e = u.aux;
        f32x4 bv[2][2];
#pragma unroll
        for (int bj = 0; bj < 2; ++bj)
#pragma unroll
            for (int n = 0; n < 2; ++n) bv[bj][n] = *(const f32x4*)(bd + e * 1024 + col0 + bj * HALF + 4 * n);
#pragma unroll
        for (int ai = 0; ai < 2; ++ai)
#pragma unroll
            for (int m = 0; m < 4; ++m) { bf16_t* rowp = YS + (size_t)(row0 + ai * HALF + m * 16) * 1024 + col0;
#pragma unroll
                for (int bj = 0; bj < 2; ++bj) { const f32x4 v0 = acc[ai][bj][m][0] * ascale + bv[bj][0], v1 = acc[ai][bj][m][1] * ascale + bv[bj][1];
                    u32x4 w; w.x = cvt_pk_bf16(v0[0], v0[1]); w.y = cvt_pk_bf16(v0[2], v0[3]); w.z = cvt_pk_bf16(v1[0], v1[1]); w.w = cvt_pk_bf16(v1[2], v1[3]);
                    *(u32x4*)(rowp + bj * HALF) = w; } }
    }
};
}

#define XB_TMO      128
#define XB_XCNT(j)  (256  + 64 * (j))
#define XB_XSUB(j)  (1280 + 64 * (j))
#define XB_XGEN(j)  (2304 + 64 * (j))
#define XB_TOP      3328
#define XB_TOPGEN   3392
#define XCD_BAR_WORDS 3456
#define XB_SPIN_CAP (1u << 18)

__device__ __forceinline__ unsigned xb_ld(unsigned* p)              { return __hip_atomic_load(p, __ATOMIC_RELAXED, __HIP_MEMORY_SCOPE_AGENT); }
__device__ __forceinline__ unsigned xb_add(unsigned* p, unsigned v) { return __hip_atomic_fetch_add(p, v, __ATOMIC_RELAXED, __HIP_MEMORY_SCOPE_AGENT); }
__device__ __forceinline__ unsigned xb_xcc_id() { return (unsigned)__builtin_amdgcn_s_getreg((3 << 11) | 20) & 0xFu; }
#define XB_SPIN(cond, bar) do { unsigned _sp = 0; while (cond) { __builtin_amdgcn_s_sleep(1); \
    if ((++_sp & 255u) == 0u) { if (xb_ld(&(bar)[XB_TMO])) break; if (_sp > XB_SPIN_CAP) { atomicAdd(&(bar)[XB_TMO], 1u); break; } } } } while (0)

struct XcdBarrier { unsigned* bar; unsigned x; volatile LAS unsigned* st; };

__device__ __forceinline__ XcdBarrier xcd_barrier_post(unsigned* bar, volatile LAS unsigned* st) {
    XcdBarrier b; b.bar = bar; b.x = xb_xcc_id(); b.st = st;
    if (threadIdx.x == 0) (void)xb_add(&bar[XB_XCNT(b.x)], 1u);
    return b;
}
__device__ __forceinline__ void xcd_barrier_complete(unsigned* bar, unsigned x, unsigned& nloc, unsigned& nx) {
    const unsigned G = gridDim.x * gridDim.y * gridDim.z;
    unsigned sum, cnt, mine, sp = 0u;
    for (;;) {
        sum = 0u; cnt = 0u; mine = 0u;
#pragma unroll
        for (unsigned j = 0; j < 16; ++j) { const unsigned c = xb_ld(&bar[XB_XCNT(j)]); sum += c; cnt += (c > 0u) ? 1u : 0u; mine = (j == x) ? c : mine; }
        if (sum == G) break;
        __builtin_amdgcn_s_sleep(1);
        if ((++sp & 255u) == 0u) { if (xb_ld(&bar[XB_TMO])) break; if (sp > XB_SPIN_CAP) { atomicAdd(&bar[XB_TMO], 1u); break; } }
    }
    nloc = mine > 0u ? mine : 1u; nx = cnt > 0u ? cnt : 1u;
}
__device__ __forceinline__ void xcd_barrier(const XcdBarrier& b) {
    asm volatile("s_waitcnt vmcnt(0)" ::: "memory");
    __syncthreads();
    if (threadIdx.x == 0) {
        unsigned* bar = b.bar;
        __builtin_amdgcn_s_waitcnt(0);
        unsigned nloc = b.st[0], nx = b.st[1];
        if (nloc == 0u) { xcd_barrier_complete(bar, b.x, nloc, nx); b.st[0] = nloc; b.st[1] = nx; }
        const unsigned old = xb_add(&bar[XB_XSUB(b.x)], 1u);
        const unsigned gen = old / nloc;
        if (old + 1u == (gen + 1u) * nloc) {
            __builtin_amdgcn_fence(__ATOMIC_RELEASE, "agent");
            asm volatile("s_waitcnt vmcnt(0)" ::: "memory");
            const unsigned og = xb_add(&bar[XB_TOP], 1u);
            const unsigned tg = og / nx;
            if (og + 1u == (tg + 1u) * nx) xb_add(&bar[XB_TOPGEN], 1u);
            else XB_SPIN(xb_ld(&bar[XB_TOPGEN]) == tg, bar);
            __builtin_amdgcn_fence(__ATOMIC_ACQUIRE, "agent");
            xb_add(&bar[XB_XGEN(b.x)], 1u);
            asm volatile("s_waitcnt vmcnt(0)" ::: "memory");
        } else {
            XB_SPIN(xb_ld(&bar[XB_XGEN(b.x)]) == gen, bar);
            __builtin_amdgcn_fence(__ATOMIC_ACQUIRE, "agent");
            asm volatile("s_waitcnt vmcnt(0)" ::: "memory");
        }
    }
    __syncthreads();
}

struct Frame {
    LAS unsigned char* lds;
    unsigned* ctl;
    unsigned char* ws;
    int tid, lane, wave, G, bid;
};

__host__ __device__ __forceinline__ int inproj_phys(int nl) {
    if (nl < 768) return nl;
    if (nl < 1536) { const int x = nl - 768, slot = x >> 6, d = x & 63; return 768 + (slot >> 2) * 256 + (d >> 5) * 128 + (slot & 3) * 32 + (d & 31); }
    if (nl < 1920) return 2304 + (nl - 1536);
    if (nl < 2688) { const int x = nl - 1920, slot = x / 48, d = x - slot * 48, hf = d >= 24 ? 1 : 0, p = slot * 24 + d - 24 * hf; return 1536 + (p >> 7) * 256 + hf * 128 + (p & 127); }
    if (nl < 3072) return 2304 + 384 + (nl - 2688);
    return nl;
}
template <class RowMap>
__device__ __forceinline__ void transpose_item(const float* W, int N, bf16* dst, int ldd, int k0, int n0, const RowMap rowmap, LAS float* scr, int lane) {
#pragma unroll 8
    for (int i = 0; i < 32; ++i) { const int kk = 2 * i + (lane >> 5); scr[kk * 33 + (lane & 31)] = W[(size_t)(k0 + kk) * N + n0 + (lane & 31)]; }
    LDS_WAIT(); asm volatile("" ::: "memory");
    const int c = lane & 7;
#pragma unroll
    for (int j = 0; j < 4; ++j) { const int n = (lane >> 3) + 8 * j; const LAS float* sp = scr + (8 * c) * 33 + n;
        v4u o; o.x = pk2(sp[0 * 33], sp[1 * 33]); o.y = pk2(sp[2 * 33], sp[3 * 33]); o.z = pk2(sp[4 * 33], sp[5 * 33]); o.w = pk2(sp[6 * 33], sp[7 * 33]);
        *(v4u*)(dst + (size_t)rowmap(n0 + n) * ldd + k0 + 8 * c) = o; }
    LDS_WAIT(); asm volatile("" ::: "memory");
}

template <class RowMap>
__device__ __forceinline__ void transpose_item_fp8(const float* W, int N, unsigned char* dst, int ldd, int k0, int n0, const RowMap rowmap, LAS float* scr, int lane, float qs) {
#pragma unroll 8
    for (int i = 0; i < 32; ++i) { const int kk = 2 * i + (lane >> 5); scr[kk * 33 + (lane & 31)] = W[(size_t)(k0 + kk) * N + n0 + (lane & 31)]; }
    LDS_WAIT(); asm volatile("" ::: "memory");
    const int c = lane & 7;
#pragma unroll
    for (int j = 0; j < 4; ++j) { const int n = (lane >> 3) + 8 * j; const LAS float* sp = scr + (8 * c) * 33 + n;
        v2u o; o.x = pk4_fp8(sp[0 * 33], sp[1 * 33], sp[2 * 33], sp[3 * 33], qs); o.y = pk4_fp8(sp[4 * 33], sp[5 * 33], sp[6 * 33], sp[7 * 33], qs);
        *(v2u*)(dst + (size_t)rowmap(n0 + n) * ldd + k0 + 8 * c) = o; }
    LDS_WAIT(); asm volatile("" ::: "memory");
}

struct Args { const float* in[22]; float* out; unsigned char* ws; int ph_lo, ph_hi; float lam_init[4]; };

__device__ __forceinline__ void p_prologue(Frame& F, const Args& a) {
    LAS float* scr = (LAS float*)(F.lds + F.wave * 16384);
    const int gw = F.bid * 8 + F.wave, NGW = F.G * 8;
    constexpr int PER_LAYER = 3072 + 128 + 64 + 192 + 512 + 32 * 1536;
    for (int it = gw; it < DEPTH * PER_LAYER; it += NGW) {
        const int l = it / PER_LAYER; int r = it - l * PER_LAYER;
        if (r < 3072) { const int kb = r / 192, nb = r % 192;
            if (nb < 96) transpose_item(a.in[1] + (size_t)l * 1024 * INC, INC, (bf16*)(F.ws + WS_WIN) + (size_t)l * INC * 1024, 1024, kb * 64, nb * 32, [](int n) { return inproj_phys(n); }, scr, F.lane);
            else transpose_item_fp8(a.in[1] + (size_t)l * 1024 * INC, INC, (unsigned char*)(F.ws + WS_WIN8) + (size_t)l * 3072 * 1024, 1024, kb * 64, nb * 32, [](int n) { return n - 3072; }, scr, F.lane, 32.f);
            continue; }
        r -= 3072;
        if (r < 128) { const int kb = r / 32, nb = r % 32;
            transpose_item(a.in[3] + (size_t)l * 256 * 1024, 1024, (bf16*)(F.ws + WS_WPROJ) + (size_t)l * 1024 * WPK + 0, WPK, kb * 64, nb * 32, [](int n) { return n; }, scr, F.lane); continue; }
        r -= 128;
        if (r < 64) { const int kb = r / 32, nb = r % 32;
            transpose_item(a.in[4] + (size_t)l * 128 * 1024, 1024, (bf16*)(F.ws + WS_WPROJ) + (size_t)l * 1024 * WPK + 256, WPK, kb * 64, nb * 32, [](int n) { return n; }, scr, F.lane); continue; }
        r -= 64;
        if (r < 192) { const int kb = r / 32, nb = r % 32;
            transpose_item(a.in[5] + (size_t)l * 384 * 1024, 1024, (bf16*)(F.ws + WS_WPROJ) + (size_t)l * 1024 * WPK + 512, WPK, kb * 64, nb * 32, [](int n) { return n; }, scr, F.lane); continue; }
        r -= 192;
        if (r < 512) { const int kb = r / 32, nb = r % 32;
            transpose_item(a.in[6] + (size_t)l * 1024 * 1024, 1024, (bf16*)(F.ws + WS_WOUT) + (size_t)l * 1024 * 1024, 1024, kb * 64, nb * 32, [](int n) { return n; }, scr, F.lane); continue; }
        r -= 512;
        { const int e = r / 1536, r2 = r % 1536, mtx = r2 / 512, r3 = r2 % 512, kb = r3 / 32, nb = r3 % 32;
          const size_t eoff = ((size_t)l * NEXP + e) * 1024 * 1024;
          if (mtx == 0) transpose_item_fp8(a.in[14] + eoff, 1024, (unsigned char*)(F.ws + WS_WGU) + 2 * eoff, 1024, kb * 64, nb * 32, [](int n) { return (n >> 7) * 256 + (n & 127); }, scr, F.lane, 32.f);
          else if (mtx == 1) transpose_item_fp8(a.in[16] + eoff, 1024, (unsigned char*)(F.ws + WS_WGU) + 2 * eoff, 1024, kb * 64, nb * 32, [](int n) { return (n >> 7) * 256 + 128 + (n & 127); }, scr, F.lane, 32.f);
          else transpose_item_fp8(a.in[18] + eoff, 1024, (unsigned char*)(F.ws + WS_WDN) + eoff, 1024, kb * 64, nb * 32, [](int n) { return n; }, scr, F.lane, 64.f); }
    }
    { const int gt = F.bid * 512 + F.tid, NT = F.G * 512;
      for (int i = gt; i < DEPTH * 1024 * 16; i += NT) { const int row = i >> 4, ch = i & 15;
          *(v4u*)((bf16*)(F.ws + WS_WPROJ) + (size_t)row * WPK + 384 + ch * 8) = (v4u){0u, 0u, 0u, 0u}; }
      for (int i = gt; i < SEQ * 32; i += NT) { const int pos = i >> 5, j = i & 31;
          const float inv = 1.0f / powf(10000.0f, (float)(2 * j) / 64.0f); const float ang = (float)pos * inv; float s, c; sincosf(ang, &s, &c);
          ((f32x2*)(F.ws + WS_ROPE64))[i] = (f32x2){c, s}; }
      for (int i = gt; i < SEQ * 24; i += NT) { const int pos = i / 24, j = i - pos * 24;
          const float inv = 1.0f / powf(10000.0f, (float)(2 * j) / 48.0f); const float ang = (float)pos * inv; float s, c; sincosf(ang, &s, &c);
          ((f32x2*)(F.ws + WS_ROPE48))[i] = (f32x2){c, s}; }
      for (int i = gt; i < DEPTH * 32 * 1024; i += NT) { const int l = i >> 15, e = (i >> 10) & 31, k = i & 1023;
          const float wv = a.in[12][((size_t)l * 1024 + k) * 32 + e]; const unsigned hi = f2bf(wv); const unsigned lo = f2bf(wv - __uint_as_float(hi << 16));
          bf16* wt = (bf16*)(F.ws + WS_WRT) + (size_t)l * 2 * 32 * 1024; wt[e * 1024 + k] = (bf16)hi; wt[32 * 1024 + e * 1024 + k] = (bf16)lo; }
      const f32x4* x4 = (const f32x4*)a.in[0]; v2u* xb = (v2u*)(F.ws + WS_XB);
      unsigned* xb8 = (unsigned*)(F.ws + WS_XB8);
      for (int i = gt; i < NTOK * 256; i += NT) { const f32x4 v = x4[i]; xb[i] = (v2u){pk2(v[0], v[1]), pk2(v[2], v[3])}; xb8[i] = pk4_fp8(v[0], v[1], v[2], v[3], 1.0f); }
    }
}

typedef float f32x16 __attribute__((ext_vector_type(16)));
typedef short s16x4 __attribute__((ext_vector_type(4)));
typedef float f32x2_t __attribute__((ext_vector_type(2)));
typedef __bf16 bf16x2_t __attribute__((ext_vector_type(2)));
__device__ __forceinline__ unsigned cvtpk(float lo, float hi) { const f32x2_t v = {lo, hi}; const bf16x2_t b = __builtin_convertvector(v, bf16x2_t); return __builtin_bit_cast(unsigned, b); }
__device__ __forceinline__ int kperm(int r) { return (r & ~12) | ((r & 4) << 1) | ((r & 8) >> 1); }
__device__ __forceinline__ s16x4 ds_tr16(const LAS unsigned char* p) { return __builtin_bit_cast(s16x4, __builtin_amdgcn_ds_read_tr16_b64_v4i16((LAS s16x4*)p)); }

__device__ __forceinline__ float fmax_nc(float a, float b) { return __builtin_amdgcn_fmed3f(a, b, __builtin_inff()); }
__device__ __forceinline__ void glds16(const void* gsrc, unsigned lds_dst) { unsigned keep;
    asm volatile("s_mov_b32 %0, m0\n\ts_mov_b32 m0, %2\n\ts_nop 0\n\tglobal_load_lds_dwordx4 %1, off\n\ts_mov_b32 m0, %0" : "=&s"(keep) : "v"(gsrc), "s"(lds_dst) : "memory"); }
__device__ __forceinline__ void attnC_pipe(Frame& F, const float* lamv, const float* ng, float lam_init) {
    const bf16* H = (const bf16*)(F.ws + WS_H); bf16* Y = (bf16*)(F.ws + WS_Y);
    const int lane = F.lane, w = F.wave, n = lane & 31, hh = lane >> 5;
    float l01 = 0.f, l23 = 0.f;
    if (lane < 48) { l01 = lamv[lane] * lamv[48 + lane]; l23 = lamv[96 + lane] * lamv[144 + lane]; }
    l01 = wave_sum(l01); l23 = wave_sum(l23);
    const float lam = expf(l01) - expf(l23) + lam_init;
    const float post = 1.0f - lam_init;
    constexpr int KST = 208, VST = 192, KBYTES = 64 * KST, STAGE = KBYTES + 64 * VST, NT = SEQ / 64;
    constexpr float CS = 0.14433756729740643f * 1.4426950408889634f;
    constexpr float PMAX = 256.0f;
    unsigned goff[4], loff[4];
#pragma unroll
    for (int j = 0; j < 4; ++j) { const int I = w + 8 * j;
        if (I < 13) { const int cid = I * 64 + lane, row = cid / 13; int col = cid - row * 13; if (col == 12) col = 0;
            goff[j] = (unsigned)(row * INC + C_KC + col * 8) * 2u; loff[j] = (unsigned)(I * 1024); }
        else { const int cid = (I - 13) * 64 + lane, row = cid / 12, col = cid - row * 12;
            goff[j] = (unsigned)(row * INC + C_VC + col * 8) * 2u; loff[j] = (unsigned)(KBYTES + (I - 13) * 1024); } }
    const int koff = kperm(n) * KST + hh * 16;
    const int g = lane >> 4, i16 = lane & 15;
    const int voff = KBYTES + (8 * (g >> 1) + (i16 >> 2)) * VST + (16 * (g & 1) + 4 * (i16 & 3)) * 2;
#define C_ISSUE(tt) do { const char* gb_ = gbase + (size_t)(tt) * (64 * INC * 2); const int so_ = ((tt) & 3) * STAGE; _Pragma("unroll") for (int j_ = 0; j_ < 4; ++j_) if (w + 8 * j_ < 25) \
        glds16(gb_ + goff[j_], (unsigned)__builtin_amdgcn_readfirstlane((int)(unsigned)(size_t)(F.lds + so_ + loff[j_]))); } while (0)
#define C_RDV(slotV, kbV, s2v) do { _Pragma("unroll") for (int d_ = 0; d_ < 3; ++d_) { const LAS unsigned char* vp_ = (slotV) + voff + ((kbV) * 32 + 16 * (s2v)) * VST + d_ * 64; \
            const s16x4 v0_ = ds_tr16(vp_), v1_ = ds_tr16(vp_ + 4 * VST); vf[d_] = (bf16x8){v0_[0], v0_[1], v0_[2], v0_[3], v1_[0], v1_[1], v1_[2], v1_[3]}; } } while (0)
#define C_RD(slotK, kbK, cK, slotV, kbV) do { C_RDV(slotV, kbV, 0); } while (0)
#define C_MM(dst, slotK, kbK, cK, cV, pf, slotV, kbV) do { \
        _Pragma("unroll") for (int s_ = 0; s_ < 3; ++s_) kf[s_] = *(const LAS bf16x8*)((slotK) + (kbK) * 32 * KST + koff + ((cK) * 6 + 2 * s_) * 16); \
        _Pragma("unroll") for (int d_ = 0; d_ < 3; ++d_) O[cV][d_] = __builtin_amdgcn_mfma_f32_32x32x16_bf16(vf[d_], pf[0], O[cV][d_], 0, 0, 0); \
        C_FENCE; C_RDV(slotV, kbV, 1); \
        dst = __builtin_amdgcn_mfma_f32_32x32x16_bf16(kf[0], qf[cK][0], NEGR[cK], 0, 0, 0); dst = __builtin_amdgcn_mfma_f32_32x32x16_bf16(kf[1], qf[cK][1], dst, 0, 0, 0); dst = __builtin_amdgcn_mfma_f32_32x32x16_bf16(kf[2], qf[cK][2], dst, 0, 0, 0); \
        C_FENCE; \
        _Pragma("unroll") for (int d_ = 0; d_ < 3; ++d_) O[cV][d_] = __builtin_amdgcn_mfma_f32_32x32x16_bf16(vf[d_], pf[1], O[cV][d_], 0, 0, 0); } while (0)
#define C_QK0(dst, slotbase) do { { const bf16x8 kf_ = *(const LAS bf16x8*)((slotbase) + koff); dst = __builtin_amdgcn_mfma_f32_32x32x16_bf16(kf_, qf[0][0], NEGR[0], 0, 0, 0); } \
        _Pragma("unroll") for (int s_ = 1; s_ < 3; ++s_) { const bf16x8 kf_ = *(const LAS bf16x8*)((slotbase) + koff + (2 * s_) * 16); dst = __builtin_amdgcn_mfma_f32_32x32x16_bf16(kf_, qf[0][s_], dst, 0, 0, 0); } } while (0)
#define C_SM(Sx, c, pf, slotK, kbK) do { _Pragma("unroll") for (int r_ = 0; r_ < 16; ++r_) Sx[r_] = __builtin_amdgcn_exp2f(Sx[r_]); \
        float pm_ = fmaxf(fmaxf(Sx[0], Sx[1]), Sx[2]); _Pragma("unroll") for (int r_ = 3; r_ < 15; r_ += 2) pm_ = fmaxf(fmaxf(pm_, Sx[r_]), Sx[r_ + 1]); pm_ = fmaxf(pm_, Sx[15]); \
        pm_ = fmaxf(pm_, __shfl_xor(pm_, 32)); \
        if (__any(pm_ > PMAX) || first) { \
            { const bf16x8 k0_ = *(const LAS bf16x8*)((slotK) + (kbK) * 32 * KST + koff + ((c) * 6 + 0) * 16), k1_ = *(const LAS bf16x8*)((slotK) + (kbK) * 32 * KST + koff + ((c) * 6 + 2) * 16), k2_ = *(const LAS bf16x8*)((slotK) + (kbK) * 32 * KST + koff + ((c) * 6 + 4) * 16); \
              Sx = __builtin_amdgcn_mfma_f32_32x32x16_bf16(k0_, qf[c][0], NEGR[c], 0, 0, 0); Sx = __builtin_amdgcn_mfma_f32_32x32x16_bf16(k1_, qf[c][1], Sx, 0, 0, 0); Sx = __builtin_amdgcn_mfma_f32_32x32x16_bf16(k2_, qf[c][2], Sx, 0, 0, 0); } \
            float mx_ = fmax_nc(Sx[0], Sx[1]); _Pragma("unroll") for (int r_ = 2; r_ < 16; ++r_) mx_ = fmax_nc(mx_, Sx[r_]); mx_ = fmaxf(mx_, __shfl_xor(mx_, 32)); \
            const float dl_ = (pm_ > PMAX || first) ? mx_ : 0.0f, al_ = __builtin_amdgcn_exp2f(-dl_); \
            _Pragma("unroll") for (int d_ = 0; d_ < 3; ++d_) _Pragma("unroll") for (int r_ = 0; r_ < 16; ++r_) O[c][d_][r_] *= al_; l[c] *= al_; \
            _Pragma("unroll") for (int r_ = 0; r_ < 16; ++r_) { NEGR[c][r_] -= dl_; Sx[r_] = __builtin_amdgcn_exp2f(Sx[r_] - dl_); } } \
        _Pragma("unroll") for (int r_ = 0; r_ < 16; ++r_) l[c] += Sx[r_]; \
        _Pragma("unroll") for (int s2_ = 0; s2_ < 2; ++s2_) { v4u pw_; pw_.x = cvtpk(Sx[8 * s2_ + 0], Sx[8 * s2_ + 1]); pw_.y = cvtpk(Sx[8 * s2_ + 2], Sx[8 * s2_ + 3]); \
            pw_.z = cvtpk(Sx[8 * s2_ + 4], Sx[8 * s2_ + 5]); pw_.w = cvtpk(Sx[8 * s2_ + 6], Sx[8 * s2_ + 7]); pf[s2_] = __builtin_bit_cast(bf16x8, pw_); } } while (0)
#define C_FENCE __builtin_amdgcn_sched_barrier(0)
    for (int unit = F.bid; unit < 512; unit += F.G) {
        const int b = unit >> 6, h = (unit >> 4) & 3, qb = unit & 15;
        const int tok = b * SEQ + qb * 256 + w * 32 + n;
        const char* gbase = (const char*)(H + (size_t)(b * SEQ) * INC + h * 96);
        C_ISSUE(0); C_ISSUE(1);
        bf16x8 qf[2][3];
        { const bf16* qp = H + (size_t)tok * INC + C_QC + h * 96 + 8 * hh;
#pragma unroll
          for (int c = 0; c < 2; ++c)
#pragma unroll
              for (int s = 0; s < 3; ++s) { const v4u qw = *(const v4u*)(qp + c * 48 + 16 * s);
                  v4u qs; qs.x = cvtpk(bflo(qw.x) * CS, bfhi(qw.x) * CS); qs.y = cvtpk(bflo(qw.y) * CS, bfhi(qw.y) * CS); qs.z = cvtpk(bflo(qw.z) * CS, bfhi(qw.z) * CS); qs.w = cvtpk(bflo(qw.w) * CS, bfhi(qw.w) * CS);
                  qf[c][s] = __builtin_bit_cast(bf16x8, qs); } }
        f32x16 O[2][3];
#pragma unroll
        for (int c = 0; c < 2; ++c)
#pragma unroll
            for (int d = 0; d < 3; ++d)
#pragma unroll
                for (int r = 0; r < 16; ++r) O[c][d][r] = 0.f;
        float l[2] = {0.f, 0.f};
        f32x16 NEGR[2];
#pragma unroll
        for (int c = 0; c < 2; ++c)
#pragma unroll
            for (int r = 0; r < 16; ++r) NEGR[c][r] = 0.f;
        f32x16 Sa, Sb; bf16x8 pf[2], kf[3], vf[3];
        {
            for (int t = 0; t < NT; ++t) {
                asm volatile("s_waitcnt vmcnt(0)" ::: "memory"); __builtin_amdgcn_s_barrier(); asm volatile("" ::: "memory");
                if (t + 2 < NT) C_ISSUE(t + 2);
                const LAS unsigned char* cur = F.lds + (t & 3) * STAGE;
                const LAS unsigned char* nxt = F.lds + ((t + 1 < NT ? t + 1 : t) & 3) * STAGE;
                if (t == 0) C_QK0(Sa, cur);
                { const bool first = (t == 0);
                C_RD(cur, 0, 1, cur, 0); C_FENCE; C_SM(Sa, 0, pf, cur, 0); C_FENCE; C_MM(Sb, cur, 0, 1, 0, pf, cur, 0); C_FENCE;
                C_RD(cur, 1, 0, cur, 0); C_FENCE; C_SM(Sb, 1, pf, cur, 0); C_FENCE; C_MM(Sa, cur, 1, 0, 1, pf, cur, 0); C_FENCE; }
                { const bool first = false;
                C_RD(cur, 1, 1, cur, 1); C_FENCE; C_SM(Sa, 0, pf, cur, 1); C_FENCE; C_MM(Sb, cur, 1, 1, 0, pf, cur, 1); C_FENCE;
                C_RD(nxt, 0, 0, cur, 1); C_FENCE; C_SM(Sb, 1, pf, cur, 1); C_FENCE; C_MM(Sa, nxt, 0, 0, 1, pf, cur, 1); C_FENCE; }
            }
        }
        const float l0 = l[0] + __shfl_xor(l[0], 32), l1 = l[1] + __shfl_xor(l[1], 32);
        const float i0 = 1.0f / l0, i1 = lam / l1;
        float ss = 0.f;
#pragma unroll
        for (int d = 0; d < 3; ++d)
#pragma unroll
            for (int r = 0; r < 16; ++r) { const float o = O[0][d][r] * i0 - O[1][d][r] * i1; O[0][d][r] = o; ss += o * o; }
        ss += __shfl_xor(ss, 32);
        const float rs = rsqrtf(ss * (1.0f / 96.0f) + LN_EPS) * post;
        bf16* yp = Y + (size_t)tok * YLD + Y_C + h * 96 + 4 * hh;
#pragma unroll
        for (int d = 0; d < 3; ++d)
#pragma unroll
            for (int rg = 0; rg < 4; ++rg) { const f32x4 gv = *(const f32x4*)(ng + d * 32 + 8 * rg + 4 * hh);
                v2u o; o.x = pk2(O[0][d][4 * rg + 0] * rs * gv[0], O[0][d][4 * rg + 1] * rs * gv[1]); o.y = pk2(O[0][d][4 * rg + 2] * rs * gv[2], O[0][d][4 * rg + 3] * rs * gv[3]);
                *(v2u*)(yp + d * 32 + 8 * rg) = o; }
        asm volatile("s_waitcnt vmcnt(0)" ::: "memory"); __builtin_amdgcn_s_barrier(); asm volatile("" ::: "memory");
    }
#undef C_ISSUE
#undef C_RD
#undef C_RDV
#undef C_MM
#undef C_QK0
#undef C_SM
#undef C_FENCE
}

constexpr int AB_VST = 192, AB_VREG = 32 * AB_VST;
constexpr int L_RPB = 51200;

__device__ __forceinline__ void sm_block64(f32x16& t, float& m, float& l, f32x16 (&O)[2], bf16x8 (&pf)[2]) {
    float mx = fmaxf(t[0], t[1]);
#pragma unroll
    for (int r = 2; r < 16; ++r) mx = fmaxf(mx, t[r]);
    mx = fmaxf(mx, __shfl_xor(mx, 32));
    if (__any(mx > m)) {
        const float mn = fmaxf(m, mx), alpha = __builtin_amdgcn_exp2f(m - mn);
#pragma unroll
        for (int d = 0; d < 2; ++d)
#pragma unroll
            for (int r = 0; r < 16; ++r) O[d][r] *= alpha;
        l *= alpha; m = mn;
    }
#pragma unroll
    for (int r = 0; r < 16; ++r) { t[r] = __builtin_amdgcn_exp2f(t[r] - m); l += t[r]; }
#pragma unroll
    for (int s2 = 0; s2 < 2; ++s2) { v4u pw; pw.x = cvtpk(t[8 * s2 + 0], t[8 * s2 + 1]); pw.y = cvtpk(t[8 * s2 + 2], t[8 * s2 + 3]);
        pw.z = cvtpk(t[8 * s2 + 4], t[8 * s2 + 5]); pw.w = cvtpk(t[8 * s2 + 6], t[8 * s2 + 7]); pf[s2] = __builtin_bit_cast(bf16x8, pw); }
}
template <class TokOf, class MaskT>
__device__ __forceinline__ void attn_run_blocks(const bf16* H, const int kcol, const int vcol, const int nb, const TokOf tok_of, const MaskT mask,
                                                const bf16x8 (&qf)[4], LAS unsigned char* vl, const int lane, f32x16 (&O)[2], float& m, float& l) {
    const int n = lane & 31, hh = lane >> 5, krow = kperm(n), g = lane >> 4, i16 = lane & 15;
    const int vrd = (8 * (g >> 1) + (i16 >> 2)) * AB_VST + (16 * (g & 1) + 4 * (i16 & 3)) * 2;
    bf16x8 kf[4]; v4u vc[4];
    { const bf16* kp = H + (size_t)tok_of(0, krow) * INC + kcol + 8 * hh;
#pragma unroll
      for (int s = 0; s < 4; ++s) kf[s] = *(const bf16x8*)(kp + 16 * s);
#pragma unroll
      for (int i = 0; i < 4; ++i) vc[i] = *(const v4u*)(H + (size_t)tok_of(0, (lane >> 3) + 8 * i) * INC + vcol + (lane & 7) * 8); }
#pragma unroll
    for (int i = 0; i < 4; ++i) *(LAS v4u*)(vl + ((lane >> 3) + 8 * i) * AB_VST + (lane & 7) * 16) = vc[i];
    for (int j = 0; j < nb; ++j) {
        const int jn = (j + 1 < nb) ? j + 1 : j;
        bf16x8 kn[4];
        { const bf16* kp = H + (size_t)tok_of(jn, krow) * INC + kcol + 8 * hh;
#pragma unroll
          for (int s = 0; s < 4; ++s) kn[s] = *(const bf16x8*)(kp + 16 * s);
#pragma unroll
          for (int i = 0; i < 4; ++i) vc[i] = *(const v4u*)(H + (size_t)tok_of(jn, (lane >> 3) + 8 * i) * INC + vcol + (lane & 7) * 8); }
        f32x16 S;
#pragma unroll
        for (int r = 0; r < 16; ++r) S[r] = 0.f;
#pragma unroll
        for (int s = 0; s < 4; ++s) S = __builtin_amdgcn_mfma_f32_32x32x16_bf16(kf[s], qf[s], S, 0, 0, 0);
        mask(j, S);
        bf16x8 pf[2];
        sm_block64(S, m, l, O, pf);
        LDS_WAIT();
#pragma unroll
        for (int s2 = 0; s2 < 2; ++s2)
#pragma unroll
            for (int d = 0; d < 2; ++d) { const LAS unsigned char* vp = vl + vrd + 16 * s2 * AB_VST + d * 64;
                const s16x4 v0 = ds_tr16(vp), v1 = ds_tr16(vp + 4 * AB_VST);
                const bf16x8 vf = (bf16x8){v0[0], v0[1], v0[2], v0[3], v1[0], v1[1], v1[2], v1[3]};
                O[d] = __builtin_amdgcn_mfma_f32_32x32x16_bf16(vf, pf[s2], O[d], 0, 0, 0); }
        LDS_WAIT(); asm volatile("" ::: "memory");
#pragma unroll
        for (int i = 0; i < 4; ++i) *(LAS v4u*)(vl + ((lane >> 3) + 8 * i) * AB_VST + (lane & 7) * 16) = vc[i];
#pragma unroll
        for (int s = 0; s < 4; ++s) kf[s] = kn[s];
    }
    LDS_WAIT(); asm volatile("" ::: "memory");
}
__device__ __forceinline__ void attn_store64(bf16* yrow, const f32x16 (&O)[2], float l, int hh) {
    const float lt = l + __shfl_xor(l, 32), inv = 1.0f / lt;
#pragma unroll
    for (int d = 0; d < 2; ++d)
#pragma unroll
        for (int rg = 0; rg < 4; ++rg) { v2u o; o.x = pk2(O[d][4 * rg + 0] * inv, O[d][4 * rg + 1] * inv); o.y = pk2(O[d][4 * rg + 2] * inv, O[d][4 * rg + 3] * inv);
            *(v2u*)(yrow + d * 32 + 8 * rg + 4 * hh) = o; }
}

__device__ __forceinline__ void attnA_mfma(Frame& F, const float* rpb  ) {
    const bf16* H = (const bf16*)(F.ws + WS_H); bf16* Y = (bf16*)(F.ws + WS_Y);
    LAS float* T = (LAS float*)(F.lds + L_RPB);
    for (int i = F.tid; i < 4 * 17 * 64; i += 512) { const int h = i / (17 * 64), rem = i - h * 17 * 64, ro = rem >> 6, co = rem & 63;
        const int rr = ro - 1, cc = co - 16; T[i] = (rr >= 0 && rr < 15 && cc >= 0 && cc < 31) ? rpb[(h * 15 + rr) * 31 + cc] * 1.4426950408889634f : 0.f; }
    __syncthreads();
    const int lane = F.lane, n = lane & 31, hh = lane >> 5;
    LAS unsigned char* vl = F.lds + F.wave * AB_VREG;
    const int gw = F.bid * 8 + F.wave, NGW = F.G * 8;
    for (int item = gw; item < 4096; item += NGW) {
        const int cb = item & 3, rp = (item >> 2) & 31, h = (item >> 7) & 3, b = item >> 9;
        const int r = 2 * rp + (n >> 4), c = 16 * cb + (n & 15);
        const int r0 = min(max(r - 4, 0), 56), c0 = min(max(c - 8, 0), 48);
        const int cw = min(max(16 * cb - 8, 0), 32);
        const int kr_lo = min(max(2 * rp - 4, 0), 56), kr_hi = min(max(2 * rp + 1 - 4, 0), 56) + 7;
        const int tokq = b * SEQ + r * 64 + c;
        bf16x8 qf[4];
        { const bf16* qp = H + (size_t)tokq * INC + C_QA + h * 64 + 8 * hh;
#pragma unroll
          for (int s = 0; s < 4; ++s) qf[s] = *(const bf16x8*)(qp + 16 * s); }
        f32x16 O[2];
#pragma unroll
        for (int d = 0; d < 2; ++d)
#pragma unroll
            for (int rr = 0; rr < 16; ++rr) O[d][rr] = 0.f;
        float m = -1e30f, l = 0.f;
        const int tok0 = b * SEQ + kr_lo * 64 + cw;
        auto tok_of = [=](int j, int kk) { return tok0 + j * 64 + kk; };
        const int colb = cw - c0 + 8 * hh;
        const int tb0 = (h * 17 + (kr_lo - r + 8)) * 64 + (cw - c + 31) + 8 * hh;
        const int rb = kr_lo - r0;
        auto mask = [=](int j, f32x16& S) {
            const bool rowok = (unsigned)(rb + j) < 8u; const LAS float* tp = T + tb0 + j * 64;
#pragma unroll
            for (int rr = 0; rr < 16; ++rr) { const int e = (rr & 7) + 16 * (rr >> 3);
                const bool ok = rowok && ((unsigned)(colb + e) < 16u);
                S[rr] = ok ? (S[rr] * (0.125f * 1.4426950408889634f) + tp[e]) : -INFINITY; }
        };
        attn_run_blocks(H, C_KA + h * 64, C_VA + h * 64, kr_hi - kr_lo + 1, tok_of, mask, qf, vl, lane, O, m, l);
        attn_store64(Y + (size_t)tokq * YLD + Y_A + h * 64, O, l, hh);
    }
}
__device__ __forceinline__ void attnB_mfma(Frame& F) {
    const bf16* H = (const bf16*)(F.ws + WS_H); bf16* Y = (bf16*)(F.ws + WS_Y);
    const int lane = F.lane, n = lane & 31, hh = lane >> 5;
    LAS unsigned char* vl = F.lds + F.wave * AB_VREG;
    const int gw = F.bid * 8 + F.wave, NGW = F.G * 8;
    for (int item = gw; item < 2048; item += NGW) {
        const int mblk = item & 7, r = (item >> 3) & 15, hg = (item >> 7) & 1, b = item >> 8;
        const int sq = r + 16 * (mblk * 32 + n), tokq = b * SEQ + sq;
        f32x16 O[2];
#pragma unroll
        for (int d = 0; d < 2; ++d)
#pragma unroll
            for (int rr = 0; rr < 16; ++rr) O[d][rr] = 0.f;
        float m = -1e30f, l = 0.f;
#pragma unroll 1
        for (int g = 0; g < 3; ++g) {
            const int sh = 2 * g, dil = 1 << sh, head = 2 * g + hg, L = SEQ >> sh, a = 16 >> sh, cls = r & (dil - 1);
            const int pq0 = (r >> sh) + a * (mblk * 32), pq = pq0 + a * n;
            const int pks = pq0 - 64, nb = (31 * a + 129 + 31) >> 5;
            bf16x8 qf[4];
            { const bf16* qp = H + (size_t)tokq * INC + C_QB + head * 64 + 8 * hh;
#pragma unroll
              for (int s = 0; s < 4; ++s) qf[s] = *(const bf16x8*)(qp + 16 * s); }
            const int tokb = b * SEQ + cls;
            auto tok_of = [=](int j, int kk) { const int pk = min(max(pks + 32 * j + kk, 0), L - 1); return tokb + (pk << sh); };
            const int b1 = pks - pq + 64 + 8 * hh, b2 = pks + 8 * hh;
            auto mask = [=](int j, f32x16& S) {
#pragma unroll
                for (int rr = 0; rr < 16; ++rr) { const int e = (rr & 7) + 16 * (rr >> 3) + 32 * j;
                    const bool ok = ((unsigned)(b1 + e) <= 128u) && ((unsigned)(b2 + e) < (unsigned)L);
                    S[rr] = ok ? S[rr] * (0.125f * 1.4426950408889634f) : -INFINITY; }
            };
            attn_run_blocks(H, C_KB + head * 64, C_VB + head * 64, nb, tok_of, mask, qf, vl, lane, O, m, l);
        }
        attn_store64(Y + (size_t)tokq * YLD + Y_B + hg * 64, O, l, hh);
    }
}

__device__ __forceinline__ void p_ln_router(Frame& F, const Args& a, int layer, bool dry = false) {
    const float* PRE = (const float*)(F.ws + WS_HH); float* XF = dry ? (float*)(F.ws + WS_H) : a.out; unsigned* XB8 = dry ? (unsigned*)(F.ws + WS_H + 160 * MiB) : (unsigned*)(F.ws + WS_XB8);
    const float* g1 = a.in[10] + layer * 1024; const float* b1 = a.in[11] + layer * 1024; const float* br = a.in[13] + layer * 32;
    const bf16* WT = (const bf16*)(F.ws + WS_WRT) + (size_t)layer * 2 * 32 * 1024;
    int* TOPE = (int*)(F.ws + (dry ? WS_H + 200 * MiB : WS_TOPE)); float* TOPW = (float*)(F.ws + (dry ? WS_H + 201 * MiB : WS_TOPW)); int* RANK = (int*)(F.ws + (dry ? WS_H + 202 * MiB : WS_RANK));
    const int cnt_off = dry ? CW_CUR : CW_CNT; int* SRCp = (int*)(F.ws + (dry ? WS_H + 204 * MiB : WS_SRC));
    LAS int* hist = (LAS int*)(F.lds + L_HIST); LAS int* base = (LAS int*)(F.lds + L_BASE);
    const int lane = F.lane;
    for (int chunk = F.bid; chunk < NTOK / 128; chunk += F.G) {
        if (F.tid < 32) hist[F.tid] = 0;
        __syncthreads();
        const int tok0 = chunk * 128 + F.wave * 16;
        {   f32x4 gv[4], bv[4];
#pragma unroll
            for (int j = 0; j < 4; ++j) { gv[j] = *(const f32x4*)(g1 + 4 * lane + 256 * j); bv[j] = *(const f32x4*)(b1 + 4 * lane + 256 * j); }
#pragma unroll 1
            for (int q = 0; q < 4; ++q) {
                f32x4 v[4][4]; float s[4], s2[4];
#pragma unroll
                for (int t = 0; t < 4; ++t) { const f32x4* pr = (const f32x4*)(PRE + (size_t)(tok0 + 4 * q + t) * 1024) + lane;
#pragma unroll
                    for (int j = 0; j < 4; ++j) v[t][j] = pr[64 * j]; }
#pragma unroll
                for (int t = 0; t < 4; ++t) { s[t] = 0.f;
#pragma unroll
                    for (int j = 0; j < 4; ++j) s[t] += (v[t][j][0] + v[t][j][1]) + (v[t][j][2] + v[t][j][3]); }
#pragma unroll
                for (int o = 1; o < 64; o <<= 1) {
#pragma unroll
                    for (int t = 0; t < 4; ++t) s[t] += __shfl_xor(s[t], o); }
#pragma unroll
                for (int t = 0; t < 4; ++t) { const float mean = s[t] * (1.f / 1024.f); s2[t] = 0.f;
#pragma unroll
                    for (int j = 0; j < 4; ++j) { v[t][j] = v[t][j] - mean; s2[t] += (v[t][j][0] * v[t][j][0] + v[t][j][1] * v[t][j][1]) + (v[t][j][2] * v[t][j][2] + v[t][j][3] * v[t][j][3]); } }
#pragma unroll
                for (int o = 1; o < 64; o <<= 1) {
#pragma unroll
                    for (int t = 0; t < 4; ++t) s2[t] += __shfl_xor(s2[t], o); }
#pragma unroll
                for (int t = 0; t < 4; ++t) { const float rstd = rsqrtf(s2[t] * (1.f / 1024.f) + LN_EPS);
                    f32x4* xo = (f32x4*)(XF + (size_t)(tok0 + 4 * q + t) * 1024) + lane; unsigned* xb = XB8 + (size_t)(tok0 + 4 * q + t) * 256 + lane;
#pragma unroll
                    for (int j = 0; j < 4; ++j) { const f32x4 y = v[t][j] * rstd * gv[j] + bv[j]; xo[64 * j] = y; xb[64 * j] = pk4_fp8(y[0], y[1], y[2], y[3], 1.0f); } }
            }
        }
        VM_WAIT(); asm volatile("" ::: "memory");
        const int tk = lane & 15, kq = lane >> 4;
        f32x4 acc[2] = {(f32x4){0.f, 0.f, 0.f, 0.f}, (f32x4){0.f, 0.f, 0.f, 0.f}};
        {   const float* xf = XF + (size_t)(tok0 + tk) * 1024 + 8 * kq;
            const bf16* w0 = WT + (size_t)tk * 1024 + 8 * kq;
#pragma unroll 4
            for (int st = 0; st < 32; ++st) {
                const f32x4 x0 = *(const f32x4*)(xf + 32 * st), x1 = *(const f32x4*)(xf + 32 * st + 4);
                v4u xhw; xhw.x = pk2(x0[0], x0[1]); xhw.y = pk2(x0[2], x0[3]); xhw.z = pk2(x1[0], x1[1]); xhw.w = pk2(x1[2], x1[3]);
                v4u xlw; xlw.x = pk2(x0[0] - bflo(xhw.x), x0[1] - bfhi(xhw.x)); xlw.y = pk2(x0[2] - bflo(xhw.y), x0[3] - bfhi(xhw.y));
                xlw.z = pk2(x1[0] - bflo(xhw.z), x1[1] - bfhi(xhw.z)); xlw.w = pk2(x1[2] - bflo(xhw.w), x1[3] - bfhi(xhw.w));
                const bf16x8 xh = __builtin_bit_cast(bf16x8, xhw), xl = __builtin_bit_cast(bf16x8, xlw);
#pragma unroll
                for (int mb = 0; mb < 2; ++mb) { const bf16x8 wh = *(const bf16x8*)(w0 + (size_t)mb * 16 * 1024 + 32 * st), wl = *(const bf16x8*)(w0 + (size_t)(32 + mb * 16) * 1024 + 32 * st);
                    acc[mb] = __builtin_amdgcn_mfma_f32_16x16x32_bf16(wh, xh, acc[mb], 0, 0, 0);
                    acc[mb] = __builtin_amdgcn_mfma_f32_16x16x32_bf16(wh, xl, acc[mb], 0, 0, 0);
                    acc[mb] = __builtin_amdgcn_mfma_f32_16x16x32_bf16(wl, xh, acc[mb], 0, 0, 0); }
            }
        }
        float v8[8];
#pragma unroll
        for (int mb = 0; mb < 2; ++mb)
#pragma unroll
            for (int i = 0; i < 4; ++i) v8[mb * 4 + i] = acc[mb][i] + br[16 * mb + 4 * kq + i];
        int se[4]; float sv[4];
#pragma unroll
        for (int r = 0; r < 4; ++r) {
            float bvv = v8[0]; int bi = 4 * kq;
#pragma unroll
            for (int sl = 1; sl < 8; ++sl) { const int eid = 16 * (sl >> 2) + 4 * kq + (sl & 3); if (v8[sl] > bvv) { bvv = v8[sl]; bi = eid; } }
#pragma unroll
            for (int o = 16; o < 64; o <<= 1) { const float ov = __shfl_xor(bvv, o); const int oi = __shfl_xor(bi, o);
                if (ov > bvv || (ov == bvv && oi < bi)) { bvv = ov; bi = oi; } }
            se[r] = bi; sv[r] = bvv;
#pragma unroll
            for (int sl = 0; sl < 8; ++sl) { const int eid = 16 * (sl >> 2) + 4 * kq + (sl & 3); if (eid == bi) v8[sl] = -3.0e38f; }
        }
        const float p1 = __expf(sv[1] - sv[0]), p2 = __expf(sv[2] - sv[0]), p3 = __expf(sv[3] - sv[0]);
        const float inv = 1.0f / (1.0f + p1 + p2 + p3);
        int lr[4] = {0, 0, 0, 0};
        if (lane < 16) { const int tok = tok0 + tk;
            *(int4*)(TOPE + tok * 4) = make_int4(se[0], se[1], se[2], se[3]);
            *(f32x4*)(TOPW + tok * 4) = (f32x4){inv, p1 * inv, p2 * inv, p3 * inv};
#pragma unroll
            for (int k = 0; k < 4; ++k) lr[k] = __hip_atomic_fetch_add(&hist[se[k]], 1, __ATOMIC_RELAXED, __HIP_MEMORY_SCOPE_WORKGROUP); }
        __syncthreads();
        if (F.tid < 32) { const int c = hist[F.tid]; base[F.tid] = c ? (int)__hip_atomic_fetch_add(F.ctl + cnt_off + layer * 64 + F.tid, (unsigned)c, RLX_AGENT) : 0; }
        __syncthreads();
        if (lane < 16) { const int tok = tok0 + tk;
            const int r0 = base[se[0]] + lr[0], r1 = base[se[1]] + lr[1], r2 = base[se[2]] + lr[2], r3 = base[se[3]] + lr[3];
            *(int4*)(RANK + tok * 4) = make_int4(r0, r1, r2, r3);
            int* SRC = SRCp; SRC[se[0] * NTOK + r0] = tok; SRC[se[1] * NTOK + r1] = tok; SRC[se[2] * NTOK + r2] = tok; SRC[se[3] * NTOK + r3] = tok; }
        __syncthreads();
    }
}

__device__ __forceinline__ int moe_build(Frame& F, int layer) {
    LAS int* offT = (LAS int*)(F.lds + L_OFFT); LAS int* tile_e = (LAS int*)(F.lds + L_TILE);
    __syncthreads();
    if (F.tid < 64) {
        const int c = (F.lane < 32) ? (int)__hip_atomic_load(F.ctl + CW_CNT + layer * 64 + F.lane, RLX_AGENT) : 0;
        const int ntile = (c + 255) >> 8; int x = ntile;
#pragma unroll
        for (int d = 1; d < 32; d <<= 1) { const int v = __shfl_up(x, d); if (F.lane >= d) x += v; }
        if (F.lane < 32) { offT[F.lane] = x - ntile; ((LAS int*)(F.lds + L_CNT))[F.lane] = c; }
        if (F.lane == 31) offT[32] = x;
    }
    __syncthreads();
    int T = __builtin_amdgcn_readfirstlane(offT[32]); if (T > MAXT) T = MAXT;
    for (int mt = F.tid; mt < T; mt += 512) { int e = 0;
#pragma unroll 1
        for (int j = 1; j < 32; ++j) if (offT[j] <= mt) e = j;
        tile_e[mt] = e; }
    __syncthreads();
    return T;
}

__device__ __forceinline__ void p_combine_ln(Frame& F, const Args& a, int layer, bool dry = false) {
    float* XF = a.out; float* XFo = dry ? (float*)(F.ws + WS_HH) : a.out; bf16* XB = (bf16*)(F.ws + (dry ? WS_M : WS_XB)); const bf16* YS = (const bf16*)(F.ws + WS_H);
    const int* TOPE = (const int*)(F.ws + WS_TOPE); const int* RANK = (const int*)(F.ws + WS_RANK); const float* TOPW = (const float*)(F.ws + WS_TOPW);
    const LAS int* offT = (const LAS int*)(F.lds + L_OFFT);
    const float* g2 = a.in[20] + layer * 1024; const float* b2 = a.in[21] + layer * 1024;
    const int gw = F.bid * 8 + F.wave, NGW = F.G * 8, lane = F.lane;
    f32x4 gv[4], bv[4];
#pragma unroll
    for (int j = 0; j < 4; ++j) { gv[j] = *(const f32x4*)(g2 + 4 * lane + 256 * j); bv[j] = *(const f32x4*)(b2 + 4 * lane + 256 * j); }
    for (int tp = gw; tp < NTOK / 2; tp += NGW) {
        f32x4 v[2][4]; v2u yw[2][4][4]; f32x4 tw[2];
#pragma unroll
        for (int u = 0; u < 2; ++u) { const int tok = tp * 2 + u;
            const int4 te = *(const int4*)(TOPE + tok * 4), rk = *(const int4*)(RANK + tok * 4); tw[u] = *(const f32x4*)(TOPW + tok * 4);
            const f32x4* xr = (const f32x4*)(XF + (size_t)tok * 1024) + lane;
#pragma unroll
            for (int j = 0; j < 4; ++j) v[u][j] = xr[64 * j];
            const int pk[4] = {offT[te.x] * 256 + rk.x, offT[te.y] * 256 + rk.y, offT[te.z] * 256 + rk.z, offT[te.w] * 256 + rk.w};
#pragma unroll
            for (int k = 0; k < 4; ++k) { const v2u* yr = (const v2u*)(YS + (size_t)pk[k] * 1024) + lane;
#pragma unroll
                for (int j = 0; j < 4; ++j) yw[u][k][j] = yr[64 * j]; } }
        float s[2], s2[2];
#pragma unroll
        for (int u = 0; u < 2; ++u) {
#pragma unroll
            for (int j = 0; j < 4; ++j) { v[u][j] = v[u][j] * DN_ALPHA;
#pragma unroll
                for (int k = 0; k < 4; ++k) { const v2u y = yw[u][k][j]; v[u][j] = v[u][j] + tw[u][k] * (f32x4){bflo(y.x), bfhi(y.x), bflo(y.y), bfhi(y.y)}; } }
            s[u] = 0.f;
#pragma unroll
            for (int j = 0; j < 4; ++j) s[u] += (v[u][j][0] + v[u][j][1]) + (v[u][j][2] + v[u][j][3]); }
#pragma unroll
        for (int o = 1; o < 64; o <<= 1) { s[0] += __shfl_xor(s[0], o); s[1] += __shfl_xor(s[1], o); }
#pragma unroll
        for (int u = 0; u < 2; ++u) { const float mean = s[u] * (1.f / 1024.f); s2[u] = 0.f;
#pragma unroll
            for (int j = 0; j < 4; ++j) { v[u][j] = v[u][j] - mean; s2[u] += (v[u][j][0] * v[u][j][0] + v[u][j][1] * v[u][j][1]) + (v[u][j][2] * v[u][j][2] + v[u][j][3] * v[u][j][3]); } }
#pragma unroll
        for (int o = 1; o < 64; o <<= 1) { s2[0] += __shfl_xor(s2[0], o); s2[1] += __shfl_xor(s2[1], o); }
#pragma unroll
        for (int u = 0; u < 2; ++u) { const int tok = tp * 2 + u; const float rstd = rsqrtf(s2[u] * (1.f / 1024.f) + LN_EPS);
            f32x4* xo = (f32x4*)(XFo + (size_t)tok * 1024) + lane; v2u* xb = (v2u*)(XB + (size_t)tok * 1024) + lane; unsigned* x8 = (unsigned*)(F.ws + (dry ? WS_M + 32 * MiB : WS_XB8)) + (size_t)tok * 256 + lane;
#pragma unroll
            for (int j = 0; j < 4; ++j) { const f32x4 y = v[u][j] * rstd * gv[j] + bv[j]; xo[64 * j] = y; xb[64 * j] = (v2u){pk2(y[0], y[1]), pk2(y[2], y[3])}; x8[64 * j] = pk4_fp8(y[0], y[1], y[2], y[3], 1.0f); } }
    }
}

__device__ __forceinline__ const Args* fresh_args() { unsigned long long p = (unsigned long long)__builtin_amdgcn_kernarg_segment_ptr(); asm volatile("" : "+s"(p)); return (const Args*)(const __attribute__((address_space(4))) void*)p; }
constexpr int PH_PER_LAYER = 10, N_PHASES = 1 + DEPTH * PH_PER_LAYER;
__global__ void __launch_bounds__(512, 2) mk_fwd(Args args) {
    extern __shared__ __attribute__((aligned(16))) unsigned char lds[];
    Frame F;
    F.lds = (LAS unsigned char*)lds; F.tid = threadIdx.x; F.lane = F.tid & 63; F.wave = __builtin_amdgcn_readfirstlane(F.tid >> 6);
    F.G = gridDim.x; F.bid = blockIdx.x; F.ws = fresh_args()->ws; F.ctl = (unsigned*)(F.ws + WS_CTL);
    for (int u = F.tid; u < (LDS_BYTES - LDSCTL_OFF) / 4; u += 512) ((LAS unsigned*)(F.lds + LDSCTL_OFF))[u] = 0u;
    __syncthreads();
    const int lo = fresh_args()->ph_lo, hi = fresh_args()->ph_hi;
    XcdBarrier bar; bar.bar = F.ctl + CW_BAR; bar.x = 0; bar.st = nullptr;
    if (hi - lo > 1) bar = xcd_barrier_post(F.ctl + CW_BAR, (volatile LAS unsigned*)(F.lds + L_MISC) + 8);
#define IN(k) (lo <= (k) && (k) < hi)
#define REFRESH() do { F.tid = opaque_tid(); F.lane = F.tid & 63; F.wave = __builtin_amdgcn_readfirstlane(F.tid >> 6); asm volatile("" : "+s"(F.bid), "+s"(F.G)); } while (0)
#define SEAM(k) do { if ((k) + 1 < hi) xcd_barrier(bar); } while (0)

#ifndef NO_P0
    if (IN(0)) { _Pragma("unroll") for (int rep = 0; rep < REP_T; ++rep) p_prologue(F, *fresh_args()); SEAM(0); }
#endif

    for (int l = 0; l < DEPTH; ++l) {
        const int pb = 1 + l * PH_PER_LAYER;
#ifndef NO_P1
        if (IN(pb + 0)) {
            REFRESH();
            {
                pg8::DenseOrder S{(const char*)(F.ws + WS_XB), (const char*)(F.ws + WS_WIN) + (size_t)l * INC * 1024 * 2, (size_t)256 * 1024 * 2, (size_t)256 * 1024 * 2, 16, NTOK / 256, 12, F.G, F.bid};
                pg8::EpiInProj E{(bf16*)(F.ws + WS_H), fresh_args()->in[2] + l * 3072, (const f32x2*)(F.ws + WS_ROPE64), (const f32x2*)(F.ws + WS_ROPE48), 1.0f, (unsigned char*)(F.ws + WS_G8)};
                _Pragma("unroll") for (int rep = 0; rep < REP_G1; ++rep) pg8::gemm_phase<pg8::EpiInProj, pg8::DenseOrder, true, true>(F.lds, 1024, 1024, S, E);
            }
            {
                REFRESH();
                pg8::DenseOrder S{(const char*)(F.ws + WS_XB8), (const char*)(F.ws + WS_WIN8) + (size_t)l * 3072 * 1024, (size_t)256 * 1024, (size_t)256 * 1024, 8, NTOK / 256, 12, F.G, F.bid, 12};
                pg8::EpiInProj E{(bf16*)(F.ws + WS_H), fresh_args()->in[2] + l * 3072, (const f32x2*)(F.ws + WS_ROPE64), (const f32x2*)(F.ws + WS_ROPE48), 1.0f / 32.0f, (unsigned char*)(F.ws + WS_G8)};
                _Pragma("unroll") for (int rep = 0; rep < REP_G1; ++rep) pg8::gemm_phase<pg8::EpiInProj, pg8::DenseOrder, true, true, true>(F.lds, 1024, 1024, S, E);
            }
            if (pb + 2 < hi) xcd_barrier(bar);
        }
#endif
#ifndef NO_P1B
#endif
        if (IN(pb + 2)) {
            REFRESH();
#ifndef NO_PC
            _Pragma("unroll") for (int rep = 0; rep < REP_C; ++rep) attnC_pipe(F, fresh_args()->in[8] + l * 4 * 48, fresh_args()->in[9] + l * 96, fresh_args()->lam_init[l]);
#endif
#ifndef NO_PA
            REFRESH();
            _Pragma("unroll") for (int rep = 0; rep < REP_AB; ++rep) attnA_mfma(F, fresh_args()->in[7] + l * 4 * 15 * 31);
#endif
#ifndef NO_PB
            REFRESH();
            _Pragma("unroll") for (int rep = 0; rep < REP_AB; ++rep) attnB_mfma(F);
#endif
            SEAM(pb + 2);
        }
#ifndef NO_P3
        if (IN(pb + 3)) {
            REFRESH();
            pg8::ProjOrder S{(const char*)(F.ws + WS_Y), (const char*)(F.ws + WS_WPROJ) + (size_t)l * 1024 * WPK * 2, NTOK / 256, 4, F.G, F.bid};
            pg8::EpiProj E{(const unsigned char*)(F.ws + WS_G8), (bf16*)(F.ws + WS_M)};
            _Pragma("unroll") for (int rep = 0; rep < REP_G3; ++rep) pg8::gemm_phase<pg8::EpiProj, pg8::ProjOrder, true, true>(F.lds, YLD, WPK, S, E);
            SEAM(pb + 3);
        }
#endif
#ifndef NO_P4
        if (IN(pb + 4)) {
            REFRESH();
            pg8::DenseOrder S{(const char*)(F.ws + WS_M), (const char*)(F.ws + WS_WOUT) + (size_t)l * 1024 * 1024 * 2, (size_t)256 * 1024 * 2, (size_t)256 * 1024 * 2, 16, NTOK / 256, 4, F.G, F.bid};
            pg8::EpiOut E{l == 0 ? fresh_args()->in[0] : (const float*)fresh_args()->out, (float*)(F.ws + WS_HH)};
            _Pragma("unroll") for (int rep = 0; rep < REP_G4; ++rep) pg8::gemm_phase<pg8::EpiOut, pg8::DenseOrder, true, true>(F.lds, 1024, 1024, S, E);
            SEAM(pb + 4);
        }
#endif
#ifndef NO_P5
        if (IN(pb + 5)) { REFRESH(); if (DRY_P5) p_ln_router(F, *fresh_args(), l, true); p_ln_router(F, *fresh_args(), l); if (pb + 7 < hi) xcd_barrier(bar); }
#endif
#ifndef NO_P5B
#endif
#ifndef NO_P6
        if (IN(pb + 7)) {
            REFRESH(); const int T = moe_build(F, l);
            pg8::MoeOrder S{(const char*)(F.ws + WS_XB8), (const char*)(F.ws + WS_WGU) + (size_t)l * NEXP * 2048 * 1024, (size_t)2048 * 1024, (size_t)256 * 1024, (size_t)256 * 1024, 8,
                            (const LAS int*)(F.lds + L_TILE), (const LAS int*)(F.lds + L_OFFT), (const LAS int*)(F.lds + L_CNT), (const int*)(F.ws + WS_SRC), T, 8, F.G, F.bid};
            pg8::EpiSwiglu E{(unsigned char*)(F.ws + WS_HH), fresh_args()->in[15] + (size_t)l * NEXP * 1024, fresh_args()->in[17] + (size_t)l * NEXP * 1024, 1.0f / 32.0f};
            _Pragma("unroll") for (int rep = 0; rep < REP_G6; ++rep) pg8::gemm_phase_gather<pg8::EpiSwiglu, pg8::MoeOrder, true>(F.lds, (const char*)(F.ws + WS_XB8), 1024, 1024, S, E);
            SEAM(pb + 7);
        }
#endif
#ifndef NO_P7
        if (IN(pb + 8)) {
            REFRESH(); const int T = moe_build(F, l);
            pg8::MoeOrder S{(const char*)(F.ws + WS_HH), (const char*)(F.ws + WS_WDN) + (size_t)l * NEXP * 1024 * 1024, (size_t)1024 * 1024, (size_t)256 * 1024, (size_t)256 * 1024, 8,
                            (const LAS int*)(F.lds + L_TILE), (const LAS int*)(F.lds + L_OFFT), (const LAS int*)(F.lds + L_CNT), (const int*)(F.ws + WS_SRC), T, 4, F.G, F.bid};
            pg8::EpiDown E{(bf16*)(F.ws + WS_H), fresh_args()->in[19] + (size_t)l * NEXP * 1024, 1.0f / 256.0f};
            _Pragma("unroll") for (int rep = 0; rep < REP_G7; ++rep) pg8::gemm_phase<pg8::EpiDown, pg8::MoeOrder, true, true, true>(F.lds, 1024, 1024, S, E);
            SEAM(pb + 8);
        }
#endif
#ifndef NO_P8
        if (IN(pb + 9)) { REFRESH(); (void)moe_build(F, l); if (DRY_P8) p_combine_ln(F, *fresh_args(), l, true); p_combine_ln(F, *fresh_args(), l); SEAM(pb + 9); }
#endif
    }
#undef IN
#undef SEAM
}

extern "C" void kernel_launch(void* const* d_in, const int* in_sizes, int n_in, void* d_out, int out_size, void* d_ws, size_t ws_size, hipStream_t stream) {
    static int grid = 0;
    if (grid == 0) {
        if (n_in != 22 || in_sizes[0] != NTOK * D || out_size != NTOK * D || ws_size < WS_END) {
            fprintf(stderr, "kernel_launch: unexpected shapes (n_in %d, in0 %d, out %d, ws %zu); nothing launched\n", n_in, n_in > 0 ? in_sizes[0] : -1, out_size, ws_size); grid = -1; return; }
        int dev = 0, cus = 0, per_cu = 0;
        if (hipGetDevice(&dev) != hipSuccess || hipDeviceGetAttribute(&cus, hipDeviceAttributeMultiprocessorCount, dev) != hipSuccess) { grid = -1; return; }
        if (hipFuncSetAttribute((const void*)mk_fwd, hipFuncAttributeMaxDynamicSharedMemorySize, LDS_BYTES) != hipSuccess) { fprintf(stderr, "kernel_launch: hipFuncSetAttribute failed\n"); grid = -1; return; }
        if (hipOccupancyMaxActiveBlocksPerMultiprocessor(&per_cu, (const void*)mk_fwd, 512, LDS_BYTES) != hipSuccess || per_cu < 1)
            fprintf(stderr, "kernel_launch: note: occupancy query reports %d workgroups per CU\n", per_cu);
        (void)hipGetLastError();
        grid = cus;
    }
    if (grid < 0) return;
    if (hipMemsetAsync((char*)d_ws + WS_CTL, 0, CTL_ZERO_BYTES, stream) != hipSuccess) { fprintf(stderr, "kernel_launch: memset failed\n"); return; }
    Args a{};
    for (int i = 0; i < 22; ++i) a.in[i] = (const float*)d_in[i];
    a.out = (float*)d_out; a.ws = (unsigned char*)d_ws;
    for (int l = 0; l < DEPTH; ++l) a.lam_init[l] = (float)(0.8 - 0.6 * exp(-0.3 * (double)l));
#if MK_ONE_LAUNCH
    a.ph_lo = 0; a.ph_hi = N_PHASES;
    hipLaunchKernelGGL(mk_fwd, dim3(grid), dim3(512), LDS_BYTES, stream, a);
#else
    for (int p = 0; p < N_PHASES; ++p) {
        a.ph_lo = p; a.ph_hi = p + 1;
        hipLaunchKernelGGL(mk_fwd, dim3(grid), dim3(512), LDS_BYTES, stream, a);
    }
#endif
    const hipError_t le = hipPeekAtLastError();
    if (le != hipSuccess) fprintf(stderr, "kernel_launch: launch failed: %s\n", hipGetErrorName(le));
}
```

```cpp
#include <hip/hip_runtime.h>
#include <cstdio>
#include <cstdint>
#include <cmath>

#ifndef REP_AB
#define REP_AB 1
#endif
#ifndef REP_C
#define REP_C 1
#endif
#ifndef REP_G
#define REP_G 1
#endif
#ifndef REP_G1
#define REP_G1 REP_G
#endif
#ifndef REP_G3
#define REP_G3 REP_G
#endif
#ifndef REP_G4
#define REP_G4 REP_G
#endif
#ifndef REP_G6
#define REP_G6 REP_G
#endif
#ifndef REP_G7
#define REP_G7 REP_G
#endif
#ifndef REP_T
#define REP_T 1
#endif
#ifndef DRY_P5
#define DRY_P5 0
#endif
#ifndef DRY_P8
#define DRY_P8 0
#endif
#ifndef C_ANTIPHASE
#define C_ANTIPHASE 0
#endif
#ifndef MK_ONE_LAUNCH
#define MK_ONE_LAUNCH 1
#endif

#define GAS __attribute__((address_space(1)))
#define LAS __attribute__((address_space(3)))
typedef unsigned short bf16;
typedef unsigned v4u __attribute__((ext_vector_type(4)));
typedef unsigned v2u __attribute__((ext_vector_type(2)));
typedef float f32x4 __attribute__((ext_vector_type(4)));
typedef float f32x2 __attribute__((ext_vector_type(2)));
typedef short bf16x8 __attribute__((ext_vector_type(8)));

constexpr int NTOK = 32768, SEQ = 4096, D = 1024, DEPTH = 4, INC = 6144, NEXP = 32, TOPK = 4;
constexpr int C_QA = 0, C_KA = 256, C_VA = 512, C_QB = 768, C_KB = 1152, C_VB = 1536, C_QC = 1920, C_KC = 2304, C_VC = 2688, C_GP = 3072;
constexpr int YLD = 768, Y_A = 0, Y_B = 256, Y_C = 384;
constexpr int WPK = 896;
constexpr int MAXT = 544;
constexpr float LN_EPS = 1e-5f;
constexpr float DN_ALPHA = 1.681792830507429f;

constexpr size_t MiB = 1u << 20;
constexpr size_t WS_CTL = 0, CTL_ZERO_BYTES = 1 * MiB;
constexpr size_t WS_ROPE64 = 1 * MiB;
constexpr size_t WS_ROPE48 = 2 * MiB;
constexpr size_t WS_TOPE = 3 * MiB;
constexpr size_t WS_TOPW = 3 * MiB + 512 * 1024;
constexpr size_t WS_POS = 4 * MiB;
constexpr size_t WS_WIN = 8 * MiB;
constexpr size_t WS_WPROJ = 56 * MiB;
constexpr size_t WS_WOUT = 64 * MiB;
constexpr size_t WS_WGU = 72 * MiB;
constexpr size_t WS_WDN = 584 * MiB;
constexpr size_t WS_XB = 840 * MiB;
constexpr size_t WS_Y = 904 * MiB;
constexpr size_t WS_M = 952 * MiB;
constexpr size_t WS_H = 1016 * MiB;
constexpr size_t WS_HH = 1400 * MiB;
constexpr size_t WS_WRT = 5 * MiB;
constexpr size_t WS_RANK = 6 * MiB;
constexpr size_t WS_SRC = 1672 * MiB;
constexpr size_t WS_XB8 = 1676 * MiB;
constexpr size_t WS_WIN8 = 1708 * MiB;
constexpr size_t WS_G8 = 1720 * MiB;
constexpr size_t WS_END = 1816 * MiB;
constexpr int CW_BAR = 4096;
constexpr int CW_CNT = 8192;
constexpr int CW_CUR = 8192 + 4 * 64;

constexpr int RING_BYTES = 131072;
constexpr int LDSCTL_OFF = RING_BYTES;
constexpr int L_MISC = LDSCTL_OFF;
constexpr int L_OFFT = LDSCTL_OFF + 256;
constexpr int L_HIST = LDSCTL_OFF + 512;
constexpr int L_BASE = LDSCTL_OFF + 768;
constexpr int L_CNT = LDSCTL_OFF + 896;
constexpr int L_TILE = LDSCTL_OFF + 1024;
constexpr int L_PPOS = LDSCTL_OFF + 4096;
constexpr int L_PTOK = LDSCTL_OFF + 6144;
constexpr int LDS_BYTES = 147456;
static_assert(L_PTOK + 2048 <= LDS_BYTES, "LDS map");

#define RLX_AGENT __ATOMIC_RELAXED, __HIP_MEMORY_SCOPE_AGENT
#define LDS_WAIT() asm volatile("s_waitcnt lgkmcnt(0)" ::: "memory")
#define VM_WAIT() asm volatile("s_waitcnt vmcnt(0)" ::: "memory")

__device__ __forceinline__ float bf2f(unsigned short b) { return __uint_as_float(((unsigned)b) << 16); }
__device__ __forceinline__ float bflo(unsigned u) { return __uint_as_float(u << 16); }
__device__ __forceinline__ float bfhi(unsigned u) { return __uint_as_float(u & 0xffff0000u); }
__device__ __forceinline__ unsigned f2bf(float f) { unsigned u = __builtin_bit_cast(unsigned, f); return (u + 0x7fffu + ((u >> 16) & 1u)) >> 16; }
__device__ __forceinline__ unsigned pk2(float lo, float hi) { return f2bf(lo) | (f2bf(hi) << 16); }
__device__ __forceinline__ float wave_sum(float v) {
#pragma unroll
    for (int o = 1; o < 64; o <<= 1) v += __shfl_xor(v, o);
    return v;
}
__device__ __forceinline__ int opaque_tid() { int t; asm volatile("v_mov_b32 %0, %1" : "=v"(t) : "v"(threadIdx.x)); return t; }
__device__ __forceinline__ unsigned pk4_fp8(float a, float b, float c, float d, float sc) {
    a = fminf(fmaxf(a * sc, -448.f), 448.f); b = fminf(fmaxf(b * sc, -448.f), 448.f); c = fminf(fmaxf(c * sc, -448.f), 448.f); d = fminf(fmaxf(d * sc, -448.f), 448.f);
    int p = __builtin_amdgcn_cvt_pk_fp8_f32(a, b, 0, false); p = __builtin_amdgcn_cvt_pk_fp8_f32(c, d, p, true); return (unsigned)p; }
__device__ __forceinline__ float fast_sigmoid(float x) { return __builtin_amdgcn_rcpf(1.0f + __builtin_amdgcn_exp2f(-1.4426950408889634f * x)); }

namespace pg8 {
#define PG8_LAS __attribute__((address_space(3)))
typedef unsigned short bf16_t;
typedef unsigned u32x4 __attribute__((ext_vector_type(4)));
constexpr int BM = 256, BK = 64, HALF = 128, HTB = HALF * BK * 2, STAGE_BYTES = 8 * HTB, NXCD = 8, WGM = 8;

__host__ __device__ __forceinline__ int lds_byte(int r, int c) { const int st = (r >> 4) * 2 + (c >> 5), rr = r & 15, cc = c & 31, ob = rr * 64 + cc * 2; return st * 1024 + (ob ^ (((ob >> 9) & 1) << 5)); }
__host__ __device__ __forceinline__ void stage_rc(int b, int& R, int& C) { const int st = b / 1024, sb = b % 1024, swz = sb ^ (((sb >> 9) & 1) << 5); R = (st >> 1) * 16 + swz / 64; C = (st & 1) * 32 + (swz % 64) / 2; }
__host__ __device__ __forceinline__ int perm32(int rho) { const int n = rho >> 4, i = rho & 15; return 8 * (i >> 2) + 4 * n + (i & 3); }

struct Unit { const char* A; const char* B; int nt; int pm, pn, aux; };

__device__ __forceinline__ void tile_of(int L, int nM, int nN, int& pm, int& pn) {
    const int nwg = nM * nN;
    int wgid = L; { const int q = nwg / NXCD, r = nwg % NXCD, xcd = wgid % NXCD, off = wgid / NXCD; wgid = (xcd < r ? xcd * (q + 1) : r * (q + 1) + (xcd - r) * q) + off; }
    const int nig = WGM * nN, gid = wgid / nig, fm = gid * WGM, gsz = (nM - fm) < WGM ? (nM - fm) : WGM;
    pm = fm + ((wgid % nig) % gsz); pn = (wgid % nig) / gsz;
}

__device__ __forceinline__ unsigned cvt_pk_bf16(float lo, float hi) { unsigned r; asm volatile("v_cvt_pk_bf16_f32 %0, %1, %2" : "=v"(r) : "v"(lo), "v"(hi)); return r; }
typedef int v8i32 __attribute__((ext_vector_type(8)));
typedef short s16x16 __attribute__((ext_vector_type(16)));
typedef int v4i32 __attribute__((ext_vector_type(4)));
__device__ __forceinline__ v8i32 cat8(bf16x8 lo, bf16x8 hi) { const v4i32 a = __builtin_bit_cast(v4i32, lo), b = __builtin_bit_cast(v4i32, hi); return __builtin_shufflevector(a, b, 0, 1, 2, 3, 4, 5, 6, 7); }

template <class Epi, class Sched, bool ALIGN_EPI, bool SP2, bool FP8 = false>
__device__ __forceinline__ void gemm_phase(PG8_LAS unsigned char* lds, const int lda, const int ldb, const Sched& S, const Epi& E, const int sclW = 0x7f7f7f7f, const int sclX = 0x7f7f7f7f) {
    constexpr int EB = FP8 ? 1 : 2;
    const int tid = opaque_tid(), wid = __builtin_amdgcn_readfirstlane(tid >> 6), lane = tid & 63, wr = wid >> 2, wc = wid & 3, fr = lane & 15, fq = lane >> 4;
    unsigned voffA[2], voffB[2];
#pragma unroll
    for (int i = 0; i < 2; ++i) { int R, C; stage_rc(tid * 16 + i * 8192, R, C); const int Rb = Epi::PERM ? ((R & ~31) + perm32(R & 31)) : R;
        voffA[i] = (unsigned)(R * lda * EB + C * 2); voffB[i] = (unsigned)(Rb * ldb * EB + C * 2); }
    const size_t kstep = (size_t)(BK * 2);
    const size_t hA = (size_t)HALF * lda * EB, hB = (size_t)HALF * ldb * EB;
    const unsigned ldsw = (unsigned)wid * 1024u;
    const int fcol = FP8 ? (32 * (fq >> 1) + 16 * (fq & 1)) : fq * 8;
    const int aoff = lds_byte(wr * 64 + fr, fcol), boff = lds_byte(wc * 32 + fr, fcol);
#define PG8_SA(b, h) (((b) * 2 + (h)) * HTB)
#define PG8_SB(b, h) ((4 + (b) * 2 + (h)) * HTB)
#define PG8_STAGE(bufoff, gbase, voff) do { _Pragma("unroll") for (int _i = 0; _i < 2; ++_i) \
        __builtin_amdgcn_global_load_lds((const unsigned*)((const char*)(gbase) + (voff)[_i]), (PG8_LAS unsigned*)(lds + (bufoff) + ldsw + _i * 8192), 16, 0, 0); } while (0)
#define PG8_LDA(dst, b, h) do { if constexpr (FP8) { _Pragma("unroll") for (int m = 0; m < 4; ++m) dst##8[m] = cat8(*(const PG8_LAS bf16x8*)(lds + PG8_SA(b, h) + aoff + m * 2048), *(const PG8_LAS bf16x8*)(lds + PG8_SA(b, h) + aoff + m * 2048 + 16)); } else { \
        _Pragma("unroll") for (int m = 0; m < 4; ++m) _Pragma("unroll") for (int k = 0; k < 2; ++k) dst[m][k] = *(const PG8_LAS bf16x8*)(lds + PG8_SA(b, h) + aoff + m * 2048 + k * 1024); } } while (0)
#define PG8_LDB(dst, b, h) do { if constexpr (FP8) { _Pragma("unroll") for (int n = 0; n < 2; ++n) dst##8[n] = cat8(*(const PG8_LAS bf16x8*)(lds + PG8_SB(b, h) + boff + n * 2048), *(const PG8_LAS bf16x8*)(lds + PG8_SB(b, h) + boff + n * 2048 + 16)); } else { \
        _Pragma("unroll") for (int n = 0; n < 2; ++n) _Pragma("unroll") for (int k = 0; k < 2; ++k) dst[n][k] = *(const PG8_LAS bf16x8*)(lds + PG8_SB(b, h) + boff + n * 2048 + k * 1024); } } while (0)
#define PG8_MMA(ai, bj, At, Bt) do { __builtin_amdgcn_s_setprio(1); if constexpr (FP8) { _Pragma("unroll") for (int m = 0; m < 4; ++m) _Pragma("unroll") for (int n = 0; n < 2; ++n) \
        asm volatile("v_mfma_f32_16x16x128_f8f6f4 %0, %1, %2, %0" : "+v"(acc[ai][bj][m][n]) : "v"(Bt##8[n]), "v"(At##8[m])); } else { \
        _Pragma("unroll") for (int m = 0; m < 4; ++m) _Pragma("unroll") for (int n = 0; n < 2; ++n) _Pragma("unroll") for (int k = 0; k < 2; ++k) \
        acc[ai][bj][m][n] = __builtin_amdgcn_mfma_f32_16x16x32_bf16(Bt[n][k], At[m][k], acc[ai][bj][m][n], 0, 0, 0); } __builtin_amdgcn_s_setprio(0); } while (0)
#define PG8_WAIT_V(n) asm volatile("s_waitcnt vmcnt(" #n ")" ::: "memory")
#define PG8_WAIT_L(n) asm volatile("s_waitcnt lgkmcnt(" #n ")" ::: "memory")
#define PG8_BAR __builtin_amdgcn_s_barrier()
#define PG8_SCHED __builtin_amdgcn_sched_barrier(0)
    Unit cur, nxt; int ui = 0;
    if (!S.next(0, cur)) return;
    f32x4 acc[2][2][4][2];
#pragma unroll
    for (int a = 0; a < 2; ++a)
#pragma unroll
        for (int b = 0; b < 2; ++b)
#pragma unroll
            for (int m = 0; m < 4; ++m)
#pragma unroll
                for (int n = 0; n < 2; ++n) acc[a][b][m][n] = (f32x4){0.f, 0.f, 0.f, 0.f};
    bf16x8 At[4][2], B0[2][2], B1[2][2]; v8i32 At8[4], B08[2], B18[2];
    const char* cA = cur.A; const char* cB = cur.B;
    if constexpr (SP2) {
        PG8_STAGE(PG8_SB(0, 0), cB, voffB); PG8_STAGE(PG8_SB(0, 1), cB + hB, voffB); PG8_STAGE(PG8_SA(0, 0), cA, voffA); PG8_STAGE(PG8_SA(0, 1), cA + hA, voffA);
        if (wr == 1) PG8_BAR;
        PG8_WAIT_V(2); PG8_BAR;
        PG8_STAGE(PG8_SB(1, 0), cB + kstep, voffB); PG8_STAGE(PG8_SA(1, 0), cA + kstep, voffA); PG8_STAGE(PG8_SB(1, 1), cB + hB + kstep, voffB);
        PG8_WAIT_V(6); PG8_BAR;
    } else {
        PG8_STAGE(PG8_SB(0, 0), cB, voffB); PG8_STAGE(PG8_SA(0, 0), cA, voffA); PG8_STAGE(PG8_SB(0, 1), cB + hB, voffB); PG8_STAGE(PG8_SA(0, 1), cA + hA, voffA);
        if (wr == 1) PG8_BAR;
        PG8_WAIT_V(4); PG8_BAR;
        PG8_STAGE(PG8_SB(1, 0), cB + kstep, voffB); PG8_STAGE(PG8_SA(1, 0), cA + kstep, voffA); PG8_STAGE(PG8_SB(1, 1), cB + hB + kstep, voffB);
        PG8_WAIT_V(6); PG8_BAR;
    }
    for (;;) {
        const bool has_next = S.next(ui + 1, nxt);
        const char* nA = has_next ? nxt.A : cA; const char* nB = has_next ? nxt.B : cB;
        const int nt = cur.nt;
        for (int t = 0; t < nt; t += 2) {
            const bool last = (t == nt - 2);
            const char* a1 = cA + (size_t)(t + 1) * kstep;
            const char* a2 = last ? nA : cA + (size_t)(t + 2) * kstep; const char* b2 = last ? nB : cB + (size_t)(t + 2) * kstep;
            const char* a3 = a2 + kstep; const char* b3 = b2 + kstep;
            if constexpr (SP2) {
            PG8_LDB(B0, 0, 0); PG8_LDB(B1, 0, 1); PG8_SCHED; PG8_LDA(At, 0, 0); PG8_STAGE(PG8_SA(1, 1), a1 + hA, voffA);
            PG8_WAIT_V(8); PG8_WAIT_L(0); PG8_BAR; PG8_MMA(0, 0, At, B0); PG8_MMA(0, 1, At, B1); PG8_BAR; PG8_SCHED;
            PG8_LDA(At, 0, 1); PG8_STAGE(PG8_SB(0, 0), b2, voffB); PG8_STAGE(PG8_SB(0, 1), b2 + hB, voffB); PG8_STAGE(PG8_SA(0, 0), a2, voffA);
            PG8_WAIT_V(8); PG8_WAIT_L(0); PG8_BAR; PG8_MMA(1, 0, At, B0); PG8_MMA(1, 1, At, B1); PG8_BAR; PG8_SCHED;
            PG8_LDB(B0, 1, 0); PG8_LDB(B1, 1, 1); PG8_SCHED; PG8_LDA(At, 1, 0); PG8_STAGE(PG8_SA(0, 1), a2 + hA, voffA);
            PG8_WAIT_V(8); PG8_WAIT_L(0); PG8_BAR; PG8_MMA(0, 0, At, B0); PG8_MMA(0, 1, At, B1); PG8_BAR; PG8_SCHED;
            PG8_LDA(At, 1, 1); PG8_STAGE(PG8_SB(1, 0), b3, voffB); PG8_STAGE(PG8_SB(1, 1), b3 + hB, voffB); PG8_STAGE(PG8_SA(1, 0), a3, voffA);
            PG8_WAIT_V(8); PG8_WAIT_L(0); PG8_BAR; PG8_MMA(1, 0, At, B0); PG8_MMA(1, 1, At, B1); PG8_BAR; PG8_SCHED;
            } else {
            PG8_LDB(B0, 0, 0); PG8_SCHED; PG8_LDA(At, 0, 0); PG8_STAGE(PG8_SA(1, 1), a1 + hA, voffA);
            PG8_WAIT_L(8); PG8_BAR; PG8_WAIT_L(0); PG8_MMA(0, 0, At, B0); PG8_BAR; PG8_SCHED;
            PG8_LDB(B1, 0, 1); PG8_STAGE(PG8_SB(0, 0), b2, voffB);
            PG8_BAR; PG8_WAIT_L(0); PG8_MMA(0, 1, At, B1); PG8_BAR;
            PG8_LDA(At, 0, 1); PG8_STAGE(PG8_SA(0, 0), a2, voffA);
            PG8_BAR; PG8_WAIT_L(0); PG8_MMA(1, 0, At, B0); PG8_BAR; PG8_SCHED;
            PG8_STAGE(PG8_SB(0, 1), b2 + hB, voffB);
            PG8_WAIT_V(6); PG8_BAR; PG8_MMA(1, 1, At, B1); PG8_BAR;
            PG8_LDB(B0, 1, 0); PG8_SCHED; PG8_LDA(At, 1, 0); PG8_STAGE(PG8_SA(0, 1), a2 + hA, voffA);
            PG8_WAIT_L(8); PG8_BAR; PG8_WAIT_L(0); PG8_MMA(0, 0, At, B0); PG8_BAR; PG8_SCHED;
            PG8_LDB(B1, 1, 1); PG8_STAGE(PG8_SB(1, 0), b3, voffB);
            PG8_BAR; PG8_WAIT_L(0); PG8_MMA(0, 1, At, B1); PG8_BAR;
            PG8_LDA(At, 1, 1); PG8_STAGE(PG8_SA(1, 0), a3, voffA);
            PG8_BAR; PG8_WAIT_L(0); PG8_MMA(1, 0, At, B0); PG8_BAR; PG8_SCHED;
            PG8_STAGE(PG8_SB(1, 1), b3 + hB, voffB);
            PG8_WAIT_V(6); PG8_BAR; PG8_MMA(1, 1, At, B1); PG8_BAR;
            }
        }
        if constexpr (ALIGN_EPI) { if (wr == 0) PG8_BAR; }
        if constexpr (FP8) asm volatile("s_nop 15\n\ts_nop 15\n\ts_nop 15" ::: "memory");
        E(acc, cur, wr, wc, fr, fq);
        if (!has_next) break;
        if (!(Epi::KEEP && cur.aux != 2)) {
#pragma unroll
        for (int a = 0; a < 2; ++a)
#pragma unroll
            for (int b = 0; b < 2; ++b)
#pragma unroll
                for (int m = 0; m < 4; ++m)
#pragma unroll
                    for (int n = 0; n < 2; ++n) acc[a][b][m][n] = (f32x4){0.f, 0.f, 0.f, 0.f};
        }
        cur = nxt; cA = nA; cB = nB; ++ui;
        if constexpr (ALIGN_EPI) { if (wr == 1) PG8_BAR; }
    }
    PG8_WAIT_V(0);
    if constexpr (!ALIGN_EPI) { if (wr == 0) PG8_BAR; }
    PG8_BAR;
#undef PG8_SA
#undef PG8_SB
#undef PG8_STAGE
#undef PG8_LDA
#undef PG8_LDB
#undef PG8_MMA
#undef PG8_WAIT_V
#undef PG8_WAIT_L
#undef PG8_BAR
#undef PG8_SCHED
}

template <class Epi, class Sched, bool FP8 = false>
__device__ __forceinline__ void gemm_phase_gather(PG8_LAS unsigned char* lds, const char* Abase, const int lda, const int ldb, const Sched& S, const Epi& E, const int sclW = 0x7f7f7f7f, const int sclX = 0x7f7f7f7f) {
    constexpr int EB = FP8 ? 1 : 2;
    const int tid = opaque_tid(), wid = __builtin_amdgcn_readfirstlane(tid >> 6), lane = tid & 63, wr = wid >> 2, wc = wid & 3, fr = lane & 15, fq = lane >> 4;
    unsigned voffB[2]; int Rr[2]; unsigned Cc[2];
#pragma unroll
    for (int i = 0; i < 2; ++i) { int R, C; stage_rc(tid * 16 + i * 8192, R, C); const int Rb = Epi::PERM ? ((R & ~31) + perm32(R & 31)) : R;
        Rr[i] = R; Cc[i] = (unsigned)C * 2u; voffB[i] = (unsigned)(Rb * ldb * EB + C * 2); }
    const size_t kstep = (size_t)(BK * 2);
    const size_t hB = (size_t)HALF * ldb * EB;
    const unsigned ldsw = (unsigned)wid * 1024u;
    const int fcol = FP8 ? (32 * (fq >> 1) + 16 * (fq & 1)) : fq * 8;
    const int aoff = lds_byte(wr * 64 + fr, fcol), boff = lds_byte(wc * 32 + fr, fcol);
#define PG8_SA(b, h) (((b) * 2 + (h)) * HTB)
#define PG8_SB(b, h) ((4 + (b) * 2 + (h)) * HTB)
#define PG8_STAGE(bufoff, gbase, voff) do { _Pragma("unroll") for (int _i = 0; _i < 2; ++_i) \
        __builtin_amdgcn_global_load_lds((const unsigned*)((const char*)(gbase) + (voff)[_i]), (PG8_LAS unsigned*)(lds + (bufoff) + ldsw + _i * 8192), 16, 0, 0); } while (0)
#define PG8_LDA(dst, b, h) do { if constexpr (FP8) { _Pragma("unroll") for (int m = 0; m < 4; ++m) dst##8[m] = cat8(*(const PG8_LAS bf16x8*)(lds + PG8_SA(b, h) + aoff + m * 2048), *(const PG8_LAS bf16x8*)(lds + PG8_SA(b, h) + aoff + m * 2048 + 16)); } else { \
        _Pragma("unroll") for (int m = 0; m < 4; ++m) _Pragma("unroll") for (int k = 0; k < 2; ++k) dst[m][k] = *(const PG8_LAS bf16x8*)(lds + PG8_SA(b, h) + aoff + m * 2048 + k * 1024); } } while (0)
#define PG8_LDB(dst, b, h) do { if constexpr (FP8) { _Pragma("unroll") for (int n = 0; n < 2; ++n) dst##8[n] = cat8(*(const PG8_LAS bf16x8*)(lds + PG8_SB(b, h) + boff + n * 2048), *(const PG8_LAS bf16x8*)(lds + PG8_SB(b, h) + boff + n * 2048 + 16)); } else { \
        _Pragma("unroll") for (int n = 0; n < 2; ++n) _Pragma("unroll") for (int k = 0; k < 2; ++k) dst[n][k] = *(const PG8_LAS bf16x8*)(lds + PG8_SB(b, h) + boff + n * 2048 + k * 1024); } } while (0)
#define PG8_MMA(ai, bj, At, Bt) do { __builtin_amdgcn_s_setprio(1); if constexpr (FP8) { _Pragma("unroll") for (int m = 0; m < 4; ++m) _Pragma("unroll") for (int n = 0; n < 2; ++n) \
        asm volatile("v_mfma_f32_16x16x128_f8f6f4 %0, %1, %2, %0" : "+v"(acc[ai][bj][m][n]) : "v"(Bt##8[n]), "v"(At##8[m])); } else { \
        _Pragma("unroll") for (int m = 0; m < 4; ++m) _Pragma("unroll") for (int n = 0; n < 2; ++n) _Pragma("unroll") for (int k = 0; k < 2; ++k) \
        acc[ai][bj][m][n] = __builtin_amdgcn_mfma_f32_16x16x32_bf16(Bt[n][k], At[m][k], acc[ai][bj][m][n], 0, 0, 0); } __builtin_amdgcn_s_setprio(0); } while (0)
#define PG8_WAIT_V(n) asm volatile("s_waitcnt vmcnt(" #n ")" ::: "memory")
#define PG8_WAIT_L(n) asm volatile("s_waitcnt lgkmcnt(" #n ")" ::: "memory")
#define PG8_BAR __builtin_amdgcn_s_barrier()
#define PG8_SCHED __builtin_amdgcn_sched_barrier(0)
#define PG8_ROWOFF(u, vo) do { _Pragma("unroll") for (int _h = 0; _h < 2; ++_h) _Pragma("unroll") for (int _i = 0; _i < 2; ++_i) \
        (vo)[_h][_i] = (unsigned)S.rowtok((u), 128 * _h + Rr[_i]) * (unsigned)(lda * EB) + Cc[_i]; } while (0)
    Unit cur, nxt, nn; int ui = 0;
    if (!S.next(0, cur)) return;
    bool has_next = S.next(1, nxt);
    unsigned cv[2][2], nv[2][2], tv[2][2];
    PG8_ROWOFF(cur, cv);
    if (has_next) PG8_ROWOFF(nxt, nv); else { _Pragma("unroll") for (int h = 0; h < 2; ++h) _Pragma("unroll") for (int i = 0; i < 2; ++i) nv[h][i] = cv[h][i]; }
    f32x4 acc[2][2][4][2];
#pragma unroll
    for (int a = 0; a < 2; ++a)
#pragma unroll
        for (int b = 0; b < 2; ++b)
#pragma unroll
            for (int m = 0; m < 4; ++m)
#pragma unroll
                for (int n = 0; n < 2; ++n) acc[a][b][m][n] = (f32x4){0.f, 0.f, 0.f, 0.f};
    bf16x8 At[4][2], B0[2][2], B1[2][2]; v8i32 At8[4], B08[2], B18[2];
    const char* cB = cur.B;
    PG8_STAGE(PG8_SB(0, 0), cB, voffB); PG8_STAGE(PG8_SB(0, 1), cB + hB, voffB); PG8_STAGE(PG8_SA(0, 0), Abase, cv[0]); PG8_STAGE(PG8_SA(0, 1), Abase, cv[1]);
    if (wr == 1) PG8_BAR;
    PG8_WAIT_V(2); PG8_BAR;
    PG8_STAGE(PG8_SB(1, 0), cB + kstep, voffB); PG8_STAGE(PG8_SA(1, 0), Abase + kstep, cv[0]); PG8_STAGE(PG8_SB(1, 1), cB + hB + kstep, voffB);
    PG8_WAIT_V(6); PG8_BAR;
    for (;;) {
        const char* nB = has_next ? nxt.B : cB;
        const int nt = cur.nt;
        for (int t = 0; t < nt; t += 2) {
            const bool last = (t == nt - 2);
            const char* a1 = Abase + (size_t)(t + 1) * kstep;
            const char* a2 = last ? Abase : Abase + (size_t)(t + 2) * kstep; const char* b2 = last ? nB : cB + (size_t)(t + 2) * kstep;
            const char* a3 = a2 + kstep; const char* b3 = b2 + kstep;
            unsigned s0[2], s1[2];
#pragma unroll
            for (int i = 0; i < 2; ++i) { s0[i] = last ? nv[0][i] : cv[0][i]; s1[i] = last ? nv[1][i] : cv[1][i]; }
            PG8_LDB(B0, 0, 0); PG8_LDB(B1, 0, 1); PG8_SCHED; PG8_LDA(At, 0, 0); PG8_STAGE(PG8_SA(1, 1), a1, cv[1]);
            PG8_WAIT_V(8); PG8_WAIT_L(0); PG8_BAR; PG8_MMA(0, 0, At, B0); PG8_MMA(0, 1, At, B1); PG8_BAR; PG8_SCHED;
            PG8_LDA(At, 0, 1); PG8_STAGE(PG8_SB(0, 0), b2, voffB); PG8_STAGE(PG8_SB(0, 1), b2 + hB, voffB); PG8_STAGE(PG8_SA(0, 0), a2, s0);
            PG8_WAIT_V(8); PG8_WAIT_L(0); PG8_BAR; PG8_MMA(1, 0, At, B0); PG8_MMA(1, 1, At, B1); PG8_BAR; PG8_SCHED;
            PG8_LDB(B0, 1, 0); PG8_LDB(B1, 1, 1); PG8_SCHED; PG8_LDA(At, 1, 0); PG8_STAGE(PG8_SA(0, 1), a2, s1);
            PG8_WAIT_V(8); PG8_WAIT_L(0); PG8_BAR; PG8_MMA(0, 0, At, B0); PG8_MMA(0, 1, At, B1); PG8_BAR; PG8_SCHED;
            PG8_LDA(At, 1, 1); PG8_STAGE(PG8_SB(1, 0), b3, voffB); PG8_STAGE(PG8_SB(1, 1), b3 + hB, voffB); PG8_STAGE(PG8_SA(1, 0), a3, s0);
            PG8_WAIT_V(8); PG8_WAIT_L(0); PG8_BAR; PG8_MMA(1, 0, At, B0); PG8_MMA(1, 1, At, B1); PG8_BAR; PG8_SCHED;
        }
        if (wr == 0) PG8_BAR;
        if constexpr (FP8) asm volatile("s_nop 15\n\ts_nop 15\n\ts_nop 15" ::: "memory");
        const bool has_nn = has_next && S.next(ui + 2, nn);
        if (has_nn) PG8_ROWOFF(nn, tv);
        E(acc, cur, wr, wc, fr, fq);
        if (!has_next) break;
#pragma unroll
        for (int a = 0; a < 2; ++a)
#pragma unroll
            for (int b = 0; b < 2; ++b)
#pragma unroll
                for (int m = 0; m < 4; ++m)
#pragma unroll
                    for (int n = 0; n < 2; ++n) acc[a][b][m][n] = (f32x4){0.f, 0.f, 0.f, 0.f};
        cur = nxt; cB = nB; ++ui;
#pragma unroll
        for (int h = 0; h < 2; ++h)
#pragma unroll
            for (int i = 0; i < 2; ++i) { cv[h][i] = nv[h][i]; if (has_nn) nv[h][i] = tv[h][i]; }
        asm volatile("" : "+v"(nv[0][0]), "+v"(nv[0][1]), "+v"(nv[1][0]), "+v"(nv[1][1]));
        nxt = nn; has_next = has_nn;
        if (wr == 1) PG8_BAR;
    }
    PG8_WAIT_V(0);
    PG8_BAR;
#undef PG8_SA
#undef PG8_SB
#undef PG8_STAGE
#undef PG8_LDA
#undef PG8_LDB
#undef PG8_MMA
#undef PG8_WAIT_V
#undef PG8_WAIT_L
#undef PG8_BAR
#undef PG8_SCHED
#undef PG8_ROWOFF
}

struct DenseOrder {
    const char* A; const char* B; size_t a_tile, b_tile; int nt, nM, nN, G, c; int pn_off = 0;
    __device__ __forceinline__ bool next(int i, Unit& u) const {
        const long L = (long)i * G + c; if (L >= (long)nM * nN) return false;
        int pm, pn; tile_of((int)L, nM, nN, pm, pn);
        u.pm = pm; u.pn = pn + pn_off; u.aux = 0; u.nt = nt; u.A = A + (size_t)pm * a_tile; u.B = B + (size_t)pn * b_tile; return true;
    }
};
struct ProjOrder {
    const char* Y; const char* W; int nM, nN, G, c;
    __device__ __forceinline__ bool next(int i, Unit& u) const {
        const int ti = i / 3, br = i - 3 * ti;
        const long L = (long)ti * G + c; if (L >= (long)nM * nN) return false;
        int pm, pn; tile_of((int)L, nM, nN, pm, pn);
        u.pm = pm; u.pn = pn; u.aux = br; u.nt = (br == 2) ? 6 : 4;
        const int acol = (br == 0) ? 0 : (br == 1 ? 256 : 384), bcol = (br == 0) ? 0 : (br == 1 ? 256 : 512);
        u.A = Y + ((size_t)pm * 256 * YLD + acol) * 2; u.B = W + ((size_t)pn * 256 * WPK + bcol) * 2; return true;
    }
};
struct MoeOrder {
    const char* A; const char* W; size_t estride, atile, btile; int nt; const LAS int* tile_e; const LAS int* offT; const LAS int* cnt; const int* SRC; int T, nN, G, c;
    __device__ __forceinline__ bool next(int i, Unit& u) const {
        const long L = (long)i * G + c; if (L >= (long)T * nN) return false;
        int pm, pn; tile_of((int)L, T, nN, pm, pn);
        const int e = __builtin_amdgcn_readfirstlane(tile_e[pm]);
        u.pm = pm; u.pn = pn; u.aux = e; u.nt = nt; u.A = A + (size_t)pm * atile; u.B = W + (size_t)e * estride + (size_t)pn * btile; return true;
    }
    __device__ __forceinline__ int rowtok(const Unit& u, int r) const {
        const int e = u.aux, rank = (u.pm - offT[e]) * 256 + r, last = cnt[e] - 1;
        return SRC[e * NTOK + (rank < last ? rank : last)];
    }
};

struct EpiInProj {
    static constexpr bool PERM = true, KEEP = false;
    bf16_t* H; const float* bg; const f32x2* r64; const f32x2* r48; float gscale; unsigned char* G8;
    __device__ __forceinline__ void operator()(f32x4 (&acc)[2][2][4][2], const Unit& u, int wr, int wc, int fr, int fq) const {
        const int row0 = u.pm * BM + wr * 64 + fr, pn = u.pn, t0 = wc * 32 + 8 * fq;
        const float gs = gscale; unsigned char* const g8 = G8;
        if (pn >= 3 && pn < 9) {
            int dst, hstep, tw, dd0; const f32x2* tab;
            if (pn < 6) { dst = 768 + (4 * (pn - 3) + wc) * 64 + 8 * fq; hstep = 32; tw = 32; dd0 = 8 * fq; tab = r64; }
            else { const int p0 = 128 * (pn - 6) + t0, slot = p0 / 24; dd0 = p0 - slot * 24; dst = 1920 + slot * 48 + dd0; hstep = 24; tw = 24; tab = r48; }
#pragma unroll
            for (int ai = 0; ai < 2; ++ai)
#pragma unroll
                for (int m = 0; m < 4; ++m) { const int row = row0 + ai * HALF + m * 16; const f32x2* tp = tab + (size_t)(row & (SEQ - 1)) * tw + dd0;
                    f32x4 y1[2], y2[2];
#pragma unroll
                    for (int n = 0; n < 2; ++n) { const f32x4 cs0 = *(const f32x4*)(tp + 4 * n), cs1 = *(const f32x4*)(tp + 4 * n + 2);
                        const f32x4 x1 = acc[ai][0][m][n], x2 = acc[ai][1][m][n];
                        y1[n][0] = x1[0] * cs0[0] - x2[0] * cs0[1]; y2[n][0] = x2[0] * cs0[0] + x1[0] * cs0[1];
                        y1[n][1] = x1[1] * cs0[2] - x2[1] * cs0[3]; y2[n][1] = x2[1] * cs0[2] + x1[1] * cs0[3];
                        y1[n][2] = x1[2] * cs1[0] - x2[2] * cs1[1]; y2[n][2] = x2[2] * cs1[0] + x1[2] * cs1[1];
                        y1[n][3] = x1[3] * cs1[2] - x2[3] * cs1[3]; y2[n][3] = x2[3] * cs1[2] + x1[3] * cs1[3]; }
                    bf16_t* rowp = H + (size_t)row * INC + dst;
                    u32x4 w; w.x = cvt_pk_bf16(y1[0][0], y1[0][1]); w.y = cvt_pk_bf16(y1[0][2], y1[0][3]); w.z = cvt_pk_bf16(y1[1][0], y1[1][1]); w.w = cvt_pk_bf16(y1[1][2], y1[1][3]);
                    *(u32x4*)rowp = w;
                    w.x = cvt_pk_bf16(y2[0][0], y2[0][1]); w.y = cvt_pk_bf16(y2[0][2], y2[0][3]); w.z = cvt_pk_bf16(y2[1][0], y2[1][1]); w.w = cvt_pk_bf16(y2[1][2], y2[1][3]);
                    *(u32x4*)(rowp + hstep) = w; }
            return;
        }
        const bool gate = pn >= 12;
        int dcol[2];
#pragma unroll
        for (int bj = 0; bj < 2; ++bj) { const int x = pn * BM + bj * HALF + t0;
            if (pn >= 9 && pn < 12) { const int xx = x - 2304; dcol[bj] = xx < 384 ? 1536 + xx : 2688 + (xx - 384); } else dcol[bj] = x; }
        f32x4 bv[2][2];
#pragma unroll
        for (int bj = 0; bj < 2; ++bj)
#pragma unroll
            for (int n = 0; n < 2; ++n) bv[bj][n] = gate ? *(const f32x4*)(bg + (dcol[bj] - C_GP) + 4 * n) : (f32x4){0.f, 0.f, 0.f, 0.f};
#pragma unroll
        for (int ai = 0; ai < 2; ++ai)
#pragma unroll
            for (int m = 0; m < 4; ++m) { bf16_t* rowp = H + (size_t)(row0 + ai * HALF + m * 16) * INC;
#pragma unroll
                for (int bj = 0; bj < 2; ++bj) { f32x4 v0 = acc[ai][bj][m][0], v1 = acc[ai][bj][m][1];
                    if (gate) {
#pragma unroll
                        for (int q = 0; q < 4; ++q) { v0[q] = v0[q] * gs + bv[bj][0][q]; v1[q] = v1[q] * gs + bv[bj][1][q]; }
                        const unsigned b0 = (unsigned)(fast_sigmoid(v0[0]) * 255.0f + 0.5f) | ((unsigned)(fast_sigmoid(v0[1]) * 255.0f + 0.5f) << 8) | ((unsigned)(fast_sigmoid(v0[2]) * 255.0f + 0.5f) << 16) | ((unsigned)(fast_sigmoid(v0[3]) * 255.0f + 0.5f) << 24);
                        const unsigned b1 = (unsigned)(fast_sigmoid(v1[0]) * 255.0f + 0.5f) | ((unsigned)(fast_sigmoid(v1[1]) * 255.0f + 0.5f) << 8) | ((unsigned)(fast_sigmoid(v1[2]) * 255.0f + 0.5f) << 16) | ((unsigned)(fast_sigmoid(v1[3]) * 255.0f + 0.5f) << 24);
                        *(v2u*)(g8 + (size_t)(row0 + ai * HALF + m * 16) * 3072 + (dcol[bj] - C_GP)) = (v2u){b0, b1};
                    } else {
                        u32x4 w; w.x = cvt_pk_bf16(v0[0], v0[1]); w.y = cvt_pk_bf16(v0[2], v0[3]); w.z = cvt_pk_bf16(v1[0], v1[1]); w.w = cvt_pk_bf16(v1[2], v1[3]);
                        *(u32x4*)(rowp + dcol[bj]) = w; } } }
    }
};
struct EpiProj {
    static constexpr bool PERM = false, KEEP = true;
    const unsigned char* G8; bf16_t* Mg;
    __device__ __forceinline__ void operator()(f32x4 (&acc)[2][2][4][2], const Unit& u, int wr, int wc, int fr, int fq) const {
        const int row0 = u.pm * BM + wr * 64 + fr, col0 = u.pn * BM + wc * 32 + 4 * fq, br = u.aux;
#pragma unroll
        for (int ai = 0; ai < 2; ++ai)
#pragma unroll
            for (int m = 0; m < 4; ++m) { const size_t row = (size_t)(row0 + ai * HALF + m * 16);
#pragma unroll
                for (int bj = 0; bj < 2; ++bj)
#pragma unroll
                    for (int n = 0; n < 2; ++n) { const int c = col0 + bj * HALF + n * 16;
                        const unsigned char* gp = G8 + row * 3072 + br * 1024 + c;
                        const unsigned gw = *(const unsigned*)gp;
                        f32x4 g = (f32x4){fmaxf((float)(gw & 255u) * (1.0f / 255.0f), 1e-6f), fmaxf((float)((gw >> 8) & 255u) * (1.0f / 255.0f), 1e-6f), fmaxf((float)((gw >> 16) & 255u) * (1.0f / 255.0f), 1e-6f), fmaxf((float)(gw >> 24) * (1.0f / 255.0f), 1e-6f)};
                        if (br < 2) { const unsigned nw = *(const unsigned*)(gp + 1024);
                            g[0] *= __builtin_amdgcn_rcpf(fmaxf((float)(nw & 255u) * (1.0f / 255.0f), 1e-6f)); g[1] *= __builtin_amdgcn_rcpf(fmaxf((float)((nw >> 8) & 255u) * (1.0f / 255.0f), 1e-6f));
                            g[2] *= __builtin_amdgcn_rcpf(fmaxf((float)((nw >> 16) & 255u) * (1.0f / 255.0f), 1e-6f)); g[3] *= __builtin_amdgcn_rcpf(fmaxf((float)(nw >> 24) * (1.0f / 255.0f), 1e-6f));
                            acc[ai][bj][m][n] = acc[ai][bj][m][n] * g; }
                        else { const f32x4 t = acc[ai][bj][m][n] * g; v2u o; o.x = cvt_pk_bf16(t[0], t[1]); o.y = cvt_pk_bf16(t[2], t[3]); *(v2u*)(Mg + row * 1024 + c) = o; } } }
    }
};
struct EpiOut {
    static constexpr bool PERM = false, KEEP = false;
    const float* X; const bf16_t* XBr; float* P;
    __device__ __forceinline__ void operator()(f32x4 (&acc)[2][2][4][2], const Unit& u, int wr, int wc, int fr, int fq) const {
        const int row0 = u.pm * BM + wr * 64 + fr, col0 = u.pn * BM + wc * 32 + 4 * fq;
        const float* const Xf = X; const bf16_t* const Xh = XBr; float* const Pp = P;
#pragma unroll
        for (int ai = 0; ai < 2; ++ai)
#pragma unroll
            for (int m = 0; m < 4; ++m) { const size_t ro = (size_t)(row0 + ai * HALF + m * 16) * 1024 + col0;
#pragma unroll
                for (int bj = 0; bj < 2; ++bj)
#pragma unroll
                    for (int n = 0; n < 2; ++n) { f32x4 xv;
                        if (Xf) xv = *(const f32x4*)(Xf + ro + bj * HALF + n * 16);
                        else { const v2u xw = *(const v2u*)(Xh + ro + bj * HALF + n * 16); xv = (f32x4){bflo(xw.x), bfhi(xw.x), bflo(xw.y), bfhi(xw.y)}; }
                        *(f32x4*)(Pp + ro + bj * HALF + n * 16) = xv * DN_ALPHA + acc[ai][bj][m][n]; } }
    }
};
struct EpiSwiglu {
    static constexpr bool PERM = true, KEEP = false;
    unsigned char* HH; const float* bgate; const float* bup; float ascale;
    __device__ __forceinline__ void operator()(f32x4 (&acc)[2][2][4][2], const Unit& u, int wr, int wc, int fr, int fq) const {
        const int row0 = u.pm * BM + wr * 64 + fr, j0 = u.pn * HALF + wc * 32 + 8 * fq, e = u.aux;
        f32x4 bg[2], bu[2];
#pragma unroll
        for (int n = 0; n < 2; ++n) { bg[n] = *(const f32x4*)(bgate + e * 1024 + j0 + 4 * n); bu[n] = *(const f32x4*)(bup + e * 1024 + j0 + 4 * n); }
#pragma unroll
        for (int ai = 0; ai < 2; ++ai)
#pragma unroll
            for (int m = 0; m < 4; ++m) { unsigned char* rowp = HH + (size_t)(row0 + ai * HALF + m * 16) * 1024 + j0;
                f32x4 o[2];
#pragma unroll
                for (int n = 0; n < 2; ++n) { f32x4 g = acc[ai][0][m][n] * ascale + bg[n], uu = acc[ai][1][m][n] * ascale + bu[n];
#pragma unroll
                    for (int q = 0; q < 4; ++q) { const float hg = fminf(g[q], 7.0f), hu = fminf(fmaxf(uu[q], -7.0f), 7.0f);
                        o[n][q] = hg * fast_sigmoid(1.702f * hg) * (hu + 1.0f); } }
                v2u w; w.x = pk4_fp8(o[0][0], o[0][1], o[0][2], o[0][3], 4.0f); w.y = pk4_fp8(o[1][0], o[1][1], o[1][2], o[1][3], 4.0f);
                *(v2u*)rowp = w; }
    }
};
struct EpiDown {
    static constexpr bool PERM = true, KEEP = false;
    bf16_t* YS; const float* bd; float ascale;
    __device__ __forceinline__ void operator()(f32x4 (&acc)[2][2][4][2], const Unit& u, int wr, int wc, int fr, int fq) const {
        const int row0 = u.pm * BM + wr * 64 + fr, col0 = u.pn * BM + wc * 32 + 8 * fq, e = u.aux;
        f32x4 bv[2][2];
#pragma unroll
        for (int bj = 0; bj < 2; ++bj)
#pragma unroll
            for (int n = 0; n < 2; ++n) bv[bj][n] = *(const f32x4*)(bd + e * 1024 + col0 + bj * HALF + 4 * n);
#pragma unroll
        for (int ai = 0; ai < 2; ++ai)
#pragma unroll
            for (int m = 0; m < 4; ++m) { bf16_t* rowp = YS + (size_t)(row0 + ai * HALF + m * 16) * 1024 + col0;
#pragma unroll
                for (int bj = 0; bj < 2; ++bj) { const f32x4 v0 = acc[ai][bj][m][0] * ascale + bv[bj][0], v1 = acc[ai][bj][m][1] * ascale + bv[bj][1];
                    u32x4 w; w.x = cvt_pk_bf16(v0[0], v0[1]); w.y = cvt_pk_bf16(v0[2], v0[3]); w.z = cvt_pk_bf16(v1[0], v1[1]); w.w = cvt_pk_bf16(v1[2], v1[3]);
                    *(u32x4*)(rowp + bj * HALF) = w; } }
    }
};
}

#define XB_TMO      128
#define XB_XCNT(j)  (256  + 64 * (j))
#define XB_XSUB(j)  (1280 + 64 * (j))
#define XB_XGEN(j)  (2304 + 64 * (j))
#define XB_TOP      3328
#define XB_TOPGEN   3392
#define XCD_BAR_WORDS 3456
#define XB_SPIN_CAP (1u << 18)

__device__ __forceinline__ unsigned xb_ld(unsigned* p)              { return __hip_atomic_load(p, __ATOMIC_RELAXED, __HIP_MEMORY_SCOPE_AGENT); }
__device__ __forceinline__ unsigned xb_add(unsigned* p, unsigned v) { return __hip_atomic_fetch_add(p, v, __ATOMIC_RELAXED, __HIP_MEMORY_SCOPE_AGENT); }
__device__ __forceinline__ unsigned xb_xcc_id() { return (unsigned)__builtin_amdgcn_s_getreg((3 << 11) | 20) & 0xFu; }
#define XB_SPIN(cond, bar) do { unsigned _sp = 0; while (cond) { __builtin_amdgcn_s_sleep(1); \
    if ((++_sp & 255u) == 0u) { if (xb_ld(&(bar)[XB_TMO])) break; if (_sp > XB_SPIN_CAP) { atomicAdd(&(bar)[XB_TMO], 1u); break; } } } } while (0)

struct XcdBarrier { unsigned* bar; unsigned x; volatile LAS unsigned* st; };

__device__ __forceinline__ XcdBarrier xcd_barrier_post(unsigned* bar, volatile LAS unsigned* st) {
    XcdBarrier b; b.bar = bar; b.x = xb_xcc_id(); b.st = st;
    if (threadIdx.x == 0) (void)xb_add(&bar[XB_XCNT(b.x)], 1u);
    return b;
}
__device__ __forceinline__ void xcd_barrier_complete(unsigned* bar, unsigned x, unsigned& nloc, unsigned& nx) {
    const unsigned G = gridDim.x * gridDim.y * gridDim.z;
    unsigned sum, cnt, mine, sp = 0u;
    for (;;) {
        sum = 0u; cnt = 0u; mine = 0u;
#pragma unroll
        for (unsigned j = 0; j < 16; ++j) { const unsigned c = xb_ld(&bar[XB_XCNT(j)]); sum += c; cnt += (c > 0u) ? 1u : 0u; mine = (j == x) ? c : mine; }
        if (sum == G) break;
        __builtin_amdgcn_s_sleep(1);
        if ((++sp & 255u) == 0u) { if (xb_ld(&bar[XB_TMO])) break; if (sp > XB_SPIN_CAP) { atomicAdd(&bar[XB_TMO], 1u); break; } }
    }
    nloc = mine > 0u ? mine : 1u; nx = cnt > 0u ? cnt : 1u;
}
__device__ __forceinline__ void xcd_barrier(const XcdBarrier& b) {
    asm volatile("s_waitcnt vmcnt(0)" ::: "memory");
    __syncthreads();
    if (threadIdx.x == 0) {
        unsigned* bar = b.bar;
        __builtin_amdgcn_s_waitcnt(0);
        unsigned nloc = b.st[0], nx = b.st[1];
        if (nloc == 0u) { xcd_barrier_complete(bar, b.x, nloc, nx); b.st[0] = nloc; b.st[1] = nx; }
        const unsigned old = xb_add(&bar[XB_XSUB(b.x)], 1u);
        const unsigned gen = old / nloc;
        if (old + 1u == (gen + 1u) * nloc) {
            __builtin_amdgcn_fence(__ATOMIC_RELEASE, "agent");
            asm volatile("s_waitcnt vmcnt(0)" ::: "memory");
            const unsigned og = xb_add(&bar[XB_TOP], 1u);
            const unsigned tg = og / nx;
            if (og + 1u == (tg + 1u) * nx) xb_add(&bar[XB_TOPGEN], 1u);
            else XB_SPIN(xb_ld(&bar[XB_TOPGEN]) == tg, bar);
            __builtin_amdgcn_fence(__ATOMIC_ACQUIRE, "agent");
            xb_add(&bar[XB_XGEN(b.x)], 1u);
            asm volatile("s_waitcnt vmcnt(0)" ::: "memory");
        } else {
            XB_SPIN(xb_ld(&bar[XB_XGEN(b.x)]) == gen, bar);
            __builtin_amdgcn_fence(__ATOMIC_ACQUIRE, "agent");
            asm volatile("s_waitcnt vmcnt(0)" ::: "memory");
        }
    }
    __syncthreads();
}

struct Frame {
    LAS unsigned char* lds;
    unsigned* ctl;
    unsigned char* ws;
    int tid, lane, wave, G, bid;
};

__host__ __device__ __forceinline__ int inproj_phys(int nl) {
    if (nl < 768) return nl;
    if (nl < 1536) { const int x = nl - 768, slot = x >> 6, d = x & 63; return 768 + (slot >> 2) * 256 + (d >> 5) * 128 + (slot & 3) * 32 + (d & 31); }
    if (nl < 1920) return 2304 + (nl - 1536);
    if (nl < 2688) { const int x = nl - 1920, slot = x / 48, d = x - slot * 48, hf = d >= 24 ? 1 : 0, p = slot * 24 + d - 24 * hf; return 1536 + (p >> 7) * 256 + hf * 128 + (p & 127); }
    if (nl < 3072) return 2304 + 384 + (nl - 2688);
    return nl;
}
template <class RowMap>
__device__ __forceinline__ void transpose_item(const float* W, int N, bf16* dst, int ldd, int k0, int n0, const RowMap rowmap, LAS float* scr, int lane) {
#pragma unroll 8
    for (int i = 0; i < 32; ++i) { const int kk = 2 * i + (lane >> 5); scr[kk * 33 + (lane & 31)] = W[(size_t)(k0 + kk) * N + n0 + (lane & 31)]; }
    LDS_WAIT(); asm volatile("" ::: "memory");
    const int c = lane & 7;
#pragma unroll
    for (int j = 0; j < 4; ++j) { const int n = (lane >> 3) + 8 * j; const LAS float* sp = scr + (8 * c) * 33 + n;
        v4u o; o.x = pk2(sp[0 * 33], sp[1 * 33]); o.y = pk2(sp[2 * 33], sp[3 * 33]); o.z = pk2(sp[4 * 33], sp[5 * 33]); o.w = pk2(sp[6 * 33], sp[7 * 33]);
        *(v4u*)(dst + (size_t)rowmap(n0 + n) * ldd + k0 + 8 * c) = o; }
    LDS_WAIT(); asm volatile("" ::: "memory");
}

template <class RowMap>
__device__ __forceinline__ void transpose_item_fp8(const float* W, int N, unsigned char* dst, int ldd, int k0, int n0, const RowMap rowmap, LAS float* scr, int lane, float qs) {
#pragma unroll 8
    for (int i = 0; i < 32; ++i) { const int kk = 2 * i + (lane >> 5); scr[kk * 33 + (lane & 31)] = W[(size_t)(k0 + kk) * N + n0 + (lane & 31)]; }
    LDS_WAIT(); asm volatile("" ::: "memory");
    const int c = lane & 7;
#pragma unroll
    for (int j = 0; j < 4; ++j) { const int n = (lane >> 3) + 8 * j; const LAS float* sp = scr + (8 * c) * 33 + n;
        v2u o; o.x = pk4_fp8(sp[0 * 33], sp[1 * 33], sp[2 * 33], sp[3 * 33], qs); o.y = pk4_fp8(sp[4 * 33], sp[5 * 33], sp[6 * 33], sp[7 * 33], qs);
        *(v2u*)(dst + (size_t)rowmap(n0 + n) * ldd + k0 + 8 * c) = o; }
    LDS_WAIT(); asm volatile("" ::: "memory");
}

struct Args { const float* in[22]; float* out; unsigned char* ws; int ph_lo, ph_hi; float lam_init[4]; };

__device__ __forceinline__ void p_prologue(Frame& F, const Args& a) {
    LAS float* scr = (LAS float*)(F.lds + F.wave * 16384);
    const int gw = F.bid * 8 + F.wave, NGW = F.G * 8;
    constexpr int PER_LAYER = 3072 + 128 + 64 + 192 + 512 + 32 * 1536;
    for (int it = gw; it < DEPTH * PER_LAYER; it += NGW) {
        const int l = it / PER_LAYER; int r = it - l * PER_LAYER;
        if (r < 3072) { const int kb = r / 192, nb = r % 192;
            if (nb < 96) transpose_item(a.in[1] + (size_t)l * 1024 * INC, INC, (bf16*)(F.ws + WS_WIN) + (size_t)l * INC * 1024, 1024, kb * 64, nb * 32, [](int n) { return inproj_phys(n); }, scr, F.lane);
            else transpose_item_fp8(a.in[1] + (size_t)l * 1024 * INC, INC, (unsigned char*)(F.ws + WS_WIN8) + (size_t)l * 3072 * 1024, 1024, kb * 64, nb * 32, [](int n) { return n - 3072; }, scr, F.lane, 32.f);
            continue; }
        r -= 3072;
        if (r < 128) { const int kb = r / 32, nb = r % 32;
            transpose_item(a.in[3] + (size_t)l * 256 * 1024, 1024, (bf16*)(F.ws + WS_WPROJ) + (size_t)l * 1024 * WPK + 0, WPK, kb * 64, nb * 32, [](int n) { return n; }, scr, F.lane); continue; }
        r -= 128;
        if (r < 64) { const int kb = r / 32, nb = r % 32;
            transpose_item(a.in[4] + (size_t)l * 128 * 1024, 1024, (bf16*)(F.ws + WS_WPROJ) + (size_t)l * 1024 * WPK + 256, WPK, kb * 64, nb * 32, [](int n) { return n; }, scr, F.lane); continue; }
        r -= 64;
        if (r < 192) { const int kb = r / 32, nb = r % 32;
            transpose_item(a.in[5] + (size_t)l * 384 * 1024, 1024, (bf16*)(F.ws + WS_WPROJ) + (size_t)l * 1024 * WPK + 512, WPK, kb * 64, nb * 32, [](int n) { return n; }, scr, F.lane); continue; }
        r -= 192;
        if (r < 512) { const int kb = r / 32, nb = r % 32;
            transpose_item(a.in[6] + (size_t)l * 1024 * 1024, 1024, (bf16*)(F.ws + WS_WOUT) + (size_t)l * 1024 * 1024, 1024, kb * 64, nb * 32, [](int n) { return n; }, scr, F.lane); continue; }
        r -= 512;
        { const int e = r / 1536, r2 = r % 1536, mtx = r2 / 512, r3 = r2 % 512, kb = r3 / 32, nb = r3 % 32;
          const size_t eoff = ((size_t)l * NEXP + e) * 1024 * 1024;
          if (mtx == 0) transpose_item_fp8(a.in[14] + eoff, 1024, (unsigned char*)(F.ws + WS_WGU) + 2 * eoff, 1024, kb * 64, nb * 32, [](int n) { return (n >> 7) * 256 + (n & 127); }, scr, F.lane, 32.f);
          else if (mtx == 1) transpose_item_fp8(a.in[16] + eoff, 1024, (unsigned char*)(F.ws + WS_WGU) + 2 * eoff, 1024, kb * 64, nb * 32, [](int n) { return (n >> 7) * 256 + 128 + (n & 127); }, scr, F.lane, 32.f);
          else transpose_item_fp8(a.in[18] + eoff, 1024, (unsigned char*)(F.ws + WS_WDN) + eoff, 1024, kb * 64, nb * 32, [](int n) { return n; }, scr, F.lane, 64.f); }
    }
    { const int gt = F.bid * 512 + F.tid, NT = F.G * 512;
      for (int i = gt; i < DEPTH * 1024 * 16; i += NT) { const int row = i >> 4, ch = i & 15;
          *(v4u*)((bf16*)(F.ws + WS_WPROJ) + (size_t)row * WPK + 384 + ch * 8) = (v4u){0u, 0u, 0u, 0u}; }
      for (int i = gt; i < SEQ * 32; i += NT) { const int pos = i >> 5, j = i & 31;
          const float inv = 1.0f / powf(10000.0f, (float)(2 * j) / 64.0f); const float ang = (float)pos * inv; float s, c; sincosf(ang, &s, &c);
          ((f32x2*)(F.ws + WS_ROPE64))[i] = (f32x2){c, s}; }
      for (int i = gt; i < SEQ * 24; i += NT) { const int pos = i / 24, j = i - pos * 24;
          const float inv = 1.0f / powf(10000.0f, (float)(2 * j) / 48.0f); const float ang = (float)pos * inv; float s, c; sincosf(ang, &s, &c);
          ((f32x2*)(F.ws + WS_ROPE48))[i] = (f32x2){c, s}; }
      for (int i = gt; i < DEPTH * 32 * 1024; i += NT) { const int l = i >> 15, e = (i >> 10) & 31, k = i & 1023;
          const float wv = a.in[12][((size_t)l * 1024 + k) * 32 + e]; const unsigned hi = f2bf(wv); const unsigned lo = f2bf(wv - __uint_as_float(hi << 16));
          bf16* wt = (bf16*)(F.ws + WS_WRT) + (size_t)l * 2 * 32 * 1024; wt[e * 1024 + k] = (bf16)hi; wt[32 * 1024 + e * 1024 + k] = (bf16)lo; }
      const f32x4* x4 = (const f32x4*)a.in[0]; v2u* xb = (v2u*)(F.ws + WS_XB);
      unsigned* xb8 = (unsigned*)(F.ws + WS_XB8);
      for (int i = gt; i < NTOK * 256; i += NT) { const f32x4 v = x4[i]; xb[i] = (v2u){pk2(v[0], v[1]), pk2(v[2], v[3])}; xb8[i] = pk4_fp8(v[0], v[1], v[2], v[3], 1.0f); }
    }
}

typedef float f32x16 __attribute__((ext_vector_type(16)));
typedef short s16x4 __attribute__((ext_vector_type(4)));
typedef float f32x2_t __attribute__((ext_vector_type(2)));
typedef __bf16 bf16x2_t __attribute__((ext_vector_type(2)));
__device__ __forceinline__ unsigned cvtpk(float lo, float hi) { const f32x2_t v = {lo, hi}; const bf16x2_t b = __builtin_convertvector(v, bf16x2_t); return __builtin_bit_cast(unsigned, b); }
__device__ __forceinline__ int kperm(int r) { return (r & ~12) | ((r & 4) << 1) | ((r & 8) >> 1); }
__device__ __forceinline__ s16x4 ds_tr16(const LAS unsigned char* p) { return __builtin_bit_cast(s16x4, __builtin_amdgcn_ds_read_tr16_b64_v4i16((LAS s16x4*)p)); }

__device__ __forceinline__ float fmax_nc(float a, float b) { return __builtin_amdgcn_fmed3f(a, b, __builtin_inff()); }
__device__ __forceinline__ void glds16(const void* gsrc, unsigned lds_dst) { unsigned keep;
    asm volatile("s_mov_b32 %0, m0\n\ts_mov_b32 m0, %2\n\ts_nop 0\n\tglobal_load_lds_dwordx4 %1, off\n\ts_mov_b32 m0, %0" : "=&s"(keep) : "v"(gsrc), "s"(lds_dst) : "memory"); }
__device__ __forceinline__ void attnC_pipe(Frame& F, const float* lamv, const float* ng, float lam_init) {
    const bf16* H = (const bf16*)(F.ws + WS_H); bf16* Y = (bf16*)(F.ws + WS_Y);
    const int lane = F.lane, w = F.wave, n = lane & 31, hh = lane >> 5;
    float l01 = 0.f, l23 = 0.f;
    if (lane < 48) { l01 = lamv[lane] * lamv[48 + lane]; l23 = lamv[96 + lane] * lamv[144 + lane]; }
    l01 = wave_sum(l01); l23 = wave_sum(l23);
    const float lam = expf(l01) - expf(l23) + lam_init;
    const float post = 1.0f - lam_init;
    constexpr int KST = 208, VST = 192, KBYTES = 64 * KST, STAGE = KBYTES + 64 * VST, NT = SEQ / 64;
    constexpr float CS = 0.14433756729740643f * 1.4426950408889634f;
    constexpr float PMAX = 256.0f;
    unsigned goff[4], loff[4];
#pragma unroll
    for (int j = 0; j < 4; ++j) { const int I = w + 8 * j;
        if (I < 13) { const int cid = I * 64 + lane, row = cid / 13; int col = cid - row * 13; if (col == 12) col = 0;
            goff[j] = (unsigned)(row * INC + C_KC + col * 8) * 2u; loff[j] = (unsigned)(I * 1024); }
        else { const int cid = (I - 13) * 64 + lane, row = cid / 12, col = cid - row * 12;
            goff[j] = (unsigned)(row * INC + C_VC + col * 8) * 2u; loff[j] = (unsigned)(KBYTES + (I - 13) * 1024); } }
    const int koff = kperm(n) * KST + hh * 16;
    const int g = lane >> 4, i16 = lane & 15;
    const int voff = KBYTES + (8 * (g >> 1) + (i16 >> 2)) * VST + (16 * (g & 1) + 4 * (i16 & 3)) * 2;
#define C_ISSUE(tt) do { const char* gb_ = gbase + (size_t)(tt) * (64 * INC * 2); const int so_ = ((tt) & 3) * STAGE; _Pragma("unroll") for (int j_ = 0; j_ < 4; ++j_) if (w + 8 * j_ < 25) \
        glds16(gb_ + goff[j_], (unsigned)__builtin_amdgcn_readfirstlane((int)(unsigned)(size_t)(F.lds + so_ + loff[j_]))); } while (0)
#define C_RDV(slotV, kbV, s2v) do { _Pragma("unroll") for (int d_ = 0; d_ < 3; ++d_) { const LAS unsigned char* vp_ = (slotV) + voff + ((kbV) * 32 + 16 * (s2v)) * VST + d_ * 64; \
            const s16x4 v0_ = ds_tr16(vp_), v1_ = ds_tr16(vp_ + 4 * VST); vf[d_] = (bf16x8){v0_[0], v0_[1], v0_[2], v0_[3], v1_[0], v1_[1], v1_[2], v1_[3]}; } } while (0)
#define C_RD(slotK, kbK, cK, slotV, kbV) do { C_RDV(slotV, kbV, 0); } while (0)
#define C_MM(dst, slotK, kbK, cK, cV, pf, slotV, kbV) do { \
        _Pragma("unroll") for (int s_ = 0; s_ < 3; ++s_) kf[s_] = *(const LAS bf16x8*)((slotK) + (kbK) * 32 * KST + koff + ((cK) * 6 + 2 * s_) * 16); \
        _Pragma("unroll") for (int d_ = 0; d_ < 3; ++d_) O[cV][d_] = __builtin_amdgcn_mfma_f32_32x32x16_bf16(vf[d_], pf[0], O[cV][d_], 0, 0, 0); \
        C_FENCE; C_RDV(slotV, kbV, 1); \
        dst = __builtin_amdgcn_mfma_f32_32x32x16_bf16(kf[0], qf[cK][0], NEGR[cK], 0, 0, 0); dst = __builtin_amdgcn_mfma_f32_32x32x16_bf16(kf[1], qf[cK][1], dst, 0, 0, 0); dst = __builtin_amdgcn_mfma_f32_32x32x16_bf16(kf[2], qf[cK][2], dst, 0, 0, 0); \
        C_FENCE; \
        _Pragma("unroll") for (int d_ = 0; d_ < 3; ++d_) O[cV][d_] = __builtin_amdgcn_mfma_f32_32x32x16_bf16(vf[d_], pf[1], O[cV][d_], 0, 0, 0); } while (0)
#define C_QK0(dst, slotbase) do { { const bf16x8 kf_ = *(const LAS bf16x8*)((slotbase) + koff); dst = __builtin_amdgcn_mfma_f32_32x32x16_bf16(kf_, qf[0][0], NEGR[0], 0, 0, 0); } \
        _Pragma("unroll") for (int s_ = 1; s_ < 3; ++s_) { const bf16x8 kf_ = *(const LAS bf16x8*)((slotbase) + koff + (2 * s_) * 16); dst = __builtin_amdgcn_mfma_f32_32x32x16_bf16(kf_, qf[0][s_], dst, 0, 0, 0); } } while (0)
#define C_SM(Sx, c, pf, slotK, kbK) do { _Pragma("unroll") for (int r_ = 0; r_ < 16; ++r_) Sx[r_] = __builtin_amdgcn_exp2f(Sx[r_]); \
        float pm_ = fmaxf(fmaxf(Sx[0], Sx[1]), Sx[2]); _Pragma("unroll") for (int r_ = 3; r_ < 15; r_ += 2) pm_ = fmaxf(fmaxf(pm_, Sx[r_]), Sx[r_ + 1]); pm_ = fmaxf(pm_, Sx[15]); \
        pm_ = fmaxf(pm_, __shfl_xor(pm_, 32)); \
        if (__any(pm_ > PMAX) || first) { \
            { const bf16x8 k0_ = *(const LAS bf16x8*)((slotK) + (kbK) * 32 * KST + koff + ((c) * 6 + 0) * 16), k1_ = *(const LAS bf16x8*)((slotK) + (kbK) * 32 * KST + koff + ((c) * 6 + 2) * 16), k2_ = *(const LAS bf16x8*)((slotK) + (kbK) * 32 * KST + koff + ((c) * 6 + 4) * 16); \
              Sx = __builtin_amdgcn_mfma_f32_32x32x16_bf16(k0_, qf[c][0], NEGR[c], 0, 0, 0); Sx = __builtin_amdgcn_mfma_f32_32x32x16_bf16(k1_, qf[c][1], Sx, 0, 0, 0); Sx = __builtin_amdgcn_mfma_f32_32x32x16_bf16(k2_, qf[c][2], Sx, 0, 0, 0); } \
            float mx_ = fmax_nc(Sx[0], Sx[1]); _Pragma("unroll") for (int r_ = 2; r_ < 16; ++r_) mx_ = fmax_nc(mx_, Sx[r_]); mx_ = fmaxf(mx_, __shfl_xor(mx_, 32)); \
            const float dl_ = (pm_ > PMAX || first) ? mx_ : 0.0f, al_ = __builtin_amdgcn_exp2f(-dl_); \
            _Pragma("unroll") for (int d_ = 0; d_ < 3; ++d_) _Pragma("unroll") for (int r_ = 0; r_ < 16; ++r_) O[c][d_][r_] *= al_; l[c] *= al_; \
            _Pragma("unroll") for (int r_ = 0; r_ < 16; ++r_) { NEGR[c][r_] -= dl_; Sx[r_] = __builtin_amdgcn_exp2f(Sx[r_] - dl_); } } \
        _Pragma("unroll") for (int r_ = 0; r_ < 16; ++r_) l[c] += Sx[r_]; \
        _Pragma("unroll") for (int s2_ = 0; s2_ < 2; ++s2_) { v4u pw_; pw_.x = cvtpk(Sx[8 * s2_ + 0], Sx[8 * s2_ + 1]); pw_.y = cvtpk(Sx[8 * s2_ + 2], Sx[8 * s2_ + 3]); \
            pw_.z = cvtpk(Sx[8 * s2_ + 4], Sx[8 * s2_ + 5]); pw_.w = cvtpk(Sx[8 * s2_ + 6], Sx[8 * s2_ + 7]); pf[s2_] = __builtin_bit_cast(bf16x8, pw_); } } while (0)
#define C_FENCE __builtin_amdgcn_sched_barrier(0)
    for (int unit = F.bid; unit < 512; unit += F.G) {
        const int b = unit >> 6, h = (unit >> 4) & 3, qb = unit & 15;
        const int tok = b * SEQ + qb * 256 + w * 32 + n;
        const char* gbase = (const char*)(H + (size_t)(b * SEQ) * INC + h * 96);
        C_ISSUE(0); C_ISSUE(1);
        bf16x8 qf[2][3];
        { const bf16* qp = H + (size_t)tok * INC + C_QC + h * 96 + 8 * hh;
#pragma unroll
          for (int c = 0; c < 2; ++c)
#pragma unroll
              for (int s = 0; s < 3; ++s) { const v4u qw = *(const v4u*)(qp + c * 48 + 16 * s);
                  v4u qs; qs.x = cvtpk(bflo(qw.x) * CS, bfhi(qw.x) * CS); qs.y = cvtpk(bflo(qw.y) * CS, bfhi(qw.y) * CS); qs.z = cvtpk(bflo(qw.z) * CS, bfhi(qw.z) * CS); qs.w = cvtpk(bflo(qw.w) * CS, bfhi(qw.w) * CS);
                  qf[c][s] = __builtin_bit_cast(bf16x8, qs); } }
        f32x16 O[2][3];
#pragma unroll
        for (int c = 0; c < 2; ++c)
#pragma unroll
            for (int d = 0; d < 3; ++d)
#pragma unroll
                for (int r = 0; r < 16; ++r) O[c][d][r] = 0.f;
        float l[2] = {0.f, 0.f};
        f32x16 NEGR[2];
#pragma unroll
        for (int c = 0; c < 2; ++c)
#pragma unroll
            for (int r = 0; r < 16; ++r) NEGR[c][r] = 0.f;
        f32x16 Sa, Sb; bf16x8 pf[2], kf[3], vf[3];
        {
            for (int t = 0; t < NT; ++t) {
                asm volatile("s_waitcnt vmcnt(0)" ::: "memory"); __builtin_amdgcn_s_barrier(); asm volatile("" ::: "memory");
                if (t + 2 < NT) C_ISSUE(t + 2);
                const LAS unsigned char* cur = F.lds + (t & 3) * STAGE;
                const LAS unsigned char* nxt = F.lds + ((t + 1 < NT ? t + 1 : t) & 3) * STAGE;
                if (t == 0) C_QK0(Sa, cur);
                { const bool first = (t == 0);
                C_RD(cur, 0, 1, cur, 0); C_FENCE; C_SM(Sa, 0, pf, cur, 0); C_FENCE; C_MM(Sb, cur, 0, 1, 0, pf, cur, 0); C_FENCE;
                C_RD(cur, 1, 0, cur, 0); C_FENCE; C_SM(Sb, 1, pf, cur, 0); C_FENCE; C_MM(Sa, cur, 1, 0, 1, pf, cur, 0); C_FENCE; }
                { const bool first = false;
                C_RD(cur, 1, 1, cur, 1); C_FENCE; C_SM(Sa, 0, pf, cur, 1); C_FENCE; C_MM(Sb, cur, 1, 1, 0, pf, cur, 1); C_FENCE;
                C_RD(nxt, 0, 0, cur, 1); C_FENCE; C_SM(Sb, 1, pf, cur, 1); C_FENCE; C_MM(Sa, nxt, 0, 0, 1, pf, cur, 1); C_FENCE; }
            }
        }
        const float l0 = l[0] + __shfl_xor(l[0], 32), l1 = l[1] + __shfl_xor(l[1], 32);
        const float i0 = 1.0f / l0, i1 = lam / l1;
        float ss = 0.f;
#pragma unroll
        for (int d = 0; d < 3; ++d)
#pragma unroll
            for (int r = 0; r < 16; ++r) { const float o = O[0][d][r] * i0 - O[1][d][r] * i1; O[0][d][r] = o; ss += o * o; }
        ss += __shfl_xor(ss, 32);
        const float rs = rsqrtf(ss * (1.0f / 96.0f) + LN_EPS) * post;
        bf16* yp = Y + (size_t)tok * YLD + Y_C + h * 96 + 4 * hh;
#pragma unroll
        for (int d = 0; d < 3; ++d)
#pragma unroll
            for (int rg = 0; rg < 4; ++rg) { const f32x4 gv = *(const f32x4*)(ng + d * 32 + 8 * rg + 4 * hh);
                v2u o; o.x = pk2(O[0][d][4 * rg + 0] * rs * gv[0], O[0][d][4 * rg + 1] * rs * gv[1]); o.y = pk2(O[0][d][4 * rg + 2] * rs * gv[2], O[0][d][4 * rg + 3] * rs * gv[3]);
                *(v2u*)(yp + d * 32 + 8 * rg) = o; }
        asm volatile("s_waitcnt vmcnt(0)" ::: "memory"); __builtin_amdgcn_s_barrier(); asm volatile("" ::: "memory");
    }
#undef C_ISSUE
#undef C_RD
#undef C_RDV
#undef C_MM
#undef C_QK0
#undef C_SM
#undef C_FENCE
}

constexpr int AB_VST = 192, AB_VREG = 32 * AB_VST;
constexpr int L_RPB = 51200;

__device__ __forceinline__ void sm_block64(f32x16& t, float& m, float& l, f32x16 (&O)[2], bf16x8 (&pf)[2]) {
    float mx = fmaxf(t[0], t[1]);
#pragma unroll
    for (int r = 2; r < 16; ++r) mx = fmaxf(mx, t[r]);
    mx = fmaxf(mx, __shfl_xor(mx, 32));
    if (__any(mx > m)) {
        const float mn = fmaxf(m, mx), alpha = __builtin_amdgcn_exp2f(m - mn);
#pragma unroll
        for (int d = 0; d < 2; ++d)
#pragma unroll
            for (int r = 0; r < 16; ++r) O[d][r] *= alpha;
        l *= alpha; m = mn;
    }
#pragma unroll
    for (int r = 0; r < 16; ++r) { t[r] = __builtin_amdgcn_exp2f(t[r] - m); l += t[r]; }
#pragma unroll
    for (int s2 = 0; s2 < 2; ++s2) { v4u pw; pw.x = cvtpk(t[8 * s2 + 0], t[8 * s2 + 1]); pw.y = cvtpk(t[8 * s2 + 2], t[8 * s2 + 3]);
        pw.z = cvtpk(t[8 * s2 + 4], t[8 * s2 + 5]); pw.w = cvtpk(t[8 * s2 + 6], t[8 * s2 + 7]); pf[s2] = __builtin_bit_cast(bf16x8, pw); }
}
template <class TokOf, class MaskT>
__device__ __forceinline__ void attn_run_blocks(const bf16* H, const int kcol, const int vcol, const int nb, const TokOf tok_of, const MaskT mask,
                                                const bf16x8 (&qf)[4], LAS unsigned char* vl, const int lane, f32x16 (&O)[2], float& m, float& l) {
    const int n = lane & 31, hh = lane >> 5, krow = kperm(n), g = lane >> 4, i16 = lane & 15;
    const int vrd = (8 * (g >> 1) + (i16 >> 2)) * AB_VST + (16 * (g & 1) + 4 * (i16 & 3)) * 2;
    bf16x8 kf[4]; v4u vc[4];
    { const bf16* kp = H + (size_t)tok_of(0, krow) * INC + kcol + 8 * hh;
#pragma unroll
      for (int s = 0; s < 4; ++s) kf[s] = *(const bf16x8*)(kp + 16 * s);
#pragma unroll
      for (int i = 0; i < 4; ++i) vc[i] = *(const v4u*)(H + (size_t)tok_of(0, (lane >> 3) + 8 * i) * INC + vcol + (lane & 7) * 8); }
#pragma unroll
    for (int i = 0; i < 4; ++i) *(LAS v4u*)(vl + ((lane >> 3) + 8 * i) * AB_VST + (lane & 7) * 16) = vc[i];
    for (int j = 0; j < nb; ++j) {
        const int jn = (j + 1 < nb) ? j + 1 : j;
        bf16x8 kn[4];
        { const bf16* kp = H + (size_t)tok_of(jn, krow) * INC + kcol + 8 * hh;
#pragma unroll
          for (int s = 0; s < 4; ++s) kn[s] = *(const bf16x8*)(kp + 16 * s);
#pragma unroll
          for (int i = 0; i < 4; ++i) vc[i] = *(const v4u*)(H + (size_t)tok_of(jn, (lane >> 3) + 8 * i) * INC + vcol + (lane & 7) * 8); }
        f32x16 S;
#pragma unroll
        for (int r = 0; r < 16; ++r) S[r] = 0.f;
#pragma unroll
        for (int s = 0; s < 4; ++s) S = __builtin_amdgcn_mfma_f32_32x32x16_bf16(kf[s], qf[s], S, 0, 0, 0);
        mask(j, S);
        bf16x8 pf[2];
        sm_block64(S, m, l, O, pf);
        LDS_WAIT();
#pragma unroll
        for (int s2 = 0; s2 < 2; ++s2)
#pragma unroll
            for (int d = 0; d < 2; ++d) { const LAS unsigned char* vp = vl + vrd + 16 * s2 * AB_VST + d * 64;
                const s16x4 v0 = ds_tr16(vp), v1 = ds_tr16(vp + 4 * AB_VST);
                const bf16x8 vf = (bf16x8){v0[0], v0[1], v0[2], v0[3], v1[0], v1[1], v1[2], v1[3]};
                O[d] = __builtin_amdgcn_mfma_f32_32x32x16_bf16(vf, pf[s2], O[d], 0, 0, 0); }
        LDS_WAIT(); asm volatile("" ::: "memory");
#pragma unroll
        for (int i = 0; i < 4; ++i) *(LAS v4u*)(vl + ((lane >> 3) + 8 * i) * AB_VST + (lane & 7) * 16) = vc[i];
#pragma unroll
        for (int s = 0; s < 4; ++s) kf[s] = kn[s];
    }
    LDS_WAIT(); asm volatile("" ::: "memory");
}
__device__ __forceinline__ void attn_store64(bf16* yrow, const f32x16 (&O)[2], float l, int hh) {
    const float lt = l + __shfl_xor(l, 32), inv = 1.0f / lt;
#pragma unroll
    for (int d = 0; d < 2; ++d)
#pragma unroll
        for (int rg = 0; rg < 4; ++rg) { v2u o; o.x = pk2(O[d][4 * rg + 0] * inv, O[d][4 * rg + 1] * inv); o.y = pk2(O[d][4 * rg + 2] * inv, O[d][4 * rg + 3] * inv);
            *(v2u*)(yrow + d * 32 + 8 * rg + 4 * hh) = o; }
}

__device__ __forceinline__ void attnA_mfma(Frame& F, const float* rpb  ) {
    const bf16* H = (const bf16*)(F.ws + WS_H); bf16* Y = (bf16*)(F.ws + WS_Y);
    LAS float* T = (LAS float*)(F.lds + L_RPB);
    for (int i = F.tid; i < 4 * 17 * 64; i += 512) { const int h = i / (17 * 64), rem = i - h * 17 * 64, ro = rem >> 6, co = rem & 63;
        const int rr = ro - 1, cc = co - 16; T[i] = (rr >= 0 && rr < 15 && cc >= 0 && cc < 31) ? rpb[(h * 15 + rr) * 31 + cc] * 1.4426950408889634f : 0.f; }
    __syncthreads();
    const int lane = F.lane, n = lane & 31, hh = lane >> 5;
    LAS unsigned char* vl = F.lds + F.wave * AB_VREG;
    const int gw = F.bid * 8 + F.wave, NGW = F.G * 8;
    for (int item = gw; item < 4096; item += NGW) {
        const int cb = item & 3, rp = (item >> 2) & 31, h = (item >> 7) & 3, b = item >> 9;
        const int r = 2 * rp + (n >> 4), c = 16 * cb + (n & 15);
        const int r0 = min(max(r - 4, 0), 56), c0 = min(max(c - 8, 0), 48);
        const int cw = min(max(16 * cb - 8, 0), 32);
        const int kr_lo = min(max(2 * rp - 4, 0), 56), kr_hi = min(max(2 * rp + 1 - 4, 0), 56) + 7;
        const int tokq = b * SEQ + r * 64 + c;
        bf16x8 qf[4];
        { const bf16* qp = H + (size_t)tokq * INC + C_QA + h * 64 + 8 * hh;
#pragma unroll
          for (int s = 0; s < 4; ++s) qf[s] = *(const bf16x8*)(qp + 16 * s); }
        f32x16 O[2];
#pragma unroll
        for (int d = 0; d < 2; ++d)
#pragma unroll
            for (int rr = 0; rr < 16; ++rr) O[d][rr] = 0.f;
        float m = -1e30f, l = 0.f;
        const int tok0 = b * SEQ + kr_lo * 64 + cw;
        auto tok_of = [=](int j, int kk) { return tok0 + j * 64 + kk; };
        const int colb = cw - c0 + 8 * hh;
        const int tb0 = (h * 17 + (kr_lo - r + 8)) * 64 + (cw - c + 31) + 8 * hh;
        const int rb = kr_lo - r0;
        auto mask = [=](int j, f32x16& S) {
            const bool rowok = (unsigned)(rb + j) < 8u; const LAS float* tp = T + tb0 + j * 64;
#pragma unroll
            for (int rr = 0; rr < 16; ++rr) { const int e = (rr & 7) + 16 * (rr >> 3);
                const bool ok = rowok && ((unsigned)(colb + e) < 16u);
                S[rr] = ok ? (S[rr] * (0.125f * 1.4426950408889634f) + tp[e]) : -INFINITY; }
        };
        attn_run_blocks(H, C_KA + h * 64, C_VA + h * 64, kr_hi - kr_lo + 1, tok_of, mask, qf, vl, lane, O, m, l);
        attn_store64(Y + (size_t)tokq * YLD + Y_A + h * 64, O, l, hh);
    }
}
__device__ __forceinline__ void attnB_mfma(Frame& F) {
    const bf16* H = (const bf16*)(F.ws + WS_H); bf16* Y = (bf16*)(F.ws + WS_Y);
    const int lane = F.lane, n = lane & 31, hh = lane >> 5;
    LAS unsigned char* vl = F.lds + F.wave * AB_VREG;
    const int gw = F.bid * 8 + F.wave, NGW = F.G * 8;
    for (int item = gw; item < 2048; item += NGW) {
        const int mblk = item & 7, r = (item >> 3) & 15, hg = (item >> 7) & 1, b = item >> 8;
        const int sq = r + 16 * (mblk * 32 + n), tokq = b * SEQ + sq;
        f32x16 O[2];
#pragma unroll
        for (int d = 0; d < 2; ++d)
#pragma unroll
            for (int rr = 0; rr < 16; ++rr) O[d][rr] = 0.f;
        float m = -1e30f, l = 0.f;
#pragma unroll 1
        for (int g = 0; g < 3; ++g) {
            const int sh = 2 * g, dil = 1 << sh, head = 2 * g + hg, L = SEQ >> sh, a = 16 >> sh, cls = r & (dil - 1);
            const int pq0 = (r >> sh) + a * (mblk * 32), pq = pq0 + a * n;
            const int pks = pq0 - 64, nb = (31 * a + 129 + 31) >> 5;
            bf16x8 qf[4];
            { const bf16* qp = H + (size_t)tokq * INC + C_QB + head * 64 + 8 * hh;
#pragma unroll
              for (int s = 0; s < 4; ++s) qf[s] = *(const bf16x8*)(qp + 16 * s); }
            const int tokb = b * SEQ + cls;
            auto tok_of = [=](int j, int kk) { const int pk = min(max(pks + 32 * j + kk, 0), L - 1); return tokb + (pk << sh); };
            const int b1 = pks - pq + 64 + 8 * hh, b2 = pks + 8 * hh;
            auto mask = [=](int j, f32x16& S) {
#pragma unroll
                for (int rr = 0; rr < 16; ++rr) { const int e = (rr & 7) + 16 * (rr >> 3) + 32 * j;
                    const bool ok = ((unsigned)(b1 + e) <= 128u) && ((unsigned)(b2 + e) < (unsigned)L);
                    S[rr] = ok ? S[rr] * (0.125f * 1.4426950408889634f) : -INFINITY; }
            };
            attn_run_blocks(H, C_KB + head * 64, C_VB + head * 64, nb, tok_of, mask, qf, vl, lane, O, m, l);
        }
        attn_store64(Y + (size_t)tokq * YLD + Y_B + hg * 64, O, l, hh);
    }
}

__device__ __forceinline__ void p_ln_router(Frame& F, const Args& a, int layer, bool dry = false) {
    const float* PRE = (const float*)(F.ws + WS_HH); float* XF = dry ? (float*)(F.ws + WS_H) : a.out; unsigned* XB8 = dry ? (unsigned*)(F.ws + WS_H + 160 * MiB) : (unsigned*)(F.ws + WS_XB8);
    const float* g1 = a.in[10] + layer * 1024; const float* b1 = a.in[11] + layer * 1024; const float* br = a.in[13] + layer * 32;
    const bf16* WT = (const bf16*)(F.ws + WS_WRT) + (size_t)layer * 2 * 32 * 1024;
    int* TOPE = (int*)(F.ws + (dry ? WS_H + 200 * MiB : WS_TOPE)); float* TOPW = (float*)(F.ws + (dry ? WS_H + 201 * MiB : WS_TOPW)); int* RANK = (int*)(F.ws + (dry ? WS_H + 202 * MiB : WS_RANK));
    const int cnt_off = dry ? CW_CUR : CW_CNT; int* SRCp = (int*)(F.ws + (dry ? WS_H + 204 * MiB : WS_SRC));
    LAS int* hist = (LAS int*)(F.lds + L_HIST); LAS int* base = (LAS int*)(F.lds + L_BASE);
    const int lane = F.lane;
    for (int chunk = F.bid; chunk < NTOK / 128; chunk += F.G) {
        if (F.tid < 32) hist[F.tid] = 0;
        __syncthreads();
        const int tok0 = chunk * 128 + F.wave * 16;
        {   f32x4 gv[4], bv[4];
#pragma unroll
            for (int j = 0; j < 4; ++j) { gv[j] = *(const f32x4*)(g1 + 4 * lane + 256 * j); bv[j] = *(const f32x4*)(b1 + 4 * lane + 256 * j); }
#pragma unroll 1
            for (int q = 0; q < 4; ++q) {
                f32x4 v[4][4]; float s[4], s2[4];
#pragma unroll
                for (int t = 0; t < 4; ++t) { const f32x4* pr = (const f32x4*)(PRE + (size_t)(tok0 + 4 * q + t) * 1024) + lane;
#pragma unroll
                    for (int j = 0; j < 4; ++j) v[t][j] = pr[64 * j]; }
#pragma unroll
                for (int t = 0; t < 4; ++t) { s[t] = 0.f;
#pragma unroll
                    for (int j = 0; j < 4; ++j) s[t] += (v[t][j][0] + v[t][j][1]) + (v[t][j][2] + v[t][j][3]); }
#pragma unroll
                for (int o = 1; o < 64; o <<= 1) {
#pragma unroll
                    for (int t = 0; t < 4; ++t) s[t] += __shfl_xor(s[t], o); }
#pragma unroll
                for (int t = 0; t < 4; ++t) { const float mean = s[t] * (1.f / 1024.f); s2[t] = 0.f;
#pragma unroll
                    for (int j = 0; j < 4; ++j) { v[t][j] = v[t][j] - mean; s2[t] += (v[t][j][0] * v[t][j][0] + v[t][j][1] * v[t][j][1]) + (v[t][j][2] * v[t][j][2] + v[t][j][3] * v[t][j][3]); } }
#pragma unroll
                for (int o = 1; o < 64; o <<= 1) {
#pragma unroll
                    for (int t = 0; t < 4; ++t) s2[t] += __shfl_xor(s2[t], o); }
#pragma unroll
                for (int t = 0; t < 4; ++t) { const float rstd = rsqrtf(s2[t] * (1.f / 1024.f) + LN_EPS);
                    f32x4* xo = (f32x4*)(XF + (size_t)(tok0 + 4 * q + t) * 1024) + lane; unsigned* xb = XB8 + (size_t)(tok0 + 4 * q + t) * 256 + lane;
#pragma unroll
                    for (int j = 0; j < 4; ++j) { const f32x4 y = v[t][j] * rstd * gv[j] + bv[j]; xo[64 * j] = y; xb[64 * j] = pk4_fp8(y[0], y[1], y[2], y[3], 1.0f); } }
            }
        }
        VM_WAIT(); asm volatile("" ::: "memory");
        const int tk = lane & 15, kq = lane >> 4;
        f32x4 acc[2] = {(f32x4){0.f, 0.f, 0.f, 0.f}, (f32x4){0.f, 0.f, 0.f, 0.f}};
        {   const float* xf = XF + (size_t)(tok0 + tk) * 1024 + 8 * kq;
            const bf16* w0 = WT + (size_t)tk * 1024 + 8 * kq;
#pragma unroll 4
            for (int st = 0; st < 32; ++st) {
                const f32x4 x0 = *(const f32x4*)(xf + 32 * st), x1 = *(const f32x4*)(xf + 32 * st + 4);
                v4u xhw; xhw.x = pk2(x0[0], x0[1]); xhw.y = pk2(x0[2], x0[3]); xhw.z = pk2(x1[0], x1[1]); xhw.w = pk2(x1[2], x1[3]);
                v4u xlw; xlw.x = pk2(x0[0] - bflo(xhw.x), x0[1] - bfhi(xhw.x)); xlw.y = pk2(x0[2] - bflo(xhw.y), x0[3] - bfhi(xhw.y));
                xlw.z = pk2(x1[0] - bflo(xhw.z), x1[1] - bfhi(xhw.z)); xlw.w = pk2(x1[2] - bflo(xhw.w), x1[3] - bfhi(xhw.w));
                const bf16x8 xh = __builtin_bit_cast(bf16x8, xhw), xl = __builtin_bit_cast(bf16x8, xlw);
#pragma unroll
                for (int mb = 0; mb < 2; ++mb) { const bf16x8 wh = *(const bf16x8*)(w0 + (size_t)mb * 16 * 1024 + 32 * st), wl = *(const bf16x8*)(w0 + (size_t)(32 + mb * 16) * 1024 + 32 * st);
                    acc[mb] = __builtin_amdgcn_mfma_f32_16x16x32_bf16(wh, xh, acc[mb], 0, 0, 0);
                    acc[mb] = __builtin_amdgcn_mfma_f32_16x16x32_bf16(wh, xl, acc[mb], 0, 0, 0);
                    acc[mb] = __builtin_amdgcn_mfma_f32_16x16x32_bf16(wl, xh, acc[mb], 0, 0, 0); }
            }
        }
        float v8[8];
#pragma unroll
        for (int mb = 0; mb < 2; ++mb)
#pragma unroll
            for (int i = 0; i < 4; ++i) v8[mb * 4 + i] = acc[mb][i] + br[16 * mb + 4 * kq + i];
        int se[4]; float sv[4];
#pragma unroll
        for (int r = 0; r < 4; ++r) {
            float bvv = v8[0]; int bi = 4 * kq;
#pragma unroll
            for (int sl = 1; sl < 8; ++sl) { const int eid = 16 * (sl >> 2) + 4 * kq + (sl & 3); if (v8[sl] > bvv) { bvv = v8[sl]; bi = eid; } }
#pragma unroll
            for (int o = 16; o < 64; o <<= 1) { const float ov = __shfl_xor(bvv, o); const int oi = __shfl_xor(bi, o);
                if (ov > bvv || (ov == bvv && oi < bi)) { bvv = ov; bi = oi; } }
            se[r] = bi; sv[r] = bvv;
#pragma unroll
            for (int sl = 0; sl < 8; ++sl) { const int eid = 16 * (sl >> 2) + 4 * kq + (sl & 3); if (eid == bi) v8[sl] = -3.0e38f; }
        }
        const float p1 = __expf(sv[1] - sv[0]), p2 = __expf(sv[2] - sv[0]), p3 = __expf(sv[3] - sv[0]);
        const float inv = 1.0f / (1.0f + p1 + p2 + p3);
        int lr[4] = {0, 0, 0, 0};
        if (lane < 16) { const int tok = tok0 + tk;
            *(int4*)(TOPE + tok * 4) = make_int4(se[0], se[1], se[2], se[3]);
            *(f32x4*)(TOPW + tok * 4) = (f32x4){inv, p1 * inv, p2 * inv, p3 * inv};
#pragma unroll
            for (int k = 0; k < 4; ++k) lr[k] = __hip_atomic_fetch_add(&hist[se[k]], 1, __ATOMIC_RELAXED, __HIP_MEMORY_SCOPE_WORKGROUP); }
        __syncthreads();
        if (F.tid < 32) { const int c = hist[F.tid]; base[F.tid] = c ? (int)__hip_atomic_fetch_add(F.ctl + cnt_off + layer * 64 + F.tid, (unsigned)c, RLX_AGENT) : 0; }
        __syncthreads();
        if (lane < 16) { const int tok = tok0 + tk;
            const int r0 = base[se[0]] + lr[0], r1 = base[se[1]] + lr[1], r2 = base[se[2]] + lr[2], r3 = base[se[3]] + lr[3];
            *(int4*)(RANK + tok * 4) = make_int4(r0, r1, r2, r3);
            int* SRC = SRCp; SRC[se[0] * NTOK + r0] = tok; SRC[se[1] * NTOK + r1] = tok; SRC[se[2] * NTOK + r2] = tok; SRC[se[3] * NTOK + r3] = tok; }
        __syncthreads();
    }
}

__device__ __forceinline__ int moe_build(Frame& F, int layer) {
    LAS int* offT = (LAS int*)(F.lds + L_OFFT); LAS int* tile_e = (LAS int*)(F.lds + L_TILE);
    __syncthreads();
    if (F.tid < 64) {
        const int c = (F.lane < 32) ? (int)__hip_atomic_load(F.ctl + CW_CNT + layer * 64 + F.lane, RLX_AGENT) : 0;
        const int ntile = (c + 255) >> 8; int x = ntile;
#pragma unroll
        for (int d = 1; d < 32; d <<= 1) { const int v = __shfl_up(x, d); if (F.lane >= d) x += v; }
        if (F.lane < 32) { offT[F.lane] = x - ntile; ((LAS int*)(F.lds + L_CNT))[F.lane] = c; }
        if (F.lane == 31) offT[32] = x;
    }
    __syncthreads();
    int T = __builtin_amdgcn_readfirstlane(offT[32]); if (T > MAXT) T = MAXT;
    for (int mt = F.tid; mt < T; mt += 512) { int e = 0;
#pragma unroll 1
        for (int j = 1; j < 32; ++j) if (offT[j] <= mt) e = j;
        tile_e[mt] = e; }
    __syncthreads();
    return T;
}

__device__ __forceinline__ void p_combine_ln(Frame& F, const Args& a, int layer, bool dry = false) {
    const bool last_layer = (layer == DEPTH - 1) || dry;
    float* XF = a.out; float* XFo = dry ? (float*)(F.ws + WS_HH) : a.out; bf16* XB = (bf16*)(F.ws + (dry ? WS_M : WS_XB)); const bf16* YS = (const bf16*)(F.ws + WS_H);
    const int* TOPE = (const int*)(F.ws + WS_TOPE); const int* RANK = (const int*)(F.ws + WS_RANK); const float* TOPW = (const float*)(F.ws + WS_TOPW);
    const LAS int* offT = (const LAS int*)(F.lds + L_OFFT);
    const float* g2 = a.in[20] + layer * 1024; const float* b2 = a.in[21] + layer * 1024;
    const int gw = F.bid * 8 + F.wave, NGW = F.G * 8, lane = F.lane;
    f32x4 gv[4], bv[4];
#pragma unroll
    for (int j = 0; j < 4; ++j) { gv[j] = *(const f32x4*)(g2 + 4 * lane + 256 * j); bv[j] = *(const f32x4*)(b2 + 4 * lane + 256 * j); }
    for (int tp = gw; tp < NTOK / 2; tp += NGW) {
        f32x4 v[2][4]; v2u yw[2][4][4]; f32x4 tw[2];
#pragma unroll
        for (int u = 0; u < 2; ++u) { const int tok = tp * 2 + u;
            const int4 te = *(const int4*)(TOPE + tok * 4), rk = *(const int4*)(RANK + tok * 4); tw[u] = *(const f32x4*)(TOPW + tok * 4);
            const f32x4* xr = (const f32x4*)(XF + (size_t)tok * 1024) + lane;
#pragma unroll
            for (int j = 0; j < 4; ++j) v[u][j] = xr[64 * j];
            const int pk[4] = {offT[te.x] * 256 + rk.x, offT[te.y] * 256 + rk.y, offT[te.z] * 256 + rk.z, offT[te.w] * 256 + rk.w};
#pragma unroll
            for (int k = 0; k < 4; ++k) { const v2u* yr = (const v2u*)(YS + (size_t)pk[k] * 1024) + lane;
#pragma unroll
                for (int j = 0; j < 4; ++j) yw[u][k][j] = yr[64 * j]; } }
        float s[2], s2[2];
#pragma unroll
        for (int u = 0; u < 2; ++u) {
#pragma unroll
            for (int j = 0; j < 4; ++j) { v[u][j] = v[u][j] * DN_ALPHA;
#pragma unroll
                for (int k = 0; k < 4; ++k) { const v2u y = yw[u][k][j]; v[u][j] = v[u][j] + tw[u][k] * (f32x4){bflo(y.x), bfhi(y.x), bflo(y.y), bfhi(y.y)}; } }
            s[u] = 0.f;
#pragma unroll
            for (int j = 0; j < 4; ++j) s[u] += (v[u][j][0] + v[u][j][1]) + (v[u][j][2] + v[u][j][3]); }
#pragma unroll
        for (int o = 1; o < 64; o <<= 1) { s[0] += __shfl_xor(s[0], o); s[1] += __shfl_xor(s[1], o); }
#pragma unroll
        for (int u = 0; u < 2; ++u) { const float mean = s[u] * (1.f / 1024.f); s2[u] = 0.f;
#pragma unroll
            for (int j = 0; j < 4; ++j) { v[u][j] = v[u][j] - mean; s2[u] += (v[u][j][0] * v[u][j][0] + v[u][j][1] * v[u][j][1]) + (v[u][j][2] * v[u][j][2] + v[u][j][3] * v[u][j][3]); } }
#pragma unroll
        for (int o = 1; o < 64; o <<= 1) { s2[0] += __shfl_xor(s2[0], o); s2[1] += __shfl_xor(s2[1], o); }
#pragma unroll
        for (int u = 0; u < 2; ++u) { const int tok = tp * 2 + u; const float rstd = rsqrtf(s2[u] * (1.f / 1024.f) + LN_EPS);
            f32x4* xo = (f32x4*)(XFo + (size_t)tok * 1024) + lane; v2u* xb = (v2u*)(XB + (size_t)tok * 1024) + lane; unsigned* x8 = (unsigned*)(F.ws + (dry ? WS_M + 32 * MiB : WS_XB8)) + (size_t)tok * 256 + lane;
#pragma unroll
            for (int j = 0; j < 4; ++j) { const f32x4 y = v[u][j] * rstd * gv[j] + bv[j]; if (last_layer) xo[64 * j] = y; xb[64 * j] = (v2u){pk2(y[0], y[1]), pk2(y[2], y[3])}; x8[64 * j] = pk4_fp8(y[0], y[1], y[2], y[3], 1.0f); } }
    }
}

__device__ __forceinline__ const Args* fresh_args() { unsigned long long p = (unsigned long long)__builtin_amdgcn_kernarg_segment_ptr(); asm volatile("" : "+s"(p)); return (const Args*)(const __attribute__((address_space(4))) void*)p; }
constexpr int PH_PER_LAYER = 10, N_PHASES = 1 + DEPTH * PH_PER_LAYER;
__global__ void __launch_bounds__(512, 2) mk_fwd(Args args) {
    extern __shared__ __attribute__((aligned(16))) unsigned char lds[];
    Frame F;
    F.lds = (LAS unsigned char*)lds; F.tid = threadIdx.x; F.lane = F.tid & 63; F.wave = __builtin_amdgcn_readfirstlane(F.tid >> 6);
    F.G = gridDim.x; F.bid = blockIdx.x; F.ws = fresh_args()->ws; F.ctl = (unsigned*)(F.ws + WS_CTL);
    for (int u = F.tid; u < (LDS_BYTES - LDSCTL_OFF) / 4; u += 512) ((LAS unsigned*)(F.lds + LDSCTL_OFF))[u] = 0u;
    __syncthreads();
    const int lo = fresh_args()->ph_lo, hi = fresh_args()->ph_hi;
    XcdBarrier bar; bar.bar = F.ctl + CW_BAR; bar.x = 0; bar.st = nullptr;
    if (hi - lo > 1) bar = xcd_barrier_post(F.ctl + CW_BAR, (volatile LAS unsigned*)(F.lds + L_MISC) + 8);
#define IN(k) (lo <= (k) && (k) < hi)
#define REFRESH() do { F.tid = opaque_tid(); F.lane = F.tid & 63; F.wave = __builtin_amdgcn_readfirstlane(F.tid >> 6); asm volatile("" : "+s"(F.bid), "+s"(F.G)); } while (0)
#define SEAM(k) do { if ((k) + 1 < hi) xcd_barrier(bar); } while (0)

#ifndef NO_P0
    if (IN(0)) { _Pragma("unroll") for (int rep = 0; rep < REP_T; ++rep) p_prologue(F, *fresh_args()); SEAM(0); }
#endif

    for (int l = 0; l < DEPTH; ++l) {
        const int pb = 1 + l * PH_PER_LAYER;
#ifndef NO_P1
        if (IN(pb + 0)) {
            REFRESH();
            {
                pg8::DenseOrder S{(const char*)(F.ws + WS_XB), (const char*)(F.ws + WS_WIN) + (size_t)l * INC * 1024 * 2, (size_t)256 * 1024 * 2, (size_t)256 * 1024 * 2, 16, NTOK / 256, 12, F.G, F.bid};
                pg8::EpiInProj E{(bf16*)(F.ws + WS_H), fresh_args()->in[2] + l * 3072, (const f32x2*)(F.ws + WS_ROPE64), (const f32x2*)(F.ws + WS_ROPE48), 1.0f, (unsigned char*)(F.ws + WS_G8)};
                _Pragma("unroll") for (int rep = 0; rep < REP_G1; ++rep) pg8::gemm_phase<pg8::EpiInProj, pg8::DenseOrder, true, true>(F.lds, 1024, 1024, S, E);
            }
            {
                REFRESH();
                pg8::DenseOrder S{(const char*)(F.ws + WS_XB8), (const char*)(F.ws + WS_WIN8) + (size_t)l * 3072 * 1024, (size_t)256 * 1024, (size_t)256 * 1024, 8, NTOK / 256, 12, F.G, F.bid, 12};
                pg8::EpiInProj E{(bf16*)(F.ws + WS_H), fresh_args()->in[2] + l * 3072, (const f32x2*)(F.ws + WS_ROPE64), (const f32x2*)(F.ws + WS_ROPE48), 1.0f / 32.0f, (unsigned char*)(F.ws + WS_G8)};
                _Pragma("unroll") for (int rep = 0; rep < REP_G1; ++rep) pg8::gemm_phase<pg8::EpiInProj, pg8::DenseOrder, true, true, true>(F.lds, 1024, 1024, S, E);
            }
            if (pb + 2 < hi) xcd_barrier(bar);
        }
#endif
#ifndef NO_P1B
#endif
        if (IN(pb + 2)) {
            REFRESH();
#ifndef NO_PC
            _Pragma("unroll") for (int rep = 0; rep < REP_C; ++rep) attnC_pipe(F, fresh_args()->in[8] + l * 4 * 48, fresh_args()->in[9] + l * 96, fresh_args()->lam_init[l]);
#endif
#ifndef NO_PA
            REFRESH();
            _Pragma("unroll") for (int rep = 0; rep < REP_AB; ++rep) attnA_mfma(F, fresh_args()->in[7] + l * 4 * 15 * 31);
#endif
#ifndef NO_PB
            REFRESH();
            _Pragma("unroll") for (int rep = 0; rep < REP_AB; ++rep) attnB_mfma(F);
#endif
            SEAM(pb + 2);
        }
#ifndef NO_P3
        if (IN(pb + 3)) {
            REFRESH();
            pg8::ProjOrder S{(const char*)(F.ws + WS_Y), (const char*)(F.ws + WS_WPROJ) + (size_t)l * 1024 * WPK * 2, NTOK / 256, 4, F.G, F.bid};
            pg8::EpiProj E{(const unsigned char*)(F.ws + WS_G8), (bf16*)(F.ws + WS_M)};
            _Pragma("unroll") for (int rep = 0; rep < REP_G3; ++rep) pg8::gemm_phase<pg8::EpiProj, pg8::ProjOrder, true, true>(F.lds, YLD, WPK, S, E);
            SEAM(pb + 3);
        }
#endif
#ifndef NO_P4
        if (IN(pb + 4)) {
            REFRESH();
            pg8::DenseOrder S{(const char*)(F.ws + WS_M), (const char*)(F.ws + WS_WOUT) + (size_t)l * 1024 * 1024 * 2, (size_t)256 * 1024 * 2, (size_t)256 * 1024 * 2, 16, NTOK / 256, 4, F.G, F.bid};
            pg8::EpiOut E{l == 0 ? fresh_args()->in[0] : (const float*)nullptr, (const bf16*)(F.ws + WS_XB), (float*)(F.ws + WS_HH)};
            _Pragma("unroll") for (int rep = 0; rep < REP_G4; ++rep) pg8::gemm_phase<pg8::EpiOut, pg8::DenseOrder, true, true>(F.lds, 1024, 1024, S, E);
            SEAM(pb + 4);
        }
#endif
#ifndef NO_P5
        if (IN(pb + 5)) { REFRESH(); if (DRY_P5) p_ln_router(F, *fresh_args(), l, true); p_ln_router(F, *fresh_args(), l); if (pb + 7 < hi) xcd_barrier(bar); }
#endif
#ifndef NO_P5B
#endif
#ifndef NO_P6
        if (IN(pb + 7)) {
            REFRESH(); const int T = moe_build(F, l);
            pg8::MoeOrder S{(const char*)(F.ws + WS_XB8), (const char*)(F.ws + WS_WGU) + (size_t)l * NEXP * 2048 * 1024, (size_t)2048 * 1024, (size_t)256 * 1024, (size_t)256 * 1024, 8,
                            (const LAS int*)(F.lds + L_TILE), (const LAS int*)(F.lds + L_OFFT), (const LAS int*)(F.lds + L_CNT), (const int*)(F.ws + WS_SRC), T, 8, F.G, F.bid};
            pg8::EpiSwiglu E{(unsigned char*)(F.ws + WS_HH), fresh_args()->in[15] + (size_t)l * NEXP * 1024, fresh_args()->in[17] + (size_t)l * NEXP * 1024, 1.0f / 32.0f};
            _Pragma("unroll") for (int rep = 0; rep < REP_G6; ++rep) pg8::gemm_phase_gather<pg8::EpiSwiglu, pg8::MoeOrder, true>(F.lds, (const char*)(F.ws + WS_XB8), 1024, 1024, S, E);
            SEAM(pb + 7);
        }
#endif
#ifndef NO_P7
        if (IN(pb + 8)) {
            REFRESH(); const int T = moe_build(F, l);
            pg8::MoeOrder S{(const char*)(F.ws + WS_HH), (const char*)(F.ws + WS_WDN) + (size_t)l * NEXP * 1024 * 1024, (size_t)1024 * 1024, (size_t)256 * 1024, (size_t)256 * 1024, 8,
                            (const LAS int*)(F.lds + L_TILE), (const LAS int*)(F.lds + L_OFFT), (const LAS int*)(F.lds + L_CNT), (const int*)(F.ws + WS_SRC), T, 4, F.G, F.bid};
            pg8::EpiDown E{(bf16*)(F.ws + WS_H), fresh_args()->in[19] + (size_t)l * NEXP * 1024, 1.0f / 256.0f};
            _Pragma("unroll") for (int rep = 0; rep < REP_G7; ++rep) pg8::gemm_phase<pg8::EpiDown, pg8::MoeOrder, true, true, true>(F.lds, 1024, 1024, S, E);
            SEAM(pb + 8);
        }
#endif
#ifndef NO_P8
        if (IN(pb + 9)) { REFRESH(); (void)moe_build(F, l); if (DRY_P8) p_combine_ln(F, *fresh_args(), l, true); p_combine_ln(F, *fresh_args(), l); SEAM(pb + 9); }
#endif
    }
#undef IN
#undef SEAM
}

extern "C" void kernel_launch(void* const* d_in, const int* in_sizes, int n_in, void* d_out, int out_size, void* d_ws, size_t ws_size, hipStream_t stream) {
    static int grid = 0;
    if (grid == 0) {
        if (n_in != 22 || in_sizes[0] != NTOK * D || out_size != NTOK * D || ws_size < WS_END) {
            fprintf(stderr, "kernel_launch: unexpected shapes (n_in %d, in0 %d, out %d, ws %zu); nothing launched\n", n_in, n_in > 0 ? in_sizes[0] : -1, out_size, ws_size); grid = -1; return; }
        int dev = 0, cus = 0, per_cu = 0;
        if (hipGetDevice(&dev) != hipSuccess || hipDeviceGetAttribute(&cus, hipDeviceAttributeMultiprocessorCount, dev) != hipSuccess) { grid = -1; return; }
        if (hipFuncSetAttribute((const void*)mk_fwd, hipFuncAttributeMaxDynamicSharedMemorySize, LDS_BYTES) != hipSuccess) { fprintf(stderr, "kernel_launch: hipFuncSetAttribute failed\n"); grid = -1; return; }
        if (hipOccupancyMaxActiveBlocksPerMultiprocessor(&per_cu, (const void*)mk_fwd, 512, LDS_BYTES) != hipSuccess || per_cu < 1)
            fprintf(stderr, "kernel_launch: note: occupancy query reports %d workgroups per CU\n", per_cu);
        (void)hipGetLastError();
        grid = cus;
    }
    if (grid < 0) return;
    if (hipMemsetAsync((char*)d_ws + WS_CTL, 0, CTL_ZERO_BYTES, stream) != hipSuccess) { fprintf(stderr, "kernel_launch: memset failed\n"); return; }
    Args a{};
    for (int i = 0; i < 22; ++i) a.in[i] = (const float*)d_in[i];
    a.out = (float*)d_out; a.ws = (unsigned char*)d_ws;
    for (int l = 0; l < DEPTH; ++l) a.lam_init[l] = (float)(0.8 - 0.6 * exp(-0.3 * (double)l));
#if MK_ONE_LAUNCH
    a.ph_lo = 0; a.ph_hi = N_PHASES;
    hipLaunchKernelGGL(mk_fwd, dim3(grid), dim3(512), LDS_BYTES, stream, a);
#else
    for (int p = 0; p < N_PHASES; ++p) {
        a.ph_lo = p; a.ph_hi = p + 1;
        hipLaunchKernelGGL(mk_fwd, dim3(grid), dim3(512), LDS_BYTES, stream, a);
    }
#endif
    const hipError_t le = hipPeekAtLastError();
    if (le != hipSuccess) fprintf(stderr, "kernel_launch: launch failed: %s\n", hipGetErrorName(le));
}
```

```cpp
#include <hip/hip_runtime.h>
#include <cstdio>
#include <cstdint>
#include <cmath>

#ifndef REP_AB
#define REP_AB 1
#endif
#ifndef REP_C
#define REP_C 1
#endif
#ifndef REP_G
#define REP_G 1
#endif
#ifndef REP_G1
#define REP_G1 REP_G
#endif
#ifndef REP_G3
#define REP_G3 REP_G
#endif
#ifndef REP_G4
#define REP_G4 REP_G
#endif
#ifndef REP_G6
#define REP_G6 REP_G
#endif
#ifndef REP_G7
#define REP_G7 REP_G
#endif
#ifndef REP_T
#define REP_T 1
#endif
#ifndef DRY_P5
#define DRY_P5 0
#endif
#ifndef DRY_P8
#define DRY_P8 0
#endif
#ifndef C_ANTIPHASE
#define C_ANTIPHASE 0
#endif
#ifndef MK_ONE_LAUNCH
#define MK_ONE_LAUNCH 1
#endif

#define GAS __attribute__((address_space(1)))
#define LAS __attribute__((address_space(3)))
typedef unsigned short bf16;
typedef unsigned v4u __attribute__((ext_vector_type(4)));
typedef unsigned v2u __attribute__((ext_vector_type(2)));
typedef float f32x4 __attribute__((ext_vector_type(4)));
typedef float f32x2 __attribute__((ext_vector_type(2)));
typedef short bf16x8 __attribute__((ext_vector_type(8)));

constexpr int NTOK = 32768, SEQ = 4096, D = 1024, DEPTH = 4, INC = 6144, NEXP = 32, TOPK = 4;
constexpr int C_QA = 0, C_KA = 256, C_VA = 512, C_QB = 768, C_KB = 1152, C_VB = 1536, C_QC = 1920, C_KC = 2304, C_VC = 2688, C_GP = 3072;
constexpr int YLD = 768, Y_A = 0, Y_B = 256, Y_C = 384;
constexpr int WPK = 896;
constexpr int MAXT = 544;
constexpr float LN_EPS = 1e-5f;
constexpr float DN_ALPHA = 1.681792830507429f;

constexpr size_t MiB = 1u << 20;
constexpr size_t WS_CTL = 0, CTL_ZERO_BYTES = 1 * MiB;
constexpr size_t WS_ROPE64 = 1 * MiB;
constexpr size_t WS_ROPE48 = 2 * MiB;
constexpr size_t WS_TOPE = 3 * MiB;
constexpr size_t WS_TOPW = 3 * MiB + 512 * 1024;
constexpr size_t WS_POS = 4 * MiB;
constexpr size_t WS_WIN = 8 * MiB;
constexpr size_t WS_WPROJ = 56 * MiB;
constexpr size_t WS_WOUT = 64 * MiB;
constexpr size_t WS_WGU = 72 * MiB;
constexpr size_t WS_WDN = 584 * MiB;
constexpr size_t WS_XB = 840 * MiB;
constexpr size_t WS_Y = 904 * MiB;
constexpr size_t WS_M = 952 * MiB;
constexpr size_t WS_H = 1016 * MiB;
constexpr size_t WS_HH = 1400 * MiB;
constexpr size_t WS_WRT = 5 * MiB;
constexpr size_t WS_RANK = 6 * MiB;
constexpr size_t WS_SRC = 1672 * MiB;
constexpr size_t WS_XB8 = 1676 * MiB;
constexpr size_t WS_WIN8 = 1708 * MiB;
constexpr size_t WS_G8 = 1720 * MiB;
constexpr size_t WS_END = 1816 * MiB;
constexpr int CW_BAR = 4096;
constexpr int CW_CNT = 8192;
constexpr int CW_CUR = 8192 + 4 * 64;

constexpr int RING_BYTES = 131072;
constexpr int LDSCTL_OFF = RING_BYTES;
constexpr int L_MISC = LDSCTL_OFF;
constexpr int L_OFFT = LDSCTL_OFF + 256;
constexpr int L_HIST = LDSCTL_OFF + 512;
constexpr int L_BASE = LDSCTL_OFF + 768;
constexpr int L_CNT = LDSCTL_OFF + 896;
constexpr int L_TILE = LDSCTL_OFF + 1024;
constexpr int L_PPOS = LDSCTL_OFF + 4096;
constexpr int L_PTOK = LDSCTL_OFF + 6144;
constexpr int LDS_BYTES = 147456;
static_assert(L_PTOK + 2048 <= LDS_BYTES, "LDS map");

#define RLX_AGENT __ATOMIC_RELAXED, __HIP_MEMORY_SCOPE_AGENT
#define LDS_WAIT() asm volatile("s_waitcnt lgkmcnt(0)" ::: "memory")
#define VM_WAIT() asm volatile("s_waitcnt vmcnt(0)" ::: "memory")

__device__ __forceinline__ float bf2f(unsigned short b) { return __uint_as_float(((unsigned)b) << 16); }
__device__ __forceinline__ float bflo(unsigned u) { return __uint_as_float(u << 16); }
__device__ __forceinline__ float bfhi(unsigned u) { return __uint_as_float(u & 0xffff0000u); }
__device__ __forceinline__ unsigned f2bf(float f) { unsigned u = __builtin_bit_cast(unsigned, f); return (u + 0x7fffu + ((u >> 16) & 1u)) >> 16; }
__device__ __forceinline__ unsigned pk2(float lo, float hi) { return f2bf(lo) | (f2bf(hi) << 16); }
__device__ __forceinline__ float wave_sum(float v) {
#pragma unroll
    for (int o = 1; o < 64; o <<= 1) v += __shfl_xor(v, o);
    return v;
}
__device__ __forceinline__ int opaque_tid() { int t; asm volatile("v_mov_b32 %0, %1" : "=v"(t) : "v"(threadIdx.x)); return t; }
__device__ __forceinline__ unsigned pk4_fp8(float a, float b, float c, float d, float sc) {
    a = fminf(fmaxf(a * sc, -448.f), 448.f); b = fminf(fmaxf(b * sc, -448.f), 448.f); c = fminf(fmaxf(c * sc, -448.f), 448.f); d = fminf(fmaxf(d * sc, -448.f), 448.f);
    int p = __builtin_amdgcn_cvt_pk_fp8_f32(a, b, 0, false); p = __builtin_amdgcn_cvt_pk_fp8_f32(c, d, p, true); return (unsigned)p; }
__device__ __forceinline__ float fast_sigmoid(float x) { return __builtin_amdgcn_rcpf(1.0f + __builtin_amdgcn_exp2f(-1.4426950408889634f * x)); }

namespace pg8 {
#define PG8_LAS __attribute__((address_space(3)))
typedef unsigned short bf16_t;
typedef unsigned u32x4 __attribute__((ext_vector_type(4)));
constexpr int BM = 256, BK = 64, HALF = 128, HTB = HALF * BK * 2, STAGE_BYTES = 8 * HTB, NXCD = 8, WGM = 8;

__host__ __device__ __forceinline__ int lds_byte(int r, int c) { const int st = (r >> 4) * 2 + (c >> 5), rr = r & 15, cc = c & 31, ob = rr * 64 + cc * 2; return st * 1024 + (ob ^ (((ob >> 9) & 1) << 5)); }
__host__ __device__ __forceinline__ void stage_rc(int b, int& R, int& C) { const int st = b / 1024, sb = b % 1024, swz = sb ^ (((sb >> 9) & 1) << 5); R = (st >> 1) * 16 + swz / 64; C = (st & 1) * 32 + (swz % 64) / 2; }
__host__ __device__ __forceinline__ int perm32(int rho) { const int n = rho >> 4, i = rho & 15; return 8 * (i >> 2) + 4 * n + (i & 3); }

struct Unit { const char* A; const char* B; int nt; int pm, pn, aux; };

__device__ __forceinline__ void tile_of(int L, int nM, int nN, int& pm, int& pn) {
    const int nwg = nM * nN;
    int wgid = L; { const int q = nwg / NXCD, r = nwg % NXCD, xcd = wgid % NXCD, off = wgid / NXCD; wgid = (xcd < r ? xcd * (q + 1) : r * (q + 1) + (xcd - r) * q) + off; }
    const int nig = WGM * nN, gid = wgid / nig, fm = gid * WGM, gsz = (nM - fm) < WGM ? (nM - fm) : WGM;
    pm = fm + ((wgid % nig) % gsz); pn = (wgid % nig) / gsz;
}

__device__ __forceinline__ unsigned cvt_pk_bf16(float lo, float hi) { unsigned r; asm volatile("v_cvt_pk_bf16_f32 %0, %1, %2" : "=v"(r) : "v"(lo), "v"(hi)); return r; }
typedef int v8i32 __attribute__((ext_vector_type(8)));
typedef short s16x16 __attribute__((ext_vector_type(16)));
typedef int v4i32 __attribute__((ext_vector_type(4)));
__device__ __forceinline__ v8i32 cat8(bf16x8 lo, bf16x8 hi) { const v4i32 a = __builtin_bit_cast(v4i32, lo), b = __builtin_bit_cast(v4i32, hi); return __builtin_shufflevector(a, b, 0, 1, 2, 3, 4, 5, 6, 7); }

template <class Epi, class Sched, bool ALIGN_EPI, bool SP2, bool FP8 = false>
__device__ __forceinline__ void gemm_phase(PG8_LAS unsigned char* lds, const int lda, const int ldb, const Sched& S, const Epi& E, const int sclW = 0x7f7f7f7f, const int sclX = 0x7f7f7f7f) {
    constexpr int EB = FP8 ? 1 : 2;
    const int tid = opaque_tid(), wid = __builtin_amdgcn_readfirstlane(tid >> 6), lane = tid & 63, wr = wid >> 2, wc = wid & 3, fr = lane & 15, fq = lane >> 4;
    unsigned voffA[2], voffB[2];
#pragma unroll
    for (int i = 0; i < 2; ++i) { int R, C; stage_rc(tid * 16 + i * 8192, R, C); const int Rb = Epi::PERM ? ((R & ~31) + perm32(R & 31)) : R;
        voffA[i] = (unsigned)(R * lda * EB + C * 2); voffB[i] = (unsigned)(Rb * ldb * EB + C * 2); }
    const size_t kstep = (size_t)(BK * 2);
    const size_t hA = (size_t)HALF * lda * EB, hB = (size_t)HALF * ldb * EB;
    const unsigned ldsw = (unsigned)wid * 1024u;
    const int fcol = FP8 ? (32 * (fq >> 1) + 16 * (fq & 1)) : fq * 8;
    const int aoff = lds_byte(wr * 64 + fr, fcol), boff = lds_byte(wc * 32 + fr, fcol);
#define PG8_SA(b, h) (((b) * 2 + (h)) * HTB)
#define PG8_SB(b, h) ((4 + (b) * 2 + (h)) * HTB)
#define PG8_STAGE(bufoff, gbase, voff) do { _Pragma("unroll") for (int _i = 0; _i < 2; ++_i) \
        __builtin_amdgcn_global_load_lds((const unsigned*)((const char*)(gbase) + (voff)[_i]), (PG8_LAS unsigned*)(lds + (bufoff) + ldsw + _i * 8192), 16, 0, 0); } while (0)
#define PG8_LDA(dst, b, h) do { if constexpr (FP8) { _Pragma("unroll") for (int m = 0; m < 4; ++m) dst##8[m] = cat8(*(const PG8_LAS bf16x8*)(lds + PG8_SA(b, h) + aoff + m * 2048), *(const PG8_LAS bf16x8*)(lds + PG8_SA(b, h) + aoff + m * 2048 + 16)); } else { \
        _Pragma("unroll") for (int m = 0; m < 4; ++m) _Pragma("unroll") for (int k = 0; k < 2; ++k) dst[m][k] = *(const PG8_LAS bf16x8*)(lds + PG8_SA(b, h) + aoff + m * 2048 + k * 1024); } } while (0)
#define PG8_LDB(dst, b, h) do { if constexpr (FP8) { _Pragma("unroll") for (int n = 0; n < 2; ++n) dst##8[n] = cat8(*(const PG8_LAS bf16x8*)(lds + PG8_SB(b, h) + boff + n * 2048), *(const PG8_LAS bf16x8*)(lds + PG8_SB(b, h) + boff + n * 2048 + 16)); } else { \
        _Pragma("unroll") for (int n = 0; n < 2; ++n) _Pragma("unroll") for (int k = 0; k < 2; ++k) dst[n][k] = *(const PG8_LAS bf16x8*)(lds + PG8_SB(b, h) + boff + n * 2048 + k * 1024); } } while (0)
#define PG8_MMA(ai, bj, At, Bt) do { __builtin_amdgcn_s_setprio(1); if constexpr (FP8) { _Pragma("unroll") for (int m = 0; m < 4; ++m) _Pragma("unroll") for (int n = 0; n < 2; ++n) \
        asm volatile("v_mfma_f32_16x16x128_f8f6f4 %0, %1, %2, %0" : "+v"(acc[ai][bj][m][n]) : "v"(Bt##8[n]), "v"(At##8[m])); } else { \
        _Pragma("unroll") for (int m = 0; m < 4; ++m) _Pragma("unroll") for (int n = 0; n < 2; ++n) _Pragma("unroll") for (int k = 0; k < 2; ++k) \
        acc[ai][bj][m][n] = __builtin_amdgcn_mfma_f32_16x16x32_bf16(Bt[n][k], At[m][k], acc[ai][bj][m][n], 0, 0, 0); } __builtin_amdgcn_s_setprio(0); } while (0)
#define PG8_WAIT_V(n) asm volatile("s_waitcnt vmcnt(" #n ")" ::: "memory")
#define PG8_WAIT_L(n) asm volatile("s_waitcnt lgkmcnt(" #n ")" ::: "memory")
#define PG8_BAR __builtin_amdgcn_s_barrier()
#define PG8_SCHED __builtin_amdgcn_sched_barrier(0)
    Unit cur, nxt; int ui = 0;
    if (!S.next(0, cur)) return;
    f32x4 acc[2][2][4][2];
#pragma unroll
    for (int a = 0; a < 2; ++a)
#pragma unroll
        for (int b = 0; b < 2; ++b)
#pragma unroll
            for (int m = 0; m < 4; ++m)
#pragma unroll
                for (int n = 0; n < 2; ++n) acc[a][b][m][n] = (f32x4){0.f, 0.f, 0.f, 0.f};
    bf16x8 At[4][2], B0[2][2], B1[2][2]; v8i32 At8[4], B08[2], B18[2];
    const char* cA = cur.A; const char* cB = cur.B;
    if constexpr (SP2) {
        PG8_STAGE(PG8_SB(0, 0), cB, voffB); PG8_STAGE(PG8_SB(0, 1), cB + hB, voffB); PG8_STAGE(PG8_SA(0, 0), cA, voffA); PG8_STAGE(PG8_SA(0, 1), cA + hA, voffA);
        if (wr == 1) PG8_BAR;
        PG8_WAIT_V(2); PG8_BAR;
        PG8_STAGE(PG8_SB(1, 0), cB + kstep, voffB); PG8_STAGE(PG8_SA(1, 0), cA + kstep, voffA); PG8_STAGE(PG8_SB(1, 1), cB + hB + kstep, voffB);
        PG8_WAIT_V(6); PG8_BAR;
    } else {
        PG8_STAGE(PG8_SB(0, 0), cB, voffB); PG8_STAGE(PG8_SA(0, 0), cA, voffA); PG8_STAGE(PG8_SB(0, 1), cB + hB, voffB); PG8_STAGE(PG8_SA(0, 1), cA + hA, voffA);
        if (wr == 1) PG8_BAR;
        PG8_WAIT_V(4); PG8_BAR;
        PG8_STAGE(PG8_SB(1, 0), cB + kstep, voffB); PG8_STAGE(PG8_SA(1, 0), cA + kstep, voffA); PG8_STAGE(PG8_SB(1, 1), cB + hB + kstep, voffB);
        PG8_WAIT_V(6); PG8_BAR;
    }
    for (;;) {
        const bool has_next = S.next(ui + 1, nxt);
        const char* nA = has_next ? nxt.A : cA; const char* nB = has_next ? nxt.B : cB;
        const int nt = cur.nt;
        for (int t = 0; t < nt; t += 2) {
            const bool last = (t == nt - 2);
            const char* a1 = cA + (size_t)(t + 1) * kstep;
            const char* a2 = last ? nA : cA + (size_t)(t + 2) * kstep; const char* b2 = last ? nB : cB + (size_t)(t + 2) * kstep;
            const char* a3 = a2 + kstep; const char* b3 = b2 + kstep;
            if constexpr (SP2) {
            PG8_LDB(B0, 0, 0); PG8_LDB(B1, 0, 1); PG8_SCHED; PG8_LDA(At, 0, 0); PG8_STAGE(PG8_SA(1, 1), a1 + hA, voffA);
            PG8_WAIT_V(8); PG8_WAIT_L(0); PG8_BAR; PG8_MMA(0, 0, At, B0); PG8_MMA(0, 1, At, B1); PG8_BAR; PG8_SCHED;
            PG8_LDA(At, 0, 1); PG8_STAGE(PG8_SB(0, 0), b2, voffB); PG8_STAGE(PG8_SB(0, 1), b2 + hB, voffB); PG8_STAGE(PG8_SA(0, 0), a2, voffA);
            PG8_WAIT_V(8); PG8_WAIT_L(0); PG8_BAR; PG8_MMA(1, 0, At, B0); PG8_MMA(1, 1, At, B1); PG8_BAR; PG8_SCHED;
            PG8_LDB(B0, 1, 0); PG8_LDB(B1, 1, 1); PG8_SCHED; PG8_LDA(At, 1, 0); PG8_STAGE(PG8_SA(0, 1), a2 + hA, voffA);
            PG8_WAIT_V(8); PG8_WAIT_L(0); PG8_BAR; PG8_MMA(0, 0, At, B0); PG8_MMA(0, 1, At, B1); PG8_BAR; PG8_SCHED;
            PG8_LDA(At, 1, 1); PG8_STAGE(PG8_SB(1, 0), b3, voffB); PG8_STAGE(PG8_SB(1, 1), b3 + hB, voffB); PG8_STAGE(PG8_SA(1, 0), a3, voffA);
            PG8_WAIT_V(8); PG8_WAIT_L(0); PG8_BAR; PG8_MMA(1, 0, At, B0); PG8_MMA(1, 1, At, B1); PG8_BAR; PG8_SCHED;
            } else {
            PG8_LDB(B0, 0, 0); PG8_SCHED; PG8_LDA(At, 0, 0); PG8_STAGE(PG8_SA(1, 1), a1 + hA, voffA);
            PG8_WAIT_L(8); PG8_BAR; PG8_WAIT_L(0); PG8_MMA(0, 0, At, B0); PG8_BAR; PG8_SCHED;
            PG8_LDB(B1, 0, 1); PG8_STAGE(PG8_SB(0, 0), b2, voffB);
            PG8_BAR; PG8_WAIT_L(0); PG8_MMA(0, 1, At, B1); PG8_BAR;
            PG8_LDA(At, 0, 1); PG8_STAGE(PG8_SA(0, 0), a2, voffA);
            PG8_BAR; PG8_WAIT_L(0); PG8_MMA(1, 0, At, B0); PG8_BAR; PG8_SCHED;
            PG8_STAGE(PG8_SB(0, 1), b2 + hB, voffB);
            PG8_WAIT_V(6); PG8_BAR; PG8_MMA(1, 1, At, B1); PG8_BAR;
            PG8_LDB(B0, 1, 0); PG8_SCHED; PG8_LDA(At, 1, 0); PG8_STAGE(PG8_SA(0, 1), a2 + hA, voffA);
            PG8_WAIT_L(8); PG8_BAR; PG8_WAIT_L(0); PG8_MMA(0, 0, At, B0); PG8_BAR; PG8_SCHED;
            PG8_LDB(B1, 1, 1); PG8_STAGE(PG8_SB(1, 0), b3, voffB);
            PG8_BAR; PG8_WAIT_L(0); PG8_MMA(0, 1, At, B1); PG8_BAR;
            PG8_LDA(At, 1, 1); PG8_STAGE(PG8_SA(1, 0), a3, voffA);
            PG8_BAR; PG8_WAIT_L(0); PG8_MMA(1, 0, At, B0); PG8_BAR; PG8_SCHED;
            PG8_STAGE(PG8_SB(1, 1), b3 + hB, voffB);
            PG8_WAIT_V(6); PG8_BAR; PG8_MMA(1, 1, At, B1); PG8_BAR;
            }
        }
        if constexpr (ALIGN_EPI) { if (wr == 0) PG8_BAR; }
        if constexpr (FP8) asm volatile("s_nop 15\n\ts_nop 15\n\ts_nop 15" ::: "memory");
        E(acc, cur, wr, wc, fr, fq);
        if (!has_next) break;
        if (!(Epi::KEEP && cur.aux != 2)) {
#pragma unroll
        for (int a = 0; a < 2; ++a)
#pragma unroll
            for (int b = 0; b < 2; ++b)
#pragma unroll
                for (int m = 0; m < 4; ++m)
#pragma unroll
                    for (int n = 0; n < 2; ++n) acc[a][b][m][n] = (f32x4){0.f, 0.f, 0.f, 0.f};
        }
        cur = nxt; cA = nA; cB = nB; ++ui;
        if constexpr (ALIGN_EPI) { if (wr == 1) PG8_BAR; }
    }
    PG8_WAIT_V(0);
    if constexpr (!ALIGN_EPI) { if (wr == 0) PG8_BAR; }
    PG8_BAR;
#undef PG8_SA
#undef PG8_SB
#undef PG8_STAGE
#undef PG8_LDA
#undef PG8_LDB
#undef PG8_MMA
#undef PG8_WAIT_V
#undef PG8_WAIT_L
#undef PG8_BAR
#undef PG8_SCHED
}

template <class Epi, class Sched, bool FP8 = false>
__device__ __forceinline__ void gemm_phase_gather(PG8_LAS unsigned char* lds, const char* Abase, const int lda, const int ldb, const Sched& S, const Epi& E, const int sclW = 0x7f7f7f7f, const int sclX = 0x7f7f7f7f) {
    constexpr int EB = FP8 ? 1 : 2;
    const int tid = opaque_tid(), wid = __builtin_amdgcn_readfirstlane(tid >> 6), lane = tid & 63, wr = wid >> 2, wc = wid & 3, fr = lane & 15, fq = lane >> 4;
    unsigned voffB[2]; int Rr[2]; unsigned Cc[2];
#pragma unroll
    for (int i = 0; i < 2; ++i) { int R, C; stage_rc(tid * 16 + i * 8192, R, C); const int Rb = Epi::PERM ? ((R & ~31) + perm32(R & 31)) : R;
        Rr[i] = R; Cc[i] = (unsigned)C * 2u; voffB[i] = (unsigned)(Rb * ldb * EB + C * 2); }
    const size_t kstep = (size_t)(BK * 2);
    const size_t hB = (size_t)HALF * ldb * EB;
    const unsigned ldsw = (unsigned)wid * 1024u;
    const int fcol = FP8 ? (32 * (fq >> 1) + 16 * (fq & 1)) : fq * 8;
    const int aoff = lds_byte(wr * 64 + fr, fcol), boff = lds_byte(wc * 32 + fr, fcol);
#define PG8_SA(b, h) (((b) * 2 + (h)) * HTB)
#define PG8_SB(b, h) ((4 + (b) * 2 + (h)) * HTB)
#define PG8_STAGE(bufoff, gbase, voff) do { _Pragma("unroll") for (int _i = 0; _i < 2; ++_i) \
        __builtin_amdgcn_global_load_lds((const unsigned*)((const char*)(gbase) + (voff)[_i]), (PG8_LAS unsigned*)(lds + (bufoff) + ldsw + _i * 8192), 16, 0, 0); } while (0)
#define PG8_LDA(dst, b, h) do { if constexpr (FP8) { _Pragma("unroll") for (int m = 0; m < 4; ++m) dst##8[m] = cat8(*(const PG8_LAS bf16x8*)(lds + PG8_SA(b, h) + aoff + m * 2048), *(const PG8_LAS bf16x8*)(lds + PG8_SA(b, h) + aoff + m * 2048 + 16)); } else { \
        _Pragma("unroll") for (int m = 0; m < 4; ++m) _Pragma("unroll") for (int k = 0; k < 2; ++k) dst[m][k] = *(const PG8_LAS bf16x8*)(lds + PG8_SA(b, h) + aoff + m * 2048 + k * 1024); } } while (0)
#define PG8_LDB(dst, b, h) do { if constexpr (FP8) { _Pragma("unroll") for (int n = 0; n < 2; ++n) dst##8[n] = cat8(*(const PG8_LAS bf16x8*)(lds + PG8_SB(b, h) + boff + n * 2048), *(const PG8_LAS bf16x8*)(lds + PG8_SB(b, h) + boff + n * 2048 + 16)); } else { \
        _Pragma("unroll") for (int n = 0; n < 2; ++n) _Pragma("unroll") for (int k = 0; k < 2; ++k) dst[n][k] = *(const PG8_LAS bf16x8*)(lds + PG8_SB(b, h) + boff + n * 2048 + k * 1024); } } while (0)
#define PG8_MMA(ai, bj, At, Bt) do { __builtin_amdgcn_s_setprio(1); if constexpr (FP8) { _Pragma("unroll") for (int m = 0; m < 4; ++m) _Pragma("unroll") for (int n = 0; n < 2; ++n) \
        asm volatile("v_mfma_f32_16x16x128_f8f6f4 %0, %1, %2, %0" : "+v"(acc[ai][bj][m][n]) : "v"(Bt##8[n]), "v"(At##8[m])); } else { \
        _Pragma("unroll") for (int m = 0; m < 4; ++m) _Pragma("unroll") for (int n = 0; n < 2; ++n) _Pragma("unroll") for (int k = 0; k < 2; ++k) \
        acc[ai][bj][m][n] = __builtin_amdgcn_mfma_f32_16x16x32_bf16(Bt[n][k], At[m][k], acc[ai][bj][m][n], 0, 0, 0); } __builtin_amdgcn_s_setprio(0); } while (0)
#define PG8_WAIT_V(n) asm volatile("s_waitcnt vmcnt(" #n ")" ::: "memory")
#define PG8_WAIT_L(n) asm volatile("s_waitcnt lgkmcnt(" #n ")" ::: "memory")
#define PG8_BAR __builtin_amdgcn_s_barrier()
#define PG8_SCHED __builtin_amdgcn_sched_barrier(0)
#define PG8_ROWOFF(u, vo) do { _Pragma("unroll") for (int _h = 0; _h < 2; ++_h) _Pragma("unroll") for (int _i = 0; _i < 2; ++_i) \
        (vo)[_h][_i] = (unsigned)S.rowtok((u), 128 * _h + Rr[_i]) * (unsigned)(lda * EB) + Cc[_i]; } while (0)
    Unit cur, nxt, nn; int ui = 0;
    if (!S.next(0, cur)) return;
    bool has_next = S.next(1, nxt);
    unsigned cv[2][2], nv[2][2], tv[2][2];
    PG8_ROWOFF(cur, cv);
    if (has_next) PG8_ROWOFF(nxt, nv); else { _Pragma("unroll") for (int h = 0; h < 2; ++h) _Pragma("unroll") for (int i = 0; i < 2; ++i) nv[h][i] = cv[h][i]; }
    f32x4 acc[2][2][4][2];
#pragma unroll
    for (int a = 0; a < 2; ++a)
#pragma unroll
        for (int b = 0; b < 2; ++b)
#pragma unroll
            for (int m = 0; m < 4; ++m)
#pragma unroll
                for (int n = 0; n < 2; ++n) acc[a][b][m][n] = (f32x4){0.f, 0.f, 0.f, 0.f};
    bf16x8 At[4][2], B0[2][2], B1[2][2]; v8i32 At8[4], B08[2], B18[2];
    const char* cB = cur.B;
    PG8_STAGE(PG8_SB(0, 0), cB, voffB); PG8_STAGE(PG8_SB(0, 1), cB + hB, voffB); PG8_STAGE(PG8_SA(0, 0), Abase, cv[0]); PG8_STAGE(PG8_SA(0, 1), Abase, cv[1]);
    if (wr == 1) PG8_BAR;
    PG8_WAIT_V(2); PG8_BAR;
    PG8_STAGE(PG8_SB(1, 0), cB + kstep, voffB); PG8_STAGE(PG8_SA(1, 0), Abase + kstep, cv[0]); PG8_STAGE(PG8_SB(1, 1), cB + hB + kstep, voffB);
    PG8_WAIT_V(6); PG8_BAR;
    for (;;) {
        const char* nB = has_next ? nxt.B : cB;
        const int nt = cur.nt;
        for (int t = 0; t < nt; t += 2) {
            const bool last = (t == nt - 2);
            const char* a1 = Abase + (size_t)(t + 1) * kstep;
            const char* a2 = last ? Abase : Abase + (size_t)(t + 2) * kstep; const char* b2 = last ? nB : cB + (size_t)(t + 2) * kstep;
            const char* a3 = a2 + kstep; const char* b3 = b2 + kstep;
            unsigned s0[2], s1[2];
#pragma unroll
            for (int i = 0; i < 2; ++i) { s0[i] = last ? nv[0][i] : cv[0][i]; s1[i] = last ? nv[1][i] : cv[1][i]; }
            PG8_LDB(B0, 0, 0); PG8_LDB(B1, 0, 1); PG8_SCHED; PG8_LDA(At, 0, 0); PG8_STAGE(PG8_SA(1, 1), a1, cv[1]);
            PG8_WAIT_V(8); PG8_WAIT_L(0); PG8_BAR; PG8_MMA(0, 0, At, B0); PG8_MMA(0, 1, At, B1); PG8_BAR; PG8_SCHED;
            PG8_LDA(At, 0, 1); PG8_STAGE(PG8_SB(0, 0), b2, voffB); PG8_STAGE(PG8_SB(0, 1), b2 + hB, voffB); PG8_STAGE(PG8_SA(0, 0), a2, s0);
            PG8_WAIT_V(8); PG8_WAIT_L(0); PG8_BAR; PG8_MMA(1, 0, At, B0); PG8_MMA(1, 1, At, B1); PG8_BAR; PG8_SCHED;
            PG8_LDB(B0, 1, 0); PG8_LDB(B1, 1, 1); PG8_SCHED; PG8_LDA(At, 1, 0); PG8_STAGE(PG8_SA(0, 1), a2, s1);
            PG8_WAIT_V(8); PG8_WAIT_L(0); PG8_BAR; PG8_MMA(0, 0, At, B0); PG8_MMA(0, 1, At, B1); PG8_BAR; PG8_SCHED;
            PG8_LDA(At, 1, 1); PG8_STAGE(PG8_SB(1, 0), b3, voffB); PG8_STAGE(PG8_SB(1, 1), b3 + hB, voffB); PG8_STAGE(PG8_SA(1, 0), a3, s0);
            PG8_WAIT_V(8); PG8_WAIT_L(0); PG8_BAR; PG8_MMA(1, 0, At, B0); PG8_MMA(1, 1, At, B1); PG8_BAR; PG8_SCHED;
        }
        if (wr == 0) PG8_BAR;
        if constexpr (FP8) asm volatile("s_nop 15\n\ts_nop 15\n\ts_nop 15" ::: "memory");
        const bool has_nn = has_next && S.next(ui + 2, nn);
        if (has_nn) PG8_ROWOFF(nn, tv);
        E(acc, cur, wr, wc, fr, fq);
        if (!has_next) break;
#pragma unroll
        for (int a = 0; a < 2; ++a)
#pragma unroll
            for (int b = 0; b < 2; ++b)
#pragma unroll
                for (int m = 0; m < 4; ++m)
#pragma unroll
                    for (int n = 0; n < 2; ++n) acc[a][b][m][n] = (f32x4){0.f, 0.f, 0.f, 0.f};
        cur = nxt; cB = nB; ++ui;
#pragma unroll
        for (int h = 0; h < 2; ++h)
#pragma unroll
            for (int i = 0; i < 2; ++i) { cv[h][i] = nv[h][i]; if (has_nn) nv[h][i] = tv[h][i]; }
        asm volatile("" : "+v"(nv[0][0]), "+v"(nv[0][1]), "+v"(nv[1][0]), "+v"(nv[1][1]));
        nxt = nn; has_next = has_nn;
        if (wr == 1) PG8_BAR;
    }
    PG8_WAIT_V(0);
    PG8_BAR;
#undef PG8_SA
#undef PG8_SB
#undef PG8_STAGE
#undef PG8_LDA
#undef PG8_LDB
#undef PG8_MMA
#undef PG8_WAIT_V
#undef PG8_WAIT_L
#undef PG8_BAR
#undef PG8_SCHED
#undef PG8_ROWOFF
}

struct DenseOrder {
    const char* A; const char* B; size_t a_tile, b_tile; int nt, nM, nN, G, c; int pn_off = 0;
    __device__ __forceinline__ bool next(int i, Unit& u) const {
        const long L = (long)i * G + c; if (L >= (long)nM * nN) return false;
        int pm, pn; tile_of((int)L, nM, nN, pm, pn);
        u.pm = pm; u.pn = pn + pn_off; u.aux = 0; u.nt = nt; u.A = A + (size_t)pm * a_tile; u.B = B + (size_t)pn * b_tile; return true;
    }
};
struct ProjOrder {
    const char* Y; const char* W; int nM, nN, G, c;
    __device__ __forceinline__ bool next(int i, Unit& u) const {
        const int ti = i / 3, br = i - 3 * ti;
        const long L = (long)ti * G + c; if (L >= (long)nM * nN) return false;
        int pm, pn; tile_of((int)L, nM, nN, pm, pn);
        u.pm = pm; u.pn = pn; u.aux = br; u.nt = (br == 2) ? 6 : 4;
        const int acol = (br == 0) ? 0 : (br == 1 ? 256 : 384), bcol = (br == 0) ? 0 : (br == 1 ? 256 : 512);
        u.A = Y + ((size_t)pm * 256 * YLD + acol) * 2; u.B = W + ((size_t)pn * 256 * WPK + bcol) * 2; return true;
    }
};
struct MoeOrder {
    const char* A; const char* W; size_t estride, atile, btile; int nt; const LAS int* tile_e; const LAS int* offT; const LAS int* cnt; const int* SRC; int T, nN, G, c;
    __device__ __forceinline__ bool next(int i, Unit& u) const {
        const long L = (long)i * G + c; if (L >= (long)T * nN) return false;
        int pm, pn; tile_of((int)L, T, nN, pm, pn);
        const int e = __builtin_amdgcn_readfirstlane(tile_e[pm]);
        u.pm = pm; u.pn = pn; u.aux = e; u.nt = nt; u.A = A + (size_t)pm * atile; u.B = W + (size_t)e * estride + (size_t)pn * btile; return true;
    }
    __device__ __forceinline__ int rowtok(const Unit& u, int r) const {
        const int e = u.aux, rank = (u.pm - offT[e]) * 256 + r, last = cnt[e] - 1;
        return SRC[e * NTOK + (rank < last ? rank : last)];
    }
};

struct EpiInProj {
    static constexpr bool PERM = true, KEEP = false;
    bf16_t* H; const float* bg; const f32x2* r64; const f32x2* r48; float gscale; unsigned char* G8;
    __device__ __forceinline__ void operator()(f32x4 (&acc)[2][2][4][2], const Unit& u, int wr, int wc, int fr, int fq) const {
        const int row0 = u.pm * BM + wr * 64 + fr, pn = u.pn, t0 = wc * 32 + 8 * fq;
        const float gs = gscale; unsigned char* const g8 = G8;
        if (pn >= 3 && pn < 9) {
            int dst, hstep, tw, dd0; const f32x2* tab;
            if (pn < 6) { dst = 768 + (4 * (pn - 3) + wc) * 64 + 8 * fq; hstep = 32; tw = 32; dd0 = 8 * fq; tab = r64; }
            else { const int p0 = 128 * (pn - 6) + t0, slot = p0 / 24; dd0 = p0 - slot * 24; dst = 1920 + slot * 48 + dd0; hstep = 24; tw = 24; tab = r48; }
#pragma unroll
            for (int ai = 0; ai < 2; ++ai)
#pragma unroll
                for (int m = 0; m < 4; ++m) { const int row = row0 + ai * HALF + m * 16; const f32x2* tp = tab + (size_t)(row & (SEQ - 1)) * tw + dd0;
                    f32x4 y1[2], y2[2];
#pragma unroll
                    for (int n = 0; n < 2; ++n) { const f32x4 cs0 = *(const f32x4*)(tp + 4 * n), cs1 = *(const f32x4*)(tp + 4 * n + 2);
                        const f32x4 x1 = acc[ai][0][m][n], x2 = acc[ai][1][m][n];
                        y1[n][0] = x1[0] * cs0[0] - x2[0] * cs0[1]; y2[n][0] = x2[0] * cs0[0] + x1[0] * cs0[1];
                        y1[n][1] = x1[1] * cs0[2] - x2[1] * cs0[3]; y2[n][1] = x2[1] * cs0[2] + x1[1] * cs0[3];
                        y1[n][2] = x1[2] * cs1[0] - x2[2] * cs1[1]; y2[n][2] = x2[2] * cs1[0] + x1[2] * cs1[1];
                        y1[n][3] = x1[3] * cs1[2] - x2[3] * cs1[3]; y2[n][3] = x2[3] * cs1[2] + x1[3] * cs1[3]; }
                    bf16_t* rowp = H + (size_t)row * INC + dst;
                    u32x4 w; w.x = cvt_pk_bf16(y1[0][0], y1[0][1]); w.y = cvt_pk_bf16(y1[0][2], y1[0][3]); w.z = cvt_pk_bf16(y1[1][0], y1[1][1]); w.w = cvt_pk_bf16(y1[1][2], y1[1][3]);
                    *(u32x4*)rowp = w;
                    w.x = cvt_pk_bf16(y2[0][0], y2[0][1]); w.y = cvt_pk_bf16(y2[0][2], y2[0][3]); w.z = cvt_pk_bf16(y2[1][0], y2[1][1]); w.w = cvt_pk_bf16(y2[1][2], y2[1][3]);
                    *(u32x4*)(rowp + hstep) = w; }
            return;
        }
        const bool gate = pn >= 12;
        int dcol[2];
#pragma unroll
        for (int bj = 0; bj < 2; ++bj) { const int x = pn * BM + bj * HALF + t0;
            if (pn >= 9 && pn < 12) { const int xx = x - 2304; dcol[bj] = xx < 384 ? 1536 + xx : 2688 + (xx - 384); } else dcol[bj] = x; }
        f32x4 bv[2][2];
#pragma unroll
        for (int bj = 0; bj < 2; ++bj)
#pragma unroll
            for (int n = 0; n < 2; ++n) bv[bj][n] = gate ? *(const f32x4*)(bg + (dcol[bj] - C_GP) + 4 * n) : (f32x4){0.f, 0.f, 0.f, 0.f};
#pragma unroll
        for (int ai = 0; ai < 2; ++ai)
#pragma unroll
            for (int m = 0; m < 4; ++m) { bf16_t* rowp = H + (size_t)(row0 + ai * HALF + m * 16) * INC;
#pragma unroll
                for (int bj = 0; bj < 2; ++bj) { f32x4 v0 = acc[ai][bj][m][0], v1 = acc[ai][bj][m][1];
                    if (gate) {
#pragma unroll
                        for (int q = 0; q < 4; ++q) { v0[q] = v0[q] * gs + bv[bj][0][q]; v1[q] = v1[q] * gs + bv[bj][1][q]; }
                        const unsigned b0 = (unsigned)(fast_sigmoid(v0[0]) * 255.0f + 0.5f) | ((unsigned)(fast_sigmoid(v0[1]) * 255.0f + 0.5f) << 8) | ((unsigned)(fast_sigmoid(v0[2]) * 255.0f + 0.5f) << 16) | ((unsigned)(fast_sigmoid(v0[3]) * 255.0f + 0.5f) << 24);
                        const unsigned b1 = (unsigned)(fast_sigmoid(v1[0]) * 255.0f + 0.5f) | ((unsigned)(fast_sigmoid(v1[1]) * 255.0f + 0.5f) << 8) | ((unsigned)(fast_sigmoid(v1[2]) * 255.0f + 0.5f) << 16) | ((unsigned)(fast_sigmoid(v1[3]) * 255.0f + 0.5f) << 24);
                        *(v2u*)(g8 + (size_t)(row0 + ai * HALF + m * 16) * 3072 + (dcol[bj] - C_GP)) = (v2u){b0, b1};
                    } else {
                        u32x4 w; w.x = cvt_pk_bf16(v0[0], v0[1]); w.y = cvt_pk_bf16(v0[2], v0[3]); w.z = cvt_pk_bf16(v1[0], v1[1]); w.w = cvt_pk_bf16(v1[2], v1[3]);
                        *(u32x4*)(rowp + dcol[bj]) = w; } } }
    }
};
struct EpiProj {
    static constexpr bool PERM = false, KEEP = true;
    const unsigned char* G8; bf16_t* Mg;
    __device__ __forceinline__ void operator()(f32x4 (&acc)[2][2][4][2], const Unit& u, int wr, int wc, int fr, int fq) const {
        const int row0 = u.pm * BM + wr * 64 + fr, col0 = u.pn * BM + wc * 32 + 4 * fq, br = u.aux;
#pragma unroll
        for (int ai = 0; ai < 2; ++ai)
#pragma unroll
            for (int m = 0; m < 4; ++m) { const size_t row = (size_t)(row0 + ai * HALF + m * 16);
#pragma unroll
                for (int bj = 0; bj < 2; ++bj)
#pragma unroll
                    for (int n = 0; n < 2; ++n) { const int c = col0 + bj * HALF + n * 16;
                        const unsigned char* gp = G8 + row * 3072 + br * 1024 + c;
                        const unsigned gw = *(const unsigned*)gp;
                        f32x4 g = (f32x4){fmaxf((float)(gw & 255u) * (1.0f / 255.0f), 1e-6f), fmaxf((float)((gw >> 8) & 255u) * (1.0f / 255.0f), 1e-6f), fmaxf((float)((gw >> 16) & 255u) * (1.0f / 255.0f), 1e-6f), fmaxf((float)(gw >> 24) * (1.0f / 255.0f), 1e-6f)};
                        if (br < 2) { const unsigned nw = *(const unsigned*)(gp + 1024);
                            g[0] *= __builtin_amdgcn_rcpf(fmaxf((float)(nw & 255u) * (1.0f / 255.0f), 1e-6f)); g[1] *= __builtin_amdgcn_rcpf(fmaxf((float)((nw >> 8) & 255u) * (1.0f / 255.0f), 1e-6f));
                            g[2] *= __builtin_amdgcn_rcpf(fmaxf((float)((nw >> 16) & 255u) * (1.0f / 255.0f), 1e-6f)); g[3] *= __builtin_amdgcn_rcpf(fmaxf((float)(nw >> 24) * (1.0f / 255.0f), 1e-6f));
                            acc[ai][bj][m][n] = acc[ai][bj][m][n] * g; }
                        else { const f32x4 t = acc[ai][bj][m][n] * g; v2u o; o.x = cvt_pk_bf16(t[0], t[1]); o.y = cvt_pk_bf16(t[2], t[3]); *(v2u*)(Mg + row * 1024 + c) = o; } } }
    }
};
struct EpiOut {
    static constexpr bool PERM = false, KEEP = false;
    const float* X; const bf16_t* XBr; float* P;
    __device__ __forceinline__ void operator()(f32x4 (&acc)[2][2][4][2], const Unit& u, int wr, int wc, int fr, int fq) const {
        const int row0 = u.pm * BM + wr * 64 + fr, col0 = u.pn * BM + wc * 32 + 4 * fq;
        const float* const Xf = X; const bf16_t* const Xh = XBr; float* const Pp = P;
#pragma unroll
        for (int ai = 0; ai < 2; ++ai)
#pragma unroll
            for (int m = 0; m < 4; ++m) { const size_t ro = (size_t)(row0 + ai * HALF + m * 16) * 1024 + col0;
#pragma unroll
                for (int bj = 0; bj < 2; ++bj)
#pragma unroll
                    for (int n = 0; n < 2; ++n) { f32x4 xv;
                        if (Xf) xv = *(const f32x4*)(Xf + ro + bj * HALF + n * 16);
                        else { const v2u xw = *(const v2u*)(Xh + ro + bj * HALF + n * 16); xv = (f32x4){bflo(xw.x), bfhi(xw.x), bflo(xw.y), bfhi(xw.y)}; }
                        *(f32x4*)(Pp + ro + bj * HALF + n * 16) = xv * DN_ALPHA + acc[ai][bj][m][n]; } }
    }
};
struct EpiSwiglu {
    static constexpr bool PERM = true, KEEP = false;
    unsigned char* HH; const float* bgate; const float* bup; float ascale;
    __device__ __forceinline__ void operator()(f32x4 (&acc)[2][2][4][2], const Unit& u, int wr, int wc, int fr, int fq) const {
        const int row0 = u.pm * BM + wr * 64 + fr, j0 = u.pn * HALF + wc * 32 + 8 * fq, e = u.aux;
        f32x4 bg[2], bu[2];
#pragma unroll
        for (int n = 0; n < 2; ++n) { bg[n] = *(const f32x4*)(bgate + e * 1024 + j0 + 4 * n); bu[n] = *(const f32x4*)(bup + e * 1024 + j0 + 4 * n); }
#pragma unroll
        for (int ai = 0; ai < 2; ++ai)
#pragma unroll
            for (int m = 0; m < 4; ++m) { unsigned char* rowp = HH + (size_t)(row0 + ai * HALF + m * 16) * 1024 + j0;
                f32x4 o[2];
#pragma unroll
                for (int n = 0; n < 2; ++n) { f32x4 g = acc[ai][0][m][n] * ascale + bg[n], uu = acc[ai][1][m][n] * ascale + bu[n];
#pragma unroll
                    for (int q = 0; q < 4; ++q) { const float hg = fminf(g[q], 7.0f), hu = fminf(fmaxf(uu[q], -7.0f), 7.0f);
                        o[n][q] = hg * fast_sigmoid(1.702f * hg) * (hu + 1.0f); } }
                v2u w; w.x = pk4_fp8(o[0][0], o[0][1], o[0][2], o[0][3], 4.0f); w.y = pk4_fp8(o[1][0], o[1][1], o[1][2], o[1][3], 4.0f);
                *(v2u*)rowp = w; }
    }
};
struct EpiDown {
    static constexpr bool PERM = true, KEEP = false;
    bf16_t* YS; const float* bd; float ascale;
    __device__ __forceinline__ void operator()(f32x4 (&acc)[2][2][4][2], const Unit& u, int wr, int wc, int fr, int fq) const {
        const int row0 = u.pm * BM + wr * 64 + fr, col0 = u.pn * BM + wc * 32 + 8 * fq, e = u.aux;
        f32x4 bv[2][2];
#pragma unroll
        for (int bj = 0; bj < 2; ++bj)
#pragma unroll
            for (int n = 0; n < 2; ++n) bv[bj][n] = *(const f32x4*)(bd + e * 1024 + col0 + bj * HALF + 4 * n);
#pragma unroll
        for (int ai = 0; ai < 2; ++ai)
#pragma unroll
            for (int m = 0; m < 4; ++m) { bf16_t* rowp = YS + (size_t)(row0 + ai * HALF + m * 16) * 1024 + col0;
#pragma unroll
                for (int bj = 0; bj < 2; ++bj) { const f32x4 v0 = acc[ai][bj][m][0] * ascale + bv[bj][0], v1 = acc[ai][bj][m][1] * ascale + bv[bj][1];
                    u32x4 w; w.x = cvt_pk_bf16(v0[0], v0[1]); w.y = cvt_pk_bf16(v0[2], v0[3]); w.z = cvt_pk_bf16(v1[0], v1[1]); w.w = cvt_pk_bf16(v1[2], v1[3]);
                    *(u32x4*)(rowp + bj * HALF) = w; } }
    }
};
}

#define XB_TMO      128
#define XB_XCNT(j)  (256  + 64 * (j))
#define XB_XSUB(j)  (1280 + 64 * (j))
#define XB_XGEN(j)  (2304 + 64 * (j))
#define XB_TOP      3328
#define XB_TOPGEN   3392
#define XCD_BAR_WORDS 3456
#define XB_SPIN_CAP (1u << 18)

__device__ __forceinline__ unsigned xb_ld(unsigned* p)              { return __hip_atomic_load(p, __ATOMIC_RELAXED, __HIP_MEMORY_SCOPE_AGENT); }
__device__ __forceinline__ unsigned xb_add(unsigned* p, unsigned v) { return __hip_atomic_fetch_add(p, v, __ATOMIC_RELAXED, __HIP_MEMORY_SCOPE_AGENT); }
__device__ __forceinline__ unsigned xb_xcc_id() { return (unsigned)__builtin_amdgcn_s_getreg((3 << 11) | 20) & 0xFu; }
#define XB_SPIN(cond, bar) do { unsigned _sp = 0; while (cond) { __builtin_amdgcn_s_sleep(1); \
    if ((++_sp & 255u) == 0u) { if (xb_ld(&(bar)[XB_TMO])) break; if (_sp > XB_SPIN_CAP) { atomicAdd(&(bar)[XB_TMO], 1u); break; } } } } while (0)

struct XcdBarrier { unsigned* bar; unsigned x; volatile LAS unsigned* st; };

__device__ __forceinline__ XcdBarrier xcd_barrier_post(unsigned* bar, volatile LAS unsigned* st) {
    XcdBarrier b; b.bar = bar; b.x = xb_xcc_id(); b.st = st;
    if (threadIdx.x == 0) (void)xb_add(&bar[XB_XCNT(b.x)], 1u);
    return b;
}
__device__ __forceinline__ void xcd_barrier_complete(unsigned* bar, unsigned x, unsigned& nloc, unsigned& nx) {
    const unsigned G = gridDim.x * gridDim.y * gridDim.z;
    unsigned sum, cnt, mine, sp = 0u;
    for (;;) {
        sum = 0u; cnt = 0u; mine = 0u;
#pragma unroll
        for (unsigned j = 0; j < 16; ++j) { const unsigned c = xb_ld(&bar[XB_XCNT(j)]); sum += c; cnt += (c > 0u) ? 1u : 0u; mine = (j == x) ? c : mine; }
        if (sum == G) break;
        __builtin_amdgcn_s_sleep(1);
        if ((++sp & 255u) == 0u) { if (xb_ld(&bar[XB_TMO])) break; if (sp > XB_SPIN_CAP) { atomicAdd(&bar[XB_TMO], 1u); break; } }
    }
    nloc = mine > 0u ? mine : 1u; nx = cnt > 0u ? cnt : 1u;
}
__device__ __forceinline__ void xcd_barrier(const XcdBarrier& b) {
    asm volatile("s_waitcnt vmcnt(0)" ::: "memory");
    __syncthreads();
    if (threadIdx.x == 0) {
        unsigned* bar = b.bar;
        __builtin_amdgcn_s_waitcnt(0);
        unsigned nloc = b.st[0], nx = b.st[1];
        if (nloc == 0u) { xcd_barrier_complete(bar, b.x, nloc, nx); b.st[0] = nloc; b.st[1] = nx; }
        const unsigned old = xb_add(&bar[XB_XSUB(b.x)], 1u);
        const unsigned gen = old / nloc;
        if (old + 1u == (gen + 1u) * nloc) {
            __builtin_amdgcn_fence(__ATOMIC_RELEASE, "agent");
            asm volatile("s_waitcnt vmcnt(0)" ::: "memory");
            const unsigned og = xb_add(&bar[XB_TOP], 1u);
            const unsigned tg = og / nx;
            if (og + 1u == (tg + 1u) * nx) xb_add(&bar[XB_TOPGEN], 1u);
            else XB_SPIN(xb_ld(&bar[XB_TOPGEN]) == tg, bar);
            __builtin_amdgcn_fence(__ATOMIC_ACQUIRE, "agent");
            xb_add(&bar[XB_XGEN(b.x)], 1u);
            asm volatile("s_waitcnt vmcnt(0)" ::: "memory");
        } else {
            XB_SPIN(xb_ld(&bar[XB_XGEN(b.x)]) == gen, bar);
            __builtin_amdgcn_fence(__ATOMIC_ACQUIRE, "agent");
            asm volatile("s_waitcnt vmcnt(0)" ::: "memory");
        }
    }
    __syncthreads();
}

struct Frame {
    LAS unsigned char* lds;
    unsigned* ctl;
    unsigned char* ws;
    int tid, lane, wave, G, bid;
};

__host__ __device__ __forceinline__ int inproj_phys(int nl) {
    if (nl < 768) return nl;
    if (nl < 1536) { const int x = nl - 768, slot = x >> 6, d = x & 63; return 768 + (slot >> 2) * 256 + (d >> 5) * 128 + (slot & 3) * 32 + (d & 31); }
    if (nl < 1920) return 2304 + (nl - 1536);
    if (nl < 2688) { const int x = nl - 1920, slot = x / 48, d = x - slot * 48, hf = d >= 24 ? 1 : 0, p = slot * 24 + d - 24 * hf; return 1536 + (p >> 7) * 256 + hf * 128 + (p & 127); }
    if (nl < 3072) return 2304 + 384 + (nl - 2688);
    return nl;
}
template <class RowMap>
__device__ __forceinline__ void transpose_item(const float* W, int N, bf16* dst, int ldd, int k0, int n0, const RowMap rowmap, LAS float* scr, int lane) {
#pragma unroll 8
    for (int i = 0; i < 32; ++i) { const int kk = 2 * i + (lane >> 5); scr[kk * 33 + (lane & 31)] = W[(size_t)(k0 + kk) * N + n0 + (lane & 31)]; }
    LDS_WAIT(); asm volatile("" ::: "memory");
    const int c = lane & 7;
#pragma unroll
    for (int j = 0; j < 4; ++j) { const int n = (lane >> 3) + 8 * j; const LAS float* sp = scr + (8 * c) * 33 + n;
        v4u o; o.x = pk2(sp[0 * 33], sp[1 * 33]); o.y = pk2(sp[2 * 33], sp[3 * 33]); o.z = pk2(sp[4 * 33], sp[5 * 33]); o.w = pk2(sp[6 * 33], sp[7 * 33]);
        *(v4u*)(dst + (size_t)rowmap(n0 + n) * ldd + k0 + 8 * c) = o; }
    LDS_WAIT(); asm volatile("" ::: "memory");
}

template <class RowMap>
__device__ __forceinline__ void transpose_item_fp8(const float* W, int N, unsigned char* dst, int ldd, int k0, int n0, const RowMap rowmap, LAS float* scr, int lane, float qs) {
#pragma unroll 8
    for (int i = 0; i < 32; ++i) { const int kk = 2 * i + (lane >> 5); scr[kk * 33 + (lane & 31)] = W[(size_t)(k0 + kk) * N + n0 + (lane & 31)]; }
    LDS_WAIT(); asm volatile("" ::: "memory");
    const int c = lane & 7;
#pragma unroll
    for (int j = 0; j < 4; ++j) { const int n = (lane >> 3) + 8 * j; const LAS float* sp = scr + (8 * c) * 33 + n;
        v2u o; o.x = pk4_fp8(sp[0 * 33], sp[1 * 33], sp[2 * 33], sp[3 * 33], qs); o.y = pk4_fp8(sp[4 * 33], sp[5 * 33], sp[6 * 33], sp[7 * 33], qs);
        *(v2u*)(dst + (size_t)rowmap(n0 + n) * ldd + k0 + 8 * c) = o; }
    LDS_WAIT(); asm volatile("" ::: "memory");
}

struct Args { const float* in[22]; float* out; unsigned char* ws; int ph_lo, ph_hi; float lam_init[4]; };

__device__ __forceinline__ void p_prologue(Frame& F, const Args& a) {
    LAS float* scr = (LAS float*)(F.lds + F.wave * 16384);
    const int gw = F.bid * 8 + F.wave, NGW = F.G * 8;
    constexpr int PER_LAYER = 3072 + 128 + 64 + 192 + 512 + 32 * 1536;
    for (int it = gw; it < DEPTH * PER_LAYER; it += NGW) {
        const int l = it / PER_LAYER; int r = it - l * PER_LAYER;
        if (r < 3072) { const int kb = r / 192, nb = r % 192;
            if (nb < 96) transpose_item(a.in[1] + (size_t)l * 1024 * INC, INC, (bf16*)(F.ws + WS_WIN) + (size_t)l * INC * 1024, 1024, kb * 64, nb * 32, [](int n) { return inproj_phys(n); }, scr, F.lane);
            else transpose_item_fp8(a.in[1] + (size_t)l * 1024 * INC, INC, (unsigned char*)(F.ws + WS_WIN8) + (size_t)l * 3072 * 1024, 1024, kb * 64, nb * 32, [](int n) { return n - 3072; }, scr, F.lane, 32.f);
            continue; }
        r -= 3072;
        if (r < 128) { const int kb = r / 32, nb = r % 32;
            transpose_item(a.in[3] + (size_t)l * 256 * 1024, 1024, (bf16*)(F.ws + WS_WPROJ) + (size_t)l * 1024 * WPK + 0, WPK, kb * 64, nb * 32, [](int n) { return n; }, scr, F.lane); continue; }
        r -= 128;
        if (r < 64) { const int kb = r / 32, nb = r % 32;
            transpose_item(a.in[4] + (size_t)l * 128 * 1024, 1024, (bf16*)(F.ws + WS_WPROJ) + (size_t)l * 1024 * WPK + 256, WPK, kb * 64, nb * 32, [](int n) { return n; }, scr, F.lane); continue; }
        r -= 64;
        if (r < 192) { const int kb = r / 32, nb = r % 32;
            transpose_item(a.in[5] + (size_t)l * 384 * 1024, 1024, (bf16*)(F.ws + WS_WPROJ) + (size_t)l * 1024 * WPK + 512, WPK, kb * 64, nb * 32, [](int n) { return n; }, scr, F.lane); continue; }
        r -= 192;
        if (r < 512) { const int kb = r / 32, nb = r % 32;
            transpose_item(a.in[6] + (size_t)l * 1024 * 1024, 1024, (bf16*)(F.ws + WS_WOUT) + (size_t)l * 1024 * 1024, 1024, kb * 64, nb * 32, [](int n) { return n; }, scr, F.lane); continue; }
        r -= 512;
        { const int e = r / 1536, r2 = r % 1536, mtx = r2 / 512, r3 = r2 % 512, kb = r3 / 32, nb = r3 % 32;
          const size_t eoff = ((size_t)l * NEXP + e) * 1024 * 1024;
          if (mtx == 0) transpose_item_fp8(a.in[14] + eoff, 1024, (unsigned char*)(F.ws + WS_WGU) + 2 * eoff, 1024, kb * 64, nb * 32, [](int n) { return (n >> 7) * 256 + (n & 127); }, scr, F.lane, 32.f);
          else if (mtx == 1) transpose_item_fp8(a.in[16] + eoff, 1024, (unsigned char*)(F.ws + WS_WGU) + 2 * eoff, 1024, kb * 64, nb * 32, [](int n) { return (n >> 7) * 256 + 128 + (n & 127); }, scr, F.lane, 32.f);
          else transpose_item_fp8(a.in[18] + eoff, 1024, (unsigned char*)(F.ws + WS_WDN) + eoff, 1024, kb * 64, nb * 32, [](int n) { return n; }, scr, F.lane, 64.f); }
    }
    { const int gt = F.bid * 512 + F.tid, NT = F.G * 512;
      for (int i = gt; i < DEPTH * 1024 * 16; i += NT) { const int row = i >> 4, ch = i & 15;
          *(v4u*)((bf16*)(F.ws + WS_WPROJ) + (size_t)row * WPK + 384 + ch * 8) = (v4u){0u, 0u, 0u, 0u}; }
      for (int i = gt; i < SEQ * 32; i += NT) { const int pos = i >> 5, j = i & 31;
          const float inv = 1.0f / powf(10000.0f, (float)(2 * j) / 64.0f); const float ang = (float)pos * inv; float s, c; sincosf(ang, &s, &c);
          ((f32x2*)(F.ws + WS_ROPE64))[i] = (f32x2){c, s}; }
      for (int i = gt; i < SEQ * 24; i += NT) { const int pos = i / 24, j = i - pos * 24;
          const float inv = 1.0f / powf(10000.0f, (float)(2 * j) / 48.0f); const float ang = (float)pos * inv; float s, c; sincosf(ang, &s, &c);
          ((f32x2*)(F.ws + WS_ROPE48))[i] = (f32x2){c, s}; }
      for (int i = gt; i < DEPTH * 32 * 1024; i += NT) { const int l = i >> 15, e = (i >> 10) & 31, k = i & 1023;
          const float wv = a.in[12][((size_t)l * 1024 + k) * 32 + e]; const unsigned hi = f2bf(wv); const unsigned lo = f2bf(wv - __uint_as_float(hi << 16));
          bf16* wt = (bf16*)(F.ws + WS_WRT) + (size_t)l * 2 * 32 * 1024; wt[e * 1024 + k] = (bf16)hi; wt[32 * 1024 + e * 1024 + k] = (bf16)lo; }
      const f32x4* x4 = (const f32x4*)a.in[0]; v2u* xb = (v2u*)(F.ws + WS_XB);
      unsigned* xb8 = (unsigned*)(F.ws + WS_XB8);
      for (int i = gt; i < NTOK * 256; i += NT) { const f32x4 v = x4[i]; xb[i] = (v2u){pk2(v[0], v[1]), pk2(v[2], v[3])}; xb8[i] = pk4_fp8(v[0], v[1], v[2], v[3], 1.0f); }
    }
}

typedef float f32x16 __attribute__((ext_vector_type(16)));
typedef short s16x4 __attribute__((ext_vector_type(4)));
typedef float f32x2_t __attribute__((ext_vector_type(2)));
typedef __bf16 bf16x2_t __attribute__((ext_vector_type(2)));
__device__ __forceinline__ unsigned cvtpk(float lo, float hi) { const f32x2_t v = {lo, hi}; const bf16x2_t b = __builtin_convertvector(v, bf16x2_t); return __builtin_bit_cast(unsigned, b); }
__device__ __forceinline__ int kperm(int r) { return (r & ~12) | ((r & 4) << 1) | ((r & 8) >> 1); }
__device__ __forceinline__ s16x4 ds_tr16(const LAS unsigned char* p) { return __builtin_bit_cast(s16x4, __builtin_amdgcn_ds_read_tr16_b64_v4i16((LAS s16x4*)p)); }

__device__ __forceinline__ float fmax_nc(float a, float b) { return __builtin_amdgcn_fmed3f(a, b, __builtin_inff()); }
__device__ __forceinline__ void glds16(const void* gsrc, unsigned lds_dst) { unsigned keep;
    asm volatile("s_mov_b32 %0, m0\n\ts_mov_b32 m0, %2\n\ts_nop 0\n\tglobal_load_lds_dwordx4 %1, off\n\ts_mov_b32 m0, %0" : "=&s"(keep) : "v"(gsrc), "s"(lds_dst) : "memory"); }
__device__ __forceinline__ void attnC_pipe(Frame& F, const float* lamv, const float* ng, float lam_init) {
    const bf16* H = (const bf16*)(F.ws + WS_H); bf16* Y = (bf16*)(F.ws + WS_Y);
    const int lane = F.lane, w = F.wave, n = lane & 31, hh = lane >> 5;
    float l01 = 0.f, l23 = 0.f;
    if (lane < 48) { l01 = lamv[lane] * lamv[48 + lane]; l23 = lamv[96 + lane] * lamv[144 + lane]; }
    l01 = wave_sum(l01); l23 = wave_sum(l23);
    const float lam = expf(l01) - expf(l23) + lam_init;
    const float post = 1.0f - lam_init;
    constexpr int KST = 208, VST = 192, KBYTES = 64 * KST, STAGE = KBYTES + 64 * VST, NT = SEQ / 64;
    constexpr float CS = 0.14433756729740643f * 1.4426950408889634f;
    constexpr float PMAX = 256.0f;
    unsigned goff[4], loff[4];
#pragma unroll
    for (int j = 0; j < 4; ++j) { const int I = w + 8 * j;
        if (I < 13) { const int cid = I * 64 + lane, row = cid / 13; int col = cid - row * 13; if (col == 12) col = 0;
            goff[j] = (unsigned)(row * INC + C_KC + col * 8) * 2u; loff[j] = (unsigned)(I * 1024); }
        else { const int cid = (I - 13) * 64 + lane, row = cid / 12, col = cid - row * 12;
            goff[j] = (unsigned)(row * INC + C_VC + col * 8) * 2u; loff[j] = (unsigned)(KBYTES + (I - 13) * 1024); } }
    const int koff = kperm(n) * KST + hh * 16;
    const int g = lane >> 4, i16 = lane & 15;
    const int voff = KBYTES + (8 * (g >> 1) + (i16 >> 2)) * VST + (16 * (g & 1) + 4 * (i16 & 3)) * 2;
#define C_ISSUE(tt) do { const char* gb_ = gbase + (size_t)(tt) * (64 * INC * 2); const int so_ = ((tt) & 3) * STAGE; _Pragma("unroll") for (int j_ = 0; j_ < 4; ++j_) if (w + 8 * j_ < 25) \
        glds16(gb_ + goff[j_], (unsigned)__builtin_amdgcn_readfirstlane((int)(unsigned)(size_t)(F.lds + so_ + loff[j_]))); } while (0)
#define C_RDV(slotV, kbV, s2v) do { _Pragma("unroll") for (int d_ = 0; d_ < 3; ++d_) { const LAS unsigned char* vp_ = (slotV) + voff + ((kbV) * 32 + 16 * (s2v)) * VST + d_ * 64; \
            const s16x4 v0_ = ds_tr16(vp_), v1_ = ds_tr16(vp_ + 4 * VST); vf[d_] = (bf16x8){v0_[0], v0_[1], v0_[2], v0_[3], v1_[0], v1_[1], v1_[2], v1_[3]}; } } while (0)
#define C_FENCE __builtin_amdgcn_sched_barrier(0)
#define C_QK0(dst, slotbase) do { { const bf16x8 kf_ = *(const LAS bf16x8*)((slotbase) + koff); dst = __builtin_amdgcn_mfma_f32_32x32x16_bf16(kf_, qf[0][0], NEGR[0], 0, 0, 0); } \
        _Pragma("unroll") for (int s_ = 1; s_ < 3; ++s_) { const bf16x8 kf_ = *(const LAS bf16x8*)((slotbase) + koff + (2 * s_) * 16); dst = __builtin_amdgcn_mfma_f32_32x32x16_bf16(kf_, qf[0][s_], dst, 0, 0, 0); } } while (0)
#define C_ITEM(Sx, c, pout, pin, cp, slotVp, kbVp, slotKc, kbKc, slotKn, kbKn, cn) do { \
        _Pragma("unroll") for (int s2_ = 0; s2_ < 2; ++s2_) _Pragma("unroll") for (int d_ = 0; d_ < 3; ++d_) { const LAS unsigned char* vp_ = (slotVp) + voff + ((kbVp) * 32 + 16 * s2_) * VST + d_ * 64; \
            const s16x4 v0_ = ds_tr16(vp_), v1_ = ds_tr16(vp_ + 4 * VST); vf[s2_ * 3 + d_] = (bf16x8){v0_[0], v0_[1], v0_[2], v0_[3], v1_[0], v1_[1], v1_[2], v1_[3]}; } \
        _Pragma("unroll") for (int s_ = 0; s_ < 3; ++s_) kf[s_] = *(const LAS bf16x8*)((slotKn) + (kbKn) * 32 * KST + koff + ((cn) * 6 + 2 * s_) * 16); \
        C_FENCE; \
        const float lold_ = l[c]; \
        _Pragma("unroll") for (int r_ = 0; r_ < 16; ++r_) Sx[r_] = __builtin_amdgcn_exp2f(Sx[r_]); \
        float pm_ = fmaxf(fmaxf(Sx[0], Sx[1]), Sx[2]); _Pragma("unroll") for (int r_ = 3; r_ < 15; r_ += 2) pm_ = fmaxf(fmaxf(pm_, Sx[r_]), Sx[r_ + 1]); pm_ = fmaxf(pm_, Sx[15]); \
        _Pragma("unroll") for (int r_ = 0; r_ < 16; ++r_) l[c] += Sx[r_]; \
        _Pragma("unroll") for (int s2_ = 0; s2_ < 2; ++s2_) { v4u pw_; pw_.x = cvtpk(Sx[8 * s2_ + 0], Sx[8 * s2_ + 1]); pw_.y = cvtpk(Sx[8 * s2_ + 2], Sx[8 * s2_ + 3]); \
            pw_.z = cvtpk(Sx[8 * s2_ + 4], Sx[8 * s2_ + 5]); pw_.w = cvtpk(Sx[8 * s2_ + 6], Sx[8 * s2_ + 7]); pout[s2_] = __builtin_bit_cast(bf16x8, pw_); } \
        _Pragma("unroll") for (int s2_ = 0; s2_ < 2; ++s2_) _Pragma("unroll") for (int d_ = 0; d_ < 3; ++d_) O[cp][d_] = __builtin_amdgcn_mfma_f32_32x32x16_bf16(vf[s2_ * 3 + d_], pin[s2_], O[cp][d_], 0, 0, 0); \
        _Pragma("unroll") for (int g_ = 0; g_ < 6; ++g_) { __builtin_amdgcn_sched_group_barrier(0x008, 1, 0); __builtin_amdgcn_sched_group_barrier(0x400, 3, 0); __builtin_amdgcn_sched_group_barrier(0x002, 7, 0); } \
        C_FENCE; \
        pm_ = fmaxf(pm_, __shfl_xor(pm_, 32)); \
        if (__any(pm_ > PMAX) || first) { f32x16 Sr_; \
            { const bf16x8 k0_ = *(const LAS bf16x8*)((slotKc) + (kbKc) * 32 * KST + koff + ((c) * 6 + 0) * 16), k1_ = *(const LAS bf16x8*)((slotKc) + (kbKc) * 32 * KST + koff + ((c) * 6 + 2) * 16), k2_ = *(const LAS bf16x8*)((slotKc) + (kbKc) * 32 * KST + koff + ((c) * 6 + 4) * 16); \
              Sr_ = __builtin_amdgcn_mfma_f32_32x32x16_bf16(k0_, qf[c][0], NEGR[c], 0, 0, 0); Sr_ = __builtin_amdgcn_mfma_f32_32x32x16_bf16(k1_, qf[c][1], Sr_, 0, 0, 0); Sr_ = __builtin_amdgcn_mfma_f32_32x32x16_bf16(k2_, qf[c][2], Sr_, 0, 0, 0); } \
            float mx_ = fmax_nc(Sr_[0], Sr_[1]); _Pragma("unroll") for (int r_ = 2; r_ < 16; ++r_) mx_ = fmax_nc(mx_, Sr_[r_]); mx_ = fmaxf(mx_, __shfl_xor(mx_, 32)); \
            const float dl_ = (pm_ > PMAX || first) ? mx_ : 0.0f, al_ = __builtin_amdgcn_exp2f(-dl_); \
            _Pragma("unroll") for (int d_ = 0; d_ < 3; ++d_) _Pragma("unroll") for (int r_ = 0; r_ < 16; ++r_) O[c][d_][r_] *= al_; \
            float ls_ = lold_ * al_; \
            _Pragma("unroll") for (int r_ = 0; r_ < 16; ++r_) { NEGR[c][r_] -= dl_; Sr_[r_] = __builtin_amdgcn_exp2f(Sr_[r_] - dl_); ls_ += Sr_[r_]; } \
            l[c] = ls_; \
            _Pragma("unroll") for (int s2_ = 0; s2_ < 2; ++s2_) { v4u pw_; pw_.x = cvtpk(Sr_[8 * s2_ + 0], Sr_[8 * s2_ + 1]); pw_.y = cvtpk(Sr_[8 * s2_ + 2], Sr_[8 * s2_ + 3]); \
                pw_.z = cvtpk(Sr_[8 * s2_ + 4], Sr_[8 * s2_ + 5]); pw_.w = cvtpk(Sr_[8 * s2_ + 6], Sr_[8 * s2_ + 7]); pout[s2_] = __builtin_bit_cast(bf16x8, pw_); } } \
        C_FENCE; \
        Sx = __builtin_amdgcn_mfma_f32_32x32x16_bf16(kf[0], qf[cn][0], NEGR[cn], 0, 0, 0); Sx = __builtin_amdgcn_mfma_f32_32x32x16_bf16(kf[1], qf[cn][1], Sx, 0, 0, 0); Sx = __builtin_amdgcn_mfma_f32_32x32x16_bf16(kf[2], qf[cn][2], Sx, 0, 0, 0); \
        C_FENCE; } while (0)
    for (int unit = F.bid; unit < 512; unit += F.G) {
        const int b = unit >> 6, h = (unit >> 4) & 3, qb = unit & 15;
        const int tok = b * SEQ + qb * 256 + w * 32 + n;
        const char* gbase = (const char*)(H + (size_t)(b * SEQ) * INC + h * 96);
        C_ISSUE(0); C_ISSUE(1);
        bf16x8 qf[2][3];
        { const bf16* qp = H + (size_t)tok * INC + C_QC + h * 96 + 8 * hh;
#pragma unroll
          for (int c = 0; c < 2; ++c)
#pragma unroll
              for (int s = 0; s < 3; ++s) { const v4u qw = *(const v4u*)(qp + c * 48 + 16 * s);
                  v4u qs; qs.x = cvtpk(bflo(qw.x) * CS, bfhi(qw.x) * CS); qs.y = cvtpk(bflo(qw.y) * CS, bfhi(qw.y) * CS); qs.z = cvtpk(bflo(qw.z) * CS, bfhi(qw.z) * CS); qs.w = cvtpk(bflo(qw.w) * CS, bfhi(qw.w) * CS);
                  qf[c][s] = __builtin_bit_cast(bf16x8, qs); } }
        f32x16 O[2][3];
#pragma unroll
        for (int c = 0; c < 2; ++c)
#pragma unroll
            for (int d = 0; d < 3; ++d)
#pragma unroll
                for (int r = 0; r < 16; ++r) O[c][d][r] = 0.f;
        float l[2] = {0.f, 0.f};
        f32x16 NEGR[2];
#pragma unroll
        for (int c = 0; c < 2; ++c)
#pragma unroll
            for (int r = 0; r < 16; ++r) NEGR[c][r] = 0.f;
        f32x16 S; bf16x8 pa[2], pb[2], kf[3], vf[6];
        pb[0] = (bf16x8){0, 0, 0, 0, 0, 0, 0, 0}; pb[1] = pb[0];
        for (int t = 0; t < NT; ++t) {
            asm volatile("s_waitcnt vmcnt(0)" ::: "memory"); __builtin_amdgcn_s_barrier(); asm volatile("" ::: "memory");
            if (t + 2 < NT) C_ISSUE(t + 2);
            const LAS unsigned char* cur = F.lds + (t & 3) * STAGE;
            const LAS unsigned char* prv = F.lds + ((t > 0 ? t - 1 : 0) & 3) * STAGE;
            const LAS unsigned char* nxt = F.lds + ((t + 1 < NT ? t + 1 : t) & 3) * STAGE;
            if (t == 0) C_QK0(S, cur);
            { const bool first = (t == 0);
            C_ITEM(S, 0, pa, pb, 1, prv, 1, cur, 0, cur, 0, 1);
            C_ITEM(S, 1, pb, pa, 0, cur, 0, cur, 0, cur, 1, 0); }
            { const bool first = false;
            C_ITEM(S, 0, pa, pb, 1, cur, 0, cur, 1, cur, 1, 1);
            C_ITEM(S, 1, pb, pa, 0, cur, 1, cur, 1, nxt, 0, 0); }
        }
        { const LAS unsigned char* lastb = F.lds + ((NT - 1) & 3) * STAGE;
#pragma unroll
          for (int s2 = 0; s2 < 2; ++s2)
#pragma unroll
              for (int d = 0; d < 3; ++d) { const LAS unsigned char* vp = lastb + voff + (32 + 16 * s2) * VST + d * 64; const s16x4 v0 = ds_tr16(vp), v1 = ds_tr16(vp + 4 * VST);
                  const bf16x8 vfl = (bf16x8){v0[0], v0[1], v0[2], v0[3], v1[0], v1[1], v1[2], v1[3]}; O[1][d] = __builtin_amdgcn_mfma_f32_32x32x16_bf16(vfl, pb[s2], O[1][d], 0, 0, 0); } }
        const float l0 = l[0] + __shfl_xor(l[0], 32), l1 = l[1] + __shfl_xor(l[1], 32);
        const float i0 = 1.0f / l0, i1 = lam / l1;
        float ss = 0.f;
#pragma unroll
        for (int d = 0; d < 3; ++d)
#pragma unroll
            for (int r = 0; r < 16; ++r) { const float o = O[0][d][r] * i0 - O[1][d][r] * i1; O[0][d][r] = o; ss += o * o; }
        ss += __shfl_xor(ss, 32);
        const float rs = rsqrtf(ss * (1.0f / 96.0f) + LN_EPS) * post;
        bf16* yp = Y + (size_t)tok * YLD + Y_C + h * 96 + 4 * hh;
#pragma unroll
        for (int d = 0; d < 3; ++d)
#pragma unroll
            for (int rg = 0; rg < 4; ++rg) { const f32x4 gv = *(const f32x4*)(ng + d * 32 + 8 * rg + 4 * hh);
                v2u o; o.x = pk2(O[0][d][4 * rg + 0] * rs * gv[0], O[0][d][4 * rg + 1] * rs * gv[1]); o.y = pk2(O[0][d][4 * rg + 2] * rs * gv[2], O[0][d][4 * rg + 3] * rs * gv[3]);
                *(v2u*)(yp + d * 32 + 8 * rg) = o; }
        asm volatile("s_waitcnt vmcnt(0)" ::: "memory"); __builtin_amdgcn_s_barrier(); asm volatile("" ::: "memory");
    }
#undef C_ISSUE
#undef C_RDV
#undef C_ITEM
#undef C_QK0
#undef C_FENCE
}

constexpr int AB_VST = 192, AB_VREG = 32 * AB_VST;
constexpr int L_RPB = 51200;

__device__ __forceinline__ void sm_block64(f32x16& t, float& m, float& l, f32x16 (&O)[2], bf16x8 (&pf)[2]) {
    float mx = fmaxf(t[0], t[1]);
#pragma unroll
    for (int r = 2; r < 16; ++r) mx = fmaxf(mx, t[r]);
    mx = fmaxf(mx, __shfl_xor(mx, 32));
    if (__any(mx > m)) {
        const float mn = fmaxf(m, mx), alpha = __builtin_amdgcn_exp2f(m - mn);
#pragma unroll
        for (int d = 0; d < 2; ++d)
#pragma unroll
            for (int r = 0; r < 16; ++r) O[d][r] *= alpha;
        l *= alpha; m = mn;
    }
#pragma unroll
    for (int r = 0; r < 16; ++r) { t[r] = __builtin_amdgcn_exp2f(t[r] - m); l += t[r]; }
#pragma unroll
    for (int s2 = 0; s2 < 2; ++s2) { v4u pw; pw.x = cvtpk(t[8 * s2 + 0], t[8 * s2 + 1]); pw.y = cvtpk(t[8 * s2 + 2], t[8 * s2 + 3]);
        pw.z = cvtpk(t[8 * s2 + 4], t[8 * s2 + 5]); pw.w = cvtpk(t[8 * s2 + 6], t[8 * s2 + 7]); pf[s2] = __builtin_bit_cast(bf16x8, pw); }
}
template <class TokOf, class MaskT>
__device__ __forceinline__ void attn_run_blocks(const bf16* H, const int kcol, const int vcol, const int nb, const TokOf tok_of, const MaskT mask,
                                                const bf16x8 (&qf)[4], LAS unsigned char* vl, const int lane, f32x16 (&O)[2], float& m, float& l) {
    const int n = lane & 31, hh = lane >> 5, krow = kperm(n), g = lane >> 4, i16 = lane & 15;
    const int vrd = (8 * (g >> 1) + (i16 >> 2)) * AB_VST + (16 * (g & 1) + 4 * (i16 & 3)) * 2;
    bf16x8 kf[4]; v4u vc[4];
    { const bf16* kp = H + (size_t)tok_of(0, krow) * INC + kcol + 8 * hh;
#pragma unroll
      for (int s = 0; s < 4; ++s) kf[s] = *(const bf16x8*)(kp + 16 * s);
#pragma unroll
      for (int i = 0; i < 4; ++i) vc[i] = *(const v4u*)(H + (size_t)tok_of(0, (lane >> 3) + 8 * i) * INC + vcol + (lane & 7) * 8); }
#pragma unroll
    for (int i = 0; i < 4; ++i) *(LAS v4u*)(vl + ((lane >> 3) + 8 * i) * AB_VST + (lane & 7) * 16) = vc[i];
    for (int j = 0; j < nb; ++j) {
        const int jn = (j + 1 < nb) ? j + 1 : j;
        bf16x8 kn[4];
        { const bf16* kp = H + (size_t)tok_of(jn, krow) * INC + kcol + 8 * hh;
#pragma unroll
          for (int s = 0; s < 4; ++s) kn[s] = *(const bf16x8*)(kp + 16 * s);
#pragma unroll
          for (int i = 0; i < 4; ++i) vc[i] = *(const v4u*)(H + (size_t)tok_of(jn, (lane >> 3) + 8 * i) * INC + vcol + (lane & 7) * 8); }
        f32x16 S;
#pragma unroll
        for (int r = 0; r < 16; ++r) S[r] = 0.f;
#pragma unroll
        for (int s = 0; s < 4; ++s) S = __builtin_amdgcn_mfma_f32_32x32x16_bf16(kf[s], qf[s], S, 0, 0, 0);
        mask(j, S);
        bf16x8 pf[2];
        sm_block64(S, m, l, O, pf);
        LDS_WAIT();
#pragma unroll
        for (int s2 = 0; s2 < 2; ++s2)
#pragma unroll
            for (int d = 0; d < 2; ++d) { const LAS unsigned char* vp = vl + vrd + 16 * s2 * AB_VST + d * 64;
                const s16x4 v0 = ds_tr16(vp), v1 = ds_tr16(vp + 4 * AB_VST);
                const bf16x8 vf = (bf16x8){v0[0], v0[1], v0[2], v0[3], v1[0], v1[1], v1[2], v1[3]};
                O[d] = __builtin_amdgcn_mfma_f32_32x32x16_bf16(vf, pf[s2], O[d], 0, 0, 0); }
        LDS_WAIT(); asm volatile("" ::: "memory");
#pragma unroll
        for (int i = 0; i < 4; ++i) *(LAS v4u*)(vl + ((lane >> 3) + 8 * i) * AB_VST + (lane & 7) * 16) = vc[i];
#pragma unroll
        for (int s = 0; s < 4; ++s) kf[s] = kn[s];
    }
    LDS_WAIT(); asm volatile("" ::: "memory");
}
__device__ __forceinline__ void attn_store64(bf16* yrow, const f32x16 (&O)[2], float l, int hh) {
    const float lt = l + __shfl_xor(l, 32), inv = 1.0f / lt;
#pragma unroll
    for (int d = 0; d < 2; ++d)
#pragma unroll
        for (int rg = 0; rg < 4; ++rg) { v2u o; o.x = pk2(O[d][4 * rg + 0] * inv, O[d][4 * rg + 1] * inv); o.y = pk2(O[d][4 * rg + 2] * inv, O[d][4 * rg + 3] * inv);
            *(v2u*)(yrow + d * 32 + 8 * rg + 4 * hh) = o; }
}

__device__ __forceinline__ void attnA_mfma(Frame& F, const float* rpb  ) {
    const bf16* H = (const bf16*)(F.ws + WS_H); bf16* Y = (bf16*)(F.ws + WS_Y);
    LAS float* T = (LAS float*)(F.lds + L_RPB);
    for (int i = F.tid; i < 4 * 17 * 64; i += 512) { const int h = i / (17 * 64), rem = i - h * 17 * 64, ro = rem >> 6, co = rem & 63;
        const int rr = ro - 1, cc = co - 16; T[i] = (rr >= 0 && rr < 15 && cc >= 0 && cc < 31) ? rpb[(h * 15 + rr) * 31 + cc] * 1.4426950408889634f : 0.f; }
    __syncthreads();
    const int lane = F.lane, n = lane & 31, hh = lane >> 5;
    LAS unsigned char* vl = F.lds + F.wave * AB_VREG;
    const int gw = F.bid * 8 + F.wave, NGW = F.G * 8;
    for (int item = gw; item < 4096; item += NGW) {
        const int cb = item & 3, rp = (item >> 2) & 31, h = (item >> 7) & 3, b = item >> 9;
        const int r = 2 * rp + (n >> 4), c = 16 * cb + (n & 15);
        const int r0 = min(max(r - 4, 0), 56), c0 = min(max(c - 8, 0), 48);
        const int cw = min(max(16 * cb - 8, 0), 32);
        const int kr_lo = min(max(2 * rp - 4, 0), 56), kr_hi = min(max(2 * rp + 1 - 4, 0), 56) + 7;
        const int tokq = b * SEQ + r * 64 + c;
        bf16x8 qf[4];
        { const bf16* qp = H + (size_t)tokq * INC + C_QA + h * 64 + 8 * hh;
#pragma unroll
          for (int s = 0; s < 4; ++s) qf[s] = *(const bf16x8*)(qp + 16 * s); }
        f32x16 O[2];
#pragma unroll
        for (int d = 0; d < 2; ++d)
#pragma unroll
            for (int rr = 0; rr < 16; ++rr) O[d][rr] = 0.f;
        float m = -1e30f, l = 0.f;
        const int tok0 = b * SEQ + kr_lo * 64 + cw;
        auto tok_of = [=](int j, int kk) { return tok0 + j * 64 + kk; };
        const int colb = cw - c0 + 8 * hh;
        const int tb0 = (h * 17 + (kr_lo - r + 8)) * 64 + (cw - c + 31) + 8 * hh;
        const int rb = kr_lo - r0;
        auto mask = [=](int j, f32x16& S) {
            const bool rowok = (unsigned)(rb + j) < 8u; const LAS float* tp = T + tb0 + j * 64;
#pragma unroll
            for (int rr = 0; rr < 16; ++rr) { const int e = (rr & 7) + 16 * (rr >> 3);
                const bool ok = rowok && ((unsigned)(colb + e) < 16u);
                S[rr] = ok ? (S[rr] * (0.125f * 1.4426950408889634f) + tp[e]) : -INFINITY; }
        };
        attn_run_blocks(H, C_KA + h * 64, C_VA + h * 64, kr_hi - kr_lo + 1, tok_of, mask, qf, vl, lane, O, m, l);
        attn_store64(Y + (size_t)tokq * YLD + Y_A + h * 64, O, l, hh);
    }
}
__device__ __forceinline__ void attnB_mfma(Frame& F) {
    const bf16* H = (const bf16*)(F.ws + WS_H); bf16* Y = (bf16*)(F.ws + WS_Y);
    const int lane = F.lane, n = lane & 31, hh = lane >> 5;
    LAS unsigned char* vl = F.lds + F.wave * AB_VREG;
    const int gw = F.bid * 8 + F.wave, NGW = F.G * 8;
    for (int item = gw; item < 2048; item += NGW) {
        const int mblk = item & 7, r = (item >> 3) & 15, hg = (item >> 7) & 1, b = item >> 8;
        const int sq = r + 16 * (mblk * 32 + n), tokq = b * SEQ + sq;
        f32x16 O[2];
#pragma unroll
        for (int d = 0; d < 2; ++d)
#pragma unroll
            for (int rr = 0; rr < 16; ++rr) O[d][rr] = 0.f;
        float m = -1e30f, l = 0.f;
#pragma unroll 1
        for (int g = 0; g < 3; ++g) {
            const int sh = 2 * g, dil = 1 << sh, head = 2 * g + hg, L = SEQ >> sh, a = 16 >> sh, cls = r & (dil - 1);
            const int pq0 = (r >> sh) + a * (mblk * 32), pq = pq0 + a * n;
            const int pks = pq0 - 64, nb = (31 * a + 129 + 31) >> 5;
            bf16x8 qf[4];
            { const bf16* qp = H + (size_t)tokq * INC + C_QB + head * 64 + 8 * hh;
#pragma unroll
              for (int s = 0; s < 4; ++s) qf[s] = *(const bf16x8*)(qp + 16 * s); }
            const int tokb = b * SEQ + cls;
            auto tok_of = [=](int j, int kk) { const int pk = min(max(pks + 32 * j + kk, 0), L - 1); return tokb + (pk << sh); };
            const int b1 = pks - pq + 64 + 8 * hh, b2 = pks + 8 * hh;
            auto mask = [=](int j, f32x16& S) {
#pragma unroll
                for (int rr = 0; rr < 16; ++rr) { const int e = (rr & 7) + 16 * (rr >> 3) + 32 * j;
                    const bool ok = ((unsigned)(b1 + e) <= 128u) && ((unsigned)(b2 + e) < (unsigned)L);
                    S[rr] = ok ? S[rr] * (0.125f * 1.4426950408889634f) : -INFINITY; }
            };
            attn_run_blocks(H, C_KB + head * 64, C_VB + head * 64, nb, tok_of, mask, qf, vl, lane, O, m, l);
        }
        attn_store64(Y + (size_t)tokq * YLD + Y_B + hg * 64, O, l, hh);
    }
}

__device__ __forceinline__ void p_ln_router(Frame& F, const Args& a, int layer, bool dry = false) {
    const float* PRE = (const float*)(F.ws + WS_HH); float* XF = dry ? (float*)(F.ws + WS_H) : a.out; unsigned* XB8 = dry ? (unsigned*)(F.ws + WS_H + 160 * MiB) : (unsigned*)(F.ws + WS_XB8);
    const float* g1 = a.in[10] + layer * 1024; const float* b1 = a.in[11] + layer * 1024; const float* br = a.in[13] + layer * 32;
    const bf16* WT = (const bf16*)(F.ws + WS_WRT) + (size_t)layer * 2 * 32 * 1024;
    int* TOPE = (int*)(F.ws + (dry ? WS_H + 200 * MiB : WS_TOPE)); float* TOPW = (float*)(F.ws + (dry ? WS_H + 201 * MiB : WS_TOPW)); int* RANK = (int*)(F.ws + (dry ? WS_H + 202 * MiB : WS_RANK));
    const int cnt_off = dry ? CW_CUR : CW_CNT; int* SRCp = (int*)(F.ws + (dry ? WS_H + 204 * MiB : WS_SRC));
    LAS int* hist = (LAS int*)(F.lds + L_HIST); LAS int* base = (LAS int*)(F.lds + L_BASE);
    const int lane = F.lane;
    for (int chunk = F.bid; chunk < NTOK / 128; chunk += F.G) {
        if (F.tid < 32) hist[F.tid] = 0;
        __syncthreads();
        const int tok0 = chunk * 128 + F.wave * 16;
        {   f32x4 gv[4], bv[4];
#pragma unroll
            for (int j = 0; j < 4; ++j) { gv[j] = *(const f32x4*)(g1 + 4 * lane + 256 * j); bv[j] = *(const f32x4*)(b1 + 4 * lane + 256 * j); }
#pragma unroll 1
            for (int q = 0; q < 4; ++q) {
                f32x4 v[4][4]; float s[4], s2[4];
#pragma unroll
                for (int t = 0; t < 4; ++t) { const f32x4* pr = (const f32x4*)(PRE + (size_t)(tok0 + 4 * q + t) * 1024) + lane;
#pragma unroll
                    for (int j = 0; j < 4; ++j) v[t][j] = pr[64 * j]; }
#pragma unroll
                for (int t = 0; t < 4; ++t) { s[t] = 0.f;
#pragma unroll
                    for (int j = 0; j < 4; ++j) s[t] += (v[t][j][0] + v[t][j][1]) + (v[t][j][2] + v[t][j][3]); }
#pragma unroll
                for (int o = 1; o < 64; o <<= 1) {
#pragma unroll
                    for (int t = 0; t < 4; ++t) s[t] += __shfl_xor(s[t], o); }
#pragma unroll
                for (int t = 0; t < 4; ++t) { const float mean = s[t] * (1.f / 1024.f); s2[t] = 0.f;
#pragma unroll
                    for (int j = 0; j < 4; ++j) { v[t][j] = v[t][j] - mean; s2[t] += (v[t][j][0] * v[t][j][0] + v[t][j][1] * v[t][j][1]) + (v[t][j][2] * v[t][j][2] + v[t][j][3] * v[t][j][3]); } }
#pragma unroll
                for (int o = 1; o < 64; o <<= 1) {
#pragma unroll
                    for (int t = 0; t < 4; ++t) s2[t] += __shfl_xor(s2[t], o); }
#pragma unroll
                for (int t = 0; t < 4; ++t) { const float rstd = rsqrtf(s2[t] * (1.f / 1024.f) + LN_EPS);
                    f32x4* xo = (f32x4*)(XF + (size_t)(tok0 + 4 * q + t) * 1024) + lane; unsigned* xb = XB8 + (size_t)(tok0 + 4 * q + t) * 256 + lane;
#pragma unroll
                    for (int j = 0; j < 4; ++j) { const f32x4 y = v[t][j] * rstd * gv[j] + bv[j]; xo[64 * j] = y; xb[64 * j] = pk4_fp8(y[0], y[1], y[2], y[3], 1.0f); } }
            }
        }
        VM_WAIT(); asm volatile("" ::: "memory");
        const int tk = lane & 15, kq = lane >> 4;
        f32x4 acc[2] = {(f32x4){0.f, 0.f, 0.f, 0.f}, (f32x4){0.f, 0.f, 0.f, 0.f}};
        {   const float* xf = XF + (size_t)(tok0 + tk) * 1024 + 8 * kq;
            const bf16* w0 = WT + (size_t)tk * 1024 + 8 * kq;
#pragma unroll 4
            for (int st = 0; st < 32; ++st) {
                const f32x4 x0 = *(const f32x4*)(xf + 32 * st), x1 = *(const f32x4*)(xf + 32 * st + 4);
                v4u xhw; xhw.x = pk2(x0[0], x0[1]); xhw.y = pk2(x0[2], x0[3]); xhw.z = pk2(x1[0], x1[1]); xhw.w = pk2(x1[2], x1[3]);
                v4u xlw; xlw.x = pk2(x0[0] - bflo(xhw.x), x0[1] - bfhi(xhw.x)); xlw.y = pk2(x0[2] - bflo(xhw.y), x0[3] - bfhi(xhw.y));
                xlw.z = pk2(x1[0] - bflo(xhw.z), x1[1] - bfhi(xhw.z)); xlw.w = pk2(x1[2] - bflo(xhw.w), x1[3] - bfhi(xhw.w));
                const bf16x8 xh = __builtin_bit_cast(bf16x8, xhw), xl = __builtin_bit_cast(bf16x8, xlw);
#pragma unroll
                for (int mb = 0; mb < 2; ++mb) { const bf16x8 wh = *(const bf16x8*)(w0 + (size_t)mb * 16 * 1024 + 32 * st), wl = *(const bf16x8*)(w0 + (size_t)(32 + mb * 16) * 1024 + 32 * st);
                    acc[mb] = __builtin_amdgcn_mfma_f32_16x16x32_bf16(wh, xh, acc[mb], 0, 0, 0);
                    acc[mb] = __builtin_amdgcn_mfma_f32_16x16x32_bf16(wh, xl, acc[mb], 0, 0, 0);
                    acc[mb] = __builtin_amdgcn_mfma_f32_16x16x32_bf16(wl, xh, acc[mb], 0, 0, 0); }
            }
        }
        float v8[8];
#pragma unroll
        for (int mb = 0; mb < 2; ++mb)
#pragma unroll
            for (int i = 0; i < 4; ++i) v8[mb * 4 + i] = acc[mb][i] + br[16 * mb + 4 * kq + i];
        int se[4]; float sv[4];
#pragma unroll
        for (int r = 0; r < 4; ++r) {
            float bvv = v8[0]; int bi = 4 * kq;
#pragma unroll
            for (int sl = 1; sl < 8; ++sl) { const int eid = 16 * (sl >> 2) + 4 * kq + (sl & 3); if (v8[sl] > bvv) { bvv = v8[sl]; bi = eid; } }
#pragma unroll
            for (int o = 16; o < 64; o <<= 1) { const float ov = __shfl_xor(bvv, o); const int oi = __shfl_xor(bi, o);
                if (ov > bvv || (ov == bvv && oi < bi)) { bvv = ov; bi = oi; } }
            se[r] = bi; sv[r] = bvv;
#pragma unroll
            for (int sl = 0; sl < 8; ++sl) { const int eid = 16 * (sl >> 2) + 4 * kq + (sl & 3); if (eid == bi) v8[sl] = -3.0e38f; }
        }
        const float p1 = __expf(sv[1] - sv[0]), p2 = __expf(sv[2] - sv[0]), p3 = __expf(sv[3] - sv[0]);
        const float inv = 1.0f / (1.0f + p1 + p2 + p3);
        int lr[4] = {0, 0, 0, 0};
        if (lane < 16) { const int tok = tok0 + tk;
            *(int4*)(TOPE + tok * 4) = make_int4(se[0], se[1], se[2], se[3]);
            *(f32x4*)(TOPW + tok * 4) = (f32x4){inv, p1 * inv, p2 * inv, p3 * inv};
#pragma unroll
            for (int k = 0; k < 4; ++k) lr[k] = __hip_atomic_fetch_add(&hist[se[k]], 1, __ATOMIC_RELAXED, __HIP_MEMORY_SCOPE_WORKGROUP); }
        __syncthreads();
        if (F.tid < 32) { const int c = hist[F.tid]; base[F.tid] = c ? (int)__hip_atomic_fetch_add(F.ctl + cnt_off + layer * 64 + F.tid, (unsigned)c, RLX_AGENT) : 0; }
        __syncthreads();
        if (lane < 16) { const int tok = tok0 + tk;
            const int r0 = base[se[0]] + lr[0], r1 = base[se[1]] + lr[1], r2 = base[se[2]] + lr[2], r3 = base[se[3]] + lr[3];
            *(int4*)(RANK + tok * 4) = make_int4(r0, r1, r2, r3);
            int* SRC = SRCp; SRC[se[0] * NTOK + r0] = tok; SRC[se[1] * NTOK + r1] = tok; SRC[se[2] * NTOK + r2] = tok; SRC[se[3] * NTOK + r3] = tok; }
        __syncthreads();
    }
}

__device__ __forceinline__ int moe_build(Frame& F, int layer) {
    LAS int* offT = (LAS int*)(F.lds + L_OFFT); LAS int* tile_e = (LAS int*)(F.lds + L_TILE);
    __syncthreads();
    if (F.tid < 64) {
        const int c = (F.lane < 32) ? (int)__hip_atomic_load(F.ctl + CW_CNT + layer * 64 + F.lane, RLX_AGENT) : 0;
        const int ntile = (c + 255) >> 8; int x = ntile;
#pragma unroll
        for (int d = 1; d < 32; d <<= 1) { const int v = __shfl_up(x, d); if (F.lane >= d) x += v; }
        if (F.lane < 32) { offT[F.lane] = x - ntile; ((LAS int*)(F.lds + L_CNT))[F.lane] = c; }
        if (F.lane == 31) offT[32] = x;
    }
    __syncthreads();
    int T = __builtin_amdgcn_readfirstlane(offT[32]); if (T > MAXT) T = MAXT;
    for (int mt = F.tid; mt < T; mt += 512) { int e = 0;
#pragma unroll 1
        for (int j = 1; j < 32; ++j) if (offT[j] <= mt) e = j;
        tile_e[mt] = e; }
    __syncthreads();
    return T;
}

__device__ __forceinline__ void p_combine_ln(Frame& F, const Args& a, int layer, bool dry = false) {
    const bool last_layer = (layer == DEPTH - 1) || dry;
    float* XF = a.out; float* XFo = dry ? (float*)(F.ws + WS_HH) : a.out; bf16* XB = (bf16*)(F.ws + (dry ? WS_M : WS_XB)); const bf16* YS = (const bf16*)(F.ws + WS_H);
    const int* TOPE = (const int*)(F.ws + WS_TOPE); const int* RANK = (const int*)(F.ws + WS_RANK); const float* TOPW = (const float*)(F.ws + WS_TOPW);
    const LAS int* offT = (const LAS int*)(F.lds + L_OFFT);
    const float* g2 = a.in[20] + layer * 1024; const float* b2 = a.in[21] + layer * 1024;
    const int gw = F.bid * 8 + F.wave, NGW = F.G * 8, lane = F.lane;
    f32x4 gv[4], bv[4];
#pragma unroll
    for (int j = 0; j < 4; ++j) { gv[j] = *(const f32x4*)(g2 + 4 * lane + 256 * j); bv[j] = *(const f32x4*)(b2 + 4 * lane + 256 * j); }
    for (int tp = gw; tp < NTOK / 2; tp += NGW) {
        f32x4 v[2][4]; v2u yw[2][4][4]; f32x4 tw[2];
#pragma unroll
        for (int u = 0; u < 2; ++u) { const int tok = tp * 2 + u;
            const int4 te = *(const int4*)(TOPE + tok * 4), rk = *(const int4*)(RANK + tok * 4); tw[u] = *(const f32x4*)(TOPW + tok * 4);
            const f32x4* xr = (const f32x4*)(XF + (size_t)tok * 1024) + lane;
#pragma unroll
            for (int j = 0; j < 4; ++j) v[u][j] = xr[64 * j];
            const int pk[4] = {offT[te.x] * 256 + rk.x, offT[te.y] * 256 + rk.y, offT[te.z] * 256 + rk.z, offT[te.w] * 256 + rk.w};
#pragma unroll
            for (int k = 0; k < 4; ++k) { const v2u* yr = (const v2u*)(YS + (size_t)pk[k] * 1024) + lane;
#pragma unroll
                for (int j = 0; j < 4; ++j) yw[u][k][j] = yr[64 * j]; } }
        float s[2], s2[2];
#pragma unroll
        for (int u = 0; u < 2; ++u) {
#pragma unroll
            for (int j = 0; j < 4; ++j) { v[u][j] = v[u][j] * DN_ALPHA;
#pragma unroll
                for (int k = 0; k < 4; ++k) { const v2u y = yw[u][k][j]; v[u][j] = v[u][j] + tw[u][k] * (f32x4){bflo(y.x), bfhi(y.x), bflo(y.y), bfhi(y.y)}; } }
            s[u] = 0.f;
#pragma unroll
            for (int j = 0; j < 4; ++j) s[u] += (v[u][j][0] + v[u][j][1]) + (v[u][j][2] + v[u][j][3]); }
#pragma unroll
        for (int o = 1; o < 64; o <<= 1) { s[0] += __shfl_xor(s[0], o); s[1] += __shfl_xor(s[1], o); }
#pragma unroll
        for (int u = 0; u < 2; ++u) { const float mean = s[u] * (1.f / 1024.f); s2[u] = 0.f;
#pragma unroll
            for (int j = 0; j < 4; ++j) { v[u][j] = v[u][j] - mean; s2[u] += (v[u][j][0] * v[u][j][0] + v[u][j][1] * v[u][j][1]) + (v[u][j][2] * v[u][j][2] + v[u][j][3] * v[u][j][3]); } }
#pragma unroll
        for (int o = 1; o < 64; o <<= 1) { s2[0] += __shfl_xor(s2[0], o); s2[1] += __shfl_xor(s2[1], o); }
#pragma unroll
        for (int u = 0; u < 2; ++u) { const int tok = tp * 2 + u; const float rstd = rsqrtf(s2[u] * (1.f / 1024.f) + LN_EPS);
            f32x4* xo = (f32x4*)(XFo + (size_t)tok * 1024) + lane; v2u* xb = (v2u*)(XB + (size_t)tok * 1024) + lane; unsigned* x8 = (unsigned*)(F.ws + (dry ? WS_M + 32 * MiB : WS_XB8)) + (size_t)tok * 256 + lane;
#pragma unroll
            for (int j = 0; j < 4; ++j) { const f32x4 y = v[u][j] * rstd * gv[j] + bv[j]; if (last_layer) xo[64 * j] = y; xb[64 * j] = (v2u){pk2(y[0], y[1]), pk2(y[2], y[3])}; x8[64 * j] = pk4_fp8(y[0], y[1], y[2], y[3], 1.0f); } }
    }
}

__device__ __forceinline__ const Args* fresh_args() { unsigned long long p = (unsigned long long)__builtin_amdgcn_kernarg_segment_ptr(); asm volatile("" : "+s"(p)); return (const Args*)(const __attribute__((address_space(4))) void*)p; }
constexpr int PH_PER_LAYER = 10, N_PHASES = 1 + DEPTH * PH_PER_LAYER;
__global__ void __launch_bounds__(512, 2) mk_fwd(Args args) {
    extern __shared__ __attribute__((aligned(16))) unsigned char lds[];
    Frame F;
    F.lds = (LAS unsigned char*)lds; F.tid = threadIdx.x; F.lane = F.tid & 63; F.wave = __builtin_amdgcn_readfirstlane(F.tid >> 6);
    F.G = gridDim.x; F.bid = blockIdx.x; F.ws = fresh_args()->ws; F.ctl = (unsigned*)(F.ws + WS_CTL);
    for (int u = F.tid; u < (LDS_BYTES - LDSCTL_OFF) / 4; u += 512) ((LAS unsigned*)(F.lds + LDSCTL_OFF))[u] = 0u;
    __syncthreads();
    const int lo = fresh_args()->ph_lo, hi = fresh_args()->ph_hi;
    XcdBarrier bar; bar.bar = F.ctl + CW_BAR; bar.x = 0; bar.st = nullptr;
    if (hi - lo > 1) bar = xcd_barrier_post(F.ctl + CW_BAR, (volatile LAS unsigned*)(F.lds + L_MISC) + 8);
#define IN(k) (lo <= (k) && (k) < hi)
#define REFRESH() do { F.tid = opaque_tid(); F.lane = F.tid & 63; F.wave = __builtin_amdgcn_readfirstlane(F.tid >> 6); asm volatile("" : "+s"(F.bid), "+s"(F.G)); } while (0)
#define SEAM(k) do { if ((k) + 1 < hi) xcd_barrier(bar); } while (0)

#ifndef NO_P0
    if (IN(0)) { _Pragma("unroll") for (int rep = 0; rep < REP_T; ++rep) p_prologue(F, *fresh_args()); SEAM(0); }
#endif

    for (int l = 0; l < DEPTH; ++l) {
        const int pb = 1 + l * PH_PER_LAYER;
#ifndef NO_P1
        if (IN(pb + 0)) {
            REFRESH();
            {
                pg8::DenseOrder S{(const char*)(F.ws + WS_XB), (const char*)(F.ws + WS_WIN) + (size_t)l * INC * 1024 * 2, (size_t)256 * 1024 * 2, (size_t)256 * 1024 * 2, 16, NTOK / 256, 12, F.G, F.bid};
                pg8::EpiInProj E{(bf16*)(F.ws + WS_H), fresh_args()->in[2] + l * 3072, (const f32x2*)(F.ws + WS_ROPE64), (const f32x2*)(F.ws + WS_ROPE48), 1.0f, (unsigned char*)(F.ws + WS_G8)};
                _Pragma("unroll") for (int rep = 0; rep < REP_G1; ++rep) pg8::gemm_phase<pg8::EpiInProj, pg8::DenseOrder, true, true>(F.lds, 1024, 1024, S, E);
            }
            {
                REFRESH();
                pg8::DenseOrder S{(const char*)(F.ws + WS_XB8), (const char*)(F.ws + WS_WIN8) + (size_t)l * 3072 * 1024, (size_t)256 * 1024, (size_t)256 * 1024, 8, NTOK / 256, 12, F.G, F.bid, 12};
                pg8::EpiInProj E{(bf16*)(F.ws + WS_H), fresh_args()->in[2] + l * 3072, (const f32x2*)(F.ws + WS_ROPE64), (const f32x2*)(F.ws + WS_ROPE48), 1.0f / 32.0f, (unsigned char*)(F.ws + WS_G8)};
                _Pragma("unroll") for (int rep = 0; rep < REP_G1; ++rep) pg8::gemm_phase<pg8::EpiInProj, pg8::DenseOrder, true, true, true>(F.lds, 1024, 1024, S, E);
            }
            if (pb + 2 < hi) xcd_barrier(bar);
        }
#endif
#ifndef NO_P1B
#endif
        if (IN(pb + 2)) {
            REFRESH();
#ifndef NO_PC
            _Pragma("unroll") for (int rep = 0; rep < REP_C; ++rep) attnC_pipe(F, fresh_args()->in[8] + l * 4 * 48, fresh_args()->in[9] + l * 96, fresh_args()->lam_init[l]);
#endif
#ifndef NO_PA
            REFRESH();
            _Pragma("unroll") for (int rep = 0; rep < REP_AB; ++rep) attnA_mfma(F, fresh_args()->in[7] + l * 4 * 15 * 31);
#endif
#ifndef NO_PB
            REFRESH();
            _Pragma("unroll") for (int rep = 0; rep < REP_AB; ++rep) attnB_mfma(F);
#endif
            SEAM(pb + 2);
        }
#ifndef NO_P3
        if (IN(pb + 3)) {
            REFRESH();
            pg8::ProjOrder S{(const char*)(F.ws + WS_Y), (const char*)(F.ws + WS_WPROJ) + (size_t)l * 1024 * WPK * 2, NTOK / 256, 4, F.G, F.bid};
            pg8::EpiProj E{(const unsigned char*)(F.ws + WS_G8), (bf16*)(F.ws + WS_M)};
            _Pragma("unroll") for (int rep = 0; rep < REP_G3; ++rep) pg8::gemm_phase<pg8::EpiProj, pg8::ProjOrder, true, true>(F.lds, YLD, WPK, S, E);
            SEAM(pb + 3);
        }
#endif
#ifndef NO_P4
        if (IN(pb + 4)) {
            REFRESH();
            pg8::DenseOrder S{(const char*)(F.ws + WS_M), (const char*)(F.ws + WS_WOUT) + (size_t)l * 1024 * 1024 * 2, (size_t)256 * 1024 * 2, (size_t)256 * 1024 * 2, 16, NTOK / 256, 4, F.G, F.bid};
            pg8::EpiOut E{l == 0 ? fresh_args()->in[0] : (const float*)nullptr, (const bf16*)(F.ws + WS_XB), (float*)(F.ws + WS_HH)};
            _Pragma("unroll") for (int rep = 0; rep < REP_G4; ++rep) pg8::gemm_phase<pg8::EpiOut, pg8::DenseOrder, true, true>(F.lds, 1024, 1024, S, E);
            SEAM(pb + 4);
        }
#endif
#ifndef NO_P5
        if (IN(pb + 5)) { REFRESH(); if (DRY_P5) p_ln_router(F, *fresh_args(), l, true); p_ln_router(F, *fresh_args(), l); if (pb + 7 < hi) xcd_barrier(bar); }
#endif
#ifndef NO_P5B
#endif
#ifndef NO_P6
        if (IN(pb + 7)) {
            REFRESH(); const int T = moe_build(F, l);
            pg8::MoeOrder S{(const char*)(F.ws + WS_XB8), (const char*)(F.ws + WS_WGU) + (size_t)l * NEXP * 2048 * 1024, (size_t)2048 * 1024, (size_t)256 * 1024, (size_t)256 * 1024, 8,
                            (const LAS int*)(F.lds + L_TILE), (const LAS int*)(F.lds + L_OFFT), (const LAS int*)(F.lds + L_CNT), (const int*)(F.ws + WS_SRC), T, 8, F.G, F.bid};
            pg8::EpiSwiglu E{(unsigned char*)(F.ws + WS_HH), fresh_args()->in[15] + (size_t)l * NEXP * 1024, fresh_args()->in[17] + (size_t)l * NEXP * 1024, 1.0f / 32.0f};
            _Pragma("unroll") for (int rep = 0; rep < REP_G6; ++rep) pg8::gemm_phase_gather<pg8::EpiSwiglu, pg8::MoeOrder, true>(F.lds, (const char*)(F.ws + WS_XB8), 1024, 1024, S, E);
            SEAM(pb + 7);
        }
#endif
#ifndef NO_P7
        if (IN(pb + 8)) {
            REFRESH(); const int T = moe_build(F, l);
            pg8::MoeOrder S{(const char*)(F.ws + WS_HH), (const char*)(F.ws + WS_WDN) + (size_t)l * NEXP * 1024 * 1024, (size_t)1024 * 1024, (size_t)256 * 1024, (size_t)256 * 1024, 8,
                            (const LAS int*)(F.lds + L_TILE), (const LAS int*)(F.lds + L_OFFT), (const LAS int*)(F.lds + L_CNT), (const int*)(F.ws + WS_SRC), T, 4, F.G, F.bid};
            pg8::EpiDown E{(bf16*)(F.ws + WS_H), fresh_args()->in[19] + (size_t)l * NEXP * 1024, 1.0f / 256.0f};
            _Pragma("unroll") for (int rep = 0; rep < REP_G7; ++rep) pg8::gemm_phase<pg8::EpiDown, pg8::MoeOrder, true, true, true>(F.lds, 1024, 1024, S, E);
            SEAM(pb + 8);
        }
#endif
#ifndef NO_P8
        if (IN(pb + 9)) { REFRESH(); (void)moe_build(F, l); if (DRY_P8) p_combine_ln(F, *fresh_args(), l, true); p_combine_ln(F, *fresh_args(), l); SEAM(pb + 9); }
#endif
    }
#undef IN
#undef SEAM
}

extern "C" void kernel_launch(void* const* d_in, const int* in_sizes, int n_in, void* d_out, int out_size, void* d_ws, size_t ws_size, hipStream_t stream) {
    static int grid = 0;
    if (grid == 0) {
        if (n_in != 22 || in_sizes[0] != NTOK * D || out_size != NTOK * D || ws_size < WS_END) {
            fprintf(stderr, "kernel_launch: unexpected shapes (n_in %d, in0 %d, out %d, ws %zu); nothing launched\n", n_in, n_in > 0 ? in_sizes[0] : -1, out_size, ws_size); grid = -1; return; }
        int dev = 0, cus = 0, per_cu = 0;
        if (hipGetDevice(&dev) != hipSuccess || hipDeviceGetAttribute(&cus, hipDeviceAttributeMultiprocessorCount, dev) != hipSuccess) { grid = -1; return; }
        if (hipFuncSetAttribute((const void*)mk_fwd, hipFuncAttributeMaxDynamicSharedMemorySize, LDS_BYTES) != hipSuccess) { fprintf(stderr, "kernel_launch: hipFuncSetAttribute failed\n"); grid = -1; return; }
        if (hipOccupancyMaxActiveBlocksPerMultiprocessor(&per_cu, (const void*)mk_fwd, 512, LDS_BYTES) != hipSuccess || per_cu < 1)
            fprintf(stderr, "kernel_launch: note: occupancy query reports %d workgroups per CU\n", per_cu);
        (void)hipGetLastError();
        grid = cus;
    }
    if (grid < 0) return;
    if (hipMemsetAsync((char*)d_ws + WS_CTL, 0, CTL_ZERO_BYTES, stream) != hipSuccess) { fprintf(stderr, "kernel_launch: memset failed\n"); return; }
    Args a{};
    for (int i = 0; i < 22; ++i) a.in[i] = (const float*)d_in[i];
    a.out = (float*)d_out; a.ws = (unsigned char*)d_ws;
    for (int l = 0; l < DEPTH; ++l) a.lam_init[l] = (float)(0.8 - 0.6 * exp(-0.3 * (double)l));
#if MK_ONE_LAUNCH
    a.ph_lo = 0; a.ph_hi = N_PHASES;
    hipLaunchKernelGGL(mk_fwd, dim3(grid), dim3(512), LDS_BYTES, stream, a);
#else
    for (int p = 0; p < N_PHASES; ++p) {
        a.ph_lo = p; a.ph_hi = p + 1;
        hipLaunchKernelGGL(mk_fwd, dim3(grid), dim3(512), LDS_BYTES, stream, a);
    }
#endif
    const hipError_t le = hipPeekAtLastError();
    if (le != hipSuccess) fprintf(stderr, "kernel_launch: launch failed: %s\n", hipGetErrorName(le));
}
```

```cpp
#include <hip/hip_runtime.h>
#include <cstdio>
#include <cstdint>
#include <cmath>

#ifndef REP_AB
#define REP_AB 1
#endif
#ifndef REP_C
#define REP_C 1
#endif
#ifndef REP_G
#define REP_G 1
#endif
#ifndef REP_G1
#define REP_G1 REP_G
#endif
#ifndef REP_G3
#define REP_G3 REP_G
#endif
#ifndef REP_G4
#define REP_G4 REP_G
#endif
#ifndef REP_G6
#define REP_G6 REP_G
#endif
#ifndef REP_G7
#define REP_G7 REP_G
#endif
#ifndef REP_T
#define REP_T 1
#endif
#ifndef DRY_P5
#define DRY_P5 0
#endif
#ifndef DRY_P8
#define DRY_P8 0
#endif
#ifndef C_ANTIPHASE
#define C_ANTIPHASE 0
#endif
#ifndef MK_ONE_LAUNCH
#define MK_ONE_LAUNCH 1
#endif

#define GAS __attribute__((address_space(1)))
#define LAS __attribute__((address_space(3)))
typedef unsigned short bf16;
typedef unsigned v4u __attribute__((ext_vector_type(4)));
typedef unsigned v2u __attribute__((ext_vector_type(2)));
typedef float f32x4 __attribute__((ext_vector_type(4)));
typedef float f32x2 __attribute__((ext_vector_type(2)));
typedef short bf16x8 __attribute__((ext_vector_type(8)));

constexpr int NTOK = 32768, SEQ = 4096, D = 1024, DEPTH = 4, INC = 6144, NEXP = 32, TOPK = 4;
constexpr int C_QA = 0, C_KA = 256, C_VA = 512, C_QB = 768, C_KB = 1152, C_VB = 1536, C_QC = 1920, C_KC = 2304, C_VC = 2688, C_GP = 3072;
constexpr int YLD = 768, Y_A = 0, Y_B = 256, Y_C = 384;
constexpr int WPK = 896;
constexpr int MAXT = 544;
constexpr float LN_EPS = 1e-5f;
constexpr float DN_ALPHA = 1.681792830507429f;

constexpr size_t MiB = 1u << 20;
constexpr size_t WS_CTL = 0, CTL_ZERO_BYTES = 1 * MiB;
constexpr size_t WS_ROPE64 = 1 * MiB;
constexpr size_t WS_ROPE48 = 2 * MiB;
constexpr size_t WS_TOPE = 3 * MiB;
constexpr size_t WS_TOPW = 3 * MiB + 512 * 1024;
constexpr size_t WS_POS = 4 * MiB;
constexpr size_t WS_WIN = 8 * MiB;
constexpr size_t WS_WPROJ = 56 * MiB;
constexpr size_t WS_WOUT = 64 * MiB;
constexpr size_t WS_WGU = 72 * MiB;
constexpr size_t WS_WDN = 584 * MiB;
constexpr size_t WS_XB = 840 * MiB;
constexpr size_t WS_Y = 904 * MiB;
constexpr size_t WS_M = 952 * MiB;
constexpr size_t WS_H = 1016 * MiB;
constexpr size_t WS_HH = 1400 * MiB;
constexpr size_t WS_WRT = 5 * MiB;
constexpr size_t WS_RANK = 6 * MiB;
constexpr size_t WS_SRC = 1672 * MiB;
constexpr size_t WS_XB8 = 1676 * MiB;
constexpr size_t WS_WIN8 = 1708 * MiB;
constexpr size_t WS_G8 = 1720 * MiB;
constexpr size_t WS_END = 1816 * MiB;
constexpr int CW_BAR = 4096;
constexpr int CW_CNT = 8192;
constexpr int CW_CUR = 8192 + 4 * 64;

constexpr int RING_BYTES = 131072;
constexpr int LDSCTL_OFF = RING_BYTES;
constexpr int L_MISC = LDSCTL_OFF;
constexpr int L_OFFT = LDSCTL_OFF + 256;
constexpr int L_HIST = LDSCTL_OFF + 512;
constexpr int L_BASE = LDSCTL_OFF + 768;
constexpr int L_CNT = LDSCTL_OFF + 896;
constexpr int L_TILE = LDSCTL_OFF + 1024;
constexpr int L_PPOS = LDSCTL_OFF + 4096;
constexpr int L_PTOK = LDSCTL_OFF + 6144;
constexpr int LDS_BYTES = 147456;
static_assert(L_PTOK + 2048 <= LDS_BYTES, "LDS map");

#define RLX_AGENT __ATOMIC_RELAXED, __HIP_MEMORY_SCOPE_AGENT
#define LDS_WAIT() asm volatile("s_waitcnt lgkmcnt(0)" ::: "memory")
#define VM_WAIT() asm volatile("s_waitcnt vmcnt(0)" ::: "memory")

__device__ __forceinline__ float bf2f(unsigned short b) { return __uint_as_float(((unsigned)b) << 16); }
__device__ __forceinline__ float bflo(unsigned u) { return __uint_as_float(u << 16); }
__device__ __forceinline__ float bfhi(unsigned u) { return __uint_as_float(u & 0xffff0000u); }
__device__ __forceinline__ unsigned f2bf(float f) { unsigned u = __builtin_bit_cast(unsigned, f); return (u + 0x7fffu + ((u >> 16) & 1u)) >> 16; }
__device__ __forceinline__ unsigned pk2(float lo, float hi) { return f2bf(lo) | (f2bf(hi) << 16); }
__device__ __forceinline__ float wave_sum(float v) {
#pragma unroll
    for (int o = 1; o < 64; o <<= 1) v += __shfl_xor(v, o);
    return v;
}
__device__ __forceinline__ int opaque_tid() { int t; asm volatile("v_mov_b32 %0, %1" : "=v"(t) : "v"(threadIdx.x)); return t; }
__device__ __forceinline__ unsigned pk4_fp8(float a, float b, float c, float d, float sc) {
    a = fminf(fmaxf(a * sc, -448.f), 448.f); b = fminf(fmaxf(b * sc, -448.f), 448.f); c = fminf(fmaxf(c * sc, -448.f), 448.f); d = fminf(fmaxf(d * sc, -448.f), 448.f);
    int p = __builtin_amdgcn_cvt_pk_fp8_f32(a, b, 0, false); p = __builtin_amdgcn_cvt_pk_fp8_f32(c, d, p, true); return (unsigned)p; }
__device__ __forceinline__ float fast_sigmoid(float x) { return __builtin_amdgcn_rcpf(1.0f + __builtin_amdgcn_exp2f(-1.4426950408889634f * x)); }

namespace pg8 {
#define PG8_LAS __attribute__((address_space(3)))
typedef unsigned short bf16_t;
typedef unsigned u32x4 __attribute__((ext_vector_type(4)));
constexpr int BM = 256, BK = 64, HALF = 128, HTB = HALF * BK * 2, STAGE_BYTES = 8 * HTB, NXCD = 8, WGM = 8;

__host__ __device__ __forceinline__ int lds_byte(int r, int c) { const int st = (r >> 4) * 2 + (c >> 5), rr = r & 15, cc = c & 31, ob = rr * 64 + cc * 2; return st * 1024 + (ob ^ (((ob >> 9) & 1) << 5)); }
__host__ __device__ __forceinline__ void stage_rc(int b, int& R, int& C) { const int st = b / 1024, sb = b % 1024, swz = sb ^ (((sb >> 9) & 1) << 5); R = (st >> 1) * 16 + swz / 64; C = (st & 1) * 32 + (swz % 64) / 2; }
__host__ __device__ __forceinline__ int perm32(int rho) { const int n = rho >> 4, i = rho & 15; return 8 * (i >> 2) + 4 * n + (i & 3); }

struct Unit { const char* A; const char* B; int nt; int pm, pn, aux; int bs; };

constexpr int L_BIAS_OFF = 139264;
__device__ __forceinline__ void glds16_u(const void* gsrc, unsigned lds_dst) { unsigned keep;
    asm volatile("s_mov_b32 %0, m0\n\ts_mov_b32 m0, %2\n\ts_nop 0\n\tglobal_load_lds_dwordx4 %1, off\n\ts_mov_b32 m0, %0" : "=&s"(keep) : "v"(gsrc), "s"(lds_dst) : "memory"); }
__device__ __forceinline__ void tile_of(int L, int nM, int nN, int& pm, int& pn) {
    const int nwg = nM * nN;
    int wgid = L; { const int q = nwg / NXCD, r = nwg % NXCD, xcd = wgid % NXCD, off = wgid / NXCD; wgid = (xcd < r ? xcd * (q + 1) : r * (q + 1) + (xcd - r) * q) + off; }
    const int nig = WGM * nN, gid = wgid / nig, fm = gid * WGM, gsz = (nM - fm) < WGM ? (nM - fm) : WGM;
    pm = fm + ((wgid % nig) % gsz); pn = (wgid % nig) / gsz;
}

__device__ __forceinline__ unsigned cvt_pk_bf16(float lo, float hi) { unsigned r; asm volatile("v_cvt_pk_bf16_f32 %0, %1, %2" : "=v"(r) : "v"(lo), "v"(hi)); return r; }
typedef int v8i32 __attribute__((ext_vector_type(8)));
typedef short s16x16 __attribute__((ext_vector_type(16)));
typedef int v4i32 __attribute__((ext_vector_type(4)));
__device__ __forceinline__ v8i32 cat8(bf16x8 lo, bf16x8 hi) { const v4i32 a = __builtin_bit_cast(v4i32, lo), b = __builtin_bit_cast(v4i32, hi); return __builtin_shufflevector(a, b, 0, 1, 2, 3, 4, 5, 6, 7); }

template <class Epi, class Sched, bool ALIGN_EPI, bool SP2, bool FP8 = false>
__device__ __forceinline__ void gemm_phase(PG8_LAS unsigned char* lds, const int lda, const int ldb, const Sched& S, const Epi& E, const int sclW = 0x7f7f7f7f, const int sclX = 0x7f7f7f7f) {
    constexpr int EB = FP8 ? 1 : 2;
    const int tid = opaque_tid(), wid = __builtin_amdgcn_readfirstlane(tid >> 6), lane = tid & 63, wr = wid >> 2, wc = wid & 3, fr = lane & 15, fq = lane >> 4;
    unsigned voffA[2], voffB[2];
#pragma unroll
    for (int i = 0; i < 2; ++i) { int R, C; stage_rc(tid * 16 + i * 8192, R, C); const int Rb = Epi::PERM ? ((R & ~31) + perm32(R & 31)) : R;
        voffA[i] = (unsigned)(R * lda * EB + C * 2); voffB[i] = (unsigned)(Rb * ldb * EB + C * 2); }
    const size_t kstep = (size_t)(BK * 2);
    const size_t hA = (size_t)HALF * lda * EB, hB = (size_t)HALF * ldb * EB;
    const unsigned ldsw = (unsigned)wid * 1024u;
    const int fcol = FP8 ? (32 * (fq >> 1) + 16 * (fq & 1)) : fq * 8;
    const int aoff = lds_byte(wr * 64 + fr, fcol), boff = lds_byte(wc * 32 + fr, fcol);
#define PG8_SA(b, h) (((b) * 2 + (h)) * HTB)
#define PG8_SB(b, h) ((4 + (b) * 2 + (h)) * HTB)
#define PG8_STAGE(bufoff, gbase, voff) do { _Pragma("unroll") for (int _i = 0; _i < 2; ++_i) \
        __builtin_amdgcn_global_load_lds((const unsigned*)((const char*)(gbase) + (voff)[_i]), (PG8_LAS unsigned*)(lds + (bufoff) + ldsw + _i * 8192), 16, 0, 0); } while (0)
#define PG8_LDA(dst, b, h) do { if constexpr (FP8) { _Pragma("unroll") for (int m = 0; m < 4; ++m) dst##8[m] = cat8(*(const PG8_LAS bf16x8*)(lds + PG8_SA(b, h) + aoff + m * 2048), *(const PG8_LAS bf16x8*)(lds + PG8_SA(b, h) + aoff + m * 2048 + 16)); } else { \
        _Pragma("unroll") for (int m = 0; m < 4; ++m) _Pragma("unroll") for (int k = 0; k < 2; ++k) dst[m][k] = *(const PG8_LAS bf16x8*)(lds + PG8_SA(b, h) + aoff + m * 2048 + k * 1024); } } while (0)
#define PG8_LDB(dst, b, h) do { if constexpr (FP8) { _Pragma("unroll") for (int n = 0; n < 2; ++n) dst##8[n] = cat8(*(const PG8_LAS bf16x8*)(lds + PG8_SB(b, h) + boff + n * 2048), *(const PG8_LAS bf16x8*)(lds + PG8_SB(b, h) + boff + n * 2048 + 16)); } else { \
        _Pragma("unroll") for (int n = 0; n < 2; ++n) _Pragma("unroll") for (int k = 0; k < 2; ++k) dst[n][k] = *(const PG8_LAS bf16x8*)(lds + PG8_SB(b, h) + boff + n * 2048 + k * 1024); } } while (0)
#define PG8_MMA(ai, bj, At, Bt) do { __builtin_amdgcn_s_setprio(1); if constexpr (FP8) { _Pragma("unroll") for (int m = 0; m < 4; ++m) _Pragma("unroll") for (int n = 0; n < 2; ++n) \
        asm volatile("v_mfma_f32_16x16x128_f8f6f4 %0, %1, %2, %0" : "+v"(acc[ai][bj][m][n]) : "v"(Bt##8[n]), "v"(At##8[m])); } else { \
        _Pragma("unroll") for (int m = 0; m < 4; ++m) _Pragma("unroll") for (int n = 0; n < 2; ++n) _Pragma("unroll") for (int k = 0; k < 2; ++k) \
        acc[ai][bj][m][n] = __builtin_amdgcn_mfma_f32_16x16x32_bf16(Bt[n][k], At[m][k], acc[ai][bj][m][n], 0, 0, 0); } __builtin_amdgcn_s_setprio(0); } while (0)
#define PG8_WAIT_V(n) asm volatile("s_waitcnt vmcnt(" #n ")" ::: "memory")
#define PG8_WAIT_L(n) asm volatile("s_waitcnt lgkmcnt(" #n ")" ::: "memory")
#define PG8_BAR __builtin_amdgcn_s_barrier()
#define PG8_SCHED __builtin_amdgcn_sched_barrier(0)
    Unit cur, nxt; int ui = 0;
    if (!S.next(0, cur)) return;
    f32x4 acc[2][2][4][2];
#pragma unroll
    for (int a = 0; a < 2; ++a)
#pragma unroll
        for (int b = 0; b < 2; ++b)
#pragma unroll
            for (int m = 0; m < 4; ++m)
#pragma unroll
                for (int n = 0; n < 2; ++n) acc[a][b][m][n] = (f32x4){0.f, 0.f, 0.f, 0.f};
    bf16x8 At[4][2], B0[2][2], B1[2][2]; v8i32 At8[4], B08[2], B18[2];
    const char* cA = cur.A; const char* cB = cur.B;
    if constexpr (Epi::BIAS_DMA) { if (wid == 0) E.bias_dma(cur, 0, lane, lds); }
    if constexpr (SP2) {
        PG8_STAGE(PG8_SB(0, 0), cB, voffB); PG8_STAGE(PG8_SB(0, 1), cB + hB, voffB); PG8_STAGE(PG8_SA(0, 0), cA, voffA); PG8_STAGE(PG8_SA(0, 1), cA + hA, voffA);
        if (wr == 1) PG8_BAR;
        PG8_WAIT_V(2); PG8_BAR;
        PG8_STAGE(PG8_SB(1, 0), cB + kstep, voffB); PG8_STAGE(PG8_SA(1, 0), cA + kstep, voffA); PG8_STAGE(PG8_SB(1, 1), cB + hB + kstep, voffB);
        PG8_WAIT_V(6); PG8_BAR;
    } else {
        PG8_STAGE(PG8_SB(0, 0), cB, voffB); PG8_STAGE(PG8_SA(0, 0), cA, voffA); PG8_STAGE(PG8_SB(0, 1), cB + hB, voffB); PG8_STAGE(PG8_SA(0, 1), cA + hA, voffA);
        if (wr == 1) PG8_BAR;
        PG8_WAIT_V(4); PG8_BAR;
        PG8_STAGE(PG8_SB(1, 0), cB + kstep, voffB); PG8_STAGE(PG8_SA(1, 0), cA + kstep, voffA); PG8_STAGE(PG8_SB(1, 1), cB + hB + kstep, voffB);
        PG8_WAIT_V(6); PG8_BAR;
    }
    for (;;) {
        const bool has_next = S.next(ui + 1, nxt);
        if constexpr (Epi::BIAS_DMA) { if (has_next && wid == 0) E.bias_dma(nxt, (ui + 1) & 1, lane, lds); }
        const char* nA = has_next ? nxt.A : cA; const char* nB = has_next ? nxt.B : cB;
        const int nt = cur.nt;
        for (int t = 0; t < nt; t += 2) {
            const bool last = (t == nt - 2);
            const char* a1 = cA + (size_t)(t + 1) * kstep;
            const char* a2 = last ? nA : cA + (size_t)(t + 2) * kstep; const char* b2 = last ? nB : cB + (size_t)(t + 2) * kstep;
            const char* a3 = a2 + kstep; const char* b3 = b2 + kstep;
            if constexpr (SP2) {
            PG8_LDB(B0, 0, 0); PG8_LDB(B1, 0, 1); PG8_SCHED; PG8_LDA(At, 0, 0); PG8_STAGE(PG8_SA(1, 1), a1 + hA, voffA);
            PG8_WAIT_V(8); PG8_WAIT_L(0); PG8_BAR; PG8_MMA(0, 0, At, B0); PG8_MMA(0, 1, At, B1); PG8_BAR; PG8_SCHED;
            PG8_LDA(At, 0, 1); PG8_STAGE(PG8_SB(0, 0), b2, voffB); PG8_STAGE(PG8_SB(0, 1), b2 + hB, voffB); PG8_STAGE(PG8_SA(0, 0), a2, voffA);
            PG8_WAIT_V(8); PG8_WAIT_L(0); PG8_BAR; PG8_MMA(1, 0, At, B0); PG8_MMA(1, 1, At, B1); PG8_BAR; PG8_SCHED;
            PG8_LDB(B0, 1, 0); PG8_LDB(B1, 1, 1); PG8_SCHED; PG8_LDA(At, 1, 0); PG8_STAGE(PG8_SA(0, 1), a2 + hA, voffA);
            PG8_WAIT_V(8); PG8_WAIT_L(0); PG8_BAR; PG8_MMA(0, 0, At, B0); PG8_MMA(0, 1, At, B1); PG8_BAR; PG8_SCHED;
            PG8_LDA(At, 1, 1); PG8_STAGE(PG8_SB(1, 0), b3, voffB); PG8_STAGE(PG8_SB(1, 1), b3 + hB, voffB); PG8_STAGE(PG8_SA(1, 0), a3, voffA);
            PG8_WAIT_V(8); PG8_WAIT_L(0); PG8_BAR; PG8_MMA(1, 0, At, B0); PG8_MMA(1, 1, At, B1); PG8_BAR; PG8_SCHED;
            } else {
            PG8_LDB(B0, 0, 0); PG8_SCHED; PG8_LDA(At, 0, 0); PG8_STAGE(PG8_SA(1, 1), a1 + hA, voffA);
            PG8_WAIT_L(8); PG8_BAR; PG8_WAIT_L(0); PG8_MMA(0, 0, At, B0); PG8_BAR; PG8_SCHED;
            PG8_LDB(B1, 0, 1); PG8_STAGE(PG8_SB(0, 0), b2, voffB);
            PG8_BAR; PG8_WAIT_L(0); PG8_MMA(0, 1, At, B1); PG8_BAR;
            PG8_LDA(At, 0, 1); PG8_STAGE(PG8_SA(0, 0), a2, voffA);
            PG8_BAR; PG8_WAIT_L(0); PG8_MMA(1, 0, At, B0); PG8_BAR; PG8_SCHED;
            PG8_STAGE(PG8_SB(0, 1), b2 + hB, voffB);
            PG8_WAIT_V(6); PG8_BAR; PG8_MMA(1, 1, At, B1); PG8_BAR;
            PG8_LDB(B0, 1, 0); PG8_SCHED; PG8_LDA(At, 1, 0); PG8_STAGE(PG8_SA(0, 1), a2 + hA, voffA);
            PG8_WAIT_L(8); PG8_BAR; PG8_WAIT_L(0); PG8_MMA(0, 0, At, B0); PG8_BAR; PG8_SCHED;
            PG8_LDB(B1, 1, 1); PG8_STAGE(PG8_SB(1, 0), b3, voffB);
            PG8_BAR; PG8_WAIT_L(0); PG8_MMA(0, 1, At, B1); PG8_BAR;
            PG8_LDA(At, 1, 1); PG8_STAGE(PG8_SA(1, 0), a3, voffA);
            PG8_BAR; PG8_WAIT_L(0); PG8_MMA(1, 0, At, B0); PG8_BAR; PG8_SCHED;
            PG8_STAGE(PG8_SB(1, 1), b3 + hB, voffB);
            PG8_WAIT_V(6); PG8_BAR; PG8_MMA(1, 1, At, B1); PG8_BAR;
            }
        }
        if constexpr (ALIGN_EPI) { if (wr == 0) PG8_BAR; }
        if constexpr (FP8) asm volatile("s_nop 15\n\ts_nop 15\n\ts_nop 15" ::: "memory");
        cur.bs = ui & 1;
        E(acc, cur, wr, wc, fr, fq);
        if (!has_next) break;
        if (!(Epi::KEEP && cur.aux != 2)) {
#pragma unroll
        for (int a = 0; a < 2; ++a)
#pragma unroll
            for (int b = 0; b < 2; ++b)
#pragma unroll
                for (int m = 0; m < 4; ++m)
#pragma unroll
                    for (int n = 0; n < 2; ++n) acc[a][b][m][n] = (f32x4){0.f, 0.f, 0.f, 0.f};
        }
        cur = nxt; cA = nA; cB = nB; ++ui;
        if constexpr (ALIGN_EPI) { if (wr == 1) PG8_BAR; }
    }
    PG8_WAIT_V(0);
    if constexpr (!ALIGN_EPI) { if (wr == 0) PG8_BAR; }
    PG8_BAR;
#undef PG8_SA
#undef PG8_SB
#undef PG8_STAGE
#undef PG8_LDA
#undef PG8_LDB
#undef PG8_MMA
#undef PG8_WAIT_V
#undef PG8_WAIT_L
#undef PG8_BAR
#undef PG8_SCHED
}

template <class Epi, class Sched, bool FP8 = false>
__device__ __forceinline__ void gemm_phase_gather(PG8_LAS unsigned char* lds, const char* Abase, const int lda, const int ldb, const Sched& S, const Epi& E, const int sclW = 0x7f7f7f7f, const int sclX = 0x7f7f7f7f) {
    constexpr int EB = FP8 ? 1 : 2;
    const int tid = opaque_tid(), wid = __builtin_amdgcn_readfirstlane(tid >> 6), lane = tid & 63, wr = wid >> 2, wc = wid & 3, fr = lane & 15, fq = lane >> 4;
    unsigned voffB[2]; int Rr[2]; unsigned Cc[2];
#pragma unroll
    for (int i = 0; i < 2; ++i) { int R, C; stage_rc(tid * 16 + i * 8192, R, C); const int Rb = Epi::PERM ? ((R & ~31) + perm32(R & 31)) : R;
        Rr[i] = R; Cc[i] = (unsigned)C * 2u; voffB[i] = (unsigned)(Rb * ldb * EB + C * 2); }
    const size_t kstep = (size_t)(BK * 2);
    const size_t hB = (size_t)HALF * ldb * EB;
    const unsigned ldsw = (unsigned)wid * 1024u;
    const int fcol = FP8 ? (32 * (fq >> 1) + 16 * (fq & 1)) : fq * 8;
    const int aoff = lds_byte(wr * 64 + fr, fcol), boff = lds_byte(wc * 32 + fr, fcol);
#define PG8_SA(b, h) (((b) * 2 + (h)) * HTB)
#define PG8_SB(b, h) ((4 + (b) * 2 + (h)) * HTB)
#define PG8_STAGE(bufoff, gbase, voff) do { _Pragma("unroll") for (int _i = 0; _i < 2; ++_i) \
        __builtin_amdgcn_global_load_lds((const unsigned*)((const char*)(gbase) + (voff)[_i]), (PG8_LAS unsigned*)(lds + (bufoff) + ldsw + _i * 8192), 16, 0, 0); } while (0)
#define PG8_LDA(dst, b, h) do { if constexpr (FP8) { _Pragma("unroll") for (int m = 0; m < 4; ++m) dst##8[m] = cat8(*(const PG8_LAS bf16x8*)(lds + PG8_SA(b, h) + aoff + m * 2048), *(const PG8_LAS bf16x8*)(lds + PG8_SA(b, h) + aoff + m * 2048 + 16)); } else { \
        _Pragma("unroll") for (int m = 0; m < 4; ++m) _Pragma("unroll") for (int k = 0; k < 2; ++k) dst[m][k] = *(const PG8_LAS bf16x8*)(lds + PG8_SA(b, h) + aoff + m * 2048 + k * 1024); } } while (0)
#define PG8_LDB(dst, b, h) do { if constexpr (FP8) { _Pragma("unroll") for (int n = 0; n < 2; ++n) dst##8[n] = cat8(*(const PG8_LAS bf16x8*)(lds + PG8_SB(b, h) + boff + n * 2048), *(const PG8_LAS bf16x8*)(lds + PG8_SB(b, h) + boff + n * 2048 + 16)); } else { \
        _Pragma("unroll") for (int n = 0; n < 2; ++n) _Pragma("unroll") for (int k = 0; k < 2; ++k) dst[n][k] = *(const PG8_LAS bf16x8*)(lds + PG8_SB(b, h) + boff + n * 2048 + k * 1024); } } while (0)
#define PG8_MMA(ai, bj, At, Bt) do { __builtin_amdgcn_s_setprio(1); if constexpr (FP8) { _Pragma("unroll") for (int m = 0; m < 4; ++m) _Pragma("unroll") for (int n = 0; n < 2; ++n) \
        asm volatile("v_mfma_f32_16x16x128_f8f6f4 %0, %1, %2, %0" : "+v"(acc[ai][bj][m][n]) : "v"(Bt##8[n]), "v"(At##8[m])); } else { \
        _Pragma("unroll") for (int m = 0; m < 4; ++m) _Pragma("unroll") for (int n = 0; n < 2; ++n) _Pragma("unroll") for (int k = 0; k < 2; ++k) \
        acc[ai][bj][m][n] = __builtin_amdgcn_mfma_f32_16x16x32_bf16(Bt[n][k], At[m][k], acc[ai][bj][m][n], 0, 0, 0); } __builtin_amdgcn_s_setprio(0); } while (0)
#define PG8_WAIT_V(n) asm volatile("s_waitcnt vmcnt(" #n ")" ::: "memory")
#define PG8_WAIT_L(n) asm volatile("s_waitcnt lgkmcnt(" #n ")" ::: "memory")
#define PG8_BAR __builtin_amdgcn_s_barrier()
#define PG8_SCHED __builtin_amdgcn_sched_barrier(0)
#define PG8_ROWOFF(u, vo) do { _Pragma("unroll") for (int _h = 0; _h < 2; ++_h) _Pragma("unroll") for (int _i = 0; _i < 2; ++_i) \
        (vo)[_h][_i] = (unsigned)S.rowtok((u), 128 * _h + Rr[_i]) * (unsigned)(lda * EB) + Cc[_i]; } while (0)
    Unit cur, nxt, nn; int ui = 0;
    if (!S.next(0, cur)) return;
    bool has_next = S.next(1, nxt);
    unsigned cv[2][2], nv[2][2], tv[2][2];
    PG8_ROWOFF(cur, cv);
    if (has_next) PG8_ROWOFF(nxt, nv); else { _Pragma("unroll") for (int h = 0; h < 2; ++h) _Pragma("unroll") for (int i = 0; i < 2; ++i) nv[h][i] = cv[h][i]; }
    f32x4 acc[2][2][4][2];
#pragma unroll
    for (int a = 0; a < 2; ++a)
#pragma unroll
        for (int b = 0; b < 2; ++b)
#pragma unroll
            for (int m = 0; m < 4; ++m)
#pragma unroll
                for (int n = 0; n < 2; ++n) acc[a][b][m][n] = (f32x4){0.f, 0.f, 0.f, 0.f};
    bf16x8 At[4][2], B0[2][2], B1[2][2]; v8i32 At8[4], B08[2], B18[2];
    const char* cB = cur.B;
    if constexpr (Epi::BIAS_DMA) { if (wid == 0) E.bias_dma(cur, 0, lane, lds); }
    PG8_STAGE(PG8_SB(0, 0), cB, voffB); PG8_STAGE(PG8_SB(0, 1), cB + hB, voffB); PG8_STAGE(PG8_SA(0, 0), Abase, cv[0]); PG8_STAGE(PG8_SA(0, 1), Abase, cv[1]);
    if (wr == 1) PG8_BAR;
    PG8_WAIT_V(2); PG8_BAR;
    PG8_STAGE(PG8_SB(1, 0), cB + kstep, voffB); PG8_STAGE(PG8_SA(1, 0), Abase + kstep, cv[0]); PG8_STAGE(PG8_SB(1, 1), cB + hB + kstep, voffB);
    PG8_WAIT_V(6); PG8_BAR;
    for (;;) {
        const char* nB = has_next ? nxt.B : cB;
        if constexpr (Epi::BIAS_DMA) { if (has_next && wid == 0) E.bias_dma(nxt, (ui + 1) & 1, lane, lds); }
        const int nt = cur.nt;
        for (int t = 0; t < nt; t += 2) {
            const bool last = (t == nt - 2);
            const char* a1 = Abase + (size_t)(t + 1) * kstep;
            const char* a2 = last ? Abase : Abase + (size_t)(t + 2) * kstep; const char* b2 = last ? nB : cB + (size_t)(t + 2) * kstep;
            const char* a3 = a2 + kstep; const char* b3 = b2 + kstep;
            unsigned s0[2], s1[2];
#pragma unroll
            for (int i = 0; i < 2; ++i) { s0[i] = last ? nv[0][i] : cv[0][i]; s1[i] = last ? nv[1][i] : cv[1][i]; }
            PG8_LDB(B0, 0, 0); PG8_LDB(B1, 0, 1); PG8_SCHED; PG8_LDA(At, 0, 0); PG8_STAGE(PG8_SA(1, 1), a1, cv[1]);
            PG8_WAIT_V(8); PG8_WAIT_L(0); PG8_BAR; PG8_MMA(0, 0, At, B0); PG8_MMA(0, 1, At, B1); PG8_BAR; PG8_SCHED;
            PG8_LDA(At, 0, 1); PG8_STAGE(PG8_SB(0, 0), b2, voffB); PG8_STAGE(PG8_SB(0, 1), b2 + hB, voffB); PG8_STAGE(PG8_SA(0, 0), a2, s0);
            PG8_WAIT_V(8); PG8_WAIT_L(0); PG8_BAR; PG8_MMA(1, 0, At, B0); PG8_MMA(1, 1, At, B1); PG8_BAR; PG8_SCHED;
            PG8_LDB(B0, 1, 0); PG8_LDB(B1, 1, 1); PG8_SCHED; PG8_LDA(At, 1, 0); PG8_STAGE(PG8_SA(0, 1), a2, s1);
            PG8_WAIT_V(8); PG8_WAIT_L(0); PG8_BAR; PG8_MMA(0, 0, At, B0); PG8_MMA(0, 1, At, B1); PG8_BAR; PG8_SCHED;
            PG8_LDA(At, 1, 1); PG8_STAGE(PG8_SB(1, 0), b3, voffB); PG8_STAGE(PG8_SB(1, 1), b3 + hB, voffB); PG8_STAGE(PG8_SA(1, 0), a3, s0);
            PG8_WAIT_V(8); PG8_WAIT_L(0); PG8_BAR; PG8_MMA(1, 0, At, B0); PG8_MMA(1, 1, At, B1); PG8_BAR; PG8_SCHED;
        }
        if (wr == 0) PG8_BAR;
        if constexpr (FP8) asm volatile("s_nop 15\n\ts_nop 15\n\ts_nop 15" ::: "memory");
        const bool has_nn = has_next && S.next(ui + 2, nn);
        if (has_nn) PG8_ROWOFF(nn, tv);
        cur.bs = ui & 1;
        E(acc, cur, wr, wc, fr, fq);
        if (!has_next) break;
#pragma unroll
        for (int a = 0; a < 2; ++a)
#pragma unroll
            for (int b = 0; b < 2; ++b)
#pragma unroll
                for (int m = 0; m < 4; ++m)
#pragma unroll
                    for (int n = 0; n < 2; ++n) acc[a][b][m][n] = (f32x4){0.f, 0.f, 0.f, 0.f};
        cur = nxt; cB = nB; ++ui;
#pragma unroll
        for (int h = 0; h < 2; ++h)
#pragma unroll
            for (int i = 0; i < 2; ++i) { cv[h][i] = nv[h][i]; if (has_nn) nv[h][i] = tv[h][i]; }
        asm volatile("" : "+v"(nv[0][0]), "+v"(nv[0][1]), "+v"(nv[1][0]), "+v"(nv[1][1]));
        nxt = nn; has_next = has_nn;
        if (wr == 1) PG8_BAR;
    }
    PG8_WAIT_V(0);
    PG8_BAR;
#undef PG8_SA
#undef PG8_SB
#undef PG8_STAGE
#undef PG8_LDA
#undef PG8_LDB
#undef PG8_MMA
#undef PG8_WAIT_V
#undef PG8_WAIT_L
#undef PG8_BAR
#undef PG8_SCHED
#undef PG8_ROWOFF
}

struct DenseOrder {
    const char* A; const char* B; size_t a_tile, b_tile; int nt, nM, nN, G, c; int pn_off = 0;
    __device__ __forceinline__ bool next(int i, Unit& u) const {
        const long L = (long)i * G + c; if (L >= (long)nM * nN) return false;
        int pm, pn; tile_of((int)L, nM, nN, pm, pn);
        u.pm = pm; u.pn = pn + pn_off; u.aux = 0; u.nt = nt; u.A = A + (size_t)pm * a_tile; u.B = B + (size_t)pn * b_tile; return true;
    }
};
struct ProjOrder {
    const char* Y; const char* W; int nM, nN, G, c;
    __device__ __forceinline__ bool next(int i, Unit& u) const {
        const int ti = i / 3, br = i - 3 * ti;
        const long L = (long)ti * G + c; if (L >= (long)nM * nN) return false;
        int pm, pn; tile_of((int)L, nM, nN, pm, pn);
        u.pm = pm; u.pn = pn; u.aux = br; u.nt = (br == 2) ? 6 : 4;
        const int acol = (br == 0) ? 0 : (br == 1 ? 256 : 384), bcol = (br == 0) ? 0 : (br == 1 ? 256 : 512);
        u.A = Y + ((size_t)pm * 256 * YLD + acol) * 2; u.B = W + ((size_t)pn * 256 * WPK + bcol) * 2; return true;
    }
};
struct MoeOrder {
    const char* A; const char* W; size_t estride, atile, btile; int nt; const LAS int* tile_e; const LAS int* offT; const LAS int* cnt; const int* SRC; int T, nN, G, c;
    __device__ __forceinline__ bool next(int i, Unit& u) const {
        const long L = (long)i * G + c; if (L >= (long)T * nN) return false;
        int pm, pn; tile_of((int)L, T, nN, pm, pn);
        const int e = __builtin_amdgcn_readfirstlane(tile_e[pm]);
        u.pm = pm; u.pn = pn; u.aux = e; u.nt = nt; u.A = A + (size_t)pm * atile; u.B = W + (size_t)e * estride + (size_t)pn * btile; return true;
    }
    __device__ __forceinline__ int rowtok(const Unit& u, int r) const {
        const int e = u.aux, rank = (u.pm - offT[e]) * 256 + r, last = cnt[e] - 1;
        return SRC[e * NTOK + (rank < last ? rank : last)];
    }
};

struct EpiInProj {
    static constexpr bool PERM = true, KEEP = false, BIAS_DMA = true;
    bf16_t* H; const float* bg; const f32x2* r64; const f32x2* r48; float gscale; unsigned char* G8; PG8_LAS unsigned char* ldsb;
    __device__ __forceinline__ void bias_dma(const Unit& u, int s, int lane, PG8_LAS unsigned char* lds) const {
        const int o = u.pn >= 12 ? (u.pn - 12) * BM : 0;
        glds16_u(bg + o + lane * 4, (unsigned)__builtin_amdgcn_readfirstlane((int)(unsigned)(size_t)(lds + L_BIAS_OFF + s * 1024))); }
    __device__ __forceinline__ void operator()(f32x4 (&acc)[2][2][4][2], const Unit& u, int wr, int wc, int fr, int fq) const {
        const int row0 = u.pm * BM + wr * 64 + fr, pn = u.pn, t0 = wc * 32 + 8 * fq;
        const float gs = gscale; unsigned char* const g8 = G8;
        if (pn >= 3 && pn < 9) {
            int dst, hstep, tw, dd0; const f32x2* tab;
            if (pn < 6) { dst = 768 + (4 * (pn - 3) + wc) * 64 + 8 * fq; hstep = 32; tw = 32; dd0 = 8 * fq; tab = r64; }
            else { const int p0 = 128 * (pn - 6) + t0, slot = p0 / 24; dd0 = p0 - slot * 24; dst = 1920 + slot * 48 + dd0; hstep = 24; tw = 24; tab = r48; }
#pragma unroll
            for (int ai = 0; ai < 2; ++ai)
#pragma unroll
                for (int m = 0; m < 4; ++m) { const int row = row0 + ai * HALF + m * 16; const f32x2* tp = tab + (size_t)(row & (SEQ - 1)) * tw + dd0;
                    f32x4 y1[2], y2[2];
#pragma unroll
                    for (int n = 0; n < 2; ++n) { const f32x4 cs0 = *(const f32x4*)(tp + 4 * n), cs1 = *(const f32x4*)(tp + 4 * n + 2);
                        const f32x4 x1 = acc[ai][0][m][n], x2 = acc[ai][1][m][n];
                        y1[n][0] = x1[0] * cs0[0] - x2[0] * cs0[1]; y2[n][0] = x2[0] * cs0[0] + x1[0] * cs0[1];
                        y1[n][1] = x1[1] * cs0[2] - x2[1] * cs0[3]; y2[n][1] = x2[1] * cs0[2] + x1[1] * cs0[3];
                        y1[n][2] = x1[2] * cs1[0] - x2[2] * cs1[1]; y2[n][2] = x2[2] * cs1[0] + x1[2] * cs1[1];
                        y1[n][3] = x1[3] * cs1[2] - x2[3] * cs1[3]; y2[n][3] = x2[3] * cs1[2] + x1[3] * cs1[3]; }
                    bf16_t* rowp = H + (size_t)row * INC + dst;
                    u32x4 w; w.x = cvt_pk_bf16(y1[0][0], y1[0][1]); w.y = cvt_pk_bf16(y1[0][2], y1[0][3]); w.z = cvt_pk_bf16(y1[1][0], y1[1][1]); w.w = cvt_pk_bf16(y1[1][2], y1[1][3]);
                    *(u32x4*)rowp = w;
                    w.x = cvt_pk_bf16(y2[0][0], y2[0][1]); w.y = cvt_pk_bf16(y2[0][2], y2[0][3]); w.z = cvt_pk_bf16(y2[1][0], y2[1][1]); w.w = cvt_pk_bf16(y2[1][2], y2[1][3]);
                    *(u32x4*)(rowp + hstep) = w; }
            return;
        }
        const bool gate = pn >= 12;
        int dcol[2];
#pragma unroll
        for (int bj = 0; bj < 2; ++bj) { const int x = pn * BM + bj * HALF + t0;
            if (pn >= 9 && pn < 12) { const int xx = x - 2304; dcol[bj] = xx < 384 ? 1536 + xx : 2688 + (xx - 384); } else dcol[bj] = x; }
        f32x4 bv[2][2];
#pragma unroll
        for (int bj = 0; bj < 2; ++bj)
#pragma unroll
            for (int n = 0; n < 2; ++n) bv[bj][n] = gate ? *(const PG8_LAS f32x4*)((const PG8_LAS float*)(ldsb + L_BIAS_OFF + u.bs * 1024) + bj * HALF + t0 + 4 * n) : (f32x4){0.f, 0.f, 0.f, 0.f};
#pragma unroll
        for (int ai = 0; ai < 2; ++ai)
#pragma unroll
            for (int m = 0; m < 4; ++m) { bf16_t* rowp = H + (size_t)(row0 + ai * HALF + m * 16) * INC;
#pragma unroll
                for (int bj = 0; bj < 2; ++bj) { f32x4 v0 = acc[ai][bj][m][0], v1 = acc[ai][bj][m][1];
                    if (gate) {
#pragma unroll
                        for (int q = 0; q < 4; ++q) { v0[q] = v0[q] * gs + bv[bj][0][q]; v1[q] = v1[q] * gs + bv[bj][1][q]; }
                        const unsigned b0 = (unsigned)(fast_sigmoid(v0[0]) * 255.0f + 0.5f) | ((unsigned)(fast_sigmoid(v0[1]) * 255.0f + 0.5f) << 8) | ((unsigned)(fast_sigmoid(v0[2]) * 255.0f + 0.5f) << 16) | ((unsigned)(fast_sigmoid(v0[3]) * 255.0f + 0.5f) << 24);
                        const unsigned b1 = (unsigned)(fast_sigmoid(v1[0]) * 255.0f + 0.5f) | ((unsigned)(fast_sigmoid(v1[1]) * 255.0f + 0.5f) << 8) | ((unsigned)(fast_sigmoid(v1[2]) * 255.0f + 0.5f) << 16) | ((unsigned)(fast_sigmoid(v1[3]) * 255.0f + 0.5f) << 24);
                        *(v2u*)(g8 + (size_t)(row0 + ai * HALF + m * 16) * 3072 + (dcol[bj] - C_GP)) = (v2u){b0, b1};
                    } else {
                        u32x4 w; w.x = cvt_pk_bf16(v0[0], v0[1]); w.y = cvt_pk_bf16(v0[2], v0[3]); w.z = cvt_pk_bf16(v1[0], v1[1]); w.w = cvt_pk_bf16(v1[2], v1[3]);
                        *(u32x4*)(rowp + dcol[bj]) = w; } } }
    }
};
struct EpiProj {
    static constexpr bool PERM = false, KEEP = true, BIAS_DMA = false;
    const unsigned char* G8; bf16_t* Mg;
    __device__ __forceinline__ void operator()(f32x4 (&acc)[2][2][4][2], const Unit& u, int wr, int wc, int fr, int fq) const {
        const int row0 = u.pm * BM + wr * 64 + fr, col0 = u.pn * BM + wc * 32 + 4 * fq, br = u.aux;
#pragma unroll
        for (int ai = 0; ai < 2; ++ai)
#pragma unroll
            for (int m = 0; m < 4; ++m) { const size_t row = (size_t)(row0 + ai * HALF + m * 16);
#pragma unroll
                for (int bj = 0; bj < 2; ++bj)
#pragma unroll
                    for (int n = 0; n < 2; ++n) { const int c = col0 + bj * HALF + n * 16;
                        const unsigned char* gp = G8 + row * 3072 + br * 1024 + c;
                        const unsigned gw = *(const unsigned*)gp;
                        f32x4 g = (f32x4){fmaxf((float)(gw & 255u) * (1.0f / 255.0f), 1e-6f), fmaxf((float)((gw >> 8) & 255u) * (1.0f / 255.0f), 1e-6f), fmaxf((float)((gw >> 16) & 255u) * (1.0f / 255.0f), 1e-6f), fmaxf((float)(gw >> 24) * (1.0f / 255.0f), 1e-6f)};
                        if (br < 2) { const unsigned nw = *(const unsigned*)(gp + 1024);
                            g[0] *= __builtin_amdgcn_rcpf(fmaxf((float)(nw & 255u) * (1.0f / 255.0f), 1e-6f)); g[1] *= __builtin_amdgcn_rcpf(fmaxf((float)((nw >> 8) & 255u) * (1.0f / 255.0f), 1e-6f));
                            g[2] *= __builtin_amdgcn_rcpf(fmaxf((float)((nw >> 16) & 255u) * (1.0f / 255.0f), 1e-6f)); g[3] *= __builtin_amdgcn_rcpf(fmaxf((float)(nw >> 24) * (1.0f / 255.0f), 1e-6f));
                            acc[ai][bj][m][n] = acc[ai][bj][m][n] * g; }
                        else { const f32x4 t = acc[ai][bj][m][n] * g; v2u o; o.x = cvt_pk_bf16(t[0], t[1]); o.y = cvt_pk_bf16(t[2], t[3]); *(v2u*)(Mg + row * 1024 + c) = o; } } }
    }
};
struct EpiOut {
    static constexpr bool PERM = false, KEEP = false, BIAS_DMA = false;
    const float* X; const bf16_t* XBr; float* P;
    __device__ __forceinline__ void operator()(f32x4 (&acc)[2][2][4][2], const Unit& u, int wr, int wc, int fr, int fq) const {
        const int row0 = u.pm * BM + wr * 64 + fr, col0 = u.pn * BM + wc * 32 + 4 * fq;
        const float* const Xf = X; const bf16_t* const Xh = XBr; float* const Pp = P;
#pragma unroll
        for (int ai = 0; ai < 2; ++ai)
#pragma unroll
            for (int m = 0; m < 4; ++m) { const size_t ro = (size_t)(row0 + ai * HALF + m * 16) * 1024 + col0;
#pragma unroll
                for (int bj = 0; bj < 2; ++bj)
#pragma unroll
                    for (int n = 0; n < 2; ++n) { f32x4 xv;
                        if (Xf) xv = *(const f32x4*)(Xf + ro + bj * HALF + n * 16);
                        else { const v2u xw = *(const v2u*)(Xh + ro + bj * HALF + n * 16); xv = (f32x4){bflo(xw.x), bfhi(xw.x), bflo(xw.y), bfhi(xw.y)}; }
                        *(f32x4*)(Pp + ro + bj * HALF + n * 16) = xv * DN_ALPHA + acc[ai][bj][m][n]; } }
    }
};
struct EpiSwiglu {
    static constexpr bool PERM = true, KEEP = false, BIAS_DMA = true;
    unsigned char* HH; const float* bgate; const float* bup; float ascale; PG8_LAS unsigned char* ldsb;
    __device__ __forceinline__ void bias_dma(const Unit& u, int s, int lane, PG8_LAS unsigned char* lds) const {
        const float* src = (lane < 32 ? bgate : bup) + u.aux * 1024 + u.pn * HALF + (lane & 31) * 4;
        glds16_u(src, (unsigned)__builtin_amdgcn_readfirstlane((int)(unsigned)(size_t)(lds + L_BIAS_OFF + s * 1024))); }
    __device__ __forceinline__ void operator()(f32x4 (&acc)[2][2][4][2], const Unit& u, int wr, int wc, int fr, int fq) const {
        const int row0 = u.pm * BM + wr * 64 + fr, j0 = u.pn * HALF + wc * 32 + 8 * fq, e = u.aux;
        f32x4 bg[2], bu[2];
#pragma unroll
        for (int n = 0; n < 2; ++n) { const PG8_LAS float* bl = (const PG8_LAS float*)(ldsb + L_BIAS_OFF + u.bs * 1024) + wc * 32 + 8 * fq + 4 * n; bg[n] = *(const PG8_LAS f32x4*)bl; bu[n] = *(const PG8_LAS f32x4*)(bl + HALF); }
#pragma unroll
        for (int ai = 0; ai < 2; ++ai)
#pragma unroll
            for (int m = 0; m < 4; ++m) { unsigned char* rowp = HH + (size_t)(row0 + ai * HALF + m * 16) * 1024 + j0;
                f32x4 o[2];
#pragma unroll
                for (int n = 0; n < 2; ++n) { f32x4 g = acc[ai][0][m][n] * ascale + bg[n], uu = acc[ai][1][m][n] * ascale + bu[n];
#pragma unroll
                    for (int q = 0; q < 4; ++q) { const float hg = fminf(g[q], 7.0f), hu = fminf(fmaxf(uu[q], -7.0f), 7.0f);
                        o[n][q] = hg * fast_sigmoid(1.702f * hg) * (hu + 1.0f); } }
                v2u w; w.x = pk4_fp8(o[0][0], o[0][1], o[0][2], o[0][3], 4.0f); w.y = pk4_fp8(o[1][0], o[1][1], o[1][2], o[1][3], 4.0f);
                *(v2u*)rowp = w; }
    }
};
struct EpiDown {
    static constexpr bool PERM = true, KEEP = false, BIAS_DMA = true;
    bf16_t* YS; const float* bd; float ascale; PG8_LAS unsigned char* ldsb;
    __device__ __forceinline__ void bias_dma(const Unit& u, int s, int lane, PG8_LAS unsigned char* lds) const {
        glds16_u(bd + u.aux * 1024 + u.pn * BM + lane * 4, (unsigned)__builtin_amdgcn_readfirstlane((int)(unsigned)(size_t)(lds + L_BIAS_OFF + s * 1024))); }
    __device__ __forceinline__ void operator()(f32x4 (&acc)[2][2][4][2], const Unit& u, int wr, int wc, int fr, int fq) const {
        const int row0 = u.pm * BM + wr * 64 + fr, col0 = u.pn * BM + wc * 32 + 8 * fq, e = u.aux;
        f32x4 bv[2][2];
#pragma unroll
        for (int bj = 0; bj < 2; ++bj)
#pragma unroll
            for (int n = 0; n < 2; ++n) bv[bj][n] = *(const PG8_LAS f32x4*)((const PG8_LAS float*)(ldsb + L_BIAS_OFF + u.bs * 1024) + wc * 32 + 8 * fq + bj * HALF + 4 * n);
#pragma unroll
        for (int ai = 0; ai < 2; ++ai)
#pragma unroll
            for (int m = 0; m < 4; ++m) { bf16_t* rowp = YS + (size_t)(row0 + ai * HALF + m * 16) * 1024 + col0;
#pragma unroll
                for (int bj = 0; bj < 2; ++bj) { const f32x4 v0 = acc[ai][bj][m][0] * ascale + bv[bj][0], v1 = acc[ai][bj][m][1] * ascale + bv[bj][1];
                    u32x4 w; w.x = cvt_pk_bf16(v0[0], v0[1]); w.y = cvt_pk_bf16(v0[2], v0[3]); w.z = cvt_pk_bf16(v1[0], v1[1]); w.w = cvt_pk_bf16(v1[2], v1[3]);
                    *(u32x4*)(rowp + bj * HALF) = w; } }
    }
};
}

#define XB_TMO      128
#define XB_XCNT(j)  (256  + 64 * (j))
#define XB_XSUB(j)  (1280 + 64 * (j))
#define XB_XGEN(j)  (2304 + 64 * (j))
#define XB_TOP      3328
#define XB_TOPGEN   3392
#define XCD_BAR_WORDS 3456
#define XB_SPIN_CAP (1u << 18)

__device__ __forceinline__ unsigned xb_ld(unsigned* p)              { return __hip_atomic_load(p, __ATOMIC_RELAXED, __HIP_MEMORY_SCOPE_AGENT); }
__device__ __forceinline__ unsigned xb_add(unsigned* p, unsigned v) { return __hip_atomic_fetch_add(p, v, __ATOMIC_RELAXED, __HIP_MEMORY_SCOPE_AGENT); }
__device__ __forceinline__ unsigned xb_xcc_id() { return (unsigned)__builtin_amdgcn_s_getreg((3 << 11) | 20) & 0xFu; }
#define XB_SPIN(cond, bar) do { unsigned _sp = 0; while (cond) { __builtin_amdgcn_s_sleep(1); \
    if ((++_sp & 255u) == 0u) { if (xb_ld(&(bar)[XB_TMO])) break; if (_sp > XB_SPIN_CAP) { atomicAdd(&(bar)[XB_TMO], 1u); break; } } } } while (0)

struct XcdBarrier { unsigned* bar; unsigned x; volatile LAS unsigned* st; };

__device__ __forceinline__ XcdBarrier xcd_barrier_post(unsigned* bar, volatile LAS unsigned* st) {
    XcdBarrier b; b.bar = bar; b.x = xb_xcc_id(); b.st = st;
    if (threadIdx.x == 0) (void)xb_add(&bar[XB_XCNT(b.x)], 1u);
    return b;
}
__device__ __forceinline__ void xcd_barrier_complete(unsigned* bar, unsigned x, unsigned& nloc, unsigned& nx) {
    const unsigned G = gridDim.x * gridDim.y * gridDim.z;
    unsigned sum, cnt, mine, sp = 0u;
    for (;;) {
        sum = 0u; cnt = 0u; mine = 0u;
#pragma unroll
        for (unsigned j = 0; j < 16; ++j) { const unsigned c = xb_ld(&bar[XB_XCNT(j)]); sum += c; cnt += (c > 0u) ? 1u : 0u; mine = (j == x) ? c : mine; }
        if (sum == G) break;
        __builtin_amdgcn_s_sleep(1);
        if ((++sp & 255u) == 0u) { if (xb_ld(&bar[XB_TMO])) break; if (sp > XB_SPIN_CAP) { atomicAdd(&bar[XB_TMO], 1u); break; } }
    }
    nloc = mine > 0u ? mine : 1u; nx = cnt > 0u ? cnt : 1u;
}
__device__ __forceinline__ void xcd_barrier(const XcdBarrier& b) {
    asm volatile("s_waitcnt vmcnt(0)" ::: "memory");
    __syncthreads();
    if (threadIdx.x == 0) {
        unsigned* bar = b.bar;
        __builtin_amdgcn_s_waitcnt(0);
        unsigned nloc = b.st[0], nx = b.st[1];
        if (nloc == 0u) { xcd_barrier_complete(bar, b.x, nloc, nx); b.st[0] = nloc; b.st[1] = nx; }
        const unsigned old = xb_add(&bar[XB_XSUB(b.x)], 1u);
        const unsigned gen = old / nloc;
        if (old + 1u == (gen + 1u) * nloc) {
            __builtin_amdgcn_fence(__ATOMIC_RELEASE, "agent");
            asm volatile("s_waitcnt vmcnt(0)" ::: "memory");
            const unsigned og = xb_add(&bar[XB_TOP], 1u);
            const unsigned tg = og / nx;
            if (og + 1u == (tg + 1u) * nx) xb_add(&bar[XB_TOPGEN], 1u);
            else XB_SPIN(xb_ld(&bar[XB_TOPGEN]) == tg, bar);
            __builtin_amdgcn_fence(__ATOMIC_ACQUIRE, "agent");
            xb_add(&bar[XB_XGEN(b.x)], 1u);
            asm volatile("s_waitcnt vmcnt(0)" ::: "memory");
        } else {
            XB_SPIN(xb_ld(&bar[XB_XGEN(b.x)]) == gen, bar);
            __builtin_amdgcn_fence(__ATOMIC_ACQUIRE, "agent");
            asm volatile("s_waitcnt vmcnt(0)" ::: "memory");
        }
    }
    __syncthreads();
}

struct Frame {
    LAS unsigned char* lds;
    unsigned* ctl;
    unsigned char* ws;
    int tid, lane, wave, G, bid;
};

__host__ __device__ __forceinline__ int inproj_phys(int nl) {
    if (nl < 768) return nl;
    if (nl < 1536) { const int x = nl - 768, slot = x >> 6, d = x & 63; return 768 + (slot >> 2) * 256 + (d >> 5) * 128 + (slot & 3) * 32 + (d & 31); }
    if (nl < 1920) return 2304 + (nl - 1536);
    if (nl < 2688) { const int x = nl - 1920, slot = x / 48, d = x - slot * 48, hf = d >= 24 ? 1 : 0, p = slot * 24 + d - 24 * hf; return 1536 + (p >> 7) * 256 + hf * 128 + (p & 127); }
    if (nl < 3072) return 2304 + 384 + (nl - 2688);
    return nl;
}
template <class RowMap>
__device__ __forceinline__ void transpose_item(const float* W, int N, bf16* dst, int ldd, int k0, int n0, const RowMap rowmap, LAS float* scr, int lane) {
#pragma unroll 8
    for (int i = 0; i < 32; ++i) { const int kk = 2 * i + (lane >> 5); scr[kk * 33 + (lane & 31)] = W[(size_t)(k0 + kk) * N + n0 + (lane & 31)]; }
    LDS_WAIT(); asm volatile("" ::: "memory");
    const int c = lane & 7;
#pragma unroll
    for (int j = 0; j < 4; ++j) { const int n = (lane >> 3) + 8 * j; const LAS float* sp = scr + (8 * c) * 33 + n;
        v4u o; o.x = pk2(sp[0 * 33], sp[1 * 33]); o.y = pk2(sp[2 * 33], sp[3 * 33]); o.z = pk2(sp[4 * 33], sp[5 * 33]); o.w = pk2(sp[6 * 33], sp[7 * 33]);
        *(v4u*)(dst + (size_t)rowmap(n0 + n) * ldd + k0 + 8 * c) = o; }
    LDS_WAIT(); asm volatile("" ::: "memory");
}

template <class RowMap>
__device__ __forceinline__ void transpose_item_fp8(const float* W, int N, unsigned char* dst, int ldd, int k0, int n0, const RowMap rowmap, LAS float* scr, int lane, float qs) {
#pragma unroll 8
    for (int i = 0; i < 32; ++i) { const int kk = 2 * i + (lane >> 5); scr[kk * 33 + (lane & 31)] = W[(size_t)(k0 + kk) * N + n0 + (lane & 31)]; }
    LDS_WAIT(); asm volatile("" ::: "memory");
    const int c = lane & 7;
#pragma unroll
    for (int j = 0; j < 4; ++j) { const int n = (lane >> 3) + 8 * j; const LAS float* sp = scr + (8 * c) * 33 + n;
        v2u o; o.x = pk4_fp8(sp[0 * 33], sp[1 * 33], sp[2 * 33], sp[3 * 33], qs); o.y = pk4_fp8(sp[4 * 33], sp[5 * 33], sp[6 * 33], sp[7 * 33], qs);
        *(v2u*)(dst + (size_t)rowmap(n0 + n) * ldd + k0 + 8 * c) = o; }
    LDS_WAIT(); asm volatile("" ::: "memory");
}

struct Args { const float* in[22]; float* out; unsigned char* ws; int ph_lo, ph_hi; float lam_init[4]; };

__device__ __forceinline__ void p_prologue(Frame& F, const Args& a) {
    LAS float* scr = (LAS float*)(F.lds + F.wave * 16384);
    const int gw = F.bid * 8 + F.wave, NGW = F.G * 8;
    constexpr int PER_LAYER = 3072 + 128 + 64 + 192 + 512 + 32 * 1536;
    for (int it = gw; it < DEPTH * PER_LAYER; it += NGW) {
        const int l = it / PER_LAYER; int r = it - l * PER_LAYER;
        if (r < 3072) { const int kb = r / 192, nb = r % 192;
            if (nb < 96) transpose_item(a.in[1] + (size_t)l * 1024 * INC, INC, (bf16*)(F.ws + WS_WIN) + (size_t)l * INC * 1024, 1024, kb * 64, nb * 32, [](int n) { return inproj_phys(n); }, scr, F.lane);
            else transpose_item_fp8(a.in[1] + (size_t)l * 1024 * INC, INC, (unsigned char*)(F.ws + WS_WIN8) + (size_t)l * 3072 * 1024, 1024, kb * 64, nb * 32, [](int n) { return n - 3072; }, scr, F.lane, 32.f);
            continue; }
        r -= 3072;
        if (r < 128) { const int kb = r / 32, nb = r % 32;
            transpose_item(a.in[3] + (size_t)l * 256 * 1024, 1024, (bf16*)(F.ws + WS_WPROJ) + (size_t)l * 1024 * WPK + 0, WPK, kb * 64, nb * 32, [](int n) { return n; }, scr, F.lane); continue; }
        r -= 128;
        if (r < 64) { const int kb = r / 32, nb = r % 32;
            transpose_item(a.in[4] + (size_t)l * 128 * 1024, 1024, (bf16*)(F.ws + WS_WPROJ) + (size_t)l * 1024 * WPK + 256, WPK, kb * 64, nb * 32, [](int n) { return n; }, scr, F.lane); continue; }
        r -= 64;
        if (r < 192) { const int kb = r / 32, nb = r % 32;
            transpose_item(a.in[5] + (size_t)l * 384 * 1024, 1024, (bf16*)(F.ws + WS_WPROJ) + (size_t)l * 1024 * WPK + 512, WPK, kb * 64, nb * 32, [](int n) { return n; }, scr, F.lane); continue; }
        r -= 192;
        if (r < 512) { const int kb = r / 32, nb = r % 32;
            transpose_item(a.in[6] + (size_t)l * 1024 * 1024, 1024, (bf16*)(F.ws + WS_WOUT) + (size_t)l * 1024 * 1024, 1024, kb * 64, nb * 32, [](int n) { return n; }, scr, F.lane); continue; }
        r -= 512;
        { const int e = r / 1536, r2 = r % 1536, mtx = r2 / 512, r3 = r2 % 512, kb = r3 / 32, nb = r3 % 32;
          const size_t eoff = ((size_t)l * NEXP + e) * 1024 * 1024;
          if (mtx == 0) transpose_item_fp8(a.in[14] + eoff, 1024, (unsigned char*)(F.ws + WS_WGU) + 2 * eoff, 1024, kb * 64, nb * 32, [](int n) { return (n >> 7) * 256 + (n & 127); }, scr, F.lane, 32.f);
          else if (mtx == 1) transpose_item_fp8(a.in[16] + eoff, 1024, (unsigned char*)(F.ws + WS_WGU) + 2 * eoff, 1024, kb * 64, nb * 32, [](int n) { return (n >> 7) * 256 + 128 + (n & 127); }, scr, F.lane, 32.f);
          else transpose_item_fp8(a.in[18] + eoff, 1024, (unsigned char*)(F.ws + WS_WDN) + eoff, 1024, kb * 64, nb * 32, [](int n) { return n; }, scr, F.lane, 64.f); }
    }
    { const int gt = F.bid * 512 + F.tid, NT = F.G * 512;
      for (int i = gt; i < DEPTH * 1024 * 16; i += NT) { const int row = i >> 4, ch = i & 15;
          *(v4u*)((bf16*)(F.ws + WS_WPROJ) + (size_t)row * WPK + 384 + ch * 8) = (v4u){0u, 0u, 0u, 0u}; }
      for (int i = gt; i < SEQ * 32; i += NT) { const int pos = i >> 5, j = i & 31;
          const float inv = 1.0f / powf(10000.0f, (float)(2 * j) / 64.0f); const float ang = (float)pos * inv; float s, c; sincosf(ang, &s, &c);
          ((f32x2*)(F.ws + WS_ROPE64))[i] = (f32x2){c, s}; }
      for (int i = gt; i < SEQ * 24; i += NT) { const int pos = i / 24, j = i - pos * 24;
          const float inv = 1.0f / powf(10000.0f, (float)(2 * j) / 48.0f); const float ang = (float)pos * inv; float s, c; sincosf(ang, &s, &c);
          ((f32x2*)(F.ws + WS_ROPE48))[i] = (f32x2){c, s}; }
      for (int i = gt; i < DEPTH * 32 * 1024; i += NT) { const int l = i >> 15, e = (i >> 10) & 31, k = i & 1023;
          const float wv = a.in[12][((size_t)l * 1024 + k) * 32 + e]; const unsigned hi = f2bf(wv); const unsigned lo = f2bf(wv - __uint_as_float(hi << 16));
          bf16* wt = (bf16*)(F.ws + WS_WRT) + (size_t)l * 2 * 32 * 1024; wt[e * 1024 + k] = (bf16)hi; wt[32 * 1024 + e * 1024 + k] = (bf16)lo; }
      const f32x4* x4 = (const f32x4*)a.in[0]; v2u* xb = (v2u*)(F.ws + WS_XB);
      unsigned* xb8 = (unsigned*)(F.ws + WS_XB8);
      for (int i = gt; i < NTOK * 256; i += NT) { const f32x4 v = x4[i]; xb[i] = (v2u){pk2(v[0], v[1]), pk2(v[2], v[3])}; xb8[i] = pk4_fp8(v[0], v[1], v[2], v[3], 1.0f); }
    }
}

typedef float f32x16 __attribute__((ext_vector_type(16)));
typedef short s16x4 __attribute__((ext_vector_type(4)));
typedef float f32x2_t __attribute__((ext_vector_type(2)));
typedef __bf16 bf16x2_t __attribute__((ext_vector_type(2)));
__device__ __forceinline__ unsigned cvtpk(float lo, float hi) { const f32x2_t v = {lo, hi}; const bf16x2_t b = __builtin_convertvector(v, bf16x2_t); return __builtin_bit_cast(unsigned, b); }
__device__ __forceinline__ int kperm(int r) { return (r & ~12) | ((r & 4) << 1) | ((r & 8) >> 1); }
__device__ __forceinline__ s16x4 ds_tr16(const LAS unsigned char* p) { return __builtin_bit_cast(s16x4, __builtin_amdgcn_ds_read_tr16_b64_v4i16((LAS s16x4*)p)); }

__device__ __forceinline__ float fmax_nc(float a, float b) { return __builtin_amdgcn_fmed3f(a, b, __builtin_inff()); }
__device__ __forceinline__ void glds16(const void* gsrc, unsigned lds_dst) { unsigned keep;
    asm volatile("s_mov_b32 %0, m0\n\ts_mov_b32 m0, %2\n\ts_nop 0\n\tglobal_load_lds_dwordx4 %1, off\n\ts_mov_b32 m0, %0" : "=&s"(keep) : "v"(gsrc), "s"(lds_dst) : "memory"); }
__device__ __forceinline__ void attnC_pipe(Frame& F, const float* lamv, const float* ng, float lam_init) {
    const bf16* H = (const bf16*)(F.ws + WS_H); bf16* Y = (bf16*)(F.ws + WS_Y);
    const int lane = F.lane, w = F.wave, n = lane & 31, hh = lane >> 5;
    float l01 = 0.f, l23 = 0.f;
    if (lane < 48) { l01 = lamv[lane] * lamv[48 + lane]; l23 = lamv[96 + lane] * lamv[144 + lane]; }
    l01 = wave_sum(l01); l23 = wave_sum(l23);
    const float lam = expf(l01) - expf(l23) + lam_init;
    const float post = 1.0f - lam_init;
    constexpr int KST = 208, VST = 192, KBYTES = 64 * KST, STAGE = KBYTES + 64 * VST, NT = SEQ / 64;
    constexpr float CS = 0.14433756729740643f * 1.4426950408889634f;
    constexpr float PMAX = 256.0f;
    unsigned goff[4], loff[4];
#pragma unroll
    for (int j = 0; j < 4; ++j) { const int I = w + 8 * j;
        if (I < 13) { const int cid = I * 64 + lane, row = cid / 13; int col = cid - row * 13; if (col == 12) col = 0;
            goff[j] = (unsigned)(row * INC + C_KC + col * 8) * 2u; loff[j] = (unsigned)(I * 1024); }
        else { const int cid = (I - 13) * 64 + lane, row = cid / 12, col = cid - row * 12;
            goff[j] = (unsigned)(row * INC + C_VC + col * 8) * 2u; loff[j] = (unsigned)(KBYTES + (I - 13) * 1024); } }
    const int koff = kperm(n) * KST + hh * 16;
    const int g = lane >> 4, i16 = lane & 15;
    const int voff = KBYTES + (8 * (g >> 1) + (i16 >> 2)) * VST + (16 * (g & 1) + 4 * (i16 & 3)) * 2;
#define C_ISSUE(tt) do { const char* gb_ = gbase + (size_t)(tt) * (64 * INC * 2); const int so_ = ((tt) & 3) * STAGE; _Pragma("unroll") for (int j_ = 0; j_ < 4; ++j_) if (w + 8 * j_ < 25) \
        glds16(gb_ + goff[j_], (unsigned)__builtin_amdgcn_readfirstlane((int)(unsigned)(size_t)(F.lds + so_ + loff[j_]))); } while (0)
#define C_RDV(slotV, kbV, s2v) do { _Pragma("unroll") for (int d_ = 0; d_ < 3; ++d_) { const LAS unsigned char* vp_ = (slotV) + voff + ((kbV) * 32 + 16 * (s2v)) * VST + d_ * 64; \
            const s16x4 v0_ = ds_tr16(vp_), v1_ = ds_tr16(vp_ + 4 * VST); vf[d_] = (bf16x8){v0_[0], v0_[1], v0_[2], v0_[3], v1_[0], v1_[1], v1_[2], v1_[3]}; } } while (0)
#define C_FENCE __builtin_amdgcn_sched_barrier(0)
#define C_QK0(dst, slotbase) do { { const bf16x8 kf_ = *(const LAS bf16x8*)((slotbase) + koff); dst = __builtin_amdgcn_mfma_f32_32x32x16_bf16(kf_, qf[0][0], NEGR[0], 0, 0, 0); } \
        _Pragma("unroll") for (int s_ = 1; s_ < 3; ++s_) { const bf16x8 kf_ = *(const LAS bf16x8*)((slotbase) + koff + (2 * s_) * 16); dst = __builtin_amdgcn_mfma_f32_32x32x16_bf16(kf_, qf[0][s_], dst, 0, 0, 0); } } while (0)
#define C_ITEM(Sx, c, pout, pin, cp, slotVp, kbVp, slotKc, kbKc, slotKn, kbKn, cn) do { \
        _Pragma("unroll") for (int s2_ = 0; s2_ < 2; ++s2_) _Pragma("unroll") for (int d_ = 0; d_ < 3; ++d_) { const LAS unsigned char* vp_ = (slotVp) + voff + ((kbVp) * 32 + 16 * s2_) * VST + d_ * 64; \
            const s16x4 v0_ = ds_tr16(vp_), v1_ = ds_tr16(vp_ + 4 * VST); vf[s2_ * 3 + d_] = (bf16x8){v0_[0], v0_[1], v0_[2], v0_[3], v1_[0], v1_[1], v1_[2], v1_[3]}; } \
        _Pragma("unroll") for (int s_ = 0; s_ < 3; ++s_) kf[s_] = *(const LAS bf16x8*)((slotKn) + (kbKn) * 32 * KST + koff + ((cn) * 6 + 2 * s_) * 16); \
        C_FENCE; \
        const float lold_ = l[c]; \
        _Pragma("unroll") for (int r_ = 0; r_ < 16; ++r_) Sx[r_] = __builtin_amdgcn_exp2f(Sx[r_]); \
        float pm_ = fmaxf(fmaxf(Sx[0], Sx[1]), Sx[2]); _Pragma("unroll") for (int r_ = 3; r_ < 15; r_ += 2) pm_ = fmaxf(fmaxf(pm_, Sx[r_]), Sx[r_ + 1]); pm_ = fmaxf(pm_, Sx[15]); \
        _Pragma("unroll") for (int r_ = 0; r_ < 16; ++r_) l[c] += Sx[r_]; \
        _Pragma("unroll") for (int s2_ = 0; s2_ < 2; ++s2_) { v4u pw_; pw_.x = cvtpk(Sx[8 * s2_ + 0], Sx[8 * s2_ + 1]); pw_.y = cvtpk(Sx[8 * s2_ + 2], Sx[8 * s2_ + 3]); \
            pw_.z = cvtpk(Sx[8 * s2_ + 4], Sx[8 * s2_ + 5]); pw_.w = cvtpk(Sx[8 * s2_ + 6], Sx[8 * s2_ + 7]); pout[s2_] = __builtin_bit_cast(bf16x8, pw_); } \
        _Pragma("unroll") for (int s2_ = 0; s2_ < 2; ++s2_) _Pragma("unroll") for (int d_ = 0; d_ < 3; ++d_) O[cp][d_] = __builtin_amdgcn_mfma_f32_32x32x16_bf16(vf[s2_ * 3 + d_], pin[s2_], O[cp][d_], 0, 0, 0); \
        _Pragma("unroll") for (int g_ = 0; g_ < 6; ++g_) { __builtin_amdgcn_sched_group_barrier(0x008, 1, 0); __builtin_amdgcn_sched_group_barrier(0x400, 3, 0); __builtin_amdgcn_sched_group_barrier(0x002, 7, 0); } \
        C_FENCE; \
        pm_ = fmaxf(pm_, __shfl_xor(pm_, 32)); \
        if (__any(pm_ > PMAX) || first) { f32x16 Sr_; \
            { const bf16x8 k0_ = *(const LAS bf16x8*)((slotKc) + (kbKc) * 32 * KST + koff + ((c) * 6 + 0) * 16), k1_ = *(const LAS bf16x8*)((slotKc) + (kbKc) * 32 * KST + koff + ((c) * 6 + 2) * 16), k2_ = *(const LAS bf16x8*)((slotKc) + (kbKc) * 32 * KST + koff + ((c) * 6 + 4) * 16); \
              Sr_ = __builtin_amdgcn_mfma_f32_32x32x16_bf16(k0_, qf[c][0], NEGR[c], 0, 0, 0); Sr_ = __builtin_amdgcn_mfma_f32_32x32x16_bf16(k1_, qf[c][1], Sr_, 0, 0, 0); Sr_ = __builtin_amdgcn_mfma_f32_32x32x16_bf16(k2_, qf[c][2], Sr_, 0, 0, 0); } \
            float mx_ = fmax_nc(Sr_[0], Sr_[1]); _Pragma("unroll") for (int r_ = 2; r_ < 16; ++r_) mx_ = fmax_nc(mx_, Sr_[r_]); mx_ = fmaxf(mx_, __shfl_xor(mx_, 32)); \
            const float dl_ = (pm_ > PMAX || first) ? mx_ : 0.0f, al_ = __builtin_amdgcn_exp2f(-dl_); \
            _Pragma("unroll") for (int d_ = 0; d_ < 3; ++d_) _Pragma("unroll") for (int r_ = 0; r_ < 16; ++r_) O[c][d_][r_] *= al_; \
            float ls_ = lold_ * al_; \
            _Pragma("unroll") for (int r_ = 0; r_ < 16; ++r_) { NEGR[c][r_] -= dl_; Sr_[r_] = __builtin_amdgcn_exp2f(Sr_[r_] - dl_); ls_ += Sr_[r_]; } \
            l[c] = ls_; \
            _Pragma("unroll") for (int s2_ = 0; s2_ < 2; ++s2_) { v4u pw_; pw_.x = cvtpk(Sr_[8 * s2_ + 0], Sr_[8 * s2_ + 1]); pw_.y = cvtpk(Sr_[8 * s2_ + 2], Sr_[8 * s2_ + 3]); \
                pw_.z = cvtpk(Sr_[8 * s2_ + 4], Sr_[8 * s2_ + 5]); pw_.w = cvtpk(Sr_[8 * s2_ + 6], Sr_[8 * s2_ + 7]); pout[s2_] = __builtin_bit_cast(bf16x8, pw_); } } \
        C_FENCE; \
        Sx = __builtin_amdgcn_mfma_f32_32x32x16_bf16(kf[0], qf[cn][0], NEGR[cn], 0, 0, 0); Sx = __builtin_amdgcn_mfma_f32_32x32x16_bf16(kf[1], qf[cn][1], Sx, 0, 0, 0); Sx = __builtin_amdgcn_mfma_f32_32x32x16_bf16(kf[2], qf[cn][2], Sx, 0, 0, 0); \
        C_FENCE; } while (0)
    for (int unit = F.bid; unit < 512; unit += F.G) {
        const int b = unit >> 6, h = (unit >> 4) & 3, qb = unit & 15;
        const int tok = b * SEQ + qb * 256 + w * 32 + n;
        const char* gbase = (const char*)(H + (size_t)(b * SEQ) * INC + h * 96);
        C_ISSUE(0); C_ISSUE(1);
        bf16x8 qf[2][3];
        { const bf16* qp = H + (size_t)tok * INC + C_QC + h * 96 + 8 * hh;
#pragma unroll
          for (int c = 0; c < 2; ++c)
#pragma unroll
              for (int s = 0; s < 3; ++s) { const v4u qw = *(const v4u*)(qp + c * 48 + 16 * s);
                  v4u qs; qs.x = cvtpk(bflo(qw.x) * CS, bfhi(qw.x) * CS); qs.y = cvtpk(bflo(qw.y) * CS, bfhi(qw.y) * CS); qs.z = cvtpk(bflo(qw.z) * CS, bfhi(qw.z) * CS); qs.w = cvtpk(bflo(qw.w) * CS, bfhi(qw.w) * CS);
                  qf[c][s] = __builtin_bit_cast(bf16x8, qs); } }
        f32x16 O[2][3];
#pragma unroll
        for (int c = 0; c < 2; ++c)
#pragma unroll
            for (int d = 0; d < 3; ++d)
#pragma unroll
                for (int r = 0; r < 16; ++r) O[c][d][r] = 0.f;
        float l[2] = {0.f, 0.f};
        f32x16 NEGR[2];
#pragma unroll
        for (int c = 0; c < 2; ++c)
#pragma unroll
            for (int r = 0; r < 16; ++r) NEGR[c][r] = 0.f;
        f32x16 S; bf16x8 pa[2], pb[2], kf[3], vf[6];
        pb[0] = (bf16x8){0, 0, 0, 0, 0, 0, 0, 0}; pb[1] = pb[0];
        for (int t = 0; t < NT; ++t) {
            asm volatile("s_waitcnt vmcnt(0)" ::: "memory"); __builtin_amdgcn_s_barrier(); asm volatile("" ::: "memory");
            if (t + 2 < NT) C_ISSUE(t + 2);
            const LAS unsigned char* cur = F.lds + (t & 3) * STAGE;
            const LAS unsigned char* prv = F.lds + ((t > 0 ? t - 1 : 0) & 3) * STAGE;
            const LAS unsigned char* nxt = F.lds + ((t + 1 < NT ? t + 1 : t) & 3) * STAGE;
            if (t == 0) C_QK0(S, cur);
            { const bool first = (t == 0);
            C_ITEM(S, 0, pa, pb, 1, prv, 1, cur, 0, cur, 0, 1);
            C_ITEM(S, 1, pb, pa, 0, cur, 0, cur, 0, cur, 1, 0); }
            { const bool first = false;
            C_ITEM(S, 0, pa, pb, 1, cur, 0, cur, 1, cur, 1, 1);
            C_ITEM(S, 1, pb, pa, 0, cur, 1, cur, 1, nxt, 0, 0); }
        }
        { const LAS unsigned char* lastb = F.lds + ((NT - 1) & 3) * STAGE;
#pragma unroll
          for (int s2 = 0; s2 < 2; ++s2)
#pragma unroll
              for (int d = 0; d < 3; ++d) { const LAS unsigned char* vp = lastb + voff + (32 + 16 * s2) * VST + d * 64; const s16x4 v0 = ds_tr16(vp), v1 = ds_tr16(vp + 4 * VST);
                  const bf16x8 vfl = (bf16x8){v0[0], v0[1], v0[2], v0[3], v1[0], v1[1], v1[2], v1[3]}; O[1][d] = __builtin_amdgcn_mfma_f32_32x32x16_bf16(vfl, pb[s2], O[1][d], 0, 0, 0); } }
        const float l0 = l[0] + __shfl_xor(l[0], 32), l1 = l[1] + __shfl_xor(l[1], 32);
        const float i0 = 1.0f / l0, i1 = lam / l1;
        float ss = 0.f;
#pragma unroll
        for (int d = 0; d < 3; ++d)
#pragma unroll
            for (int r = 0; r < 16; ++r) { const float o = O[0][d][r] * i0 - O[1][d][r] * i1; O[0][d][r] = o; ss += o * o; }
        ss += __shfl_xor(ss, 32);
        const float rs = rsqrtf(ss * (1.0f / 96.0f) + LN_EPS) * post;
        bf16* yp = Y + (size_t)tok * YLD + Y_C + h * 96 + 4 * hh;
#pragma unroll
        for (int d = 0; d < 3; ++d)
#pragma unroll
            for (int rg = 0; rg < 4; ++rg) { const f32x4 gv = *(const f32x4*)(ng + d * 32 + 8 * rg + 4 * hh);
                v2u o; o.x = pk2(O[0][d][4 * rg + 0] * rs * gv[0], O[0][d][4 * rg + 1] * rs * gv[1]); o.y = pk2(O[0][d][4 * rg + 2] * rs * gv[2], O[0][d][4 * rg + 3] * rs * gv[3]);
                *(v2u*)(yp + d * 32 + 8 * rg) = o; }
        asm volatile("s_waitcnt vmcnt(0)" ::: "memory"); __builtin_amdgcn_s_barrier(); asm volatile("" ::: "memory");
    }
#undef C_ISSUE
#undef C_RDV
#undef C_ITEM
#undef C_QK0
#undef C_FENCE
}

constexpr int AB_VST = 192, AB_VREG = 32 * AB_VST;
constexpr int L_RPB = 51200;

__device__ __forceinline__ void sm_block64(f32x16& t, float& m, float& l, f32x16 (&O)[2], bf16x8 (&pf)[2]) {
    float mx = fmaxf(t[0], t[1]);
#pragma unroll
    for (int r = 2; r < 16; ++r) mx = fmaxf(mx, t[r]);
    mx = fmaxf(mx, __shfl_xor(mx, 32));
    if (__any(mx > m)) {
        const float mn = fmaxf(m, mx), alpha = __builtin_amdgcn_exp2f(m - mn);
#pragma unroll
        for (int d = 0; d < 2; ++d)
#pragma unroll
            for (int r = 0; r < 16; ++r) O[d][r] *= alpha;
        l *= alpha; m = mn;
    }
#pragma unroll
    for (int r = 0; r < 16; ++r) { t[r] = __builtin_amdgcn_exp2f(t[r] - m); l += t[r]; }
#pragma unroll
    for (int s2 = 0; s2 < 2; ++s2) { v4u pw; pw.x = cvtpk(t[8 * s2 + 0], t[8 * s2 + 1]); pw.y = cvtpk(t[8 * s2 + 2], t[8 * s2 + 3]);
        pw.z = cvtpk(t[8 * s2 + 4], t[8 * s2 + 5]); pw.w = cvtpk(t[8 * s2 + 6], t[8 * s2 + 7]); pf[s2] = __builtin_bit_cast(bf16x8, pw); }
}
template <class TokOf, class MaskT>
__device__ __forceinline__ void attn_run_blocks(const bf16* H, const int kcol, const int vcol, const int nb, const TokOf tok_of, const MaskT mask,
                                                const bf16x8 (&qf)[4], LAS unsigned char* vl, const int lane, f32x16 (&O)[2], float& m, float& l) {
    const int n = lane & 31, hh = lane >> 5, krow = kperm(n), g = lane >> 4, i16 = lane & 15;
    const int vrd = (8 * (g >> 1) + (i16 >> 2)) * AB_VST + (16 * (g & 1) + 4 * (i16 & 3)) * 2;
    bf16x8 kf[4]; v4u vc[4];
    { const bf16* kp = H + (size_t)tok_of(0, krow) * INC + kcol + 8 * hh;
#pragma unroll
      for (int s = 0; s < 4; ++s) kf[s] = *(const bf16x8*)(kp + 16 * s);
#pragma unroll
      for (int i = 0; i < 4; ++i) vc[i] = *(const v4u*)(H + (size_t)tok_of(0, (lane >> 3) + 8 * i) * INC + vcol + (lane & 7) * 8); }
#pragma unroll
    for (int i = 0; i < 4; ++i) *(LAS v4u*)(vl + ((lane >> 3) + 8 * i) * AB_VST + (lane & 7) * 16) = vc[i];
    for (int j = 0; j < nb; ++j) {
        const int jn = (j + 1 < nb) ? j + 1 : j;
        bf16x8 kn[4];
        { const bf16* kp = H + (size_t)tok_of(jn, krow) * INC + kcol + 8 * hh;
#pragma unroll
          for (int s = 0; s < 4; ++s) kn[s] = *(const bf16x8*)(kp + 16 * s);
#pragma unroll
          for (int i = 0; i < 4; ++i) vc[i] = *(const v4u*)(H + (size_t)tok_of(jn, (lane >> 3) + 8 * i) * INC + vcol + (lane & 7) * 8); }
        f32x16 S;
#pragma unroll
        for (int r = 0; r < 16; ++r) S[r] = 0.f;
#pragma unroll
        for (int s = 0; s < 4; ++s) S = __builtin_amdgcn_mfma_f32_32x32x16_bf16(kf[s], qf[s], S, 0, 0, 0);
        mask(j, S);
        bf16x8 pf[2];
        sm_block64(S, m, l, O, pf);
        LDS_WAIT();
#pragma unroll
        for (int s2 = 0; s2 < 2; ++s2)
#pragma unroll
            for (int d = 0; d < 2; ++d) { const LAS unsigned char* vp = vl + vrd + 16 * s2 * AB_VST + d * 64;
                const s16x4 v0 = ds_tr16(vp), v1 = ds_tr16(vp + 4 * AB_VST);
                const bf16x8 vf = (bf16x8){v0[0], v0[1], v0[2], v0[3], v1[0], v1[1], v1[2], v1[3]};
                O[d] = __builtin_amdgcn_mfma_f32_32x32x16_bf16(vf, pf[s2], O[d], 0, 0, 0); }
        LDS_WAIT(); asm volatile("" ::: "memory");
#pragma unroll
        for (int i = 0; i < 4; ++i) *(LAS v4u*)(vl + ((lane >> 3) + 8 * i) * AB_VST + (lane & 7) * 16) = vc[i];
#pragma unroll
        for (int s = 0; s < 4; ++s) kf[s] = kn[s];
    }
    LDS_WAIT(); asm volatile("" ::: "memory");
}
__device__ __forceinline__ void attn_store64(bf16* yrow, const f32x16 (&O)[2], float l, int hh) {
    const float lt = l + __shfl_xor(l, 32), inv = 1.0f / lt;
#pragma unroll
    for (int d = 0; d < 2; ++d)
#pragma unroll
        for (int rg = 0; rg < 4; ++rg) { v2u o; o.x = pk2(O[d][4 * rg + 0] * inv, O[d][4 * rg + 1] * inv); o.y = pk2(O[d][4 * rg + 2] * inv, O[d][4 * rg + 3] * inv);
            *(v2u*)(yrow + d * 32 + 8 * rg + 4 * hh) = o; }
}

__device__ __forceinline__ void attnA_mfma(Frame& F, const float* rpb  ) {
    const bf16* H = (const bf16*)(F.ws + WS_H); bf16* Y = (bf16*)(F.ws + WS_Y);
    LAS float* T = (LAS float*)(F.lds + L_RPB);
    for (int i = F.tid; i < 4 * 17 * 64; i += 512) { const int h = i / (17 * 64), rem = i - h * 17 * 64, ro = rem >> 6, co = rem & 63;
        const int rr = ro - 1, cc = co - 16; T[i] = (rr >= 0 && rr < 15 && cc >= 0 && cc < 31) ? rpb[(h * 15 + rr) * 31 + cc] * 1.4426950408889634f : 0.f; }
    __syncthreads();
    const int lane = F.lane, n = lane & 31, hh = lane >> 5;
    LAS unsigned char* vl = F.lds + F.wave * AB_VREG;
    const int gw = F.bid * 8 + F.wave, NGW = F.G * 8;
    for (int item = gw; item < 4096; item += NGW) {
        const int cb = item & 3, rp = (item >> 2) & 31, h = (item >> 7) & 3, b = item >> 9;
        const int r = 2 * rp + (n >> 4), c = 16 * cb + (n & 15);
        const int r0 = min(max(r - 4, 0), 56), c0 = min(max(c - 8, 0), 48);
        const int cw = min(max(16 * cb - 8, 0), 32);
        const int kr_lo = min(max(2 * rp - 4, 0), 56), kr_hi = min(max(2 * rp + 1 - 4, 0), 56) + 7;
        const int tokq = b * SEQ + r * 64 + c;
        bf16x8 qf[4];
        { const bf16* qp = H + (size_t)tokq * INC + C_QA + h * 64 + 8 * hh;
#pragma unroll
          for (int s = 0; s < 4; ++s) qf[s] = *(const bf16x8*)(qp + 16 * s); }
        f32x16 O[2];
#pragma unroll
        for (int d = 0; d < 2; ++d)
#pragma unroll
            for (int rr = 0; rr < 16; ++rr) O[d][rr] = 0.f;
        float m = -1e30f, l = 0.f;
        const int tok0 = b * SEQ + kr_lo * 64 + cw;
        auto tok_of = [=](int j, int kk) { return tok0 + j * 64 + kk; };
        const int colb = cw - c0 + 8 * hh;
        const int tb0 = (h * 17 + (kr_lo - r + 8)) * 64 + (cw - c + 31) + 8 * hh;
        const int rb = kr_lo - r0;
        auto mask = [=](int j, f32x16& S) {
            const bool rowok = (unsigned)(rb + j) < 8u; const LAS float* tp = T + tb0 + j * 64;
#pragma unroll
            for (int rr = 0; rr < 16; ++rr) { const int e = (rr & 7) + 16 * (rr >> 3);
                const bool ok = rowok && ((unsigned)(colb + e) < 16u);
                S[rr] = ok ? (S[rr] * (0.125f * 1.4426950408889634f) + tp[e]) : -INFINITY; }
        };
        attn_run_blocks(H, C_KA + h * 64, C_VA + h * 64, kr_hi - kr_lo + 1, tok_of, mask, qf, vl, lane, O, m, l);
        attn_store64(Y + (size_t)tokq * YLD + Y_A + h * 64, O, l, hh);
    }
}
__device__ __forceinline__ void attnB_mfma(Frame& F) {
    const bf16* H = (const bf16*)(F.ws + WS_H); bf16* Y = (bf16*)(F.ws + WS_Y);
    const int lane = F.lane, n = lane & 31, hh = lane >> 5;
    LAS unsigned char* vl = F.lds + F.wave * AB_VREG;
    const int gw = F.bid * 8 + F.wave, NGW = F.G * 8;
    for (int item = gw; item < 2048; item += NGW) {
        const int mblk = item & 7, r = (item >> 3) & 15, hg = (item >> 7) & 1, b = item >> 8;
        const int sq = r + 16 * (mblk * 32 + n), tokq = b * SEQ + sq;
        f32x16 O[2];
#pragma unroll
        for (int d = 0; d < 2; ++d)
#pragma unroll
            for (int rr = 0; rr < 16; ++rr) O[d][rr] = 0.f;
        float m = -1e30f, l = 0.f;
#pragma unroll 1
        for (int g = 0; g < 3; ++g) {
            const int sh = 2 * g, dil = 1 << sh, head = 2 * g + hg, L = SEQ >> sh, a = 16 >> sh, cls = r & (dil - 1);
            const int pq0 = (r >> sh) + a * (mblk * 32), pq = pq0 + a * n;
            const int pks = pq0 - 64, nb = (31 * a + 129 + 31) >> 5;
            bf16x8 qf[4];
            { const bf16* qp = H + (size_t)tokq * INC + C_QB + head * 64 + 8 * hh;
#pragma unroll
              for (int s = 0; s < 4; ++s) qf[s] = *(const bf16x8*)(qp + 16 * s); }
            const int tokb = b * SEQ + cls;
            auto tok_of = [=](int j, int kk) { const int pk = min(max(pks + 32 * j + kk, 0), L - 1); return tokb + (pk << sh); };
            const int b1 = pks - pq + 64 + 8 * hh, b2 = pks + 8 * hh;
            auto mask = [=](int j, f32x16& S) {
#pragma unroll
                for (int rr = 0; rr < 16; ++rr) { const int e = (rr & 7) + 16 * (rr >> 3) + 32 * j;
                    const bool ok = ((unsigned)(b1 + e) <= 128u) && ((unsigned)(b2 + e) < (unsigned)L);
                    S[rr] = ok ? S[rr] * (0.125f * 1.4426950408889634f) : -INFINITY; }
            };
            attn_run_blocks(H, C_KB + head * 64, C_VB + head * 64, nb, tok_of, mask, qf, vl, lane, O, m, l);
        }
        attn_store64(Y + (size_t)tokq * YLD + Y_B + hg * 64, O, l, hh);
    }
}

__device__ __forceinline__ void p_ln_router(Frame& F, const Args& a, int layer, bool dry = false) {
    const float* PRE = (const float*)(F.ws + WS_HH); float* XF = dry ? (float*)(F.ws + WS_H) : a.out; unsigned* XB8 = dry ? (unsigned*)(F.ws + WS_H + 160 * MiB) : (unsigned*)(F.ws + WS_XB8);
    const float* g1 = a.in[10] + layer * 1024; const float* b1 = a.in[11] + layer * 1024; const float* br = a.in[13] + layer * 32;
    const bf16* WT = (const bf16*)(F.ws + WS_WRT) + (size_t)layer * 2 * 32 * 1024;
    int* TOPE = (int*)(F.ws + (dry ? WS_H + 200 * MiB : WS_TOPE)); float* TOPW = (float*)(F.ws + (dry ? WS_H + 201 * MiB : WS_TOPW)); int* RANK = (int*)(F.ws + (dry ? WS_H + 202 * MiB : WS_RANK));
    const int cnt_off = dry ? CW_CUR : CW_CNT; int* SRCp = (int*)(F.ws + (dry ? WS_H + 204 * MiB : WS_SRC));
    LAS int* hist = (LAS int*)(F.lds + L_HIST); LAS int* base = (LAS int*)(F.lds + L_BASE);
    const int lane = F.lane;
    for (int chunk = F.bid; chunk < NTOK / 128; chunk += F.G) {
        if (F.tid < 32) hist[F.tid] = 0;
        __syncthreads();
        const int tok0 = chunk * 128 + F.wave * 16;
        {   f32x4 gv[4], bv[4];
#pragma unroll
            for (int j = 0; j < 4; ++j) { gv[j] = *(const f32x4*)(g1 + 4 * lane + 256 * j); bv[j] = *(const f32x4*)(b1 + 4 * lane + 256 * j); }
#pragma unroll 1
            for (int q = 0; q < 4; ++q) {
                f32x4 v[4][4]; float s[4], s2[4];
#pragma unroll
                for (int t = 0; t < 4; ++t) { const f32x4* pr = (const f32x4*)(PRE + (size_t)(tok0 + 4 * q + t) * 1024) + lane;
#pragma unroll
                    for (int j = 0; j < 4; ++j) v[t][j] = pr[64 * j]; }
#pragma unroll
                for (int t = 0; t < 4; ++t) { s[t] = 0.f;
#pragma unroll
                    for (int j = 0; j < 4; ++j) s[t] += (v[t][j][0] + v[t][j][1]) + (v[t][j][2] + v[t][j][3]); }
#pragma unroll
                for (int o = 1; o < 64; o <<= 1) {
#pragma unroll
                    for (int t = 0; t < 4; ++t) s[t] += __shfl_xor(s[t], o); }
#pragma unroll
                for (int t = 0; t < 4; ++t) { const float mean = s[t] * (1.f / 1024.f); s2[t] = 0.f;
#pragma unroll
                    for (int j = 0; j < 4; ++j) { v[t][j] = v[t][j] - mean; s2[t] += (v[t][j][0] * v[t][j][0] + v[t][j][1] * v[t][j][1]) + (v[t][j][2] * v[t][j][2] + v[t][j][3] * v[t][j][3]); } }
#pragma unroll
                for (int o = 1; o < 64; o <<= 1) {
#pragma unroll
                    for (int t = 0; t < 4; ++t) s2[t] += __shfl_xor(s2[t], o); }
#pragma unroll
                for (int t = 0; t < 4; ++t) { const float rstd = rsqrtf(s2[t] * (1.f / 1024.f) + LN_EPS);
                    f32x4* xo = (f32x4*)(XF + (size_t)(tok0 + 4 * q + t) * 1024) + lane; unsigned* xb = XB8 + (size_t)(tok0 + 4 * q + t) * 256 + lane;
#pragma unroll
                    for (int j = 0; j < 4; ++j) { const f32x4 y = v[t][j] * rstd * gv[j] + bv[j]; xo[64 * j] = y; xb[64 * j] = pk4_fp8(y[0], y[1], y[2], y[3], 1.0f); } }
            }
        }
        VM_WAIT(); asm volatile("" ::: "memory");
        const int tk = lane & 15, kq = lane >> 4;
        f32x4 acc[2] = {(f32x4){0.f, 0.f, 0.f, 0.f}, (f32x4){0.f, 0.f, 0.f, 0.f}};
        {   const float* xf = XF + (size_t)(tok0 + tk) * 1024 + 8 * kq;
            const bf16* w0 = WT + (size_t)tk * 1024 + 8 * kq;
#pragma unroll 4
            for (int st = 0; st < 32; ++st) {
                const f32x4 x0 = *(const f32x4*)(xf + 32 * st), x1 = *(const f32x4*)(xf + 32 * st + 4);
                v4u xhw; xhw.x = pk2(x0[0], x0[1]); xhw.y = pk2(x0[2], x0[3]); xhw.z = pk2(x1[0], x1[1]); xhw.w = pk2(x1[2], x1[3]);
                v4u xlw; xlw.x = pk2(x0[0] - bflo(xhw.x), x0[1] - bfhi(xhw.x)); xlw.y = pk2(x0[2] - bflo(xhw.y), x0[3] - bfhi(xhw.y));
                xlw.z = pk2(x1[0] - bflo(xhw.z), x1[1] - bfhi(xhw.z)); xlw.w = pk2(x1[2] - bflo(xhw.w), x1[3] - bfhi(xhw.w));
                const bf16x8 xh = __builtin_bit_cast(bf16x8, xhw), xl = __builtin_bit_cast(bf16x8, xlw);
#pragma unroll
                for (int mb = 0; mb < 2; ++mb) { const bf16x8 wh = *(const bf16x8*)(w0 + (size_t)mb * 16 * 1024 + 32 * st), wl = *(const bf16x8*)(w0 + (size_t)(32 + mb * 16) * 1024 + 32 * st);
                    acc[mb] = __builtin_amdgcn_mfma_f32_16x16x32_bf16(wh, xh, acc[mb], 0, 0, 0);
                    acc[mb] = __builtin_amdgcn_mfma_f32_16x16x32_bf16(wh, xl, acc[mb], 0, 0, 0);
                    acc[mb] = __builtin_amdgcn_mfma_f32_16x16x32_bf16(wl, xh, acc[mb], 0, 0, 0); }
            }
        }
        float v8[8];
#pragma unroll
        for (int mb = 0; mb < 2; ++mb)
#pragma unroll
            for (int i = 0; i < 4; ++i) v8[mb * 4 + i] = acc[mb][i] + br[16 * mb + 4 * kq + i];
        int se[4]; float sv[4];
#pragma unroll
        for (int r = 0; r < 4; ++r) {
            float bvv = v8[0]; int bi = 4 * kq;
#pragma unroll
            for (int sl = 1; sl < 8; ++sl) { const int eid = 16 * (sl >> 2) + 4 * kq + (sl & 3); if (v8[sl] > bvv) { bvv = v8[sl]; bi = eid; } }
#pragma unroll
            for (int o = 16; o < 64; o <<= 1) { const float ov = __shfl_xor(bvv, o); const int oi = __shfl_xor(bi, o);
                if (ov > bvv || (ov == bvv && oi < bi)) { bvv = ov; bi = oi; } }
            se[r] = bi; sv[r] = bvv;
#pragma unroll
            for (int sl = 0; sl < 8; ++sl) { const int eid = 16 * (sl >> 2) + 4 * kq + (sl & 3); if (eid == bi) v8[sl] = -3.0e38f; }
        }
        const float p1 = __expf(sv[1] - sv[0]), p2 = __expf(sv[2] - sv[0]), p3 = __expf(sv[3] - sv[0]);
        const float inv = 1.0f / (1.0f + p1 + p2 + p3);
        int lr[4] = {0, 0, 0, 0};
        if (lane < 16) { const int tok = tok0 + tk;
            *(int4*)(TOPE + tok * 4) = make_int4(se[0], se[1], se[2], se[3]);
            *(f32x4*)(TOPW + tok * 4) = (f32x4){inv, p1 * inv, p2 * inv, p3 * inv};
#pragma unroll
            for (int k = 0; k < 4; ++k) lr[k] = __hip_atomic_fetch_add(&hist[se[k]], 1, __ATOMIC_RELAXED, __HIP_MEMORY_SCOPE_WORKGROUP); }
        __syncthreads();
        if (F.tid < 32) { const int c = hist[F.tid]; base[F.tid] = c ? (int)__hip_atomic_fetch_add(F.ctl + cnt_off + layer * 64 + F.tid, (unsigned)c, RLX_AGENT) : 0; }
        __syncthreads();
        if (lane < 16) { const int tok = tok0 + tk;
            const int r0 = base[se[0]] + lr[0], r1 = base[se[1]] + lr[1], r2 = base[se[2]] + lr[2], r3 = base[se[3]] + lr[3];
            *(int4*)(RANK + tok * 4) = make_int4(r0, r1, r2, r3);
            int* SRC = SRCp; SRC[se[0] * NTOK + r0] = tok; SRC[se[1] * NTOK + r1] = tok; SRC[se[2] * NTOK + r2] = tok; SRC[se[3] * NTOK + r3] = tok; }
        __syncthreads();
    }
}

__device__ __forceinline__ int moe_build(Frame& F, int layer) {
    LAS int* offT = (LAS int*)(F.lds + L_OFFT); LAS int* tile_e = (LAS int*)(F.lds + L_TILE);
    __syncthreads();
    if (F.tid < 64) {
        const int c = (F.lane < 32) ? (int)__hip_atomic_load(F.ctl + CW_CNT + layer * 64 + F.lane, RLX_AGENT) : 0;
        const int ntile = (c + 255) >> 8; int x = ntile;
#pragma unroll
        for (int d = 1; d < 32; d <<= 1) { const int v = __shfl_up(x, d); if (F.lane >= d) x += v; }
        if (F.lane < 32) { offT[F.lane] = x - ntile; ((LAS int*)(F.lds + L_CNT))[F.lane] = c; }
        if (F.lane == 31) offT[32] = x;
    }
    __syncthreads();
    int T = __builtin_amdgcn_readfirstlane(offT[32]); if (T > MAXT) T = MAXT;
    for (int mt = F.tid; mt < T; mt += 512) { int e = 0;
#pragma unroll 1
        for (int j = 1; j < 32; ++j) if (offT[j] <= mt) e = j;
        tile_e[mt] = e; }
    __syncthreads();
    return T;
}

__device__ __forceinline__ void p_combine_ln(Frame& F, const Args& a, int layer, bool dry = false) {
    const bool last_layer = (layer == DEPTH - 1) || dry;
    float* XF = a.out; float* XFo = dry ? (float*)(F.ws + WS_HH) : a.out; bf16* XB = (bf16*)(F.ws + (dry ? WS_M : WS_XB)); const bf16* YS = (const bf16*)(F.ws + WS_H);
    const int* TOPE = (const int*)(F.ws + WS_TOPE); const int* RANK = (const int*)(F.ws + WS_RANK); const float* TOPW = (const float*)(F.ws + WS_TOPW);
    const LAS int* offT = (const LAS int*)(F.lds + L_OFFT);
    const float* g2 = a.in[20] + layer * 1024; const float* b2 = a.in[21] + layer * 1024;
    const int gw = F.bid * 8 + F.wave, NGW = F.G * 8, lane = F.lane;
    f32x4 gv[4], bv[4];
#pragma unroll
    for (int j = 0; j < 4; ++j) { gv[j] = *(const f32x4*)(g2 + 4 * lane + 256 * j); bv[j] = *(const f32x4*)(b2 + 4 * lane + 256 * j); }
    for (int tp = gw; tp < NTOK / 2; tp += NGW) {
        f32x4 v[2][4]; v2u yw[2][4][4]; f32x4 tw[2];
#pragma unroll
        for (int u = 0; u < 2; ++u) { const int tok = tp * 2 + u;
            const int4 te = *(const int4*)(TOPE + tok * 4), rk = *(const int4*)(RANK + tok * 4); tw[u] = *(const f32x4*)(TOPW + tok * 4);
            const f32x4* xr = (const f32x4*)(XF + (size_t)tok * 1024) + lane;
#pragma unroll
            for (int j = 0; j < 4; ++j) v[u][j] = xr[64 * j];
            const int pk[4] = {offT[te.x] * 256 + rk.x, offT[te.y] * 256 + rk.y, offT[te.z] * 256 + rk.z, offT[te.w] * 256 + rk.w};
#pragma unroll
            for (int k = 0; k < 4; ++k) { const v2u* yr = (const v2u*)(YS + (size_t)pk[k] * 1024) + lane;
#pragma unroll
                for (int j = 0; j < 4; ++j) yw[u][k][j] = yr[64 * j]; } }
        float s[2], s2[2];
#pragma unroll
        for (int u = 0; u < 2; ++u) {
#pragma unroll
            for (int j = 0; j < 4; ++j) { v[u][j] = v[u][j] * DN_ALPHA;
#pragma unroll
                for (int k = 0; k < 4; ++k) { const v2u y = yw[u][k][j]; v[u][j] = v[u][j] + tw[u][k] * (f32x4){bflo(y.x), bfhi(y.x), bflo(y.y), bfhi(y.y)}; } }
            s[u] = 0.f;
#pragma unroll
            for (int j = 0; j < 4; ++j) s[u] += (v[u][j][0] + v[u][j][1]) + (v[u][j][2] + v[u][j][3]); }
#pragma unroll
        for (int o = 1; o < 64; o <<= 1) { s[0] += __shfl_xor(s[0], o); s[1] += __shfl_xor(s[1], o); }
#pragma unroll
        for (int u = 0; u < 2; ++u) { const float mean = s[u] * (1.f / 1024.f); s2[u] = 0.f;
#pragma unroll
            for (int j = 0; j < 4; ++j) { v[u][j] = v[u][j] - mean; s2[u] += (v[u][j][0] * v[u][j][0] + v[u][j][1] * v[u][j][1]) + (v[u][j][2] * v[u][j][2] + v[u][j][3] * v[u][j][3]); } }
#pragma unroll
        for (int o = 1; o < 64; o <<= 1) { s2[0] += __shfl_xor(s2[0], o); s2[1] += __shfl_xor(s2[1], o); }
#pragma unroll
        for (int u = 0; u < 2; ++u) { const int tok = tp * 2 + u; const float rstd = rsqrtf(s2[u] * (1.f / 1024.f) + LN_EPS);
            f32x4* xo = (f32x4*)(XFo + (size_t)tok * 1024) + lane; v2u* xb = (v2u*)(XB + (size_t)tok * 1024) + lane; unsigned* x8 = (unsigned*)(F.ws + (dry ? WS_M + 32 * MiB : WS_XB8)) + (size_t)tok * 256 + lane;
#pragma unroll
            for (int j = 0; j < 4; ++j) { const f32x4 y = v[u][j] * rstd * gv[j] + bv[j]; if (last_layer) xo[64 * j] = y; xb[64 * j] = (v2u){pk2(y[0], y[1]), pk2(y[2], y[3])}; x8[64 * j] = pk4_fp8(y[0], y[1], y[2], y[3], 1.0f); } }
    }
}

__device__ __forceinline__ const Args* fresh_args() { unsigned long long p = (unsigned long long)__builtin_amdgcn_kernarg_segment_ptr(); asm volatile("" : "+s"(p)); return (const Args*)(const __attribute__((address_space(4))) void*)p; }
constexpr int PH_PER_LAYER = 10, N_PHASES = 1 + DEPTH * PH_PER_LAYER;
__global__ void __launch_bounds__(512, 2) mk_fwd(Args args) {
    extern __shared__ __attribute__((aligned(16))) unsigned char lds[];
    Frame F;
    F.lds = (LAS unsigned char*)lds; F.tid = threadIdx.x; F.lane = F.tid & 63; F.wave = __builtin_amdgcn_readfirstlane(F.tid >> 6);
    F.G = gridDim.x; F.bid = blockIdx.x; F.ws = fresh_args()->ws; F.ctl = (unsigned*)(F.ws + WS_CTL);
    for (int u = F.tid; u < (LDS_BYTES - LDSCTL_OFF) / 4; u += 512) ((LAS unsigned*)(F.lds + LDSCTL_OFF))[u] = 0u;
    __syncthreads();
    const int lo = fresh_args()->ph_lo, hi = fresh_args()->ph_hi;
    XcdBarrier bar; bar.bar = F.ctl + CW_BAR; bar.x = 0; bar.st = nullptr;
    if (hi - lo > 1) bar = xcd_barrier_post(F.ctl + CW_BAR, (volatile LAS unsigned*)(F.lds + L_MISC) + 8);
#define IN(k) (lo <= (k) && (k) < hi)
#define REFRESH() do { F.tid = opaque_tid(); F.lane = F.tid & 63; F.wave = __builtin_amdgcn_readfirstlane(F.tid >> 6); asm volatile("" : "+s"(F.bid), "+s"(F.G)); } while (0)
#define SEAM(k) do { if ((k) + 1 < hi) xcd_barrier(bar); } while (0)

#ifndef NO_P0
    if (IN(0)) { _Pragma("unroll") for (int rep = 0; rep < REP_T; ++rep) p_prologue(F, *fresh_args()); SEAM(0); }
#endif

    for (int l = 0; l < DEPTH; ++l) {
        const int pb = 1 + l * PH_PER_LAYER;
#ifndef NO_P1
        if (IN(pb + 0)) {
            REFRESH();
            {
                pg8::DenseOrder S{(const char*)(F.ws + WS_XB), (const char*)(F.ws + WS_WIN) + (size_t)l * INC * 1024 * 2, (size_t)256 * 1024 * 2, (size_t)256 * 1024 * 2, 16, NTOK / 256, 12, F.G, F.bid};
                pg8::EpiInProj E{(bf16*)(F.ws + WS_H), fresh_args()->in[2] + l * 3072, (const f32x2*)(F.ws + WS_ROPE64), (const f32x2*)(F.ws + WS_ROPE48), 1.0f, (unsigned char*)(F.ws + WS_G8), F.lds};
                _Pragma("unroll") for (int rep = 0; rep < REP_G1; ++rep) pg8::gemm_phase<pg8::EpiInProj, pg8::DenseOrder, true, true>(F.lds, 1024, 1024, S, E);
            }
            {
                REFRESH();
                pg8::DenseOrder S{(const char*)(F.ws + WS_XB8), (const char*)(F.ws + WS_WIN8) + (size_t)l * 3072 * 1024, (size_t)256 * 1024, (size_t)256 * 1024, 8, NTOK / 256, 12, F.G, F.bid, 12};
                pg8::EpiInProj E{(bf16*)(F.ws + WS_H), fresh_args()->in[2] + l * 3072, (const f32x2*)(F.ws + WS_ROPE64), (const f32x2*)(F.ws + WS_ROPE48), 1.0f / 32.0f, (unsigned char*)(F.ws + WS_G8), F.lds};
                _Pragma("unroll") for (int rep = 0; rep < REP_G1; ++rep) pg8::gemm_phase<pg8::EpiInProj, pg8::DenseOrder, true, true, true>(F.lds, 1024, 1024, S, E);
            }
            if (pb + 2 < hi) xcd_barrier(bar);
        }
#endif
#ifndef NO_P1B
#endif
        if (IN(pb + 2)) {
            REFRESH();
#ifndef NO_PC
            _Pragma("unroll") for (int rep = 0; rep < REP_C; ++rep) attnC_pipe(F, fresh_args()->in[8] + l * 4 * 48, fresh_args()->in[9] + l * 96, fresh_args()->lam_init[l]);
#endif
#ifndef NO_PA
            REFRESH();
            _Pragma("unroll") for (int rep = 0; rep < REP_AB; ++rep) attnA_mfma(F, fresh_args()->in[7] + l * 4 * 15 * 31);
#endif
#ifndef NO_PB
            REFRESH();
            _Pragma("unroll") for (int rep = 0; rep < REP_AB; ++rep) attnB_mfma(F);
#endif
            SEAM(pb + 2);
        }
#ifndef NO_P3
        if (IN(pb + 3)) {
            REFRESH();
            pg8::ProjOrder S{(const char*)(F.ws + WS_Y), (const char*)(F.ws + WS_WPROJ) + (size_t)l * 1024 * WPK * 2, NTOK / 256, 4, F.G, F.bid};
            pg8::EpiProj E{(const unsigned char*)(F.ws + WS_G8), (bf16*)(F.ws + WS_M)};
            _Pragma("unroll") for (int rep = 0; rep < REP_G3; ++rep) pg8::gemm_phase<pg8::EpiProj, pg8::ProjOrder, true, true>(F.lds, YLD, WPK, S, E);
            SEAM(pb + 3);
        }
#endif
#ifndef NO_P4
        if (IN(pb + 4)) {
            REFRESH();
            pg8::DenseOrder S{(const char*)(F.ws + WS_M), (const char*)(F.ws + WS_WOUT) + (size_t)l * 1024 * 1024 * 2, (size_t)256 * 1024 * 2, (size_t)256 * 1024 * 2, 16, NTOK / 256, 4, F.G, F.bid};
            pg8::EpiOut E{l == 0 ? fresh_args()->in[0] : (const float*)nullptr, (const bf16*)(F.ws + WS_XB), (float*)(F.ws + WS_HH)};
            _Pragma("unroll") for (int rep = 0; rep < REP_G4; ++rep) pg8::gemm_phase<pg8::EpiOut, pg8::DenseOrder, true, true>(F.lds, 1024, 1024, S, E);
            SEAM(pb + 4);
        }
#endif
#ifndef NO_P5
        if (IN(pb + 5)) { REFRESH(); if (DRY_P5) p_ln_router(F, *fresh_args(), l, true); p_ln_router(F, *fresh_args(), l); if (pb + 7 < hi) xcd_barrier(bar); }
#endif
#ifndef NO_P5B
#endif
#ifndef NO_P6
        if (IN(pb + 7)) {
            REFRESH(); const int T = moe_build(F, l);
            pg8::MoeOrder S{(const char*)(F.ws + WS_XB8), (const char*)(F.ws + WS_WGU) + (size_t)l * NEXP * 2048 * 1024, (size_t)2048 * 1024, (size_t)256 * 1024, (size_t)256 * 1024, 8,
                            (const LAS int*)(F.lds + L_TILE), (const LAS int*)(F.lds + L_OFFT), (const LAS int*)(F.lds + L_CNT), (const int*)(F.ws + WS_SRC), T, 8, F.G, F.bid};
            pg8::EpiSwiglu E{(unsigned char*)(F.ws + WS_HH), fresh_args()->in[15] + (size_t)l * NEXP * 1024, fresh_args()->in[17] + (size_t)l * NEXP * 1024, 1.0f / 32.0f, F.lds};
            _Pragma("unroll") for (int rep = 0; rep < REP_G6; ++rep) pg8::gemm_phase_gather<pg8::EpiSwiglu, pg8::MoeOrder, true>(F.lds, (const char*)(F.ws + WS_XB8), 1024, 1024, S, E);
            SEAM(pb + 7);
        }
#endif
#ifndef NO_P7
        if (IN(pb + 8)) {
            REFRESH(); const int T = moe_build(F, l);
            pg8::MoeOrder S{(const char*)(F.ws + WS_HH), (const char*)(F.ws + WS_WDN) + (size_t)l * NEXP * 1024 * 1024, (size_t)1024 * 1024, (size_t)256 * 1024, (size_t)256 * 1024, 8,
                            (const LAS int*)(F.lds + L_TILE), (const LAS int*)(F.lds + L_OFFT), (const LAS int*)(F.lds + L_CNT), (const int*)(F.ws + WS_SRC), T, 4, F.G, F.bid};
            pg8::EpiDown E{(bf16*)(F.ws + WS_H), fresh_args()->in[19] + (size_t)l * NEXP * 1024, 1.0f / 256.0f, F.lds};
            _Pragma("unroll") for (int rep = 0; rep < REP_G7; ++rep) pg8::gemm_phase<pg8::EpiDown, pg8::MoeOrder, true, true, true>(F.lds, 1024, 1024, S, E);
            SEAM(pb + 8);
        }
#endif
#ifndef NO_P8
        if (IN(pb + 9)) { REFRESH(); (void)moe_build(F, l); if (DRY_P8) p_combine_ln(F, *fresh_args(), l, true); p_combine_ln(F, *fresh_args(), l); SEAM(pb + 9); }
#endif
    }
#undef IN
#undef SEAM
}

extern "C" void kernel_launch(void* const* d_in, const int* in_sizes, int n_in, void* d_out, int out_size, void* d_ws, size_t ws_size, hipStream_t stream) {
    static int grid = 0;
    if (grid == 0) {
        if (n_in != 22 || in_sizes[0] != NTOK * D || out_size != NTOK * D || ws_size < WS_END) {
            fprintf(stderr, "kernel_launch: unexpected shapes (n_in %d, in0 %d, out %d, ws %zu); nothing launched\n", n_in, n_in > 0 ? in_sizes[0] : -1, out_size, ws_size); grid = -1; return; }
        int dev = 0, cus = 0, per_cu = 0;
        if (hipGetDevice(&dev) != hipSuccess || hipDeviceGetAttribute(&cus, hipDeviceAttributeMultiprocessorCount, dev) != hipSuccess) { grid = -1; return; }
        if (hipFuncSetAttribute((const void*)mk_fwd, hipFuncAttributeMaxDynamicSharedMemorySize, LDS_BYTES) != hipSuccess) { fprintf(stderr, "kernel_launch: hipFuncSetAttribute failed\n"); grid = -1; return; }
        if (hipOccupancyMaxActiveBlocksPerMultiprocessor(&per_cu, (const void*)mk_fwd, 512, LDS_BYTES) != hipSuccess || per_cu < 1)
            fprintf(stderr, "kernel_launch: note: occupancy query reports %d workgroups per CU\n", per_cu);
        (void)hipGetLastError();
        grid = cus;
    }
    if (grid < 0) return;
    if (hipMemsetAsync((char*)d_ws + WS_CTL, 0, CTL_ZERO_BYTES, stream) != hipSuccess) { fprintf(stderr, "kernel_launch: memset failed\n"); return; }
    Args a{};
    for (int i = 0; i < 22; ++i) a.in[i] = (const float*)d_in[i];
    a.out = (float*)d_out; a.ws = (unsigned char*)d_ws;
    for (int l = 0; l < DEPTH; ++l) a.lam_init[l] = (float)(0.8 - 0.6 * exp(-0.3 * (double)l));
#if MK_ONE_LAUNCH
    a.ph_lo = 0; a.ph_hi = N_PHASES;
    hipLaunchKernelGGL(mk_fwd, dim3(grid), dim3(512), LDS_BYTES, stream, a);
#else
    for (int p = 0; p < N_PHASES; ++p) {
        a.ph_lo = p; a.ph_hi = p + 1;
        hipLaunchKernelGGL(mk_fwd, dim3(grid), dim3(512), LDS_BYTES, stream, a);
    }
#endif
    const hipError_t le = hipPeekAtLastError();
    if (le != hipSuccess) fprintf(stderr, "kernel_launch: launch failed: %s\n", hipGetErrorName(le));
}
```

```cpp
#include <hip/hip_runtime.h>
#include <cstdio>
#include <cstdint>
#include <cmath>

#ifndef REP_AB
#define REP_AB 1
#endif
#ifndef REP_C
#define REP_C 1
#endif
#ifndef REP_G
#define REP_G 1
#endif
#ifndef REP_G1
#define REP_G1 REP_G
#endif
#ifndef REP_G3
#define REP_G3 REP_G
#endif
#ifndef REP_G4
#define REP_G4 REP_G
#endif
#ifndef REP_G6
#define REP_G6 REP_G
#endif
#ifndef REP_G7
#define REP_G7 REP_G
#endif
#ifndef REP_T
#define REP_T 1
#endif
#ifndef DRY_P5
#define DRY_P5 0
#endif
#ifndef DRY_P8
#define DRY_P8 0
#endif
#ifndef C_ANTIPHASE
#define C_ANTIPHASE 0
#endif
#ifndef MK_ONE_LAUNCH
#define MK_ONE_LAUNCH 1
#endif

#define GAS __attribute__((address_space(1)))
#define LAS __attribute__((address_space(3)))
typedef unsigned short bf16;
typedef unsigned v4u __attribute__((ext_vector_type(4)));
typedef unsigned v2u __attribute__((ext_vector_type(2)));
typedef float f32x4 __attribute__((ext_vector_type(4)));
typedef float f32x2 __attribute__((ext_vector_type(2)));
typedef short bf16x8 __attribute__((ext_vector_type(8)));

constexpr int NTOK = 32768, SEQ = 4096, D = 1024, DEPTH = 4, INC = 6144, NEXP = 32, TOPK = 4;
constexpr int C_QA = 0, C_KA = 256, C_VA = 512, C_QB = 768, C_KB = 1152, C_VB = 1536, C_QC = 1920, C_KC = 2304, C_VC = 2688, C_GP = 3072;
constexpr int YLD = 768, Y_A = 0, Y_B = 256, Y_C = 384;
constexpr int WPK = 896;
constexpr int MAXT = 544;
constexpr float LN_EPS = 1e-5f;
constexpr float DN_ALPHA = 1.681792830507429f;

constexpr size_t MiB = 1u << 20;
constexpr size_t WS_CTL = 0, CTL_ZERO_BYTES = 1 * MiB;
constexpr size_t WS_ROPE64 = 1 * MiB;
constexpr size_t WS_ROPE48 = 2 * MiB;
constexpr size_t WS_TOPE = 3 * MiB;
constexpr size_t WS_TOPW = 3 * MiB + 512 * 1024;
constexpr size_t WS_POS = 4 * MiB;
constexpr size_t WS_WIN = 8 * MiB;
constexpr size_t WS_WPROJ = 56 * MiB;
constexpr size_t WS_WOUT = 64 * MiB;
constexpr size_t WS_WGU = 72 * MiB;
constexpr size_t WS_WDN = 584 * MiB;
constexpr size_t WS_XB = 840 * MiB;
constexpr size_t WS_Y = 904 * MiB;
constexpr size_t WS_M = 952 * MiB;
constexpr size_t WS_H = 1016 * MiB;
constexpr size_t WS_HH = 1400 * MiB;
constexpr size_t WS_WRT = 5 * MiB;
constexpr size_t WS_RANK = 6 * MiB;
constexpr size_t WS_SRC = 1672 * MiB;
constexpr size_t WS_XB8 = 1676 * MiB;
constexpr size_t WS_WIN8 = 1708 * MiB;
constexpr size_t WS_G8 = 1720 * MiB;
constexpr size_t WS_END = 1816 * MiB;
constexpr int CW_BAR = 4096;
constexpr int CW_CNT = 8192;
constexpr int CW_CUR = 8192 + 4 * 64;

constexpr int RING_BYTES = 131072;
constexpr int LDSCTL_OFF = RING_BYTES;
constexpr int L_MISC = LDSCTL_OFF;
constexpr int L_OFFT = LDSCTL_OFF + 256;
constexpr int L_HIST = LDSCTL_OFF + 512;
constexpr int L_BASE = LDSCTL_OFF + 768;
constexpr int L_CNT = LDSCTL_OFF + 896;
constexpr int L_TILE = LDSCTL_OFF + 1024;
constexpr int L_PPOS = LDSCTL_OFF + 4096;
constexpr int L_PTOK = LDSCTL_OFF + 6144;
constexpr int LDS_BYTES = 147456;
static_assert(L_PTOK + 2048 <= LDS_BYTES, "LDS map");

#define RLX_AGENT __ATOMIC_RELAXED, __HIP_MEMORY_SCOPE_AGENT
#define LDS_WAIT() asm volatile("s_waitcnt lgkmcnt(0)" ::: "memory")
#define VM_WAIT() asm volatile("s_waitcnt vmcnt(0)" ::: "memory")

__device__ __forceinline__ float bf2f(unsigned short b) { return __uint_as_float(((unsigned)b) << 16); }
__device__ __forceinline__ float bflo(unsigned u) { return __uint_as_float(u << 16); }
__device__ __forceinline__ float bfhi(unsigned u) { return __uint_as_float(u & 0xffff0000u); }
__device__ __forceinline__ unsigned f2bf(float f) { unsigned u = __builtin_bit_cast(unsigned, f); return (u + 0x7fffu + ((u >> 16) & 1u)) >> 16; }
__device__ __forceinline__ unsigned pk2(float lo, float hi) { return f2bf(lo) | (f2bf(hi) << 16); }
__device__ __forceinline__ float wave_sum(float v) {
#pragma unroll
    for (int o = 1; o < 64; o <<= 1) v += __shfl_xor(v, o);
    return v;
}
__device__ __forceinline__ int opaque_tid() { int t; asm volatile("v_mov_b32 %0, %1" : "=v"(t) : "v"(threadIdx.x)); return t; }
__device__ __forceinline__ unsigned pk4_fp8(float a, float b, float c, float d, float sc) {
    a = fminf(fmaxf(a * sc, -448.f), 448.f); b = fminf(fmaxf(b * sc, -448.f), 448.f); c = fminf(fmaxf(c * sc, -448.f), 448.f); d = fminf(fmaxf(d * sc, -448.f), 448.f);
    int p = __builtin_amdgcn_cvt_pk_fp8_f32(a, b, 0, false); p = __builtin_amdgcn_cvt_pk_fp8_f32(c, d, p, true); return (unsigned)p; }
__device__ __forceinline__ float fast_sigmoid(float x) { return __builtin_amdgcn_rcpf(1.0f + __builtin_amdgcn_exp2f(-1.4426950408889634f * x)); }

namespace pg8 {
#define PG8_LAS __attribute__((address_space(3)))
typedef unsigned short bf16_t;
typedef unsigned u32x4 __attribute__((ext_vector_type(4)));
constexpr int BM = 256, BK = 64, HALF = 128, HTB = HALF * BK * 2, STAGE_BYTES = 8 * HTB, NXCD = 8, WGM = 8;

__host__ __device__ __forceinline__ int lds_byte(int r, int c) { const int st = (r >> 4) * 2 + (c >> 5), rr = r & 15, cc = c & 31, ob = rr * 64 + cc * 2; return st * 1024 + (ob ^ (((ob >> 9) & 1) << 5)); }
__host__ __device__ __forceinline__ void stage_rc(int b, int& R, int& C) { const int st = b / 1024, sb = b % 1024, swz = sb ^ (((sb >> 9) & 1) << 5); R = (st >> 1) * 16 + swz / 64; C = (st & 1) * 32 + (swz % 64) / 2; }
__host__ __device__ __forceinline__ int perm32(int rho) { const int n = rho >> 4, i = rho & 15; return 8 * (i >> 2) + 4 * n + (i & 3); }

struct Unit { const char* A; const char* B; int nt; int pm, pn, aux; int bs; };

constexpr int L_BIAS_OFF = 139264;
__device__ __forceinline__ void glds16_u(const void* gsrc, unsigned lds_dst) { unsigned keep;
    asm volatile("s_mov_b32 %0, m0\n\ts_mov_b32 m0, %2\n\ts_nop 0\n\tglobal_load_lds_dwordx4 %1, off\n\ts_mov_b32 m0, %0" : "=&s"(keep) : "v"(gsrc), "s"(lds_dst) : "memory"); }
__device__ __forceinline__ void tile_of(int L, int nM, int nN, int& pm, int& pn) {
    const int nwg = nM * nN;
    int wgid = L; { const int q = nwg / NXCD, r = nwg % NXCD, xcd = wgid % NXCD, off = wgid / NXCD; wgid = (xcd < r ? xcd * (q + 1) : r * (q + 1) + (xcd - r) * q) + off; }
    const int nig = WGM * nN, gid = wgid / nig, fm = gid * WGM, gsz = (nM - fm) < WGM ? (nM - fm) : WGM;
    pm = fm + ((wgid % nig) % gsz); pn = (wgid % nig) / gsz;
}

__device__ __forceinline__ unsigned cvt_pk_bf16(float lo, float hi) { unsigned r; asm volatile("v_cvt_pk_bf16_f32 %0, %1, %2" : "=v"(r) : "v"(lo), "v"(hi)); return r; }
typedef int v8i32 __attribute__((ext_vector_type(8)));
typedef short s16x16 __attribute__((ext_vector_type(16)));
typedef int v4i32 __attribute__((ext_vector_type(4)));
__device__ __forceinline__ v8i32 cat8(bf16x8 lo, bf16x8 hi) { const v4i32 a = __builtin_bit_cast(v4i32, lo), b = __builtin_bit_cast(v4i32, hi); return __builtin_shufflevector(a, b, 0, 1, 2, 3, 4, 5, 6, 7); }

template <class Epi, class Sched, bool ALIGN_EPI, bool SP2, bool FP8 = false>
__device__ __forceinline__ void gemm_phase(PG8_LAS unsigned char* lds, const int lda, const int ldb, const Sched& S, const Epi& E, const int sclW = 0x7f7f7f7f, const int sclX = 0x7f7f7f7f) {
    constexpr int EB = FP8 ? 1 : 2;
    const int tid = opaque_tid(), wid = __builtin_amdgcn_readfirstlane(tid >> 6), lane = tid & 63, wr = wid >> 2, wc = wid & 3, fr = lane & 15, fq = lane >> 4;
    unsigned voffA[2], voffB[2];
#pragma unroll
    for (int i = 0; i < 2; ++i) { int R, C; stage_rc(tid * 16 + i * 8192, R, C); const int Rb = Epi::PERM ? ((R & ~31) + perm32(R & 31)) : R;
        voffA[i] = (unsigned)(R * lda * EB + C * 2); voffB[i] = (unsigned)(Rb * ldb * EB + C * 2); }
    const size_t kstep = (size_t)(BK * 2);
    const size_t hA = (size_t)HALF * lda * EB, hB = (size_t)HALF * ldb * EB;
    const unsigned ldsw = (unsigned)wid * 1024u;
    const int fcol = FP8 ? (32 * (fq >> 1) + 16 * (fq & 1)) : fq * 8;
    const int aoff = lds_byte(wr * 64 + fr, fcol), boff = lds_byte(wc * 32 + fr, fcol);
#define PG8_SA(b, h) (((b) * 2 + (h)) * HTB)
#define PG8_SB(b, h) ((4 + (b) * 2 + (h)) * HTB)
#define PG8_STAGE(bufoff, gbase, voff) do { _Pragma("unroll") for (int _i = 0; _i < 2; ++_i) \
        __builtin_amdgcn_global_load_lds((const unsigned*)((const char*)(gbase) + (voff)[_i]), (PG8_LAS unsigned*)(lds + (bufoff) + ldsw + _i * 8192), 16, 0, 0); } while (0)
#define PG8_LDA(dst, b, h) do { if constexpr (FP8) { _Pragma("unroll") for (int m = 0; m < 4; ++m) dst##8[m] = cat8(*(const PG8_LAS bf16x8*)(lds + PG8_SA(b, h) + aoff + m * 2048), *(const PG8_LAS bf16x8*)(lds + PG8_SA(b, h) + aoff + m * 2048 + 16)); } else { \
        _Pragma("unroll") for (int m = 0; m < 4; ++m) _Pragma("unroll") for (int k = 0; k < 2; ++k) dst[m][k] = *(const PG8_LAS bf16x8*)(lds + PG8_SA(b, h) + aoff + m * 2048 + k * 1024); } } while (0)
#define PG8_LDB(dst, b, h) do { if constexpr (FP8) { _Pragma("unroll") for (int n = 0; n < 2; ++n) dst##8[n] = cat8(*(const PG8_LAS bf16x8*)(lds + PG8_SB(b, h) + boff + n * 2048), *(const PG8_LAS bf16x8*)(lds + PG8_SB(b, h) + boff + n * 2048 + 16)); } else { \
        _Pragma("unroll") for (int n = 0; n < 2; ++n) _Pragma("unroll") for (int k = 0; k < 2; ++k) dst[n][k] = *(const PG8_LAS bf16x8*)(lds + PG8_SB(b, h) + boff + n * 2048 + k * 1024); } } while (0)
#define PG8_MMA(ai, bj, At, Bt) do { __builtin_amdgcn_s_setprio(1); if constexpr (FP8) { _Pragma("unroll") for (int m = 0; m < 4; ++m) _Pragma("unroll") for (int n = 0; n < 2; ++n) \
        asm volatile("v_mfma_f32_16x16x128_f8f6f4 %0, %1, %2, %0" : "+v"(acc[ai][bj][m][n]) : "v"(Bt##8[n]), "v"(At##8[m])); } else { \
        _Pragma("unroll") for (int m = 0; m < 4; ++m) _Pragma("unroll") for (int n = 0; n < 2; ++n) _Pragma("unroll") for (int k = 0; k < 2; ++k) \
        acc[ai][bj][m][n] = __builtin_amdgcn_mfma_f32_16x16x32_bf16(Bt[n][k], At[m][k], acc[ai][bj][m][n], 0, 0, 0); } __builtin_amdgcn_s_setprio(0); } while (0)
#define PG8_WAIT_V(n) asm volatile("s_waitcnt vmcnt(" #n ")" ::: "memory")
#define PG8_WAIT_L(n) asm volatile("s_waitcnt lgkmcnt(" #n ")" ::: "memory")
#define PG8_BAR __builtin_amdgcn_s_barrier()
#define PG8_SCHED __builtin_amdgcn_sched_barrier(0)
    Unit cur, nxt; int ui = 0;
    if (!S.next(0, cur)) return;
    f32x4 acc[2][2][4][2];
#pragma unroll
    for (int a = 0; a < 2; ++a)
#pragma unroll
        for (int b = 0; b < 2; ++b)
#pragma unroll
            for (int m = 0; m < 4; ++m)
#pragma unroll
                for (int n = 0; n < 2; ++n) acc[a][b][m][n] = (f32x4){0.f, 0.f, 0.f, 0.f};
    bf16x8 At[4][2], B0[2][2], B1[2][2]; v8i32 At8[4], B08[2], B18[2];
    const char* cA = cur.A; const char* cB = cur.B;
    if constexpr (Epi::BIAS_DMA) { if (wid == 0) E.bias_dma(cur, 0, lane, lds); }
    if constexpr (SP2) {
        PG8_STAGE(PG8_SB(0, 0), cB, voffB); PG8_STAGE(PG8_SB(0, 1), cB + hB, voffB); PG8_STAGE(PG8_SA(0, 0), cA, voffA); PG8_STAGE(PG8_SA(0, 1), cA + hA, voffA);
        if (wr == 1) PG8_BAR;
        PG8_WAIT_V(2); PG8_BAR;
        PG8_STAGE(PG8_SB(1, 0), cB + kstep, voffB); PG8_STAGE(PG8_SA(1, 0), cA + kstep, voffA); PG8_STAGE(PG8_SB(1, 1), cB + hB + kstep, voffB);
        PG8_WAIT_V(6); PG8_BAR;
    } else {
        PG8_STAGE(PG8_SB(0, 0), cB, voffB); PG8_STAGE(PG8_SA(0, 0), cA, voffA); PG8_STAGE(PG8_SB(0, 1), cB + hB, voffB); PG8_STAGE(PG8_SA(0, 1), cA + hA, voffA);
        if (wr == 1) PG8_BAR;
        PG8_WAIT_V(4); PG8_BAR;
        PG8_STAGE(PG8_SB(1, 0), cB + kstep, voffB); PG8_STAGE(PG8_SA(1, 0), cA + kstep, voffA); PG8_STAGE(PG8_SB(1, 1), cB + hB + kstep, voffB);
        PG8_WAIT_V(6); PG8_BAR;
    }
    for (;;) {
        const bool has_next = S.next(ui + 1, nxt);
        if constexpr (Epi::BIAS_DMA) { if (has_next && wid == 0) E.bias_dma(nxt, (ui + 1) % 3, lane, lds); }
        const char* nA = has_next ? nxt.A : cA; const char* nB = has_next ? nxt.B : cB;
        const int nt = cur.nt;
        for (int t = 0; t < nt; t += 2) {
            const bool last = (t == nt - 2);
            const char* a1 = cA + (size_t)(t + 1) * kstep;
            const char* a2 = last ? nA : cA + (size_t)(t + 2) * kstep; const char* b2 = last ? nB : cB + (size_t)(t + 2) * kstep;
            const char* a3 = a2 + kstep; const char* b3 = b2 + kstep;
            if constexpr (SP2) {
            PG8_LDB(B0, 0, 0); PG8_LDB(B1, 0, 1); PG8_SCHED; PG8_LDA(At, 0, 0); PG8_STAGE(PG8_SA(1, 1), a1 + hA, voffA);
            PG8_WAIT_V(8); PG8_WAIT_L(0); PG8_BAR; PG8_MMA(0, 0, At, B0); PG8_MMA(0, 1, At, B1); PG8_BAR; PG8_SCHED;
            PG8_LDA(At, 0, 1); PG8_STAGE(PG8_SB(0, 0), b2, voffB); PG8_STAGE(PG8_SB(0, 1), b2 + hB, voffB); PG8_STAGE(PG8_SA(0, 0), a2, voffA);
            PG8_WAIT_V(8); PG8_WAIT_L(0); PG8_BAR; PG8_MMA(1, 0, At, B0); PG8_MMA(1, 1, At, B1); PG8_BAR; PG8_SCHED;
            PG8_LDB(B0, 1, 0); PG8_LDB(B1, 1, 1); PG8_SCHED; PG8_LDA(At, 1, 0); PG8_STAGE(PG8_SA(0, 1), a2 + hA, voffA);
            PG8_WAIT_V(8); PG8_WAIT_L(0); PG8_BAR; PG8_MMA(0, 0, At, B0); PG8_MMA(0, 1, At, B1); PG8_BAR; PG8_SCHED;
            PG8_LDA(At, 1, 1); PG8_STAGE(PG8_SB(1, 0), b3, voffB); PG8_STAGE(PG8_SB(1, 1), b3 + hB, voffB); PG8_STAGE(PG8_SA(1, 0), a3, voffA);
            PG8_WAIT_V(8); PG8_WAIT_L(0); PG8_BAR; PG8_MMA(1, 0, At, B0); PG8_MMA(1, 1, At, B1); PG8_BAR; PG8_SCHED;
            } else {
            PG8_LDB(B0, 0, 0); PG8_SCHED; PG8_LDA(At, 0, 0); PG8_STAGE(PG8_SA(1, 1), a1 + hA, voffA);
            PG8_WAIT_L(8); PG8_BAR; PG8_WAIT_L(0); PG8_MMA(0, 0, At, B0); PG8_BAR; PG8_SCHED;
            PG8_LDB(B1, 0, 1); PG8_STAGE(PG8_SB(0, 0), b2, voffB);
            PG8_BAR; PG8_WAIT_L(0); PG8_MMA(0, 1, At, B1); PG8_BAR;
            PG8_LDA(At, 0, 1); PG8_STAGE(PG8_SA(0, 0), a2, voffA);
            PG8_BAR; PG8_WAIT_L(0); PG8_MMA(1, 0, At, B0); PG8_BAR; PG8_SCHED;
            PG8_STAGE(PG8_SB(0, 1), b2 + hB, voffB);
            PG8_WAIT_V(6); PG8_BAR; PG8_MMA(1, 1, At, B1); PG8_BAR;
            PG8_LDB(B0, 1, 0); PG8_SCHED; PG8_LDA(At, 1, 0); PG8_STAGE(PG8_SA(0, 1), a2 + hA, voffA);
            PG8_WAIT_L(8); PG8_BAR; PG8_WAIT_L(0); PG8_MMA(0, 0, At, B0); PG8_BAR; PG8_SCHED;
            PG8_LDB(B1, 1, 1); PG8_STAGE(PG8_SB(1, 0), b3, voffB);
            PG8_BAR; PG8_WAIT_L(0); PG8_MMA(0, 1, At, B1); PG8_BAR;
            PG8_LDA(At, 1, 1); PG8_STAGE(PG8_SA(1, 0), a3, voffA);
            PG8_BAR; PG8_WAIT_L(0); PG8_MMA(1, 0, At, B0); PG8_BAR; PG8_SCHED;
            PG8_STAGE(PG8_SB(1, 1), b3 + hB, voffB);
            PG8_WAIT_V(6); PG8_BAR; PG8_MMA(1, 1, At, B1); PG8_BAR;
            }
        }
        if constexpr (ALIGN_EPI) { if (wr == 0) PG8_BAR; }
        if constexpr (FP8) asm volatile("s_nop 15\n\ts_nop 15\n\ts_nop 15" ::: "memory");
        cur.bs = ui % 3;
        E(acc, cur, wr, wc, fr, fq);
        if (!has_next) break;
        if (!(Epi::KEEP && cur.aux != 2)) {
#pragma unroll
        for (int a = 0; a < 2; ++a)
#pragma unroll
            for (int b = 0; b < 2; ++b)
#pragma unroll
                for (int m = 0; m < 4; ++m)
#pragma unroll
                    for (int n = 0; n < 2; ++n) acc[a][b][m][n] = (f32x4){0.f, 0.f, 0.f, 0.f};
        }
        cur = nxt; cA = nA; cB = nB; ++ui;
        if constexpr (ALIGN_EPI) { if (wr == 1) PG8_BAR; }
    }
    PG8_WAIT_V(0);
    if constexpr (!ALIGN_EPI) { if (wr == 0) PG8_BAR; }
    PG8_BAR;
#undef PG8_SA
#undef PG8_SB
#undef PG8_STAGE
#undef PG8_LDA
#undef PG8_LDB
#undef PG8_MMA
#undef PG8_WAIT_V
#undef PG8_WAIT_L
#undef PG8_BAR
#undef PG8_SCHED
}

template <class Epi, class Sched, bool FP8 = false>
__device__ __forceinline__ void gemm_phase_gather(PG8_LAS unsigned char* lds, const char* Abase, const int lda, const int ldb, const Sched& S, const Epi& E, const int sclW = 0x7f7f7f7f, const int sclX = 0x7f7f7f7f) {
    constexpr int EB = FP8 ? 1 : 2;
    const int tid = opaque_tid(), wid = __builtin_amdgcn_readfirstlane(tid >> 6), lane = tid & 63, wr = wid >> 2, wc = wid & 3, fr = lane & 15, fq = lane >> 4;
    unsigned voffB[2]; int Rr[2]; unsigned Cc[2];
#pragma unroll
    for (int i = 0; i < 2; ++i) { int R, C; stage_rc(tid * 16 + i * 8192, R, C); const int Rb = Epi::PERM ? ((R & ~31) + perm32(R & 31)) : R;
        Rr[i] = R; Cc[i] = (unsigned)C * 2u; voffB[i] = (unsigned)(Rb * ldb * EB + C * 2); }
    const size_t kstep = (size_t)(BK * 2);
    const size_t hB = (size_t)HALF * ldb * EB;
    const unsigned ldsw = (unsigned)wid * 1024u;
    const int fcol = FP8 ? (32 * (fq >> 1) + 16 * (fq & 1)) : fq * 8;
    const int aoff = lds_byte(wr * 64 + fr, fcol), boff = lds_byte(wc * 32 + fr, fcol);
#define PG8_SA(b, h) (((b) * 2 + (h)) * HTB)
#define PG8_SB(b, h) ((4 + (b) * 2 + (h)) * HTB)
#define PG8_STAGE(bufoff, gbase, voff) do { _Pragma("unroll") for (int _i = 0; _i < 2; ++_i) \
        __builtin_amdgcn_global_load_lds((const unsigned*)((const char*)(gbase) + (voff)[_i]), (PG8_LAS unsigned*)(lds + (bufoff) + ldsw + _i * 8192), 16, 0, 0); } while (0)
#define PG8_LDA(dst, b, h) do { if constexpr (FP8) { _Pragma("unroll") for (int m = 0; m < 4; ++m) dst##8[m] = cat8(*(const PG8_LAS bf16x8*)(lds + PG8_SA(b, h) + aoff + m * 2048), *(const PG8_LAS bf16x8*)(lds + PG8_SA(b, h) + aoff + m * 2048 + 16)); } else { \
        _Pragma("unroll") for (int m = 0; m < 4; ++m) _Pragma("unroll") for (int k = 0; k < 2; ++k) dst[m][k] = *(const PG8_LAS bf16x8*)(lds + PG8_SA(b, h) + aoff + m * 2048 + k * 1024); } } while (0)
#define PG8_LDB(dst, b, h) do { if constexpr (FP8) { _Pragma("unroll") for (int n = 0; n < 2; ++n) dst##8[n] = cat8(*(const PG8_LAS bf16x8*)(lds + PG8_SB(b, h) + boff + n * 2048), *(const PG8_LAS bf16x8*)(lds + PG8_SB(b, h) + boff + n * 2048 + 16)); } else { \
        _Pragma("unroll") for (int n = 0; n < 2; ++n) _Pragma("unroll") for (int k = 0; k < 2; ++k) dst[n][k] = *(const PG8_LAS bf16x8*)(lds + PG8_SB(b, h) + boff + n * 2048 + k * 1024); } } while (0)
#define PG8_MMA(ai, bj, At, Bt) do { __builtin_amdgcn_s_setprio(1); if constexpr (FP8) { _Pragma("unroll") for (int m = 0; m < 4; ++m) _Pragma("unroll") for (int n = 0; n < 2; ++n) \
        asm volatile("v_mfma_f32_16x16x128_f8f6f4 %0, %1, %2, %0" : "+v"(acc[ai][bj][m][n]) : "v"(Bt##8[n]), "v"(At##8[m])); } else { \
        _Pragma("unroll") for (int m = 0; m < 4; ++m) _Pragma("unroll") for (int n = 0; n < 2; ++n) _Pragma("unroll") for (int k = 0; k < 2; ++k) \
        acc[ai][bj][m][n] = __builtin_amdgcn_mfma_f32_16x16x32_bf16(Bt[n][k], At[m][k], acc[ai][bj][m][n], 0, 0, 0); } __builtin_amdgcn_s_setprio(0); } while (0)
#define PG8_WAIT_V(n) asm volatile("s_waitcnt vmcnt(" #n ")" ::: "memory")
#define PG8_WAIT_L(n) asm volatile("s_waitcnt lgkmcnt(" #n ")" ::: "memory")
#define PG8_BAR __builtin_amdgcn_s_barrier()
#define PG8_SCHED __builtin_amdgcn_sched_barrier(0)
#define PG8_ROWOFF(u, vo) do { _Pragma("unroll") for (int _h = 0; _h < 2; ++_h) _Pragma("unroll") for (int _i = 0; _i < 2; ++_i) \
        (vo)[_h][_i] = (unsigned)S.rowtok((u), 128 * _h + Rr[_i]) * (unsigned)(lda * EB) + Cc[_i]; } while (0)
    Unit cur, nxt, nn; int ui = 0;
    if (!S.next(0, cur)) return;
    bool has_next = S.next(1, nxt);
    unsigned cv[2][2], nv[2][2], tv[2][2];
    PG8_ROWOFF(cur, cv);
    if (has_next) PG8_ROWOFF(nxt, nv); else { _Pragma("unroll") for (int h = 0; h < 2; ++h) _Pragma("unroll") for (int i = 0; i < 2; ++i) nv[h][i] = cv[h][i]; }
    f32x4 acc[2][2][4][2];
#pragma unroll
    for (int a = 0; a < 2; ++a)
#pragma unroll
        for (int b = 0; b < 2; ++b)
#pragma unroll
            for (int m = 0; m < 4; ++m)
#pragma unroll
                for (int n = 0; n < 2; ++n) acc[a][b][m][n] = (f32x4){0.f, 0.f, 0.f, 0.f};
    bf16x8 At[4][2], B0[2][2], B1[2][2]; v8i32 At8[4], B08[2], B18[2];
    const char* cB = cur.B;
    if constexpr (Epi::BIAS_DMA) { if (wid == 0) E.bias_dma(cur, 0, lane, lds); }
    PG8_STAGE(PG8_SB(0, 0), cB, voffB); PG8_STAGE(PG8_SB(0, 1), cB + hB, voffB); PG8_STAGE(PG8_SA(0, 0), Abase, cv[0]); PG8_STAGE(PG8_SA(0, 1), Abase, cv[1]);
    if (wr == 1) PG8_BAR;
    PG8_WAIT_V(2); PG8_BAR;
    PG8_STAGE(PG8_SB(1, 0), cB + kstep, voffB); PG8_STAGE(PG8_SA(1, 0), Abase + kstep, cv[0]); PG8_STAGE(PG8_SB(1, 1), cB + hB + kstep, voffB);
    PG8_WAIT_V(6); PG8_BAR;
    for (;;) {
        const char* nB = has_next ? nxt.B : cB;
        if constexpr (Epi::BIAS_DMA) { if (has_next && wid == 0) E.bias_dma(nxt, (ui + 1) % 3, lane, lds); }
        const int nt = cur.nt;
        for (int t = 0; t < nt; t += 2) {
            const bool last = (t == nt - 2);
            const char* a1 = Abase + (size_t)(t + 1) * kstep;
            const char* a2 = last ? Abase : Abase + (size_t)(t + 2) * kstep; const char* b2 = last ? nB : cB + (size_t)(t + 2) * kstep;
            const char* a3 = a2 + kstep; const char* b3 = b2 + kstep;
            unsigned s0[2], s1[2];
#pragma unroll
            for (int i = 0; i < 2; ++i) { s0[i] = last ? nv[0][i] : cv[0][i]; s1[i] = last ? nv[1][i] : cv[1][i]; }
            PG8_LDB(B0, 0, 0); PG8_LDB(B1, 0, 1); PG8_SCHED; PG8_LDA(At, 0, 0); PG8_STAGE(PG8_SA(1, 1), a1, cv[1]);
            PG8_WAIT_V(8); PG8_WAIT_L(0); PG8_BAR; PG8_MMA(0, 0, At, B0); PG8_MMA(0, 1, At, B1); PG8_BAR; PG8_SCHED;
            PG8_LDA(At, 0, 1); PG8_STAGE(PG8_SB(0, 0), b2, voffB); PG8_STAGE(PG8_SB(0, 1), b2 + hB, voffB); PG8_STAGE(PG8_SA(0, 0), a2, s0);
            PG8_WAIT_V(8); PG8_WAIT_L(0); PG8_BAR; PG8_MMA(1, 0, At, B0); PG8_MMA(1, 1, At, B1); PG8_BAR; PG8_SCHED;
            PG8_LDB(B0, 1, 0); PG8_LDB(B1, 1, 1); PG8_SCHED; PG8_LDA(At, 1, 0); PG8_STAGE(PG8_SA(0, 1), a2, s1);
            PG8_WAIT_V(8); PG8_WAIT_L(0); PG8_BAR; PG8_MMA(0, 0, At, B0); PG8_MMA(0, 1, At, B1); PG8_BAR; PG8_SCHED;
            PG8_LDA(At, 1, 1); PG8_STAGE(PG8_SB(1, 0), b3, voffB); PG8_STAGE(PG8_SB(1, 1), b3 + hB, voffB); PG8_STAGE(PG8_SA(1, 0), a3, s0);
            PG8_WAIT_V(8); PG8_WAIT_L(0); PG8_BAR; PG8_MMA(1, 0, At, B0); PG8_MMA(1, 1, At, B1); PG8_BAR; PG8_SCHED;
        }
        if (wr == 0) PG8_BAR;
        if constexpr (FP8) asm volatile("s_nop 15\n\ts_nop 15\n\ts_nop 15" ::: "memory");
        const bool has_nn = has_next && S.next(ui + 2, nn);
        if (has_nn) PG8_ROWOFF(nn, tv);
        cur.bs = ui % 3;
        E(acc, cur, wr, wc, fr, fq);
        if (!has_next) break;
#pragma unroll
        for (int a = 0; a < 2; ++a)
#pragma unroll
            for (int b = 0; b < 2; ++b)
#pragma unroll
                for (int m = 0; m < 4; ++m)
#pragma unroll
                    for (int n = 0; n < 2; ++n) acc[a][b][m][n] = (f32x4){0.f, 0.f, 0.f, 0.f};
        cur = nxt; cB = nB; ++ui;
#pragma unroll
        for (int h = 0; h < 2; ++h)
#pragma unroll
            for (int i = 0; i < 2; ++i) { cv[h][i] = nv[h][i]; if (has_nn) nv[h][i] = tv[h][i]; }
        asm volatile("" : "+v"(nv[0][0]), "+v"(nv[0][1]), "+v"(nv[1][0]), "+v"(nv[1][1]));
        nxt = nn; has_next = has_nn;
        if (wr == 1) PG8_BAR;
    }
    PG8_WAIT_V(0);
    PG8_BAR;
#undef PG8_SA
#undef PG8_SB
#undef PG8_STAGE
#undef PG8_LDA
#undef PG8_LDB
#undef PG8_MMA
#undef PG8_WAIT_V
#undef PG8_WAIT_L
#undef PG8_BAR
#undef PG8_SCHED
#undef PG8_ROWOFF
}

struct DenseOrder {
    const char* A; const char* B; size_t a_tile, b_tile; int nt, nM, nN, G, c; int pn_off = 0;
    __device__ __forceinline__ bool next(int i, Unit& u) const {
        const long L = (long)i * G + c; if (L >= (long)nM * nN) return false;
        int pm, pn; tile_of((int)L, nM, nN, pm, pn);
        u.pm = pm; u.pn = pn + pn_off; u.aux = 0; u.nt = nt; u.A = A + (size_t)pm * a_tile; u.B = B + (size_t)pn * b_tile; return true;
    }
};
struct ProjOrder {
    const char* Y; const char* W; int nM, nN, G, c;
    __device__ __forceinline__ bool next(int i, Unit& u) const {
        const int ti = i / 3, br = i - 3 * ti;
        const long L = (long)ti * G + c; if (L >= (long)nM * nN) return false;
        int pm, pn; tile_of((int)L, nM, nN, pm, pn);
        u.pm = pm; u.pn = pn; u.aux = br; u.nt = (br == 2) ? 6 : 4;
        const int acol = (br == 0) ? 0 : (br == 1 ? 256 : 384), bcol = (br == 0) ? 0 : (br == 1 ? 256 : 512);
        u.A = Y + ((size_t)pm * 256 * YLD + acol) * 2; u.B = W + ((size_t)pn * 256 * WPK + bcol) * 2; return true;
    }
};
struct MoeOrder {
    const char* A; const char* W; size_t estride, atile, btile; int nt; const LAS int* tile_e; const LAS int* offT; const LAS int* cnt; const int* SRC; int T, nN, G, c;
    __device__ __forceinline__ bool next(int i, Unit& u) const {
        const long L = (long)i * G + c; if (L >= (long)T * nN) return false;
        int pm, pn; tile_of((int)L, T, nN, pm, pn);
        const int e = __builtin_amdgcn_readfirstlane(tile_e[pm]);
        u.pm = pm; u.pn = pn; u.aux = e; u.nt = nt; u.A = A + (size_t)pm * atile; u.B = W + (size_t)e * estride + (size_t)pn * btile; return true;
    }
    __device__ __forceinline__ int rowtok(const Unit& u, int r) const {
        const int e = u.aux, rank = (u.pm - offT[e]) * 256 + r, last = cnt[e] - 1;
        return SRC[e * NTOK + (rank < last ? rank : last)];
    }
};

struct EpiInProj {
    static constexpr bool PERM = true, KEEP = false, BIAS_DMA = true;
    bf16_t* H; const float* bg; const f32x2* r64; const f32x2* r48; float gscale; unsigned char* G8; PG8_LAS unsigned char* ldsb;
    __device__ __forceinline__ void bias_dma(const Unit& u, int s, int lane, PG8_LAS unsigned char* lds) const {
        const int o = u.pn >= 12 ? (u.pn - 12) * BM : 0;
        glds16_u(bg + o + lane * 4, (unsigned)__builtin_amdgcn_readfirstlane((int)(unsigned)(size_t)(lds + L_BIAS_OFF + s * 1024))); }
    __device__ __forceinline__ void operator()(f32x4 (&acc)[2][2][4][2], const Unit& u, int wr, int wc, int fr, int fq) const {
        const int row0 = u.pm * BM + wr * 64 + fr, pn = u.pn, t0 = wc * 32 + 8 * fq;
        const float gs = gscale; unsigned char* const g8 = G8;
        if (pn >= 3 && pn < 9) {
            int dst, hstep, tw, dd0; const f32x2* tab;
            if (pn < 6) { dst = 768 + (4 * (pn - 3) + wc) * 64 + 8 * fq; hstep = 32; tw = 32; dd0 = 8 * fq; tab = r64; }
            else { const int p0 = 128 * (pn - 6) + t0, slot = p0 / 24; dd0 = p0 - slot * 24; dst = 1920 + slot * 48 + dd0; hstep = 24; tw = 24; tab = r48; }
#pragma unroll
            for (int ai = 0; ai < 2; ++ai)
#pragma unroll
                for (int m = 0; m < 4; ++m) { const int row = row0 + ai * HALF + m * 16; const f32x2* tp = tab + (size_t)(row & (SEQ - 1)) * tw + dd0;
                    f32x4 y1[2], y2[2];
#pragma unroll
                    for (int n = 0; n < 2; ++n) { const f32x4 cs0 = *(const f32x4*)(tp + 4 * n), cs1 = *(const f32x4*)(tp + 4 * n + 2);
                        const f32x4 x1 = acc[ai][0][m][n], x2 = acc[ai][1][m][n];
                        y1[n][0] = x1[0] * cs0[0] - x2[0] * cs0[1]; y2[n][0] = x2[0] * cs0[0] + x1[0] * cs0[1];
                        y1[n][1] = x1[1] * cs0[2] - x2[1] * cs0[3]; y2[n][1] = x2[1] * cs0[2] + x1[1] * cs0[3];
                        y1[n][2] = x1[2] * cs1[0] - x2[2] * cs1[1]; y2[n][2] = x2[2] * cs1[0] + x1[2] * cs1[1];
                        y1[n][3] = x1[3] * cs1[2] - x2[3] * cs1[3]; y2[n][3] = x2[3] * cs1[2] + x1[3] * cs1[3]; }
                    bf16_t* rowp = H + (size_t)row * INC + dst;
                    u32x4 w; w.x = cvt_pk_bf16(y1[0][0], y1[0][1]); w.y = cvt_pk_bf16(y1[0][2], y1[0][3]); w.z = cvt_pk_bf16(y1[1][0], y1[1][1]); w.w = cvt_pk_bf16(y1[1][2], y1[1][3]);
                    *(u32x4*)rowp = w;
                    w.x = cvt_pk_bf16(y2[0][0], y2[0][1]); w.y = cvt_pk_bf16(y2[0][2], y2[0][3]); w.z = cvt_pk_bf16(y2[1][0], y2[1][1]); w.w = cvt_pk_bf16(y2[1][2], y2[1][3]);
                    *(u32x4*)(rowp + hstep) = w; }
            return;
        }
        const bool gate = pn >= 12;
        int dcol[2];
#pragma unroll
        for (int bj = 0; bj < 2; ++bj) { const int x = pn * BM + bj * HALF + t0;
            if (pn >= 9 && pn < 12) { const int xx = x - 2304; dcol[bj] = xx < 384 ? 1536 + xx : 2688 + (xx - 384); } else dcol[bj] = x; }
        f32x4 bv[2][2];
#pragma unroll
        for (int bj = 0; bj < 2; ++bj)
#pragma unroll
            for (int n = 0; n < 2; ++n) bv[bj][n] = gate ? *(const PG8_LAS f32x4*)((const PG8_LAS float*)(ldsb + L_BIAS_OFF + u.bs * 1024) + bj * HALF + t0 + 4 * n) : (f32x4){0.f, 0.f, 0.f, 0.f};
#pragma unroll
        for (int ai = 0; ai < 2; ++ai)
#pragma unroll
            for (int m = 0; m < 4; ++m) { bf16_t* rowp = H + (size_t)(row0 + ai * HALF + m * 16) * INC;
#pragma unroll
                for (int bj = 0; bj < 2; ++bj) { f32x4 v0 = acc[ai][bj][m][0], v1 = acc[ai][bj][m][1];
                    if (gate) {
#pragma unroll
                        for (int q = 0; q < 4; ++q) { v0[q] = v0[q] * gs + bv[bj][0][q]; v1[q] = v1[q] * gs + bv[bj][1][q]; }
                        const unsigned b0 = (unsigned)(fast_sigmoid(v0[0]) * 255.0f + 0.5f) | ((unsigned)(fast_sigmoid(v0[1]) * 255.0f + 0.5f) << 8) | ((unsigned)(fast_sigmoid(v0[2]) * 255.0f + 0.5f) << 16) | ((unsigned)(fast_sigmoid(v0[3]) * 255.0f + 0.5f) << 24);
                        const unsigned b1 = (unsigned)(fast_sigmoid(v1[0]) * 255.0f + 0.5f) | ((unsigned)(fast_sigmoid(v1[1]) * 255.0f + 0.5f) << 8) | ((unsigned)(fast_sigmoid(v1[2]) * 255.0f + 0.5f) << 16) | ((unsigned)(fast_sigmoid(v1[3]) * 255.0f + 0.5f) << 24);
                        *(v2u*)(g8 + (size_t)(row0 + ai * HALF + m * 16) * 3072 + (dcol[bj] - C_GP)) = (v2u){b0, b1};
                    } else {
                        u32x4 w; w.x = cvt_pk_bf16(v0[0], v0[1]); w.y = cvt_pk_bf16(v0[2], v0[3]); w.z = cvt_pk_bf16(v1[0], v1[1]); w.w = cvt_pk_bf16(v1[2], v1[3]);
                        *(u32x4*)(rowp + dcol[bj]) = w; } } }
    }
};
struct EpiProj {
    static constexpr bool PERM = false, KEEP = true, BIAS_DMA = false;
    const unsigned char* G8; bf16_t* Mg;
    __device__ __forceinline__ void operator()(f32x4 (&acc)[2][2][4][2], const Unit& u, int wr, int wc, int fr, int fq) const {
        const int row0 = u.pm * BM + wr * 64 + fr, col0 = u.pn * BM + wc * 32 + 4 * fq, br = u.aux;
#pragma unroll
        for (int ai = 0; ai < 2; ++ai)
#pragma unroll
            for (int m = 0; m < 4; ++m) { const size_t row = (size_t)(row0 + ai * HALF + m * 16);
#pragma unroll
                for (int bj = 0; bj < 2; ++bj)
#pragma unroll
                    for (int n = 0; n < 2; ++n) { const int c = col0 + bj * HALF + n * 16;
                        const unsigned char* gp = G8 + row * 3072 + br * 1024 + c;
                        const unsigned gw = *(const unsigned*)gp;
                        f32x4 g = (f32x4){fmaxf((float)(gw & 255u) * (1.0f / 255.0f), 1e-6f), fmaxf((float)((gw >> 8) & 255u) * (1.0f / 255.0f), 1e-6f), fmaxf((float)((gw >> 16) & 255u) * (1.0f / 255.0f), 1e-6f), fmaxf((float)(gw >> 24) * (1.0f / 255.0f), 1e-6f)};
                        if (br < 2) { const unsigned nw = *(const unsigned*)(gp + 1024);
                            g[0] *= __builtin_amdgcn_rcpf(fmaxf((float)(nw & 255u) * (1.0f / 255.0f), 1e-6f)); g[1] *= __builtin_amdgcn_rcpf(fmaxf((float)((nw >> 8) & 255u) * (1.0f / 255.0f), 1e-6f));
                            g[2] *= __builtin_amdgcn_rcpf(fmaxf((float)((nw >> 16) & 255u) * (1.0f / 255.0f), 1e-6f)); g[3] *= __builtin_amdgcn_rcpf(fmaxf((float)(nw >> 24) * (1.0f / 255.0f), 1e-6f));
                            acc[ai][bj][m][n] = acc[ai][bj][m][n] * g; }
                        else { const f32x4 t = acc[ai][bj][m][n] * g; v2u o; o.x = cvt_pk_bf16(t[0], t[1]); o.y = cvt_pk_bf16(t[2], t[3]); *(v2u*)(Mg + row * 1024 + c) = o; } } }
    }
};
struct EpiOut {
    static constexpr bool PERM = false, KEEP = false, BIAS_DMA = false;
    const float* X; const bf16_t* XBr; float* P;
    __device__ __forceinline__ void operator()(f32x4 (&acc)[2][2][4][2], const Unit& u, int wr, int wc, int fr, int fq) const {
        const int row0 = u.pm * BM + wr * 64 + fr, col0 = u.pn * BM + wc * 32 + 4 * fq;
        const float* const Xf = X; const bf16_t* const Xh = XBr; float* const Pp = P;
#pragma unroll
        for (int ai = 0; ai < 2; ++ai)
#pragma unroll
            for (int m = 0; m < 4; ++m) { const size_t ro = (size_t)(row0 + ai * HALF + m * 16) * 1024 + col0;
#pragma unroll
                for (int bj = 0; bj < 2; ++bj)
#pragma unroll
                    for (int n = 0; n < 2; ++n) { f32x4 xv;
                        if (Xf) xv = *(const f32x4*)(Xf + ro + bj * HALF + n * 16);
                        else { const v2u xw = *(const v2u*)(Xh + ro + bj * HALF + n * 16); xv = (f32x4){bflo(xw.x), bfhi(xw.x), bflo(xw.y), bfhi(xw.y)}; }
                        *(f32x4*)(Pp + ro + bj * HALF + n * 16) = xv * DN_ALPHA + acc[ai][bj][m][n]; } }
    }
};
struct EpiSwiglu {
    static constexpr bool PERM = true, KEEP = false, BIAS_DMA = true;
    unsigned char* HH; const float* bgate; const float* bup; float ascale; PG8_LAS unsigned char* ldsb;
    __device__ __forceinline__ void bias_dma(const Unit& u, int s, int lane, PG8_LAS unsigned char* lds) const {
        const float* src = (lane < 32 ? bgate : bup) + u.aux * 1024 + u.pn * HALF + (lane & 31) * 4;
        glds16_u(src, (unsigned)__builtin_amdgcn_readfirstlane((int)(unsigned)(size_t)(lds + L_BIAS_OFF + s * 1024))); }
    __device__ __forceinline__ void operator()(f32x4 (&acc)[2][2][4][2], const Unit& u, int wr, int wc, int fr, int fq) const {
        const int row0 = u.pm * BM + wr * 64 + fr, j0 = u.pn * HALF + wc * 32 + 8 * fq, e = u.aux;
        f32x4 bg[2], bu[2];
#pragma unroll
        for (int n = 0; n < 2; ++n) { const PG8_LAS float* bl = (const PG8_LAS float*)(ldsb + L_BIAS_OFF + u.bs * 1024) + wc * 32 + 8 * fq + 4 * n; bg[n] = *(const PG8_LAS f32x4*)bl; bu[n] = *(const PG8_LAS f32x4*)(bl + HALF); }
#pragma unroll
        for (int ai = 0; ai < 2; ++ai)
#pragma unroll
            for (int m = 0; m < 4; ++m) { unsigned char* rowp = HH + (size_t)(row0 + ai * HALF + m * 16) * 1024 + j0;
                f32x4 o[2];
#pragma unroll
                for (int n = 0; n < 2; ++n) { f32x4 g = acc[ai][0][m][n] * ascale + bg[n], uu = acc[ai][1][m][n] * ascale + bu[n];
#pragma unroll
                    for (int q = 0; q < 4; ++q) { const float hg = fminf(g[q], 7.0f), hu = fminf(fmaxf(uu[q], -7.0f), 7.0f);
                        o[n][q] = hg * fast_sigmoid(1.702f * hg) * (hu + 1.0f); } }
                v2u w; w.x = pk4_fp8(o[0][0], o[0][1], o[0][2], o[0][3], 4.0f); w.y = pk4_fp8(o[1][0], o[1][1], o[1][2], o[1][3], 4.0f);
                *(v2u*)rowp = w; }
    }
};
struct EpiDown {
    static constexpr bool PERM = true, KEEP = false, BIAS_DMA = true;
    bf16_t* YS; const float* bd; float ascale; PG8_LAS unsigned char* ldsb;
    __device__ __forceinline__ void bias_dma(const Unit& u, int s, int lane, PG8_LAS unsigned char* lds) const {
        glds16_u(bd + u.aux * 1024 + u.pn * BM + lane * 4, (unsigned)__builtin_amdgcn_readfirstlane((int)(unsigned)(size_t)(lds + L_BIAS_OFF + s * 1024))); }
    __device__ __forceinline__ void operator()(f32x4 (&acc)[2][2][4][2], const Unit& u, int wr, int wc, int fr, int fq) const {
        const int row0 = u.pm * BM + wr * 64 + fr, col0 = u.pn * BM + wc * 32 + 8 * fq, e = u.aux;
        f32x4 bv[2][2];
#pragma unroll
        for (int bj = 0; bj < 2; ++bj)
#pragma unroll
            for (int n = 0; n < 2; ++n) bv[bj][n] = *(const PG8_LAS f32x4*)((const PG8_LAS float*)(ldsb + L_BIAS_OFF + u.bs * 1024) + wc * 32 + 8 * fq + bj * HALF + 4 * n);
#pragma unroll
        for (int ai = 0; ai < 2; ++ai)
#pragma unroll
            for (int m = 0; m < 4; ++m) { bf16_t* rowp = YS + (size_t)(row0 + ai * HALF + m * 16) * 1024 + col0;
#pragma unroll
                for (int bj = 0; bj < 2; ++bj) { const f32x4 v0 = acc[ai][bj][m][0] * ascale + bv[bj][0], v1 = acc[ai][bj][m][1] * ascale + bv[bj][1];
                    u32x4 w; w.x = cvt_pk_bf16(v0[0], v0[1]); w.y = cvt_pk_bf16(v0[2], v0[3]); w.z = cvt_pk_bf16(v1[0], v1[1]); w.w = cvt_pk_bf16(v1[2], v1[3]);
                    *(u32x4*)(rowp + bj * HALF) = w; } }
    }
};
}

#define XB_TMO      128
#define XB_XCNT(j)  (256  + 64 * (j))
#define XB_XSUB(j)  (1280 + 64 * (j))
#define XB_XGEN(j)  (2304 + 64 * (j))
#define XB_TOP      3328
#define XB_TOPGEN   3392
#define XCD_BAR_WORDS 3456
#define XB_SPIN_CAP (1u << 18)

__device__ __forceinline__ unsigned xb_ld(unsigned* p)              { return __hip_atomic_load(p, __ATOMIC_RELAXED, __HIP_MEMORY_SCOPE_AGENT); }
__device__ __forceinline__ unsigned xb_add(unsigned* p, unsigned v) { return __hip_atomic_fetch_add(p, v, __ATOMIC_RELAXED, __HIP_MEMORY_SCOPE_AGENT); }
__device__ __forceinline__ unsigned xb_xcc_id() { return (unsigned)__builtin_amdgcn_s_getreg((3 << 11) | 20) & 0xFu; }
#define XB_SPIN(cond, bar) do { unsigned _sp = 0; while (cond) { __builtin_amdgcn_s_sleep(1); \
    if ((++_sp & 255u) == 0u) { if (xb_ld(&(bar)[XB_TMO])) break; if (_sp > XB_SPIN_CAP) { atomicAdd(&(bar)[XB_TMO], 1u); break; } } } } while (0)

struct XcdBarrier { unsigned* bar; unsigned x; volatile LAS unsigned* st; };

__device__ __forceinline__ XcdBarrier xcd_barrier_post(unsigned* bar, volatile LAS unsigned* st) {
    XcdBarrier b; b.bar = bar; b.x = xb_xcc_id(); b.st = st;
    if (threadIdx.x == 0) (void)xb_add(&bar[XB_XCNT(b.x)], 1u);
    return b;
}
__device__ __forceinline__ void xcd_barrier_complete(unsigned* bar, unsigned x, unsigned& nloc, unsigned& nx) {
    const unsigned G = gridDim.x * gridDim.y * gridDim.z;
    unsigned sum, cnt, mine, sp = 0u;
    for (;;) {
        sum = 0u; cnt = 0u; mine = 0u;
#pragma unroll
        for (unsigned j = 0; j < 16; ++j) { const unsigned c = xb_ld(&bar[XB_XCNT(j)]); sum += c; cnt += (c > 0u) ? 1u : 0u; mine = (j == x) ? c : mine; }
        if (sum == G) break;
        __builtin_amdgcn_s_sleep(1);
        if ((++sp & 255u) == 0u) { if (xb_ld(&bar[XB_TMO])) break; if (sp > XB_SPIN_CAP) { atomicAdd(&bar[XB_TMO], 1u); break; } }
    }
    nloc = mine > 0u ? mine : 1u; nx = cnt > 0u ? cnt : 1u;
}
__device__ __forceinline__ void xcd_barrier(const XcdBarrier& b) {
    asm volatile("s_waitcnt vmcnt(0)" ::: "memory");
    __syncthreads();
    if (threadIdx.x == 0) {
        unsigned* bar = b.bar;
        __builtin_amdgcn_s_waitcnt(0);
        unsigned nloc = b.st[0], nx = b.st[1];
        if (nloc == 0u) { xcd_barrier_complete(bar, b.x, nloc, nx); b.st[0] = nloc; b.st[1] = nx; }
        const unsigned old = xb_add(&bar[XB_XSUB(b.x)], 1u);
        const unsigned gen = old / nloc;
        if (old + 1u == (gen + 1u) * nloc) {
            __builtin_amdgcn_fence(__ATOMIC_RELEASE, "agent");
            asm volatile("s_waitcnt vmcnt(0)" ::: "memory");
            const unsigned og = xb_add(&bar[XB_TOP], 1u);
            const unsigned tg = og / nx;
            if (og + 1u == (tg + 1u) * nx) xb_add(&bar[XB_TOPGEN], 1u);
            else XB_SPIN(xb_ld(&bar[XB_TOPGEN]) == tg, bar);
            __builtin_amdgcn_fence(__ATOMIC_ACQUIRE, "agent");
            xb_add(&bar[XB_XGEN(b.x)], 1u);
            asm volatile("s_waitcnt vmcnt(0)" ::: "memory");
        } else {
            XB_SPIN(xb_ld(&bar[XB_XGEN(b.x)]) == gen, bar);
            __builtin_amdgcn_fence(__ATOMIC_ACQUIRE, "agent");
            asm volatile("s_waitcnt vmcnt(0)" ::: "memory");
        }
    }
    __syncthreads();
}

struct Frame {
    LAS unsigned char* lds;
    unsigned* ctl;
    unsigned char* ws;
    int tid, lane, wave, G, bid;
};

__host__ __device__ __forceinline__ int inproj_phys(int nl) {
    if (nl < 768) return nl;
    if (nl < 1536) { const int x = nl - 768, slot = x >> 6, d = x & 63; return 768 + (slot >> 2) * 256 + (d >> 5) * 128 + (slot & 3) * 32 + (d & 31); }
    if (nl < 1920) return 2304 + (nl - 1536);
    if (nl < 2688) { const int x = nl - 1920, slot = x / 48, d = x - slot * 48, hf = d >= 24 ? 1 : 0, p = slot * 24 + d - 24 * hf; return 1536 + (p >> 7) * 256 + hf * 128 + (p & 127); }
    if (nl < 3072) return 2304 + 384 + (nl - 2688);
    return nl;
}
template <class RowMap>
__device__ __forceinline__ void transpose_item(const float* W, int N, bf16* dst, int ldd, int k0, int n0, const RowMap rowmap, LAS float* scr, int lane) {
#pragma unroll 8
    for (int i = 0; i < 32; ++i) { const int kk = 2 * i + (lane >> 5); scr[kk * 33 + (lane & 31)] = W[(size_t)(k0 + kk) * N + n0 + (lane & 31)]; }
    LDS_WAIT(); asm volatile("" ::: "memory");
    const int c = lane & 7;
#pragma unroll
    for (int j = 0; j < 4; ++j) { const int n = (lane >> 3) + 8 * j; const LAS float* sp = scr + (8 * c) * 33 + n;
        v4u o; o.x = pk2(sp[0 * 33], sp[1 * 33]); o.y = pk2(sp[2 * 33], sp[3 * 33]); o.z = pk2(sp[4 * 33], sp[5 * 33]); o.w = pk2(sp[6 * 33], sp[7 * 33]);
        *(v4u*)(dst + (size_t)rowmap(n0 + n) * ldd + k0 + 8 * c) = o; }
    LDS_WAIT(); asm volatile("" ::: "memory");
}

template <class RowMap>
__device__ __forceinline__ void transpose_item_fp8(const float* W, int N, unsigned char* dst, int ldd, int k0, int n0, const RowMap rowmap, LAS float* scr, int lane, float qs) {
#pragma unroll 8
    for (int i = 0; i < 32; ++i) { const int kk = 2 * i + (lane >> 5); scr[kk * 33 + (lane & 31)] = W[(size_t)(k0 + kk) * N + n0 + (lane & 31)]; }
    LDS_WAIT(); asm volatile("" ::: "memory");
    const int c = lane & 7;
#pragma unroll
    for (int j = 0; j < 4; ++j) { const int n = (lane >> 3) + 8 * j; const LAS float* sp = scr + (8 * c) * 33 + n;
        v2u o; o.x = pk4_fp8(sp[0 * 33], sp[1 * 33], sp[2 * 33], sp[3 * 33], qs); o.y = pk4_fp8(sp[4 * 33], sp[5 * 33], sp[6 * 33], sp[7 * 33], qs);
        *(v2u*)(dst + (size_t)rowmap(n0 + n) * ldd + k0 + 8 * c) = o; }
    LDS_WAIT(); asm volatile("" ::: "memory");
}

struct Args { const float* in[22]; float* out; unsigned char* ws; int ph_lo, ph_hi; float lam_init[4]; };

__device__ __forceinline__ void p_prologue(Frame& F, const Args& a) {
    LAS float* scr = (LAS float*)(F.lds + F.wave * 16384);
    const int gw = F.bid * 8 + F.wave, NGW = F.G * 8;
    constexpr int PER_LAYER = 3072 + 128 + 64 + 192 + 512 + 32 * 1536;
    for (int it = gw; it < DEPTH * PER_LAYER; it += NGW) {
        const int l = it / PER_LAYER; int r = it - l * PER_LAYER;
        if (r < 3072) { const int kb = r / 192, nb = r % 192;
            if (nb < 96) transpose_item(a.in[1] + (size_t)l * 1024 * INC, INC, (bf16*)(F.ws + WS_WIN) + (size_t)l * INC * 1024, 1024, kb * 64, nb * 32, [](int n) { return inproj_phys(n); }, scr, F.lane);
            else transpose_item_fp8(a.in[1] + (size_t)l * 1024 * INC, INC, (unsigned char*)(F.ws + WS_WIN8) + (size_t)l * 3072 * 1024, 1024, kb * 64, nb * 32, [](int n) { return n - 3072; }, scr, F.lane, 32.f);
            continue; }
        r -= 3072;
        if (r < 128) { const int kb = r / 32, nb = r % 32;
            transpose_item(a.in[3] + (size_t)l * 256 * 1024, 1024, (bf16*)(F.ws + WS_WPROJ) + (size_t)l * 1024 * WPK + 0, WPK, kb * 64, nb * 32, [](int n) { return n; }, scr, F.lane); continue; }
        r -= 128;
        if (r < 64) { const int kb = r / 32, nb = r % 32;
            transpose_item(a.in[4] + (size_t)l * 128 * 1024, 1024, (bf16*)(F.ws + WS_WPROJ) + (size_t)l * 1024 * WPK + 256, WPK, kb * 64, nb * 32, [](int n) { return n; }, scr, F.lane); continue; }
        r -= 64;
        if (r < 192) { const int kb = r / 32, nb = r % 32;
            transpose_item(a.in[5] + (size_t)l * 384 * 1024, 1024, (bf16*)(F.ws + WS_WPROJ) + (size_t)l * 1024 * WPK + 512, WPK, kb * 64, nb * 32, [](int n) { return n; }, scr, F.lane); continue; }
        r -= 192;
        if (r < 512) { const int kb = r / 32, nb = r % 32;
            transpose_item(a.in[6] + (size_t)l * 1024 * 1024, 1024, (bf16*)(F.ws + WS_WOUT) + (size_t)l * 1024 * 1024, 1024, kb * 64, nb * 32, [](int n) { return n; }, scr, F.lane); continue; }
        r -= 512;
        { const int e = r / 1536, r2 = r % 1536, mtx = r2 / 512, r3 = r2 % 512, kb = r3 / 32, nb = r3 % 32;
          const size_t eoff = ((size_t)l * NEXP + e) * 1024 * 1024;
          if (mtx == 0) transpose_item_fp8(a.in[14] + eoff, 1024, (unsigned char*)(F.ws + WS_WGU) + 2 * eoff, 1024, kb * 64, nb * 32, [](int n) { return (n >> 7) * 256 + (n & 127); }, scr, F.lane, 32.f);
          else if (mtx == 1) transpose_item_fp8(a.in[16] + eoff, 1024, (unsigned char*)(F.ws + WS_WGU) + 2 * eoff, 1024, kb * 64, nb * 32, [](int n) { return (n >> 7) * 256 + 128 + (n & 127); }, scr, F.lane, 32.f);
          else transpose_item_fp8(a.in[18] + eoff, 1024, (unsigned char*)(F.ws + WS_WDN) + eoff, 1024, kb * 64, nb * 32, [](int n) { return n; }, scr, F.lane, 64.f); }
    }
    { const int gt = F.bid * 512 + F.tid, NT = F.G * 512;
      for (int i = gt; i < DEPTH * 1024 * 16; i += NT) { const int row = i >> 4, ch = i & 15;
          *(v4u*)((bf16*)(F.ws + WS_WPROJ) + (size_t)row * WPK + 384 + ch * 8) = (v4u){0u, 0u, 0u, 0u}; }
      for (int i = gt; i < SEQ * 32; i += NT) { const int pos = i >> 5, j = i & 31;
          const float inv = 1.0f / powf(10000.0f, (float)(2 * j) / 64.0f); const float ang = (float)pos * inv; float s, c; sincosf(ang, &s, &c);
          ((f32x2*)(F.ws + WS_ROPE64))[i] = (f32x2){c, s}; }
      for (int i = gt; i < SEQ * 24; i += NT) { const int pos = i / 24, j = i - pos * 24;
          const float inv = 1.0f / powf(10000.0f, (float)(2 * j) / 48.0f); const float ang = (float)pos * inv; float s, c; sincosf(ang, &s, &c);
          ((f32x2*)(F.ws + WS_ROPE48))[i] = (f32x2){c, s}; }
      for (int i = gt; i < DEPTH * 32 * 1024; i += NT) { const int l = i >> 15, e = (i >> 10) & 31, k = i & 1023;
          const float wv = a.in[12][((size_t)l * 1024 + k) * 32 + e]; const unsigned hi = f2bf(wv); const unsigned lo = f2bf(wv - __uint_as_float(hi << 16));
          bf16* wt = (bf16*)(F.ws + WS_WRT) + (size_t)l * 2 * 32 * 1024; wt[e * 1024 + k] = (bf16)hi; wt[32 * 1024 + e * 1024 + k] = (bf16)lo; }
      const f32x4* x4 = (const f32x4*)a.in[0]; v2u* xb = (v2u*)(F.ws + WS_XB);
      unsigned* xb8 = (unsigned*)(F.ws + WS_XB8);
      for (int i = gt; i < NTOK * 256; i += NT) { const f32x4 v = x4[i]; xb[i] = (v2u){pk2(v[0], v[1]), pk2(v[2], v[3])}; xb8[i] = pk4_fp8(v[0], v[1], v[2], v[3], 1.0f); }
    }
}

typedef float f32x16 __attribute__((ext_vector_type(16)));
typedef short s16x4 __attribute__((ext_vector_type(4)));
typedef float f32x2_t __attribute__((ext_vector_type(2)));
typedef __bf16 bf16x2_t __attribute__((ext_vector_type(2)));
__device__ __forceinline__ unsigned cvtpk(float lo, float hi) { const f32x2_t v = {lo, hi}; const bf16x2_t b = __builtin_convertvector(v, bf16x2_t); return __builtin_bit_cast(unsigned, b); }
__device__ __forceinline__ int kperm(int r) { return (r & ~12) | ((r & 4) << 1) | ((r & 8) >> 1); }
__device__ __forceinline__ s16x4 ds_tr16(const LAS unsigned char* p) { return __builtin_bit_cast(s16x4, __builtin_amdgcn_ds_read_tr16_b64_v4i16((LAS s16x4*)p)); }

__device__ __forceinline__ float fmax_nc(float a, float b) { return __builtin_amdgcn_fmed3f(a, b, __builtin_inff()); }
__device__ __forceinline__ void glds16(const void* gsrc, unsigned lds_dst) { unsigned keep;
    asm volatile("s_mov_b32 %0, m0\n\ts_mov_b32 m0, %2\n\ts_nop 0\n\tglobal_load_lds_dwordx4 %1, off\n\ts_mov_b32 m0, %0" : "=&s"(keep) : "v"(gsrc), "s"(lds_dst) : "memory"); }
__device__ __forceinline__ void attnC_pipe(Frame& F, const float* lamv, const float* ng, float lam_init) {
    const bf16* H = (const bf16*)(F.ws + WS_H); bf16* Y = (bf16*)(F.ws + WS_Y);
    const int lane = F.lane, w = F.wave, n = lane & 31, hh = lane >> 5;
    float l01 = 0.f, l23 = 0.f;
    if (lane < 48) { l01 = lamv[lane] * lamv[48 + lane]; l23 = lamv[96 + lane] * lamv[144 + lane]; }
    l01 = wave_sum(l01); l23 = wave_sum(l23);
    const float lam = expf(l01) - expf(l23) + lam_init;
    const float post = 1.0f - lam_init;
    constexpr int KST = 208, VST = 192, KBYTES = 64 * KST, STAGE = KBYTES + 64 * VST, NT = SEQ / 64;
    constexpr float CS = 0.14433756729740643f * 1.4426950408889634f;
    constexpr float PMAX = 256.0f;
    unsigned goff[4], loff[4];
#pragma unroll
    for (int j = 0; j < 4; ++j) { const int I = w + 8 * j;
        if (I < 13) { const int cid = I * 64 + lane, row = cid / 13; int col = cid - row * 13; if (col == 12) col = 0;
            goff[j] = (unsigned)(row * INC + C_KC + col * 8) * 2u; loff[j] = (unsigned)(I * 1024); }
        else { const int cid = (I - 13) * 64 + lane, row = cid / 12, col = cid - row * 12;
            goff[j] = (unsigned)(row * INC + C_VC + col * 8) * 2u; loff[j] = (unsigned)(KBYTES + (I - 13) * 1024); } }
    const int koff = kperm(n) * KST + hh * 16;
    const int g = lane >> 4, i16 = lane & 15;
    const int voff = KBYTES + (8 * (g >> 1) + (i16 >> 2)) * VST + (16 * (g & 1) + 4 * (i16 & 3)) * 2;
#define C_ISSUE(tt) do { const char* gb_ = gbase + (size_t)(tt) * (64 * INC * 2); const int so_ = ((tt) & 3) * STAGE; _Pragma("unroll") for (int j_ = 0; j_ < 4; ++j_) if (w + 8 * j_ < 25) \
        glds16(gb_ + goff[j_], (unsigned)__builtin_amdgcn_readfirstlane((int)(unsigned)(size_t)(F.lds + so_ + loff[j_]))); } while (0)
#define C_RDV(slotV, kbV, s2v) do { _Pragma("unroll") for (int d_ = 0; d_ < 3; ++d_) { const LAS unsigned char* vp_ = (slotV) + voff + ((kbV) * 32 + 16 * (s2v)) * VST + d_ * 64; \
            const s16x4 v0_ = ds_tr16(vp_), v1_ = ds_tr16(vp_ + 4 * VST); vf[d_] = (bf16x8){v0_[0], v0_[1], v0_[2], v0_[3], v1_[0], v1_[1], v1_[2], v1_[3]}; } } while (0)
#define C_FENCE __builtin_amdgcn_sched_barrier(0)
#define C_QK0(dst, slotbase) do { { const bf16x8 kf_ = *(const LAS bf16x8*)((slotbase) + koff); dst = __builtin_amdgcn_mfma_f32_32x32x16_bf16(kf_, qf[0][0], NEGR[0], 0, 0, 0); } \
        _Pragma("unroll") for (int s_ = 1; s_ < 3; ++s_) { const bf16x8 kf_ = *(const LAS bf16x8*)((slotbase) + koff + (2 * s_) * 16); dst = __builtin_amdgcn_mfma_f32_32x32x16_bf16(kf_, qf[0][s_], dst, 0, 0, 0); } } while (0)
#define C_ITEM(Sx, c, pout, pin, cp, slotVp, kbVp, slotKc, kbKc, slotKn, kbKn, cn) do { \
        _Pragma("unroll") for (int s2_ = 0; s2_ < 2; ++s2_) _Pragma("unroll") for (int d_ = 0; d_ < 3; ++d_) { const LAS unsigned char* vp_ = (slotVp) + voff + ((kbVp) * 32 + 16 * s2_) * VST + d_ * 64; \
            const s16x4 v0_ = ds_tr16(vp_), v1_ = ds_tr16(vp_ + 4 * VST); vf[s2_ * 3 + d_] = (bf16x8){v0_[0], v0_[1], v0_[2], v0_[3], v1_[0], v1_[1], v1_[2], v1_[3]}; } \
        _Pragma("unroll") for (int s_ = 0; s_ < 3; ++s_) kf[s_] = *(const LAS bf16x8*)((slotKn) + (kbKn) * 32 * KST + koff + ((cn) * 6 + 2 * s_) * 16); \
        C_FENCE; \
        const float lold_ = l[c]; \
        _Pragma("unroll") for (int r_ = 0; r_ < 16; ++r_) Sx[r_] = __builtin_amdgcn_exp2f(Sx[r_]); \
        float pm_ = fmaxf(fmaxf(Sx[0], Sx[1]), Sx[2]); _Pragma("unroll") for (int r_ = 3; r_ < 15; r_ += 2) pm_ = fmaxf(fmaxf(pm_, Sx[r_]), Sx[r_ + 1]); pm_ = fmaxf(pm_, Sx[15]); \
        _Pragma("unroll") for (int r_ = 0; r_ < 16; ++r_) l[c] += Sx[r_]; \
        _Pragma("unroll") for (int s2_ = 0; s2_ < 2; ++s2_) { v4u pw_; pw_.x = cvtpk(Sx[8 * s2_ + 0], Sx[8 * s2_ + 1]); pw_.y = cvtpk(Sx[8 * s2_ + 2], Sx[8 * s2_ + 3]); \
            pw_.z = cvtpk(Sx[8 * s2_ + 4], Sx[8 * s2_ + 5]); pw_.w = cvtpk(Sx[8 * s2_ + 6], Sx[8 * s2_ + 7]); pout[s2_] = __builtin_bit_cast(bf16x8, pw_); } \
        _Pragma("unroll") for (int s2_ = 0; s2_ < 2; ++s2_) _Pragma("unroll") for (int d_ = 0; d_ < 3; ++d_) O[cp][d_] = __builtin_amdgcn_mfma_f32_32x32x16_bf16(vf[s2_ * 3 + d_], pin[s2_], O[cp][d_], 0, 0, 0); \
        _Pragma("unroll") for (int g_ = 0; g_ < 6; ++g_) { __builtin_amdgcn_sched_group_barrier(0x008, 1, 0); __builtin_amdgcn_sched_group_barrier(0x400, 3, 0); __builtin_amdgcn_sched_group_barrier(0x002, 7, 0); } \
        C_FENCE; \
        pm_ = fmaxf(pm_, __shfl_xor(pm_, 32)); \
        if (__any(pm_ > PMAX) || first) { f32x16 Sr_; \
            { const bf16x8 k0_ = *(const LAS bf16x8*)((slotKc) + (kbKc) * 32 * KST + koff + ((c) * 6 + 0) * 16), k1_ = *(const LAS bf16x8*)((slotKc) + (kbKc) * 32 * KST + koff + ((c) * 6 + 2) * 16), k2_ = *(const LAS bf16x8*)((slotKc) + (kbKc) * 32 * KST + koff + ((c) * 6 + 4) * 16); \
              Sr_ = __builtin_amdgcn_mfma_f32_32x32x16_bf16(k0_, qf[c][0], NEGR[c], 0, 0, 0); Sr_ = __builtin_amdgcn_mfma_f32_32x32x16_bf16(k1_, qf[c][1], Sr_, 0, 0, 0); Sr_ = __builtin_amdgcn_mfma_f32_32x32x16_bf16(k2_, qf[c][2], Sr_, 0, 0, 0); } \
            float mx_ = fmax_nc(Sr_[0], Sr_[1]); _Pragma("unroll") for (int r_ = 2; r_ < 16; ++r_) mx_ = fmax_nc(mx_, Sr_[r_]); mx_ = fmaxf(mx_, __shfl_xor(mx_, 32)); \
            const float dl_ = (pm_ > PMAX || first) ? mx_ : 0.0f, al_ = __builtin_amdgcn_exp2f(-dl_); \
            _Pragma("unroll") for (int d_ = 0; d_ < 3; ++d_) _Pragma("unroll") for (int r_ = 0; r_ < 16; ++r_) O[c][d_][r_] *= al_; \
            float ls_ = lold_ * al_; \
            _Pragma("unroll") for (int r_ = 0; r_ < 16; ++r_) { NEGR[c][r_] -= dl_; Sr_[r_] = __builtin_amdgcn_exp2f(Sr_[r_] - dl_); ls_ += Sr_[r_]; } \
            l[c] = ls_; \
            _Pragma("unroll") for (int s2_ = 0; s2_ < 2; ++s2_) { v4u pw_; pw_.x = cvtpk(Sr_[8 * s2_ + 0], Sr_[8 * s2_ + 1]); pw_.y = cvtpk(Sr_[8 * s2_ + 2], Sr_[8 * s2_ + 3]); \
                pw_.z = cvtpk(Sr_[8 * s2_ + 4], Sr_[8 * s2_ + 5]); pw_.w = cvtpk(Sr_[8 * s2_ + 6], Sr_[8 * s2_ + 7]); pout[s2_] = __builtin_bit_cast(bf16x8, pw_); } } \
        C_FENCE; \
        Sx = __builtin_amdgcn_mfma_f32_32x32x16_bf16(kf[0], qf[cn][0], NEGR[cn], 0, 0, 0); Sx = __builtin_amdgcn_mfma_f32_32x32x16_bf16(kf[1], qf[cn][1], Sx, 0, 0, 0); Sx = __builtin_amdgcn_mfma_f32_32x32x16_bf16(kf[2], qf[cn][2], Sx, 0, 0, 0); \
        C_FENCE; } while (0)
    for (int unit = F.bid; unit < 512; unit += F.G) {
        const int b = unit >> 6, h = (unit >> 4) & 3, qb = unit & 15;
        const int tok = b * SEQ + qb * 256 + w * 32 + n;
        const char* gbase = (const char*)(H + (size_t)(b * SEQ) * INC + h * 96);
        C_ISSUE(0); C_ISSUE(1);
        bf16x8 qf[2][3];
        { const bf16* qp = H + (size_t)tok * INC + C_QC + h * 96 + 8 * hh;
#pragma unroll
          for (int c = 0; c < 2; ++c)
#pragma unroll
              for (int s = 0; s < 3; ++s) { const v4u qw = *(const v4u*)(qp + c * 48 + 16 * s);
                  v4u qs; qs.x = cvtpk(bflo(qw.x) * CS, bfhi(qw.x) * CS); qs.y = cvtpk(bflo(qw.y) * CS, bfhi(qw.y) * CS); qs.z = cvtpk(bflo(qw.z) * CS, bfhi(qw.z) * CS); qs.w = cvtpk(bflo(qw.w) * CS, bfhi(qw.w) * CS);
                  qf[c][s] = __builtin_bit_cast(bf16x8, qs); } }
        f32x16 O[2][3];
#pragma unroll
        for (int c = 0; c < 2; ++c)
#pragma unroll
            for (int d = 0; d < 3; ++d)
#pragma unroll
                for (int r = 0; r < 16; ++r) O[c][d][r] = 0.f;
        float l[2] = {0.f, 0.f};
        f32x16 NEGR[2];
#pragma unroll
        for (int c = 0; c < 2; ++c)
#pragma unroll
            for (int r = 0; r < 16; ++r) NEGR[c][r] = 0.f;
        f32x16 S; bf16x8 pa[2], pb[2], kf[3], vf[6];
        pb[0] = (bf16x8){0, 0, 0, 0, 0, 0, 0, 0}; pb[1] = pb[0];
        for (int t = 0; t < NT; ++t) {
            asm volatile("s_waitcnt vmcnt(0)" ::: "memory"); __builtin_amdgcn_s_barrier(); asm volatile("" ::: "memory");
            if (t + 2 < NT) C_ISSUE(t + 2);
            const LAS unsigned char* cur = F.lds + (t & 3) * STAGE;
            const LAS unsigned char* prv = F.lds + ((t > 0 ? t - 1 : 0) & 3) * STAGE;
            const LAS unsigned char* nxt = F.lds + ((t + 1 < NT ? t + 1 : t) & 3) * STAGE;
            if (t == 0) C_QK0(S, cur);
            { const bool first = (t == 0);
            C_ITEM(S, 0, pa, pb, 1, prv, 1, cur, 0, cur, 0, 1);
            C_ITEM(S, 1, pb, pa, 0, cur, 0, cur, 0, cur, 1, 0); }
            { const bool first = false;
            C_ITEM(S, 0, pa, pb, 1, cur, 0, cur, 1, cur, 1, 1);
            C_ITEM(S, 1, pb, pa, 0, cur, 1, cur, 1, nxt, 0, 0); }
        }
        { const LAS unsigned char* lastb = F.lds + ((NT - 1) & 3) * STAGE;
#pragma unroll
          for (int s2 = 0; s2 < 2; ++s2)
#pragma unroll
              for (int d = 0; d < 3; ++d) { const LAS unsigned char* vp = lastb + voff + (32 + 16 * s2) * VST + d * 64; const s16x4 v0 = ds_tr16(vp), v1 = ds_tr16(vp + 4 * VST);
                  const bf16x8 vfl = (bf16x8){v0[0], v0[1], v0[2], v0[3], v1[0], v1[1], v1[2], v1[3]}; O[1][d] = __builtin_amdgcn_mfma_f32_32x32x16_bf16(vfl, pb[s2], O[1][d], 0, 0, 0); } }
        const float l0 = l[0] + __shfl_xor(l[0], 32), l1 = l[1] + __shfl_xor(l[1], 32);
        const float i0 = 1.0f / l0, i1 = lam / l1;
        float ss = 0.f;
#pragma unroll
        for (int d = 0; d < 3; ++d)
#pragma unroll
            for (int r = 0; r < 16; ++r) { const float o = O[0][d][r] * i0 - O[1][d][r] * i1; O[0][d][r] = o; ss += o * o; }
        ss += __shfl_xor(ss, 32);
        const float rs = rsqrtf(ss * (1.0f / 96.0f) + LN_EPS) * post;
        bf16* yp = Y + (size_t)tok * YLD + Y_C + h * 96 + 4 * hh;
#pragma unroll
        for (int d = 0; d < 3; ++d)
#pragma unroll
            for (int rg = 0; rg < 4; ++rg) { const f32x4 gv = *(const f32x4*)(ng + d * 32 + 8 * rg + 4 * hh);
                v2u o; o.x = pk2(O[0][d][4 * rg + 0] * rs * gv[0], O[0][d][4 * rg + 1] * rs * gv[1]); o.y = pk2(O[0][d][4 * rg + 2] * rs * gv[2], O[0][d][4 * rg + 3] * rs * gv[3]);
                *(v2u*)(yp + d * 32 + 8 * rg) = o; }
        asm volatile("s_waitcnt vmcnt(0)" ::: "memory"); __builtin_amdgcn_s_barrier(); asm volatile("" ::: "memory");
    }
#undef C_ISSUE
#undef C_RDV
#undef C_ITEM
#undef C_QK0
#undef C_FENCE
}

constexpr int AB_VST = 192, AB_VREG = 32 * AB_VST;
constexpr int L_RPB = 51200;

__device__ __forceinline__ void sm_block64(f32x16& t, float& m, float& l, f32x16 (&O)[2], bf16x8 (&pf)[2]) {
    float mx = fmaxf(t[0], t[1]);
#pragma unroll
    for (int r = 2; r < 16; ++r) mx = fmaxf(mx, t[r]);
    mx = fmaxf(mx, __shfl_xor(mx, 32));
    if (__any(mx > m)) {
        const float mn = fmaxf(m, mx), alpha = __builtin_amdgcn_exp2f(m - mn);
#pragma unroll
        for (int d = 0; d < 2; ++d)
#pragma unroll
            for (int r = 0; r < 16; ++r) O[d][r] *= alpha;
        l *= alpha; m = mn;
    }
#pragma unroll
    for (int r = 0; r < 16; ++r) { t[r] = __builtin_amdgcn_exp2f(t[r] - m); l += t[r]; }
#pragma unroll
    for (int s2 = 0; s2 < 2; ++s2) { v4u pw; pw.x = cvtpk(t[8 * s2 + 0], t[8 * s2 + 1]); pw.y = cvtpk(t[8 * s2 + 2], t[8 * s2 + 3]);
        pw.z = cvtpk(t[8 * s2 + 4], t[8 * s2 + 5]); pw.w = cvtpk(t[8 * s2 + 6], t[8 * s2 + 7]); pf[s2] = __builtin_bit_cast(bf16x8, pw); }
}
template <class TokOf, class MaskT>
__device__ __forceinline__ void attn_run_blocks(const bf16* H, const int kcol, const int vcol, const int nb, const TokOf tok_of, const MaskT mask,
                                                const bf16x8 (&qf)[4], LAS unsigned char* vl, const int lane, f32x16 (&O)[2], float& m, float& l) {
    const int n = lane & 31, hh = lane >> 5, krow = kperm(n), g = lane >> 4, i16 = lane & 15;
    const int vrd = (8 * (g >> 1) + (i16 >> 2)) * AB_VST + (16 * (g & 1) + 4 * (i16 & 3)) * 2;
    bf16x8 kf[4]; v4u vc[4];
    { const bf16* kp = H + (size_t)tok_of(0, krow) * INC + kcol + 8 * hh;
#pragma unroll
      for (int s = 0; s < 4; ++s) kf[s] = *(const bf16x8*)(kp + 16 * s);
#pragma unroll
      for (int i = 0; i < 4; ++i) vc[i] = *(const v4u*)(H + (size_t)tok_of(0, (lane >> 3) + 8 * i) * INC + vcol + (lane & 7) * 8); }
#pragma unroll
    for (int i = 0; i < 4; ++i) *(LAS v4u*)(vl + ((lane >> 3) + 8 * i) * AB_VST + (lane & 7) * 16) = vc[i];
    for (int j = 0; j < nb; ++j) {
        const int jn = (j + 1 < nb) ? j + 1 : j;
        bf16x8 kn[4];
        { const bf16* kp = H + (size_t)tok_of(jn, krow) * INC + kcol + 8 * hh;
#pragma unroll
          for (int s = 0; s < 4; ++s) kn[s] = *(const bf16x8*)(kp + 16 * s);
#pragma unroll
          for (int i = 0; i < 4; ++i) vc[i] = *(const v4u*)(H + (size_t)tok_of(jn, (lane >> 3) + 8 * i) * INC + vcol + (lane & 7) * 8); }
        f32x16 S;
#pragma unroll
        for (int r = 0; r < 16; ++r) S[r] = 0.f;
#pragma unroll
        for (int s = 0; s < 4; ++s) S = __builtin_amdgcn_mfma_f32_32x32x16_bf16(kf[s], qf[s], S, 0, 0, 0);
        mask(j, S);
        bf16x8 pf[2];
        sm_block64(S, m, l, O, pf);
        LDS_WAIT();
#pragma unroll
        for (int s2 = 0; s2 < 2; ++s2)
#pragma unroll
            for (int d = 0; d < 2; ++d) { const LAS unsigned char* vp = vl + vrd + 16 * s2 * AB_VST + d * 64;
                const s16x4 v0 = ds_tr16(vp), v1 = ds_tr16(vp + 4 * AB_VST);
                const bf16x8 vf = (bf16x8){v0[0], v0[1], v0[2], v0[3], v1[0], v1[1], v1[2], v1[3]};
                O[d] = __builtin_amdgcn_mfma_f32_32x32x16_bf16(vf, pf[s2], O[d], 0, 0, 0); }
        LDS_WAIT(); asm volatile("" ::: "memory");
#pragma unroll
        for (int i = 0; i < 4; ++i) *(LAS v4u*)(vl + ((lane >> 3) + 8 * i) * AB_VST + (lane & 7) * 16) = vc[i];
#pragma unroll
        for (int s = 0; s < 4; ++s) kf[s] = kn[s];
    }
    LDS_WAIT(); asm volatile("" ::: "memory");
}
__device__ __forceinline__ void attn_store64(bf16* yrow, const f32x16 (&O)[2], float l, int hh) {
    const float lt = l + __shfl_xor(l, 32), inv = 1.0f / lt;
#pragma unroll
    for (int d = 0; d < 2; ++d)
#pragma unroll
        for (int rg = 0; rg < 4; ++rg) { v2u o; o.x = pk2(O[d][4 * rg + 0] * inv, O[d][4 * rg + 1] * inv); o.y = pk2(O[d][4 * rg + 2] * inv, O[d][4 * rg + 3] * inv);
            *(v2u*)(yrow + d * 32 + 8 * rg + 4 * hh) = o; }
}

__device__ __forceinline__ void attnA_mfma(Frame& F, const float* rpb  ) {
    const bf16* H = (const bf16*)(F.ws + WS_H); bf16* Y = (bf16*)(F.ws + WS_Y);
    LAS float* T = (LAS float*)(F.lds + L_RPB);
    for (int i = F.tid; i < 4 * 17 * 64; i += 512) { const int h = i / (17 * 64), rem = i - h * 17 * 64, ro = rem >> 6, co = rem & 63;
        const int rr = ro - 1, cc = co - 16; T[i] = (rr >= 0 && rr < 15 && cc >= 0 && cc < 31) ? rpb[(h * 15 + rr) * 31 + cc] * 1.4426950408889634f : 0.f; }
    __syncthreads();
    const int lane = F.lane, n = lane & 31, hh = lane >> 5;
    LAS unsigned char* vl = F.lds + F.wave * AB_VREG;
    const int gw = F.bid * 8 + F.wave, NGW = F.G * 8;
    for (int item = gw; item < 4096; item += NGW) {
        const int cb = item & 3, rp = (item >> 2) & 31, h = (item >> 7) & 3, b = item >> 9;
        const int r = 2 * rp + (n >> 4), c = 16 * cb + (n & 15);
        const int r0 = min(max(r - 4, 0), 56), c0 = min(max(c - 8, 0), 48);
        const int cw = min(max(16 * cb - 8, 0), 32);
        const int kr_lo = min(max(2 * rp - 4, 0), 56), kr_hi = min(max(2 * rp + 1 - 4, 0), 56) + 7;
        const int tokq = b * SEQ + r * 64 + c;
        bf16x8 qf[4];
        { const bf16* qp = H + (size_t)tokq * INC + C_QA + h * 64 + 8 * hh;
#pragma unroll
          for (int s = 0; s < 4; ++s) qf[s] = *(const bf16x8*)(qp + 16 * s); }
        f32x16 O[2];
#pragma unroll
        for (int d = 0; d < 2; ++d)
#pragma unroll
            for (int rr = 0; rr < 16; ++rr) O[d][rr] = 0.f;
        float m = -1e30f, l = 0.f;
        const int tok0 = b * SEQ + kr_lo * 64 + cw;
        auto tok_of = [=](int j, int kk) { return tok0 + j * 64 + kk; };
        const int colb = cw - c0 + 8 * hh;
        const int tb0 = (h * 17 + (kr_lo - r + 8)) * 64 + (cw - c + 31) + 8 * hh;
        const int rb = kr_lo - r0;
        auto mask = [=](int j, f32x16& S) {
            const bool rowok = (unsigned)(rb + j) < 8u; const LAS float* tp = T + tb0 + j * 64;
#pragma unroll
            for (int rr = 0; rr < 16; ++rr) { const int e = (rr & 7) + 16 * (rr >> 3);
                const bool ok = rowok && ((unsigned)(colb + e) < 16u);
                S[rr] = ok ? (S[rr] * (0.125f * 1.4426950408889634f) + tp[e]) : -INFINITY; }
        };
        attn_run_blocks(H, C_KA + h * 64, C_VA + h * 64, kr_hi - kr_lo + 1, tok_of, mask, qf, vl, lane, O, m, l);
        attn_store64(Y + (size_t)tokq * YLD + Y_A + h * 64, O, l, hh);
    }
}
__device__ __forceinline__ void attnB_mfma(Frame& F) {
    const bf16* H = (const bf16*)(F.ws + WS_H); bf16* Y = (bf16*)(F.ws + WS_Y);
    const int lane = F.lane, n = lane & 31, hh = lane >> 5;
    LAS unsigned char* vl = F.lds + F.wave * AB_VREG;
    const int gw = F.bid * 8 + F.wave, NGW = F.G * 8;
    for (int item = gw; item < 2048; item += NGW) {
        const int mblk = item & 7, r = (item >> 3) & 15, hg = (item >> 7) & 1, b = item >> 8;
        const int sq = r + 16 * (mblk * 32 + n), tokq = b * SEQ + sq;
        f32x16 O[2];
#pragma unroll
        for (int d = 0; d < 2; ++d)
#pragma unroll
            for (int rr = 0; rr < 16; ++rr) O[d][rr] = 0.f;
        float m = -1e30f, l = 0.f;
#pragma unroll 1
        for (int g = 0; g < 3; ++g) {
            const int sh = 2 * g, dil = 1 << sh, head = 2 * g + hg, L = SEQ >> sh, a = 16 >> sh, cls = r & (dil - 1);
            const int pq0 = (r >> sh) + a * (mblk * 32), pq = pq0 + a * n;
            const int pks = pq0 - 64, nb = (31 * a + 129 + 31) >> 5;
            bf16x8 qf[4];
            { const bf16* qp = H + (size_t)tokq * INC + C_QB + head * 64 + 8 * hh;
#pragma unroll
              for (int s = 0; s < 4; ++s) qf[s] = *(const bf16x8*)(qp + 16 * s); }
            const int tokb = b * SEQ + cls;
            auto tok_of = [=](int j, int kk) { const int pk = min(max(pks + 32 * j + kk, 0), L - 1); return tokb + (pk << sh); };
            const int b1 = pks - pq + 64 + 8 * hh, b2 = pks + 8 * hh;
            auto mask = [=](int j, f32x16& S) {
#pragma unroll
                for (int rr = 0; rr < 16; ++rr) { const int e = (rr & 7) + 16 * (rr >> 3) + 32 * j;
                    const bool ok = ((unsigned)(b1 + e) <= 128u) && ((unsigned)(b2 + e) < (unsigned)L);
                    S[rr] = ok ? S[rr] * (0.125f * 1.4426950408889634f) : -INFINITY; }
            };
            attn_run_blocks(H, C_KB + head * 64, C_VB + head * 64, nb, tok_of, mask, qf, vl, lane, O, m, l);
        }
        attn_store64(Y + (size_t)tokq * YLD + Y_B + hg * 64, O, l, hh);
    }
}

__device__ __forceinline__ void p_ln_router(Frame& F, const Args& a, int layer, bool dry = false) {
    const float* PRE = (const float*)(F.ws + WS_HH); float* XF = dry ? (float*)(F.ws + WS_H) : a.out; unsigned* XB8 = dry ? (unsigned*)(F.ws + WS_H + 160 * MiB) : (unsigned*)(F.ws + WS_XB8);
    const float* g1 = a.in[10] + layer * 1024; const float* b1 = a.in[11] + layer * 1024; const float* br = a.in[13] + layer * 32;
    const bf16* WT = (const bf16*)(F.ws + WS_WRT) + (size_t)layer * 2 * 32 * 1024;
    int* TOPE = (int*)(F.ws + (dry ? WS_H + 200 * MiB : WS_TOPE)); float* TOPW = (float*)(F.ws + (dry ? WS_H + 201 * MiB : WS_TOPW)); int* RANK = (int*)(F.ws + (dry ? WS_H + 202 * MiB : WS_RANK));
    const int cnt_off = dry ? CW_CUR : CW_CNT; int* SRCp = (int*)(F.ws + (dry ? WS_H + 204 * MiB : WS_SRC));
    LAS int* hist = (LAS int*)(F.lds + L_HIST); LAS int* base = (LAS int*)(F.lds + L_BASE);
    const int lane = F.lane;
    for (int chunk = F.bid; chunk < NTOK / 128; chunk += F.G) {
        if (F.tid < 32) hist[F.tid] = 0;
        __syncthreads();
        const int tok0 = chunk * 128 + F.wave * 16;
        {   f32x4 gv[4], bv[4];
#pragma unroll
            for (int j = 0; j < 4; ++j) { gv[j] = *(const f32x4*)(g1 + 4 * lane + 256 * j); bv[j] = *(const f32x4*)(b1 + 4 * lane + 256 * j); }
#pragma unroll 1
            for (int q = 0; q < 4; ++q) {
                f32x4 v[4][4]; float s[4], s2[4];
#pragma unroll
                for (int t = 0; t < 4; ++t) { const f32x4* pr = (const f32x4*)(PRE + (size_t)(tok0 + 4 * q + t) * 1024) + lane;
#pragma unroll
                    for (int j = 0; j < 4; ++j) v[t][j] = pr[64 * j]; }
#pragma unroll
                for (int t = 0; t < 4; ++t) { s[t] = 0.f;
#pragma unroll
                    for (int j = 0; j < 4; ++j) s[t] += (v[t][j][0] + v[t][j][1]) + (v[t][j][2] + v[t][j][3]); }
#pragma unroll
                for (int o = 1; o < 64; o <<= 1) {
#pragma unroll
                    for (int t = 0; t < 4; ++t) s[t] += __shfl_xor(s[t], o); }
#pragma unroll
                for (int t = 0; t < 4; ++t) { const float mean = s[t] * (1.f / 1024.f); s2[t] = 0.f;
#pragma unroll
                    for (int j = 0; j < 4; ++j) { v[t][j] = v[t][j] - mean; s2[t] += (v[t][j][0] * v[t][j][0] + v[t][j][1] * v[t][j][1]) + (v[t][j][2] * v[t][j][2] + v[t][j][3] * v[t][j][3]); } }
#pragma unroll
                for (int o = 1; o < 64; o <<= 1) {
#pragma unroll
                    for (int t = 0; t < 4; ++t) s2[t] += __shfl_xor(s2[t], o); }
#pragma unroll
                for (int t = 0; t < 4; ++t) { const float rstd = rsqrtf(s2[t] * (1.f / 1024.f) + LN_EPS);
                    f32x4* xo = (f32x4*)(XF + (size_t)(tok0 + 4 * q + t) * 1024) + lane; unsigned* xb = XB8 + (size_t)(tok0 + 4 * q + t) * 256 + lane;
#pragma unroll
                    for (int j = 0; j < 4; ++j) { const f32x4 y = v[t][j] * rstd * gv[j] + bv[j]; xo[64 * j] = y; xb[64 * j] = pk4_fp8(y[0], y[1], y[2], y[3], 1.0f); } }
            }
        }
        VM_WAIT(); asm volatile("" ::: "memory");
        const int tk = lane & 15, kq = lane >> 4;
        f32x4 acc[2] = {(f32x4){0.f, 0.f, 0.f, 0.f}, (f32x4){0.f, 0.f, 0.f, 0.f}};
        {   const float* xf = XF + (size_t)(tok0 + tk) * 1024 + 8 * kq;
            const bf16* w0 = WT + (size_t)tk * 1024 + 8 * kq;
#pragma unroll 4
            for (int st = 0; st < 32; ++st) {
                const f32x4 x0 = *(const f32x4*)(xf + 32 * st), x1 = *(const f32x4*)(xf + 32 * st + 4);
                v4u xhw; xhw.x = pk2(x0[0], x0[1]); xhw.y = pk2(x0[2], x0[3]); xhw.z = pk2(x1[0], x1[1]); xhw.w = pk2(x1[2], x1[3]);
                v4u xlw; xlw.x = pk2(x0[0] - bflo(xhw.x), x0[1] - bfhi(xhw.x)); xlw.y = pk2(x0[2] - bflo(xhw.y), x0[3] - bfhi(xhw.y));
                xlw.z = pk2(x1[0] - bflo(xhw.z), x1[1] - bfhi(xhw.z)); xlw.w = pk2(x1[2] - bflo(xhw.w), x1[3] - bfhi(xhw.w));
                const bf16x8 xh = __builtin_bit_cast(bf16x8, xhw), xl = __builtin_bit_cast(bf16x8, xlw);
#pragma unroll
                for (int mb = 0; mb < 2; ++mb) { const bf16x8 wh = *(const bf16x8*)(w0 + (size_t)mb * 16 * 1024 + 32 * st), wl = *(const bf16x8*)(w0 + (size_t)(32 + mb * 16) * 1024 + 32 * st);
                    acc[mb] = __builtin_amdgcn_mfma_f32_16x16x32_bf16(wh, xh, acc[mb], 0, 0, 0);
                    acc[mb] = __builtin_amdgcn_mfma_f32_16x16x32_bf16(wh, xl, acc[mb], 0, 0, 0);
                    acc[mb] = __builtin_amdgcn_mfma_f32_16x16x32_bf16(wl, xh, acc[mb], 0, 0, 0); }
            }
        }
        float v8[8];
#pragma unroll
        for (int mb = 0; mb < 2; ++mb)
#pragma unroll
            for (int i = 0; i < 4; ++i) v8[mb * 4 + i] = acc[mb][i] + br[16 * mb + 4 * kq + i];
        int se[4]; float sv[4];
#pragma unroll
        for (int r = 0; r < 4; ++r) {
            float bvv = v8[0]; int bi = 4 * kq;
#pragma unroll
            for (int sl = 1; sl < 8; ++sl) { const int eid = 16 * (sl >> 2) + 4 * kq + (sl & 3); if (v8[sl] > bvv) { bvv = v8[sl]; bi = eid; } }
#pragma unroll
            for (int o = 16; o < 64; o <<= 1) { const float ov = __shfl_xor(bvv, o); const int oi = __shfl_xor(bi, o);
                if (ov > bvv || (ov == bvv && oi < bi)) { bvv = ov; bi = oi; } }
            se[r] = bi; sv[r] = bvv;
#pragma unroll
            for (int sl = 0; sl < 8; ++sl) { const int eid = 16 * (sl >> 2) + 4 * kq + (sl & 3); if (eid == bi) v8[sl] = -3.0e38f; }
        }
        const float p1 = __expf(sv[1] - sv[0]), p2 = __expf(sv[2] - sv[0]), p3 = __expf(sv[3] - sv[0]);
        const float inv = 1.0f / (1.0f + p1 + p2 + p3);
        int lr[4] = {0, 0, 0, 0};
        if (lane < 16) { const int tok = tok0 + tk;
            *(int4*)(TOPE + tok * 4) = make_int4(se[0], se[1], se[2], se[3]);
            *(f32x4*)(TOPW + tok * 4) = (f32x4){inv, p1 * inv, p2 * inv, p3 * inv};
#pragma unroll
            for (int k = 0; k < 4; ++k) lr[k] = __hip_atomic_fetch_add(&hist[se[k]], 1, __ATOMIC_RELAXED, __HIP_MEMORY_SCOPE_WORKGROUP); }
        __syncthreads();
        if (F.tid < 32) { const int c = hist[F.tid]; base[F.tid] = c ? (int)__hip_atomic_fetch_add(F.ctl + cnt_off + layer * 64 + F.tid, (unsigned)c, RLX_AGENT) : 0; }
        __syncthreads();
        if (lane < 16) { const int tok = tok0 + tk;
            const int r0 = base[se[0]] + lr[0], r1 = base[se[1]] + lr[1], r2 = base[se[2]] + lr[2], r3 = base[se[3]] + lr[3];
            *(int4*)(RANK + tok * 4) = make_int4(r0, r1, r2, r3);
            int* SRC = SRCp; SRC[se[0] * NTOK + r0] = tok; SRC[se[1] * NTOK + r1] = tok; SRC[se[2] * NTOK + r2] = tok; SRC[se[3] * NTOK + r3] = tok; }
        __syncthreads();
    }
}

__device__ __forceinline__ int moe_build(Frame& F, int layer) {
    LAS int* offT = (LAS int*)(F.lds + L_OFFT); LAS int* tile_e = (LAS int*)(F.lds + L_TILE);
    __syncthreads();
    if (F.tid < 64) {
        const int c = (F.lane < 32) ? (int)__hip_atomic_load(F.ctl + CW_CNT + layer * 64 + F.lane, RLX_AGENT) : 0;
        const int ntile = (c + 255) >> 8; int x = ntile;
#pragma unroll
        for (int d = 1; d < 32; d <<= 1) { const int v = __shfl_up(x, d); if (F.lane >= d) x += v; }
        if (F.lane < 32) { offT[F.lane] = x - ntile; ((LAS int*)(F.lds + L_CNT))[F.lane] = c; }
        if (F.lane == 31) offT[32] = x;
    }
    __syncthreads();
    int T = __builtin_amdgcn_readfirstlane(offT[32]); if (T > MAXT) T = MAXT;
    for (int mt = F.tid; mt < T; mt += 512) { int e = 0;
#pragma unroll 1
        for (int j = 1; j < 32; ++j) if (offT[j] <= mt) e = j;
        tile_e[mt] = e; }
    __syncthreads();
    return T;
}

__device__ __forceinline__ void p_combine_ln(Frame& F, const Args& a, int layer, bool dry = false) {
    const bool last_layer = (layer == DEPTH - 1) || dry;
    float* XF = a.out; float* XFo = dry ? (float*)(F.ws + WS_HH) : a.out; bf16* XB = (bf16*)(F.ws + (dry ? WS_M : WS_XB)); const bf16* YS = (const bf16*)(F.ws + WS_H);
    const int* TOPE = (const int*)(F.ws + WS_TOPE); const int* RANK = (const int*)(F.ws + WS_RANK); const float* TOPW = (const float*)(F.ws + WS_TOPW);
    const LAS int* offT = (const LAS int*)(F.lds + L_OFFT);
    const float* g2 = a.in[20] + layer * 1024; const float* b2 = a.in[21] + layer * 1024;
    const int gw = F.bid * 8 + F.wave, NGW = F.G * 8, lane = F.lane;
    f32x4 gv[4], bv[4];
#pragma unroll
    for (int j = 0; j < 4; ++j) { gv[j] = *(const f32x4*)(g2 + 4 * lane + 256 * j); bv[j] = *(const f32x4*)(b2 + 4 * lane + 256 * j); }
    for (int tp = gw; tp < NTOK / 2; tp += NGW) {
        f32x4 v[2][4]; v2u yw[2][4][4]; f32x4 tw[2];
#pragma unroll
        for (int u = 0; u < 2; ++u) { const int tok = tp * 2 + u;
            const int4 te = *(const int4*)(TOPE + tok * 4), rk = *(const int4*)(RANK + tok * 4); tw[u] = *(const f32x4*)(TOPW + tok * 4);
            const f32x4* xr = (const f32x4*)(XF + (size_t)tok * 1024) + lane;
#pragma unroll
            for (int j = 0; j < 4; ++j) v[u][j] = xr[64 * j];
            const int pk[4] = {offT[te.x] * 256 + rk.x, offT[te.y] * 256 + rk.y, offT[te.z] * 256 + rk.z, offT[te.w] * 256 + rk.w};
#pragma unroll
            for (int k = 0; k < 4; ++k) { const v2u* yr = (const v2u*)(YS + (size_t)pk[k] * 1024) + lane;
#pragma unroll
                for (int j = 0; j < 4; ++j) yw[u][k][j] = yr[64 * j]; } }
        float s[2], s2[2];
#pragma unroll
        for (int u = 0; u < 2; ++u) {
#pragma unroll
            for (int j = 0; j < 4; ++j) { v[u][j] = v[u][j] * DN_ALPHA;
#pragma unroll
                for (int k = 0; k < 4; ++k) { const v2u y = yw[u][k][j]; v[u][j] = v[u][j] + tw[u][k] * (f32x4){bflo(y.x), bfhi(y.x), bflo(y.y), bfhi(y.y)}; } }
            s[u] = 0.f;
#pragma unroll
            for (int j = 0; j < 4; ++j) s[u] += (v[u][j][0] + v[u][j][1]) + (v[u][j][2] + v[u][j][3]); }
#pragma unroll
        for (int o = 1; o < 64; o <<= 1) { s[0] += __shfl_xor(s[0], o); s[1] += __shfl_xor(s[1], o); }
#pragma unroll
        for (int u = 0; u < 2; ++u) { const float mean = s[u] * (1.f / 1024.f); s2[u] = 0.f;
#pragma unroll
            for (int j = 0; j < 4; ++j) { v[u][j] = v[u][j] - mean; s2[u] += (v[u][j][0] * v[u][j][0] + v[u][j][1] * v[u][j][1]) + (v[u][j][2] * v[u][j][2] + v[u][j][3] * v[u][j][3]); } }
#pragma unroll
        for (int o = 1; o < 64; o <<= 1) { s2[0] += __shfl_xor(s2[0], o); s2[1] += __shfl_xor(s2[1], o); }
#pragma unroll
        for (int u = 0; u < 2; ++u) { const int tok = tp * 2 + u; const float rstd = rsqrtf(s2[u] * (1.f / 1024.f) + LN_EPS);
            f32x4* xo = (f32x4*)(XFo + (size_t)tok * 1024) + lane; v2u* xb = (v2u*)(XB + (size_t)tok * 1024) + lane; unsigned* x8 = (unsigned*)(F.ws + (dry ? WS_M + 32 * MiB : WS_XB8)) + (size_t)tok * 256 + lane;
#pragma unroll
            for (int j = 0; j < 4; ++j) { const f32x4 y = v[u][j] * rstd * gv[j] + bv[j]; if (last_layer) xo[64 * j] = y; xb[64 * j] = (v2u){pk2(y[0], y[1]), pk2(y[2], y[3])}; x8[64 * j] = pk4_fp8(y[0], y[1], y[2], y[3], 1.0f); } }
    }
}

__device__ __forceinline__ const Args* fresh_args() { unsigned long long p = (unsigned long long)__builtin_amdgcn_kernarg_segment_ptr(); asm volatile("" : "+s"(p)); return (const Args*)(const __attribute__((address_space(4))) void*)p; }
constexpr int PH_PER_LAYER = 10, N_PHASES = 1 + DEPTH * PH_PER_LAYER;
__global__ void __launch_bounds__(512, 2) mk_fwd(Args args) {
    extern __shared__ __attribute__((aligned(16))) unsigned char lds[];
    Frame F;
    F.lds = (LAS unsigned char*)lds; F.tid = threadIdx.x; F.lane = F.tid & 63; F.wave = __builtin_amdgcn_readfirstlane(F.tid >> 6);
    F.G = gridDim.x; F.bid = blockIdx.x; F.ws = fresh_args()->ws; F.ctl = (unsigned*)(F.ws + WS_CTL);
    for (int u = F.tid; u < (LDS_BYTES - LDSCTL_OFF) / 4; u += 512) ((LAS unsigned*)(F.lds + LDSCTL_OFF))[u] = 0u;
    __syncthreads();
    const int lo = fresh_args()->ph_lo, hi = fresh_args()->ph_hi;
    XcdBarrier bar; bar.bar = F.ctl + CW_BAR; bar.x = 0; bar.st = nullptr;
    if (hi - lo > 1) bar = xcd_barrier_post(F.ctl + CW_BAR, (volatile LAS unsigned*)(F.lds + L_MISC) + 8);
#define IN(k) (lo <= (k) && (k) < hi)
#define REFRESH() do { F.tid = opaque_tid(); F.lane = F.tid & 63; F.wave = __builtin_amdgcn_readfirstlane(F.tid >> 6); asm volatile("" : "+s"(F.bid), "+s"(F.G)); } while (0)
#define SEAM(k) do { if ((k) + 1 < hi) xcd_barrier(bar); } while (0)

#ifndef NO_P0
    if (IN(0)) { _Pragma("unroll") for (int rep = 0; rep < REP_T; ++rep) p_prologue(F, *fresh_args()); SEAM(0); }
#endif

    for (int l = 0; l < DEPTH; ++l) {
        const int pb = 1 + l * PH_PER_LAYER;
#ifndef NO_P1
        if (IN(pb + 0)) {
            REFRESH();
            {
                pg8::DenseOrder S{(const char*)(F.ws + WS_XB), (const char*)(F.ws + WS_WIN) + (size_t)l * INC * 1024 * 2, (size_t)256 * 1024 * 2, (size_t)256 * 1024 * 2, 16, NTOK / 256, 12, F.G, F.bid};
                pg8::EpiInProj E{(bf16*)(F.ws + WS_H), fresh_args()->in[2] + l * 3072, (const f32x2*)(F.ws + WS_ROPE64), (const f32x2*)(F.ws + WS_ROPE48), 1.0f, (unsigned char*)(F.ws + WS_G8), F.lds};
                _Pragma("unroll") for (int rep = 0; rep < REP_G1; ++rep) pg8::gemm_phase<pg8::EpiInProj, pg8::DenseOrder, true, true>(F.lds, 1024, 1024, S, E);
            }
            {
                REFRESH();
                pg8::DenseOrder S{(const char*)(F.ws + WS_XB8), (const char*)(F.ws + WS_WIN8) + (size_t)l * 3072 * 1024, (size_t)256 * 1024, (size_t)256 * 1024, 8, NTOK / 256, 12, F.G, F.bid, 12};
                pg8::EpiInProj E{(bf16*)(F.ws + WS_H), fresh_args()->in[2] + l * 3072, (const f32x2*)(F.ws + WS_ROPE64), (const f32x2*)(F.ws + WS_ROPE48), 1.0f / 32.0f, (unsigned char*)(F.ws + WS_G8), F.lds};
                _Pragma("unroll") for (int rep = 0; rep < REP_G1; ++rep) pg8::gemm_phase<pg8::EpiInProj, pg8::DenseOrder, true, true, true>(F.lds, 1024, 1024, S, E);
            }
            if (pb + 2 < hi) xcd_barrier(bar);
        }
#endif
#ifndef NO_P1B
#endif
        if (IN(pb + 2)) {
            REFRESH();
#ifndef NO_PC
            _Pragma("unroll") for (int rep = 0; rep < REP_C; ++rep) attnC_pipe(F, fresh_args()->in[8] + l * 4 * 48, fresh_args()->in[9] + l * 96, fresh_args()->lam_init[l]);
#endif
#ifndef NO_PA
            REFRESH();
            _Pragma("unroll") for (int rep = 0; rep < REP_AB; ++rep) attnA_mfma(F, fresh_args()->in[7] + l * 4 * 15 * 31);
#endif
#ifndef NO_PB
            REFRESH();
            _Pragma("unroll") for (int rep = 0; rep < REP_AB; ++rep) attnB_mfma(F);
#endif
            SEAM(pb + 2);
        }
#ifndef NO_P3
        if (IN(pb + 3)) {
            REFRESH();
            pg8::ProjOrder S{(const char*)(F.ws + WS_Y), (const char*)(F.ws + WS_WPROJ) + (size_t)l * 1024 * WPK * 2, NTOK / 256, 4, F.G, F.bid};
            pg8::EpiProj E{(const unsigned char*)(F.ws + WS_G8), (bf16*)(F.ws + WS_M)};
            _Pragma("unroll") for (int rep = 0; rep < REP_G3; ++rep) pg8::gemm_phase<pg8::EpiProj, pg8::ProjOrder, true, true>(F.lds, YLD, WPK, S, E);
            SEAM(pb + 3);
        }
#endif
#ifndef NO_P4
        if (IN(pb + 4)) {
            REFRESH();
            pg8::DenseOrder S{(const char*)(F.ws + WS_M), (const char*)(F.ws + WS_WOUT) + (size_t)l * 1024 * 1024 * 2, (size_t)256 * 1024 * 2, (size_t)256 * 1024 * 2, 16, NTOK / 256, 4, F.G, F.bid};
            pg8::EpiOut E{l == 0 ? fresh_args()->in[0] : (const float*)nullptr, (const bf16*)(F.ws + WS_XB), (float*)(F.ws + WS_HH)};
            _Pragma("unroll") for (int rep = 0; rep < REP_G4; ++rep) pg8::gemm_phase<pg8::EpiOut, pg8::DenseOrder, true, true>(F.lds, 1024, 1024, S, E);
            SEAM(pb + 4);
        }
#endif
#ifndef NO_P5
        if (IN(pb + 5)) { REFRESH(); if (DRY_P5) p_ln_router(F, *fresh_args(), l, true); p_ln_router(F, *fresh_args(), l); if (pb + 7 < hi) xcd_barrier(bar); }
#endif
#ifndef NO_P5B
#endif
#ifndef NO_P6
        if (IN(pb + 7)) {
            REFRESH(); const int T = moe_build(F, l);
            pg8::MoeOrder S{(const char*)(F.ws + WS_XB8), (const char*)(F.ws + WS_WGU) + (size_t)l * NEXP * 2048 * 1024, (size_t)2048 * 1024, (size_t)256 * 1024, (size_t)256 * 1024, 8,
                            (const LAS int*)(F.lds + L_TILE), (const LAS int*)(F.lds + L_OFFT), (const LAS int*)(F.lds + L_CNT), (const int*)(F.ws + WS_SRC), T, 8, F.G, F.bid};
            pg8::EpiSwiglu E{(unsigned char*)(F.ws + WS_HH), fresh_args()->in[15] + (size_t)l * NEXP * 1024, fresh_args()->in[17] + (size_t)l * NEXP * 1024, 1.0f / 32.0f, F.lds};
            _Pragma("unroll") for (int rep = 0; rep < REP_G6; ++rep) pg8::gemm_phase_gather<pg8::EpiSwiglu, pg8::MoeOrder, true>(F.lds, (const char*)(F.ws + WS_XB8), 1024, 1024, S, E);
            SEAM(pb + 7);
        }
#endif
#ifndef NO_P7
        if (IN(pb + 8)) {
            REFRESH(); const int T = moe_build(F, l);
            pg8::MoeOrder S{(const char*)(F.ws + WS_HH), (const char*)(F.ws + WS_WDN) + (size_t)l * NEXP * 1024 * 1024, (size_t)1024 * 1024, (size_t)256 * 1024, (size_t)256 * 1024, 8,
                            (const LAS int*)(F.lds + L_TILE), (const LAS int*)(F.lds + L_OFFT), (const LAS int*)(F.lds + L_CNT), (const int*)(F.ws + WS_SRC), T, 4, F.G, F.bid};
            pg8::EpiDown E{(bf16*)(F.ws + WS_H), fresh_args()->in[19] + (size_t)l * NEXP * 1024, 1.0f / 256.0f, F.lds};
            _Pragma("unroll") for (int rep = 0; rep < REP_G7; ++rep) pg8::gemm_phase<pg8::EpiDown, pg8::MoeOrder, true, true, true>(F.lds, 1024, 1024, S, E);
            SEAM(pb + 8);
        }
#endif
#ifndef NO_P8
        if (IN(pb + 9)) { REFRESH(); (void)moe_build(F, l); if (DRY_P8) p_combine_ln(F, *fresh_args(), l, true); p_combine_ln(F, *fresh_args(), l); SEAM(pb + 9); }
#endif
    }
#undef IN
#undef SEAM
}

extern "C" void kernel_launch(void* const* d_in, const int* in_sizes, int n_in, void* d_out, int out_size, void* d_ws, size_t ws_size, hipStream_t stream) {
    static int grid = 0;
    if (grid == 0) {
        if (n_in != 22 || in_sizes[0] != NTOK * D || out_size != NTOK * D || ws_size < WS_END) {
            fprintf(stderr, "kernel_launch: unexpected shapes (n_in %d, in0 %d, out %d, ws %zu); nothing launched\n", n_in, n_in > 0 ? in_sizes[0] : -1, out_size, ws_size); grid = -1; return; }
        int dev = 0, cus = 0, per_cu = 0;
        if (hipGetDevice(&dev) != hipSuccess || hipDeviceGetAttribute(&cus, hipDeviceAttributeMultiprocessorCount, dev) != hipSuccess) { grid = -1; return; }
        if (hipFuncSetAttribute((const void*)mk_fwd, hipFuncAttributeMaxDynamicSharedMemorySize, LDS_BYTES) != hipSuccess) { fprintf(stderr, "kernel_launch: hipFuncSetAttribute failed\n"); grid = -1; return; }
        if (hipOccupancyMaxActiveBlocksPerMultiprocessor(&per_cu, (const void*)mk_fwd, 512, LDS_BYTES) != hipSuccess || per_cu < 1)
            fprintf(stderr, "kernel_launch: note: occupancy query reports %d workgroups per CU\n", per_cu);
        (void)hipGetLastError();
        grid = cus;
    }
    if (grid < 0) return;
    if (hipMemsetAsync((char*)d_ws + WS_CTL, 0, CTL_ZERO_BYTES, stream) != hipSuccess) { fprintf(stderr, "kernel_launch: memset failed\n"); return; }
    Args a{};
    for (int i = 0; i < 22; ++i) a.in[i] = (const float*)d_in[i];
    a.out = (float*)d_out; a.ws = (unsigned char*)d_ws;
    for (int l = 0; l < DEPTH; ++l) a.lam_init[l] = (float)(0.8 - 0.6 * exp(-0.3 * (double)l));
#if MK_ONE_LAUNCH
    a.ph_lo = 0; a.ph_hi = N_PHASES;
    hipLaunchKernelGGL(mk_fwd, dim3(grid), dim3(512), LDS_BYTES, stream, a);
#else
    for (int p = 0; p < N_PHASES; ++p) {
        a.ph_lo = p; a.ph_hi = p + 1;
        hipLaunchKernelGGL(mk_fwd, dim3(grid), dim3(512), LDS_BYTES, stream, a);
    }
#endif
    const hipError_t le = hipPeekAtLastError();
    if (le != hipSuccess) fprintf(stderr, "kernel_launch: launch failed: %s\n", hipGetErrorName(le));
}
```

```cpp
#include <hip/hip_runtime.h>
#include <cstdio>
#include <cstdint>
#include <cmath>

#ifndef REP_AB
#define REP_AB 1
#endif
#ifndef REP_C
#define REP_C 1
#endif
#ifndef REP_G
#define REP_G 1
#endif
#ifndef REP_G1
#define REP_G1 REP_G
#endif
#ifndef REP_G3
#define REP_G3 REP_G
#endif
#ifndef REP_G4
#define REP_G4 REP_G
#endif
#ifndef REP_G6
#define REP_G6 REP_G
#endif
#ifndef REP_G7
#define REP_G7 REP_G
#endif
#ifndef REP_T
#define REP_T 1
#endif
#ifndef DRY_P5
#define DRY_P5 0
#endif
#ifndef DRY_P8
#define DRY_P8 0
#endif
#ifndef C_ANTIPHASE
#define C_ANTIPHASE 0
#endif
#ifndef MK_ONE_LAUNCH
#define MK_ONE_LAUNCH 1
#endif

#define GAS __attribute__((address_space(1)))
#define LAS __attribute__((address_space(3)))
typedef unsigned short bf16;
typedef unsigned v4u __attribute__((ext_vector_type(4)));
typedef unsigned v2u __attribute__((ext_vector_type(2)));
typedef float f32x4 __attribute__((ext_vector_type(4)));
typedef float f32x2 __attribute__((ext_vector_type(2)));
typedef short bf16x8 __attribute__((ext_vector_type(8)));

constexpr int NTOK = 32768, SEQ = 4096, D = 1024, DEPTH = 4, INC = 6144, NEXP = 32, TOPK = 4;
constexpr int C_QA = 0, C_KA = 256, C_VA = 512, C_QB = 768, C_KB = 1152, C_VB = 1536, C_QC = 1920, C_KC = 2304, C_VC = 2688, C_GP = 3072;
constexpr int YLD = 768, Y_A = 0, Y_B = 256, Y_C = 384;
constexpr int WPK = 896;
constexpr int MAXT = 544;
constexpr float LN_EPS = 1e-5f;
constexpr float DN_ALPHA = 1.681792830507429f;

constexpr size_t MiB = 1u << 20;
constexpr size_t WS_CTL = 0, CTL_ZERO_BYTES = 1 * MiB;
constexpr size_t WS_ROPE64 = 1 * MiB;
constexpr size_t WS_ROPE48 = 2 * MiB;
constexpr size_t WS_TOPE = 3 * MiB;
constexpr size_t WS_TOPW = 3 * MiB + 512 * 1024;
constexpr size_t WS_POS = 4 * MiB;
constexpr size_t WS_WIN = 8 * MiB;
constexpr size_t WS_WPROJ = 56 * MiB;
constexpr size_t WS_WOUT = 64 * MiB;
constexpr size_t WS_WGU = 72 * MiB;
constexpr size_t WS_WDN = 584 * MiB;
constexpr size_t WS_XB = 840 * MiB;
constexpr size_t WS_Y = 904 * MiB;
constexpr size_t WS_M = 952 * MiB;
constexpr size_t WS_H = 1016 * MiB;
constexpr size_t WS_HH = 1400 * MiB;
constexpr size_t WS_WRT = 5 * MiB;
constexpr size_t WS_RANK = 6 * MiB;
constexpr size_t WS_SRC = 1672 * MiB;
constexpr size_t WS_XB8 = 1676 * MiB;
constexpr size_t WS_WIN8 = 1708 * MiB;
constexpr size_t WS_G8 = 1720 * MiB;
constexpr size_t WS_END = 1816 * MiB;
constexpr int CW_BAR = 4096;
constexpr int CW_CNT = 8192;
constexpr int CW_CUR = 8192 + 4 * 64;

constexpr int RING_BYTES = 131072;
constexpr int LDSCTL_OFF = RING_BYTES;
constexpr int L_MISC = LDSCTL_OFF;
constexpr int L_OFFT = LDSCTL_OFF + 256;
constexpr int L_HIST = LDSCTL_OFF + 512;
constexpr int L_BASE = LDSCTL_OFF + 768;
constexpr int L_CNT = LDSCTL_OFF + 896;
constexpr int L_TILE = LDSCTL_OFF + 1024;
constexpr int L_PPOS = LDSCTL_OFF + 4096;
constexpr int L_PTOK = LDSCTL_OFF + 6144;
constexpr int LDS_BYTES = 147456;
static_assert(L_PTOK + 2048 <= LDS_BYTES, "LDS map");

#define RLX_AGENT __ATOMIC_RELAXED, __HIP_MEMORY_SCOPE_AGENT
#define LDS_WAIT() asm volatile("s_waitcnt lgkmcnt(0)" ::: "memory")
#define VM_WAIT() asm volatile("s_waitcnt vmcnt(0)" ::: "memory")

__device__ __forceinline__ float bf2f(unsigned short b) { return __uint_as_float(((unsigned)b) << 16); }
__device__ __forceinline__ float bflo(unsigned u) { return __uint_as_float(u << 16); }
__device__ __forceinline__ float bfhi(unsigned u) { return __uint_as_float(u & 0xffff0000u); }
__device__ __forceinline__ unsigned f2bf(float f) { unsigned u = __builtin_bit_cast(unsigned, f); return (u + 0x7fffu + ((u >> 16) & 1u)) >> 16; }
__device__ __forceinline__ unsigned pk2(float lo, float hi) { return f2bf(lo) | (f2bf(hi) << 16); }
__device__ __forceinline__ float wave_sum(float v) {
#pragma unroll
    for (int o = 1; o < 64; o <<= 1) v += __shfl_xor(v, o);
    return v;
}
__device__ __forceinline__ int opaque_tid() { int t; asm volatile("v_mov_b32 %0, %1" : "=v"(t) : "v"(threadIdx.x)); return t; }
__device__ __forceinline__ unsigned pk4_fp8(float a, float b, float c, float d, float sc) {
    a = fminf(fmaxf(a * sc, -448.f), 448.f); b = fminf(fmaxf(b * sc, -448.f), 448.f); c = fminf(fmaxf(c * sc, -448.f), 448.f); d = fminf(fmaxf(d * sc, -448.f), 448.f);
    int p = __builtin_amdgcn_cvt_pk_fp8_f32(a, b, 0, false); p = __builtin_amdgcn_cvt_pk_fp8_f32(c, d, p, true); return (unsigned)p; }
__device__ __forceinline__ float fast_sigmoid(float x) { return __builtin_amdgcn_rcpf(1.0f + __builtin_amdgcn_exp2f(-1.4426950408889634f * x)); }

namespace pg8 {
#define PG8_LAS __attribute__((address_space(3)))
typedef unsigned short bf16_t;
typedef unsigned u32x4 __attribute__((ext_vector_type(4)));
constexpr int BM = 256, BK = 64, HALF = 128, HTB = HALF * BK * 2, STAGE_BYTES = 8 * HTB, NXCD = 8, WGM = 8;

__host__ __device__ __forceinline__ int lds_byte(int r, int c) { const int st = (r >> 4) * 2 + (c >> 5), rr = r & 15, cc = c & 31, ob = rr * 64 + cc * 2; return st * 1024 + (ob ^ (((ob >> 9) & 1) << 5)); }
__host__ __device__ __forceinline__ void stage_rc(int b, int& R, int& C) { const int st = b / 1024, sb = b % 1024, swz = sb ^ (((sb >> 9) & 1) << 5); R = (st >> 1) * 16 + swz / 64; C = (st & 1) * 32 + (swz % 64) / 2; }
__host__ __device__ __forceinline__ int perm32(int rho) { const int n = rho >> 4, i = rho & 15; return 8 * (i >> 2) + 4 * n + (i & 3); }

struct Unit { const char* A; const char* B; int nt; int pm, pn, aux; int bs; };

constexpr int L_BIAS_OFF = 139264;
__device__ __forceinline__ void glds16_u(const void* gsrc, unsigned lds_dst) { unsigned keep;
    asm volatile("s_mov_b32 %0, m0\n\ts_mov_b32 m0, %2\n\ts_nop 0\n\tglobal_load_lds_dwordx4 %1, off\n\ts_mov_b32 m0, %0" : "=&s"(keep) : "v"(gsrc), "s"(lds_dst) : "memory"); }
__device__ __forceinline__ void tile_of(int L, int nM, int nN, int& pm, int& pn) {
    const int nwg = nM * nN;
    int wgid = L; { const int q = nwg / NXCD, r = nwg % NXCD, xcd = wgid % NXCD, off = wgid / NXCD; wgid = (xcd < r ? xcd * (q + 1) : r * (q + 1) + (xcd - r) * q) + off; }
    const int nig = WGM * nN, gid = wgid / nig, fm = gid * WGM, gsz = (nM - fm) < WGM ? (nM - fm) : WGM;
    pm = fm + ((wgid % nig) % gsz); pn = (wgid % nig) / gsz;
}

__device__ __forceinline__ unsigned cvt_pk_bf16(float lo, float hi) { unsigned r; asm volatile("v_cvt_pk_bf16_f32 %0, %1, %2" : "=v"(r) : "v"(lo), "v"(hi)); return r; }
typedef int v8i32 __attribute__((ext_vector_type(8)));
typedef short s16x16 __attribute__((ext_vector_type(16)));
typedef int v4i32 __attribute__((ext_vector_type(4)));
__device__ __forceinline__ v8i32 cat8(bf16x8 lo, bf16x8 hi) { const v4i32 a = __builtin_bit_cast(v4i32, lo), b = __builtin_bit_cast(v4i32, hi); return __builtin_shufflevector(a, b, 0, 1, 2, 3, 4, 5, 6, 7); }

template <class Epi, class Sched, bool ALIGN_EPI, bool SP2, bool FP8 = false>
__device__ __forceinline__ void gemm_phase(PG8_LAS unsigned char* lds, const int lda, const int ldb, const Sched& S, const Epi& E, const int sclW = 0x7f7f7f7f, const int sclX = 0x7f7f7f7f) {
    constexpr int EB = FP8 ? 1 : 2;
    const int tid = opaque_tid(), wid = __builtin_amdgcn_readfirstlane(tid >> 6), lane = tid & 63, wr = wid >> 2, wc = wid & 3, fr = lane & 15, fq = lane >> 4;
    unsigned voffA[2], voffB[2];
#pragma unroll
    for (int i = 0; i < 2; ++i) { int R, C; stage_rc(tid * 16 + i * 8192, R, C); const int Rb = Epi::PERM ? ((R & ~31) + perm32(R & 31)) : R;
        voffA[i] = (unsigned)(R * lda * EB + C * 2); voffB[i] = (unsigned)(Rb * ldb * EB + C * 2); }
    const size_t kstep = (size_t)(BK * 2);
    const size_t hA = (size_t)HALF * lda * EB, hB = (size_t)HALF * ldb * EB;
    const unsigned ldsw = (unsigned)wid * 1024u;
    const int fcol = FP8 ? (32 * (fq >> 1) + 16 * (fq & 1)) : fq * 8;
    const int aoff = lds_byte(wr * 64 + fr, fcol), boff = lds_byte(wc * 32 + fr, fcol);
#define PG8_SA(b, h) (((b) * 2 + (h)) * HTB)
#define PG8_SB(b, h) ((4 + (b) * 2 + (h)) * HTB)
#define PG8_STAGE(bufoff, gbase, voff) do { _Pragma("unroll") for (int _i = 0; _i < 2; ++_i) \
        __builtin_amdgcn_global_load_lds((const unsigned*)((const char*)(gbase) + (voff)[_i]), (PG8_LAS unsigned*)(lds + (bufoff) + ldsw + _i * 8192), 16, 0, 0); } while (0)
#define PG8_LDA(dst, b, h) do { if constexpr (FP8) { _Pragma("unroll") for (int m = 0; m < 4; ++m) dst##8[m] = cat8(*(const PG8_LAS bf16x8*)(lds + PG8_SA(b, h) + aoff + m * 2048), *(const PG8_LAS bf16x8*)(lds + PG8_SA(b, h) + aoff + m * 2048 + 16)); } else { \
        _Pragma("unroll") for (int m = 0; m < 4; ++m) _Pragma("unroll") for (int k = 0; k < 2; ++k) dst[m][k] = *(const PG8_LAS bf16x8*)(lds + PG8_SA(b, h) + aoff + m * 2048 + k * 1024); } } while (0)
#define PG8_LDB(dst, b, h) do { if constexpr (FP8) { _Pragma("unroll") for (int n = 0; n < 2; ++n) dst##8[n] = cat8(*(const PG8_LAS bf16x8*)(lds + PG8_SB(b, h) + boff + n * 2048), *(const PG8_LAS bf16x8*)(lds + PG8_SB(b, h) + boff + n * 2048 + 16)); } else { \
        _Pragma("unroll") for (int n = 0; n < 2; ++n) _Pragma("unroll") for (int k = 0; k < 2; ++k) dst[n][k] = *(const PG8_LAS bf16x8*)(lds + PG8_SB(b, h) + boff + n * 2048 + k * 1024); } } while (0)
#define PG8_MMA(ai, bj, At, Bt) do { __builtin_amdgcn_s_setprio(1); if constexpr (FP8) { _Pragma("unroll") for (int m = 0; m < 4; ++m) _Pragma("unroll") for (int n = 0; n < 2; ++n) \
        asm volatile("v_mfma_f32_16x16x128_f8f6f4 %0, %1, %2, %0" : "+v"(acc[ai][bj][m][n]) : "v"(Bt##8[n]), "v"(At##8[m])); } else { \
        _Pragma("unroll") for (int m = 0; m < 4; ++m) _Pragma("unroll") for (int n = 0; n < 2; ++n) _Pragma("unroll") for (int k = 0; k < 2; ++k) \
        acc[ai][bj][m][n] = __builtin_amdgcn_mfma_f32_16x16x32_bf16(Bt[n][k], At[m][k], acc[ai][bj][m][n], 0, 0, 0); } __builtin_amdgcn_s_setprio(0); } while (0)
#define PG8_WAIT_V(n) asm volatile("s_waitcnt vmcnt(" #n ")" ::: "memory")
#define PG8_WAIT_L(n) asm volatile("s_waitcnt lgkmcnt(" #n ")" ::: "memory")
#define PG8_BAR __builtin_amdgcn_s_barrier()
#define PG8_SCHED __builtin_amdgcn_sched_barrier(0)
    Unit cur, nxt; int ui = 0;
    if (!S.next(0, cur)) return;
    f32x4 acc[2][2][4][2];
#pragma unroll
    for (int a = 0; a < 2; ++a)
#pragma unroll
        for (int b = 0; b < 2; ++b)
#pragma unroll
            for (int m = 0; m < 4; ++m)
#pragma unroll
                for (int n = 0; n < 2; ++n) acc[a][b][m][n] = (f32x4){0.f, 0.f, 0.f, 0.f};
    bf16x8 At[4][2], B0[2][2], B1[2][2]; v8i32 At8[4], B08[2], B18[2];
    const char* cA = cur.A; const char* cB = cur.B;
    if constexpr (Epi::BIAS_DMA) { if (wid == 0) E.bias_dma(cur, 0, lane, lds); }
    if constexpr (SP2) {
        PG8_STAGE(PG8_SB(0, 0), cB, voffB); PG8_STAGE(PG8_SB(0, 1), cB + hB, voffB); PG8_STAGE(PG8_SA(0, 0), cA, voffA); PG8_STAGE(PG8_SA(0, 1), cA + hA, voffA);
        if (wr == 1) PG8_BAR;
        PG8_WAIT_V(2); PG8_BAR;
        PG8_STAGE(PG8_SB(1, 0), cB + kstep, voffB); PG8_STAGE(PG8_SA(1, 0), cA + kstep, voffA); PG8_STAGE(PG8_SB(1, 1), cB + hB + kstep, voffB);
        PG8_WAIT_V(6); PG8_BAR;
    } else {
        PG8_STAGE(PG8_SB(0, 0), cB, voffB); PG8_STAGE(PG8_SA(0, 0), cA, voffA); PG8_STAGE(PG8_SB(0, 1), cB + hB, voffB); PG8_STAGE(PG8_SA(0, 1), cA + hA, voffA);
        if (wr == 1) PG8_BAR;
        PG8_WAIT_V(4); PG8_BAR;
        PG8_STAGE(PG8_SB(1, 0), cB + kstep, voffB); PG8_STAGE(PG8_SA(1, 0), cA + kstep, voffA); PG8_STAGE(PG8_SB(1, 1), cB + hB + kstep, voffB);
        PG8_WAIT_V(6); PG8_BAR;
    }
    for (;;) {
        const bool has_next = S.next(ui + 1, nxt);
        if constexpr (Epi::BIAS_DMA) { if (has_next && wid == 0) E.bias_dma(nxt, (ui + 1) % 3, lane, lds); }
        const char* nA = has_next ? nxt.A : cA; const char* nB = has_next ? nxt.B : cB;
        const int nt = cur.nt;
        for (int t = 0; t < nt; t += 2) {
            const bool last = (t == nt - 2);
            const char* a1 = cA + (size_t)(t + 1) * kstep;
            const char* a2 = last ? nA : cA + (size_t)(t + 2) * kstep; const char* b2 = last ? nB : cB + (size_t)(t + 2) * kstep;
            const char* a3 = a2 + kstep; const char* b3 = b2 + kstep;
            if constexpr (SP2) {
            PG8_LDB(B0, 0, 0); PG8_LDB(B1, 0, 1); PG8_SCHED; PG8_LDA(At, 0, 0); PG8_STAGE(PG8_SA(1, 1), a1 + hA, voffA);
            PG8_WAIT_V(8); PG8_WAIT_L(0); PG8_BAR; PG8_MMA(0, 0, At, B0); PG8_MMA(0, 1, At, B1); PG8_BAR; PG8_SCHED;
            PG8_LDA(At, 0, 1); PG8_STAGE(PG8_SB(0, 0), b2, voffB); PG8_STAGE(PG8_SB(0, 1), b2 + hB, voffB); PG8_STAGE(PG8_SA(0, 0), a2, voffA);
            PG8_WAIT_V(8); PG8_WAIT_L(0); PG8_BAR; PG8_MMA(1, 0, At, B0); PG8_MMA(1, 1, At, B1); PG8_BAR; PG8_SCHED;
            PG8_LDB(B0, 1, 0); PG8_LDB(B1, 1, 1); PG8_SCHED; PG8_LDA(At, 1, 0); PG8_STAGE(PG8_SA(0, 1), a2 + hA, voffA);
            PG8_WAIT_V(8); PG8_WAIT_L(0); PG8_BAR; PG8_MMA(0, 0, At, B0); PG8_MMA(0, 1, At, B1); PG8_BAR; PG8_SCHED;
            PG8_LDA(At, 1, 1); PG8_STAGE(PG8_SB(1, 0), b3, voffB); PG8_STAGE(PG8_SB(1, 1), b3 + hB, voffB); PG8_STAGE(PG8_SA(1, 0), a3, voffA);
            PG8_WAIT_V(8); PG8_WAIT_L(0); PG8_BAR; PG8_MMA(1, 0, At, B0); PG8_MMA(1, 1, At, B1); PG8_BAR; PG8_SCHED;
            } else {
            PG8_LDB(B0, 0, 0); PG8_SCHED; PG8_LDA(At, 0, 0); PG8_STAGE(PG8_SA(1, 1), a1 + hA, voffA);
            PG8_WAIT_L(8); PG8_BAR; PG8_WAIT_L(0); PG8_MMA(0, 0, At, B0); PG8_BAR; PG8_SCHED;
            PG8_LDB(B1, 0, 1); PG8_STAGE(PG8_SB(0, 0), b2, voffB);
            PG8_BAR; PG8_WAIT_L(0); PG8_MMA(0, 1, At, B1); PG8_BAR;
            PG8_LDA(At, 0, 1); PG8_STAGE(PG8_SA(0, 0), a2, voffA);
            PG8_BAR; PG8_WAIT_L(0); PG8_MMA(1, 0, At, B0); PG8_BAR; PG8_SCHED;
            PG8_STAGE(PG8_SB(0, 1), b2 + hB, voffB);
            PG8_WAIT_V(6); PG8_BAR; PG8_MMA(1, 1, At, B1); PG8_BAR;
            PG8_LDB(B0, 1, 0); PG8_SCHED; PG8_LDA(At, 1, 0); PG8_STAGE(PG8_SA(0, 1), a2 + hA, voffA);
            PG8_WAIT_L(8); PG8_BAR; PG8_WAIT_L(0); PG8_MMA(0, 0, At, B0); PG8_BAR; PG8_SCHED;
            PG8_LDB(B1, 1, 1); PG8_STAGE(PG8_SB(1, 0), b3, voffB);
            PG8_BAR; PG8_WAIT_L(0); PG8_MMA(0, 1, At, B1); PG8_BAR;
            PG8_LDA(At, 1, 1); PG8_STAGE(PG8_SA(1, 0), a3, voffA);
            PG8_BAR; PG8_WAIT_L(0); PG8_MMA(1, 0, At, B0); PG8_BAR; PG8_SCHED;
            PG8_STAGE(PG8_SB(1, 1), b3 + hB, voffB);
            PG8_WAIT_V(6); PG8_BAR; PG8_MMA(1, 1, At, B1); PG8_BAR;
            }
        }
        if constexpr (ALIGN_EPI) { if (wr == 0) PG8_BAR; }
        if constexpr (FP8) asm volatile("s_nop 15\n\ts_nop 15\n\ts_nop 15" ::: "memory");
        cur.bs = ui % 3;
        E(acc, cur, wr, wc, fr, fq);
        if (!has_next) break;
        if (!(Epi::KEEP && cur.aux != 2)) {
#pragma unroll
        for (int a = 0; a < 2; ++a)
#pragma unroll
            for (int b = 0; b < 2; ++b)
#pragma unroll
                for (int m = 0; m < 4; ++m)
#pragma unroll
                    for (int n = 0; n < 2; ++n) acc[a][b][m][n] = (f32x4){0.f, 0.f, 0.f, 0.f};
        }
        cur = nxt; cA = nA; cB = nB; ++ui;
        if constexpr (ALIGN_EPI) { if (wr == 1) PG8_BAR; }
    }
    PG8_WAIT_V(0);
    if constexpr (!ALIGN_EPI) { if (wr == 0) PG8_BAR; }
    PG8_BAR;
#undef PG8_SA
#undef PG8_SB
#undef PG8_STAGE
#undef PG8_LDA
#undef PG8_LDB
#undef PG8_MMA
#undef PG8_WAIT_V
#undef PG8_WAIT_L
#undef PG8_BAR
#undef PG8_SCHED
}

template <class Epi, class Sched, bool FP8 = false>
__device__ __forceinline__ void gemm_phase_gather(PG8_LAS unsigned char* lds, const char* Abase, const int lda, const int ldb, const Sched& S, const Epi& E, const int sclW = 0x7f7f7f7f, const int sclX = 0x7f7f7f7f) {
    constexpr int EB = FP8 ? 1 : 2;
    const int tid = opaque_tid(), wid = __builtin_amdgcn_readfirstlane(tid >> 6), lane = tid & 63, wr = wid >> 2, wc = wid & 3, fr = lane & 15, fq = lane >> 4;
    unsigned voffB[2]; int Rr[2]; unsigned Cc[2];
#pragma unroll
    for (int i = 0; i < 2; ++i) { int R, C; stage_rc(tid * 16 + i * 8192, R, C); const int Rb = Epi::PERM ? ((R & ~31) + perm32(R & 31)) : R;
        Rr[i] = R; Cc[i] = (unsigned)C * 2u; voffB[i] = (unsigned)(Rb * ldb * EB + C * 2); }
    const size_t kstep = (size_t)(BK * 2);
    const size_t hB = (size_t)HALF * ldb * EB;
    const unsigned ldsw = (unsigned)wid * 1024u;
    const int fcol = FP8 ? (32 * (fq >> 1) + 16 * (fq & 1)) : fq * 8;
    const int aoff = lds_byte(wr * 64 + fr, fcol), boff = lds_byte(wc * 32 + fr, fcol);
#define PG8_SA(b, h) (((b) * 2 + (h)) * HTB)
#define PG8_SB(b, h) ((4 + (b) * 2 + (h)) * HTB)
#define PG8_STAGE(bufoff, gbase, voff) do { _Pragma("unroll") for (int _i = 0; _i < 2; ++_i) \
        __builtin_amdgcn_global_load_lds((const unsigned*)((const char*)(gbase) + (voff)[_i]), (PG8_LAS unsigned*)(lds + (bufoff) + ldsw + _i * 8192), 16, 0, 0); } while (0)
#define PG8_LDA(dst, b, h) do { if constexpr (FP8) { _Pragma("unroll") for (int m = 0; m < 4; ++m) dst##8[m] = cat8(*(const PG8_LAS bf16x8*)(lds + PG8_SA(b, h) + aoff + m * 2048), *(const PG8_LAS bf16x8*)(lds + PG8_SA(b, h) + aoff + m * 2048 + 16)); } else { \
        _Pragma("unroll") for (int m = 0; m < 4; ++m) _Pragma("unroll") for (int k = 0; k < 2; ++k) dst[m][k] = *(const PG8_LAS bf16x8*)(lds + PG8_SA(b, h) + aoff + m * 2048 + k * 1024); } } while (0)
#define PG8_LDB(dst, b, h) do { if constexpr (FP8) { _Pragma("unroll") for (int n = 0; n < 2; ++n) dst##8[n] = cat8(*(const PG8_LAS bf16x8*)(lds + PG8_SB(b, h) + boff + n * 2048), *(const PG8_LAS bf16x8*)(lds + PG8_SB(b, h) + boff + n * 2048 + 16)); } else { \
        _Pragma("unroll") for (int n = 0; n < 2; ++n) _Pragma("unroll") for (int k = 0; k < 2; ++k) dst[n][k] = *(const PG8_LAS bf16x8*)(lds + PG8_SB(b, h) + boff + n * 2048 + k * 1024); } } while (0)
#define PG8_MMA(ai, bj, At, Bt) do { __builtin_amdgcn_s_setprio(1); if constexpr (FP8) { _Pragma("unroll") for (int m = 0; m < 4; ++m) _Pragma("unroll") for (int n = 0; n < 2; ++n) \
        asm volatile("v_mfma_f32_16x16x128_f8f6f4 %0, %1, %2, %0" : "+v"(acc[ai][bj][m][n]) : "v"(Bt##8[n]), "v"(At##8[m])); } else { \
        _Pragma("unroll") for (int m = 0; m < 4; ++m) _Pragma("unroll") for (int n = 0; n < 2; ++n) _Pragma("unroll") for (int k = 0; k < 2; ++k) \
        acc[ai][bj][m][n] = __builtin_amdgcn_mfma_f32_16x16x32_bf16(Bt[n][k], At[m][k], acc[ai][bj][m][n], 0, 0, 0); } __builtin_amdgcn_s_setprio(0); } while (0)
#define PG8_WAIT_V(n) asm volatile("s_waitcnt vmcnt(" #n ")" ::: "memory")
#define PG8_WAIT_L(n) asm volatile("s_waitcnt lgkmcnt(" #n ")" ::: "memory")
#define PG8_BAR __builtin_amdgcn_s_barrier()
#define PG8_SCHED __builtin_amdgcn_sched_barrier(0)
#define PG8_ROWOFF(u, vo) do { _Pragma("unroll") for (int _h = 0; _h < 2; ++_h) _Pragma("unroll") for (int _i = 0; _i < 2; ++_i) \
        (vo)[_h][_i] = (unsigned)S.rowtok((u), 128 * _h + Rr[_i]) * (unsigned)(lda * EB) + Cc[_i]; } while (0)
    Unit cur, nxt, nn; int ui = 0;
    if (!S.next(0, cur)) return;
    bool has_next = S.next(1, nxt);
    unsigned cv[2][2], nv[2][2], tv[2][2];
    PG8_ROWOFF(cur, cv);
    if (has_next) PG8_ROWOFF(nxt, nv); else { _Pragma("unroll") for (int h = 0; h < 2; ++h) _Pragma("unroll") for (int i = 0; i < 2; ++i) nv[h][i] = cv[h][i]; }
    f32x4 acc[2][2][4][2];
#pragma unroll
    for (int a = 0; a < 2; ++a)
#pragma unroll
        for (int b = 0; b < 2; ++b)
#pragma unroll
            for (int m = 0; m < 4; ++m)
#pragma unroll
                for (int n = 0; n < 2; ++n) acc[a][b][m][n] = (f32x4){0.f, 0.f, 0.f, 0.f};
    bf16x8 At[4][2], B0[2][2], B1[2][2]; v8i32 At8[4], B08[2], B18[2];
    const char* cB = cur.B;
    if constexpr (Epi::BIAS_DMA) { if (wid == 0) E.bias_dma(cur, 0, lane, lds); }
    PG8_STAGE(PG8_SB(0, 0), cB, voffB); PG8_STAGE(PG8_SB(0, 1), cB + hB, voffB); PG8_STAGE(PG8_SA(0, 0), Abase, cv[0]); PG8_STAGE(PG8_SA(0, 1), Abase, cv[1]);
    if (wr == 1) PG8_BAR;
    PG8_WAIT_V(2); PG8_BAR;
    PG8_STAGE(PG8_SB(1, 0), cB + kstep, voffB); PG8_STAGE(PG8_SA(1, 0), Abase + kstep, cv[0]); PG8_STAGE(PG8_SB(1, 1), cB + hB + kstep, voffB);
    PG8_WAIT_V(6); PG8_BAR;
    for (;;) {
        const char* nB = has_next ? nxt.B : cB;
        if constexpr (Epi::BIAS_DMA) { if (has_next && wid == 0) E.bias_dma(nxt, (ui + 1) % 3, lane, lds); }
        const int nt = cur.nt;
        for (int t = 0; t < nt; t += 2) {
            const bool last = (t == nt - 2);
            const char* a1 = Abase + (size_t)(t + 1) * kstep;
            const char* a2 = last ? Abase : Abase + (size_t)(t + 2) * kstep; const char* b2 = last ? nB : cB + (size_t)(t + 2) * kstep;
            const char* a3 = a2 + kstep; const char* b3 = b2 + kstep;
            unsigned s0[2], s1[2];
#pragma unroll
            for (int i = 0; i < 2; ++i) { s0[i] = last ? nv[0][i] : cv[0][i]; s1[i] = last ? nv[1][i] : cv[1][i]; }
            PG8_LDB(B0, 0, 0); PG8_LDB(B1, 0, 1); PG8_SCHED; PG8_LDA(At, 0, 0); PG8_STAGE(PG8_SA(1, 1), a1, cv[1]);
            PG8_WAIT_V(8); PG8_WAIT_L(0); PG8_BAR; PG8_MMA(0, 0, At, B0); PG8_MMA(0, 1, At, B1); PG8_BAR; PG8_SCHED;
            PG8_LDA(At, 0, 1); PG8_STAGE(PG8_SB(0, 0), b2, voffB); PG8_STAGE(PG8_SB(0, 1), b2 + hB, voffB); PG8_STAGE(PG8_SA(0, 0), a2, s0);
            PG8_WAIT_V(8); PG8_WAIT_L(0); PG8_BAR; PG8_MMA(1, 0, At, B0); PG8_MMA(1, 1, At, B1); PG8_BAR; PG8_SCHED;
            PG8_LDB(B0, 1, 0); PG8_LDB(B1, 1, 1); PG8_SCHED; PG8_LDA(At, 1, 0); PG8_STAGE(PG8_SA(0, 1), a2, s1);
            PG8_WAIT_V(8); PG8_WAIT_L(0); PG8_BAR; PG8_MMA(0, 0, At, B0); PG8_MMA(0, 1, At, B1); PG8_BAR; PG8_SCHED;
            PG8_LDA(At, 1, 1); PG8_STAGE(PG8_SB(1, 0), b3, voffB); PG8_STAGE(PG8_SB(1, 1), b3 + hB, voffB); PG8_STAGE(PG8_SA(1, 0), a3, s0);
            PG8_WAIT_V(8); PG8_WAIT_L(0); PG8_BAR; PG8_MMA(1, 0, At, B0); PG8_MMA(1, 1, At, B1); PG8_BAR; PG8_SCHED;
        }
        if (wr == 0) PG8_BAR;
        if constexpr (FP8) asm volatile("s_nop 15\n\ts_nop 15\n\ts_nop 15" ::: "memory");
        const bool has_nn = has_next && S.next(ui + 2, nn);
        if (has_nn) PG8_ROWOFF(nn, tv);
        cur.bs = ui % 3;
        E(acc, cur, wr, wc, fr, fq);
        if (!has_next) break;
#pragma unroll
        for (int a = 0; a < 2; ++a)
#pragma unroll
            for (int b = 0; b < 2; ++b)
#pragma unroll
                for (int m = 0; m < 4; ++m)
#pragma unroll
                    for (int n = 0; n < 2; ++n) acc[a][b][m][n] = (f32x4){0.f, 0.f, 0.f, 0.f};
        cur = nxt; cB = nB; ++ui;
#pragma unroll
        for (int h = 0; h < 2; ++h)
#pragma unroll
            for (int i = 0; i < 2; ++i) { cv[h][i] = nv[h][i]; if (has_nn) nv[h][i] = tv[h][i]; }
        asm volatile("" : "+v"(nv[0][0]), "+v"(nv[0][1]), "+v"(nv[1][0]), "+v"(nv[1][1]));
        nxt = nn; has_next = has_nn;
        if (wr == 1) PG8_BAR;
    }
    PG8_WAIT_V(0);
    PG8_BAR;
#undef PG8_SA
#undef PG8_SB
#undef PG8_STAGE
#undef PG8_LDA
#undef PG8_LDB
#undef PG8_MMA
#undef PG8_WAIT_V
#undef PG8_WAIT_L
#undef PG8_BAR
#undef PG8_SCHED
#undef PG8_ROWOFF
}

struct DenseOrder {
    const char* A; const char* B; size_t a_tile, b_tile; int nt, nM, nN, G, c; int pn_off = 0;
    __device__ __forceinline__ bool next(int i, Unit& u) const {
        const long L = (long)i * G + c; if (L >= (long)nM * nN) return false;
        int pm, pn; tile_of((int)L, nM, nN, pm, pn);
        u.pm = pm; u.pn = pn + pn_off; u.aux = 0; u.nt = nt; u.A = A + (size_t)pm * a_tile; u.B = B + (size_t)pn * b_tile; return true;
    }
};
struct ProjOrder {
    const char* Y; const char* W; int nM, nN, G, c;
    __device__ __forceinline__ bool next(int i, Unit& u) const {
        const int ti = i / 3, br = i - 3 * ti;
        const long L = (long)ti * G + c; if (L >= (long)nM * nN) return false;
        int pm, pn; tile_of((int)L, nM, nN, pm, pn);
        u.pm = pm; u.pn = pn; u.aux = br; u.nt = (br == 2) ? 6 : 4;
        const int acol = (br == 0) ? 0 : (br == 1 ? 256 : 384), bcol = (br == 0) ? 0 : (br == 1 ? 256 : 512);
        u.A = Y + ((size_t)pm * 256 * YLD + acol) * 2; u.B = W + ((size_t)pn * 256 * WPK + bcol) * 2; return true;
    }
};
struct MoeOrder {
    const char* A; const char* W; size_t estride, atile, btile; int nt; const LAS int* tile_e; const LAS int* offT; const LAS int* cnt; const int* SRC; int T, nN, G, c;
    __device__ __forceinline__ bool next(int i, Unit& u) const {
        const long L = (long)i * G + c; if (L >= (long)T * nN) return false;
        int pm, pn; tile_of((int)L, T, nN, pm, pn);
        const int e = __builtin_amdgcn_readfirstlane(tile_e[pm]);
        u.pm = pm; u.pn = pn; u.aux = e; u.nt = nt; u.A = A + (size_t)pm * atile; u.B = W + (size_t)e * estride + (size_t)pn * btile; return true;
    }
    __device__ __forceinline__ int rowtok(const Unit& u, int r) const {
        const int e = u.aux, rank = (u.pm - offT[e]) * 256 + r, last = cnt[e] - 1;
        return SRC[e * NTOK + (rank < last ? rank : last)];
    }
};

struct EpiInProj {
    static constexpr bool PERM = true, KEEP = false, BIAS_DMA = true;
    bf16_t* H; const float* bg; const f32x2* r64; const f32x2* r48; float gscale; unsigned char* G8; PG8_LAS unsigned char* ldsb;
    __device__ __forceinline__ void bias_dma(const Unit& u, int s, int lane, PG8_LAS unsigned char* lds) const {
        const int o = u.pn >= 12 ? (u.pn - 12) * BM : 0;
        glds16_u(bg + o + lane * 4, (unsigned)__builtin_amdgcn_readfirstlane((int)(unsigned)(size_t)(lds + L_BIAS_OFF + s * 1024))); }
    __device__ __forceinline__ void operator()(f32x4 (&acc)[2][2][4][2], const Unit& u, int wr, int wc, int fr, int fq) const {
        const int row0 = u.pm * BM + wr * 64 + fr, pn = u.pn, t0 = wc * 32 + 8 * fq;
        const float gs = gscale; unsigned char* const g8 = G8;
        if (pn >= 3 && pn < 9) {
            int dst, hstep, tw, dd0; const f32x2* tab;
            if (pn < 6) { dst = 768 + (4 * (pn - 3) + wc) * 64 + 8 * fq; hstep = 32; tw = 32; dd0 = 8 * fq; tab = r64; }
            else { const int p0 = 128 * (pn - 6) + t0, slot = p0 / 24; dd0 = p0 - slot * 24; dst = 1920 + slot * 48 + dd0; hstep = 24; tw = 24; tab = r48; }
#pragma unroll
            for (int ai = 0; ai < 2; ++ai)
#pragma unroll
                for (int m = 0; m < 4; ++m) { const int row = row0 + ai * HALF + m * 16; const f32x2* tp = tab + (size_t)(row & (SEQ - 1)) * tw + dd0;
                    f32x4 y1[2], y2[2];
#pragma unroll
                    for (int n = 0; n < 2; ++n) { const f32x4 cs0 = *(const f32x4*)(tp + 4 * n), cs1 = *(const f32x4*)(tp + 4 * n + 2);
                        const f32x4 x1 = acc[ai][0][m][n], x2 = acc[ai][1][m][n];
                        y1[n][0] = x1[0] * cs0[0] - x2[0] * cs0[1]; y2[n][0] = x2[0] * cs0[0] + x1[0] * cs0[1];
                        y1[n][1] = x1[1] * cs0[2] - x2[1] * cs0[3]; y2[n][1] = x2[1] * cs0[2] + x1[1] * cs0[3];
                        y1[n][2] = x1[2] * cs1[0] - x2[2] * cs1[1]; y2[n][2] = x2[2] * cs1[0] + x1[2] * cs1[1];
                        y1[n][3] = x1[3] * cs1[2] - x2[3] * cs1[3]; y2[n][3] = x2[3] * cs1[2] + x1[3] * cs1[3]; }
                    bf16_t* rowp = H + (size_t)row * INC + dst;
                    u32x4 w; w.x = cvt_pk_bf16(y1[0][0], y1[0][1]); w.y = cvt_pk_bf16(y1[0][2], y1[0][3]); w.z = cvt_pk_bf16(y1[1][0], y1[1][1]); w.w = cvt_pk_bf16(y1[1][2], y1[1][3]);
                    *(u32x4*)rowp = w;
                    w.x = cvt_pk_bf16(y2[0][0], y2[0][1]); w.y = cvt_pk_bf16(y2[0][2], y2[0][3]); w.z = cvt_pk_bf16(y2[1][0], y2[1][1]); w.w = cvt_pk_bf16(y2[1][2], y2[1][3]);
                    *(u32x4*)(rowp + hstep) = w; }
            return;
        }
        const bool gate = pn >= 12;
        int dcol[2];
#pragma unroll
        for (int bj = 0; bj < 2; ++bj) { const int x = pn * BM + bj * HALF + t0;
            if (pn >= 9 && pn < 12) { const int xx = x - 2304; dcol[bj] = xx < 384 ? 1536 + xx : 2688 + (xx - 384); } else dcol[bj] = x; }
        f32x4 bv[2][2];
#pragma unroll
        for (int bj = 0; bj < 2; ++bj)
#pragma unroll
            for (int n = 0; n < 2; ++n) bv[bj][n] = gate ? *(const PG8_LAS f32x4*)((const PG8_LAS float*)(ldsb + L_BIAS_OFF + u.bs * 1024) + bj * HALF + t0 + 4 * n) : (f32x4){0.f, 0.f, 0.f, 0.f};
#pragma unroll
        for (int ai = 0; ai < 2; ++ai)
#pragma unroll
            for (int m = 0; m < 4; ++m) { bf16_t* rowp = H + (size_t)(row0 + ai * HALF + m * 16) * INC;
#pragma unroll
                for (int bj = 0; bj < 2; ++bj) { f32x4 v0 = acc[ai][bj][m][0], v1 = acc[ai][bj][m][1];
                    if (gate) {
#pragma unroll
                        for (int q = 0; q < 4; ++q) { v0[q] = v0[q] * gs + bv[bj][0][q]; v1[q] = v1[q] * gs + bv[bj][1][q]; }
                        const unsigned b0 = (unsigned)(fast_sigmoid(v0[0]) * 255.0f + 0.5f) | ((unsigned)(fast_sigmoid(v0[1]) * 255.0f + 0.5f) << 8) | ((unsigned)(fast_sigmoid(v0[2]) * 255.0f + 0.5f) << 16) | ((unsigned)(fast_sigmoid(v0[3]) * 255.0f + 0.5f) << 24);
                        const unsigned b1 = (unsigned)(fast_sigmoid(v1[0]) * 255.0f + 0.5f) | ((unsigned)(fast_sigmoid(v1[1]) * 255.0f + 0.5f) << 8) | ((unsigned)(fast_sigmoid(v1[2]) * 255.0f + 0.5f) << 16) | ((unsigned)(fast_sigmoid(v1[3]) * 255.0f + 0.5f) << 24);
                        *(v2u*)(g8 + (size_t)(row0 + ai * HALF + m * 16) * 3072 + (dcol[bj] - C_GP)) = (v2u){b0, b1};
                    } else {
                        u32x4 w; w.x = cvt_pk_bf16(v0[0], v0[1]); w.y = cvt_pk_bf16(v0[2], v0[3]); w.z = cvt_pk_bf16(v1[0], v1[1]); w.w = cvt_pk_bf16(v1[2], v1[3]);
                        *(u32x4*)(rowp + dcol[bj]) = w; } } }
    }
};
struct EpiProj {
    static constexpr bool PERM = false, KEEP = true, BIAS_DMA = false;
    const unsigned char* G8; bf16_t* Mg;
    __device__ __forceinline__ void operator()(f32x4 (&acc)[2][2][4][2], const Unit& u, int wr, int wc, int fr, int fq) const {
        const int row0 = u.pm * BM + wr * 64 + fr, col0 = u.pn * BM + wc * 32 + 4 * fq, br = u.aux;
#pragma unroll
        for (int ai = 0; ai < 2; ++ai)
#pragma unroll
            for (int m = 0; m < 4; ++m) { const size_t row = (size_t)(row0 + ai * HALF + m * 16);
#pragma unroll
                for (int bj = 0; bj < 2; ++bj)
#pragma unroll
                    for (int n = 0; n < 2; ++n) { const int c = col0 + bj * HALF + n * 16;
                        const unsigned char* gp = G8 + row * 3072 + br * 1024 + c;
                        const unsigned gw = *(const unsigned*)gp;
                        f32x4 g = (f32x4){fmaxf((float)(gw & 255u) * (1.0f / 255.0f), 1e-6f), fmaxf((float)((gw >> 8) & 255u) * (1.0f / 255.0f), 1e-6f), fmaxf((float)((gw >> 16) & 255u) * (1.0f / 255.0f), 1e-6f), fmaxf((float)(gw >> 24) * (1.0f / 255.0f), 1e-6f)};
                        if (br < 2) { const unsigned nw = *(const unsigned*)(gp + 1024);
                            g[0] *= __builtin_amdgcn_rcpf(fmaxf((float)(nw & 255u) * (1.0f / 255.0f), 1e-6f)); g[1] *= __builtin_amdgcn_rcpf(fmaxf((float)((nw >> 8) & 255u) * (1.0f / 255.0f), 1e-6f));
                            g[2] *= __builtin_amdgcn_rcpf(fmaxf((float)((nw >> 16) & 255u) * (1.0f / 255.0f), 1e-6f)); g[3] *= __builtin_amdgcn_rcpf(fmaxf((float)(nw >> 24) * (1.0f / 255.0f), 1e-6f));
                            acc[ai][bj][m][n] = acc[ai][bj][m][n] * g; }
                        else { const f32x4 t = acc[ai][bj][m][n] * g; v2u o; o.x = cvt_pk_bf16(t[0], t[1]); o.y = cvt_pk_bf16(t[2], t[3]); *(v2u*)(Mg + row * 1024 + c) = o; } } }
    }
};
struct EpiOut {
    static constexpr bool PERM = false, KEEP = false, BIAS_DMA = false;
    const float* X; const bf16_t* XBr; bf16_t* P;
    __device__ __forceinline__ void operator()(f32x4 (&acc)[2][2][4][2], const Unit& u, int wr, int wc, int fr, int fq) const {
        const int row0 = u.pm * BM + wr * 64 + fr, col0 = u.pn * BM + wc * 32 + 4 * fq;
        const float* const Xf = X; const bf16_t* const Xh = XBr; bf16_t* const Pp = P;
#pragma unroll
        for (int ai = 0; ai < 2; ++ai)
#pragma unroll
            for (int m = 0; m < 4; ++m) { const size_t ro = (size_t)(row0 + ai * HALF + m * 16) * 1024 + col0;
#pragma unroll
                for (int bj = 0; bj < 2; ++bj)
#pragma unroll
                    for (int n = 0; n < 2; ++n) { f32x4 xv;
                        if (Xf) xv = *(const f32x4*)(Xf + ro + bj * HALF + n * 16);
                        else { const v2u xw = *(const v2u*)(Xh + ro + bj * HALF + n * 16); xv = (f32x4){bflo(xw.x), bfhi(xw.x), bflo(xw.y), bfhi(xw.y)}; }
                        const f32x4 pv = xv * DN_ALPHA + acc[ai][bj][m][n]; v2u o; o.x = cvt_pk_bf16(pv[0], pv[1]); o.y = cvt_pk_bf16(pv[2], pv[3]); *(v2u*)(Pp + ro + bj * HALF + n * 16) = o; } }
    }
};
struct EpiSwiglu {
    static constexpr bool PERM = true, KEEP = false, BIAS_DMA = true;
    unsigned char* HH; const float* bgate; const float* bup; float ascale; PG8_LAS unsigned char* ldsb;
    __device__ __forceinline__ void bias_dma(const Unit& u, int s, int lane, PG8_LAS unsigned char* lds) const {
        const float* src = (lane < 32 ? bgate : bup) + u.aux * 1024 + u.pn * HALF + (lane & 31) * 4;
        glds16_u(src, (unsigned)__builtin_amdgcn_readfirstlane((int)(unsigned)(size_t)(lds + L_BIAS_OFF + s * 1024))); }
    __device__ __forceinline__ void operator()(f32x4 (&acc)[2][2][4][2], const Unit& u, int wr, int wc, int fr, int fq) const {
        const int row0 = u.pm * BM + wr * 64 + fr, j0 = u.pn * HALF + wc * 32 + 8 * fq, e = u.aux;
        f32x4 bg[2], bu[2];
#pragma unroll
        for (int n = 0; n < 2; ++n) { const PG8_LAS float* bl = (const PG8_LAS float*)(ldsb + L_BIAS_OFF + u.bs * 1024) + wc * 32 + 8 * fq + 4 * n; bg[n] = *(const PG8_LAS f32x4*)bl; bu[n] = *(const PG8_LAS f32x4*)(bl + HALF); }
#pragma unroll
        for (int ai = 0; ai < 2; ++ai)
#pragma unroll
            for (int m = 0; m < 4; ++m) { unsigned char* rowp = HH + (size_t)(row0 + ai * HALF + m * 16) * 1024 + j0;
                f32x4 o[2];
#pragma unroll
                for (int n = 0; n < 2; ++n) { f32x4 g = acc[ai][0][m][n] * ascale + bg[n], uu = acc[ai][1][m][n] * ascale + bu[n];
#pragma unroll
                    for (int q = 0; q < 4; ++q) { const float hg = fminf(g[q], 7.0f), hu = fminf(fmaxf(uu[q], -7.0f), 7.0f);
                        o[n][q] = hg * fast_sigmoid(1.702f * hg) * (hu + 1.0f); } }
                v2u w; w.x = pk4_fp8(o[0][0], o[0][1], o[0][2], o[0][3], 4.0f); w.y = pk4_fp8(o[1][0], o[1][1], o[1][2], o[1][3], 4.0f);
                *(v2u*)rowp = w; }
    }
};
struct EpiDown {
    static constexpr bool PERM = true, KEEP = false, BIAS_DMA = true;
    bf16_t* YS; const float* bd; float ascale; PG8_LAS unsigned char* ldsb;
    __device__ __forceinline__ void bias_dma(const Unit& u, int s, int lane, PG8_LAS unsigned char* lds) const {
        glds16_u(bd + u.aux * 1024 + u.pn * BM + lane * 4, (unsigned)__builtin_amdgcn_readfirstlane((int)(unsigned)(size_t)(lds + L_BIAS_OFF + s * 1024))); }
    __device__ __forceinline__ void operator()(f32x4 (&acc)[2][2][4][2], const Unit& u, int wr, int wc, int fr, int fq) const {
        const int row0 = u.pm * BM + wr * 64 + fr, col0 = u.pn * BM + wc * 32 + 8 * fq, e = u.aux;
        f32x4 bv[2][2];
#pragma unroll
        for (int bj = 0; bj < 2; ++bj)
#pragma unroll
            for (int n = 0; n < 2; ++n) bv[bj][n] = *(const PG8_LAS f32x4*)((const PG8_LAS float*)(ldsb + L_BIAS_OFF + u.bs * 1024) + wc * 32 + 8 * fq + bj * HALF + 4 * n);
#pragma unroll
        for (int ai = 0; ai < 2; ++ai)
#pragma unroll
            for (int m = 0; m < 4; ++m) { bf16_t* rowp = YS + (size_t)(row0 + ai * HALF + m * 16) * 1024 + col0;
#pragma unroll
                for (int bj = 0; bj < 2; ++bj) { const f32x4 v0 = acc[ai][bj][m][0] * ascale + bv[bj][0], v1 = acc[ai][bj][m][1] * ascale + bv[bj][1];
                    u32x4 w; w.x = cvt_pk_bf16(v0[0], v0[1]); w.y = cvt_pk_bf16(v0[2], v0[3]); w.z = cvt_pk_bf16(v1[0], v1[1]); w.w = cvt_pk_bf16(v1[2], v1[3]);
                    *(u32x4*)(rowp + bj * HALF) = w; } }
    }
};
}

#define XB_TMO      128
#define XB_XCNT(j)  (256  + 64 * (j))
#define XB_XSUB(j)  (1280 + 64 * (j))
#define XB_XGEN(j)  (2304 + 64 * (j))
#define XB_TOP      3328
#define XB_TOPGEN   3392
#define XCD_BAR_WORDS 3456
#define XB_SPIN_CAP (1u << 18)

__device__ __forceinline__ unsigned xb_ld(unsigned* p)              { return __hip_atomic_load(p, __ATOMIC_RELAXED, __HIP_MEMORY_SCOPE_AGENT); }
__device__ __forceinline__ unsigned xb_add(unsigned* p, unsigned v) { return __hip_atomic_fetch_add(p, v, __ATOMIC_RELAXED, __HIP_MEMORY_SCOPE_AGENT); }
__device__ __forceinline__ unsigned xb_xcc_id() { return (unsigned)__builtin_amdgcn_s_getreg((3 << 11) | 20) & 0xFu; }
#define XB_SPIN(cond, bar) do { unsigned _sp = 0; while (cond) { __builtin_amdgcn_s_sleep(1); \
    if ((++_sp & 255u) == 0u) { if (xb_ld(&(bar)[XB_TMO])) break; if (_sp > XB_SPIN_CAP) { atomicAdd(&(bar)[XB_TMO], 1u); break; } } } } while (0)

struct XcdBarrier { unsigned* bar; unsigned x; volatile LAS unsigned* st; };

__device__ __forceinline__ XcdBarrier xcd_barrier_post(unsigned* bar, volatile LAS unsigned* st) {
    XcdBarrier b; b.bar = bar; b.x = xb_xcc_id(); b.st = st;
    if (threadIdx.x == 0) (void)xb_add(&bar[XB_XCNT(b.x)], 1u);
    return b;
}
__device__ __forceinline__ void xcd_barrier_complete(unsigned* bar, unsigned x, unsigned& nloc, unsigned& nx) {
    const unsigned G = gridDim.x * gridDim.y * gridDim.z;
    unsigned sum, cnt, mine, sp = 0u;
    for (;;) {
        sum = 0u; cnt = 0u; mine = 0u;
#pragma unroll
        for (unsigned j = 0; j < 16; ++j) { const unsigned c = xb_ld(&bar[XB_XCNT(j)]); sum += c; cnt += (c > 0u) ? 1u : 0u; mine = (j == x) ? c : mine; }
        if (sum == G) break;
        __builtin_amdgcn_s_sleep(1);
        if ((++sp & 255u) == 0u) { if (xb_ld(&bar[XB_TMO])) break; if (sp > XB_SPIN_CAP) { atomicAdd(&bar[XB_TMO], 1u); break; } }
    }
    nloc = mine > 0u ? mine : 1u; nx = cnt > 0u ? cnt : 1u;
}
__device__ __forceinline__ void xcd_barrier(const XcdBarrier& b) {
    asm volatile("s_waitcnt vmcnt(0)" ::: "memory");
    __syncthreads();
    if (threadIdx.x == 0) {
        unsigned* bar = b.bar;
        __builtin_amdgcn_s_waitcnt(0);
        unsigned nloc = b.st[0], nx = b.st[1];
        if (nloc == 0u) { xcd_barrier_complete(bar, b.x, nloc, nx); b.st[0] = nloc; b.st[1] = nx; }
        const unsigned old = xb_add(&bar[XB_XSUB(b.x)], 1u);
        const unsigned gen = old / nloc;
        if (old + 1u == (gen + 1u) * nloc) {
            __builtin_amdgcn_fence(__ATOMIC_RELEASE, "agent");
            asm volatile("s_waitcnt vmcnt(0)" ::: "memory");
            const unsigned og = xb_add(&bar[XB_TOP], 1u);
            const unsigned tg = og / nx;
            if (og + 1u == (tg + 1u) * nx) xb_add(&bar[XB_TOPGEN], 1u);
            else XB_SPIN(xb_ld(&bar[XB_TOPGEN]) == tg, bar);
            __builtin_amdgcn_fence(__ATOMIC_ACQUIRE, "agent");
            xb_add(&bar[XB_XGEN(b.x)], 1u);
            asm volatile("s_waitcnt vmcnt(0)" ::: "memory");
        } else {
            XB_SPIN(xb_ld(&bar[XB_XGEN(b.x)]) == gen, bar);
            __builtin_amdgcn_fence(__ATOMIC_ACQUIRE, "agent");
            asm volatile("s_waitcnt vmcnt(0)" ::: "memory");
        }
    }
    __syncthreads();
}

struct Frame {
    LAS unsigned char* lds;
    unsigned* ctl;
    unsigned char* ws;
    int tid, lane, wave, G, bid;
};

__host__ __device__ __forceinline__ int inproj_phys(int nl) {
    if (nl < 768) return nl;
    if (nl < 1536) { const int x = nl - 768, slot = x >> 6, d = x & 63; return 768 + (slot >> 2) * 256 + (d >> 5) * 128 + (slot & 3) * 32 + (d & 31); }
    if (nl < 1920) return 2304 + (nl - 1536);
    if (nl < 2688) { const int x = nl - 1920, slot = x / 48, d = x - slot * 48, hf = d >= 24 ? 1 : 0, p = slot * 24 + d - 24 * hf; return 1536 + (p >> 7) * 256 + hf * 128 + (p & 127); }
    if (nl < 3072) return 2304 + 384 + (nl - 2688);
    return nl;
}
template <class RowMap>
__device__ __forceinline__ void transpose_item(const float* W, int N, bf16* dst, int ldd, int k0, int n0, const RowMap rowmap, LAS float* scr, int lane) {
#pragma unroll 8
    for (int i = 0; i < 32; ++i) { const int kk = 2 * i + (lane >> 5); scr[kk * 33 + (lane & 31)] = W[(size_t)(k0 + kk) * N + n0 + (lane & 31)]; }
    LDS_WAIT(); asm volatile("" ::: "memory");
    const int c = lane & 7;
#pragma unroll
    for (int j = 0; j < 4; ++j) { const int n = (lane >> 3) + 8 * j; const LAS float* sp = scr + (8 * c) * 33 + n;
        v4u o; o.x = pk2(sp[0 * 33], sp[1 * 33]); o.y = pk2(sp[2 * 33], sp[3 * 33]); o.z = pk2(sp[4 * 33], sp[5 * 33]); o.w = pk2(sp[6 * 33], sp[7 * 33]);
        *(v4u*)(dst + (size_t)rowmap(n0 + n) * ldd + k0 + 8 * c) = o; }
    LDS_WAIT(); asm volatile("" ::: "memory");
}

template <class RowMap>
__device__ __forceinline__ void transpose_item_fp8(const float* W, int N, unsigned char* dst, int ldd, int k0, int n0, const RowMap rowmap, LAS float* scr, int lane, float qs) {
#pragma unroll 8
    for (int i = 0; i < 32; ++i) { const int kk = 2 * i + (lane >> 5); scr[kk * 33 + (lane & 31)] = W[(size_t)(k0 + kk) * N + n0 + (lane & 31)]; }
    LDS_WAIT(); asm volatile("" ::: "memory");
    const int c = lane & 7;
#pragma unroll
    for (int j = 0; j < 4; ++j) { const int n = (lane >> 3) + 8 * j; const LAS float* sp = scr + (8 * c) * 33 + n;
        v2u o; o.x = pk4_fp8(sp[0 * 33], sp[1 * 33], sp[2 * 33], sp[3 * 33], qs); o.y = pk4_fp8(sp[4 * 33], sp[5 * 33], sp[6 * 33], sp[7 * 33], qs);
        *(v2u*)(dst + (size_t)rowmap(n0 + n) * ldd + k0 + 8 * c) = o; }
    LDS_WAIT(); asm volatile("" ::: "memory");
}

struct Args { const float* in[22]; float* out; unsigned char* ws; int ph_lo, ph_hi; float lam_init[4]; };

__device__ __forceinline__ void p_prologue(Frame& F, const Args& a) {
    LAS float* scr = (LAS float*)(F.lds + F.wave * 16384);
    const int gw = F.bid * 8 + F.wave, NGW = F.G * 8;
    constexpr int PER_LAYER = 3072 + 128 + 64 + 192 + 512 + 32 * 1536;
    for (int it = gw; it < DEPTH * PER_LAYER; it += NGW) {
        const int l = it / PER_LAYER; int r = it - l * PER_LAYER;
        if (r < 3072) { const int kb = r / 192, nb = r % 192;
            if (nb < 96) transpose_item(a.in[1] + (size_t)l * 1024 * INC, INC, (bf16*)(F.ws + WS_WIN) + (size_t)l * INC * 1024, 1024, kb * 64, nb * 32, [](int n) { return inproj_phys(n); }, scr, F.lane);
            else transpose_item_fp8(a.in[1] + (size_t)l * 1024 * INC, INC, (unsigned char*)(F.ws + WS_WIN8) + (size_t)l * 3072 * 1024, 1024, kb * 64, nb * 32, [](int n) { return n - 3072; }, scr, F.lane, 32.f);
            continue; }
        r -= 3072;
        if (r < 128) { const int kb = r / 32, nb = r % 32;
            transpose_item(a.in[3] + (size_t)l * 256 * 1024, 1024, (bf16*)(F.ws + WS_WPROJ) + (size_t)l * 1024 * WPK + 0, WPK, kb * 64, nb * 32, [](int n) { return n; }, scr, F.lane); continue; }
        r -= 128;
        if (r < 64) { const int kb = r / 32, nb = r % 32;
            transpose_item(a.in[4] + (size_t)l * 128 * 1024, 1024, (bf16*)(F.ws + WS_WPROJ) + (size_t)l * 1024 * WPK + 256, WPK, kb * 64, nb * 32, [](int n) { return n; }, scr, F.lane); continue; }
        r -= 64;
        if (r < 192) { const int kb = r / 32, nb = r % 32;
            transpose_item(a.in[5] + (size_t)l * 384 * 1024, 1024, (bf16*)(F.ws + WS_WPROJ) + (size_t)l * 1024 * WPK + 512, WPK, kb * 64, nb * 32, [](int n) { return n; }, scr, F.lane); continue; }
        r -= 192;
        if (r < 512) { const int kb = r / 32, nb = r % 32;
            transpose_item(a.in[6] + (size_t)l * 1024 * 1024, 1024, (bf16*)(F.ws + WS_WOUT) + (size_t)l * 1024 * 1024, 1024, kb * 64, nb * 32, [](int n) { return n; }, scr, F.lane); continue; }
        r -= 512;
        { const int e = r / 1536, r2 = r % 1536, mtx = r2 / 512, r3 = r2 % 512, kb = r3 / 32, nb = r3 % 32;
          const size_t eoff = ((size_t)l * NEXP + e) * 1024 * 1024;
          if (mtx == 0) transpose_item_fp8(a.in[14] + eoff, 1024, (unsigned char*)(F.ws + WS_WGU) + 2 * eoff, 1024, kb * 64, nb * 32, [](int n) { return (n >> 7) * 256 + (n & 127); }, scr, F.lane, 32.f);
          else if (mtx == 1) transpose_item_fp8(a.in[16] + eoff, 1024, (unsigned char*)(F.ws + WS_WGU) + 2 * eoff, 1024, kb * 64, nb * 32, [](int n) { return (n >> 7) * 256 + 128 + (n & 127); }, scr, F.lane, 32.f);
          else transpose_item_fp8(a.in[18] + eoff, 1024, (unsigned char*)(F.ws + WS_WDN) + eoff, 1024, kb * 64, nb * 32, [](int n) { return n; }, scr, F.lane, 64.f); }
    }
    { const int gt = F.bid * 512 + F.tid, NT = F.G * 512;
      for (int i = gt; i < DEPTH * 1024 * 16; i += NT) { const int row = i >> 4, ch = i & 15;
          *(v4u*)((bf16*)(F.ws + WS_WPROJ) + (size_t)row * WPK + 384 + ch * 8) = (v4u){0u, 0u, 0u, 0u}; }
      for (int i = gt; i < SEQ * 32; i += NT) { const int pos = i >> 5, j = i & 31;
          const float inv = 1.0f / powf(10000.0f, (float)(2 * j) / 64.0f); const float ang = (float)pos * inv; float s, c; sincosf(ang, &s, &c);
          ((f32x2*)(F.ws + WS_ROPE64))[i] = (f32x2){c, s}; }
      for (int i = gt; i < SEQ * 24; i += NT) { const int pos = i / 24, j = i - pos * 24;
          const float inv = 1.0f / powf(10000.0f, (float)(2 * j) / 48.0f); const float ang = (float)pos * inv; float s, c; sincosf(ang, &s, &c);
          ((f32x2*)(F.ws + WS_ROPE48))[i] = (f32x2){c, s}; }
      for (int i = gt; i < DEPTH * 32 * 1024; i += NT) { const int l = i >> 15, e = (i >> 10) & 31, k = i & 1023;
          const float wv = a.in[12][((size_t)l * 1024 + k) * 32 + e]; const unsigned hi = f2bf(wv); const unsigned lo = f2bf(wv - __uint_as_float(hi << 16));
          bf16* wt = (bf16*)(F.ws + WS_WRT) + (size_t)l * 2 * 32 * 1024; wt[e * 1024 + k] = (bf16)hi; wt[32 * 1024 + e * 1024 + k] = (bf16)lo; }
      const f32x4* x4 = (const f32x4*)a.in[0]; v2u* xb = (v2u*)(F.ws + WS_XB);
      unsigned* xb8 = (unsigned*)(F.ws + WS_XB8);
      for (int i = gt; i < NTOK * 256; i += NT) { const f32x4 v = x4[i]; xb[i] = (v2u){pk2(v[0], v[1]), pk2(v[2], v[3])}; xb8[i] = pk4_fp8(v[0], v[1], v[2], v[3], 1.0f); }
    }
}

typedef float f32x16 __attribute__((ext_vector_type(16)));
typedef short s16x4 __attribute__((ext_vector_type(4)));
typedef float f32x2_t __attribute__((ext_vector_type(2)));
typedef __bf16 bf16x2_t __attribute__((ext_vector_type(2)));
__device__ __forceinline__ unsigned cvtpk(float lo, float hi) { const f32x2_t v = {lo, hi}; const bf16x2_t b = __builtin_convertvector(v, bf16x2_t); return __builtin_bit_cast(unsigned, b); }
__device__ __forceinline__ int kperm(int r) { return (r & ~12) | ((r & 4) << 1) | ((r & 8) >> 1); }
__device__ __forceinline__ s16x4 ds_tr16(const LAS unsigned char* p) { return __builtin_bit_cast(s16x4, __builtin_amdgcn_ds_read_tr16_b64_v4i16((LAS s16x4*)p)); }

__device__ __forceinline__ float fmax_nc(float a, float b) { return __builtin_amdgcn_fmed3f(a, b, __builtin_inff()); }
__device__ __forceinline__ void glds16(const void* gsrc, unsigned lds_dst) { unsigned keep;
    asm volatile("s_mov_b32 %0, m0\n\ts_mov_b32 m0, %2\n\ts_nop 0\n\tglobal_load_lds_dwordx4 %1, off\n\ts_mov_b32 m0, %0" : "=&s"(keep) : "v"(gsrc), "s"(lds_dst) : "memory"); }
__device__ __forceinline__ void attnC_pipe(Frame& F, const float* lamv, const float* ng, float lam_init) {
    const bf16* H = (const bf16*)(F.ws + WS_H); bf16* Y = (bf16*)(F.ws + WS_Y);
    const int lane = F.lane, w = F.wave, n = lane & 31, hh = lane >> 5;
    float l01 = 0.f, l23 = 0.f;
    if (lane < 48) { l01 = lamv[lane] * lamv[48 + lane]; l23 = lamv[96 + lane] * lamv[144 + lane]; }
    l01 = wave_sum(l01); l23 = wave_sum(l23);
    const float lam = expf(l01) - expf(l23) + lam_init;
    const float post = 1.0f - lam_init;
    constexpr int KST = 208, VST = 192, KBYTES = 64 * KST, STAGE = KBYTES + 64 * VST, NT = SEQ / 64;
    constexpr float CS = 0.14433756729740643f * 1.4426950408889634f;
    constexpr float PMAX = 256.0f;
    unsigned goff[4], loff[4];
#pragma unroll
    for (int j = 0; j < 4; ++j) { const int I = w + 8 * j;
        if (I < 13) { const int cid = I * 64 + lane, row = cid / 13; int col = cid - row * 13; if (col == 12) col = 0;
            goff[j] = (unsigned)(row * INC + C_KC + col * 8) * 2u; loff[j] = (unsigned)(I * 1024); }
        else { const int cid = (I - 13) * 64 + lane, row = cid / 12, col = cid - row * 12;
            goff[j] = (unsigned)(row * INC + C_VC + col * 8) * 2u; loff[j] = (unsigned)(KBYTES + (I - 13) * 1024); } }
    const int koff = kperm(n) * KST + hh * 16;
    const int g = lane >> 4, i16 = lane & 15;
    const int voff = KBYTES + (8 * (g >> 1) + (i16 >> 2)) * VST + (16 * (g & 1) + 4 * (i16 & 3)) * 2;
#define C_ISSUE(tt) do { const char* gb_ = gbase + (size_t)(tt) * (64 * INC * 2); const int so_ = ((tt) & 3) * STAGE; _Pragma("unroll") for (int j_ = 0; j_ < 4; ++j_) if (w + 8 * j_ < 25) \
        glds16(gb_ + goff[j_], (unsigned)__builtin_amdgcn_readfirstlane((int)(unsigned)(size_t)(F.lds + so_ + loff[j_]))); } while (0)
#define C_RDV(slotV, kbV, s2v) do { _Pragma("unroll") for (int d_ = 0; d_ < 3; ++d_) { const LAS unsigned char* vp_ = (slotV) + voff + ((kbV) * 32 + 16 * (s2v)) * VST + d_ * 64; \
            const s16x4 v0_ = ds_tr16(vp_), v1_ = ds_tr16(vp_ + 4 * VST); vf[d_] = (bf16x8){v0_[0], v0_[1], v0_[2], v0_[3], v1_[0], v1_[1], v1_[2], v1_[3]}; } } while (0)
#define C_FENCE __builtin_amdgcn_sched_barrier(0)
#define C_QK0(dst, slotbase) do { { const bf16x8 kf_ = *(const LAS bf16x8*)((slotbase) + koff); dst = __builtin_amdgcn_mfma_f32_32x32x16_bf16(kf_, qf[0][0], NEGR[0], 0, 0, 0); } \
        _Pragma("unroll") for (int s_ = 1; s_ < 3; ++s_) { const bf16x8 kf_ = *(const LAS bf16x8*)((slotbase) + koff + (2 * s_) * 16); dst = __builtin_amdgcn_mfma_f32_32x32x16_bf16(kf_, qf[0][s_], dst, 0, 0, 0); } } while (0)
#define C_ITEM(Sx, c, pout, pin, cp, slotVp, kbVp, slotKc, kbKc, slotKn, kbKn, cn) do { \
        _Pragma("unroll") for (int s2_ = 0; s2_ < 2; ++s2_) _Pragma("unroll") for (int d_ = 0; d_ < 3; ++d_) { const LAS unsigned char* vp_ = (slotVp) + voff + ((kbVp) * 32 + 16 * s2_) * VST + d_ * 64; \
            const s16x4 v0_ = ds_tr16(vp_), v1_ = ds_tr16(vp_ + 4 * VST); vf[s2_ * 3 + d_] = (bf16x8){v0_[0], v0_[1], v0_[2], v0_[3], v1_[0], v1_[1], v1_[2], v1_[3]}; } \
        _Pragma("unroll") for (int s_ = 0; s_ < 3; ++s_) kf[s_] = *(const LAS bf16x8*)((slotKn) + (kbKn) * 32 * KST + koff + ((cn) * 6 + 2 * s_) * 16); \
        C_FENCE; \
        const float lold_ = l[c]; \
        _Pragma("unroll") for (int r_ = 0; r_ < 16; ++r_) Sx[r_] = __builtin_amdgcn_exp2f(Sx[r_]); \
        float pm_ = fmaxf(fmaxf(Sx[0], Sx[1]), Sx[2]); _Pragma("unroll") for (int r_ = 3; r_ < 15; r_ += 2) pm_ = fmaxf(fmaxf(pm_, Sx[r_]), Sx[r_ + 1]); pm_ = fmaxf(pm_, Sx[15]); \
        _Pragma("unroll") for (int r_ = 0; r_ < 16; ++r_) l[c] += Sx[r_]; \
        _Pragma("unroll") for (int s2_ = 0; s2_ < 2; ++s2_) { v4u pw_; pw_.x = cvtpk(Sx[8 * s2_ + 0], Sx[8 * s2_ + 1]); pw_.y = cvtpk(Sx[8 * s2_ + 2], Sx[8 * s2_ + 3]); \
            pw_.z = cvtpk(Sx[8 * s2_ + 4], Sx[8 * s2_ + 5]); pw_.w = cvtpk(Sx[8 * s2_ + 6], Sx[8 * s2_ + 7]); pout[s2_] = __builtin_bit_cast(bf16x8, pw_); } \
        _Pragma("unroll") for (int s2_ = 0; s2_ < 2; ++s2_) _Pragma("unroll") for (int d_ = 0; d_ < 3; ++d_) O[cp][d_] = __builtin_amdgcn_mfma_f32_32x32x16_bf16(vf[s2_ * 3 + d_], pin[s2_], O[cp][d_], 0, 0, 0); \
        _Pragma("unroll") for (int g_ = 0; g_ < 6; ++g_) { __builtin_amdgcn_sched_group_barrier(0x008, 1, 0); __builtin_amdgcn_sched_group_barrier(0x400, 3, 0); __builtin_amdgcn_sched_group_barrier(0x002, 7, 0); } \
        C_FENCE; \
        pm_ = fmaxf(pm_, __shfl_xor(pm_, 32)); \
        if (__any(pm_ > PMAX) || first) { f32x16 Sr_; \
            { const bf16x8 k0_ = *(const LAS bf16x8*)((slotKc) + (kbKc) * 32 * KST + koff + ((c) * 6 + 0) * 16), k1_ = *(const LAS bf16x8*)((slotKc) + (kbKc) * 32 * KST + koff + ((c) * 6 + 2) * 16), k2_ = *(const LAS bf16x8*)((slotKc) + (kbKc) * 32 * KST + koff + ((c) * 6 + 4) * 16); \
              Sr_ = __builtin_amdgcn_mfma_f32_32x32x16_bf16(k0_, qf[c][0], NEGR[c], 0, 0, 0); Sr_ = __builtin_amdgcn_mfma_f32_32x32x16_bf16(k1_, qf[c][1], Sr_, 0, 0, 0); Sr_ = __builtin_amdgcn_mfma_f32_32x32x16_bf16(k2_, qf[c][2], Sr_, 0, 0, 0); } \
            float mx_ = fmax_nc(Sr_[0], Sr_[1]); _Pragma("unroll") for (int r_ = 2; r_ < 16; ++r_) mx_ = fmax_nc(mx_, Sr_[r_]); mx_ = fmaxf(mx_, __shfl_xor(mx_, 32)); \
            const float dl_ = (pm_ > PMAX || first) ? mx_ : 0.0f, al_ = __builtin_amdgcn_exp2f(-dl_); \
            _Pragma("unroll") for (int d_ = 0; d_ < 3; ++d_) _Pragma("unroll") for (int r_ = 0; r_ < 16; ++r_) O[c][d_][r_] *= al_; \
            float ls_ = lold_ * al_; \
            _Pragma("unroll") for (int r_ = 0; r_ < 16; ++r_) { NEGR[c][r_] -= dl_; Sr_[r_] = __builtin_amdgcn_exp2f(Sr_[r_] - dl_); ls_ += Sr_[r_]; } \
            l[c] = ls_; \
            _Pragma("unroll") for (int s2_ = 0; s2_ < 2; ++s2_) { v4u pw_; pw_.x = cvtpk(Sr_[8 * s2_ + 0], Sr_[8 * s2_ + 1]); pw_.y = cvtpk(Sr_[8 * s2_ + 2], Sr_[8 * s2_ + 3]); \
                pw_.z = cvtpk(Sr_[8 * s2_ + 4], Sr_[8 * s2_ + 5]); pw_.w = cvtpk(Sr_[8 * s2_ + 6], Sr_[8 * s2_ + 7]); pout[s2_] = __builtin_bit_cast(bf16x8, pw_); } } \
        C_FENCE; \
        Sx = __builtin_amdgcn_mfma_f32_32x32x16_bf16(kf[0], qf[cn][0], NEGR[cn], 0, 0, 0); Sx = __builtin_amdgcn_mfma_f32_32x32x16_bf16(kf[1], qf[cn][1], Sx, 0, 0, 0); Sx = __builtin_amdgcn_mfma_f32_32x32x16_bf16(kf[2], qf[cn][2], Sx, 0, 0, 0); \
        C_FENCE; } while (0)
    for (int unit = F.bid; unit < 512; unit += F.G) {
        const int b = unit >> 6, h = (unit >> 4) & 3, qb = unit & 15;
        const int tok = b * SEQ + qb * 256 + w * 32 + n;
        const char* gbase = (const char*)(H + (size_t)(b * SEQ) * INC + h * 96);
        C_ISSUE(0); C_ISSUE(1);
        bf16x8 qf[2][3];
        { const bf16* qp = H + (size_t)tok * INC + C_QC + h * 96 + 8 * hh;
#pragma unroll
          for (int c = 0; c < 2; ++c)
#pragma unroll
              for (int s = 0; s < 3; ++s) { const v4u qw = *(const v4u*)(qp + c * 48 + 16 * s);
                  v4u qs; qs.x = cvtpk(bflo(qw.x) * CS, bfhi(qw.x) * CS); qs.y = cvtpk(bflo(qw.y) * CS, bfhi(qw.y) * CS); qs.z = cvtpk(bflo(qw.z) * CS, bfhi(qw.z) * CS); qs.w = cvtpk(bflo(qw.w) * CS, bfhi(qw.w) * CS);
                  qf[c][s] = __builtin_bit_cast(bf16x8, qs); } }
        f32x16 O[2][3];
#pragma unroll
        for (int c = 0; c < 2; ++c)
#pragma unroll
            for (int d = 0; d < 3; ++d)
#pragma unroll
                for (int r = 0; r < 16; ++r) O[c][d][r] = 0.f;
        float l[2] = {0.f, 0.f};
        f32x16 NEGR[2];
#pragma unroll
        for (int c = 0; c < 2; ++c)
#pragma unroll
            for (int r = 0; r < 16; ++r) NEGR[c][r] = 0.f;
        f32x16 S; bf16x8 pa[2], pb[2], kf[3], vf[6];
        pb[0] = (bf16x8){0, 0, 0, 0, 0, 0, 0, 0}; pb[1] = pb[0];
        for (int t = 0; t < NT; ++t) {
            asm volatile("s_waitcnt vmcnt(0)" ::: "memory"); __builtin_amdgcn_s_barrier(); asm volatile("" ::: "memory");
            if (t + 2 < NT) C_ISSUE(t + 2);
            const LAS unsigned char* cur = F.lds + (t & 3) * STAGE;
            const LAS unsigned char* prv = F.lds + ((t > 0 ? t - 1 : 0) & 3) * STAGE;
            const LAS unsigned char* nxt = F.lds + ((t + 1 < NT ? t + 1 : t) & 3) * STAGE;
            if (t == 0) C_QK0(S, cur);
            { const bool first = (t == 0);
            C_ITEM(S, 0, pa, pb, 1, prv, 1, cur, 0, cur, 0, 1);
            C_ITEM(S, 1, pb, pa, 0, cur, 0, cur, 0, cur, 1, 0); }
            { const bool first = false;
            C_ITEM(S, 0, pa, pb, 1, cur, 0, cur, 1, cur, 1, 1);
            C_ITEM(S, 1, pb, pa, 0, cur, 1, cur, 1, nxt, 0, 0); }
        }
        { const LAS unsigned char* lastb = F.lds + ((NT - 1) & 3) * STAGE;
#pragma unroll
          for (int s2 = 0; s2 < 2; ++s2)
#pragma unroll
              for (int d = 0; d < 3; ++d) { const LAS unsigned char* vp = lastb + voff + (32 + 16 * s2) * VST + d * 64; const s16x4 v0 = ds_tr16(vp), v1 = ds_tr16(vp + 4 * VST);
                  const bf16x8 vfl = (bf16x8){v0[0], v0[1], v0[2], v0[3], v1[0], v1[1], v1[2], v1[3]}; O[1][d] = __builtin_amdgcn_mfma_f32_32x32x16_bf16(vfl, pb[s2], O[1][d], 0, 0, 0); } }
        const float l0 = l[0] + __shfl_xor(l[0], 32), l1 = l[1] + __shfl_xor(l[1], 32);
        const float i0 = 1.0f / l0, i1 = lam / l1;
        float ss = 0.f;
#pragma unroll
        for (int d = 0; d < 3; ++d)
#pragma unroll
            for (int r = 0; r < 16; ++r) { const float o = O[0][d][r] * i0 - O[1][d][r] * i1; O[0][d][r] = o; ss += o * o; }
        ss += __shfl_xor(ss, 32);
        const float rs = rsqrtf(ss * (1.0f / 96.0f) + LN_EPS) * post;
        bf16* yp = Y + (size_t)tok * YLD + Y_C + h * 96 + 4 * hh;
#pragma unroll
        for (int d = 0; d < 3; ++d)
#pragma unroll
            for (int rg = 0; rg < 4; ++rg) { const f32x4 gv = *(const f32x4*)(ng + d * 32 + 8 * rg + 4 * hh);
                v2u o; o.x = pk2(O[0][d][4 * rg + 0] * rs * gv[0], O[0][d][4 * rg + 1] * rs * gv[1]); o.y = pk2(O[0][d][4 * rg + 2] * rs * gv[2], O[0][d][4 * rg + 3] * rs * gv[3]);
                *(v2u*)(yp + d * 32 + 8 * rg) = o; }
        asm volatile("s_waitcnt vmcnt(0)" ::: "memory"); __builtin_amdgcn_s_barrier(); asm volatile("" ::: "memory");
    }
#undef C_ISSUE
#undef C_RDV
#undef C_ITEM
#undef C_QK0
#undef C_FENCE
}

constexpr int AB_VST = 192, AB_VREG = 32 * AB_VST;
constexpr int L_RPB = 51200;

__device__ __forceinline__ void sm_block64(f32x16& t, float& m, float& l, f32x16 (&O)[2], bf16x8 (&pf)[2]) {
    float mx = fmaxf(t[0], t[1]);
#pragma unroll
    for (int r = 2; r < 16; ++r) mx = fmaxf(mx, t[r]);
    mx = fmaxf(mx, __shfl_xor(mx, 32));
    if (__any(mx > m)) {
        const float mn = fmaxf(m, mx), alpha = __builtin_amdgcn_exp2f(m - mn);
#pragma unroll
        for (int d = 0; d < 2; ++d)
#pragma unroll
            for (int r = 0; r < 16; ++r) O[d][r] *= alpha;
        l *= alpha; m = mn;
    }
#pragma unroll
    for (int r = 0; r < 16; ++r) { t[r] = __builtin_amdgcn_exp2f(t[r] - m); l += t[r]; }
#pragma unroll
    for (int s2 = 0; s2 < 2; ++s2) { v4u pw; pw.x = cvtpk(t[8 * s2 + 0], t[8 * s2 + 1]); pw.y = cvtpk(t[8 * s2 + 2], t[8 * s2 + 3]);
        pw.z = cvtpk(t[8 * s2 + 4], t[8 * s2 + 5]); pw.w = cvtpk(t[8 * s2 + 6], t[8 * s2 + 7]); pf[s2] = __builtin_bit_cast(bf16x8, pw); }
}
template <class TokOf, class MaskT>
__device__ __forceinline__ void attn_run_blocks(const bf16* H, const int kcol, const int vcol, const int nb, const TokOf tok_of, const MaskT mask,
                                                const bf16x8 (&qf)[4], LAS unsigned char* vl, const int lane, f32x16 (&O)[2], float& m, float& l) {
    const int n = lane & 31, hh = lane >> 5, krow = kperm(n), g = lane >> 4, i16 = lane & 15;
    const int vrd = (8 * (g >> 1) + (i16 >> 2)) * AB_VST + (16 * (g & 1) + 4 * (i16 & 3)) * 2;
    bf16x8 kf[4]; v4u vc[4];
    { const bf16* kp = H + (size_t)tok_of(0, krow) * INC + kcol + 8 * hh;
#pragma unroll
      for (int s = 0; s < 4; ++s) kf[s] = *(const bf16x8*)(kp + 16 * s);
#pragma unroll
      for (int i = 0; i < 4; ++i) vc[i] = *(const v4u*)(H + (size_t)tok_of(0, (lane >> 3) + 8 * i) * INC + vcol + (lane & 7) * 8); }
#pragma unroll
    for (int i = 0; i < 4; ++i) *(LAS v4u*)(vl + ((lane >> 3) + 8 * i) * AB_VST + (lane & 7) * 16) = vc[i];
    for (int j = 0; j < nb; ++j) {
        const int jn = (j + 1 < nb) ? j + 1 : j;
        bf16x8 kn[4];
        { const bf16* kp = H + (size_t)tok_of(jn, krow) * INC + kcol + 8 * hh;
#pragma unroll
          for (int s = 0; s < 4; ++s) kn[s] = *(const bf16x8*)(kp + 16 * s);
#pragma unroll
          for (int i = 0; i < 4; ++i) vc[i] = *(const v4u*)(H + (size_t)tok_of(jn, (lane >> 3) + 8 * i) * INC + vcol + (lane & 7) * 8); }
        f32x16 S;
#pragma unroll
        for (int r = 0; r < 16; ++r) S[r] = 0.f;
#pragma unroll
        for (int s = 0; s < 4; ++s) S = __builtin_amdgcn_mfma_f32_32x32x16_bf16(kf[s], qf[s], S, 0, 0, 0);
        mask(j, S);
        bf16x8 pf[2];
        sm_block64(S, m, l, O, pf);
        LDS_WAIT();
#pragma unroll
        for (int s2 = 0; s2 < 2; ++s2)
#pragma unroll
            for (int d = 0; d < 2; ++d) { const LAS unsigned char* vp = vl + vrd + 16 * s2 * AB_VST + d * 64;
                const s16x4 v0 = ds_tr16(vp), v1 = ds_tr16(vp + 4 * AB_VST);
                const bf16x8 vf = (bf16x8){v0[0], v0[1], v0[2], v0[3], v1[0], v1[1], v1[2], v1[3]};
                O[d] = __builtin_amdgcn_mfma_f32_32x32x16_bf16(vf, pf[s2], O[d], 0, 0, 0); }
        LDS_WAIT(); asm volatile("" ::: "memory");
#pragma unroll
        for (int i = 0; i < 4; ++i) *(LAS v4u*)(vl + ((lane >> 3) + 8 * i) * AB_VST + (lane & 7) * 16) = vc[i];
#pragma unroll
        for (int s = 0; s < 4; ++s) kf[s] = kn[s];
    }
    LDS_WAIT(); asm volatile("" ::: "memory");
}
__device__ __forceinline__ void attn_store64(bf16* yrow, const f32x16 (&O)[2], float l, int hh) {
    const float lt = l + __shfl_xor(l, 32), inv = 1.0f / lt;
#pragma unroll
    for (int d = 0; d < 2; ++d)
#pragma unroll
        for (int rg = 0; rg < 4; ++rg) { v2u o; o.x = pk2(O[d][4 * rg + 0] * inv, O[d][4 * rg + 1] * inv); o.y = pk2(O[d][4 * rg + 2] * inv, O[d][4 * rg + 3] * inv);
            *(v2u*)(yrow + d * 32 + 8 * rg + 4 * hh) = o; }
}

__device__ __forceinline__ void attnA_mfma(Frame& F, const float* rpb  ) {
    const bf16* H = (const bf16*)(F.ws + WS_H); bf16* Y = (bf16*)(F.ws + WS_Y);
    LAS float* T = (LAS float*)(F.lds + L_RPB);
    for (int i = F.tid; i < 4 * 17 * 64; i += 512) { const int h = i / (17 * 64), rem = i - h * 17 * 64, ro = rem >> 6, co = rem & 63;
        const int rr = ro - 1, cc = co - 16; T[i] = (rr >= 0 && rr < 15 && cc >= 0 && cc < 31) ? rpb[(h * 15 + rr) * 31 + cc] * 1.4426950408889634f : 0.f; }
    __syncthreads();
    const int lane = F.lane, n = lane & 31, hh = lane >> 5;
    LAS unsigned char* vl = F.lds + F.wave * AB_VREG;
    const int gw = F.bid * 8 + F.wave, NGW = F.G * 8;
    for (int item = gw; item < 4096; item += NGW) {
        const int cb = item & 3, rp = (item >> 2) & 31, h = (item >> 7) & 3, b = item >> 9;
        const int r = 2 * rp + (n >> 4), c = 16 * cb + (n & 15);
        const int r0 = min(max(r - 4, 0), 56), c0 = min(max(c - 8, 0), 48);
        const int cw = min(max(16 * cb - 8, 0), 32);
        const int kr_lo = min(max(2 * rp - 4, 0), 56), kr_hi = min(max(2 * rp + 1 - 4, 0), 56) + 7;
        const int tokq = b * SEQ + r * 64 + c;
        bf16x8 qf[4];
        { const bf16* qp = H + (size_t)tokq * INC + C_QA + h * 64 + 8 * hh;
#pragma unroll
          for (int s = 0; s < 4; ++s) qf[s] = *(const bf16x8*)(qp + 16 * s); }
        f32x16 O[2];
#pragma unroll
        for (int d = 0; d < 2; ++d)
#pragma unroll
            for (int rr = 0; rr < 16; ++rr) O[d][rr] = 0.f;
        float m = -1e30f, l = 0.f;
        const int tok0 = b * SEQ + kr_lo * 64 + cw;
        auto tok_of = [=](int j, int kk) { return tok0 + j * 64 + kk; };
        const int colb = cw - c0 + 8 * hh;
        const int tb0 = (h * 17 + (kr_lo - r + 8)) * 64 + (cw - c + 31) + 8 * hh;
        const int rb = kr_lo - r0;
        auto mask = [=](int j, f32x16& S) {
            const bool rowok = (unsigned)(rb + j) < 8u; const LAS float* tp = T + tb0 + j * 64;
#pragma unroll
            for (int rr = 0; rr < 16; ++rr) { const int e = (rr & 7) + 16 * (rr >> 3);
                const bool ok = rowok && ((unsigned)(colb + e) < 16u);
                S[rr] = ok ? (S[rr] * (0.125f * 1.4426950408889634f) + tp[e]) : -INFINITY; }
        };
        attn_run_blocks(H, C_KA + h * 64, C_VA + h * 64, kr_hi - kr_lo + 1, tok_of, mask, qf, vl, lane, O, m, l);
        attn_store64(Y + (size_t)tokq * YLD + Y_A + h * 64, O, l, hh);
    }
}
__device__ __forceinline__ void attnB_mfma(Frame& F) {
    const bf16* H = (const bf16*)(F.ws + WS_H); bf16* Y = (bf16*)(F.ws + WS_Y);
    const int lane = F.lane, n = lane & 31, hh = lane >> 5;
    LAS unsigned char* vl = F.lds + F.wave * AB_VREG;
    const int gw = F.bid * 8 + F.wave, NGW = F.G * 8;
    for (int item = gw; item < 2048; item += NGW) {
        const int mblk = item & 7, r = (item >> 3) & 15, hg = (item >> 7) & 1, b = item >> 8;
        const int sq = r + 16 * (mblk * 32 + n), tokq = b * SEQ + sq;
        f32x16 O[2];
#pragma unroll
        for (int d = 0; d < 2; ++d)
#pragma unroll
            for (int rr = 0; rr < 16; ++rr) O[d][rr] = 0.f;
        float m = -1e30f, l = 0.f;
#pragma unroll 1
        for (int g = 0; g < 3; ++g) {
            const int sh = 2 * g, dil = 1 << sh, head = 2 * g + hg, L = SEQ >> sh, a = 16 >> sh, cls = r & (dil - 1);
            const int pq0 = (r >> sh) + a * (mblk * 32), pq = pq0 + a * n;
            const int pks = pq0 - 64, nb = (31 * a + 129 + 31) >> 5;
            bf16x8 qf[4];
            { const bf16* qp = H + (size_t)tokq * INC + C_QB + head * 64 + 8 * hh;
#pragma unroll
              for (int s = 0; s < 4; ++s) qf[s] = *(const bf16x8*)(qp + 16 * s); }
            const int tokb = b * SEQ + cls;
            auto tok_of = [=](int j, int kk) { const int pk = min(max(pks + 32 * j + kk, 0), L - 1); return tokb + (pk << sh); };
            const int b1 = pks - pq + 64 + 8 * hh, b2 = pks + 8 * hh;
            auto mask = [=](int j, f32x16& S) {
#pragma unroll
                for (int rr = 0; rr < 16; ++rr) { const int e = (rr & 7) + 16 * (rr >> 3) + 32 * j;
                    const bool ok = ((unsigned)(b1 + e) <= 128u) && ((unsigned)(b2 + e) < (unsigned)L);
                    S[rr] = ok ? S[rr] * (0.125f * 1.4426950408889634f) : -INFINITY; }
            };
            attn_run_blocks(H, C_KB + head * 64, C_VB + head * 64, nb, tok_of, mask, qf, vl, lane, O, m, l);
        }
        attn_store64(Y + (size_t)tokq * YLD + Y_B + hg * 64, O, l, hh);
    }
}

__device__ __forceinline__ void p_ln_router(Frame& F, const Args& a, int layer, bool dry = false) {
    const bf16* PRE = (const bf16*)(F.ws + WS_HH); float* XF = dry ? (float*)(F.ws + WS_H) : a.out; unsigned* XB8 = dry ? (unsigned*)(F.ws + WS_H + 160 * MiB) : (unsigned*)(F.ws + WS_XB8);
    const float* g1 = a.in[10] + layer * 1024; const float* b1 = a.in[11] + layer * 1024; const float* br = a.in[13] + layer * 32;
    const bf16* WT = (const bf16*)(F.ws + WS_WRT) + (size_t)layer * 2 * 32 * 1024;
    int* TOPE = (int*)(F.ws + (dry ? WS_H + 200 * MiB : WS_TOPE)); float* TOPW = (float*)(F.ws + (dry ? WS_H + 201 * MiB : WS_TOPW)); int* RANK = (int*)(F.ws + (dry ? WS_H + 202 * MiB : WS_RANK));
    const int cnt_off = dry ? CW_CUR : CW_CNT; int* SRCp = (int*)(F.ws + (dry ? WS_H + 204 * MiB : WS_SRC));
    LAS int* hist = (LAS int*)(F.lds + L_HIST); LAS int* base = (LAS int*)(F.lds + L_BASE);
    const int lane = F.lane;
    for (int chunk = F.bid; chunk < NTOK / 128; chunk += F.G) {
        if (F.tid < 32) hist[F.tid] = 0;
        __syncthreads();
        const int tok0 = chunk * 128 + F.wave * 16;
        {   f32x4 gv[4], bv[4];
#pragma unroll
            for (int j = 0; j < 4; ++j) { gv[j] = *(const f32x4*)(g1 + 4 * lane + 256 * j); bv[j] = *(const f32x4*)(b1 + 4 * lane + 256 * j); }
#pragma unroll 1
            for (int q = 0; q < 4; ++q) {
                f32x4 v[4][4]; float s[4], s2[4];
#pragma unroll
                for (int t = 0; t < 4; ++t) { const v2u* pr = (const v2u*)(PRE + (size_t)(tok0 + 4 * q + t) * 1024) + lane;
#pragma unroll
                    for (int j = 0; j < 4; ++j) { const v2u pw = pr[64 * j]; v[t][j] = (f32x4){bflo(pw.x), bfhi(pw.x), bflo(pw.y), bfhi(pw.y)}; } }
#pragma unroll
                for (int t = 0; t < 4; ++t) { s[t] = 0.f;
#pragma unroll
                    for (int j = 0; j < 4; ++j) s[t] += (v[t][j][0] + v[t][j][1]) + (v[t][j][2] + v[t][j][3]); }
#pragma unroll
                for (int o = 1; o < 64; o <<= 1) {
#pragma unroll
                    for (int t = 0; t < 4; ++t) s[t] += __shfl_xor(s[t], o); }
#pragma unroll
                for (int t = 0; t < 4; ++t) { const float mean = s[t] * (1.f / 1024.f); s2[t] = 0.f;
#pragma unroll
                    for (int j = 0; j < 4; ++j) { v[t][j] = v[t][j] - mean; s2[t] += (v[t][j][0] * v[t][j][0] + v[t][j][1] * v[t][j][1]) + (v[t][j][2] * v[t][j][2] + v[t][j][3] * v[t][j][3]); } }
#pragma unroll
                for (int o = 1; o < 64; o <<= 1) {
#pragma unroll
                    for (int t = 0; t < 4; ++t) s2[t] += __shfl_xor(s2[t], o); }
#pragma unroll
                for (int t = 0; t < 4; ++t) { const float rstd = rsqrtf(s2[t] * (1.f / 1024.f) + LN_EPS);
                    f32x4* xo = (f32x4*)(XF + (size_t)(tok0 + 4 * q + t) * 1024) + lane; unsigned* xb = XB8 + (size_t)(tok0 + 4 * q + t) * 256 + lane;
#pragma unroll
                    for (int j = 0; j < 4; ++j) { const f32x4 y = v[t][j] * rstd * gv[j] + bv[j]; xo[64 * j] = y; xb[64 * j] = pk4_fp8(y[0], y[1], y[2], y[3], 1.0f); } }
            }
        }
        VM_WAIT(); asm volatile("" ::: "memory");
        const int tk = lane & 15, kq = lane >> 4;
        f32x4 acc[2] = {(f32x4){0.f, 0.f, 0.f, 0.f}, (f32x4){0.f, 0.f, 0.f, 0.f}};
        {   const float* xf = XF + (size_t)(tok0 + tk) * 1024 + 8 * kq;
            const bf16* w0 = WT + (size_t)tk * 1024 + 8 * kq;
#pragma unroll 4
            for (int st = 0; st < 32; ++st) {
                const f32x4 x0 = *(const f32x4*)(xf + 32 * st), x1 = *(const f32x4*)(xf + 32 * st + 4);
                v4u xhw; xhw.x = pk2(x0[0], x0[1]); xhw.y = pk2(x0[2], x0[3]); xhw.z = pk2(x1[0], x1[1]); xhw.w = pk2(x1[2], x1[3]);
                v4u xlw; xlw.x = pk2(x0[0] - bflo(xhw.x), x0[1] - bfhi(xhw.x)); xlw.y = pk2(x0[2] - bflo(xhw.y), x0[3] - bfhi(xhw.y));
                xlw.z = pk2(x1[0] - bflo(xhw.z), x1[1] - bfhi(xhw.z)); xlw.w = pk2(x1[2] - bflo(xhw.w), x1[3] - bfhi(xhw.w));
                const bf16x8 xh = __builtin_bit_cast(bf16x8, xhw), xl = __builtin_bit_cast(bf16x8, xlw);
#pragma unroll
                for (int mb = 0; mb < 2; ++mb) { const bf16x8 wh = *(const bf16x8*)(w0 + (size_t)mb * 16 * 1024 + 32 * st), wl = *(const bf16x8*)(w0 + (size_t)(32 + mb * 16) * 1024 + 32 * st);
                    acc[mb] = __builtin_amdgcn_mfma_f32_16x16x32_bf16(wh, xh, acc[mb], 0, 0, 0);
                    acc[mb] = __builtin_amdgcn_mfma_f32_16x16x32_bf16(wh, xl, acc[mb], 0, 0, 0);
                    acc[mb] = __builtin_amdgcn_mfma_f32_16x16x32_bf16(wl, xh, acc[mb], 0, 0, 0); }
            }
        }
        float v8[8];
#pragma unroll
        for (int mb = 0; mb < 2; ++mb)
#pragma unroll
            for (int i = 0; i < 4; ++i) v8[mb * 4 + i] = acc[mb][i] + br[16 * mb + 4 * kq + i];
        int se[4]; float sv[4];
#pragma unroll
        for (int r = 0; r < 4; ++r) {
            float bvv = v8[0]; int bi = 4 * kq;
#pragma unroll
            for (int sl = 1; sl < 8; ++sl) { const int eid = 16 * (sl >> 2) + 4 * kq + (sl & 3); if (v8[sl] > bvv) { bvv = v8[sl]; bi = eid; } }
#pragma unroll
            for (int o = 16; o < 64; o <<= 1) { const float ov = __shfl_xor(bvv, o); const int oi = __shfl_xor(bi, o);
                if (ov > bvv || (ov == bvv && oi < bi)) { bvv = ov; bi = oi; } }
            se[r] = bi; sv[r] = bvv;
#pragma unroll
            for (int sl = 0; sl < 8; ++sl) { const int eid = 16 * (sl >> 2) + 4 * kq + (sl & 3); if (eid == bi) v8[sl] = -3.0e38f; }
        }
        const float p1 = __expf(sv[1] - sv[0]), p2 = __expf(sv[2] - sv[0]), p3 = __expf(sv[3] - sv[0]);
        const float inv = 1.0f / (1.0f + p1 + p2 + p3);
        int lr[4] = {0, 0, 0, 0};
        if (lane < 16) { const int tok = tok0 + tk;
            *(int4*)(TOPE + tok * 4) = make_int4(se[0], se[1], se[2], se[3]);
            *(f32x4*)(TOPW + tok * 4) = (f32x4){inv, p1 * inv, p2 * inv, p3 * inv};
#pragma unroll
            for (int k = 0; k < 4; ++k) lr[k] = __hip_atomic_fetch_add(&hist[se[k]], 1, __ATOMIC_RELAXED, __HIP_MEMORY_SCOPE_WORKGROUP); }
        __syncthreads();
        if (F.tid < 32) { const int c = hist[F.tid]; base[F.tid] = c ? (int)__hip_atomic_fetch_add(F.ctl + cnt_off + layer * 64 + F.tid, (unsigned)c, RLX_AGENT) : 0; }
        __syncthreads();
        if (lane < 16) { const int tok = tok0 + tk;
            const int r0 = base[se[0]] + lr[0], r1 = base[se[1]] + lr[1], r2 = base[se[2]] + lr[2], r3 = base[se[3]] + lr[3];
            *(int4*)(RANK + tok * 4) = make_int4(r0, r1, r2, r3);
            int* SRC = SRCp; SRC[se[0] * NTOK + r0] = tok; SRC[se[1] * NTOK + r1] = tok; SRC[se[2] * NTOK + r2] = tok; SRC[se[3] * NTOK + r3] = tok; }
        __syncthreads();
    }
}

__device__ __forceinline__ int moe_build(Frame& F, int layer) {
    LAS int* offT = (LAS int*)(F.lds + L_OFFT); LAS int* tile_e = (LAS int*)(F.lds + L_TILE);
    __syncthreads();
    if (F.tid < 64) {
        const int c = (F.lane < 32) ? (int)__hip_atomic_load(F.ctl + CW_CNT + layer * 64 + F.lane, RLX_AGENT) : 0;
        const int ntile = (c + 255) >> 8; int x = ntile;
#pragma unroll
        for (int d = 1; d < 32; d <<= 1) { const int v = __shfl_up(x, d); if (F.lane >= d) x += v; }
        if (F.lane < 32) { offT[F.lane] = x - ntile; ((LAS int*)(F.lds + L_CNT))[F.lane] = c; }
        if (F.lane == 31) offT[32] = x;
    }
    __syncthreads();
    int T = __builtin_amdgcn_readfirstlane(offT[32]); if (T > MAXT) T = MAXT;
    for (int mt = F.tid; mt < T; mt += 512) { int e = 0;
#pragma unroll 1
        for (int j = 1; j < 32; ++j) if (offT[j] <= mt) e = j;
        tile_e[mt] = e; }
    __syncthreads();
    return T;
}

__device__ __forceinline__ void p_combine_ln(Frame& F, const Args& a, int layer, bool dry = false) {
    const bool last_layer = (layer == DEPTH - 1) || dry;
    float* XF = a.out; float* XFo = dry ? (float*)(F.ws + WS_HH) : a.out; bf16* XB = (bf16*)(F.ws + (dry ? WS_M : WS_XB)); const bf16* YS = (const bf16*)(F.ws + WS_H);
    const int* TOPE = (const int*)(F.ws + WS_TOPE); const int* RANK = (const int*)(F.ws + WS_RANK); const float* TOPW = (const float*)(F.ws + WS_TOPW);
    const LAS int* offT = (const LAS int*)(F.lds + L_OFFT);
    const float* g2 = a.in[20] + layer * 1024; const float* b2 = a.in[21] + layer * 1024;
    const int gw = F.bid * 8 + F.wave, NGW = F.G * 8, lane = F.lane;
    f32x4 gv[4], bv[4];
#pragma unroll
    for (int j = 0; j < 4; ++j) { gv[j] = *(const f32x4*)(g2 + 4 * lane + 256 * j); bv[j] = *(const f32x4*)(b2 + 4 * lane + 256 * j); }
    for (int tp = gw; tp < NTOK / 2; tp += NGW) {
        f32x4 v[2][4]; v2u yw[2][4][4]; f32x4 tw[2];
#pragma unroll
        for (int u = 0; u < 2; ++u) { const int tok = tp * 2 + u;
            const int4 te = *(const int4*)(TOPE + tok * 4), rk = *(const int4*)(RANK + tok * 4); tw[u] = *(const f32x4*)(TOPW + tok * 4);
            const f32x4* xr = (const f32x4*)(XF + (size_t)tok * 1024) + lane;
#pragma unroll
            for (int j = 0; j < 4; ++j) v[u][j] = xr[64 * j];
            const int pk[4] = {offT[te.x] * 256 + rk.x, offT[te.y] * 256 + rk.y, offT[te.z] * 256 + rk.z, offT[te.w] * 256 + rk.w};
#pragma unroll
            for (int k = 0; k < 4; ++k) { const v2u* yr = (const v2u*)(YS + (size_t)pk[k] * 1024) + lane;
#pragma unroll
                for (int j = 0; j < 4; ++j) yw[u][k][j] = yr[64 * j]; } }
        float s[2], s2[2];
#pragma unroll
        for (int u = 0; u < 2; ++u) {
#pragma unroll
            for (int j = 0; j < 4; ++j) { v[u][j] = v[u][j] * DN_ALPHA;
#pragma unroll
                for (int k = 0; k < 4; ++k) { const v2u y = yw[u][k][j]; v[u][j] = v[u][j] + tw[u][k] * (f32x4){bflo(y.x), bfhi(y.x), bflo(y.y), bfhi(y.y)}; } }
            s[u] = 0.f;
#pragma unroll
            for (int j = 0; j < 4; ++j) s[u] += (v[u][j][0] + v[u][j][1]) + (v[u][j][2] + v[u][j][3]); }
#pragma unroll
        for (int o = 1; o < 64; o <<= 1) { s[0] += __shfl_xor(s[0], o); s[1] += __shfl_xor(s[1], o); }
#pragma unroll
        for (int u = 0; u < 2; ++u) { const float mean = s[u] * (1.f / 1024.f); s2[u] = 0.f;
#pragma unroll
            for (int j = 0; j < 4; ++j) { v[u][j] = v[u][j] - mean; s2[u] += (v[u][j][0] * v[u][j][0] + v[u][j][1] * v[u][j][1]) + (v[u][j][2] * v[u][j][2] + v[u][j][3] * v[u][j][3]); } }
#pragma unroll
        for (int o = 1; o < 64; o <<= 1) { s2[0] += __shfl_xor(s2[0], o); s2[1] += __shfl_xor(s2[1], o); }
#pragma unroll
        for (int u = 0; u < 2; ++u) { const int tok = tp * 2 + u; const float rstd = rsqrtf(s2[u] * (1.f / 1024.f) + LN_EPS);
            f32x4* xo = (f32x4*)(XFo + (size_t)tok * 1024) + lane; v2u* xb = (v2u*)(XB + (size_t)tok * 1024) + lane; unsigned* x8 = (unsigned*)(F.ws + (dry ? WS_M + 32 * MiB : WS_XB8)) + (size_t)tok * 256 + lane;
#pragma unroll
            for (int j = 0; j < 4; ++j) { const f32x4 y = v[u][j] * rstd * gv[j] + bv[j]; if (last_layer) xo[64 * j] = y; xb[64 * j] = (v2u){pk2(y[0], y[1]), pk2(y[2], y[3])}; x8[64 * j] = pk4_fp8(y[0], y[1], y[2], y[3], 1.0f); } }
    }
}

__device__ __forceinline__ const Args* fresh_args() { unsigned long long p = (unsigned long long)__builtin_amdgcn_kernarg_segment_ptr(); asm volatile("" : "+s"(p)); return (const Args*)(const __attribute__((address_space(4))) void*)p; }
constexpr int PH_PER_LAYER = 10, N_PHASES = 1 + DEPTH * PH_PER_LAYER;
__global__ void __launch_bounds__(512, 2) mk_fwd(Args args) {
    extern __shared__ __attribute__((aligned(16))) unsigned char lds[];
    Frame F;
    F.lds = (LAS unsigned char*)lds; F.tid = threadIdx.x; F.lane = F.tid & 63; F.wave = __builtin_amdgcn_readfirstlane(F.tid >> 6);
    F.G = gridDim.x; F.bid = blockIdx.x; F.ws = fresh_args()->ws; F.ctl = (unsigned*)(F.ws + WS_CTL);
    for (int u = F.tid; u < (LDS_BYTES - LDSCTL_OFF) / 4; u += 512) ((LAS unsigned*)(F.lds + LDSCTL_OFF))[u] = 0u;
    __syncthreads();
    const int lo = fresh_args()->ph_lo, hi = fresh_args()->ph_hi;
    XcdBarrier bar; bar.bar = F.ctl + CW_BAR; bar.x = 0; bar.st = nullptr;
    if (hi - lo > 1) bar = xcd_barrier_post(F.ctl + CW_BAR, (volatile LAS unsigned*)(F.lds + L_MISC) + 8);
#define IN(k) (lo <= (k) && (k) < hi)
#define REFRESH() do { F.tid = opaque_tid(); F.lane = F.tid & 63; F.wave = __builtin_amdgcn_readfirstlane(F.tid >> 6); asm volatile("" : "+s"(F.bid), "+s"(F.G)); } while (0)
#define SEAM(k) do { if ((k) + 1 < hi) xcd_barrier(bar); } while (0)

#ifndef NO_P0
    if (IN(0)) { _Pragma("unroll") for (int rep = 0; rep < REP_T; ++rep) p_prologue(F, *fresh_args()); SEAM(0); }
#endif

    for (int l = 0; l < DEPTH; ++l) {
        const int pb = 1 + l * PH_PER_LAYER;
#ifndef NO_P1
        if (IN(pb + 0)) {
            REFRESH();
            {
                pg8::DenseOrder S{(const char*)(F.ws + WS_XB), (const char*)(F.ws + WS_WIN) + (size_t)l * INC * 1024 * 2, (size_t)256 * 1024 * 2, (size_t)256 * 1024 * 2, 16, NTOK / 256, 12, F.G, F.bid};
                pg8::EpiInProj E{(bf16*)(F.ws + WS_H), fresh_args()->in[2] + l * 3072, (const f32x2*)(F.ws + WS_ROPE64), (const f32x2*)(F.ws + WS_ROPE48), 1.0f, (unsigned char*)(F.ws + WS_G8), F.lds};
                _Pragma("unroll") for (int rep = 0; rep < REP_G1; ++rep) pg8::gemm_phase<pg8::EpiInProj, pg8::DenseOrder, true, true>(F.lds, 1024, 1024, S, E);
            }
            {
                REFRESH();
                pg8::DenseOrder S{(const char*)(F.ws + WS_XB8), (const char*)(F.ws + WS_WIN8) + (size_t)l * 3072 * 1024, (size_t)256 * 1024, (size_t)256 * 1024, 8, NTOK / 256, 12, F.G, F.bid, 12};
                pg8::EpiInProj E{(bf16*)(F.ws + WS_H), fresh_args()->in[2] + l * 3072, (const f32x2*)(F.ws + WS_ROPE64), (const f32x2*)(F.ws + WS_ROPE48), 1.0f / 32.0f, (unsigned char*)(F.ws + WS_G8), F.lds};
                _Pragma("unroll") for (int rep = 0; rep < REP_G1; ++rep) pg8::gemm_phase<pg8::EpiInProj, pg8::DenseOrder, true, true, true>(F.lds, 1024, 1024, S, E);
            }
            if (pb + 2 < hi) xcd_barrier(bar);
        }
#endif
#ifndef NO_P1B
#endif
        if (IN(pb + 2)) {
            REFRESH();
#ifndef NO_PC
            _Pragma("unroll") for (int rep = 0; rep < REP_C; ++rep) attnC_pipe(F, fresh_args()->in[8] + l * 4 * 48, fresh_args()->in[9] + l * 96, fresh_args()->lam_init[l]);
#endif
#ifndef NO_PA
            REFRESH();
            _Pragma("unroll") for (int rep = 0; rep < REP_AB; ++rep) attnA_mfma(F, fresh_args()->in[7] + l * 4 * 15 * 31);
#endif
#ifndef NO_PB
            REFRESH();
            _Pragma("unroll") for (int rep = 0; rep < REP_AB; ++rep) attnB_mfma(F);
#endif
            SEAM(pb + 2);
        }
#ifndef NO_P3
        if (IN(pb + 3)) {
            REFRESH();
            pg8::ProjOrder S{(const char*)(F.ws + WS_Y), (const char*)(F.ws + WS_WPROJ) + (size_t)l * 1024 * WPK * 2, NTOK / 256, 4, F.G, F.bid};
            pg8::EpiProj E{(const unsigned char*)(F.ws + WS_G8), (bf16*)(F.ws + WS_M)};
            _Pragma("unroll") for (int rep = 0; rep < REP_G3; ++rep) pg8::gemm_phase<pg8::EpiProj, pg8::ProjOrder, true, true>(F.lds, YLD, WPK, S, E);
            SEAM(pb + 3);
        }
#endif
#ifndef NO_P4
        if (IN(pb + 4)) {
            REFRESH();
            pg8::DenseOrder S{(const char*)(F.ws + WS_M), (const char*)(F.ws + WS_WOUT) + (size_t)l * 1024 * 1024 * 2, (size_t)256 * 1024 * 2, (size_t)256 * 1024 * 2, 16, NTOK / 256, 4, F.G, F.bid};
            pg8::EpiOut E{l == 0 ? fresh_args()->in[0] : (const float*)nullptr, (const bf16*)(F.ws + WS_XB), (bf16*)(F.ws + WS_HH)};
            _Pragma("unroll") for (int rep = 0; rep < REP_G4; ++rep) pg8::gemm_phase<pg8::EpiOut, pg8::DenseOrder, true, true>(F.lds, 1024, 1024, S, E);
            SEAM(pb + 4);
        }
#endif
#ifndef NO_P5
        if (IN(pb + 5)) { REFRESH(); if (DRY_P5) p_ln_router(F, *fresh_args(), l, true); p_ln_router(F, *fresh_args(), l); if (pb + 7 < hi) xcd_barrier(bar); }
#endif
#ifndef NO_P5B
#endif
#ifndef NO_P6
        if (IN(pb + 7)) {
            REFRESH(); const int T = moe_build(F, l);
            pg8::MoeOrder S{(const char*)(F.ws + WS_XB8), (const char*)(F.ws + WS_WGU) + (size_t)l * NEXP * 2048 * 1024, (size_t)2048 * 1024, (size_t)256 * 1024, (size_t)256 * 1024, 8,
                            (const LAS int*)(F.lds + L_TILE), (const LAS int*)(F.lds + L_OFFT), (const LAS int*)(F.lds + L_CNT), (const int*)(F.ws + WS_SRC), T, 8, F.G, F.bid};
            pg8::EpiSwiglu E{(unsigned char*)(F.ws + WS_HH), fresh_args()->in[15] + (size_t)l * NEXP * 1024, fresh_args()->in[17] + (size_t)l * NEXP * 1024, 1.0f / 32.0f, F.lds};
            _Pragma("unroll") for (int rep = 0; rep < REP_G6; ++rep) pg8::gemm_phase_gather<pg8::EpiSwiglu, pg8::MoeOrder, true>(F.lds, (const char*)(F.ws + WS_XB8), 1024, 1024, S, E);
            SEAM(pb + 7);
        }
#endif
#ifndef NO_P7
        if (IN(pb + 8)) {
            REFRESH(); const int T = moe_build(F, l);
            pg8::MoeOrder S{(const char*)(F.ws + WS_HH), (const char*)(F.ws + WS_WDN) + (size_t)l * NEXP * 1024 * 1024, (size_t)1024 * 1024, (size_t)256 * 1024, (size_t)256 * 1024, 8,
                            (const LAS int*)(F.lds + L_TILE), (const LAS int*)(F.lds + L_OFFT), (const LAS int*)(F.lds + L_CNT), (const int*)(F.ws + WS_SRC), T, 4, F.G, F.bid};
            pg8::EpiDown E{(bf16*)(F.ws + WS_H), fresh_args()->in[19] + (size_t)l * NEXP * 1024, 1.0f / 256.0f, F.lds};
            _Pragma("unroll") for (int rep = 0; rep < REP_G7; ++rep) pg8::gemm_phase<pg8::EpiDown, pg8::MoeOrder, true, true, true>(F.lds, 1024, 1024, S, E);
            SEAM(pb + 8);
        }
#endif
#ifndef NO_P8
        if (IN(pb + 9)) { REFRESH(); (void)moe_build(F, l); if (DRY_P8) p_combine_ln(F, *fresh_args(), l, true); p_combine_ln(F, *fresh_args(), l); SEAM(pb + 9); }
#endif
    }
#undef IN
#undef SEAM
}

extern "C" void kernel_launch(void* const* d_in, const int* in_sizes, int n_in, void* d_out, int out_size, void* d_ws, size_t ws_size, hipStream_t stream) {
    static int grid = 0;
    if (grid == 0) {
        if (n_in != 22 || in_sizes[0] != NTOK * D || out_size != NTOK * D || ws_size < WS_END) {
            fprintf(stderr, "kernel_launch: unexpected shapes (n_in %d, in0 %d, out %d, ws %zu); nothing launched\n", n_in, n_in > 0 ? in_sizes[0] : -1, out_size, ws_size); grid = -1; return; }
        int dev = 0, cus = 0, per_cu = 0;
        if (hipGetDevice(&dev) != hipSuccess || hipDeviceGetAttribute(&cus, hipDeviceAttributeMultiprocessorCount, dev) != hipSuccess) { grid = -1; return; }
        if (hipFuncSetAttribute((const void*)mk_fwd, hipFuncAttributeMaxDynamicSharedMemorySize, LDS_BYTES) != hipSuccess) { fprintf(stderr, "kernel_launch: hipFuncSetAttribute failed\n"); grid = -1; return; }
        if (hipOccupancyMaxActiveBlocksPerMultiprocessor(&per_cu, (const void*)mk_fwd, 512, LDS_BYTES) != hipSuccess || per_cu < 1)
            fprintf(stderr, "kernel_launch: note: occupancy query reports %d workgroups per CU\n", per_cu);
        (void)hipGetLastError();
        grid = cus;
    }
    if (grid < 0) return;
    if (hipMemsetAsync((char*)d_ws + WS_CTL, 0, CTL_ZERO_BYTES, stream) != hipSuccess) { fprintf(stderr, "kernel_launch: memset failed\n"); return; }
    Args a{};
    for (int i = 0; i < 22; ++i) a.in[i] = (const float*)d_in[i];
    a.out = (float*)d_out; a.ws = (unsigned char*)d_ws;
    for (int l = 0; l < DEPTH; ++l) a.lam_init[l] = (float)(0.8 - 0.6 * exp(-0.3 * (double)l));
#if MK_ONE_LAUNCH
    a.ph_lo = 0; a.ph_hi = N_PHASES;
    hipLaunchKernelGGL(mk_fwd, dim3(grid), dim3(512), LDS_BYTES, stream, a);
#else
    for (int p = 0; p < N_PHASES; ++p) {
        a.ph_lo = p; a.ph_hi = p + 1;
        hipLaunchKernelGGL(mk_fwd, dim3(grid), dim3(512), LDS_BYTES, stream, a);
    }
#endif
    const hipError_t le = hipPeekAtLastError();
    if (le != hipSuccess) fprintf(stderr, "kernel_launch: launch failed: %s\n", hipGetErrorName(le));
}
```

```cpp
#include <hip/hip_runtime.h>
#include <cstdio>
#include <cstdint>
#include <cmath>

#ifndef REP_AB
#define REP_AB 1
#endif
#ifndef REP_C
#define REP_C 1
#endif
#ifndef REP_G
#define REP_G 1
#endif
#ifndef REP_G1
#define REP_G1 REP_G
#endif
#ifndef REP_G3
#define REP_G3 REP_G
#endif
#ifndef REP_G4
#define REP_G4 REP_G
#endif
#ifndef REP_G6
#define REP_G6 REP_G
#endif
#ifndef REP_G7
#define REP_G7 REP_G
#endif
#ifndef REP_T
#define REP_T 1
#endif
#ifndef DRY_P5
#define DRY_P5 0
#endif
#ifndef DRY_P8
#define DRY_P8 0
#endif
#ifndef C_ANTIPHASE
#define C_ANTIPHASE 0
#endif
#ifndef MK_ONE_LAUNCH
#define MK_ONE_LAUNCH 1
#endif

#define GAS __attribute__((address_space(1)))
#define LAS __attribute__((address_space(3)))
typedef unsigned short bf16;
typedef unsigned v4u __attribute__((ext_vector_type(4)));
typedef unsigned v2u __attribute__((ext_vector_type(2)));
typedef float f32x4 __attribute__((ext_vector_type(4)));
typedef float f32x2 __attribute__((ext_vector_type(2)));
typedef short bf16x8 __attribute__((ext_vector_type(8)));

constexpr int NTOK = 32768, SEQ = 4096, D = 1024, DEPTH = 4, INC = 6144, NEXP = 32, TOPK = 4;
constexpr int C_QA = 0, C_KA = 256, C_VA = 512, C_QB = 768, C_KB = 1152, C_VB = 1536, C_QC = 1920, C_KC = 2304, C_VC = 2688, C_GP = 3072;
constexpr int YLD = 768, Y_A = 0, Y_B = 256, Y_C = 384;
constexpr int WPK = 896;
constexpr int MAXT = 544;
constexpr float LN_EPS = 1e-5f;
constexpr float DN_ALPHA = 1.681792830507429f;

constexpr size_t MiB = 1u << 20;
constexpr size_t WS_CTL = 0, CTL_ZERO_BYTES = 1 * MiB;
constexpr size_t WS_ROPE64 = 1 * MiB;
constexpr size_t WS_ROPE48 = 2 * MiB;
constexpr size_t WS_TOPE = 3 * MiB;
constexpr size_t WS_TOPW = 3 * MiB + 512 * 1024;
constexpr size_t WS_POS = 4 * MiB;
constexpr size_t WS_WIN = 8 * MiB;
constexpr size_t WS_WPROJ = 56 * MiB;
constexpr size_t WS_WOUT = 64 * MiB;
constexpr size_t WS_WGU = 72 * MiB;
constexpr size_t WS_WDN = 584 * MiB;
constexpr size_t WS_XB = 840 * MiB;
constexpr size_t WS_Y = 904 * MiB;
constexpr size_t WS_M = 952 * MiB;
constexpr size_t WS_H = 1016 * MiB;
constexpr size_t WS_HH = 1400 * MiB;
constexpr size_t WS_WRT = 5 * MiB;
constexpr size_t WS_RANK = 6 * MiB;
constexpr size_t WS_SRC = 1672 * MiB;
constexpr size_t WS_XB8 = 1676 * MiB;
constexpr size_t WS_WIN8 = 1708 * MiB;
constexpr size_t WS_G8 = 1720 * MiB;
constexpr size_t WS_END = 1816 * MiB;
constexpr int CW_BAR = 4096;
constexpr int CW_CNT = 8192;
constexpr int CW_CUR = 8192 + 4 * 64;

constexpr int RING_BYTES = 131072;
constexpr int LDSCTL_OFF = RING_BYTES;
constexpr int L_MISC = LDSCTL_OFF;
constexpr int L_OFFT = LDSCTL_OFF + 256;
constexpr int L_HIST = LDSCTL_OFF + 512;
constexpr int L_BASE = LDSCTL_OFF + 768;
constexpr int L_CNT = LDSCTL_OFF + 896;
constexpr int L_TILE = LDSCTL_OFF + 1024;
constexpr int L_PPOS = LDSCTL_OFF + 4096;
constexpr int L_PTOK = LDSCTL_OFF + 6144;
constexpr int LDS_BYTES = 147456;
static_assert(L_PTOK + 2048 <= LDS_BYTES, "LDS map");

#define RLX_AGENT __ATOMIC_RELAXED, __HIP_MEMORY_SCOPE_AGENT
#define LDS_WAIT() asm volatile("s_waitcnt lgkmcnt(0)" ::: "memory")
#define VM_WAIT() asm volatile("s_waitcnt vmcnt(0)" ::: "memory")

__device__ __forceinline__ float bf2f(unsigned short b) { return __uint_as_float(((unsigned)b) << 16); }
__device__ __forceinline__ float bflo(unsigned u) { return __uint_as_float(u << 16); }
__device__ __forceinline__ float bfhi(unsigned u) { return __uint_as_float(u & 0xffff0000u); }
__device__ __forceinline__ unsigned f2bf(float f) { unsigned u = __builtin_bit_cast(unsigned, f); return (u + 0x7fffu + ((u >> 16) & 1u)) >> 16; }
__device__ __forceinline__ unsigned pk2(float lo, float hi) { return f2bf(lo) | (f2bf(hi) << 16); }
__device__ __forceinline__ float wave_sum(float v) {
#pragma unroll
    for (int o = 1; o < 64; o <<= 1) v += __shfl_xor(v, o);
    return v;
}
__device__ __forceinline__ int opaque_tid() { int t; asm volatile("v_mov_b32 %0, %1" : "=v"(t) : "v"(threadIdx.x)); return t; }
__device__ __forceinline__ unsigned pk4_fp8(float a, float b, float c, float d, float sc) {
    a = fminf(fmaxf(a * sc, -448.f), 448.f); b = fminf(fmaxf(b * sc, -448.f), 448.f); c = fminf(fmaxf(c * sc, -448.f), 448.f); d = fminf(fmaxf(d * sc, -448.f), 448.f);
    int p = __builtin_amdgcn_cvt_pk_fp8_f32(a, b, 0, false); p = __builtin_amdgcn_cvt_pk_fp8_f32(c, d, p, true); return (unsigned)p; }
__device__ __forceinline__ float fast_sigmoid(float x) { return __builtin_amdgcn_rcpf(1.0f + __builtin_amdgcn_exp2f(-1.4426950408889634f * x)); }

namespace pg8 {
#define PG8_LAS __attribute__((address_space(3)))
typedef unsigned short bf16_t;
typedef unsigned u32x4 __attribute__((ext_vector_type(4)));
constexpr int BM = 256, BK = 64, HALF = 128, HTB = HALF * BK * 2, STAGE_BYTES = 8 * HTB, NXCD = 8, WGM = 8;

__host__ __device__ __forceinline__ int lds_byte(int r, int c) { const int st = (r >> 4) * 2 + (c >> 5), rr = r & 15, cc = c & 31, ob = rr * 64 + cc * 2; return st * 1024 + (ob ^ (((ob >> 9) & 1) << 5)); }
__host__ __device__ __forceinline__ void stage_rc(int b, int& R, int& C) { const int st = b / 1024, sb = b % 1024, swz = sb ^ (((sb >> 9) & 1) << 5); R = (st >> 1) * 16 + swz / 64; C = (st & 1) * 32 + (swz % 64) / 2; }
__host__ __device__ __forceinline__ int perm32(int rho) { const int n = rho >> 4, i = rho & 15; return 8 * (i >> 2) + 4 * n + (i & 3); }

struct Unit { const char* A; const char* B; int nt; int pm, pn, aux; int bs; };

constexpr int L_BIAS_OFF = 139264;
__device__ __forceinline__ void glds16_u(const void* gsrc, unsigned lds_dst) { unsigned keep;
    asm volatile("s_mov_b32 %0, m0\n\ts_mov_b32 m0, %2\n\ts_nop 0\n\tglobal_load_lds_dwordx4 %1, off\n\ts_mov_b32 m0, %0" : "=&s"(keep) : "v"(gsrc), "s"(lds_dst) : "memory"); }
__device__ __forceinline__ void tile_of(int L, int nM, int nN, int& pm, int& pn) {
    const int nwg = nM * nN;
    int wgid = L; { const int q = nwg / NXCD, r = nwg % NXCD, xcd = wgid % NXCD, off = wgid / NXCD; wgid = (xcd < r ? xcd * (q + 1) : r * (q + 1) + (xcd - r) * q) + off; }
    const int nig = WGM * nN, gid = wgid / nig, fm = gid * WGM, gsz = (nM - fm) < WGM ? (nM - fm) : WGM;
    pm = fm + ((wgid % nig) % gsz); pn = (wgid % nig) / gsz;
}

__device__ __forceinline__ unsigned cvt_pk_bf16(float lo, float hi) { unsigned r; asm volatile("v_cvt_pk_bf16_f32 %0, %1, %2" : "=v"(r) : "v"(lo), "v"(hi)); return r; }
typedef int v8i32 __attribute__((ext_vector_type(8)));
typedef short s16x16 __attribute__((ext_vector_type(16)));
typedef int v4i32 __attribute__((ext_vector_type(4)));
__device__ __forceinline__ v8i32 cat8(bf16x8 lo, bf16x8 hi) { const v4i32 a = __builtin_bit_cast(v4i32, lo), b = __builtin_bit_cast(v4i32, hi); return __builtin_shufflevector(a, b, 0, 1, 2, 3, 4, 5, 6, 7); }

template <class Epi, class Sched, bool ALIGN_EPI, bool SP2, bool FP8 = false>
__device__ __forceinline__ void gemm_phase(PG8_LAS unsigned char* lds, const int lda, const int ldb, const Sched& S, const Epi& E, const int sclW = 0x7f7f7f7f, const int sclX = 0x7f7f7f7f) {
    constexpr int EB = FP8 ? 1 : 2;
    const int tid = opaque_tid(), wid = __builtin_amdgcn_readfirstlane(tid >> 6), lane = tid & 63, wr = wid >> 2, wc = wid & 3, fr = lane & 15, fq = lane >> 4;
    unsigned voffA[2], voffB[2];
#pragma unroll
    for (int i = 0; i < 2; ++i) { int R, C; stage_rc(tid * 16 + i * 8192, R, C); const int Rb = Epi::PERM ? ((R & ~31) + perm32(R & 31)) : R;
        voffA[i] = (unsigned)(R * lda * EB + C * 2); voffB[i] = (unsigned)(Rb * ldb * EB + C * 2); }
    const size_t kstep = (size_t)(BK * 2);
    const size_t hA = (size_t)HALF * lda * EB, hB = (size_t)HALF * ldb * EB;
    const unsigned ldsw = (unsigned)wid * 1024u;
    const int fcol = FP8 ? (32 * (fq >> 1) + 16 * (fq & 1)) : fq * 8;
    const int aoff = lds_byte(wr * 64 + fr, fcol), boff = lds_byte(wc * 32 + fr, fcol);
#define PG8_SA(b, h) (((b) * 2 + (h)) * HTB)
#define PG8_SB(b, h) ((4 + (b) * 2 + (h)) * HTB)
#define PG8_STAGE(bufoff, gbase, voff) do { _Pragma("unroll") for (int _i = 0; _i < 2; ++_i) \
        __builtin_amdgcn_global_load_lds((const unsigned*)((const char*)(gbase) + (voff)[_i]), (PG8_LAS unsigned*)(lds + (bufoff) + ldsw + _i * 8192), 16, 0, 0); } while (0)
#define PG8_LDA(dst, b, h) do { if constexpr (FP8) { _Pragma("unroll") for (int m = 0; m < 4; ++m) dst##8[m] = cat8(*(const PG8_LAS bf16x8*)(lds + PG8_SA(b, h) + aoff + m * 2048), *(const PG8_LAS bf16x8*)(lds + PG8_SA(b, h) + aoff + m * 2048 + 16)); } else { \
        _Pragma("unroll") for (int m = 0; m < 4; ++m) _Pragma("unroll") for (int k = 0; k < 2; ++k) dst[m][k] = *(const PG8_LAS bf16x8*)(lds + PG8_SA(b, h) + aoff + m * 2048 + k * 1024); } } while (0)
#define PG8_LDB(dst, b, h) do { if constexpr (FP8) { _Pragma("unroll") for (int n = 0; n < 2; ++n) dst##8[n] = cat8(*(const PG8_LAS bf16x8*)(lds + PG8_SB(b, h) + boff + n * 2048), *(const PG8_LAS bf16x8*)(lds + PG8_SB(b, h) + boff + n * 2048 + 16)); } else { \
        _Pragma("unroll") for (int n = 0; n < 2; ++n) _Pragma("unroll") for (int k = 0; k < 2; ++k) dst[n][k] = *(const PG8_LAS bf16x8*)(lds + PG8_SB(b, h) + boff + n * 2048 + k * 1024); } } while (0)
#define PG8_MMA(ai, bj, At, Bt) do { __builtin_amdgcn_s_setprio(1); if constexpr (FP8) { _Pragma("unroll") for (int m = 0; m < 4; ++m) _Pragma("unroll") for (int n = 0; n < 2; ++n) \
        asm volatile("v_mfma_f32_16x16x128_f8f6f4 %0, %1, %2, %0" : "+v"(acc[ai][bj][m][n]) : "v"(Bt##8[n]), "v"(At##8[m])); } else { \
        _Pragma("unroll") for (int m = 0; m < 4; ++m) _Pragma("unroll") for (int n = 0; n < 2; ++n) _Pragma("unroll") for (int k = 0; k < 2; ++k) \
        acc[ai][bj][m][n] = __builtin_amdgcn_mfma_f32_16x16x32_bf16(Bt[n][k], At[m][k], acc[ai][bj][m][n], 0, 0, 0); } __builtin_amdgcn_s_setprio(0); } while (0)
#define PG8_WAIT_V(n) asm volatile("s_waitcnt vmcnt(" #n ")" ::: "memory")
#define PG8_WAIT_L(n) asm volatile("s_waitcnt lgkmcnt(" #n ")" ::: "memory")
#define PG8_BAR __builtin_amdgcn_s_barrier()
#define PG8_SCHED __builtin_amdgcn_sched_barrier(0)
    Unit cur, nxt; int ui = 0;
    if (!S.next(0, cur)) return;
    f32x4 acc[2][2][4][2];
#pragma unroll
    for (int a = 0; a < 2; ++a)
#pragma unroll
        for (int b = 0; b < 2; ++b)
#pragma unroll
            for (int m = 0; m < 4; ++m)
#pragma unroll
                for (int n = 0; n < 2; ++n) acc[a][b][m][n] = (f32x4){0.f, 0.f, 0.f, 0.f};
    bf16x8 At[4][2], B0[2][2], B1[2][2]; v8i32 At8[4], B08[2], B18[2];
    const char* cA = cur.A; const char* cB = cur.B;
    if constexpr (Epi::BIAS_DMA) { if (wid == 0) E.bias_dma(cur, 0, lane, lds); }
    if constexpr (SP2) {
        PG8_STAGE(PG8_SB(0, 0), cB, voffB); PG8_STAGE(PG8_SB(0, 1), cB + hB, voffB); PG8_STAGE(PG8_SA(0, 0), cA, voffA); PG8_STAGE(PG8_SA(0, 1), cA + hA, voffA);
        if (wr == 1) PG8_BAR;
        PG8_WAIT_V(2); PG8_BAR;
        PG8_STAGE(PG8_SB(1, 0), cB + kstep, voffB); PG8_STAGE(PG8_SA(1, 0), cA + kstep, voffA); PG8_STAGE(PG8_SB(1, 1), cB + hB + kstep, voffB);
        PG8_WAIT_V(6); PG8_BAR;
    } else {
        PG8_STAGE(PG8_SB(0, 0), cB, voffB); PG8_STAGE(PG8_SA(0, 0), cA, voffA); PG8_STAGE(PG8_SB(0, 1), cB + hB, voffB); PG8_STAGE(PG8_SA(0, 1), cA + hA, voffA);
        if (wr == 1) PG8_BAR;
        PG8_WAIT_V(4); PG8_BAR;
        PG8_STAGE(PG8_SB(1, 0), cB + kstep, voffB); PG8_STAGE(PG8_SA(1, 0), cA + kstep, voffA); PG8_STAGE(PG8_SB(1, 1), cB + hB + kstep, voffB);
        PG8_WAIT_V(6); PG8_BAR;
    }
    for (;;) {
        const bool has_next = S.next(ui + 1, nxt);
        if constexpr (Epi::BIAS_DMA) { if (has_next && wid == 0) E.bias_dma(nxt, (ui + 1) % 3, lane, lds); }
        const char* nA = has_next ? nxt.A : cA; const char* nB = has_next ? nxt.B : cB;
        const int nt = cur.nt;
        for (int t = 0; t < nt; t += 2) {
            const bool last = (t == nt - 2);
            const char* a1 = cA + (size_t)(t + 1) * kstep;
            const char* a2 = last ? nA : cA + (size_t)(t + 2) * kstep; const char* b2 = last ? nB : cB + (size_t)(t + 2) * kstep;
            const char* a3 = a2 + kstep; const char* b3 = b2 + kstep;
            if constexpr (SP2) {
            PG8_LDB(B0, 0, 0); PG8_LDB(B1, 0, 1); PG8_SCHED; PG8_LDA(At, 0, 0); PG8_STAGE(PG8_SA(1, 1), a1 + hA, voffA);
            PG8_WAIT_V(8); PG8_WAIT_L(0); PG8_BAR; PG8_MMA(0, 0, At, B0); PG8_MMA(0, 1, At, B1); PG8_BAR; PG8_SCHED;
            PG8_LDA(At, 0, 1); PG8_STAGE(PG8_SB(0, 0), b2, voffB); PG8_STAGE(PG8_SB(0, 1), b2 + hB, voffB); PG8_STAGE(PG8_SA(0, 0), a2, voffA);
            PG8_WAIT_V(8); PG8_WAIT_L(0); PG8_BAR; PG8_MMA(1, 0, At, B0); PG8_MMA(1, 1, At, B1); PG8_BAR; PG8_SCHED;
            PG8_LDB(B0, 1, 0); PG8_LDB(B1, 1, 1); PG8_SCHED; PG8_LDA(At, 1, 0); PG8_STAGE(PG8_SA(0, 1), a2 + hA, voffA);
            PG8_WAIT_V(8); PG8_WAIT_L(0); PG8_BAR; PG8_MMA(0, 0, At, B0); PG8_MMA(0, 1, At, B1); PG8_BAR; PG8_SCHED;
            PG8_LDA(At, 1, 1); PG8_STAGE(PG8_SB(1, 0), b3, voffB); PG8_STAGE(PG8_SB(1, 1), b3 + hB, voffB); PG8_STAGE(PG8_SA(1, 0), a3, voffA);
            PG8_WAIT_V(8); PG8_WAIT_L(0); PG8_BAR; PG8_MMA(1, 0, At, B0); PG8_MMA(1, 1, At, B1); PG8_BAR; PG8_SCHED;
            } else {
            PG8_LDB(B0, 0, 0); PG8_SCHED; PG8_LDA(At, 0, 0); PG8_STAGE(PG8_SA(1, 1), a1 + hA, voffA);
            PG8_WAIT_L(8); PG8_BAR; PG8_WAIT_L(0); PG8_MMA(0, 0, At, B0); PG8_BAR; PG8_SCHED;
            PG8_LDB(B1, 0, 1); PG8_STAGE(PG8_SB(0, 0), b2, voffB);
            PG8_BAR; PG8_WAIT_L(0); PG8_MMA(0, 1, At, B1); PG8_BAR;
            PG8_LDA(At, 0, 1); PG8_STAGE(PG8_SA(0, 0), a2, voffA);
            PG8_BAR; PG8_WAIT_L(0); PG8_MMA(1, 0, At, B0); PG8_BAR; PG8_SCHED;
            PG8_STAGE(PG8_SB(0, 1), b2 + hB, voffB);
            PG8_WAIT_V(6); PG8_BAR; PG8_MMA(1, 1, At, B1); PG8_BAR;
            PG8_LDB(B0, 1, 0); PG8_SCHED; PG8_LDA(At, 1, 0); PG8_STAGE(PG8_SA(0, 1), a2 + hA, voffA);
            PG8_WAIT_L(8); PG8_BAR; PG8_WAIT_L(0); PG8_MMA(0, 0, At, B0); PG8_BAR; PG8_SCHED;
            PG8_LDB(B1, 1, 1); PG8_STAGE(PG8_SB(1, 0), b3, voffB);
            PG8_BAR; PG8_WAIT_L(0); PG8_MMA(0, 1, At, B1); PG8_BAR;
            PG8_LDA(At, 1, 1); PG8_STAGE(PG8_SA(1, 0), a3, voffA);
            PG8_BAR; PG8_WAIT_L(0); PG8_MMA(1, 0, At, B0); PG8_BAR; PG8_SCHED;
            PG8_STAGE(PG8_SB(1, 1), b3 + hB, voffB);
            PG8_WAIT_V(6); PG8_BAR; PG8_MMA(1, 1, At, B1); PG8_BAR;
            }
        }
        if constexpr (ALIGN_EPI) { if (wr == 0) PG8_BAR; }
        if constexpr (FP8) asm volatile("s_nop 15\n\ts_nop 15\n\ts_nop 15" ::: "memory");
        cur.bs = ui % 3;
        E(acc, cur, wr, wc, fr, fq);
        if (!has_next) break;
        if (!(Epi::KEEP && cur.aux != 2)) {
#pragma unroll
        for (int a = 0; a < 2; ++a)
#pragma unroll
            for (int b = 0; b < 2; ++b)
#pragma unroll
                for (int m = 0; m < 4; ++m)
#pragma unroll
                    for (int n = 0; n < 2; ++n) acc[a][b][m][n] = (f32x4){0.f, 0.f, 0.f, 0.f};
        }
        cur = nxt; cA = nA; cB = nB; ++ui;
        if constexpr (ALIGN_EPI) { if (wr == 1) PG8_BAR; }
    }
    PG8_WAIT_V(0);
    if constexpr (!ALIGN_EPI) { if (wr == 0) PG8_BAR; }
    PG8_BAR;
#undef PG8_SA
#undef PG8_SB
#undef PG8_STAGE
#undef PG8_LDA
#undef PG8_LDB
#undef PG8_MMA
#undef PG8_WAIT_V
#undef PG8_WAIT_L
#undef PG8_BAR
#undef PG8_SCHED
}

template <class Epi, class Sched, bool FP8 = false>
__device__ __forceinline__ void gemm_phase_gather(PG8_LAS unsigned char* lds, const char* Abase, const int lda, const int ldb, const Sched& S, const Epi& E, const int sclW = 0x7f7f7f7f, const int sclX = 0x7f7f7f7f) {
    constexpr int EB = FP8 ? 1 : 2;
    const int tid = opaque_tid(), wid = __builtin_amdgcn_readfirstlane(tid >> 6), lane = tid & 63, wr = wid >> 2, wc = wid & 3, fr = lane & 15, fq = lane >> 4;
    unsigned voffB[2]; int Rr[2]; unsigned Cc[2];
#pragma unroll
    for (int i = 0; i < 2; ++i) { int R, C; stage_rc(tid * 16 + i * 8192, R, C); const int Rb = Epi::PERM ? ((R & ~31) + perm32(R & 31)) : R;
        Rr[i] = R; Cc[i] = (unsigned)C * 2u; voffB[i] = (unsigned)(Rb * ldb * EB + C * 2); }
    const size_t kstep = (size_t)(BK * 2);
    const size_t hB = (size_t)HALF * ldb * EB;
    const unsigned ldsw = (unsigned)wid * 1024u;
    const int fcol = FP8 ? (32 * (fq >> 1) + 16 * (fq & 1)) : fq * 8;
    const int aoff = lds_byte(wr * 64 + fr, fcol), boff = lds_byte(wc * 32 + fr, fcol);
#define PG8_SA(b, h) (((b) * 2 + (h)) * HTB)
#define PG8_SB(b, h) ((4 + (b) * 2 + (h)) * HTB)
#define PG8_STAGE(bufoff, gbase, voff) do { _Pragma("unroll") for (int _i = 0; _i < 2; ++_i) \
        __builtin_amdgcn_global_load_lds((const unsigned*)((const char*)(gbase) + (voff)[_i]), (PG8_LAS unsigned*)(lds + (bufoff) + ldsw + _i * 8192), 16, 0, 0); } while (0)
#define PG8_LDA(dst, b, h) do { if constexpr (FP8) { _Pragma("unroll") for (int m = 0; m < 4; ++m) dst##8[m] = cat8(*(const PG8_LAS bf16x8*)(lds + PG8_SA(b, h) + aoff + m * 2048), *(const PG8_LAS bf16x8*)(lds + PG8_SA(b, h) + aoff + m * 2048 + 16)); } else { \
        _Pragma("unroll") for (int m = 0; m < 4; ++m) _Pragma("unroll") for (int k = 0; k < 2; ++k) dst[m][k] = *(const PG8_LAS bf16x8*)(lds + PG8_SA(b, h) + aoff + m * 2048 + k * 1024); } } while (0)
#define PG8_LDB(dst, b, h) do { if constexpr (FP8) { _Pragma("unroll") for (int n = 0; n < 2; ++n) dst##8[n] = cat8(*(const PG8_LAS bf16x8*)(lds + PG8_SB(b, h) + boff + n * 2048), *(const PG8_LAS bf16x8*)(lds + PG8_SB(b, h) + boff + n * 2048 + 16)); } else { \
        _Pragma("unroll") for (int n = 0; n < 2; ++n) _Pragma("unroll") for (int k = 0; k < 2; ++k) dst[n][k] = *(const PG8_LAS bf16x8*)(lds + PG8_SB(b, h) + boff + n * 2048 + k * 1024); } } while (0)
#define PG8_MMA(ai, bj, At, Bt) do { __builtin_amdgcn_s_setprio(1); if constexpr (FP8) { _Pragma("unroll") for (int m = 0; m < 4; ++m) _Pragma("unroll") for (int n = 0; n < 2; ++n) \
        asm volatile("v_mfma_f32_16x16x128_f8f6f4 %0, %1, %2, %0" : "+v"(acc[ai][bj][m][n]) : "v"(Bt##8[n]), "v"(At##8[m])); } else { \
        _Pragma("unroll") for (int m = 0; m < 4; ++m) _Pragma("unroll") for (int n = 0; n < 2; ++n) _Pragma("unroll") for (int k = 0; k < 2; ++k) \
        acc[ai][bj][m][n] = __builtin_amdgcn_mfma_f32_16x16x32_bf16(Bt[n][k], At[m][k], acc[ai][bj][m][n], 0, 0, 0); } __builtin_amdgcn_s_setprio(0); } while (0)
#define PG8_WAIT_V(n) asm volatile("s_waitcnt vmcnt(" #n ")" ::: "memory")
#define PG8_WAIT_L(n) asm volatile("s_waitcnt lgkmcnt(" #n ")" ::: "memory")
#define PG8_BAR __builtin_amdgcn_s_barrier()
#define PG8_SCHED __builtin_amdgcn_sched_barrier(0)
#define PG8_ROWOFF(u, vo) do { _Pragma("unroll") for (int _h = 0; _h < 2; ++_h) _Pragma("unroll") for (int _i = 0; _i < 2; ++_i) \
        (vo)[_h][_i] = (unsigned)S.rowtok((u), 128 * _h + Rr[_i]) * (unsigned)(lda * EB) + Cc[_i]; } while (0)
    Unit cur, nxt, nn; int ui = 0;
    if (!S.next(0, cur)) return;
    bool has_next = S.next(1, nxt);
    unsigned cv[2][2], nv[2][2], tv[2][2];
    PG8_ROWOFF(cur, cv);
    if (has_next) PG8_ROWOFF(nxt, nv); else { _Pragma("unroll") for (int h = 0; h < 2; ++h) _Pragma("unroll") for (int i = 0; i < 2; ++i) nv[h][i] = cv[h][i]; }
    f32x4 acc[2][2][4][2];
#pragma unroll
    for (int a = 0; a < 2; ++a)
#pragma unroll
        for (int b = 0; b < 2; ++b)
#pragma unroll
            for (int m = 0; m < 4; ++m)
#pragma unroll
                for (int n = 0; n < 2; ++n) acc[a][b][m][n] = (f32x4){0.f, 0.f, 0.f, 0.f};
    bf16x8 At[4][2], B0[2][2], B1[2][2]; v8i32 At8[4], B08[2], B18[2];
    const char* cB = cur.B;
    if constexpr (Epi::BIAS_DMA) { if (wid == 0) E.bias_dma(cur, 0, lane, lds); }
    PG8_STAGE(PG8_SB(0, 0), cB, voffB); PG8_STAGE(PG8_SB(0, 1), cB + hB, voffB); PG8_STAGE(PG8_SA(0, 0), Abase, cv[0]); PG8_STAGE(PG8_SA(0, 1), Abase, cv[1]);
    if (wr == 1) PG8_BAR;
    PG8_WAIT_V(2); PG8_BAR;
    PG8_STAGE(PG8_SB(1, 0), cB + kstep, voffB); PG8_STAGE(PG8_SA(1, 0), Abase + kstep, cv[0]); PG8_STAGE(PG8_SB(1, 1), cB + hB + kstep, voffB);
    PG8_WAIT_V(6); PG8_BAR;
    for (;;) {
        const char* nB = has_next ? nxt.B : cB;
        if constexpr (Epi::BIAS_DMA) { if (has_next && wid == 0) E.bias_dma(nxt, (ui + 1) % 3, lane, lds); }
        const int nt = cur.nt;
        for (int t = 0; t < nt; t += 2) {
            const bool last = (t == nt - 2);
            const char* a1 = Abase + (size_t)(t + 1) * kstep;
            const char* a2 = last ? Abase : Abase + (size_t)(t + 2) * kstep; const char* b2 = last ? nB : cB + (size_t)(t + 2) * kstep;
            const char* a3 = a2 + kstep; const char* b3 = b2 + kstep;
            unsigned s0[2], s1[2];
#pragma unroll
            for (int i = 0; i < 2; ++i) { s0[i] = last ? nv[0][i] : cv[0][i]; s1[i] = last ? nv[1][i] : cv[1][i]; }
            PG8_LDB(B0, 0, 0); PG8_LDB(B1, 0, 1); PG8_SCHED; PG8_LDA(At, 0, 0); PG8_STAGE(PG8_SA(1, 1), a1, cv[1]);
            PG8_WAIT_V(8); PG8_WAIT_L(0); PG8_BAR; PG8_MMA(0, 0, At, B0); PG8_MMA(0, 1, At, B1); PG8_BAR; PG8_SCHED;
            PG8_LDA(At, 0, 1); PG8_STAGE(PG8_SB(0, 0), b2, voffB); PG8_STAGE(PG8_SB(0, 1), b2 + hB, voffB); PG8_STAGE(PG8_SA(0, 0), a2, s0);
            PG8_WAIT_V(8); PG8_WAIT_L(0); PG8_BAR; PG8_MMA(1, 0, At, B0); PG8_MMA(1, 1, At, B1); PG8_BAR; PG8_SCHED;
            PG8_LDB(B0, 1, 0); PG8_LDB(B1, 1, 1); PG8_SCHED; PG8_LDA(At, 1, 0); PG8_STAGE(PG8_SA(0, 1), a2, s1);
            PG8_WAIT_V(8); PG8_WAIT_L(0); PG8_BAR; PG8_MMA(0, 0, At, B0); PG8_MMA(0, 1, At, B1); PG8_BAR; PG8_SCHED;
            PG8_LDA(At, 1, 1); PG8_STAGE(PG8_SB(1, 0), b3, voffB); PG8_STAGE(PG8_SB(1, 1), b3 + hB, voffB); PG8_STAGE(PG8_SA(1, 0), a3, s0);
            PG8_WAIT_V(8); PG8_WAIT_L(0); PG8_BAR; PG8_MMA(1, 0, At, B0); PG8_MMA(1, 1, At, B1); PG8_BAR; PG8_SCHED;
        }
        if (wr == 0) PG8_BAR;
        if constexpr (FP8) asm volatile("s_nop 15\n\ts_nop 15\n\ts_nop 15" ::: "memory");
        const bool has_nn = has_next && S.next(ui + 2, nn);
        if (has_nn) PG8_ROWOFF(nn, tv);
        cur.bs = ui % 3;
        E(acc, cur, wr, wc, fr, fq);
        if (!has_next) break;
#pragma unroll
        for (int a = 0; a < 2; ++a)
#pragma unroll
            for (int b = 0; b < 2; ++b)
#pragma unroll
                for (int m = 0; m < 4; ++m)
#pragma unroll
                    for (int n = 0; n < 2; ++n) acc[a][b][m][n] = (f32x4){0.f, 0.f, 0.f, 0.f};
        cur = nxt; cB = nB; ++ui;
#pragma unroll
        for (int h = 0; h < 2; ++h)
#pragma unroll
            for (int i = 0; i < 2; ++i) { cv[h][i] = nv[h][i]; if (has_nn) nv[h][i] = tv[h][i]; }
        asm volatile("" : "+v"(nv[0][0]), "+v"(nv[0][1]), "+v"(nv[1][0]), "+v"(nv[1][1]));
        nxt = nn; has_next = has_nn;
        if (wr == 1) PG8_BAR;
    }
    PG8_WAIT_V(0);
    PG8_BAR;
#undef PG8_SA
#undef PG8_SB
#undef PG8_STAGE
#undef PG8_LDA
#undef PG8_LDB
#undef PG8_MMA
#undef PG8_WAIT_V
#undef PG8_WAIT_L
#undef PG8_BAR
#undef PG8_SCHED
#undef PG8_ROWOFF
}

struct DenseOrder {
    const char* A; const char* B; size_t a_tile, b_tile; int nt, nM, nN, G, c; int pn_off = 0;
    __device__ __forceinline__ bool next(int i, Unit& u) const {
        const long L = (long)i * G + c; if (L >= (long)nM * nN) return false;
        int pm, pn; tile_of((int)L, nM, nN, pm, pn);
        u.pm = pm; u.pn = pn + pn_off; u.aux = 0; u.nt = nt; u.A = A + (size_t)pm * a_tile; u.B = B + (size_t)pn * b_tile; return true;
    }
};
struct ProjOrder {
    const char* Y; const char* W; int nM, nN, G, c;
    __device__ __forceinline__ bool next(int i, Unit& u) const {
        const int ti = i / 3, br = i - 3 * ti;
        const long L = (long)ti * G + c; if (L >= (long)nM * nN) return false;
        int pm, pn; tile_of((int)L, nM, nN, pm, pn);
        u.pm = pm; u.pn = pn; u.aux = br; u.nt = (br == 2) ? 6 : 4;
        const int acol = (br == 0) ? 0 : (br == 1 ? 256 : 384), bcol = (br == 0) ? 0 : (br == 1 ? 256 : 512);
        u.A = Y + ((size_t)pm * 256 * YLD + acol) * 2; u.B = W + ((size_t)pn * 256 * WPK + bcol) * 2; return true;
    }
};
struct MoeOrder {
    const char* A; const char* W; size_t estride, atile, btile; int nt; const LAS int* tile_e; const LAS int* offT; const LAS int* cnt; const int* SRC; int T, nN, G, c;
    __device__ __forceinline__ bool next(int i, Unit& u) const {
        const long L = (long)i * G + c; if (L >= (long)T * nN) return false;
        int pm, pn; tile_of((int)L, T, nN, pm, pn);
        const int e = __builtin_amdgcn_readfirstlane(tile_e[pm]);
        u.pm = pm; u.pn = pn; u.aux = e; u.nt = nt; u.A = A + (size_t)pm * atile; u.B = W + (size_t)e * estride + (size_t)pn * btile; return true;
    }
    __device__ __forceinline__ int rowtok(const Unit& u, int r) const {
        const int e = u.aux, rank = (u.pm - offT[e]) * 256 + r, last = cnt[e] - 1;
        return SRC[e * NTOK + (rank < last ? rank : last)];
    }
};

struct EpiInProj {
    static constexpr bool PERM = true, KEEP = false, BIAS_DMA = true;
    bf16_t* H; const float* bg; const f32x2* r64; const f32x2* r48; float gscale; unsigned char* G8; PG8_LAS unsigned char* ldsb;
    __device__ __forceinline__ void bias_dma(const Unit& u, int s, int lane, PG8_LAS unsigned char* lds) const {
        const int o = u.pn >= 12 ? (u.pn - 12) * BM : 0;
        glds16_u(bg + o + lane * 4, (unsigned)__builtin_amdgcn_readfirstlane((int)(unsigned)(size_t)(lds + L_BIAS_OFF + s * 1024))); }
    __device__ __forceinline__ void operator()(f32x4 (&acc)[2][2][4][2], const Unit& u, int wr, int wc, int fr, int fq) const {
        const int row0 = u.pm * BM + wr * 64 + fr, pn = u.pn, t0 = wc * 32 + 8 * fq;
        const float gs = gscale; unsigned char* const g8 = G8;
        if (pn >= 3 && pn < 9) {
            int dst, hstep, tw, dd0; const f32x2* tab;
            if (pn < 6) { dst = 768 + (4 * (pn - 3) + wc) * 64 + 8 * fq; hstep = 32; tw = 32; dd0 = 8 * fq; tab = r64; }
            else { const int p0 = 128 * (pn - 6) + t0, slot = p0 / 24; dd0 = p0 - slot * 24; dst = 1920 + slot * 48 + dd0; hstep = 24; tw = 24; tab = r48; }
#pragma unroll
            for (int ai = 0; ai < 2; ++ai)
#pragma unroll
                for (int m = 0; m < 4; ++m) { const int row = row0 + ai * HALF + m * 16; const f32x2* tp = tab + (size_t)(row & (SEQ - 1)) * tw + dd0;
                    f32x4 y1[2], y2[2];
#pragma unroll
                    for (int n = 0; n < 2; ++n) { const f32x4 cs0 = *(const f32x4*)(tp + 4 * n), cs1 = *(const f32x4*)(tp + 4 * n + 2);
                        const f32x4 x1 = acc[ai][0][m][n], x2 = acc[ai][1][m][n];
                        y1[n][0] = x1[0] * cs0[0] - x2[0] * cs0[1]; y2[n][0] = x2[0] * cs0[0] + x1[0] * cs0[1];
                        y1[n][1] = x1[1] * cs0[2] - x2[1] * cs0[3]; y2[n][1] = x2[1] * cs0[2] + x1[1] * cs0[3];
                        y1[n][2] = x1[2] * cs1[0] - x2[2] * cs1[1]; y2[n][2] = x2[2] * cs1[0] + x1[2] * cs1[1];
                        y1[n][3] = x1[3] * cs1[2] - x2[3] * cs1[3]; y2[n][3] = x2[3] * cs1[2] + x1[3] * cs1[3]; }
                    bf16_t* rowp = H + (size_t)row * INC + dst;
                    u32x4 w; w.x = cvt_pk_bf16(y1[0][0], y1[0][1]); w.y = cvt_pk_bf16(y1[0][2], y1[0][3]); w.z = cvt_pk_bf16(y1[1][0], y1[1][1]); w.w = cvt_pk_bf16(y1[1][2], y1[1][3]);
                    *(u32x4*)rowp = w;
                    w.x = cvt_pk_bf16(y2[0][0], y2[0][1]); w.y = cvt_pk_bf16(y2[0][2], y2[0][3]); w.z = cvt_pk_bf16(y2[1][0], y2[1][1]); w.w = cvt_pk_bf16(y2[1][2], y2[1][3]);
                    *(u32x4*)(rowp + hstep) = w; }
            return;
        }
        const bool gate = pn >= 12;
        int dcol[2];
#pragma unroll
        for (int bj = 0; bj < 2; ++bj) { const int x = pn * BM + bj * HALF + t0;
            if (pn >= 9 && pn < 12) { const int xx = x - 2304; dcol[bj] = xx < 384 ? 1536 + xx : 2688 + (xx - 384); } else dcol[bj] = x; }
        f32x4 bv[2][2];
#pragma unroll
        for (int bj = 0; bj < 2; ++bj)
#pragma unroll
            for (int n = 0; n < 2; ++n) bv[bj][n] = gate ? *(const PG8_LAS f32x4*)((const PG8_LAS float*)(ldsb + L_BIAS_OFF + u.bs * 1024) + bj * HALF + t0 + 4 * n) : (f32x4){0.f, 0.f, 0.f, 0.f};
#pragma unroll
        for (int ai = 0; ai < 2; ++ai)
#pragma unroll
            for (int m = 0; m < 4; ++m) { bf16_t* rowp = H + (size_t)(row0 + ai * HALF + m * 16) * INC;
#pragma unroll
                for (int bj = 0; bj < 2; ++bj) { f32x4 v0 = acc[ai][bj][m][0], v1 = acc[ai][bj][m][1];
                    if (gate) {
#pragma unroll
                        for (int q = 0; q < 4; ++q) { v0[q] = v0[q] * gs + bv[bj][0][q]; v1[q] = v1[q] * gs + bv[bj][1][q]; }
                        const unsigned b0 = (unsigned)(fast_sigmoid(v0[0]) * 255.0f + 0.5f) | ((unsigned)(fast_sigmoid(v0[1]) * 255.0f + 0.5f) << 8) | ((unsigned)(fast_sigmoid(v0[2]) * 255.0f + 0.5f) << 16) | ((unsigned)(fast_sigmoid(v0[3]) * 255.0f + 0.5f) << 24);
                        const unsigned b1 = (unsigned)(fast_sigmoid(v1[0]) * 255.0f + 0.5f) | ((unsigned)(fast_sigmoid(v1[1]) * 255.0f + 0.5f) << 8) | ((unsigned)(fast_sigmoid(v1[2]) * 255.0f + 0.5f) << 16) | ((unsigned)(fast_sigmoid(v1[3]) * 255.0f + 0.5f) << 24);
                        *(v2u*)(g8 + (size_t)(row0 + ai * HALF + m * 16) * 3072 + (dcol[bj] - C_GP)) = (v2u){b0, b1};
                    } else {
                        u32x4 w; w.x = cvt_pk_bf16(v0[0], v0[1]); w.y = cvt_pk_bf16(v0[2], v0[3]); w.z = cvt_pk_bf16(v1[0], v1[1]); w.w = cvt_pk_bf16(v1[2], v1[3]);
                        *(u32x4*)(rowp + dcol[bj]) = w; } } }
    }
};
struct EpiProj {
    static constexpr bool PERM = false, KEEP = true, BIAS_DMA = false;
    const unsigned char* G8; bf16_t* Mg;
    __device__ __forceinline__ void operator()(f32x4 (&acc)[2][2][4][2], const Unit& u, int wr, int wc, int fr, int fq) const {
        const int row0 = u.pm * BM + wr * 64 + fr, col0 = u.pn * BM + wc * 32 + 4 * fq, br = u.aux;
#pragma unroll
        for (int ai = 0; ai < 2; ++ai)
#pragma unroll
            for (int m = 0; m < 4; ++m) { const size_t row = (size_t)(row0 + ai * HALF + m * 16);
#pragma unroll
                for (int bj = 0; bj < 2; ++bj)
#pragma unroll
                    for (int n = 0; n < 2; ++n) { const int c = col0 + bj * HALF + n * 16;
                        const unsigned char* gp = G8 + row * 3072 + br * 1024 + c;
                        const unsigned gw = *(const unsigned*)gp;
                        f32x4 g = (f32x4){fmaxf((float)(gw & 255u) * (1.0f / 255.0f), 1e-6f), fmaxf((float)((gw >> 8) & 255u) * (1.0f / 255.0f), 1e-6f), fmaxf((float)((gw >> 16) & 255u) * (1.0f / 255.0f), 1e-6f), fmaxf((float)(gw >> 24) * (1.0f / 255.0f), 1e-6f)};
                        if (br < 2) { const unsigned nw = *(const unsigned*)(gp + 1024);
                            g[0] *= __builtin_amdgcn_rcpf(fmaxf((float)(nw & 255u) * (1.0f / 255.0f), 1e-6f)); g[1] *= __builtin_amdgcn_rcpf(fmaxf((float)((nw >> 8) & 255u) * (1.0f / 255.0f), 1e-6f));
                            g[2] *= __builtin_amdgcn_rcpf(fmaxf((float)((nw >> 16) & 255u) * (1.0f / 255.0f), 1e-6f)); g[3] *= __builtin_amdgcn_rcpf(fmaxf((float)(nw >> 24) * (1.0f / 255.0f), 1e-6f));
                            acc[ai][bj][m][n] = acc[ai][bj][m][n] * g; }
                        else { const f32x4 t = acc[ai][bj][m][n] * g; v2u o; o.x = cvt_pk_bf16(t[0], t[1]); o.y = cvt_pk_bf16(t[2], t[3]); *(v2u*)(Mg + row * 1024 + c) = o; } } }
    }
};
struct EpiOut {
    static constexpr bool PERM = false, KEEP = false, BIAS_DMA = false;
    const float* X; const bf16_t* XBr; bf16_t* P;
    __device__ __forceinline__ void operator()(f32x4 (&acc)[2][2][4][2], const Unit& u, int wr, int wc, int fr, int fq) const {
        const int row0 = u.pm * BM + wr * 64 + fr, col0 = u.pn * BM + wc * 32 + 4 * fq;
        const float* const Xf = X; const bf16_t* const Xh = XBr; bf16_t* const Pp = P;
#pragma unroll
        for (int ai = 0; ai < 2; ++ai)
#pragma unroll
            for (int m = 0; m < 4; ++m) { const size_t ro = (size_t)(row0 + ai * HALF + m * 16) * 1024 + col0;
#pragma unroll
                for (int bj = 0; bj < 2; ++bj)
#pragma unroll
                    for (int n = 0; n < 2; ++n) { f32x4 xv;
                        if (Xf) xv = *(const f32x4*)(Xf + ro + bj * HALF + n * 16);
                        else { const v2u xw = *(const v2u*)(Xh + ro + bj * HALF + n * 16); xv = (f32x4){bflo(xw.x), bfhi(xw.x), bflo(xw.y), bfhi(xw.y)}; }
                        const f32x4 pv = xv * DN_ALPHA + acc[ai][bj][m][n]; v2u o; o.x = cvt_pk_bf16(pv[0], pv[1]); o.y = cvt_pk_bf16(pv[2], pv[3]); *(v2u*)(Pp + ro + bj * HALF + n * 16) = o; } }
    }
};
struct EpiSwiglu {
    static constexpr bool PERM = true, KEEP = false, BIAS_DMA = true;
    unsigned char* HH; const float* bgate; const float* bup; float ascale; PG8_LAS unsigned char* ldsb;
    __device__ __forceinline__ void bias_dma(const Unit& u, int s, int lane, PG8_LAS unsigned char* lds) const {
        const float* src = (lane < 32 ? bgate : bup) + u.aux * 1024 + u.pn * HALF + (lane & 31) * 4;
        glds16_u(src, (unsigned)__builtin_amdgcn_readfirstlane((int)(unsigned)(size_t)(lds + L_BIAS_OFF + s * 1024))); }
    __device__ __forceinline__ void operator()(f32x4 (&acc)[2][2][4][2], const Unit& u, int wr, int wc, int fr, int fq) const {
        const int row0 = u.pm * BM + wr * 64 + fr, j0 = u.pn * HALF + wc * 32 + 8 * fq, e = u.aux;
        f32x4 bg[2], bu[2];
#pragma unroll
        for (int n = 0; n < 2; ++n) { const PG8_LAS float* bl = (const PG8_LAS float*)(ldsb + L_BIAS_OFF + u.bs * 1024) + wc * 32 + 8 * fq + 4 * n; bg[n] = *(const PG8_LAS f32x4*)bl; bu[n] = *(const PG8_LAS f32x4*)(bl + HALF); }
#pragma unroll
        for (int ai = 0; ai < 2; ++ai)
#pragma unroll
            for (int m = 0; m < 4; ++m) { unsigned char* rowp = HH + (size_t)(row0 + ai * HALF + m * 16) * 1024 + j0;
                f32x4 o[2];
#pragma unroll
                for (int n = 0; n < 2; ++n) { f32x4 g = acc[ai][0][m][n] * ascale + bg[n], uu = acc[ai][1][m][n] * ascale + bu[n];
#pragma unroll
                    for (int q = 0; q < 4; ++q) { const float hg = fminf(g[q], 7.0f), hu = fminf(fmaxf(uu[q], -7.0f), 7.0f);
                        o[n][q] = hg * fast_sigmoid(1.702f * hg) * (hu + 1.0f); } }
                v2u w; w.x = pk4_fp8(o[0][0], o[0][1], o[0][2], o[0][3], 4.0f); w.y = pk4_fp8(o[1][0], o[1][1], o[1][2], o[1][3], 4.0f);
                *(v2u*)rowp = w; }
    }
};
struct EpiDown {
    static constexpr bool PERM = true, KEEP = false, BIAS_DMA = true;
    unsigned char* YS; const float* bd; float ascale; PG8_LAS unsigned char* ldsb;
    __device__ __forceinline__ void bias_dma(const Unit& u, int s, int lane, PG8_LAS unsigned char* lds) const {
        glds16_u(bd + u.aux * 1024 + u.pn * BM + lane * 4, (unsigned)__builtin_amdgcn_readfirstlane((int)(unsigned)(size_t)(lds + L_BIAS_OFF + s * 1024))); }
    __device__ __forceinline__ void operator()(f32x4 (&acc)[2][2][4][2], const Unit& u, int wr, int wc, int fr, int fq) const {
        const int row0 = u.pm * BM + wr * 64 + fr, col0 = u.pn * BM + wc * 32 + 8 * fq, e = u.aux;
        f32x4 bv[2][2];
#pragma unroll
        for (int bj = 0; bj < 2; ++bj)
#pragma unroll
            for (int n = 0; n < 2; ++n) bv[bj][n] = *(const PG8_LAS f32x4*)((const PG8_LAS float*)(ldsb + L_BIAS_OFF + u.bs * 1024) + wc * 32 + 8 * fq + bj * HALF + 4 * n);
#pragma unroll
        for (int ai = 0; ai < 2; ++ai)
#pragma unroll
            for (int m = 0; m < 4; ++m) { unsigned char* rowp = YS + (size_t)(row0 + ai * HALF + m * 16) * 1024 + col0;
#pragma unroll
                for (int bj = 0; bj < 2; ++bj) { const f32x4 v0 = acc[ai][bj][m][0] * ascale + bv[bj][0], v1 = acc[ai][bj][m][1] * ascale + bv[bj][1];
                    v2u w; w.x = pk4_fp8(v0[0], v0[1], v0[2], v0[3], 16.0f); w.y = pk4_fp8(v1[0], v1[1], v1[2], v1[3], 16.0f);
                    *(v2u*)(rowp + bj * HALF) = w; } }
    }
};
}

#define XB_TMO      128
#define XB_XCNT(j)  (256  + 64 * (j))
#define XB_XSUB(j)  (1280 + 64 * (j))
#define XB_XGEN(j)  (2304 + 64 * (j))
#define XB_TOP      3328
#define XB_TOPGEN   3392
#define XCD_BAR_WORDS 3456
#define XB_SPIN_CAP (1u << 18)

__device__ __forceinline__ unsigned xb_ld(unsigned* p)              { return __hip_atomic_load(p, __ATOMIC_RELAXED, __HIP_MEMORY_SCOPE_AGENT); }
__device__ __forceinline__ unsigned xb_add(unsigned* p, unsigned v) { return __hip_atomic_fetch_add(p, v, __ATOMIC_RELAXED, __HIP_MEMORY_SCOPE_AGENT); }
__device__ __forceinline__ unsigned xb_xcc_id() { return (unsigned)__builtin_amdgcn_s_getreg((3 << 11) | 20) & 0xFu; }
#define XB_SPIN(cond, bar) do { unsigned _sp = 0; while (cond) { __builtin_amdgcn_s_sleep(1); \
    if ((++_sp & 255u) == 0u) { if (xb_ld(&(bar)[XB_TMO])) break; if (_sp > XB_SPIN_CAP) { atomicAdd(&(bar)[XB_TMO], 1u); break; } } } } while (0)

struct XcdBarrier { unsigned* bar; unsigned x; volatile LAS unsigned* st; };

__device__ __forceinline__ XcdBarrier xcd_barrier_post(unsigned* bar, volatile LAS unsigned* st) {
    XcdBarrier b; b.bar = bar; b.x = xb_xcc_id(); b.st = st;
    if (threadIdx.x == 0) (void)xb_add(&bar[XB_XCNT(b.x)], 1u);
    return b;
}
__device__ __forceinline__ void xcd_barrier_complete(unsigned* bar, unsigned x, unsigned& nloc, unsigned& nx) {
    const unsigned G = gridDim.x * gridDim.y * gridDim.z;
    unsigned sum, cnt, mine, sp = 0u;
    for (;;) {
        sum = 0u; cnt = 0u; mine = 0u;
#pragma unroll
        for (unsigned j = 0; j < 16; ++j) { const unsigned c = xb_ld(&bar[XB_XCNT(j)]); sum += c; cnt += (c > 0u) ? 1u : 0u; mine = (j == x) ? c : mine; }
        if (sum == G) break;
        __builtin_amdgcn_s_sleep(1);
        if ((++sp & 255u) == 0u) { if (xb_ld(&bar[XB_TMO])) break; if (sp > XB_SPIN_CAP) { atomicAdd(&bar[XB_TMO], 1u); break; } }
    }
    nloc = mine > 0u ? mine : 1u; nx = cnt > 0u ? cnt : 1u;
}
__device__ __forceinline__ void xcd_barrier(const XcdBarrier& b) {
    asm volatile("s_waitcnt vmcnt(0)" ::: "memory");
    __syncthreads();
    if (threadIdx.x == 0) {
        unsigned* bar = b.bar;
        __builtin_amdgcn_s_waitcnt(0);
        unsigned nloc = b.st[0], nx = b.st[1];
        if (nloc == 0u) { xcd_barrier_complete(bar, b.x, nloc, nx); b.st[0] = nloc; b.st[1] = nx; }
        const unsigned old = xb_add(&bar[XB_XSUB(b.x)], 1u);
        const unsigned gen = old / nloc;
        if (old + 1u == (gen + 1u) * nloc) {
            __builtin_amdgcn_fence(__ATOMIC_RELEASE, "agent");
            asm volatile("s_waitcnt vmcnt(0)" ::: "memory");
            const unsigned og = xb_add(&bar[XB_TOP], 1u);
            const unsigned tg = og / nx;
            if (og + 1u == (tg + 1u) * nx) xb_add(&bar[XB_TOPGEN], 1u);
            else XB_SPIN(xb_ld(&bar[XB_TOPGEN]) == tg, bar);
            __builtin_amdgcn_fence(__ATOMIC_ACQUIRE, "agent");
            xb_add(&bar[XB_XGEN(b.x)], 1u);
            asm volatile("s_waitcnt vmcnt(0)" ::: "memory");
        } else {
            XB_SPIN(xb_ld(&bar[XB_XGEN(b.x)]) == gen, bar);
            __builtin_amdgcn_fence(__ATOMIC_ACQUIRE, "agent");
            asm volatile("s_waitcnt vmcnt(0)" ::: "memory");
        }
    }
    __syncthreads();
}

struct Frame {
    LAS unsigned char* lds;
    unsigned* ctl;
    unsigned char* ws;
    int tid, lane, wave, G, bid;
};

__host__ __device__ __forceinline__ int inproj_phys(int nl) {
    if (nl < 768) return nl;
    if (nl < 1536) { const int x = nl - 768, slot = x >> 6, d = x & 63; return 768 + (slot >> 2) * 256 + (d >> 5) * 128 + (slot & 3) * 32 + (d & 31); }
    if (nl < 1920) return 2304 + (nl - 1536);
    if (nl < 2688) { const int x = nl - 1920, slot = x / 48, d = x - slot * 48, hf = d >= 24 ? 1 : 0, p = slot * 24 + d - 24 * hf; return 1536 + (p >> 7) * 256 + hf * 128 + (p & 127); }
    if (nl < 3072) return 2304 + 384 + (nl - 2688);
    return nl;
}
template <class RowMap>
__device__ __forceinline__ void transpose_item(const float* W, int N, bf16* dst, int ldd, int k0, int n0, const RowMap rowmap, LAS float* scr, int lane) {
#pragma unroll 8
    for (int i = 0; i < 32; ++i) { const int kk = 2 * i + (lane >> 5); scr[kk * 33 + (lane & 31)] = W[(size_t)(k0 + kk) * N + n0 + (lane & 31)]; }
    LDS_WAIT(); asm volatile("" ::: "memory");
    const int c = lane & 7;
#pragma unroll
    for (int j = 0; j < 4; ++j) { const int n = (lane >> 3) + 8 * j; const LAS float* sp = scr + (8 * c) * 33 + n;
        v4u o; o.x = pk2(sp[0 * 33], sp[1 * 33]); o.y = pk2(sp[2 * 33], sp[3 * 33]); o.z = pk2(sp[4 * 33], sp[5 * 33]); o.w = pk2(sp[6 * 33], sp[7 * 33]);
        *(v4u*)(dst + (size_t)rowmap(n0 + n) * ldd + k0 + 8 * c) = o; }
    LDS_WAIT(); asm volatile("" ::: "memory");
}

template <class RowMap>
__device__ __forceinline__ void transpose_item_fp8(const float* W, int N, unsigned char* dst, int ldd, int k0, int n0, const RowMap rowmap, LAS float* scr, int lane, float qs) {
#pragma unroll 8
    for (int i = 0; i < 32; ++i) { const int kk = 2 * i + (lane >> 5); scr[kk * 33 + (lane & 31)] = W[(size_t)(k0 + kk) * N + n0 + (lane & 31)]; }
    LDS_WAIT(); asm volatile("" ::: "memory");
    const int c = lane & 7;
#pragma unroll
    for (int j = 0; j < 4; ++j) { const int n = (lane >> 3) + 8 * j; const LAS float* sp = scr + (8 * c) * 33 + n;
        v2u o; o.x = pk4_fp8(sp[0 * 33], sp[1 * 33], sp[2 * 33], sp[3 * 33], qs); o.y = pk4_fp8(sp[4 * 33], sp[5 * 33], sp[6 * 33], sp[7 * 33], qs);
        *(v2u*)(dst + (size_t)rowmap(n0 + n) * ldd + k0 + 8 * c) = o; }
    LDS_WAIT(); asm volatile("" ::: "memory");
}

struct Args { const float* in[22]; float* out; unsigned char* ws; int ph_lo, ph_hi; float lam_init[4]; };

__device__ __forceinline__ void p_prologue(Frame& F, const Args& a) {
    LAS float* scr = (LAS float*)(F.lds + F.wave * 16384);
    const int gw = F.bid * 8 + F.wave, NGW = F.G * 8;
    constexpr int PER_LAYER = 3072 + 128 + 64 + 192 + 512 + 32 * 1536;
    for (int it = gw; it < DEPTH * PER_LAYER; it += NGW) {
        const int l = it / PER_LAYER; int r = it - l * PER_LAYER;
        if (r < 3072) { const int kb = r / 192, nb = r % 192;
            if (nb < 96) transpose_item(a.in[1] + (size_t)l * 1024 * INC, INC, (bf16*)(F.ws + WS_WIN) + (size_t)l * INC * 1024, 1024, kb * 64, nb * 32, [](int n) { return inproj_phys(n); }, scr, F.lane);
            else transpose_item_fp8(a.in[1] + (size_t)l * 1024 * INC, INC, (unsigned char*)(F.ws + WS_WIN8) + (size_t)l * 3072 * 1024, 1024, kb * 64, nb * 32, [](int n) { return n - 3072; }, scr, F.lane, 32.f);
            continue; }
        r -= 3072;
        if (r < 128) { const int kb = r / 32, nb = r % 32;
            transpose_item(a.in[3] + (size_t)l * 256 * 1024, 1024, (bf16*)(F.ws + WS_WPROJ) + (size_t)l * 1024 * WPK + 0, WPK, kb * 64, nb * 32, [](int n) { return n; }, scr, F.lane); continue; }
        r -= 128;
        if (r < 64) { const int kb = r / 32, nb = r % 32;
            transpose_item(a.in[4] + (size_t)l * 128 * 1024, 1024, (bf16*)(F.ws + WS_WPROJ) + (size_t)l * 1024 * WPK + 256, WPK, kb * 64, nb * 32, [](int n) { return n; }, scr, F.lane); continue; }
        r -= 64;
        if (r < 192) { const int kb = r / 32, nb = r % 32;
            transpose_item(a.in[5] + (size_t)l * 384 * 1024, 1024, (bf16*)(F.ws + WS_WPROJ) + (size_t)l * 1024 * WPK + 512, WPK, kb * 64, nb * 32, [](int n) { return n; }, scr, F.lane); continue; }
        r -= 192;
        if (r < 512) { const int kb = r / 32, nb = r % 32;
            transpose_item(a.in[6] + (size_t)l * 1024 * 1024, 1024, (bf16*)(F.ws + WS_WOUT) + (size_t)l * 1024 * 1024, 1024, kb * 64, nb * 32, [](int n) { return n; }, scr, F.lane); continue; }
        r -= 512;
        { const int e = r / 1536, r2 = r % 1536, mtx = r2 / 512, r3 = r2 % 512, kb = r3 / 32, nb = r3 % 32;
          const size_t eoff = ((size_t)l * NEXP + e) * 1024 * 1024;
          if (mtx == 0) transpose_item_fp8(a.in[14] + eoff, 1024, (unsigned char*)(F.ws + WS_WGU) + 2 * eoff, 1024, kb * 64, nb * 32, [](int n) { return (n >> 7) * 256 + (n & 127); }, scr, F.lane, 32.f);
          else if (mtx == 1) transpose_item_fp8(a.in[16] + eoff, 1024, (unsigned char*)(F.ws + WS_WGU) + 2 * eoff, 1024, kb * 64, nb * 32, [](int n) { return (n >> 7) * 256 + 128 + (n & 127); }, scr, F.lane, 32.f);
          else transpose_item_fp8(a.in[18] + eoff, 1024, (unsigned char*)(F.ws + WS_WDN) + eoff, 1024, kb * 64, nb * 32, [](int n) { return n; }, scr, F.lane, 64.f); }
    }
    { const int gt = F.bid * 512 + F.tid, NT = F.G * 512;
      for (int i = gt; i < DEPTH * 1024 * 16; i += NT) { const int row = i >> 4, ch = i & 15;
          *(v4u*)((bf16*)(F.ws + WS_WPROJ) + (size_t)row * WPK + 384 + ch * 8) = (v4u){0u, 0u, 0u, 0u}; }
      for (int i = gt; i < SEQ * 32; i += NT) { const int pos = i >> 5, j = i & 31;
          const float inv = 1.0f / powf(10000.0f, (float)(2 * j) / 64.0f); const float ang = (float)pos * inv; float s, c; sincosf(ang, &s, &c);
          ((f32x2*)(F.ws + WS_ROPE64))[i] = (f32x2){c, s}; }
      for (int i = gt; i < SEQ * 24; i += NT) { const int pos = i / 24, j = i - pos * 24;
          const float inv = 1.0f / powf(10000.0f, (float)(2 * j) / 48.0f); const float ang = (float)pos * inv; float s, c; sincosf(ang, &s, &c);
          ((f32x2*)(F.ws + WS_ROPE48))[i] = (f32x2){c, s}; }
      for (int i = gt; i < DEPTH * 32 * 1024; i += NT) { const int l = i >> 15, e = (i >> 10) & 31, k = i & 1023;
          const float wv = a.in[12][((size_t)l * 1024 + k) * 32 + e]; const unsigned hi = f2bf(wv); const unsigned lo = f2bf(wv - __uint_as_float(hi << 16));
          bf16* wt = (bf16*)(F.ws + WS_WRT) + (size_t)l * 2 * 32 * 1024; wt[e * 1024 + k] = (bf16)hi; wt[32 * 1024 + e * 1024 + k] = (bf16)lo; }
      const f32x4* x4 = (const f32x4*)a.in[0]; v2u* xb = (v2u*)(F.ws + WS_XB);
      unsigned* xb8 = (unsigned*)(F.ws + WS_XB8);
      for (int i = gt; i < NTOK * 256; i += NT) { const f32x4 v = x4[i]; xb[i] = (v2u){pk2(v[0], v[1]), pk2(v[2], v[3])}; xb8[i] = pk4_fp8(v[0], v[1], v[2], v[3], 1.0f); }
    }
}

typedef float f32x16 __attribute__((ext_vector_type(16)));
typedef short s16x4 __attribute__((ext_vector_type(4)));
typedef float f32x2_t __attribute__((ext_vector_type(2)));
typedef __bf16 bf16x2_t __attribute__((ext_vector_type(2)));
__device__ __forceinline__ unsigned cvtpk(float lo, float hi) { const f32x2_t v = {lo, hi}; const bf16x2_t b = __builtin_convertvector(v, bf16x2_t); return __builtin_bit_cast(unsigned, b); }
__device__ __forceinline__ int kperm(int r) { return (r & ~12) | ((r & 4) << 1) | ((r & 8) >> 1); }
__device__ __forceinline__ s16x4 ds_tr16(const LAS unsigned char* p) { return __builtin_bit_cast(s16x4, __builtin_amdgcn_ds_read_tr16_b64_v4i16((LAS s16x4*)p)); }

__device__ __forceinline__ float fmax_nc(float a, float b) { return __builtin_amdgcn_fmed3f(a, b, __builtin_inff()); }
__device__ __forceinline__ void glds16(const void* gsrc, unsigned lds_dst) { unsigned keep;
    asm volatile("s_mov_b32 %0, m0\n\ts_mov_b32 m0, %2\n\ts_nop 0\n\tglobal_load_lds_dwordx4 %1, off\n\ts_mov_b32 m0, %0" : "=&s"(keep) : "v"(gsrc), "s"(lds_dst) : "memory"); }
__device__ __forceinline__ void attnC_pipe(Frame& F, const float* lamv, const float* ng, float lam_init) {
    const bf16* H = (const bf16*)(F.ws + WS_H); bf16* Y = (bf16*)(F.ws + WS_Y);
    const int lane = F.lane, w = F.wave, n = lane & 31, hh = lane >> 5;
    float l01 = 0.f, l23 = 0.f;
    if (lane < 48) { l01 = lamv[lane] * lamv[48 + lane]; l23 = lamv[96 + lane] * lamv[144 + lane]; }
    l01 = wave_sum(l01); l23 = wave_sum(l23);
    const float lam = expf(l01) - expf(l23) + lam_init;
    const float post = 1.0f - lam_init;
    constexpr int KST = 208, VST = 192, KBYTES = 64 * KST, STAGE = KBYTES + 64 * VST, NT = SEQ / 64;
    constexpr float CS = 0.14433756729740643f * 1.4426950408889634f;
    constexpr float PMAX = 256.0f;
    unsigned goff[4], loff[4];
#pragma unroll
    for (int j = 0; j < 4; ++j) { const int I = w + 8 * j;
        if (I < 13) { const int cid = I * 64 + lane, row = cid / 13; int col = cid - row * 13; if (col == 12) col = 0;
            goff[j] = (unsigned)(row * INC + C_KC + col * 8) * 2u; loff[j] = (unsigned)(I * 1024); }
        else { const int cid = (I - 13) * 64 + lane, row = cid / 12, col = cid - row * 12;
            goff[j] = (unsigned)(row * INC + C_VC + col * 8) * 2u; loff[j] = (unsigned)(KBYTES + (I - 13) * 1024); } }
    const int koff = kperm(n) * KST + hh * 16;
    const int g = lane >> 4, i16 = lane & 15;
    const int voff = KBYTES + (8 * (g >> 1) + (i16 >> 2)) * VST + (16 * (g & 1) + 4 * (i16 & 3)) * 2;
#define C_ISSUE(tt) do { const char* gb_ = gbase + (size_t)(tt) * (64 * INC * 2); const int so_ = ((tt) & 3) * STAGE; _Pragma("unroll") for (int j_ = 0; j_ < 4; ++j_) if (w + 8 * j_ < 25) \
        glds16(gb_ + goff[j_], (unsigned)__builtin_amdgcn_readfirstlane((int)(unsigned)(size_t)(F.lds + so_ + loff[j_]))); } while (0)
#define C_RDV(slotV, kbV, s2v) do { _Pragma("unroll") for (int d_ = 0; d_ < 3; ++d_) { const LAS unsigned char* vp_ = (slotV) + voff + ((kbV) * 32 + 16 * (s2v)) * VST + d_ * 64; \
            const s16x4 v0_ = ds_tr16(vp_), v1_ = ds_tr16(vp_ + 4 * VST); vf[d_] = (bf16x8){v0_[0], v0_[1], v0_[2], v0_[3], v1_[0], v1_[1], v1_[2], v1_[3]}; } } while (0)
#define C_FENCE __builtin_amdgcn_sched_barrier(0)
#define C_QK0(dst, slotbase) do { { const bf16x8 kf_ = *(const LAS bf16x8*)((slotbase) + koff); dst = __builtin_amdgcn_mfma_f32_32x32x16_bf16(kf_, qf[0][0], NEGR[0], 0, 0, 0); } \
        _Pragma("unroll") for (int s_ = 1; s_ < 3; ++s_) { const bf16x8 kf_ = *(const LAS bf16x8*)((slotbase) + koff + (2 * s_) * 16); dst = __builtin_amdgcn_mfma_f32_32x32x16_bf16(kf_, qf[0][s_], dst, 0, 0, 0); } } while (0)
#define C_ITEM(Sx, c, pout, pin, cp, slotVp, kbVp, slotKc, kbKc, slotKn, kbKn, cn) do { \
        _Pragma("unroll") for (int s2_ = 0; s2_ < 2; ++s2_) _Pragma("unroll") for (int d_ = 0; d_ < 3; ++d_) { const LAS unsigned char* vp_ = (slotVp) + voff + ((kbVp) * 32 + 16 * s2_) * VST + d_ * 64; \
            const s16x4 v0_ = ds_tr16(vp_), v1_ = ds_tr16(vp_ + 4 * VST); vf[s2_ * 3 + d_] = (bf16x8){v0_[0], v0_[1], v0_[2], v0_[3], v1_[0], v1_[1], v1_[2], v1_[3]}; } \
        _Pragma("unroll") for (int s_ = 0; s_ < 3; ++s_) kf[s_] = *(const LAS bf16x8*)((slotKn) + (kbKn) * 32 * KST + koff + ((cn) * 6 + 2 * s_) * 16); \
        C_FENCE; \
        const float lold_ = l[c]; \
        _Pragma("unroll") for (int r_ = 0; r_ < 16; ++r_) Sx[r_] = __builtin_amdgcn_exp2f(Sx[r_]); \
        float pm_ = fmaxf(fmaxf(Sx[0], Sx[1]), Sx[2]); _Pragma("unroll") for (int r_ = 3; r_ < 15; r_ += 2) pm_ = fmaxf(fmaxf(pm_, Sx[r_]), Sx[r_ + 1]); pm_ = fmaxf(pm_, Sx[15]); \
        _Pragma("unroll") for (int r_ = 0; r_ < 16; ++r_) l[c] += Sx[r_]; \
        _Pragma("unroll") for (int s2_ = 0; s2_ < 2; ++s2_) { v4u pw_; pw_.x = cvtpk(Sx[8 * s2_ + 0], Sx[8 * s2_ + 1]); pw_.y = cvtpk(Sx[8 * s2_ + 2], Sx[8 * s2_ + 3]); \
            pw_.z = cvtpk(Sx[8 * s2_ + 4], Sx[8 * s2_ + 5]); pw_.w = cvtpk(Sx[8 * s2_ + 6], Sx[8 * s2_ + 7]); pout[s2_] = __builtin_bit_cast(bf16x8, pw_); } \
        _Pragma("unroll") for (int s2_ = 0; s2_ < 2; ++s2_) _Pragma("unroll") for (int d_ = 0; d_ < 3; ++d_) O[cp][d_] = __builtin_amdgcn_mfma_f32_32x32x16_bf16(vf[s2_ * 3 + d_], pin[s2_], O[cp][d_], 0, 0, 0); \
        _Pragma("unroll") for (int g_ = 0; g_ < 6; ++g_) { __builtin_amdgcn_sched_group_barrier(0x008, 1, 0); __builtin_amdgcn_sched_group_barrier(0x400, 3, 0); __builtin_amdgcn_sched_group_barrier(0x002, 7, 0); } \
        C_FENCE; \
        pm_ = fmaxf(pm_, __shfl_xor(pm_, 32)); \
        if (__any(pm_ > PMAX) || first) { f32x16 Sr_; \
            { const bf16x8 k0_ = *(const LAS bf16x8*)((slotKc) + (kbKc) * 32 * KST + koff + ((c) * 6 + 0) * 16), k1_ = *(const LAS bf16x8*)((slotKc) + (kbKc) * 32 * KST + koff + ((c) * 6 + 2) * 16), k2_ = *(const LAS bf16x8*)((slotKc) + (kbKc) * 32 * KST + koff + ((c) * 6 + 4) * 16); \
              Sr_ = __builtin_amdgcn_mfma_f32_32x32x16_bf16(k0_, qf[c][0], NEGR[c], 0, 0, 0); Sr_ = __builtin_amdgcn_mfma_f32_32x32x16_bf16(k1_, qf[c][1], Sr_, 0, 0, 0); Sr_ = __builtin_amdgcn_mfma_f32_32x32x16_bf16(k2_, qf[c][2], Sr_, 0, 0, 0); } \
            float mx_ = fmax_nc(Sr_[0], Sr_[1]); _Pragma("unroll") for (int r_ = 2; r_ < 16; ++r_) mx_ = fmax_nc(mx_, Sr_[r_]); mx_ = fmaxf(mx_, __shfl_xor(mx_, 32)); \
            const float dl_ = (pm_ > PMAX || first) ? mx_ : 0.0f, al_ = __builtin_amdgcn_exp2f(-dl_); \
            _Pragma("unroll") for (int d_ = 0; d_ < 3; ++d_) _Pragma("unroll") for (int r_ = 0; r_ < 16; ++r_) O[c][d_][r_] *= al_; \
            float ls_ = lold_ * al_; \
            _Pragma("unroll") for (int r_ = 0; r_ < 16; ++r_) { NEGR[c][r_] -= dl_; Sr_[r_] = __builtin_amdgcn_exp2f(Sr_[r_] - dl_); ls_ += Sr_[r_]; } \
            l[c] = ls_; \
            _Pragma("unroll") for (int s2_ = 0; s2_ < 2; ++s2_) { v4u pw_; pw_.x = cvtpk(Sr_[8 * s2_ + 0], Sr_[8 * s2_ + 1]); pw_.y = cvtpk(Sr_[8 * s2_ + 2], Sr_[8 * s2_ + 3]); \
                pw_.z = cvtpk(Sr_[8 * s2_ + 4], Sr_[8 * s2_ + 5]); pw_.w = cvtpk(Sr_[8 * s2_ + 6], Sr_[8 * s2_ + 7]); pout[s2_] = __builtin_bit_cast(bf16x8, pw_); } } \
        C_FENCE; \
        Sx = __builtin_amdgcn_mfma_f32_32x32x16_bf16(kf[0], qf[cn][0], NEGR[cn], 0, 0, 0); Sx = __builtin_amdgcn_mfma_f32_32x32x16_bf16(kf[1], qf[cn][1], Sx, 0, 0, 0); Sx = __builtin_amdgcn_mfma_f32_32x32x16_bf16(kf[2], qf[cn][2], Sx, 0, 0, 0); \
        C_FENCE; } while (0)
    for (int unit = F.bid; unit < 512; unit += F.G) {
        const int b = unit >> 6, h = (unit >> 4) & 3, qb = unit & 15;
        const int tok = b * SEQ + qb * 256 + w * 32 + n;
        const char* gbase = (const char*)(H + (size_t)(b * SEQ) * INC + h * 96);
        C_ISSUE(0); C_ISSUE(1);
        bf16x8 qf[2][3];
        { const bf16* qp = H + (size_t)tok * INC + C_QC + h * 96 + 8 * hh;
#pragma unroll
          for (int c = 0; c < 2; ++c)
#pragma unroll
              for (int s = 0; s < 3; ++s) { const v4u qw = *(const v4u*)(qp + c * 48 + 16 * s);
                  v4u qs; qs.x = cvtpk(bflo(qw.x) * CS, bfhi(qw.x) * CS); qs.y = cvtpk(bflo(qw.y) * CS, bfhi(qw.y) * CS); qs.z = cvtpk(bflo(qw.z) * CS, bfhi(qw.z) * CS); qs.w = cvtpk(bflo(qw.w) * CS, bfhi(qw.w) * CS);
                  qf[c][s] = __builtin_bit_cast(bf16x8, qs); } }
        f32x16 O[2][3];
#pragma unroll
        for (int c = 0; c < 2; ++c)
#pragma unroll
            for (int d = 0; d < 3; ++d)
#pragma unroll
                for (int r = 0; r < 16; ++r) O[c][d][r] = 0.f;
        float l[2] = {0.f, 0.f};
        f32x16 NEGR[2];
#pragma unroll
        for (int c = 0; c < 2; ++c)
#pragma unroll
            for (int r = 0; r < 16; ++r) NEGR[c][r] = 0.f;
        f32x16 S; bf16x8 pa[2], pb[2], kf[3], vf[6];
        pb[0] = (bf16x8){0, 0, 0, 0, 0, 0, 0, 0}; pb[1] = pb[0];
        for (int t = 0; t < NT; ++t) {
            asm volatile("s_waitcnt vmcnt(0)" ::: "memory"); __builtin_amdgcn_s_barrier(); asm volatile("" ::: "memory");
            if (t + 2 < NT) C_ISSUE(t + 2);
            const LAS unsigned char* cur = F.lds + (t & 3) * STAGE;
            const LAS unsigned char* prv = F.lds + ((t > 0 ? t - 1 : 0) & 3) * STAGE;
            const LAS unsigned char* nxt = F.lds + ((t + 1 < NT ? t + 1 : t) & 3) * STAGE;
            if (t == 0) C_QK0(S, cur);
            { const bool first = (t == 0);
            C_ITEM(S, 0, pa, pb, 1, prv, 1, cur, 0, cur, 0, 1);
            C_ITEM(S, 1, pb, pa, 0, cur, 0, cur, 0, cur, 1, 0); }
            { const bool first = false;
            C_ITEM(S, 0, pa, pb, 1, cur, 0, cur, 1, cur, 1, 1);
            C_ITEM(S, 1, pb, pa, 0, cur, 1, cur, 1, nxt, 0, 0); }
        }
        { const LAS unsigned char* lastb = F.lds + ((NT - 1) & 3) * STAGE;
#pragma unroll
          for (int s2 = 0; s2 < 2; ++s2)
#pragma unroll
              for (int d = 0; d < 3; ++d) { const LAS unsigned char* vp = lastb + voff + (32 + 16 * s2) * VST + d * 64; const s16x4 v0 = ds_tr16(vp), v1 = ds_tr16(vp + 4 * VST);
                  const bf16x8 vfl = (bf16x8){v0[0], v0[1], v0[2], v0[3], v1[0], v1[1], v1[2], v1[3]}; O[1][d] = __builtin_amdgcn_mfma_f32_32x32x16_bf16(vfl, pb[s2], O[1][d], 0, 0, 0); } }
        const float l0 = l[0] + __shfl_xor(l[0], 32), l1 = l[1] + __shfl_xor(l[1], 32);
        const float i0 = 1.0f / l0, i1 = lam / l1;
        float ss = 0.f;
#pragma unroll
        for (int d = 0; d < 3; ++d)
#pragma unroll
            for (int r = 0; r < 16; ++r) { const float o = O[0][d][r] * i0 - O[1][d][r] * i1; O[0][d][r] = o; ss += o * o; }
        ss += __shfl_xor(ss, 32);
        const float rs = rsqrtf(ss * (1.0f / 96.0f) + LN_EPS) * post;
        bf16* yp = Y + (size_t)tok * YLD + Y_C + h * 96 + 4 * hh;
#pragma unroll
        for (int d = 0; d < 3; ++d)
#pragma unroll
            for (int rg = 0; rg < 4; ++rg) { const f32x4 gv = *(const f32x4*)(ng + d * 32 + 8 * rg + 4 * hh);
                v2u o; o.x = pk2(O[0][d][4 * rg + 0] * rs * gv[0], O[0][d][4 * rg + 1] * rs * gv[1]); o.y = pk2(O[0][d][4 * rg + 2] * rs * gv[2], O[0][d][4 * rg + 3] * rs * gv[3]);
                *(v2u*)(yp + d * 32 + 8 * rg) = o; }
        asm volatile("s_waitcnt vmcnt(0)" ::: "memory"); __builtin_amdgcn_s_barrier(); asm volatile("" ::: "memory");
    }
#undef C_ISSUE
#undef C_RDV
#undef C_ITEM
#undef C_QK0
#undef C_FENCE
}

constexpr int AB_VST = 192, AB_VREG = 32 * AB_VST;
constexpr int L_RPB = 51200;

__device__ __forceinline__ void sm_block64(f32x16& t, float& m, float& l, f32x16 (&O)[2], bf16x8 (&pf)[2]) {
    float mx = fmaxf(t[0], t[1]);
#pragma unroll
    for (int r = 2; r < 16; ++r) mx = fmaxf(mx, t[r]);
    mx = fmaxf(mx, __shfl_xor(mx, 32));
    if (__any(mx > m)) {
        const float mn = fmaxf(m, mx), alpha = __builtin_amdgcn_exp2f(m - mn);
#pragma unroll
        for (int d = 0; d < 2; ++d)
#pragma unroll
            for (int r = 0; r < 16; ++r) O[d][r] *= alpha;
        l *= alpha; m = mn;
    }
#pragma unroll
    for (int r = 0; r < 16; ++r) { t[r] = __builtin_amdgcn_exp2f(t[r] - m); l += t[r]; }
#pragma unroll
    for (int s2 = 0; s2 < 2; ++s2) { v4u pw; pw.x = cvtpk(t[8 * s2 + 0], t[8 * s2 + 1]); pw.y = cvtpk(t[8 * s2 + 2], t[8 * s2 + 3]);
        pw.z = cvtpk(t[8 * s2 + 4], t[8 * s2 + 5]); pw.w = cvtpk(t[8 * s2 + 6], t[8 * s2 + 7]); pf[s2] = __builtin_bit_cast(bf16x8, pw); }
}
template <class TokOf, class MaskT>
__device__ __forceinline__ void attn_run_blocks(const bf16* H, const int kcol, const int vcol, const int nb, const TokOf tok_of, const MaskT mask,
                                                const bf16x8 (&qf)[4], LAS unsigned char* vl, const int lane, f32x16 (&O)[2], float& m, float& l) {
    const int n = lane & 31, hh = lane >> 5, krow = kperm(n), g = lane >> 4, i16 = lane & 15;
    const int vrd = (8 * (g >> 1) + (i16 >> 2)) * AB_VST + (16 * (g & 1) + 4 * (i16 & 3)) * 2;
    bf16x8 kf[4]; v4u vc[4];
    { const bf16* kp = H + (size_t)tok_of(0, krow) * INC + kcol + 8 * hh;
#pragma unroll
      for (int s = 0; s < 4; ++s) kf[s] = *(const bf16x8*)(kp + 16 * s);
#pragma unroll
      for (int i = 0; i < 4; ++i) vc[i] = *(const v4u*)(H + (size_t)tok_of(0, (lane >> 3) + 8 * i) * INC + vcol + (lane & 7) * 8); }
#pragma unroll
    for (int i = 0; i < 4; ++i) *(LAS v4u*)(vl + ((lane >> 3) + 8 * i) * AB_VST + (lane & 7) * 16) = vc[i];
    for (int j = 0; j < nb; ++j) {
        const int jn = (j + 1 < nb) ? j + 1 : j;
        bf16x8 kn[4];
        { const bf16* kp = H + (size_t)tok_of(jn, krow) * INC + kcol + 8 * hh;
#pragma unroll
          for (int s = 0; s < 4; ++s) kn[s] = *(const bf16x8*)(kp + 16 * s);
#pragma unroll
          for (int i = 0; i < 4; ++i) vc[i] = *(const v4u*)(H + (size_t)tok_of(jn, (lane >> 3) + 8 * i) * INC + vcol + (lane & 7) * 8); }
        f32x16 S;
#pragma unroll
        for (int r = 0; r < 16; ++r) S[r] = 0.f;
#pragma unroll
        for (int s = 0; s < 4; ++s) S = __builtin_amdgcn_mfma_f32_32x32x16_bf16(kf[s], qf[s], S, 0, 0, 0);
        mask(j, S);
        bf16x8 pf[2];
        sm_block64(S, m, l, O, pf);
        LDS_WAIT();
#pragma unroll
        for (int s2 = 0; s2 < 2; ++s2)
#pragma unroll
            for (int d = 0; d < 2; ++d) { const LAS unsigned char* vp = vl + vrd + 16 * s2 * AB_VST + d * 64;
                const s16x4 v0 = ds_tr16(vp), v1 = ds_tr16(vp + 4 * AB_VST);
                const bf16x8 vf = (bf16x8){v0[0], v0[1], v0[2], v0[3], v1[0], v1[1], v1[2], v1[3]};
                O[d] = __builtin_amdgcn_mfma_f32_32x32x16_bf16(vf, pf[s2], O[d], 0, 0, 0); }
        LDS_WAIT(); asm volatile("" ::: "memory");
#pragma unroll
        for (int i = 0; i < 4; ++i) *(LAS v4u*)(vl + ((lane >> 3) + 8 * i) * AB_VST + (lane & 7) * 16) = vc[i];
#pragma unroll
        for (int s = 0; s < 4; ++s) kf[s] = kn[s];
    }
    LDS_WAIT(); asm volatile("" ::: "memory");
}
__device__ __forceinline__ void attn_store64(bf16* yrow, const f32x16 (&O)[2], float l, int hh) {
    const float lt = l + __shfl_xor(l, 32), inv = 1.0f / lt;
#pragma unroll
    for (int d = 0; d < 2; ++d)
#pragma unroll
        for (int rg = 0; rg < 4; ++rg) { v2u o; o.x = pk2(O[d][4 * rg + 0] * inv, O[d][4 * rg + 1] * inv); o.y = pk2(O[d][4 * rg + 2] * inv, O[d][4 * rg + 3] * inv);
            *(v2u*)(yrow + d * 32 + 8 * rg + 4 * hh) = o; }
}

__device__ __forceinline__ void attnA_mfma(Frame& F, const float* rpb  ) {
    const bf16* H = (const bf16*)(F.ws + WS_H); bf16* Y = (bf16*)(F.ws + WS_Y);
    LAS float* T = (LAS float*)(F.lds + L_RPB);
    for (int i = F.tid; i < 4 * 17 * 64; i += 512) { const int h = i / (17 * 64), rem = i - h * 17 * 64, ro = rem >> 6, co = rem & 63;
        const int rr = ro - 1, cc = co - 16; T[i] = (rr >= 0 && rr < 15 && cc >= 0 && cc < 31) ? rpb[(h * 15 + rr) * 31 + cc] * 1.4426950408889634f : 0.f; }
    __syncthreads();
    const int lane = F.lane, n = lane & 31, hh = lane >> 5;
    LAS unsigned char* vl = F.lds + F.wave * AB_VREG;
    const int gw = F.bid * 8 + F.wave, NGW = F.G * 8;
    for (int item = gw; item < 4096; item += NGW) {
        const int cb = item & 3, rp = (item >> 2) & 31, h = (item >> 7) & 3, b = item >> 9;
        const int r = 2 * rp + (n >> 4), c = 16 * cb + (n & 15);
        const int r0 = min(max(r - 4, 0), 56), c0 = min(max(c - 8, 0), 48);
        const int cw = min(max(16 * cb - 8, 0), 32);
        const int kr_lo = min(max(2 * rp - 4, 0), 56), kr_hi = min(max(2 * rp + 1 - 4, 0), 56) + 7;
        const int tokq = b * SEQ + r * 64 + c;
        bf16x8 qf[4];
        { const bf16* qp = H + (size_t)tokq * INC + C_QA + h * 64 + 8 * hh;
#pragma unroll
          for (int s = 0; s < 4; ++s) qf[s] = *(const bf16x8*)(qp + 16 * s); }
        f32x16 O[2];
#pragma unroll
        for (int d = 0; d < 2; ++d)
#pragma unroll
            for (int rr = 0; rr < 16; ++rr) O[d][rr] = 0.f;
        float m = -1e30f, l = 0.f;
        const int tok0 = b * SEQ + kr_lo * 64 + cw;
        auto tok_of = [=](int j, int kk) { return tok0 + j * 64 + kk; };
        const int colb = cw - c0 + 8 * hh;
        const int tb0 = (h * 17 + (kr_lo - r + 8)) * 64 + (cw - c + 31) + 8 * hh;
        const int rb = kr_lo - r0;
        auto mask = [=](int j, f32x16& S) {
            const bool rowok = (unsigned)(rb + j) < 8u; const LAS float* tp = T + tb0 + j * 64;
#pragma unroll
            for (int rr = 0; rr < 16; ++rr) { const int e = (rr & 7) + 16 * (rr >> 3);
                const bool ok = rowok && ((unsigned)(colb + e) < 16u);
                S[rr] = ok ? (S[rr] * (0.125f * 1.4426950408889634f) + tp[e]) : -INFINITY; }
        };
        attn_run_blocks(H, C_KA + h * 64, C_VA + h * 64, kr_hi - kr_lo + 1, tok_of, mask, qf, vl, lane, O, m, l);
        attn_store64(Y + (size_t)tokq * YLD + Y_A + h * 64, O, l, hh);
    }
}
__device__ __forceinline__ void attnB_mfma(Frame& F) {
    const bf16* H = (const bf16*)(F.ws + WS_H); bf16* Y = (bf16*)(F.ws + WS_Y);
    const int lane = F.lane, n = lane & 31, hh = lane >> 5;
    LAS unsigned char* vl = F.lds + F.wave * AB_VREG;
    const int gw = F.bid * 8 + F.wave, NGW = F.G * 8;
    for (int item = gw; item < 2048; item += NGW) {
        const int mblk = item & 7, r = (item >> 3) & 15, hg = (item >> 7) & 1, b = item >> 8;
        const int sq = r + 16 * (mblk * 32 + n), tokq = b * SEQ + sq;
        f32x16 O[2];
#pragma unroll
        for (int d = 0; d < 2; ++d)
#pragma unroll
            for (int rr = 0; rr < 16; ++rr) O[d][rr] = 0.f;
        float m = -1e30f, l = 0.f;
#pragma unroll 1
        for (int g = 0; g < 3; ++g) {
            const int sh = 2 * g, dil = 1 << sh, head = 2 * g + hg, L = SEQ >> sh, a = 16 >> sh, cls = r & (dil - 1);
            const int pq0 = (r >> sh) + a * (mblk * 32), pq = pq0 + a * n;
            const int pks = pq0 - 64, nb = (31 * a + 129 + 31) >> 5;
            bf16x8 qf[4];
            { const bf16* qp = H + (size_t)tokq * INC + C_QB + head * 64 + 8 * hh;
#pragma unroll
              for (int s = 0; s < 4; ++s) qf[s] = *(const bf16x8*)(qp + 16 * s); }
            const int tokb = b * SEQ + cls;
            auto tok_of = [=](int j, int kk) { const int pk = min(max(pks + 32 * j + kk, 0), L - 1); return tokb + (pk << sh); };
            const int b1 = pks - pq + 64 + 8 * hh, b2 = pks + 8 * hh;
            auto mask = [=](int j, f32x16& S) {
#pragma unroll
                for (int rr = 0; rr < 16; ++rr) { const int e = (rr & 7) + 16 * (rr >> 3) + 32 * j;
                    const bool ok = ((unsigned)(b1 + e) <= 128u) && ((unsigned)(b2 + e) < (unsigned)L);
                    S[rr] = ok ? S[rr] * (0.125f * 1.4426950408889634f) : -INFINITY; }
            };
            attn_run_blocks(H, C_KB + head * 64, C_VB + head * 64, nb, tok_of, mask, qf, vl, lane, O, m, l);
        }
        attn_store64(Y + (size_t)tokq * YLD + Y_B + hg * 64, O, l, hh);
    }
}

__device__ __forceinline__ void p_ln_router(Frame& F, const Args& a, int layer, bool dry = false) {
    const bf16* PRE = (const bf16*)(F.ws + WS_HH); float* XF = dry ? (float*)(F.ws + WS_H) : a.out; unsigned* XB8 = dry ? (unsigned*)(F.ws + WS_H + 160 * MiB) : (unsigned*)(F.ws + WS_XB8);
    const float* g1 = a.in[10] + layer * 1024; const float* b1 = a.in[11] + layer * 1024; const float* br = a.in[13] + layer * 32;
    const bf16* WT = (const bf16*)(F.ws + WS_WRT) + (size_t)layer * 2 * 32 * 1024;
    int* TOPE = (int*)(F.ws + (dry ? WS_H + 200 * MiB : WS_TOPE)); float* TOPW = (float*)(F.ws + (dry ? WS_H + 201 * MiB : WS_TOPW)); int* RANK = (int*)(F.ws + (dry ? WS_H + 202 * MiB : WS_RANK));
    const int cnt_off = dry ? CW_CUR : CW_CNT; int* SRCp = (int*)(F.ws + (dry ? WS_H + 204 * MiB : WS_SRC));
    LAS int* hist = (LAS int*)(F.lds + L_HIST); LAS int* base = (LAS int*)(F.lds + L_BASE);
    const int lane = F.lane;
    for (int chunk = F.bid; chunk < NTOK / 128; chunk += F.G) {
        if (F.tid < 32) hist[F.tid] = 0;
        __syncthreads();
        const int tok0 = chunk * 128 + F.wave * 16;
        {   f32x4 gv[4], bv[4];
#pragma unroll
            for (int j = 0; j < 4; ++j) { gv[j] = *(const f32x4*)(g1 + 4 * lane + 256 * j); bv[j] = *(const f32x4*)(b1 + 4 * lane + 256 * j); }
#pragma unroll 1
            for (int q = 0; q < 4; ++q) {
                f32x4 v[4][4]; float s[4], s2[4];
#pragma unroll
                for (int t = 0; t < 4; ++t) { const v2u* pr = (const v2u*)(PRE + (size_t)(tok0 + 4 * q + t) * 1024) + lane;
#pragma unroll
                    for (int j = 0; j < 4; ++j) { const v2u pw = pr[64 * j]; v[t][j] = (f32x4){bflo(pw.x), bfhi(pw.x), bflo(pw.y), bfhi(pw.y)}; } }
#pragma unroll
                for (int t = 0; t < 4; ++t) { s[t] = 0.f;
#pragma unroll
                    for (int j = 0; j < 4; ++j) s[t] += (v[t][j][0] + v[t][j][1]) + (v[t][j][2] + v[t][j][3]); }
#pragma unroll
                for (int o = 1; o < 64; o <<= 1) {
#pragma unroll
                    for (int t = 0; t < 4; ++t) s[t] += __shfl_xor(s[t], o); }
#pragma unroll
                for (int t = 0; t < 4; ++t) { const float mean = s[t] * (1.f / 1024.f); s2[t] = 0.f;
#pragma unroll
                    for (int j = 0; j < 4; ++j) { v[t][j] = v[t][j] - mean; s2[t] += (v[t][j][0] * v[t][j][0] + v[t][j][1] * v[t][j][1]) + (v[t][j][2] * v[t][j][2] + v[t][j][3] * v[t][j][3]); } }
#pragma unroll
                for (int o = 1; o < 64; o <<= 1) {
#pragma unroll
                    for (int t = 0; t < 4; ++t) s2[t] += __shfl_xor(s2[t], o); }
#pragma unroll
                for (int t = 0; t < 4; ++t) { const float rstd = rsqrtf(s2[t] * (1.f / 1024.f) + LN_EPS);
                    f32x4* xo = (f32x4*)(XF + (size_t)(tok0 + 4 * q + t) * 1024) + lane; unsigned* xb = XB8 + (size_t)(tok0 + 4 * q + t) * 256 + lane;
#pragma unroll
                    for (int j = 0; j < 4; ++j) { const f32x4 y = v[t][j] * rstd * gv[j] + bv[j]; xo[64 * j] = y; xb[64 * j] = pk4_fp8(y[0], y[1], y[2], y[3], 1.0f); } }
            }
        }
        VM_WAIT(); asm volatile("" ::: "memory");
        const int tk = lane & 15, kq = lane >> 4;
        f32x4 acc[2] = {(f32x4){0.f, 0.f, 0.f, 0.f}, (f32x4){0.f, 0.f, 0.f, 0.f}};
        {   const float* xf = XF + (size_t)(tok0 + tk) * 1024 + 8 * kq;
            const bf16* w0 = WT + (size_t)tk * 1024 + 8 * kq;
#pragma unroll 4
            for (int st = 0; st < 32; ++st) {
                const f32x4 x0 = *(const f32x4*)(xf + 32 * st), x1 = *(const f32x4*)(xf + 32 * st + 4);
                v4u xhw; xhw.x = pk2(x0[0], x0[1]); xhw.y = pk2(x0[2], x0[3]); xhw.z = pk2(x1[0], x1[1]); xhw.w = pk2(x1[2], x1[3]);
                v4u xlw; xlw.x = pk2(x0[0] - bflo(xhw.x), x0[1] - bfhi(xhw.x)); xlw.y = pk2(x0[2] - bflo(xhw.y), x0[3] - bfhi(xhw.y));
                xlw.z = pk2(x1[0] - bflo(xhw.z), x1[1] - bfhi(xhw.z)); xlw.w = pk2(x1[2] - bflo(xhw.w), x1[3] - bfhi(xhw.w));
                const bf16x8 xh = __builtin_bit_cast(bf16x8, xhw), xl = __builtin_bit_cast(bf16x8, xlw);
#pragma unroll
                for (int mb = 0; mb < 2; ++mb) { const bf16x8 wh = *(const bf16x8*)(w0 + (size_t)mb * 16 * 1024 + 32 * st), wl = *(const bf16x8*)(w0 + (size_t)(32 + mb * 16) * 1024 + 32 * st);
                    acc[mb] = __builtin_amdgcn_mfma_f32_16x16x32_bf16(wh, xh, acc[mb], 0, 0, 0);
                    acc[mb] = __builtin_amdgcn_mfma_f32_16x16x32_bf16(wh, xl, acc[mb], 0, 0, 0);
                    acc[mb] = __builtin_amdgcn_mfma_f32_16x16x32_bf16(wl, xh, acc[mb], 0, 0, 0); }
            }
        }
        float v8[8];
#pragma unroll
        for (int mb = 0; mb < 2; ++mb)
#pragma unroll
            for (int i = 0; i < 4; ++i) v8[mb * 4 + i] = acc[mb][i] + br[16 * mb + 4 * kq + i];
        int se[4]; float sv[4];
#pragma unroll
        for (int r = 0; r < 4; ++r) {
            float bvv = v8[0]; int bi = 4 * kq;
#pragma unroll
            for (int sl = 1; sl < 8; ++sl) { const int eid = 16 * (sl >> 2) + 4 * kq + (sl & 3); if (v8[sl] > bvv) { bvv = v8[sl]; bi = eid; } }
#pragma unroll
            for (int o = 16; o < 64; o <<= 1) { const float ov = __shfl_xor(bvv, o); const int oi = __shfl_xor(bi, o);
                if (ov > bvv || (ov == bvv && oi < bi)) { bvv = ov; bi = oi; } }
            se[r] = bi; sv[r] = bvv;
#pragma unroll
            for (int sl = 0; sl < 8; ++sl) { const int eid = 16 * (sl >> 2) + 4 * kq + (sl & 3); if (eid == bi) v8[sl] = -3.0e38f; }
        }
        const float p1 = __expf(sv[1] - sv[0]), p2 = __expf(sv[2] - sv[0]), p3 = __expf(sv[3] - sv[0]);
        const float inv = 1.0f / (1.0f + p1 + p2 + p3);
        int lr[4] = {0, 0, 0, 0};
        if (lane < 16) { const int tok = tok0 + tk;
            *(int4*)(TOPE + tok * 4) = make_int4(se[0], se[1], se[2], se[3]);
            *(f32x4*)(TOPW + tok * 4) = (f32x4){inv, p1 * inv, p2 * inv, p3 * inv};
#pragma unroll
            for (int k = 0; k < 4; ++k) lr[k] = __hip_atomic_fetch_add(&hist[se[k]], 1, __ATOMIC_RELAXED, __HIP_MEMORY_SCOPE_WORKGROUP); }
        __syncthreads();
        if (F.tid < 32) { const int c = hist[F.tid]; base[F.tid] = c ? (int)__hip_atomic_fetch_add(F.ctl + cnt_off + layer * 64 + F.tid, (unsigned)c, RLX_AGENT) : 0; }
        __syncthreads();
        if (lane < 16) { const int tok = tok0 + tk;
            const int r0 = base[se[0]] + lr[0], r1 = base[se[1]] + lr[1], r2 = base[se[2]] + lr[2], r3 = base[se[3]] + lr[3];
            *(int4*)(RANK + tok * 4) = make_int4(r0, r1, r2, r3);
            int* SRC = SRCp; SRC[se[0] * NTOK + r0] = tok; SRC[se[1] * NTOK + r1] = tok; SRC[se[2] * NTOK + r2] = tok; SRC[se[3] * NTOK + r3] = tok; }
        __syncthreads();
    }
}

__device__ __forceinline__ int moe_build(Frame& F, int layer) {
    LAS int* offT = (LAS int*)(F.lds + L_OFFT); LAS int* tile_e = (LAS int*)(F.lds + L_TILE);
    __syncthreads();
    if (F.tid < 64) {
        const int c = (F.lane < 32) ? (int)__hip_atomic_load(F.ctl + CW_CNT + layer * 64 + F.lane, RLX_AGENT) : 0;
        const int ntile = (c + 255) >> 8; int x = ntile;
#pragma unroll
        for (int d = 1; d < 32; d <<= 1) { const int v = __shfl_up(x, d); if (F.lane >= d) x += v; }
        if (F.lane < 32) { offT[F.lane] = x - ntile; ((LAS int*)(F.lds + L_CNT))[F.lane] = c; }
        if (F.lane == 31) offT[32] = x;
    }
    __syncthreads();
    int T = __builtin_amdgcn_readfirstlane(offT[32]); if (T > MAXT) T = MAXT;
    for (int mt = F.tid; mt < T; mt += 512) { int e = 0;
#pragma unroll 1
        for (int j = 1; j < 32; ++j) if (offT[j] <= mt) e = j;
        tile_e[mt] = e; }
    __syncthreads();
    return T;
}

__device__ __forceinline__ void p_combine_ln(Frame& F, const Args& a, int layer, bool dry = false) {
    const bool last_layer = (layer == DEPTH - 1) || dry;
    float* XF = a.out; float* XFo = dry ? (float*)(F.ws + WS_HH) : a.out; bf16* XB = (bf16*)(F.ws + (dry ? WS_M : WS_XB)); const unsigned char* YS = (const unsigned char*)(F.ws + WS_H);
    const int* TOPE = (const int*)(F.ws + WS_TOPE); const int* RANK = (const int*)(F.ws + WS_RANK); const float* TOPW = (const float*)(F.ws + WS_TOPW);
    const LAS int* offT = (const LAS int*)(F.lds + L_OFFT);
    const float* g2 = a.in[20] + layer * 1024; const float* b2 = a.in[21] + layer * 1024;
    const int gw = F.bid * 8 + F.wave, NGW = F.G * 8, lane = F.lane;
    f32x4 gv[4], bv[4];
#pragma unroll
    for (int j = 0; j < 4; ++j) { gv[j] = *(const f32x4*)(g2 + 4 * lane + 256 * j); bv[j] = *(const f32x4*)(b2 + 4 * lane + 256 * j); }
    for (int tp = gw; tp < NTOK / 2; tp += NGW) {
        f32x4 v[2][4]; unsigned yw[2][4][4]; f32x4 tw[2];
#pragma unroll
        for (int u = 0; u < 2; ++u) { const int tok = tp * 2 + u;
            const int4 te = *(const int4*)(TOPE + tok * 4), rk = *(const int4*)(RANK + tok * 4); tw[u] = *(const f32x4*)(TOPW + tok * 4);
            const f32x4* xr = (const f32x4*)(XF + (size_t)tok * 1024) + lane;
#pragma unroll
            for (int j = 0; j < 4; ++j) v[u][j] = xr[64 * j];
            const int pk[4] = {offT[te.x] * 256 + rk.x, offT[te.y] * 256 + rk.y, offT[te.z] * 256 + rk.z, offT[te.w] * 256 + rk.w};
#pragma unroll
            for (int k = 0; k < 4; ++k) { const unsigned* yr = (const unsigned*)(YS + (size_t)pk[k] * 1024) + lane;
#pragma unroll
                for (int j = 0; j < 4; ++j) yw[u][k][j] = yr[64 * j]; } }
        float s[2], s2[2];
#pragma unroll
        for (int u = 0; u < 2; ++u) {
#pragma unroll
            for (int j = 0; j < 4; ++j) { v[u][j] = v[u][j] * DN_ALPHA;
#pragma unroll
                for (int k = 0; k < 4; ++k) { const int y = (int)yw[u][k][j]; v[u][j] = v[u][j] + (tw[u][k] * (1.0f / 16.0f)) * (f32x4){__builtin_amdgcn_cvt_f32_fp8(y, 0), __builtin_amdgcn_cvt_f32_fp8(y, 1), __builtin_amdgcn_cvt_f32_fp8(y, 2), __builtin_amdgcn_cvt_f32_fp8(y, 3)}; } }
            s[u] = 0.f;
#pragma unroll
            for (int j = 0; j < 4; ++j) s[u] += (v[u][j][0] + v[u][j][1]) + (v[u][j][2] + v[u][j][3]); }
#pragma unroll
        for (int o = 1; o < 64; o <<= 1) { s[0] += __shfl_xor(s[0], o); s[1] += __shfl_xor(s[1], o); }
#pragma unroll
        for (int u = 0; u < 2; ++u) { const float mean = s[u] * (1.f / 1024.f); s2[u] = 0.f;
#pragma unroll
            for (int j = 0; j < 4; ++j) { v[u][j] = v[u][j] - mean; s2[u] += (v[u][j][0] * v[u][j][0] + v[u][j][1] * v[u][j][1]) + (v[u][j][2] * v[u][j][2] + v[u][j][3] * v[u][j][3]); } }
#pragma unroll
        for (int o = 1; o < 64; o <<= 1) { s2[0] += __shfl_xor(s2[0], o); s2[1] += __shfl_xor(s2[1], o); }
#pragma unroll
        for (int u = 0; u < 2; ++u) { const int tok = tp * 2 + u; const float rstd = rsqrtf(s2[u] * (1.f / 1024.f) + LN_EPS);
            f32x4* xo = (f32x4*)(XFo + (size_t)tok * 1024) + lane; v2u* xb = (v2u*)(XB + (size_t)tok * 1024) + lane; unsigned* x8 = (unsigned*)(F.ws + (dry ? WS_M + 32 * MiB : WS_XB8)) + (size_t)tok * 256 + lane;
#pragma unroll
            for (int j = 0; j < 4; ++j) { const f32x4 y = v[u][j] * rstd * gv[j] + bv[j]; if (last_layer) xo[64 * j] = y; xb[64 * j] = (v2u){pk2(y[0], y[1]), pk2(y[2], y[3])}; x8[64 * j] = pk4_fp8(y[0], y[1], y[2], y[3], 1.0f); } }
    }
}

__device__ __forceinline__ const Args* fresh_args() { unsigned long long p = (unsigned long long)__builtin_amdgcn_kernarg_segment_ptr(); asm volatile("" : "+s"(p)); return (const Args*)(const __attribute__((address_space(4))) void*)p; }
constexpr int PH_PER_LAYER = 10, N_PHASES = 1 + DEPTH * PH_PER_LAYER;
__global__ void __launch_bounds__(512, 2) mk_fwd(Args args) {
    extern __shared__ __attribute__((aligned(16))) unsigned char lds[];
    Frame F;
    F.lds = (LAS unsigned char*)lds; F.tid = threadIdx.x; F.lane = F.tid & 63; F.wave = __builtin_amdgcn_readfirstlane(F.tid >> 6);
    F.G = gridDim.x; F.bid = blockIdx.x; F.ws = fresh_args()->ws; F.ctl = (unsigned*)(F.ws + WS_CTL);
    for (int u = F.tid; u < (LDS_BYTES - LDSCTL_OFF) / 4; u += 512) ((LAS unsigned*)(F.lds + LDSCTL_OFF))[u] = 0u;
    __syncthreads();
    const int lo = fresh_args()->ph_lo, hi = fresh_args()->ph_hi;
    XcdBarrier bar; bar.bar = F.ctl + CW_BAR; bar.x = 0; bar.st = nullptr;
    if (hi - lo > 1) bar = xcd_barrier_post(F.ctl + CW_BAR, (volatile LAS unsigned*)(F.lds + L_MISC) + 8);
#define IN(k) (lo <= (k) && (k) < hi)
#define REFRESH() do { F.tid = opaque_tid(); F.lane = F.tid & 63; F.wave = __builtin_amdgcn_readfirstlane(F.tid >> 6); asm volatile("" : "+s"(F.bid), "+s"(F.G)); } while (0)
#define SEAM(k) do { if ((k) + 1 < hi) xcd_barrier(bar); } while (0)

#ifndef NO_P0
    if (IN(0)) { _Pragma("unroll") for (int rep = 0; rep < REP_T; ++rep) p_prologue(F, *fresh_args()); SEAM(0); }
#endif

    for (int l = 0; l < DEPTH; ++l) {
        const int pb = 1 + l * PH_PER_LAYER;
#ifndef NO_P1
        if (IN(pb + 0)) {
            REFRESH();
            {
                pg8::DenseOrder S{(const char*)(F.ws + WS_XB), (const char*)(F.ws + WS_WIN) + (size_t)l * INC * 1024 * 2, (size_t)256 * 1024 * 2, (size_t)256 * 1024 * 2, 16, NTOK / 256, 12, F.G, F.bid};
                pg8::EpiInProj E{(bf16*)(F.ws + WS_H), fresh_args()->in[2] + l * 3072, (const f32x2*)(F.ws + WS_ROPE64), (const f32x2*)(F.ws + WS_ROPE48), 1.0f, (unsigned char*)(F.ws + WS_G8), F.lds};
                _Pragma("unroll") for (int rep = 0; rep < REP_G1; ++rep) pg8::gemm_phase<pg8::EpiInProj, pg8::DenseOrder, true, true>(F.lds, 1024, 1024, S, E);
            }
            {
                REFRESH();
                pg8::DenseOrder S{(const char*)(F.ws + WS_XB8), (const char*)(F.ws + WS_WIN8) + (size_t)l * 3072 * 1024, (size_t)256 * 1024, (size_t)256 * 1024, 8, NTOK / 256, 12, F.G, F.bid, 12};
                pg8::EpiInProj E{(bf16*)(F.ws + WS_H), fresh_args()->in[2] + l * 3072, (const f32x2*)(F.ws + WS_ROPE64), (const f32x2*)(F.ws + WS_ROPE48), 1.0f / 32.0f, (unsigned char*)(F.ws + WS_G8), F.lds};
                _Pragma("unroll") for (int rep = 0; rep < REP_G1; ++rep) pg8::gemm_phase<pg8::EpiInProj, pg8::DenseOrder, true, true, true>(F.lds, 1024, 1024, S, E);
            }
            if (pb + 2 < hi) xcd_barrier(bar);
        }
#endif
#ifndef NO_P1B
#endif
        if (IN(pb + 2)) {
            REFRESH();
#ifndef NO_PC
            _Pragma("unroll") for (int rep = 0; rep < REP_C; ++rep) attnC_pipe(F, fresh_args()->in[8] + l * 4 * 48, fresh_args()->in[9] + l * 96, fresh_args()->lam_init[l]);
#endif
#ifndef NO_PA
            REFRESH();
            _Pragma("unroll") for (int rep = 0; rep < REP_AB; ++rep) attnA_mfma(F, fresh_args()->in[7] + l * 4 * 15 * 31);
#endif
#ifndef NO_PB
            REFRESH();
            _Pragma("unroll") for (int rep = 0; rep < REP_AB; ++rep) attnB_mfma(F);
#endif
            SEAM(pb + 2);
        }
#ifndef NO_P3
        if (IN(pb + 3)) {
            REFRESH();
            pg8::ProjOrder S{(const char*)(F.ws + WS_Y), (const char*)(F.ws + WS_WPROJ) + (size_t)l * 1024 * WPK * 2, NTOK / 256, 4, F.G, F.bid};
            pg8::EpiProj E{(const unsigned char*)(F.ws + WS_G8), (bf16*)(F.ws + WS_M)};
            _Pragma("unroll") for (int rep = 0; rep < REP_G3; ++rep) pg8::gemm_phase<pg8::EpiProj, pg8::ProjOrder, true, true>(F.lds, YLD, WPK, S, E);
            SEAM(pb + 3);
        }
#endif
#ifndef NO_P4
        if (IN(pb + 4)) {
            REFRESH();
            pg8::DenseOrder S{(const char*)(F.ws + WS_M), (const char*)(F.ws + WS_WOUT) + (size_t)l * 1024 * 1024 * 2, (size_t)256 * 1024 * 2, (size_t)256 * 1024 * 2, 16, NTOK / 256, 4, F.G, F.bid};
            pg8::EpiOut E{l == 0 ? fresh_args()->in[0] : (const float*)nullptr, (const bf16*)(F.ws + WS_XB), (bf16*)(F.ws + WS_HH)};
            _Pragma("unroll") for (int rep = 0; rep < REP_G4; ++rep) pg8::gemm_phase<pg8::EpiOut, pg8::DenseOrder, true, true>(F.lds, 1024, 1024, S, E);
            SEAM(pb + 4);
        }
#endif
#ifndef NO_P5
        if (IN(pb + 5)) { REFRESH(); if (DRY_P5) p_ln_router(F, *fresh_args(), l, true); p_ln_router(F, *fresh_args(), l); if (pb + 7 < hi) xcd_barrier(bar); }
#endif
#ifndef NO_P5B
#endif
#ifndef NO_P6
        if (IN(pb + 7)) {
            REFRESH(); const int T = moe_build(F, l);
            pg8::MoeOrder S{(const char*)(F.ws + WS_XB8), (const char*)(F.ws + WS_WGU) + (size_t)l * NEXP * 2048 * 1024, (size_t)2048 * 1024, (size_t)256 * 1024, (size_t)256 * 1024, 8,
                            (const LAS int*)(F.lds + L_TILE), (const LAS int*)(F.lds + L_OFFT), (const LAS int*)(F.lds + L_CNT), (const int*)(F.ws + WS_SRC), T, 8, F.G, F.bid};
            pg8::EpiSwiglu E{(unsigned char*)(F.ws + WS_HH), fresh_args()->in[15] + (size_t)l * NEXP * 1024, fresh_args()->in[17] + (size_t)l * NEXP * 1024, 1.0f / 32.0f, F.lds};
            _Pragma("unroll") for (int rep = 0; rep < REP_G6; ++rep) pg8::gemm_phase_gather<pg8::EpiSwiglu, pg8::MoeOrder, true>(F.lds, (const char*)(F.ws + WS_XB8), 1024, 1024, S, E);
            SEAM(pb + 7);
        }
#endif
#ifndef NO_P7
        if (IN(pb + 8)) {
            REFRESH(); const int T = moe_build(F, l);
            pg8::MoeOrder S{(const char*)(F.ws + WS_HH), (const char*)(F.ws + WS_WDN) + (size_t)l * NEXP * 1024 * 1024, (size_t)1024 * 1024, (size_t)256 * 1024, (size_t)256 * 1024, 8,
                            (const LAS int*)(F.lds + L_TILE), (const LAS int*)(F.lds + L_OFFT), (const LAS int*)(F.lds + L_CNT), (const int*)(F.ws + WS_SRC), T, 4, F.G, F.bid};
            pg8::EpiDown E{(unsigned char*)(F.ws + WS_H), fresh_args()->in[19] + (size_t)l * NEXP * 1024, 1.0f / 256.0f, F.lds};
            _Pragma("unroll") for (int rep = 0; rep < REP_G7; ++rep) pg8::gemm_phase<pg8::EpiDown, pg8::MoeOrder, true, true, true>(F.lds, 1024, 1024, S, E);
            SEAM(pb + 8);
        }
#endif
#ifndef NO_P8
        if (IN(pb + 9)) { REFRESH(); (void)moe_build(F, l); if (DRY_P8) p_combine_ln(F, *fresh_args(), l, true); p_combine_ln(F, *fresh_args(), l); SEAM(pb + 9); }
#endif
    }
#undef IN
#undef SEAM
}

extern "C" void kernel_launch(void* const* d_in, const int* in_sizes, int n_in, void* d_out, int out_size, void* d_ws, size_t ws_size, hipStream_t stream) {
    static int grid = 0;
    if (grid == 0) {
        if (n_in != 22 || in_sizes[0] != NTOK * D || out_size != NTOK * D || ws_size < WS_END) {
            fprintf(stderr, "kernel_launch: unexpected shapes (n_in %d, in0 %d, out %d, ws %zu); nothing launched\n", n_in, n_in > 0 ? in_sizes[0] : -1, out_size, ws_size); grid = -1; return; }
        int dev = 0, cus = 0, per_cu = 0;
        if (hipGetDevice(&dev) != hipSuccess || hipDeviceGetAttribute(&cus, hipDeviceAttributeMultiprocessorCount, dev) != hipSuccess) { grid = -1; return; }
        if (hipFuncSetAttribute((const void*)mk_fwd, hipFuncAttributeMaxDynamicSharedMemorySize, LDS_BYTES) != hipSuccess) { fprintf(stderr, "kernel_launch: hipFuncSetAttribute failed\n"); grid = -1; return; }
        if (hipOccupancyMaxActiveBlocksPerMultiprocessor(&per_cu, (const void*)mk_fwd, 512, LDS_BYTES) != hipSuccess || per_cu < 1)
            fprintf(stderr, "kernel_launch: note: occupancy query reports %d workgroups per CU\n", per_cu);
        (void)hipGetLastError();
        grid = cus;
    }
    if (grid < 0) return;
    if (hipMemsetAsync((char*)d_ws + WS_CTL, 0, CTL_ZERO_BYTES, stream) != hipSuccess) { fprintf(stderr, "kernel_launch: memset failed\n"); return; }
    Args a{};
    for (int i = 0; i < 22; ++i) a.in[i] = (const float*)d_in[i];
    a.out = (float*)d_out; a.ws = (unsigned char*)d_ws;
    for (int l = 0; l < DEPTH; ++l) a.lam_init[l] = (float)(0.8 - 0.6 * exp(-0.3 * (double)l));
#if MK_ONE_LAUNCH
    a.ph_lo = 0; a.ph_hi = N_PHASES;
    hipLaunchKernelGGL(mk_fwd, dim3(grid), dim3(512), LDS_BYTES, stream, a);
#else
    for (int p = 0; p < N_PHASES; ++p) {
        a.ph_lo = p; a.ph_hi = p + 1;
        hipLaunchKernelGGL(mk_fwd, dim3(grid), dim3(512), LDS_BYTES, stream, a);
    }
#endif
    const hipError_t le = hipPeekAtLastError();
    if (le != hipSuccess) fprintf(stderr, "kernel_launch: launch failed: %s\n", hipGetErrorName(le));
}
```

```cpp
#include <hip/hip_runtime.h>
#include <cstdio>
#include <cstdint>
#include <cmath>

#ifndef REP_AB
#define REP_AB 1
#endif
#ifndef REP_C
#define REP_C 1
#endif
#ifndef REP_G
#define REP_G 1
#endif
#ifndef REP_G1
#define REP_G1 REP_G
#endif
#ifndef REP_G3
#define REP_G3 REP_G
#endif
#ifndef REP_G4
#define REP_G4 REP_G
#endif
#ifndef REP_G6
#define REP_G6 REP_G
#endif
#ifndef REP_G7
#define REP_G7 REP_G
#endif
#ifndef REP_T
#define REP_T 1
#endif
#ifndef DRY_P5
#define DRY_P5 0
#endif
#ifndef DRY_P8
#define DRY_P8 0
#endif
#ifndef C_ANTIPHASE
#define C_ANTIPHASE 0
#endif
#ifndef MK_ONE_LAUNCH
#define MK_ONE_LAUNCH 1
#endif

#define GAS __attribute__((address_space(1)))
#define LAS __attribute__((address_space(3)))
typedef unsigned short bf16;
typedef unsigned v4u __attribute__((ext_vector_type(4)));
typedef unsigned v2u __attribute__((ext_vector_type(2)));
typedef float f32x4 __attribute__((ext_vector_type(4)));
typedef float f32x2 __attribute__((ext_vector_type(2)));
typedef short bf16x8 __attribute__((ext_vector_type(8)));

constexpr int NTOK = 32768, SEQ = 4096, D = 1024, DEPTH = 4, INC = 6144, NEXP = 32, TOPK = 4;
constexpr int C_QA = 0, C_KA = 256, C_VA = 512, C_QB = 768, C_KB = 1152, C_VB = 1536, C_QC = 1920, C_KC = 2304, C_VC = 2688, C_GP = 3072;
constexpr int YLD = 768, Y_A = 0, Y_B = 256, Y_C = 384;
constexpr int WPK = 896;
constexpr int MAXT = 544;
constexpr float LN_EPS = 1e-5f;
constexpr float DN_ALPHA = 1.681792830507429f;

constexpr size_t MiB = 1u << 20;
constexpr size_t WS_CTL = 0, CTL_ZERO_BYTES = 1 * MiB;
constexpr size_t WS_ROPE64 = 1 * MiB;
constexpr size_t WS_ROPE48 = 2 * MiB;
constexpr size_t WS_TOPE = 3 * MiB;
constexpr size_t WS_TOPW = 3 * MiB + 512 * 1024;
constexpr size_t WS_POS = 4 * MiB;
constexpr size_t WS_WIN = 8 * MiB;
constexpr size_t WS_WPROJ = 56 * MiB;
constexpr size_t WS_WOUT = 64 * MiB;
constexpr size_t WS_WGU = 72 * MiB;
constexpr size_t WS_WDN = 584 * MiB;
constexpr size_t WS_XB = 840 * MiB;
constexpr size_t WS_Y = 904 * MiB;
constexpr size_t WS_M = 952 * MiB;
constexpr size_t WS_H = 1016 * MiB;
constexpr size_t WS_HH = 1400 * MiB;
constexpr int WRT_LAYER = 2 * 32 * 1024 + 128;
constexpr size_t WS_WRT = 5 * MiB;
constexpr size_t WS_RANK = 6 * MiB;
constexpr size_t WS_SRC = 1672 * MiB;
constexpr size_t WS_XB8 = 1676 * MiB;
constexpr size_t WS_WIN8 = 1708 * MiB;
constexpr size_t WS_G8 = 1720 * MiB;
constexpr size_t WS_END = 1816 * MiB;
constexpr int CW_BAR = 4096;
constexpr int CW_CNT = 8192;
constexpr int CW_CUR = 8192 + 4 * 64;

constexpr int RING_BYTES = 131072;
constexpr int LDSCTL_OFF = RING_BYTES;
constexpr int L_MISC = LDSCTL_OFF;
constexpr int L_OFFT = LDSCTL_OFF + 256;
constexpr int L_HIST = LDSCTL_OFF + 512;
constexpr int L_BASE = LDSCTL_OFF + 768;
constexpr int L_CNT = LDSCTL_OFF + 896;
constexpr int L_TILE = LDSCTL_OFF + 1024;
constexpr int L_PPOS = LDSCTL_OFF + 4096;
constexpr int L_PTOK = LDSCTL_OFF + 6144;
constexpr int LDS_BYTES = 147456;
static_assert(L_PTOK + 2048 <= LDS_BYTES, "LDS map");

#define RLX_AGENT __ATOMIC_RELAXED, __HIP_MEMORY_SCOPE_AGENT
#define LDS_WAIT() asm volatile("s_waitcnt lgkmcnt(0)" ::: "memory")
#define VM_WAIT() asm volatile("s_waitcnt vmcnt(0)" ::: "memory")

__device__ __forceinline__ float bf2f(unsigned short b) { return __uint_as_float(((unsigned)b) << 16); }
__device__ __forceinline__ float bflo(unsigned u) { return __uint_as_float(u << 16); }
__device__ __forceinline__ float bfhi(unsigned u) { return __uint_as_float(u & 0xffff0000u); }
__device__ __forceinline__ unsigned f2bf(float f) { unsigned u = __builtin_bit_cast(unsigned, f); return (u + 0x7fffu + ((u >> 16) & 1u)) >> 16; }
typedef float pk2_f32x2 __attribute__((ext_vector_type(2)));
typedef __bf16 pk2_bf16x2 __attribute__((ext_vector_type(2)));
__device__ __forceinline__ unsigned pk2(float lo, float hi) { const pk2_f32x2 v = {lo, hi}; const pk2_bf16x2 b = __builtin_convertvector(v, pk2_bf16x2); return __builtin_bit_cast(unsigned, b); }
__device__ __forceinline__ float shx(float v, int o, int lane) { return __int_as_float(__builtin_amdgcn_ds_bpermute((lane ^ o) << 2, __float_as_int(v))); }
__device__ __forceinline__ int shxi(int v, int o, int lane) { return __builtin_amdgcn_ds_bpermute((lane ^ o) << 2, v); }
__device__ __forceinline__ float wave_sum(float v, int lane) {
#pragma unroll
    for (int o = 1; o < 64; o <<= 1) v += shx(v, o, lane);
    return v;
}
__device__ __forceinline__ int opaque_tid(int wv) { int l; asm volatile("v_mbcnt_lo_u32_b32 %0, -1, 0\n\tv_mbcnt_hi_u32_b32 %0, -1, %0" : "=v"(l)); return wv * 64 + l; }
__device__ __forceinline__ unsigned pk4_fp8(float a, float b, float c, float d, float sc) {
    a = fminf(fmaxf(a * sc, -448.f), 448.f); b = fminf(fmaxf(b * sc, -448.f), 448.f); c = fminf(fmaxf(c * sc, -448.f), 448.f); d = fminf(fmaxf(d * sc, -448.f), 448.f);
    int p = __builtin_amdgcn_cvt_pk_fp8_f32(a, b, 0, false); p = __builtin_amdgcn_cvt_pk_fp8_f32(c, d, p, true); return (unsigned)p; }
__device__ __forceinline__ unsigned pk4_fp8_nc(float a, float b, float c, float d) {
    int p = __builtin_amdgcn_cvt_pk_fp8_f32(a, b, 0, false); p = __builtin_amdgcn_cvt_pk_fp8_f32(c, d, p, true); return (unsigned)p; }
__device__ __forceinline__ float fast_sigmoid(float x) { return __builtin_amdgcn_rcpf(1.0f + __builtin_amdgcn_exp2f(-1.4426950408889634f * x)); }

namespace pg8 {
#define PG8_LAS __attribute__((address_space(3)))
typedef unsigned short bf16_t;
typedef unsigned u32x4 __attribute__((ext_vector_type(4)));
constexpr int BM = 256, BK = 64, HALF = 128, HTB = HALF * BK * 2, STAGE_BYTES = 8 * HTB, NXCD = 8, WGM = 8;

__host__ __device__ __forceinline__ int lds_byte(int r, int c) { const int st = (r >> 4) * 2 + (c >> 5), rr = r & 15, cc = c & 31, ob = rr * 64 + cc * 2; return st * 1024 + (ob ^ (((ob >> 9) & 1) << 5)); }
__host__ __device__ __forceinline__ void stage_rc(int b, int& R, int& C) { const int st = b / 1024, sb = b % 1024, swz = sb ^ (((sb >> 9) & 1) << 5); R = (st >> 1) * 16 + swz / 64; C = (st & 1) * 32 + (swz % 64) / 2; }
__host__ __device__ __forceinline__ int perm32(int rho) { const int n = rho >> 4, i = rho & 15; return 8 * (i >> 2) + 4 * n + (i & 3); }

struct Unit { const char* A; const char* B; int nt; int pm, pn, aux; int bs; };

constexpr int L_BIAS_OFF = 139264;
__device__ __forceinline__ void glds16_u(const void* gsrc, unsigned lds_dst) { unsigned keep;
    asm volatile("s_mov_b32 %0, m0\n\ts_mov_b32 m0, %2\n\ts_nop 0\n\tglobal_load_lds_dwordx4 %1, off\n\ts_mov_b32 m0, %0" : "=&s"(keep) : "v"(gsrc), "s"(lds_dst) : "memory"); }
__device__ __forceinline__ void glds16_s(const void* sbase, unsigned voff, unsigned lds_dst) { unsigned keep;
    asm volatile("s_mov_b32 %0, m0\n\ts_mov_b32 m0, %3\n\ts_nop 0\n\tglobal_load_lds_dwordx4 %1, %2\n\ts_mov_b32 m0, %0" : "=&s"(keep) : "v"(voff), "s"(sbase), "s"(lds_dst) : "memory"); }
__device__ __forceinline__ void tile_of(int L, int nM, int nN, int& pm, int& pn) {
    const int nwg = nM * nN;
    int wgid = L; { const int q = nwg / NXCD, r = nwg % NXCD, xcd = wgid % NXCD, off = wgid / NXCD; wgid = (xcd < r ? xcd * (q + 1) : r * (q + 1) + (xcd - r) * q) + off; }
    const int nig = WGM * nN, gid = wgid / nig, fm = gid * WGM, gsz = (nM - fm) < WGM ? (nM - fm) : WGM;
    pm = fm + ((wgid % nig) % gsz); pn = (wgid % nig) / gsz;
}

__device__ __forceinline__ unsigned cvt_pk_bf16(float lo, float hi) { unsigned r; asm volatile("v_cvt_pk_bf16_f32 %0, %1, %2" : "=v"(r) : "v"(lo), "v"(hi)); return r; }
typedef int v8i32 __attribute__((ext_vector_type(8)));
typedef short s16x16 __attribute__((ext_vector_type(16)));
typedef int v4i32 __attribute__((ext_vector_type(4)));
__device__ __forceinline__ v8i32 cat8(bf16x8 lo, bf16x8 hi) { const v4i32 a = __builtin_bit_cast(v4i32, lo), b = __builtin_bit_cast(v4i32, hi); return __builtin_shufflevector(a, b, 0, 1, 2, 3, 4, 5, 6, 7); }

template <class Epi, class Sched, bool ALIGN_EPI, bool SP2, bool FP8 = false, int ABLK = 0>
__device__ __forceinline__ void gemm_phase(PG8_LAS unsigned char* lds, const int lda, const int ldb, const Sched& S, const Epi& E, const int wv) {
    constexpr int EB = FP8 ? 1 : 2;
    const int tid = opaque_tid(wv), wid = wv, lane = tid & 63, wr = wid >> 2, wc = wid & 3, fr = lane & 15, fq = lane >> 4;
    unsigned voffA[2], voffB[2];
#pragma unroll
    for (int i = 0; i < 2; ++i) { int R, C; stage_rc(tid * 16 + i * 8192, R, C);
        const int Rb = Epi::PERM2 ? (64 * (R >> 5) + 16 * ((R >> 2) & 3) + 4 * ((R >> 4) & 1) + (R & 3)) : Epi::PERM ? ((R & ~31) + perm32(R & 31)) : R;
        voffA[i] = ABLK ? (unsigned)(((C * 2) / (ABLK ? ABLK : 1)) * 256 * ABLK + R * ABLK + (C * 2) % (ABLK ? ABLK : 1)) : (unsigned)(R * lda * EB + C * 2); voffB[i] = (unsigned)(Rb * ldb * EB + C * 2); }
    const size_t kstep = (size_t)(BK * 2), kstepA = ABLK ? (size_t)32768 : kstep;
    const size_t hA = ABLK ? (size_t)(HALF * ABLK) : (size_t)HALF * lda * EB, hB = (size_t)(Epi::PERM2 ? 8 : HALF) * ldb * EB;
    const unsigned ldsw = (unsigned)wid * 1024u;
    const int fcol = fq * 8;
    const int aoff = lds_byte(wr * 64 + fr, fcol), boff = lds_byte(wc * 32 + fr, fcol);
#define PG8_SA(b, h) (((b) * 2 + (h)) * HTB)
#define PG8_SB(b, h) ((4 + (b) * 2 + (h)) * HTB)
#define PG8_STAGE(bufoff, gbase, voff) do { _Pragma("unroll") for (int _i = 0; _i < 2; ++_i) \
        __builtin_amdgcn_global_load_lds((const unsigned*)((const char*)(gbase) + (voff)[_i]), (PG8_LAS unsigned*)(lds + (bufoff) + ldsw + _i * 8192), 16, 0, 0); } while (0)
#define PG8_LDA(dst, b, h) do { if constexpr (FP8) { _Pragma("unroll") for (int m = 0; m < 4; ++m) dst##8[m] = cat8(*(const PG8_LAS bf16x8*)(lds + PG8_SA(b, h) + aoff + m * 2048), *(const PG8_LAS bf16x8*)(lds + PG8_SA(b, h) + aoff + m * 2048 + 1024)); } else { \
        _Pragma("unroll") for (int m = 0; m < 4; ++m) _Pragma("unroll") for (int k = 0; k < 2; ++k) dst[m][k] = *(const PG8_LAS bf16x8*)(lds + PG8_SA(b, h) + aoff + m * 2048 + k * 1024); } } while (0)
#define PG8_LDB(dst, b, h) do { if constexpr (FP8) { _Pragma("unroll") for (int n = 0; n < 2; ++n) dst##8[n] = cat8(*(const PG8_LAS bf16x8*)(lds + PG8_SB(b, h) + boff + n * 2048), *(const PG8_LAS bf16x8*)(lds + PG8_SB(b, h) + boff + n * 2048 + 1024)); } else { \
        _Pragma("unroll") for (int n = 0; n < 2; ++n) _Pragma("unroll") for (int k = 0; k < 2; ++k) dst[n][k] = *(const PG8_LAS bf16x8*)(lds + PG8_SB(b, h) + boff + n * 2048 + k * 1024); } } while (0)
#define PG8_MMA(ai, bj, At, Bt) do { __builtin_amdgcn_s_setprio(1); if constexpr (FP8) { _Pragma("unroll") for (int m = 0; m < 4; ++m) _Pragma("unroll") for (int n = 0; n < 2; ++n) \
        asm volatile("v_mfma_f32_16x16x128_f8f6f4 %0, %1, %2, %0" : "+v"(acc[ai][bj][m][n]) : "v"(Bt##8[n]), "v"(At##8[m])); } else { \
        _Pragma("unroll") for (int m = 0; m < 4; ++m) _Pragma("unroll") for (int n = 0; n < 2; ++n) _Pragma("unroll") for (int k = 0; k < 2; ++k) \
        acc[ai][bj][m][n] = __builtin_amdgcn_mfma_f32_16x16x32_bf16(Bt[n][k], At[m][k], acc[ai][bj][m][n], 0, 0, 0); } __builtin_amdgcn_s_setprio(0); } while (0)
#define PG8_WAIT_V(n) asm volatile("s_waitcnt vmcnt(" #n ")" ::: "memory")
#define PG8_WAIT_VF(f) do { if constexpr (Epi::NS > 0) asm volatile("s_cmp_lg_u32 %0, 0\n\ts_cbranch_scc1 .Lwf%=\n\ts_waitcnt vmcnt(8)\n\ts_branch .Lwe%=\n.Lwf%=:\n\ts_waitcnt vmcnt(%1)\n.Lwe%=:" :: "s"(f), "n"(8 + Epi::NS) : "memory", "scc"); else PG8_WAIT_V(8); } while (0)
#define PG8_WAIT_L(n) asm volatile("s_waitcnt lgkmcnt(" #n ")" ::: "memory")
#define PG8_BAR __builtin_amdgcn_s_barrier()
#define PG8_SCHED __builtin_amdgcn_sched_barrier(0)
    Unit cur, nxt; int ui = 0;
    if (!S.next(0, cur)) return;
    f32x4 acc[2][2][4][2];
#pragma unroll
    for (int a = 0; a < 2; ++a)
#pragma unroll
        for (int b = 0; b < 2; ++b)
#pragma unroll
            for (int m = 0; m < 4; ++m)
#pragma unroll
                for (int n = 0; n < 2; ++n) acc[a][b][m][n] = (f32x4){0.f, 0.f, 0.f, 0.f};
    bf16x8 At[4][2], B0[2][2], B1[2][2]; v8i32 At8[4], B08[2], B18[2];
    const char* cA = cur.A; const char* cB = cur.B;
    if constexpr (Epi::BIAS_DMA) { if (wid == 4) E.bias_dma(cur, 0, lane, lds); }
    if constexpr (SP2) {
        PG8_STAGE(PG8_SB(0, 0), cB, voffB); PG8_STAGE(PG8_SB(0, 1), cB + hB, voffB); PG8_STAGE(PG8_SA(0, 0), cA, voffA); PG8_STAGE(PG8_SA(0, 1), cA + hA, voffA);
        if (wr == 1) PG8_BAR;
        PG8_WAIT_V(2); PG8_BAR;
        PG8_STAGE(PG8_SB(1, 0), cB + kstep, voffB); PG8_STAGE(PG8_SA(1, 0), cA + kstepA, voffA); PG8_STAGE(PG8_SB(1, 1), cB + hB + kstep, voffB);
        PG8_WAIT_V(6); PG8_BAR;
    } else {
        PG8_STAGE(PG8_SB(0, 0), cB, voffB); PG8_STAGE(PG8_SA(0, 0), cA, voffA); PG8_STAGE(PG8_SB(0, 1), cB + hB, voffB); PG8_STAGE(PG8_SA(0, 1), cA + hA, voffA);
        if (wr == 1) PG8_BAR;
        PG8_WAIT_V(4); PG8_BAR;
        PG8_STAGE(PG8_SB(1, 0), cB + kstep, voffB); PG8_STAGE(PG8_SA(1, 0), cA + kstepA, voffA); PG8_STAGE(PG8_SB(1, 1), cB + hB + kstep, voffB);
        PG8_WAIT_V(6); PG8_BAR;
    }
    for (;;) {
        const bool has_next = S.next(ui + 1, nxt);
        if constexpr (Epi::BIAS_DMA) { if (has_next && wid == 4) E.bias_dma(nxt, (ui + 1) % 3, lane, lds); }
        const char* nA = has_next ? nxt.A : cA; const char* nB = has_next ? nxt.B : cB;
        const int nt = cur.nt;
        for (int t = 0; t < nt; t += 2) {
            const bool last = (t == nt - 2); const int fst = __builtin_amdgcn_readfirstlane((t == 0 && ui > 0) ? 1 : 0);
            const char* a1 = cA + (size_t)(t + 1) * kstepA;
            const char* a2 = last ? nA : cA + (size_t)(t + 2) * kstepA; const char* b2 = last ? nB : cB + (size_t)(t + 2) * kstep;
            const char* a3 = a2 + kstepA; const char* b3 = b2 + kstep;
            if constexpr (SP2) {
            PG8_LDB(B0, 0, 0); PG8_LDB(B1, 0, 1); PG8_SCHED; PG8_LDA(At, 0, 0); PG8_STAGE(PG8_SA(1, 1), a1 + hA, voffA);
            PG8_WAIT_VF(fst); PG8_WAIT_L(0); PG8_BAR; PG8_MMA(0, 0, At, B0); PG8_MMA(0, 1, At, B1); PG8_BAR; PG8_SCHED;
            PG8_LDA(At, 0, 1); PG8_STAGE(PG8_SB(0, 0), b2, voffB); PG8_STAGE(PG8_SB(0, 1), b2 + hB, voffB); PG8_STAGE(PG8_SA(0, 0), a2, voffA);
            PG8_WAIT_VF(fst); PG8_WAIT_L(0); PG8_BAR; PG8_MMA(1, 0, At, B0); PG8_MMA(1, 1, At, B1); PG8_BAR; PG8_SCHED;
            PG8_LDB(B0, 1, 0); PG8_LDB(B1, 1, 1); PG8_SCHED; PG8_LDA(At, 1, 0); PG8_STAGE(PG8_SA(0, 1), a2 + hA, voffA);
            PG8_WAIT_V(8); PG8_WAIT_L(0); PG8_BAR; PG8_MMA(0, 0, At, B0); PG8_MMA(0, 1, At, B1); PG8_BAR; PG8_SCHED;
            PG8_LDA(At, 1, 1); PG8_STAGE(PG8_SB(1, 0), b3, voffB); PG8_STAGE(PG8_SB(1, 1), b3 + hB, voffB); PG8_STAGE(PG8_SA(1, 0), a3, voffA);
            PG8_WAIT_V(8); PG8_WAIT_L(0); PG8_BAR; PG8_MMA(1, 0, At, B0); PG8_MMA(1, 1, At, B1); PG8_BAR; PG8_SCHED;
            } else {
            PG8_LDB(B0, 0, 0); PG8_SCHED; PG8_LDA(At, 0, 0); PG8_STAGE(PG8_SA(1, 1), a1 + hA, voffA);
            PG8_WAIT_L(8); PG8_BAR; PG8_WAIT_L(0); PG8_MMA(0, 0, At, B0); PG8_BAR; PG8_SCHED;
            PG8_LDB(B1, 0, 1); PG8_STAGE(PG8_SB(0, 0), b2, voffB);
            PG8_BAR; PG8_WAIT_L(0); PG8_MMA(0, 1, At, B1); PG8_BAR;
            PG8_LDA(At, 0, 1); PG8_STAGE(PG8_SA(0, 0), a2, voffA);
            PG8_BAR; PG8_WAIT_L(0); PG8_MMA(1, 0, At, B0); PG8_BAR; PG8_SCHED;
            PG8_STAGE(PG8_SB(0, 1), b2 + hB, voffB);
            PG8_WAIT_V(6); PG8_BAR; PG8_MMA(1, 1, At, B1); PG8_BAR;
            PG8_LDB(B0, 1, 0); PG8_SCHED; PG8_LDA(At, 1, 0); PG8_STAGE(PG8_SA(0, 1), a2 + hA, voffA);
            PG8_WAIT_L(8); PG8_BAR; PG8_WAIT_L(0); PG8_MMA(0, 0, At, B0); PG8_BAR; PG8_SCHED;
            PG8_LDB(B1, 1, 1); PG8_STAGE(PG8_SB(1, 0), b3, voffB);
            PG8_BAR; PG8_WAIT_L(0); PG8_MMA(0, 1, At, B1); PG8_BAR;
            PG8_LDA(At, 1, 1); PG8_STAGE(PG8_SA(1, 0), a3, voffA);
            PG8_BAR; PG8_WAIT_L(0); PG8_MMA(1, 0, At, B0); PG8_BAR; PG8_SCHED;
            PG8_STAGE(PG8_SB(1, 1), b3 + hB, voffB);
            PG8_WAIT_V(6); PG8_BAR; PG8_MMA(1, 1, At, B1); PG8_BAR;
            }
        }
        if constexpr (ALIGN_EPI) { if (wr == 0) PG8_BAR; }
        if constexpr (FP8) asm volatile("s_nop 15\n\ts_nop 15\n\ts_nop 15" ::: "memory");
        cur.bs = ui % 3;
        E(acc, cur, wr, wc, fr, fq);
        if (!has_next) break;
        if (!(Epi::KEEP && cur.aux != 2)) {
#pragma unroll
        for (int a = 0; a < 2; ++a)
#pragma unroll
            for (int b = 0; b < 2; ++b)
#pragma unroll
                for (int m = 0; m < 4; ++m)
#pragma unroll
                    for (int n = 0; n < 2; ++n) acc[a][b][m][n] = (f32x4){0.f, 0.f, 0.f, 0.f};
        }
        cur = nxt; cA = nA; cB = nB; ++ui;
        if constexpr (ALIGN_EPI) { if (wr == 1) PG8_BAR; }
    }
    PG8_WAIT_V(0);
    if constexpr (!ALIGN_EPI) { if (wr == 0) PG8_BAR; }
    PG8_BAR;
#undef PG8_SA
#undef PG8_SB
#undef PG8_STAGE
#undef PG8_LDA
#undef PG8_LDB
#undef PG8_MMA
#undef PG8_WAIT_V
#undef PG8_WAIT_VF
#undef PG8_WAIT_L
#undef PG8_BAR
#undef PG8_SCHED
}

template <class Epi, class Sched, bool FP8 = false>
__device__ __forceinline__ void gemm_phase_gather(PG8_LAS unsigned char* lds, const char* Abase, const int lda, const int ldb, const Sched& S, const Epi& E, const int wv) {
    constexpr int EB = FP8 ? 1 : 2;
    const int tid = opaque_tid(wv), wid = wv, lane = tid & 63, wr = wid >> 2, wc = wid & 3, fr = lane & 15, fq = lane >> 4;
    unsigned voffB[2]; int Rr[2]; unsigned Cc[2];
#pragma unroll
    for (int i = 0; i < 2; ++i) { int R, C; stage_rc(tid * 16 + i * 8192, R, C); const int Rb = Epi::PERM ? ((R & ~31) + perm32(R & 31)) : R;
        Rr[i] = R; Cc[i] = (unsigned)C * 2u; voffB[i] = (unsigned)(Rb * ldb * EB + C * 2); }
    const size_t kstep = (size_t)(BK * 2);
    const size_t hB = (size_t)HALF * ldb * EB;
    const unsigned ldsw = (unsigned)wid * 1024u;
    const int fcol = fq * 8;
    const int aoff = lds_byte(wr * 64 + fr, fcol), boff = lds_byte(wc * 32 + fr, fcol);
#define PG8_SA(b, h) (((b) * 2 + (h)) * HTB)
#define PG8_SB(b, h) ((4 + (b) * 2 + (h)) * HTB)
#define PG8_STAGE(bufoff, gbase, voff) do { _Pragma("unroll") for (int _i = 0; _i < 2; ++_i) \
        __builtin_amdgcn_global_load_lds((const unsigned*)((const char*)(gbase) + (voff)[_i]), (PG8_LAS unsigned*)(lds + (bufoff) + ldsw + _i * 8192), 16, 0, 0); } while (0)
#define PG8_LDA(dst, b, h) do { if constexpr (FP8) { _Pragma("unroll") for (int m = 0; m < 4; ++m) dst##8[m] = cat8(*(const PG8_LAS bf16x8*)(lds + PG8_SA(b, h) + aoff + m * 2048), *(const PG8_LAS bf16x8*)(lds + PG8_SA(b, h) + aoff + m * 2048 + 1024)); } else { \
        _Pragma("unroll") for (int m = 0; m < 4; ++m) _Pragma("unroll") for (int k = 0; k < 2; ++k) dst[m][k] = *(const PG8_LAS bf16x8*)(lds + PG8_SA(b, h) + aoff + m * 2048 + k * 1024); } } while (0)
#define PG8_LDB(dst, b, h) do { if constexpr (FP8) { _Pragma("unroll") for (int n = 0; n < 2; ++n) dst##8[n] = cat8(*(const PG8_LAS bf16x8*)(lds + PG8_SB(b, h) + boff + n * 2048), *(const PG8_LAS bf16x8*)(lds + PG8_SB(b, h) + boff + n * 2048 + 1024)); } else { \
        _Pragma("unroll") for (int n = 0; n < 2; ++n) _Pragma("unroll") for (int k = 0; k < 2; ++k) dst[n][k] = *(const PG8_LAS bf16x8*)(lds + PG8_SB(b, h) + boff + n * 2048 + k * 1024); } } while (0)
#define PG8_MMA(ai, bj, At, Bt) do { __builtin_amdgcn_s_setprio(1); if constexpr (FP8) { _Pragma("unroll") for (int m = 0; m < 4; ++m) _Pragma("unroll") for (int n = 0; n < 2; ++n) \
        asm volatile("v_mfma_f32_16x16x128_f8f6f4 %0, %1, %2, %0" : "+v"(acc[ai][bj][m][n]) : "v"(Bt##8[n]), "v"(At##8[m])); } else { \
        _Pragma("unroll") for (int m = 0; m < 4; ++m) _Pragma("unroll") for (int n = 0; n < 2; ++n) _Pragma("unroll") for (int k = 0; k < 2; ++k) \
        acc[ai][bj][m][n] = __builtin_amdgcn_mfma_f32_16x16x32_bf16(Bt[n][k], At[m][k], acc[ai][bj][m][n], 0, 0, 0); } __builtin_amdgcn_s_setprio(0); } while (0)
#define PG8_WAIT_V(n) asm volatile("s_waitcnt vmcnt(" #n ")" ::: "memory")
#define PG8_WAIT_VF(f) do { if constexpr (Epi::NS > 0) asm volatile("s_cmp_lg_u32 %0, 0\n\ts_cbranch_scc1 .Lwf%=\n\ts_waitcnt vmcnt(8)\n\ts_branch .Lwe%=\n.Lwf%=:\n\ts_waitcnt vmcnt(%1)\n.Lwe%=:" :: "s"(f), "n"(8 + Epi::NS) : "memory", "scc"); else PG8_WAIT_V(8); } while (0)
#define PG8_WAIT_L(n) asm volatile("s_waitcnt lgkmcnt(" #n ")" ::: "memory")
#define PG8_BAR __builtin_amdgcn_s_barrier()
#define PG8_SCHED __builtin_amdgcn_sched_barrier(0)
#define PG8_ROWOFF(u, vo) do { _Pragma("unroll") for (int _h = 0; _h < 2; ++_h) _Pragma("unroll") for (int _i = 0; _i < 2; ++_i) \
        (vo)[_h][_i] = (unsigned)S.rowtok((u), 128 * _h + Rr[_i]) * (unsigned)(lda * EB) + Cc[_i]; } while (0)
    Unit cur, nxt, nn; int ui = 0;
    if (!S.next(0, cur)) return;
    bool has_next = S.next(1, nxt);
    unsigned cv[2][2], nv[2][2], tv[2][2];
    PG8_ROWOFF(cur, cv);
    if (has_next) PG8_ROWOFF(nxt, nv); else { _Pragma("unroll") for (int h = 0; h < 2; ++h) _Pragma("unroll") for (int i = 0; i < 2; ++i) nv[h][i] = cv[h][i]; }
    f32x4 acc[2][2][4][2];
#pragma unroll
    for (int a = 0; a < 2; ++a)
#pragma unroll
        for (int b = 0; b < 2; ++b)
#pragma unroll
            for (int m = 0; m < 4; ++m)
#pragma unroll
                for (int n = 0; n < 2; ++n) acc[a][b][m][n] = (f32x4){0.f, 0.f, 0.f, 0.f};
    bf16x8 At[4][2], B0[2][2], B1[2][2]; v8i32 At8[4], B08[2], B18[2];
    const char* cB = cur.B;
    if constexpr (Epi::BIAS_DMA) { if (wid == 4) E.bias_dma(cur, 0, lane, lds); }
    PG8_STAGE(PG8_SB(0, 0), cB, voffB); PG8_STAGE(PG8_SB(0, 1), cB + hB, voffB); PG8_STAGE(PG8_SA(0, 0), Abase, cv[0]); PG8_STAGE(PG8_SA(0, 1), Abase, cv[1]);
    if (wr == 1) PG8_BAR;
    PG8_WAIT_V(2); PG8_BAR;
    PG8_STAGE(PG8_SB(1, 0), cB + kstep, voffB); PG8_STAGE(PG8_SA(1, 0), Abase + kstep, cv[0]); PG8_STAGE(PG8_SB(1, 1), cB + hB + kstep, voffB);
    PG8_WAIT_V(6); PG8_BAR;
    for (;;) {
        const char* nB = has_next ? nxt.B : cB;
        if constexpr (Epi::BIAS_DMA) { if (has_next && wid == 4) E.bias_dma(nxt, (ui + 1) % 3, lane, lds); }
        const int nt = cur.nt;
        for (int t = 0; t < nt; t += 2) {
            const bool last = (t == nt - 2); const int fst = __builtin_amdgcn_readfirstlane((t == 0 && ui > 0) ? 1 : 0);
            const char* a1 = Abase + (size_t)(t + 1) * kstep;
            const char* a2 = last ? Abase : Abase + (size_t)(t + 2) * kstep; const char* b2 = last ? nB : cB + (size_t)(t + 2) * kstep;
            const char* a3 = a2 + kstep; const char* b3 = b2 + kstep;
            unsigned s0[2], s1[2];
#pragma unroll
            for (int i = 0; i < 2; ++i) { s0[i] = last ? nv[0][i] : cv[0][i]; s1[i] = last ? nv[1][i] : cv[1][i]; }
            PG8_LDB(B0, 0, 0); PG8_LDB(B1, 0, 1); PG8_SCHED; PG8_LDA(At, 0, 0); PG8_STAGE(PG8_SA(1, 1), a1, cv[1]);
            PG8_WAIT_VF(fst); PG8_WAIT_L(0); PG8_BAR; PG8_MMA(0, 0, At, B0); PG8_MMA(0, 1, At, B1); PG8_BAR; PG8_SCHED;
            PG8_LDA(At, 0, 1); PG8_STAGE(PG8_SB(0, 0), b2, voffB); PG8_STAGE(PG8_SB(0, 1), b2 + hB, voffB); PG8_STAGE(PG8_SA(0, 0), a2, s0);
            PG8_WAIT_VF(fst); PG8_WAIT_L(0); PG8_BAR; PG8_MMA(1, 0, At, B0); PG8_MMA(1, 1, At, B1); PG8_BAR; PG8_SCHED;
            PG8_LDB(B0, 1, 0); PG8_LDB(B1, 1, 1); PG8_SCHED; PG8_LDA(At, 1, 0); PG8_STAGE(PG8_SA(0, 1), a2, s1);
            PG8_WAIT_V(8); PG8_WAIT_L(0); PG8_BAR; PG8_MMA(0, 0, At, B0); PG8_MMA(0, 1, At, B1); PG8_BAR; PG8_SCHED;
            PG8_LDA(At, 1, 1); PG8_STAGE(PG8_SB(1, 0), b3, voffB); PG8_STAGE(PG8_SB(1, 1), b3 + hB, voffB); PG8_STAGE(PG8_SA(1, 0), a3, s0);
            PG8_WAIT_V(8); PG8_WAIT_L(0); PG8_BAR; PG8_MMA(1, 0, At, B0); PG8_MMA(1, 1, At, B1); PG8_BAR; PG8_SCHED;
        }
        if (wr == 0) PG8_BAR;
        if constexpr (FP8) asm volatile("s_nop 15\n\ts_nop 15\n\ts_nop 15" ::: "memory");
        const bool has_nn = has_next && S.next(ui + 2, nn);
        if (has_nn) PG8_ROWOFF(nn, tv);
        cur.bs = ui % 3;
        E(acc, cur, wr, wc, fr, fq);
        if (!has_next) break;
#pragma unroll
        for (int a = 0; a < 2; ++a)
#pragma unroll
            for (int b = 0; b < 2; ++b)
#pragma unroll
                for (int m = 0; m < 4; ++m)
#pragma unroll
                    for (int n = 0; n < 2; ++n) acc[a][b][m][n] = (f32x4){0.f, 0.f, 0.f, 0.f};
        cur = nxt; cB = nB; ++ui;
#pragma unroll
        for (int h = 0; h < 2; ++h)
#pragma unroll
            for (int i = 0; i < 2; ++i) { cv[h][i] = nv[h][i]; if (has_nn) nv[h][i] = tv[h][i]; }
        asm volatile("" : "+v"(nv[0][0]), "+v"(nv[0][1]), "+v"(nv[1][0]), "+v"(nv[1][1]));
        nxt = nn; has_next = has_nn;
        if (wr == 1) PG8_BAR;
    }
    PG8_WAIT_V(0);
    PG8_BAR;
#undef PG8_SA
#undef PG8_SB
#undef PG8_STAGE
#undef PG8_LDA
#undef PG8_LDB
#undef PG8_MMA
#undef PG8_WAIT_V
#undef PG8_WAIT_VF
#undef PG8_WAIT_L
#undef PG8_BAR
#undef PG8_SCHED
#undef PG8_ROWOFF
}

struct DenseOrder {
    const char* A; const char* B; size_t a_tile, b_tile; int nt, nM, nN, G, c; int pn_off = 0;
    __device__ __forceinline__ bool next(int i, Unit& u) const {
        const long L = (long)i * G + c; if (L >= (long)nM * nN) return false;
        int pm, pn; tile_of((int)L, nM, nN, pm, pn);
        u.pm = pm; u.pn = pn + pn_off; u.aux = 0; u.nt = nt; u.A = A + (size_t)pm * a_tile; u.B = B + (size_t)pn * b_tile; return true;
    }
};
struct ProjOrder {
    const char* Y; const char* W; int nM, nN, G, c;
    __device__ __forceinline__ bool next(int i, Unit& u) const {
        const int ti = i / 3, br = i - 3 * ti;
        const long L = (long)ti * G + c; if (L >= (long)nM * nN) return false;
        int pm, pn; tile_of((int)L, nM, nN, pm, pn);
        u.pm = pm; u.pn = pn; u.aux = br; u.nt = (br == 2) ? 6 : 4;
        const int acol = (br == 0) ? 0 : (br == 1 ? 256 : 384), bcol = (br == 0) ? 0 : (br == 1 ? 256 : 512);
        u.A = Y + ((size_t)pm * 256 * YLD + acol) * 2; u.B = W + ((size_t)pn * 256 * WPK + bcol) * 2; return true;
    }
};
struct MoeOrder {
    const char* A; const char* W; size_t estride, atile, btile; int nt; const LAS int* tile_e; const LAS int* offT; const LAS int* cnt; const int* SRC; int T, nN, G, c;
    __device__ __forceinline__ bool next(int i, Unit& u) const {
        const long L = (long)i * G + c; if (L >= (long)T * nN) return false;
        int pm, pn; tile_of((int)L, T, nN, pm, pn);
        const int e = __builtin_amdgcn_readfirstlane(tile_e[pm]);
        u.pm = pm; u.pn = pn; u.aux = e; u.nt = nt; u.A = A + (size_t)pm * atile; u.B = W + (size_t)e * estride + (size_t)pn * btile; return true;
    }
    __device__ __forceinline__ int rowtok(const Unit& u, int r) const {
        const int e = u.aux, rank = (u.pm - offT[e]) * 256 + r, last = cnt[e] - 1;
        return SRC[e * NTOK + (rank < last ? rank : last)];
    }
};

struct EpiInProj {
    static constexpr bool PERM2 = false; static constexpr bool PERM = true, KEEP = false, BIAS_DMA = true; static constexpr int NS = 16;
    bf16_t* H; const float* bg; const f32x2* r64; const f32x2* r48; float gscale; unsigned char* G8; PG8_LAS unsigned char* ldsb;
    __device__ __forceinline__ void bias_dma(const Unit& u, int s, int lane, PG8_LAS unsigned char* lds) const {
        const int o = u.pn >= 12 ? (u.pn - 12) * BM : 0;
        glds16_s(bg + o, (unsigned)lane * 16u, (unsigned)__builtin_amdgcn_readfirstlane((int)(unsigned)(size_t)(lds + L_BIAS_OFF + s * 1024))); }
    __device__ __forceinline__ void operator()(f32x4 (&acc)[2][2][4][2], const Unit& u, int wr, int wc, int fr, int fq) const {
        const int row0 = u.pm * BM + wr * 64 + fr, pn = u.pn, t0 = wc * 32 + 8 * fq;
        const float gs = gscale; unsigned char* const g8 = G8;
        if (pn >= 3 && pn < 9) {
            int dst, hstep, tw, dd0; const f32x2* tab;
            if (pn < 6) { dst = 768 + (4 * (pn - 3) + wc) * 64 + 8 * fq; hstep = 32; tw = 32; dd0 = 8 * fq; tab = r64; }
            else { const int p0 = 128 * (pn - 6) + t0, slot = p0 / 24; dd0 = p0 - slot * 24; dst = 1920 + slot * 48 + dd0; hstep = 24; tw = 24; tab = r48; }
            f32x4 cb[2][2], s16[2][2], s128[2][2];
            { const f32x2* tp = tab + (size_t)(row0 & (SEQ - 1)) * tw + dd0; const f32x2* t16 = tab + (size_t)16 * tw + dd0; const f32x2* t128 = tab + (size_t)128 * tw + dd0;
#pragma unroll
              for (int n = 0; n < 2; ++n)
#pragma unroll
                  for (int h = 0; h < 2; ++h) { cb[n][h] = *(const f32x4*)(tp + 4 * n + 2 * h); s16[n][h] = *(const f32x4*)(t16 + 4 * n + 2 * h); s128[n][h] = *(const f32x4*)(t128 + 4 * n + 2 * h); } }
#pragma unroll
            for (int ai = 0; ai < 2; ++ai) {
                f32x4 cs[2][2];
#pragma unroll
                for (int n = 0; n < 2; ++n)
#pragma unroll
                    for (int h = 0; h < 2; ++h) { const f32x4 b = cb[n][h], r = s128[n][h];
                        cs[n][h] = ai == 0 ? b : (f32x4){b[0] * r[0] - b[1] * r[1], b[1] * r[0] + b[0] * r[1], b[2] * r[2] - b[3] * r[3], b[3] * r[2] + b[2] * r[3]}; }
#pragma unroll
                for (int m = 0; m < 4; ++m) { const int row = row0 + ai * HALF + m * 16;
                    f32x4 y1[2], y2[2];
#pragma unroll
                    for (int n = 0; n < 2; ++n) { const f32x4 cs0 = cs[n][0], cs1 = cs[n][1];
                        const f32x4 x1 = acc[ai][0][m][n], x2 = acc[ai][1][m][n];
                        y1[n][0] = x1[0] * cs0[0] - x2[0] * cs0[1]; y2[n][0] = x2[0] * cs0[0] + x1[0] * cs0[1];
                        y1[n][1] = x1[1] * cs0[2] - x2[1] * cs0[3]; y2[n][1] = x2[1] * cs0[2] + x1[1] * cs0[3];
                        y1[n][2] = x1[2] * cs1[0] - x2[2] * cs1[1]; y2[n][2] = x2[2] * cs1[0] + x1[2] * cs1[1];
                        y1[n][3] = x1[3] * cs1[2] - x2[3] * cs1[3]; y2[n][3] = x2[3] * cs1[2] + x1[3] * cs1[3]; }
                    bf16_t* rowp = H + (size_t)row * INC + dst;
                    u32x4 w; w.x = cvt_pk_bf16(y1[0][0], y1[0][1]); w.y = cvt_pk_bf16(y1[0][2], y1[0][3]); w.z = cvt_pk_bf16(y1[1][0], y1[1][1]); w.w = cvt_pk_bf16(y1[1][2], y1[1][3]);
                    *(u32x4*)rowp = w;
                    w.x = cvt_pk_bf16(y2[0][0], y2[0][1]); w.y = cvt_pk_bf16(y2[0][2], y2[0][3]); w.z = cvt_pk_bf16(y2[1][0], y2[1][1]); w.w = cvt_pk_bf16(y2[1][2], y2[1][3]);
                    *(u32x4*)(rowp + hstep) = w;
                    if (m < 3) {
#pragma unroll
                        for (int n = 0; n < 2; ++n)
#pragma unroll
                            for (int h = 0; h < 2; ++h) { const f32x4 b = cs[n][h], r = s16[n][h];
                                cs[n][h] = (f32x4){b[0] * r[0] - b[1] * r[1], b[1] * r[0] + b[0] * r[1], b[2] * r[2] - b[3] * r[3], b[3] * r[2] + b[2] * r[3]}; } } } }
            return;
        }
        const bool gate = pn >= 12;
        if (gate) {
            const int gb = pn - 12, gbr = gb >> 2, pno = gb & 3;
            v4u* gimg = (v4u*)g8 + (size_t)((u.pm * 3 + gbr) * 4 + pno) * 4096 + (wr * 4 + wc) * 64 + fq * 16 + fr;
            f32x4 bv[2][2];
#pragma unroll
            for (int bj = 0; bj < 2; ++bj)
#pragma unroll
                for (int n = 0; n < 2; ++n) bv[bj][n] = *(const PG8_LAS f32x4*)((const PG8_LAS float*)(ldsb + L_BIAS_OFF + u.bs * 1024) + bj * HALF + t0 + 4 * n) * (-1.4426950408889634f);
            const float gsn = gs * (-1.4426950408889634f);
#pragma unroll
            for (int ai = 0; ai < 2; ++ai)
#pragma unroll
                for (int m = 0; m < 4; ++m) { v4u w;
#pragma unroll
                    for (int bj = 0; bj < 2; ++bj)
#pragma unroll
                        for (int n = 0; n < 2; ++n) { const f32x4 z = acc[ai][bj][m][n] * gsn + bv[bj][n]; unsigned d = 0;
#pragma unroll
                            for (int q = 0; q < 4; ++q) d |= (unsigned)fmaxf(__builtin_amdgcn_rcpf(__builtin_amdgcn_exp2f(z[q]) * (1.0f / 255.0f) + (1.0f / 255.0f)) + 0.5f, 1.0f) << (8 * q);
                            w[bj * 2 + n] = d; }
                    gimg[(ai * 4 + m) * 512] = w; }
            return;
        }
        int dcol[2];
#pragma unroll
        for (int bj = 0; bj < 2; ++bj) { const int x = pn * BM + bj * HALF + t0;
            if (pn >= 9 && pn < 12) { const int xx = x - 2304; dcol[bj] = xx < 384 ? 1536 + xx : 2688 + (xx - 384); } else dcol[bj] = x; }
#pragma unroll
        for (int ai = 0; ai < 2; ++ai)
#pragma unroll
            for (int m = 0; m < 4; ++m) { bf16_t* rowp = H + (size_t)(row0 + ai * HALF + m * 16) * INC;
#pragma unroll
                for (int bj = 0; bj < 2; ++bj) { const f32x4 v0 = acc[ai][bj][m][0], v1 = acc[ai][bj][m][1];
                    u32x4 w; w.x = cvt_pk_bf16(v0[0], v0[1]); w.y = cvt_pk_bf16(v0[2], v0[3]); w.z = cvt_pk_bf16(v1[0], v1[1]); w.w = cvt_pk_bf16(v1[2], v1[3]);
                    *(u32x4*)(rowp + dcol[bj]) = w; } }
    }
};
struct EpiProj {
    static constexpr bool PERM2 = false; static constexpr bool PERM = true, KEEP = true, BIAS_DMA = false; static constexpr int NS = 0;
    const unsigned char* G8; bf16_t* Mg;
    __device__ __forceinline__ void operator()(f32x4 (&acc)[2][2][4][2], const Unit& u, int wr, int wc, int fr, int fq) const {
        const int row0 = u.pm * BM + wr * 64 + fr, col0 = u.pn * BM + wc * 32 + 8 * fq, br = u.aux;
        const v4u* gp = (const v4u*)G8 + (size_t)((u.pm * 3 + br) * 4 + u.pn) * 4096 + (wr * 4 + wc) * 64 + fq * 16 + fr;
        bf16_t* const mg = Mg;
#pragma unroll
        for (int ai = 0; ai < 2; ++ai)
#pragma unroll
            for (int m = 0; m < 4; ++m) { const v4u gq = gp[(ai * 4 + m) * 512];
                if (br < 2) { const v4u gn = gp[(ai * 4 + m) * 512 + 4 * 4096];
#pragma unroll
                    for (int bj = 0; bj < 2; ++bj)
#pragma unroll
                        for (int n = 0; n < 2; ++n) { const unsigned a = gq[bj * 2 + n], b = gn[bj * 2 + n];
                            const f32x4 r = (f32x4){(float)(a & 255u) * __builtin_amdgcn_rcpf((float)(b & 255u)), (float)((a >> 8) & 255u) * __builtin_amdgcn_rcpf((float)((b >> 8) & 255u)),
                                                    (float)((a >> 16) & 255u) * __builtin_amdgcn_rcpf((float)((b >> 16) & 255u)), (float)(a >> 24) * __builtin_amdgcn_rcpf((float)(b >> 24))};
                            acc[ai][bj][m][n] = acc[ai][bj][m][n] * r; } }
                else { bf16_t* rowp = mg + (size_t)(row0 + ai * HALF + m * 16) * 1024 + col0;
#pragma unroll
                    for (int bj = 0; bj < 2; ++bj) { f32x4 t[2];
#pragma unroll
                        for (int n = 0; n < 2; ++n) { const unsigned a = gq[bj * 2 + n];
                            t[n] = acc[ai][bj][m][n] * ((f32x4){(float)(a & 255u), (float)((a >> 8) & 255u), (float)((a >> 16) & 255u), (float)(a >> 24)} * (1.0f / 255.0f)); }
                        u32x4 o; o.x = cvt_pk_bf16(t[0][0], t[0][1]); o.y = cvt_pk_bf16(t[0][2], t[0][3]); o.z = cvt_pk_bf16(t[1][0], t[1][1]); o.w = cvt_pk_bf16(t[1][2], t[1][3]);
                        *(u32x4*)(rowp + bj * HALF) = o; } } }
    }
};
struct EpiOut {
    static constexpr bool PERM2 = false; static constexpr bool PERM = true, KEEP = false, BIAS_DMA = false; static constexpr int NS = 16;
    const float* X; const bf16_t* XBr; bf16_t* P;
    __device__ __forceinline__ void operator()(f32x4 (&acc)[2][2][4][2], const Unit& u, int wr, int wc, int fr, int fq) const {
        const int row0 = u.pm * BM + wr * 64 + fr, col0 = u.pn * BM + wc * 32 + 8 * fq;
        const float* const Xf = X; const bf16_t* const Xh = XBr; bf16_t* const Pp = P;
#pragma unroll
        for (int ai = 0; ai < 2; ++ai)
#pragma unroll
            for (int m = 0; m < 4; ++m) { const size_t ro = (size_t)(row0 + ai * HALF + m * 16) * 1024 + col0;
#pragma unroll
                for (int bj = 0; bj < 2; ++bj) { f32x4 x0, x1;
                    if (Xf) { x0 = *(const f32x4*)(Xf + ro + bj * HALF); x1 = *(const f32x4*)(Xf + ro + bj * HALF + 4); }
                    else { const u32x4 xw = *(const u32x4*)(Xh + ro + bj * HALF); x0 = (f32x4){bflo(xw.x), bfhi(xw.x), bflo(xw.y), bfhi(xw.y)}; x1 = (f32x4){bflo(xw.z), bfhi(xw.z), bflo(xw.w), bfhi(xw.w)}; }
                    const f32x4 p0 = x0 * DN_ALPHA + acc[ai][bj][m][0], p1 = x1 * DN_ALPHA + acc[ai][bj][m][1];
                    u32x4 o; o.x = cvt_pk_bf16(p0[0], p0[1]); o.y = cvt_pk_bf16(p0[2], p0[3]); o.z = cvt_pk_bf16(p1[0], p1[1]); o.w = cvt_pk_bf16(p1[2], p1[3]);
                    *(u32x4*)(Pp + ro + bj * HALF) = o; } }
    }
};
struct EpiSwiglu {
    static constexpr bool PERM2 = false; static constexpr bool PERM = true, KEEP = false, BIAS_DMA = true; static constexpr int NS = 8;
    unsigned char* HH; const float* bgate; const float* bup; float ascale; PG8_LAS unsigned char* ldsb;
    __device__ __forceinline__ void bias_dma(const Unit& u, int s, int lane, PG8_LAS unsigned char* lds) const {
        const unsigned dst = (unsigned)__builtin_amdgcn_readfirstlane((int)(unsigned)(size_t)(lds + L_BIAS_OFF + s * 1024)); const int o = u.aux * 1024 + u.pn * HALF;
        if (lane < 32) glds16_s(bgate + o, (unsigned)lane * 16u, dst); else glds16_s(bup + o, (unsigned)(lane - 32) * 16u, dst); }
    __device__ __forceinline__ void operator()(f32x4 (&acc)[2][2][4][2], const Unit& u, int wr, int wc, int fr, int fq) const {
        const int row0 = u.pm * BM + wr * 64 + fr, j0 = u.pn * HALF + wc * 32 + 8 * fq, e = u.aux;
        f32x4 bg[2], bu4[2];
#pragma unroll
        for (int n = 0; n < 2; ++n) { const PG8_LAS float* bl = (const PG8_LAS float*)(ldsb + L_BIAS_OFF + u.bs * 1024) + wc * 32 + 8 * fq + 4 * n; bg[n] = *(const PG8_LAS f32x4*)bl; bu4[n] = *(const PG8_LAS f32x4*)(bl + HALF) * 4.0f + 4.0f; }
        const float as4 = ascale * 4.0f;
#pragma unroll
        for (int ai = 0; ai < 2; ++ai)
#pragma unroll
            for (int m = 0; m < 4; ++m) { unsigned char* rowp = HH + (size_t)u.pm * (256 * 1024) + (size_t)(u.pn * 4 + wc) * 8192 + (wr * 64 + fr + ai * HALF + m * 16) * 32 + 8 * fq;
                f32x4 o[2];
#pragma unroll
                for (int n = 0; n < 2; ++n) { const f32x4 g = acc[ai][0][m][n] * ascale + bg[n], u4 = acc[ai][1][m][n] * as4 + bu4[n];
#pragma unroll
                    for (int q = 0; q < 4; ++q) { const float hg = fminf(g[q], 7.0f), hu4 = __builtin_amdgcn_fmed3f(u4[q], -24.0f, 32.0f);
                        o[n][q] = hg * __builtin_amdgcn_rcpf(1.0f + __builtin_amdgcn_exp2f((-1.702f * 1.4426950408889634f) * hg)) * hu4; } }
                v2u w; w.x = pk4_fp8_nc(o[0][0], o[0][1], o[0][2], o[0][3]); w.y = pk4_fp8_nc(o[1][0], o[1][1], o[1][2], o[1][3]);
                *(v2u*)rowp = w; }
    }
};
struct EpiDown {
    static constexpr bool PERM2 = true; static constexpr bool PERM = true, KEEP = false, BIAS_DMA = true; static constexpr int NS = 8;
    unsigned char* YS; const float* bd; float ascale; PG8_LAS unsigned char* ldsb;
    __device__ __forceinline__ void bias_dma(const Unit& u, int s, int lane, PG8_LAS unsigned char* lds) const {
        glds16_s(bd + u.aux * 1024 + u.pn * BM, (unsigned)lane * 16u, (unsigned)__builtin_amdgcn_readfirstlane((int)(unsigned)(size_t)(lds + L_BIAS_OFF + s * 1024))); }
    __device__ __forceinline__ void operator()(f32x4 (&acc)[2][2][4][2], const Unit& u, int wr, int wc, int fr, int fq) const {
        const int row0 = u.pm * BM + wr * 64 + fr, cl = wc * 64 + 16 * fq;
        f32x4 bv[2][2];
#pragma unroll
        for (int bj = 0; bj < 2; ++bj)
#pragma unroll
            for (int n = 0; n < 2; ++n) bv[bj][n] = *(const PG8_LAS f32x4*)((const PG8_LAS float*)(ldsb + L_BIAS_OFF + u.bs * 1024) + cl + 8 * bj + 4 * n) * 16.0f;
        const float as16 = ascale * 16.0f;
#pragma unroll
        for (int ai = 0; ai < 2; ++ai)
#pragma unroll
            for (int m = 0; m < 4; ++m) { u32x4 w;
#pragma unroll
                for (int bj = 0; bj < 2; ++bj)
#pragma unroll
                    for (int n = 0; n < 2; ++n) { f32x4 v = acc[ai][bj][m][n] * as16 + bv[bj][n];
#pragma unroll
                        for (int q = 0; q < 4; ++q) v[q] = __builtin_amdgcn_fmed3f(v[q], -448.0f, 448.0f);
                        w[bj * 2 + n] = pk4_fp8_nc(v[0], v[1], v[2], v[3]); }
                *(u32x4*)(YS + (size_t)(row0 + ai * HALF + m * 16) * 1024 + u.pn * BM + cl) = w; }
    }
};
}

#define XB_TMO      128
#define XB_XCNT(j)  (256  + 64 * (j))
#define XB_XSUB(j)  (1280 + 64 * (j))
#define XB_XGEN(j)  (2304 + 64 * (j))
#define XB_TOP      3328
#define XB_TOPGEN   3392
#define XCD_BAR_WORDS 3456
#define XB_SPIN_CAP (1u << 18)

__device__ __forceinline__ unsigned xb_ld(unsigned* p)              { return __hip_atomic_load(p, __ATOMIC_RELAXED, __HIP_MEMORY_SCOPE_AGENT); }
__device__ __forceinline__ unsigned xb_add(unsigned* p, unsigned v) { return __hip_atomic_fetch_add(p, v, __ATOMIC_RELAXED, __HIP_MEMORY_SCOPE_AGENT); }
__device__ __forceinline__ unsigned xb_xcc_id() { return (unsigned)__builtin_amdgcn_s_getreg((3 << 11) | 20) & 0xFu; }
#define XB_SPIN(cond, bar) do { unsigned _sp = 0; while (cond) { __builtin_amdgcn_s_sleep(1); \
    if ((++_sp & 255u) == 0u) { if (xb_ld(&(bar)[XB_TMO])) break; if (_sp > XB_SPIN_CAP) { atomicAdd(&(bar)[XB_TMO], 1u); break; } } } } while (0)

struct XcdBarrier { unsigned* bar; unsigned x; volatile LAS unsigned* st; };

__device__ __forceinline__ XcdBarrier xcd_barrier_post(unsigned* bar, volatile LAS unsigned* st) {
    XcdBarrier b; b.bar = bar; b.x = xb_xcc_id(); b.st = st;
    if (threadIdx.x == 0) (void)xb_add(&bar[XB_XCNT(b.x)], 1u);
    return b;
}
__device__ __forceinline__ void xcd_barrier_complete(unsigned* bar, unsigned x, unsigned& nloc, unsigned& nx) {
    const unsigned G = gridDim.x * gridDim.y * gridDim.z;
    unsigned sum, cnt, mine, sp = 0u;
    for (;;) {
        sum = 0u; cnt = 0u; mine = 0u;
#pragma unroll
        for (unsigned j = 0; j < 16; ++j) { const unsigned c = xb_ld(&bar[XB_XCNT(j)]); sum += c; cnt += (c > 0u) ? 1u : 0u; mine = (j == x) ? c : mine; }
        if (sum == G) break;
        __builtin_amdgcn_s_sleep(1);
        if ((++sp & 255u) == 0u) { if (xb_ld(&bar[XB_TMO])) break; if (sp > XB_SPIN_CAP) { atomicAdd(&bar[XB_TMO], 1u); break; } }
    }
    nloc = mine > 0u ? mine : 1u; nx = cnt > 0u ? cnt : 1u;
}
__device__ __forceinline__ void xcd_barrier(const XcdBarrier& b) {
    asm volatile("s_waitcnt vmcnt(0)" ::: "memory");
    __syncthreads();
    if (threadIdx.x == 0) {
        unsigned* bar = b.bar;
        __builtin_amdgcn_s_waitcnt(0);
        unsigned nloc = b.st[0], nx = b.st[1];
        if (nloc == 0u) { xcd_barrier_complete(bar, b.x, nloc, nx); b.st[0] = nloc; b.st[1] = nx; }
        const unsigned old = xb_add(&bar[XB_XSUB(b.x)], 1u);
        const unsigned gen = old / nloc;
        if (old + 1u == (gen + 1u) * nloc) {
            __builtin_amdgcn_fence(__ATOMIC_RELEASE, "agent");
            asm volatile("s_waitcnt vmcnt(0)" ::: "memory");
            const unsigned og = xb_add(&bar[XB_TOP], 1u);
            const unsigned tg = og / nx;
            if (og + 1u == (tg + 1u) * nx) xb_add(&bar[XB_TOPGEN], 1u);
            else XB_SPIN(xb_ld(&bar[XB_TOPGEN]) == tg, bar);
            __builtin_amdgcn_fence(__ATOMIC_ACQUIRE, "agent");
            xb_add(&bar[XB_XGEN(b.x)], 1u);
            asm volatile("s_waitcnt vmcnt(0)" ::: "memory");
        } else {
            XB_SPIN(xb_ld(&bar[XB_XGEN(b.x)]) == gen, bar);
            __builtin_amdgcn_fence(__ATOMIC_ACQUIRE, "agent");
            asm volatile("s_waitcnt vmcnt(0)" ::: "memory");
        }
    }
    __syncthreads();
}

struct Frame {
    LAS unsigned char* lds;
    unsigned* ctl;
    unsigned char* ws;
    int tid, lane, wave, G, bid, wv;
};

__host__ __device__ __forceinline__ int inproj_phys(int nl) {
    if (nl < 768) return nl;
    if (nl < 1536) { const int x = nl - 768, slot = x >> 6, d = x & 63; return 768 + (slot >> 2) * 256 + (d >> 5) * 128 + (slot & 3) * 32 + (d & 31); }
    if (nl < 1920) return 2304 + (nl - 1536);
    if (nl < 2688) { const int x = nl - 1920, slot = x / 48, d = x - slot * 48, hf = d >= 24 ? 1 : 0, p = slot * 24 + d - 24 * hf; return 1536 + (p >> 7) * 256 + hf * 128 + (p & 127); }
    if (nl < 3072) return 2304 + 384 + (nl - 2688);
    return nl;
}
template <class RowMap>
__device__ __forceinline__ void transpose_item(const float* W, int N, bf16* dst, int ldd, int k0, int n0, const RowMap rowmap, LAS float* scr, int lane) {
#pragma unroll 8
    for (int i = 0; i < 32; ++i) { const int kk = 2 * i + (lane >> 5); scr[kk * 33 + (lane & 31)] = W[(size_t)(k0 + kk) * N + n0 + (lane & 31)]; }
    LDS_WAIT(); asm volatile("" ::: "memory");
    const int c = lane & 7;
#pragma unroll
    for (int j = 0; j < 4; ++j) { const int n = (lane >> 3) + 8 * j; const LAS float* sp = scr + (8 * c) * 33 + n;
        v4u o; o.x = pk2(sp[0 * 33], sp[1 * 33]); o.y = pk2(sp[2 * 33], sp[3 * 33]); o.z = pk2(sp[4 * 33], sp[5 * 33]); o.w = pk2(sp[6 * 33], sp[7 * 33]);
        *(v4u*)(dst + (size_t)rowmap(n0 + n) * ldd + k0 + 8 * c) = o; }
    LDS_WAIT(); asm volatile("" ::: "memory");
}

template <class RowMap>
__device__ __forceinline__ void transpose_item_fp8(const float* W, int N, unsigned char* dst, int ldd, int k0, int n0, const RowMap rowmap, LAS float* scr, int lane, float qs) {
#pragma unroll 8
    for (int i = 0; i < 32; ++i) { const int kk = 2 * i + (lane >> 5); scr[kk * 33 + (lane & 31)] = W[(size_t)(k0 + kk) * N + n0 + (lane & 31)]; }
    LDS_WAIT(); asm volatile("" ::: "memory");
    const int c = lane & 7;
#pragma unroll
    for (int j = 0; j < 4; ++j) { const int n = (lane >> 3) + 8 * j; const LAS float* sp = scr + (8 * c) * 33 + n;
        v2u o; o.x = pk4_fp8(sp[0 * 33], sp[1 * 33], sp[2 * 33], sp[3 * 33], qs); o.y = pk4_fp8(sp[4 * 33], sp[5 * 33], sp[6 * 33], sp[7 * 33], qs);
        *(v2u*)(dst + (size_t)rowmap(n0 + n) * ldd + k0 + 8 * c) = o; }
    LDS_WAIT(); asm volatile("" ::: "memory");
}

struct Args { const float* in[22]; float* out; unsigned char* ws; int ph_lo, ph_hi; float lam_init[4]; };

__device__ __forceinline__ void p_prologue(Frame& F, const Args& a) {
    LAS float* scr = (LAS float*)(F.lds + F.wave * 16384);
    const int gw = F.bid * 8 + F.wave, NGW = F.G * 8;
    constexpr int PER_LAYER = 3072 + 128 + 64 + 192 + 512 + 32 * 1536;
    for (int it = gw; it < DEPTH * PER_LAYER; it += NGW) {
        const int l = it / PER_LAYER; int r = it - l * PER_LAYER;
        if (r < 3072) { const int kb = r / 192, nb = r % 192;
            if (nb < 96) transpose_item(a.in[1] + (size_t)l * 1024 * INC, INC, (bf16*)(F.ws + WS_WIN) + (size_t)l * INC * 1024, 1024, kb * 64, nb * 32, [](int n) { return inproj_phys(n); }, scr, F.lane);
            else transpose_item_fp8(a.in[1] + (size_t)l * 1024 * INC, INC, (unsigned char*)(F.ws + WS_WIN8) + (size_t)l * 3072 * 1024, 1024, kb * 64, nb * 32, [](int n) { return n - 3072; }, scr, F.lane, 32.f);
            continue; }
        r -= 3072;
        if (r < 128) { const int kb = r / 32, nb = r % 32;
            transpose_item(a.in[3] + (size_t)l * 256 * 1024, 1024, (bf16*)(F.ws + WS_WPROJ) + (size_t)l * 1024 * WPK + 0, WPK, kb * 64, nb * 32, [](int n) { return n; }, scr, F.lane); continue; }
        r -= 128;
        if (r < 64) { const int kb = r / 32, nb = r % 32;
            transpose_item(a.in[4] + (size_t)l * 128 * 1024, 1024, (bf16*)(F.ws + WS_WPROJ) + (size_t)l * 1024 * WPK + 256, WPK, kb * 64, nb * 32, [](int n) { return n; }, scr, F.lane); continue; }
        r -= 64;
        if (r < 192) { const int kb = r / 32, nb = r % 32;
            transpose_item(a.in[5] + (size_t)l * 384 * 1024, 1024, (bf16*)(F.ws + WS_WPROJ) + (size_t)l * 1024 * WPK + 512, WPK, kb * 64, nb * 32, [](int n) { return n; }, scr, F.lane); continue; }
        r -= 192;
        if (r < 512) { const int kb = r / 32, nb = r % 32;
            transpose_item(a.in[6] + (size_t)l * 1024 * 1024, 1024, (bf16*)(F.ws + WS_WOUT) + (size_t)l * 1024 * 1024, 1024, kb * 64, nb * 32, [](int n) { return n; }, scr, F.lane); continue; }
        r -= 512;
        { const int e = r / 1536, r2 = r % 1536, mtx = r2 / 512, r3 = r2 % 512, kb = r3 / 32, nb = r3 % 32;
          const size_t eoff = ((size_t)l * NEXP + e) * 1024 * 1024;
          if (mtx == 0) transpose_item_fp8(a.in[14] + eoff, 1024, (unsigned char*)(F.ws + WS_WGU) + 2 * eoff, 1024, kb * 64, nb * 32, [](int n) { return (n >> 7) * 256 + (n & 127); }, scr, F.lane, 32.f);
          else if (mtx == 1) transpose_item_fp8(a.in[16] + eoff, 1024, (unsigned char*)(F.ws + WS_WGU) + 2 * eoff, 1024, kb * 64, nb * 32, [](int n) { return (n >> 7) * 256 + 128 + (n & 127); }, scr, F.lane, 32.f);
          else transpose_item_fp8(a.in[18] + eoff, 1024, (unsigned char*)(F.ws + WS_WDN) + eoff, 1024, kb * 64, nb * 32, [](int n) { return n; }, scr, F.lane, 64.f); }
    }
    { const int gt = F.bid * 512 + F.tid, NT = F.G * 512;
      for (int i = gt; i < DEPTH * 1024 * 16; i += NT) { const int row = i >> 4, ch = i & 15;
          *(v4u*)((bf16*)(F.ws + WS_WPROJ) + (size_t)row * WPK + 384 + ch * 8) = (v4u){0u, 0u, 0u, 0u}; }
      for (int i = gt; i < SEQ * 32; i += NT) { const int pos = i >> 5, j = i & 31;
          const float inv = 1.0f / powf(10000.0f, (float)(2 * j) / 64.0f); const float ang = (float)pos * inv; float s, c; sincosf(ang, &s, &c);
          ((f32x2*)(F.ws + WS_ROPE64))[i] = (f32x2){c, s}; }
      for (int i = gt; i < SEQ * 24; i += NT) { const int pos = i / 24, j = i - pos * 24;
          const float inv = 1.0f / powf(10000.0f, (float)(2 * j) / 48.0f); const float ang = (float)pos * inv; float s, c; sincosf(ang, &s, &c);
          ((f32x2*)(F.ws + WS_ROPE48))[i] = (f32x2){c, s}; }
      for (int i = gt; i < DEPTH * 32 * 1024; i += NT) { const int l = i >> 15, e = (i >> 10) & 31, k = i & 1023;
          const float wv = a.in[12][((size_t)l * 1024 + k) * 32 + e] * a.in[10][l * 1024 + k]; const unsigned hi = f2bf(wv); const unsigned lo = f2bf(wv - __uint_as_float(hi << 16));
          bf16* wt = (bf16*)(F.ws + WS_WRT) + (size_t)l * WRT_LAYER; wt[e * 1024 + k] = (bf16)hi; wt[32 * 1024 + e * 1024 + k] = (bf16)lo; }
      { const int gwv = F.bid * 8 + F.wave;
        if (gwv < DEPTH * 32) { const int l = gwv >> 5, e = gwv & 31; float su = 0.f, sv = 0.f;
            for (int j = 0; j < 16; ++j) { const int k = F.lane + 64 * j; const float w0 = a.in[12][((size_t)l * 1024 + k) * 32 + e], wv = w0 * a.in[10][l * 1024 + k];
                const unsigned hi = f2bf(wv); const unsigned lo = f2bf(wv - __uint_as_float(hi << 16));
                su += __uint_as_float(hi << 16) + __uint_as_float(lo << 16); sv += a.in[11][l * 1024 + k] * w0; }
            su = wave_sum(su, F.lane); sv = wave_sum(sv, F.lane);
            if (F.lane == 0) { float* ru = (float*)((bf16*)(F.ws + WS_WRT) + (size_t)l * WRT_LAYER + 2 * 32 * 1024); ru[e] = su; ru[32 + e] = sv + a.in[13][gwv]; } } }
      const f32x4* x4 = (const f32x4*)a.in[0]; v2u* xb = (v2u*)(F.ws + WS_XB);
      unsigned* xb8 = (unsigned*)(F.ws + WS_XB8);
      for (int i = gt; i < NTOK * 256; i += NT) { const f32x4 v = x4[i]; xb[i] = (v2u){pk2(v[0], v[1]), pk2(v[2], v[3])}; xb8[i] = pk4_fp8(v[0], v[1], v[2], v[3], 1.0f); }
    }
}

typedef float f32x16 __attribute__((ext_vector_type(16)));
typedef short s16x4 __attribute__((ext_vector_type(4)));
typedef float f32x2_t __attribute__((ext_vector_type(2)));
typedef __bf16 bf16x2_t __attribute__((ext_vector_type(2)));
__device__ __forceinline__ unsigned cvtpk(float lo, float hi) { const f32x2_t v = {lo, hi}; const bf16x2_t b = __builtin_convertvector(v, bf16x2_t); return __builtin_bit_cast(unsigned, b); }
__device__ __forceinline__ int kperm(int r) { return (r & ~12) | ((r & 4) << 1) | ((r & 8) >> 1); }
__device__ __forceinline__ s16x4 ds_tr16(const LAS unsigned char* p) { return __builtin_bit_cast(s16x4, __builtin_amdgcn_ds_read_tr16_b64_v4i16((LAS s16x4*)p)); }

__device__ __forceinline__ float fmax_nc(float a, float b) { return __builtin_amdgcn_fmed3f(a, b, __builtin_inff()); }
__device__ __forceinline__ void glds16(const void* gsrc, unsigned lds_dst) { unsigned keep;
    asm volatile("s_mov_b32 %0, m0\n\ts_mov_b32 m0, %2\n\ts_nop 0\n\tglobal_load_lds_dwordx4 %1, off\n\ts_mov_b32 m0, %0" : "=&s"(keep) : "v"(gsrc), "s"(lds_dst) : "memory"); }
__device__ __forceinline__ void attnC_pipe(Frame& F, const float* lamv, const float* ng, float lam_init) {
    const bf16* H = (const bf16*)(F.ws + WS_H); bf16* Y = (bf16*)(F.ws + WS_Y);
    const int lane = F.lane, w = F.wave, n = lane & 31, hh = lane >> 5;
    float l01 = 0.f, l23 = 0.f;
    if (lane < 48) { l01 = lamv[lane] * lamv[48 + lane]; l23 = lamv[96 + lane] * lamv[144 + lane]; }
    l01 = wave_sum(l01, lane); l23 = wave_sum(l23, lane);
    const float lam = expf(l01) - expf(l23) + lam_init;
    const float post = 1.0f - lam_init;
    constexpr int KST = 192, VST = 192, KBYTES = 64 * KST, STAGE = KBYTES + 64 * VST, NT = SEQ / 64;
    constexpr float CS = 0.14433756729740643f * 1.4426950408889634f;
    constexpr float PMAX = 256.0f;
    unsigned goff[3], loff[3];
#pragma unroll
    for (int j = 0; j < 3; ++j) { const int I = w + 8 * j;
        if (I < 12) { const int cid = I * 64 + lane, row = cid / 12, cl = cid - row * 12, col = (cl & ~3) | ((cl & 3) ^ ((row >> 2) & 3));
            goff[j] = (unsigned)(row * INC + C_KC + col * 8) * 2u; loff[j] = (unsigned)(I * 1024); }
        else { const int cid = (I - 12) * 64 + lane, row = cid / 12, col = cid - row * 12;
            goff[j] = (unsigned)(row * INC + C_VC + col * 8) * 2u; loff[j] = (unsigned)(KBYTES + (I - 12) * 1024); } }
    const int krow_ = kperm(n), kg_ = (krow_ >> 2) & 3;
    const int koffA = krow_ * KST + ((hh ^ kg_) * 16), koffB = krow_ * KST + (((hh + 2) ^ kg_) * 16);
#define C_KOFF(t) ((((t) & 1) ? koffB : koffA) + ((t) >> 1) * 64)
    const int g = lane >> 4, i16 = lane & 15;
    const int voff = KBYTES + (8 * (g >> 1) + (i16 >> 2)) * VST + (16 * (g & 1) + 4 * (i16 & 3)) * 2;
#define C_ISSUE(tt) do { const char* gb_ = gbase + (size_t)(tt) * (64 * INC * 2); const int so_ = ((tt) & 3) * STAGE; _Pragma("unroll") for (int j_ = 0; j_ < 3; ++j_) \
        glds16(gb_ + goff[j_], (unsigned)__builtin_amdgcn_readfirstlane((int)(unsigned)(size_t)(F.lds + so_ + loff[j_]))); } while (0)
#define C_RDV(slotV, kbV, s2v) do { _Pragma("unroll") for (int d_ = 0; d_ < 3; ++d_) { const LAS unsigned char* vp_ = (slotV) + voff + ((kbV) * 32 + 16 * (s2v)) * VST + d_ * 64; \
            const s16x4 v0_ = ds_tr16(vp_), v1_ = ds_tr16(vp_ + 4 * VST); vf[d_] = (bf16x8){v0_[0], v0_[1], v0_[2], v0_[3], v1_[0], v1_[1], v1_[2], v1_[3]}; } } while (0)
#define C_FENCE __builtin_amdgcn_sched_barrier(0)
#define C_QK0(dst, slotbase) do { { const bf16x8 kf_ = *(const LAS bf16x8*)((slotbase) + C_KOFF(0)); dst = __builtin_amdgcn_mfma_f32_32x32x16_bf16(kf_, qf[0][0], NEGR[0], 0, 0, 0); } \
        _Pragma("unroll") for (int s_ = 1; s_ < 3; ++s_) { const bf16x8 kf_ = *(const LAS bf16x8*)((slotbase) + C_KOFF(s_)); dst = __builtin_amdgcn_mfma_f32_32x32x16_bf16(kf_, qf[0][s_], dst, 0, 0, 0); } } while (0)
#define C_ITEM(Sx, c, pout, pin, cp, slotVp, kbVp, slotKc, kbKc, slotKn, kbKn, cn) do { \
        _Pragma("unroll") for (int s2_ = 0; s2_ < 2; ++s2_) _Pragma("unroll") for (int d_ = 0; d_ < 3; ++d_) { const LAS unsigned char* vp_ = (slotVp) + voff + ((kbVp) * 32 + 16 * s2_) * VST + d_ * 64; \
            const s16x4 v0_ = ds_tr16(vp_), v1_ = ds_tr16(vp_ + 4 * VST); vf[s2_ * 3 + d_] = (bf16x8){v0_[0], v0_[1], v0_[2], v0_[3], v1_[0], v1_[1], v1_[2], v1_[3]}; } \
        _Pragma("unroll") for (int s_ = 0; s_ < 3; ++s_) kf[s_] = *(const LAS bf16x8*)((slotKn) + (kbKn) * 32 * KST + C_KOFF((cn) * 3 + s_)); \
        C_FENCE; __builtin_amdgcn_s_setprio(1); \
        const float lold_ = l[c]; \
        _Pragma("unroll") for (int r_ = 0; r_ < 16; ++r_) Sx[r_] = __builtin_amdgcn_exp2f(Sx[r_]); \
        float pm_ = fmaxf(fmaxf(Sx[0], Sx[1]), Sx[2]); _Pragma("unroll") for (int r_ = 3; r_ < 15; r_ += 2) pm_ = fmaxf(fmaxf(pm_, Sx[r_]), Sx[r_ + 1]); pm_ = fmaxf(pm_, Sx[15]); \
        _Pragma("unroll") for (int r_ = 0; r_ < 16; ++r_) l[c] += Sx[r_]; \
        _Pragma("unroll") for (int s2_ = 0; s2_ < 2; ++s2_) { v4u pw_; pw_.x = cvtpk(Sx[8 * s2_ + 0], Sx[8 * s2_ + 1]); pw_.y = cvtpk(Sx[8 * s2_ + 2], Sx[8 * s2_ + 3]); \
            pw_.z = cvtpk(Sx[8 * s2_ + 4], Sx[8 * s2_ + 5]); pw_.w = cvtpk(Sx[8 * s2_ + 6], Sx[8 * s2_ + 7]); pout[s2_] = __builtin_bit_cast(bf16x8, pw_); } \
        _Pragma("unroll") for (int s2_ = 0; s2_ < 2; ++s2_) _Pragma("unroll") for (int d_ = 0; d_ < 3; ++d_) O[cp][d_] = __builtin_amdgcn_mfma_f32_32x32x16_bf16(vf[s2_ * 3 + d_], pin[s2_], O[cp][d_], 0, 0, 0); \
        _Pragma("unroll") for (int g_ = 0; g_ < 6; ++g_) { __builtin_amdgcn_sched_group_barrier(0x008, 1, 0); __builtin_amdgcn_sched_group_barrier(0x400, 3, 0); __builtin_amdgcn_sched_group_barrier(0x002, 7, 0); } \
        C_FENCE; \
        Sx = __builtin_amdgcn_mfma_f32_32x32x16_bf16(kf[0], qf[cn][0], NEGR[cn], 0, 0, 0); Sx = __builtin_amdgcn_mfma_f32_32x32x16_bf16(kf[1], qf[cn][1], Sx, 0, 0, 0); Sx = __builtin_amdgcn_mfma_f32_32x32x16_bf16(kf[2], qf[cn][2], Sx, 0, 0, 0); \
        __builtin_amdgcn_s_setprio(0); C_FENCE; \
        if (__any(pm_ > PMAX) || first) { f32x16 Sr_; pm_ = fmaxf(pm_, shx(pm_, 32, lane));     \
            { const bf16x8 k0_ = *(const LAS bf16x8*)((slotKc) + (kbKc) * 32 * KST + C_KOFF((c) * 3 + 0)), k1_ = *(const LAS bf16x8*)((slotKc) + (kbKc) * 32 * KST + C_KOFF((c) * 3 + 1)), k2_ = *(const LAS bf16x8*)((slotKc) + (kbKc) * 32 * KST + C_KOFF((c) * 3 + 2)); \
              Sr_ = __builtin_amdgcn_mfma_f32_32x32x16_bf16(k0_, qf[c][0], NEGR[c], 0, 0, 0); Sr_ = __builtin_amdgcn_mfma_f32_32x32x16_bf16(k1_, qf[c][1], Sr_, 0, 0, 0); Sr_ = __builtin_amdgcn_mfma_f32_32x32x16_bf16(k2_, qf[c][2], Sr_, 0, 0, 0); } \
            float mx_ = fmax_nc(Sr_[0], Sr_[1]); _Pragma("unroll") for (int r_ = 2; r_ < 16; ++r_) mx_ = fmax_nc(mx_, Sr_[r_]); mx_ = fmaxf(mx_, shx(mx_, 32, lane)); \
            const float dl_ = (pm_ > PMAX || first) ? mx_ : 0.0f, al_ = __builtin_amdgcn_exp2f(-dl_); \
            _Pragma("unroll") for (int d_ = 0; d_ < 3; ++d_) _Pragma("unroll") for (int r_ = 0; r_ < 16; ++r_) O[c][d_][r_] *= al_; \
            float ls_ = lold_ * al_; \
            _Pragma("unroll") for (int r_ = 0; r_ < 16; ++r_) { NEGR[c][r_] -= dl_; Sr_[r_] = __builtin_amdgcn_exp2f(Sr_[r_] - dl_); ls_ += Sr_[r_]; } \
            l[c] = ls_; \
            _Pragma("unroll") for (int s2_ = 0; s2_ < 2; ++s2_) { v4u pw_; pw_.x = cvtpk(Sr_[8 * s2_ + 0], Sr_[8 * s2_ + 1]); pw_.y = cvtpk(Sr_[8 * s2_ + 2], Sr_[8 * s2_ + 3]); \
                pw_.z = cvtpk(Sr_[8 * s2_ + 4], Sr_[8 * s2_ + 5]); pw_.w = cvtpk(Sr_[8 * s2_ + 6], Sr_[8 * s2_ + 7]); pout[s2_] = __builtin_bit_cast(bf16x8, pw_); } } \
        C_FENCE; } while (0)
    for (int unit = F.bid; unit < 512; unit += F.G) {
        const int b = unit >> 6, h = (unit >> 4) & 3, qb = unit & 15;
        const int tok = b * SEQ + qb * 256 + w * 32 + n;
        const char* gbase = (const char*)(H + (size_t)(b * SEQ) * INC + h * 96);
        C_ISSUE(0); C_ISSUE(1);
        bf16x8 qf[2][3];
        { const bf16* qp = H + (size_t)tok * INC + C_QC + h * 96 + 8 * hh;
#pragma unroll
          for (int c = 0; c < 2; ++c)
#pragma unroll
              for (int s = 0; s < 3; ++s) { const v4u qw = *(const v4u*)(qp + c * 48 + 16 * s);
                  v4u qs; qs.x = cvtpk(bflo(qw.x) * CS, bfhi(qw.x) * CS); qs.y = cvtpk(bflo(qw.y) * CS, bfhi(qw.y) * CS); qs.z = cvtpk(bflo(qw.z) * CS, bfhi(qw.z) * CS); qs.w = cvtpk(bflo(qw.w) * CS, bfhi(qw.w) * CS);
                  qf[c][s] = __builtin_bit_cast(bf16x8, qs); } }
        f32x16 O[2][3];
#pragma unroll
        for (int c = 0; c < 2; ++c)
#pragma unroll
            for (int d = 0; d < 3; ++d)
#pragma unroll
                for (int r = 0; r < 16; ++r) O[c][d][r] = 0.f;
        float l[2] = {0.f, 0.f};
        f32x16 NEGR[2];
#pragma unroll
        for (int c = 0; c < 2; ++c)
#pragma unroll
            for (int r = 0; r < 16; ++r) NEGR[c][r] = 0.f;
        f32x16 S; bf16x8 pa[2], pb[2], kf[3], vf[6];
        pb[0] = (bf16x8){0, 0, 0, 0, 0, 0, 0, 0}; pb[1] = pb[0];
        for (int t = 0; t < NT; ++t) {
            asm volatile("s_waitcnt vmcnt(0)" ::: "memory"); __builtin_amdgcn_s_barrier(); asm volatile("" ::: "memory");
            if (t + 2 < NT) C_ISSUE(t + 2);
            const LAS unsigned char* cur = F.lds + (t & 3) * STAGE;
            const LAS unsigned char* prv = F.lds + ((t > 0 ? t - 1 : 0) & 3) * STAGE;
            const LAS unsigned char* nxt = F.lds + ((t + 1 < NT ? t + 1 : t) & 3) * STAGE;
            if (t == 0) C_QK0(S, cur);
            { const bool first = (t == 0);
            C_ITEM(S, 0, pa, pb, 1, prv, 1, cur, 0, cur, 0, 1);
            C_ITEM(S, 1, pb, pa, 0, cur, 0, cur, 0, cur, 1, 0); }
            { const bool first = false;
            C_ITEM(S, 0, pa, pb, 1, cur, 0, cur, 1, cur, 1, 1);
            C_ITEM(S, 1, pb, pa, 0, cur, 1, cur, 1, nxt, 0, 0); }
        }
        { const LAS unsigned char* lastb = F.lds + ((NT - 1) & 3) * STAGE;
#pragma unroll
          for (int s2 = 0; s2 < 2; ++s2)
#pragma unroll
              for (int d = 0; d < 3; ++d) { const LAS unsigned char* vp = lastb + voff + (32 + 16 * s2) * VST + d * 64; const s16x4 v0 = ds_tr16(vp), v1 = ds_tr16(vp + 4 * VST);
                  const bf16x8 vfl = (bf16x8){v0[0], v0[1], v0[2], v0[3], v1[0], v1[1], v1[2], v1[3]}; O[1][d] = __builtin_amdgcn_mfma_f32_32x32x16_bf16(vfl, pb[s2], O[1][d], 0, 0, 0); } }
        const float l0 = l[0] + shx(l[0], 32, lane), l1 = l[1] + shx(l[1], 32, lane);
        const float i0 = 1.0f / l0, i1 = lam / l1;
        float ss = 0.f;
#pragma unroll
        for (int d = 0; d < 3; ++d)
#pragma unroll
            for (int r = 0; r < 16; ++r) { const float o = O[0][d][r] * i0 - O[1][d][r] * i1; O[0][d][r] = o; ss += o * o; }
        ss += shx(ss, 32, lane);
        const float rs = rsqrtf(ss * (1.0f / 96.0f) + LN_EPS) * post;
        bf16* yp = Y + (size_t)tok * YLD + Y_C + h * 96 + 4 * hh;
#pragma unroll
        for (int d = 0; d < 3; ++d)
#pragma unroll
            for (int rg = 0; rg < 4; ++rg) { const f32x4 gv = *(const f32x4*)(ng + d * 32 + 8 * rg + 4 * hh);
                v2u o; o.x = pk2(O[0][d][4 * rg + 0] * rs * gv[0], O[0][d][4 * rg + 1] * rs * gv[1]); o.y = pk2(O[0][d][4 * rg + 2] * rs * gv[2], O[0][d][4 * rg + 3] * rs * gv[3]);
                *(v2u*)(yp + d * 32 + 8 * rg) = o; }
        asm volatile("s_waitcnt vmcnt(0)" ::: "memory"); __builtin_amdgcn_s_barrier(); asm volatile("" ::: "memory");
    }
#undef C_ISSUE
#undef C_KOFF
#undef C_RDV
#undef C_ITEM
#undef C_QK0
#undef C_FENCE
}

constexpr int AB_VST = 192, AB_VREG = 32 * AB_VST;
constexpr int L_RPB = 51200;

__device__ __forceinline__ void sm_block64(f32x16& t, float& m, float& l, f32x16 (&O)[2], bf16x8 (&pf)[2], const int lane) {
    float mx = fmaxf(t[0], t[1]);
#pragma unroll
    for (int r = 2; r < 16; ++r) mx = fmaxf(mx, t[r]);
    if (__any(mx > m)) {
        mx = fmaxf(mx, shx(mx, 32, lane));
        const float mn = fmaxf(m, mx), alpha = __builtin_amdgcn_exp2f(m - mn);
#pragma unroll
        for (int d = 0; d < 2; ++d)
#pragma unroll
            for (int r = 0; r < 16; ++r) O[d][r] *= alpha;
        l *= alpha; m = mn;
    }
#pragma unroll
    for (int r = 0; r < 16; ++r) { t[r] = __builtin_amdgcn_exp2f(t[r] - m); l += t[r]; }
#pragma unroll
    for (int s2 = 0; s2 < 2; ++s2) { v4u pw; pw.x = cvtpk(t[8 * s2 + 0], t[8 * s2 + 1]); pw.y = cvtpk(t[8 * s2 + 2], t[8 * s2 + 3]);
        pw.z = cvtpk(t[8 * s2 + 4], t[8 * s2 + 5]); pw.w = cvtpk(t[8 * s2 + 6], t[8 * s2 + 7]); pf[s2] = __builtin_bit_cast(bf16x8, pw); }
}
template <class TokOf, class MaskT>
__device__ __forceinline__ void attn_run_blocks(const bf16* H, const int kcol, const int vcol, const int nb, const TokOf tok_of, const MaskT mask,
                                                const bf16x8 (&qf)[4], LAS unsigned char* vl, const int lane, f32x16 (&O)[2], float& m, float& l) {
    const int n = lane & 31, hh = lane >> 5, krow = kperm(n), g = lane >> 4, i16 = lane & 15;
    const int vrd = (8 * (g >> 1) + (i16 >> 2)) * AB_VST + (16 * (g & 1) + 4 * (i16 & 3)) * 2;
    bf16x8 kf[4]; v4u vc[4];
    { const bf16* kp = H + (size_t)tok_of(0, krow) * INC + kcol + 8 * hh;
#pragma unroll
      for (int s = 0; s < 4; ++s) kf[s] = *(const bf16x8*)(kp + 16 * s);
#pragma unroll
      for (int i = 0; i < 4; ++i) vc[i] = *(const v4u*)(H + (size_t)tok_of(0, (lane >> 3) + 8 * i) * INC + vcol + (lane & 7) * 8); }
#pragma unroll
    for (int i = 0; i < 4; ++i) *(LAS v4u*)(vl + ((lane >> 3) + 8 * i) * AB_VST + (lane & 7) * 16) = vc[i];
    for (int j = 0; j < nb; ++j) {
        const int jn = (j + 1 < nb) ? j + 1 : j;
        bf16x8 kn[4];
        { const bf16* kp = H + (size_t)tok_of(jn, krow) * INC + kcol + 8 * hh;
#pragma unroll
          for (int s = 0; s < 4; ++s) kn[s] = *(const bf16x8*)(kp + 16 * s);
#pragma unroll
          for (int i = 0; i < 4; ++i) vc[i] = *(const v4u*)(H + (size_t)tok_of(jn, (lane >> 3) + 8 * i) * INC + vcol + (lane & 7) * 8); }
        f32x16 S;
#pragma unroll
        for (int r = 0; r < 16; ++r) S[r] = 0.f;
#pragma unroll
        for (int s = 0; s < 4; ++s) S = __builtin_amdgcn_mfma_f32_32x32x16_bf16(kf[s], qf[s], S, 0, 0, 0);
        mask(j, S);
        bf16x8 pf[2];
        sm_block64(S, m, l, O, pf, lane);
        LDS_WAIT();
#pragma unroll
        for (int s2 = 0; s2 < 2; ++s2)
#pragma unroll
            for (int d = 0; d < 2; ++d) { const LAS unsigned char* vp = vl + vrd + 16 * s2 * AB_VST + d * 64;
                const s16x4 v0 = ds_tr16(vp), v1 = ds_tr16(vp + 4 * AB_VST);
                const bf16x8 vf = (bf16x8){v0[0], v0[1], v0[2], v0[3], v1[0], v1[1], v1[2], v1[3]};
                O[d] = __builtin_amdgcn_mfma_f32_32x32x16_bf16(vf, pf[s2], O[d], 0, 0, 0); }
        LDS_WAIT(); asm volatile("" ::: "memory");
#pragma unroll
        for (int i = 0; i < 4; ++i) *(LAS v4u*)(vl + ((lane >> 3) + 8 * i) * AB_VST + (lane & 7) * 16) = vc[i];
#pragma unroll
        for (int s = 0; s < 4; ++s) kf[s] = kn[s];
    }
    LDS_WAIT(); asm volatile("" ::: "memory");
}
__device__ __forceinline__ void attn_store64(bf16* yrow, const f32x16 (&O)[2], float l, int hh, const int lane) {
    const float lt = l + shx(l, 32, lane), inv = 1.0f / lt;
#pragma unroll
    for (int d = 0; d < 2; ++d)
#pragma unroll
        for (int rg = 0; rg < 4; ++rg) { v2u o; o.x = pk2(O[d][4 * rg + 0] * inv, O[d][4 * rg + 1] * inv); o.y = pk2(O[d][4 * rg + 2] * inv, O[d][4 * rg + 3] * inv);
            *(v2u*)(yrow + d * 32 + 8 * rg + 4 * hh) = o; }
}

__device__ __forceinline__ void attnA_mfma(Frame& F, const float* rpb  ) {
    const bf16* H = (const bf16*)(F.ws + WS_H); bf16* Y = (bf16*)(F.ws + WS_Y);
    LAS float* T = (LAS float*)(F.lds + L_RPB);
    for (int i = F.tid; i < 4 * 17 * 64; i += 512) { const int h = i / (17 * 64), rem = i - h * 17 * 64, ro = rem >> 6, co = rem & 63;
        const int rr = ro - 1, cc = co - 16; T[i] = (rr >= 0 && rr < 15 && cc >= 0 && cc < 31) ? rpb[(h * 15 + rr) * 31 + cc] * 1.4426950408889634f : 0.f; }
    __syncthreads();
    const int lane = F.lane, n = lane & 31, hh = lane >> 5;
    LAS unsigned char* vl = F.lds + F.wave * AB_VREG;
    const int gw = F.bid * 8 + F.wave, NGW = F.G * 8;
    for (int item = gw; item < 4096; item += NGW) {
        const int cb = item & 3, rp = (item >> 2) & 31, h = (item >> 7) & 3, b = item >> 9;
        const int r = 2 * rp + (n >> 4), c = 16 * cb + (n & 15);
        const int r0 = min(max(r - 4, 0), 56), c0 = min(max(c - 8, 0), 48);
        const int cw = min(max(16 * cb - 8, 0), 32);
        const int kr_lo = min(max(2 * rp - 4, 0), 56), kr_hi = min(max(2 * rp + 1 - 4, 0), 56) + 7;
        const int tokq = b * SEQ + r * 64 + c;
        bf16x8 qf[4];
        { const bf16* qp = H + (size_t)tokq * INC + C_QA + h * 64 + 8 * hh;
#pragma unroll
          for (int s = 0; s < 4; ++s) qf[s] = *(const bf16x8*)(qp + 16 * s); }
        f32x16 O[2];
#pragma unroll
        for (int d = 0; d < 2; ++d)
#pragma unroll
            for (int rr = 0; rr < 16; ++rr) O[d][rr] = 0.f;
        float m = -1e30f, l = 0.f;
        const int tok0 = b * SEQ + kr_lo * 64 + cw;
        auto tok_of = [=](int j, int kk) { return tok0 + j * 64 + kk; };
        const int colb = cw - c0 + 8 * hh;
        const int tb0 = (h * 17 + (kr_lo - r + 8)) * 64 + (cw - c + 31) + 8 * hh;
        const int rb = kr_lo - r0;
        auto mask = [=](int j, f32x16& S) {
            const bool rowok = (unsigned)(rb + j) < 8u; const LAS float* tp = T + tb0 + j * 64;
#pragma unroll
            for (int rr = 0; rr < 16; ++rr) { const int e = (rr & 7) + 16 * (rr >> 3);
                const bool ok = rowok && ((unsigned)(colb + e) < 16u);
                S[rr] = ok ? (S[rr] * (0.125f * 1.4426950408889634f) + tp[e]) : -INFINITY; }
        };
        attn_run_blocks(H, C_KA + h * 64, C_VA + h * 64, kr_hi - kr_lo + 1, tok_of, mask, qf, vl, lane, O, m, l);
        attn_store64(Y + (size_t)tokq * YLD + Y_A + h * 64, O, l, hh, lane);
    }
}
__device__ __forceinline__ void attnB_mfma(Frame& F) {
    const bf16* H = (const bf16*)(F.ws + WS_H); bf16* Y = (bf16*)(F.ws + WS_Y);
    const int lane = F.lane, n = lane & 31, hh = lane >> 5;
    LAS unsigned char* vl = F.lds + F.wave * AB_VREG;
    const int gw = F.bid * 8 + F.wave, NGW = F.G * 8;
    for (int item = gw; item < 2048; item += NGW) {
        const int mblk = item & 7, r = (item >> 3) & 15, hg = (item >> 7) & 1, b = item >> 8;
        const int sq = r + 16 * (mblk * 32 + n), tokq = b * SEQ + sq;
        f32x16 O[2];
#pragma unroll
        for (int d = 0; d < 2; ++d)
#pragma unroll
            for (int rr = 0; rr < 16; ++rr) O[d][rr] = 0.f;
        float m = -1e30f, l = 0.f;
#pragma unroll 1
        for (int g = 0; g < 3; ++g) {
            const int sh = 2 * g, dil = 1 << sh, head = 2 * g + hg, L = SEQ >> sh, a = 16 >> sh, cls = r & (dil - 1);
            const int pq0 = (r >> sh) + a * (mblk * 32), pq = pq0 + a * n;
            const int pks = pq0 - 64, nb = (31 * a + 129 + 31) >> 5;
            bf16x8 qf[4];
            { const bf16* qp = H + (size_t)tokq * INC + C_QB + head * 64 + 8 * hh;
#pragma unroll
              for (int s = 0; s < 4; ++s) { const v4u qw = *(const v4u*)(qp + 16 * s); constexpr float QS = 0.125f * 1.4426950408889634f;
                  v4u qs; qs.x = cvtpk(bflo(qw.x) * QS, bfhi(qw.x) * QS); qs.y = cvtpk(bflo(qw.y) * QS, bfhi(qw.y) * QS); qs.z = cvtpk(bflo(qw.z) * QS, bfhi(qw.z) * QS); qs.w = cvtpk(bflo(qw.w) * QS, bfhi(qw.w) * QS);
                  qf[s] = __builtin_bit_cast(bf16x8, qs); } }
            const int tokb = b * SEQ + cls;
            auto tok_of = [=](int j, int kk) { const int pk = min(max(pks + 32 * j + kk, 0), L - 1); return tokb + (pk << sh); };
            const int b1 = pks - pq + 64 + 8 * hh, b2 = pks + 8 * hh;
            int elo = max(-b1, -b2); int ew = min(128 - b1, L - 1 - b2) - elo; if (ew < 0) { elo = 1 << 29; ew = 0; }
            auto mask = [=](int j, f32x16& S) { const int base = 32 * j - elo;
#pragma unroll
                for (int rr = 0; rr < 16; ++rr) { const int ec = (rr & 7) + 16 * (rr >> 3);
                    S[rr] = ((unsigned)(base + ec) <= (unsigned)ew) ? S[rr] : -INFINITY; }
            };
            attn_run_blocks(H, C_KB + head * 64, C_VB + head * 64, nb, tok_of, mask, qf, vl, lane, O, m, l);
        }
        attn_store64(Y + (size_t)tokq * YLD + Y_B + hg * 64, O, l, hh, lane);
    }
}

__device__ __forceinline__ void p_ln_router(Frame& F, const Args& a, int layer, bool dry = false) {
    const bf16* PRE = (const bf16*)(F.ws + WS_HH); bf16* XB1 = (bf16*)(F.ws + (dry ? WS_H + 210 * MiB : WS_M)); unsigned* XB8 = dry ? (unsigned*)(F.ws + WS_H + 160 * MiB) : (unsigned*)(F.ws + WS_XB8);
    const float* g1 = a.in[10] + layer * 1024; const float* b1 = a.in[11] + layer * 1024;
    LAS float* stat = (LAS float*)(F.lds + 65536 + F.wave * 128);
    const bf16* WT = (const bf16*)(F.ws + WS_WRT) + (size_t)layer * WRT_LAYER;
    int* TOPE = (int*)(F.ws + (dry ? WS_H + 200 * MiB : WS_TOPE)); float* TOPW = (float*)(F.ws + (dry ? WS_H + 201 * MiB : WS_TOPW)); int* RANK = (int*)(F.ws + (dry ? WS_H + 202 * MiB : WS_RANK));
    const int cnt_off = dry ? CW_CUR : CW_CNT; int* SRCp = (int*)(F.ws + (dry ? WS_H + 204 * MiB : WS_SRC));
    LAS int* hist = (LAS int*)(F.lds + L_HIST); LAS int* base = (LAS int*)(F.lds + L_BASE);
    const int lane = F.lane;
    for (int chunk = F.bid; chunk < NTOK / 128; chunk += F.G) {
        if (F.tid < 32) hist[F.tid] = 0;
        __syncthreads();
        const int tok0 = chunk * 128 + F.wave * 16;
        {   f32x4 gv[4], bv[4];
#pragma unroll
            for (int j = 0; j < 4; ++j) { gv[j] = *(const f32x4*)(g1 + 4 * lane + 256 * j); bv[j] = *(const f32x4*)(b1 + 4 * lane + 256 * j); }
#pragma unroll 1
            for (int q = 0; q < 4; ++q) {
                f32x4 v[4][4]; float s[4], s2[4];
#pragma unroll
                for (int t = 0; t < 4; ++t) { const v2u* pr = (const v2u*)(PRE + (size_t)(tok0 + 4 * q + t) * 1024) + lane;
#pragma unroll
                    for (int j = 0; j < 4; ++j) { const v2u pw = pr[64 * j]; v[t][j] = (f32x4){bflo(pw.x), bfhi(pw.x), bflo(pw.y), bfhi(pw.y)}; } }
#pragma unroll
                for (int t = 0; t < 4; ++t) { s[t] = 0.f;
#pragma unroll
                    for (int j = 0; j < 4; ++j) s[t] += (v[t][j][0] + v[t][j][1]) + (v[t][j][2] + v[t][j][3]); }
#pragma unroll
                for (int o = 1; o < 64; o <<= 1) {
#pragma unroll
                    for (int t = 0; t < 4; ++t) s[t] += shx(s[t], o, lane); }
#pragma unroll
                for (int t = 0; t < 4; ++t) { const float mean = s[t] * (1.f / 1024.f); s2[t] = 0.f;
#pragma unroll
                    for (int j = 0; j < 4; ++j) { v[t][j] = v[t][j] - mean; s2[t] += (v[t][j][0] * v[t][j][0] + v[t][j][1] * v[t][j][1]) + (v[t][j][2] * v[t][j][2] + v[t][j][3] * v[t][j][3]); } }
#pragma unroll
                for (int o = 1; o < 64; o <<= 1) {
#pragma unroll
                    for (int t = 0; t < 4; ++t) s2[t] += shx(s2[t], o, lane); }
#pragma unroll
                for (int t = 0; t < 4; ++t) { const float rstd = rsqrtf(s2[t] * (1.f / 1024.f) + LN_EPS);
                    if (lane == 0) { stat[2 * (4 * q + t)] = s[t] * (1.f / 1024.f); stat[2 * (4 * q + t) + 1] = rstd; }
                    v2u* x1 = (v2u*)(XB1 + (size_t)(tok0 + 4 * q + t) * 1024) + lane; unsigned* xb = XB8 + (size_t)(tok0 + 4 * q + t) * 256 + lane;
#pragma unroll
                    for (int j = 0; j < 4; ++j) { const f32x4 y = v[t][j] * rstd * gv[j] + bv[j]; x1[64 * j] = (v2u){pk2(y[0], y[1]), pk2(y[2], y[3])}; xb[64 * j] = pk4_fp8(y[0], y[1], y[2], y[3], 1.0f); } }
            }
        }
        const int tk = lane & 15, kq = lane >> 4;
        f32x4 acc[2] = {(f32x4){0.f, 0.f, 0.f, 0.f}, (f32x4){0.f, 0.f, 0.f, 0.f}};
        {   const bf16* xp = PRE + (size_t)(tok0 + tk) * 1024 + 8 * kq;
            const bf16* w0 = WT + (size_t)tk * 1024 + 8 * kq;
#pragma unroll 4
            for (int st = 0; st < 32; ++st) {
                const bf16x8 xh = *(const bf16x8*)(xp + 32 * st);
#pragma unroll
                for (int mb = 0; mb < 2; ++mb) { const bf16x8 wh = *(const bf16x8*)(w0 + (size_t)mb * 16 * 1024 + 32 * st), wl = *(const bf16x8*)(w0 + (size_t)(32 + mb * 16) * 1024 + 32 * st);
                    acc[mb] = __builtin_amdgcn_mfma_f32_16x16x32_bf16(wh, xh, acc[mb], 0, 0, 0);
                    acc[mb] = __builtin_amdgcn_mfma_f32_16x16x32_bf16(wl, xh, acc[mb], 0, 0, 0); }
            }
        }
        LDS_WAIT();
        const float mu = stat[2 * tk], rsd = stat[2 * tk + 1];
        float v8[8];
#pragma unroll
        for (int mb = 0; mb < 2; ++mb)
#pragma unroll
            for (int i = 0; i < 4; ++i) { const float* ru = (const float*)(WT + 2 * 32 * 1024) + 16 * mb + 4 * kq + i; v8[mb * 4 + i] = rsd * (acc[mb][i] - mu * ru[0]) + ru[32]; }
        int se[4]; float sv[4];
#pragma unroll
        for (int r = 0; r < 4; ++r) {
            float bvv = v8[0]; int bi = 4 * kq;
#pragma unroll
            for (int sl = 1; sl < 8; ++sl) { const int eid = 16 * (sl >> 2) + 4 * kq + (sl & 3); if (v8[sl] > bvv) { bvv = v8[sl]; bi = eid; } }
#pragma unroll
            for (int o = 16; o < 64; o <<= 1) { const float ov = shx(bvv, o, lane); const int oi = shxi(bi, o, lane);
                if (ov > bvv || (ov == bvv && oi < bi)) { bvv = ov; bi = oi; } }
            se[r] = bi; sv[r] = bvv;
#pragma unroll
            for (int sl = 0; sl < 8; ++sl) { const int eid = 16 * (sl >> 2) + 4 * kq + (sl & 3); if (eid == bi) v8[sl] = -3.0e38f; }
        }
        const float p1 = __expf(sv[1] - sv[0]), p2 = __expf(sv[2] - sv[0]), p3 = __expf(sv[3] - sv[0]);
        const float inv = 1.0f / (1.0f + p1 + p2 + p3);
        int lr[4] = {0, 0, 0, 0};
        if (lane < 16) { const int tok = tok0 + tk;
            *(int4*)(TOPE + tok * 4) = make_int4(se[0], se[1], se[2], se[3]);
            *(f32x4*)(TOPW + tok * 4) = (f32x4){inv, p1 * inv, p2 * inv, p3 * inv};
#pragma unroll
            for (int k = 0; k < 4; ++k) lr[k] = __hip_atomic_fetch_add(&hist[se[k]], 1, __ATOMIC_RELAXED, __HIP_MEMORY_SCOPE_WORKGROUP); }
        __syncthreads();
        if (F.tid < 32) { const int c = hist[F.tid]; base[F.tid] = c ? (int)__hip_atomic_fetch_add(F.ctl + cnt_off + layer * 64 + F.tid, (unsigned)c, RLX_AGENT) : 0; }
        __syncthreads();
        if (lane < 16) { const int tok = tok0 + tk;
            const int r0 = base[se[0]] + lr[0], r1 = base[se[1]] + lr[1], r2 = base[se[2]] + lr[2], r3 = base[se[3]] + lr[3];
            *(int4*)(RANK + tok * 4) = make_int4(r0, r1, r2, r3);
            int* SRC = SRCp; SRC[se[0] * NTOK + r0] = tok; SRC[se[1] * NTOK + r1] = tok; SRC[se[2] * NTOK + r2] = tok; SRC[se[3] * NTOK + r3] = tok; }
        __syncthreads();
    }
}

__device__ __forceinline__ int moe_build(Frame& F, int layer) {
    LAS int* offT = (LAS int*)(F.lds + L_OFFT); LAS int* tile_e = (LAS int*)(F.lds + L_TILE);
    __syncthreads();
    if (F.tid < 64) {
        const int c = (F.lane < 32) ? (int)__hip_atomic_load(F.ctl + CW_CNT + layer * 64 + F.lane, RLX_AGENT) : 0;
        const int ntile = (c + 255) >> 8; int x = ntile;
#pragma unroll
        for (int d = 1; d < 32; d <<= 1) { const int v = __builtin_amdgcn_ds_bpermute((F.lane - d) << 2, x); if (F.lane >= d) x += v; }
        if (F.lane < 32) { offT[F.lane] = x - ntile; ((LAS int*)(F.lds + L_CNT))[F.lane] = c; }
        if (F.lane == 31) offT[32] = x;
    }
    __syncthreads();
    int T = __builtin_amdgcn_readfirstlane(offT[32]); if (T > MAXT) T = MAXT;
    for (int mt = F.tid; mt < T; mt += 512) { int e = 0;
#pragma unroll 1
        for (int j = 1; j < 32; ++j) if (offT[j] <= mt) e = j;
        tile_e[mt] = e; }
    __syncthreads();
    return T;
}

__device__ __forceinline__ void p_combine_ln(Frame& F, const Args& a, int layer, bool dry = false) {
    constexpr int TPI = 4;
    const bool last_layer = (layer == DEPTH - 1) || dry, feeds_next = (layer != DEPTH - 1) || dry;
    const bf16* XB1 = (const bf16*)(F.ws + WS_M); float* XFo = dry ? (float*)(F.ws + WS_HH) : a.out; bf16* XB = (bf16*)(F.ws + (dry ? WS_H + 280 * MiB : WS_XB)); const unsigned char* YS = (const unsigned char*)(F.ws + WS_H);
    const int* TOPE = (const int*)(F.ws + WS_TOPE); const int* RANK = (const int*)(F.ws + WS_RANK); const float* TOPW = (const float*)(F.ws + WS_TOPW);
    const LAS int* offT = (const LAS int*)(F.lds + L_OFFT);
    const float* g2 = a.in[20] + layer * 1024; const float* b2 = a.in[21] + layer * 1024;
    const int gw = F.bid * 8 + F.wave, NGW = F.G * 8, lane = F.lane;
    f32x4 gv[4], bv[4];
#pragma unroll
    for (int j = 0; j < 4; ++j) { gv[j] = *(const f32x4*)(g2 + 4 * lane + 256 * j); bv[j] = *(const f32x4*)(b2 + 4 * lane + 256 * j); }
    for (int tp = gw; tp < NTOK / TPI; tp += NGW) {
        f32x4 v[TPI][4]; unsigned yw[TPI][4][4]; f32x4 tw[TPI]; int pk[TPI][4];
#pragma unroll
        for (int u = 0; u < TPI; ++u) { const int tok = tp * TPI + u;
            const int4 te = *(const int4*)(TOPE + tok * 4), rk = *(const int4*)(RANK + tok * 4); tw[u] = *(const f32x4*)(TOPW + tok * 4);
            const v2u* xr = (const v2u*)(XB1 + (size_t)tok * 1024) + lane;
#pragma unroll
            for (int j = 0; j < 4; ++j) { const v2u pw = xr[64 * j]; v[u][j] = (f32x4){bflo(pw.x), bfhi(pw.x), bflo(pw.y), bfhi(pw.y)}; }
            pk[u][0] = offT[te.x] * 256 + rk.x; pk[u][1] = offT[te.y] * 256 + rk.y; pk[u][2] = offT[te.z] * 256 + rk.z; pk[u][3] = offT[te.w] * 256 + rk.w; }
#pragma unroll
        for (int u = 0; u < TPI; ++u)
#pragma unroll
            for (int k = 0; k < 4; ++k) { const unsigned* yr = (const unsigned*)(YS + (size_t)pk[u][k] * 1024) + lane;
#pragma unroll
                for (int j = 0; j < 4; ++j) yw[u][k][j] = yr[64 * j]; }
        float s[TPI], s2[TPI];
#pragma unroll
        for (int u = 0; u < TPI; ++u) {
#pragma unroll
            for (int j = 0; j < 4; ++j) { v[u][j] = v[u][j] * DN_ALPHA;
#pragma unroll
                for (int k = 0; k < 4; ++k) { const int y = (int)yw[u][k][j]; v[u][j] = v[u][j] + (tw[u][k] * (1.0f / 16.0f)) * (f32x4){__builtin_amdgcn_cvt_f32_fp8(y, 0), __builtin_amdgcn_cvt_f32_fp8(y, 1), __builtin_amdgcn_cvt_f32_fp8(y, 2), __builtin_amdgcn_cvt_f32_fp8(y, 3)}; } }
            s[u] = 0.f;
#pragma unroll
            for (int j = 0; j < 4; ++j) s[u] += (v[u][j][0] + v[u][j][1]) + (v[u][j][2] + v[u][j][3]); }
#pragma unroll
        for (int o = 1; o < 64; o <<= 1) {
#pragma unroll
            for (int u = 0; u < TPI; ++u) s[u] += shx(s[u], o, lane); }
#pragma unroll
        for (int u = 0; u < TPI; ++u) { const float mean = s[u] * (1.f / 1024.f); s2[u] = 0.f;
#pragma unroll
            for (int j = 0; j < 4; ++j) { v[u][j] = v[u][j] - mean; s2[u] += (v[u][j][0] * v[u][j][0] + v[u][j][1] * v[u][j][1]) + (v[u][j][2] * v[u][j][2] + v[u][j][3] * v[u][j][3]); } }
#pragma unroll
        for (int o = 1; o < 64; o <<= 1) {
#pragma unroll
            for (int u = 0; u < TPI; ++u) s2[u] += shx(s2[u], o, lane); }
#pragma unroll
        for (int u = 0; u < TPI; ++u) { const int tok = tp * TPI + u; const float rstd = rsqrtf(s2[u] * (1.f / 1024.f) + LN_EPS);
            f32x4* xo = (f32x4*)(XFo + (size_t)tok * 1024) + lane; v2u* xb = (v2u*)(XB + (size_t)tok * 1024) + lane; unsigned* x8 = (unsigned*)(F.ws + (dry ? WS_H + 344 * MiB : WS_XB8)) + (size_t)tok * 256 + lane;
#pragma unroll
            for (int j = 0; j < 4; ++j) { const f32x4 y = v[u][j] * rstd * gv[j] + bv[j]; if (last_layer) xo[64 * j] = y;
                if (feeds_next) { xb[64 * j] = (v2u){pk2(y[0], y[1]), pk2(y[2], y[3])}; x8[64 * j] = pk4_fp8(y[0], y[1], y[2], y[3], 1.0f); } } }
    }
}

__device__ __forceinline__ const Args* fresh_args() { unsigned long long p = (unsigned long long)__builtin_amdgcn_kernarg_segment_ptr(); asm volatile("" : "+s"(p)); return (const Args*)(const __attribute__((address_space(4))) void*)p; }
constexpr int PH_PER_LAYER = 10, N_PHASES = 1 + DEPTH * PH_PER_LAYER;
__global__ void __launch_bounds__(512, 2) mk_fwd(Args args) {
    extern __shared__ __attribute__((aligned(16))) unsigned char lds[];
    Frame F;
    F.lds = (LAS unsigned char*)lds; F.tid = threadIdx.x; F.lane = F.tid & 63; F.wave = __builtin_amdgcn_readfirstlane(F.tid >> 6); F.wv = F.wave;
    F.G = gridDim.x; F.bid = blockIdx.x; F.ws = fresh_args()->ws; F.ctl = (unsigned*)(F.ws + WS_CTL);
    for (int u = F.tid; u < (LDS_BYTES - LDSCTL_OFF) / 4; u += 512) ((LAS unsigned*)(F.lds + LDSCTL_OFF))[u] = 0u;
    __syncthreads();
    const int lo = fresh_args()->ph_lo, hi = fresh_args()->ph_hi;
    XcdBarrier bar; bar.bar = F.ctl + CW_BAR; bar.x = 0; bar.st = nullptr;
    if (hi - lo > 1) bar = xcd_barrier_post(F.ctl + CW_BAR, (volatile LAS unsigned*)(F.lds + L_MISC) + 8);
#define IN(k) (lo <= (k) && (k) < hi)
#define REFRESH() do { F.tid = opaque_tid(F.wv); F.lane = F.tid & 63; F.wave = __builtin_amdgcn_readfirstlane(F.tid >> 6); asm volatile("" : "+s"(F.bid), "+s"(F.G)); } while (0)
#define SEAM(k) do { if ((k) + 1 < hi) xcd_barrier(bar); } while (0)

#ifndef NO_P0
    if (IN(0)) { _Pragma("unroll") for (int rep = 0; rep < REP_T; ++rep) p_prologue(F, *fresh_args()); SEAM(0); }
#endif

    for (int l = 0; l < DEPTH; ++l) {
        const int pb = 1 + l * PH_PER_LAYER;
#ifndef NO_P1
        if (IN(pb + 0)) {
            REFRESH();
            {
                pg8::DenseOrder S{(const char*)(F.ws + WS_XB), (const char*)(F.ws + WS_WIN) + (size_t)l * INC * 1024 * 2, (size_t)256 * 1024 * 2, (size_t)256 * 1024 * 2, 16, NTOK / 256, 12, F.G, F.bid};
                pg8::EpiInProj E{(bf16*)(F.ws + WS_H), fresh_args()->in[2] + l * 3072, (const f32x2*)(F.ws + WS_ROPE64), (const f32x2*)(F.ws + WS_ROPE48), 1.0f, (unsigned char*)(F.ws + WS_G8), F.lds};
                _Pragma("unroll") for (int rep = 0; rep < REP_G1; ++rep) pg8::gemm_phase<pg8::EpiInProj, pg8::DenseOrder, true, true>(F.lds, 1024, 1024, S, E, F.wv);
            }
            {
                REFRESH();
                pg8::DenseOrder S{(const char*)(F.ws + WS_XB8), (const char*)(F.ws + WS_WIN8) + (size_t)l * 3072 * 1024, (size_t)256 * 1024, (size_t)256 * 1024, 8, NTOK / 256, 12, F.G, F.bid, 12};
                pg8::EpiInProj E{(bf16*)(F.ws + WS_H), fresh_args()->in[2] + l * 3072, (const f32x2*)(F.ws + WS_ROPE64), (const f32x2*)(F.ws + WS_ROPE48), 1.0f / 32.0f, (unsigned char*)(F.ws + WS_G8), F.lds};
                _Pragma("unroll") for (int rep = 0; rep < REP_G1; ++rep) pg8::gemm_phase<pg8::EpiInProj, pg8::DenseOrder, true, true, true>(F.lds, 1024, 1024, S, E, F.wv);
            }
            if (pb + 2 < hi) xcd_barrier(bar);
        }
#endif
#ifndef NO_P1B
#endif
        if (IN(pb + 2)) {
            REFRESH();
#ifndef NO_PC
            _Pragma("unroll") for (int rep = 0; rep < REP_C; ++rep) attnC_pipe(F, fresh_args()->in[8] + l * 4 * 48, fresh_args()->in[9] + l * 96, fresh_args()->lam_init[l]);
#endif
#ifndef NO_PA
            REFRESH();
            _Pragma("unroll") for (int rep = 0; rep < REP_AB; ++rep) attnA_mfma(F, fresh_args()->in[7] + l * 4 * 15 * 31);
#endif
#ifndef NO_PB
            REFRESH();
            _Pragma("unroll") for (int rep = 0; rep < REP_AB; ++rep) attnB_mfma(F);
#endif
            SEAM(pb + 2);
        }
#ifndef NO_P3
        if (IN(pb + 3)) {
            REFRESH();
            pg8::ProjOrder S{(const char*)(F.ws + WS_Y), (const char*)(F.ws + WS_WPROJ) + (size_t)l * 1024 * WPK * 2, NTOK / 256, 4, F.G, F.bid};
            pg8::EpiProj E{(const unsigned char*)(F.ws + WS_G8), (bf16*)(F.ws + WS_M)};
            _Pragma("unroll") for (int rep = 0; rep < REP_G3; ++rep) pg8::gemm_phase<pg8::EpiProj, pg8::ProjOrder, true, true>(F.lds, YLD, WPK, S, E, F.wv);
            SEAM(pb + 3);
        }
#endif
#ifndef NO_P4
        if (IN(pb + 4)) {
            REFRESH();
            pg8::DenseOrder S{(const char*)(F.ws + WS_M), (const char*)(F.ws + WS_WOUT) + (size_t)l * 1024 * 1024 * 2, (size_t)256 * 1024 * 2, (size_t)256 * 1024 * 2, 16, NTOK / 256, 4, F.G, F.bid};
            pg8::EpiOut E{l == 0 ? fresh_args()->in[0] : (const float*)nullptr, (const bf16*)(F.ws + WS_XB), (bf16*)(F.ws + WS_HH)};
            _Pragma("unroll") for (int rep = 0; rep < REP_G4; ++rep) pg8::gemm_phase<pg8::EpiOut, pg8::DenseOrder, true, true>(F.lds, 1024, 1024, S, E, F.wv);
            SEAM(pb + 4);
        }
#endif
#ifndef NO_P5
        if (IN(pb + 5)) { REFRESH(); if (DRY_P5) p_ln_router(F, *fresh_args(), l, true); p_ln_router(F, *fresh_args(), l); if (pb + 7 < hi) xcd_barrier(bar); }
#endif
#ifndef NO_P5B
#endif
#ifndef NO_P6
        if (IN(pb + 7)) {
            REFRESH(); const int T = moe_build(F, l);
            pg8::MoeOrder S{(const char*)(F.ws + WS_XB8), (const char*)(F.ws + WS_WGU) + (size_t)l * NEXP * 2048 * 1024, (size_t)2048 * 1024, (size_t)256 * 1024, (size_t)256 * 1024, 8,
                            (const LAS int*)(F.lds + L_TILE), (const LAS int*)(F.lds + L_OFFT), (const LAS int*)(F.lds + L_CNT), (const int*)(F.ws + WS_SRC), T, 8, F.G, F.bid};
            pg8::EpiSwiglu E{(unsigned char*)(F.ws + WS_HH), fresh_args()->in[15] + (size_t)l * NEXP * 1024, fresh_args()->in[17] + (size_t)l * NEXP * 1024, 1.0f / 32.0f, F.lds};
            _Pragma("unroll") for (int rep = 0; rep < REP_G6; ++rep) pg8::gemm_phase_gather<pg8::EpiSwiglu, pg8::MoeOrder, true>(F.lds, (const char*)(F.ws + WS_XB8), 1024, 1024, S, E, F.wv);
            SEAM(pb + 7);
        }
#endif
#ifndef NO_P7
        if (IN(pb + 8)) {
            REFRESH();
#if MK_ONE_LAUNCH
            int T = __builtin_amdgcn_readfirstlane(((const LAS int*)(F.lds + L_OFFT))[32]); if (T > MAXT) T = MAXT;
#else
            const int T = moe_build(F, l);
#endif
            pg8::MoeOrder S{(const char*)(F.ws + WS_HH), (const char*)(F.ws + WS_WDN) + (size_t)l * NEXP * 1024 * 1024, (size_t)1024 * 1024, (size_t)256 * 1024, (size_t)256 * 1024, 8,
                            (const LAS int*)(F.lds + L_TILE), (const LAS int*)(F.lds + L_OFFT), (const LAS int*)(F.lds + L_CNT), (const int*)(F.ws + WS_SRC), T, 4, F.G, F.bid};
            pg8::EpiDown E{(unsigned char*)(F.ws + WS_H), fresh_args()->in[19] + (size_t)l * NEXP * 1024, 1.0f / 256.0f, F.lds};
            _Pragma("unroll") for (int rep = 0; rep < REP_G7; ++rep) pg8::gemm_phase<pg8::EpiDown, pg8::MoeOrder, true, true, true, 32>(F.lds, 1024, 1024, S, E, F.wv);
            SEAM(pb + 8);
        }
#endif
#ifndef NO_P8
        if (IN(pb + 9)) { REFRESH(); if (!MK_ONE_LAUNCH) (void)moe_build(F, l); if (DRY_P8) p_combine_ln(F, *fresh_args(), l, true); p_combine_ln(F, *fresh_args(), l); SEAM(pb + 9); }
#endif
    }
#undef IN
#undef SEAM
}

extern "C" void kernel_launch(void* const* d_in, const int* in_sizes, int n_in, void* d_out, int out_size, void* d_ws, size_t ws_size, hipStream_t stream) {
    static int grid = 0;
    if (grid == 0) {
        if (n_in != 22 || in_sizes[0] != NTOK * D || out_size != NTOK * D || ws_size < WS_END) {
            fprintf(stderr, "kernel_launch: unexpected shapes (n_in %d, in0 %d, out %d, ws %zu); nothing launched\n", n_in, n_in > 0 ? in_sizes[0] : -1, out_size, ws_size); grid = -1; return; }
        int dev = 0, cus = 0, per_cu = 0;
        if (hipGetDevice(&dev) != hipSuccess || hipDeviceGetAttribute(&cus, hipDeviceAttributeMultiprocessorCount, dev) != hipSuccess) { grid = -1; return; }
        if (hipFuncSetAttribute((const void*)mk_fwd, hipFuncAttributeMaxDynamicSharedMemorySize, LDS_BYTES) != hipSuccess) { fprintf(stderr, "kernel_launch: hipFuncSetAttribute failed\n"); grid = -1; return; }
        if (hipOccupancyMaxActiveBlocksPerMultiprocessor(&per_cu, (const void*)mk_fwd, 512, LDS_BYTES) != hipSuccess || per_cu < 1)
            fprintf(stderr, "kernel_launch: note: occupancy query reports %d workgroups per CU\n", per_cu);
        (void)hipGetLastError();
        grid = cus;
    }
    if (grid < 0) return;
    if (hipMemsetAsync((char*)d_ws + WS_CTL, 0, CTL_ZERO_BYTES, stream) != hipSuccess) { fprintf(stderr, "kernel_launch: memset failed\n"); return; }
    Args a{};
    for (int i = 0; i < 22; ++i) a.in[i] = (const float*)d_in[i];
    a.out = (float*)d_out; a.ws = (unsigned char*)d_ws;
    for (int l = 0; l < DEPTH; ++l) a.lam_init[l] = (float)(0.8 - 0.6 * exp(-0.3 * (double)l));
#if MK_ONE_LAUNCH
    a.ph_lo = 0; a.ph_hi = N_PHASES;
    hipLaunchKernelGGL(mk_fwd, dim3(grid), dim3(512), LDS_BYTES, stream, a);
#else
    for (int p = 0; p < N_PHASES; ++p) {
        a.ph_lo = p; a.ph_hi = p + 1;
        hipLaunchKernelGGL(mk_fwd, dim3(grid), dim3(512), LDS_BYTES, stream, a);
    }
#endif
    const hipError_t le = hipPeekAtLastError();
    if (le != hipSuccess) fprintf(stderr, "kernel_launch: launch failed: %s\n", hipGetErrorName(le));
}
```

```cpp
#include <hip/hip_runtime.h>
#include <cstdio>
#include <cstdint>
#include <cmath>

#ifndef REP_AB
#define REP_AB 1
#endif
#ifndef REP_C
#define REP_C 1
#endif
#ifndef REP_G
#define REP_G 1
#endif
#ifndef REP_G1
#define REP_G1 REP_G
#endif
#ifndef REP_G3
#define REP_G3 REP_G
#endif
#ifndef REP_G4
#define REP_G4 REP_G
#endif
#ifndef REP_G6
#define REP_G6 REP_G
#endif
#ifndef REP_G7
#define REP_G7 REP_G
#endif
#ifndef REP_T
#define REP_T 1
#endif
#ifndef DRY_P5
#define DRY_P5 0
#endif
#ifndef DRY_P8
#define DRY_P8 0
#endif
#ifndef C_ANTIPHASE
#define C_ANTIPHASE 0
#endif
#ifndef MK_ONE_LAUNCH
#define MK_ONE_LAUNCH 1
#endif

#define GAS __attribute__((address_space(1)))
#define LAS __attribute__((address_space(3)))
typedef unsigned short bf16;
typedef unsigned v4u __attribute__((ext_vector_type(4)));
typedef unsigned v2u __attribute__((ext_vector_type(2)));
typedef float f32x4 __attribute__((ext_vector_type(4)));
typedef float f32x2 __attribute__((ext_vector_type(2)));
typedef short bf16x8 __attribute__((ext_vector_type(8)));

constexpr int NTOK = 32768, SEQ = 4096, D = 1024, DEPTH = 4, INC = 6144, NEXP = 32, TOPK = 4;
constexpr int C_QA = 0, C_KA = 256, C_VA = 512, C_QB = 768, C_KB = 1152, C_VB = 1536, C_QC = 1920, C_KC = 2304, C_VC = 2688, C_GP = 3072;
constexpr int YLD = 768, Y_A = 0, Y_B = 256, Y_C = 384;
constexpr int WPK = 896;
constexpr int MAXT = 544;
constexpr float LN_EPS = 1e-5f;
constexpr float DN_ALPHA = 1.681792830507429f;

constexpr size_t MiB = 1u << 20;
constexpr size_t WS_CTL = 0, CTL_ZERO_BYTES = 1 * MiB;
constexpr size_t WS_ROPE64 = 1 * MiB;
constexpr size_t WS_ROPE48 = 2 * MiB;
constexpr size_t WS_TOPE = 3 * MiB;
constexpr size_t WS_TOPW = 3 * MiB + 512 * 1024;
constexpr size_t WS_POS = 4 * MiB;
constexpr size_t WS_WIN = 8 * MiB;
constexpr size_t WS_WPROJ = 56 * MiB;
constexpr size_t WS_WOUT = 64 * MiB;
constexpr size_t WS_WGU = 72 * MiB;
constexpr size_t WS_WDN = 584 * MiB;
constexpr size_t WS_XB = 840 * MiB;
constexpr size_t WS_Y = 904 * MiB;
constexpr size_t WS_M = 952 * MiB;
constexpr size_t WS_H = 1016 * MiB;
constexpr size_t WS_HH = 1400 * MiB;
constexpr int WRT_LAYER = 2 * 32 * 1024 + 128;
constexpr size_t WS_WRT = 5 * MiB;
constexpr size_t WS_RANK = 6 * MiB;
constexpr size_t WS_SRC = 1672 * MiB;
constexpr size_t WS_XB8 = 1676 * MiB;
constexpr size_t WS_WIN8 = 1708 * MiB;
constexpr size_t WS_G8 = 1720 * MiB;
constexpr size_t WS_END = 1816 * MiB;
constexpr int CW_BAR = 4096;
constexpr int CW_CNT = 8192;
constexpr int CW_CUR = 8192 + 4 * 64;

constexpr int RING_BYTES = 131072;
constexpr int LDSCTL_OFF = RING_BYTES;
constexpr int L_MISC = LDSCTL_OFF;
constexpr int L_OFFT = LDSCTL_OFF + 256;
constexpr int L_HIST = LDSCTL_OFF + 512;
constexpr int L_BASE = LDSCTL_OFF + 768;
constexpr int L_CNT = LDSCTL_OFF + 896;
constexpr int L_TILE = LDSCTL_OFF + 1024;
constexpr int L_PPOS = LDSCTL_OFF + 4096;
constexpr int L_PTOK = LDSCTL_OFF + 6144;
constexpr int LDS_BYTES = 147456;
static_assert(L_PTOK + 2048 <= LDS_BYTES, "LDS map");

#define RLX_AGENT __ATOMIC_RELAXED, __HIP_MEMORY_SCOPE_AGENT
#define LDS_WAIT() asm volatile("s_waitcnt lgkmcnt(0)" ::: "memory")
#define VM_WAIT() asm volatile("s_waitcnt vmcnt(0)" ::: "memory")

__device__ __forceinline__ float bf2f(unsigned short b) { return __uint_as_float(((unsigned)b) << 16); }
__device__ __forceinline__ float bflo(unsigned u) { return __uint_as_float(u << 16); }
__device__ __forceinline__ float bfhi(unsigned u) { return __uint_as_float(u & 0xffff0000u); }
__device__ __forceinline__ unsigned f2bf(float f) { unsigned u = __builtin_bit_cast(unsigned, f); return (u + 0x7fffu + ((u >> 16) & 1u)) >> 16; }
typedef float pk2_f32x2 __attribute__((ext_vector_type(2)));
typedef __bf16 pk2_bf16x2 __attribute__((ext_vector_type(2)));
__device__ __forceinline__ unsigned pk2(float lo, float hi) { const pk2_f32x2 v = {lo, hi}; const pk2_bf16x2 b = __builtin_convertvector(v, pk2_bf16x2); return __builtin_bit_cast(unsigned, b); }
__device__ __forceinline__ float shx(float v, int o, int lane) { return __int_as_float(__builtin_amdgcn_ds_bpermute((lane ^ o) << 2, __float_as_int(v))); }
__device__ __forceinline__ int shxi(int v, int o, int lane) { return __builtin_amdgcn_ds_bpermute((lane ^ o) << 2, v); }
__device__ __forceinline__ float wave_sum(float v, int lane) {
#pragma unroll
    for (int o = 1; o < 64; o <<= 1) v += shx(v, o, lane);
    return v;
}
__device__ __forceinline__ int opaque_tid(int wv) { int l; asm volatile("v_mbcnt_lo_u32_b32 %0, -1, 0\n\tv_mbcnt_hi_u32_b32 %0, -1, %0" : "=v"(l)); return wv * 64 + l; }
__device__ __forceinline__ unsigned pk4_fp8(float a, float b, float c, float d, float sc) {
    a = fminf(fmaxf(a * sc, -448.f), 448.f); b = fminf(fmaxf(b * sc, -448.f), 448.f); c = fminf(fmaxf(c * sc, -448.f), 448.f); d = fminf(fmaxf(d * sc, -448.f), 448.f);
    int p = __builtin_amdgcn_cvt_pk_fp8_f32(a, b, 0, false); p = __builtin_amdgcn_cvt_pk_fp8_f32(c, d, p, true); return (unsigned)p; }
__device__ __forceinline__ unsigned pk4_fp8_nc(float a, float b, float c, float d) {
    int p = __builtin_amdgcn_cvt_pk_fp8_f32(a, b, 0, false); p = __builtin_amdgcn_cvt_pk_fp8_f32(c, d, p, true); return (unsigned)p; }
__device__ __forceinline__ float fast_sigmoid(float x) { return __builtin_amdgcn_rcpf(1.0f + __builtin_amdgcn_exp2f(-1.4426950408889634f * x)); }

namespace pg8 {
#define PG8_LAS __attribute__((address_space(3)))
typedef unsigned short bf16_t;
typedef unsigned u32x4 __attribute__((ext_vector_type(4)));
constexpr int BM = 256, BK = 64, HALF = 128, HTB = HALF * BK * 2, STAGE_BYTES = 8 * HTB, NXCD = 8, WGM = 8;

__host__ __device__ __forceinline__ int lds_byte(int r, int c) { const int st = (r >> 4) * 2 + (c >> 5), rr = r & 15, cc = c & 31, ob = rr * 64 + cc * 2; return st * 1024 + (ob ^ (((ob >> 9) & 1) << 5)); }
__host__ __device__ __forceinline__ void stage_rc(int b, int& R, int& C) { const int st = b / 1024, sb = b % 1024, swz = sb ^ (((sb >> 9) & 1) << 5); R = (st >> 1) * 16 + swz / 64; C = (st & 1) * 32 + (swz % 64) / 2; }
__host__ __device__ __forceinline__ int perm32(int rho) { const int n = rho >> 4, i = rho & 15; return 8 * (i >> 2) + 4 * n + (i & 3); }

struct Unit { const char* A; const char* B; int nt; int pm, pn, aux; int bs; };

constexpr int L_BIAS_OFF = 139264;
__device__ __forceinline__ void glds16_u(const void* gsrc, unsigned lds_dst) { unsigned keep;
    asm volatile("s_mov_b32 %0, m0\n\ts_mov_b32 m0, %2\n\ts_nop 0\n\tglobal_load_lds_dwordx4 %1, off\n\ts_mov_b32 m0, %0" : "=&s"(keep) : "v"(gsrc), "s"(lds_dst) : "memory"); }
__device__ __forceinline__ void glds16_s(const void* sbase, unsigned voff, unsigned lds_dst) { unsigned keep;
    asm volatile("s_mov_b32 %0, m0\n\ts_mov_b32 m0, %3\n\ts_nop 0\n\tglobal_load_lds_dwordx4 %1, %2\n\ts_mov_b32 m0, %0" : "=&s"(keep) : "v"(voff), "s"(sbase), "s"(lds_dst) : "memory"); }
__device__ __forceinline__ void tile_of(int L, int nM, int nN, int& pm, int& pn) {
    const int nwg = nM * nN;
    int wgid = L; { const int q = nwg / NXCD, r = nwg % NXCD, xcd = wgid % NXCD, off = wgid / NXCD; wgid = (xcd < r ? xcd * (q + 1) : r * (q + 1) + (xcd - r) * q) + off; }
    const int nig = WGM * nN, gid = wgid / nig, fm = gid * WGM, gsz = (nM - fm) < WGM ? (nM - fm) : WGM;
    pm = fm + ((wgid % nig) % gsz); pn = (wgid % nig) / gsz;
}

__device__ __forceinline__ unsigned cvt_pk_bf16(float lo, float hi) { unsigned r; asm volatile("v_cvt_pk_bf16_f32 %0, %1, %2" : "=v"(r) : "v"(lo), "v"(hi)); return r; }
typedef int v8i32 __attribute__((ext_vector_type(8)));
typedef short s16x16 __attribute__((ext_vector_type(16)));
typedef int v4i32 __attribute__((ext_vector_type(4)));
__device__ __forceinline__ v8i32 cat8(bf16x8 lo, bf16x8 hi) { const v4i32 a = __builtin_bit_cast(v4i32, lo), b = __builtin_bit_cast(v4i32, hi); return __builtin_shufflevector(a, b, 0, 1, 2, 3, 4, 5, 6, 7); }

template <class Epi, class Sched, bool ALIGN_EPI, bool SP2, bool FP8 = false, int ABLK = 0>
__device__ __forceinline__ void gemm_phase(PG8_LAS unsigned char* lds, const int lda, const int ldb, const Sched& S, const Epi& E, const int wv) {
    constexpr int EB = FP8 ? 1 : 2;
    const int tid = opaque_tid(wv), wid = wv, lane = tid & 63, wr = wid >> 2, wc = wid & 3, fr = lane & 15, fq = lane >> 4;
    unsigned voffA[2], voffB[2];
#pragma unroll
    for (int i = 0; i < 2; ++i) { int R, C; stage_rc(tid * 16 + i * 8192, R, C);
        const int Rb = Epi::PERM2 ? (64 * (R >> 5) + 16 * ((R >> 2) & 3) + 4 * ((R >> 4) & 1) + (R & 3)) : Epi::PERM ? ((R & ~31) + perm32(R & 31)) : R;
        voffA[i] = ABLK ? (unsigned)(((C * 2) / (ABLK ? ABLK : 1)) * 256 * ABLK + R * ABLK + (C * 2) % (ABLK ? ABLK : 1)) : (unsigned)(R * lda * EB + C * 2); voffB[i] = (unsigned)(Rb * ldb * EB + C * 2); }
    const size_t kstep = (size_t)(BK * 2), kstepA = ABLK ? (size_t)32768 : kstep;
    const size_t hA = ABLK ? (size_t)(HALF * ABLK) : (size_t)HALF * lda * EB, hB = (size_t)(Epi::PERM2 ? 8 : HALF) * ldb * EB;
    const unsigned ldsw = (unsigned)wid * 1024u;
    const int fcol = fq * 8;
    const int aoff = lds_byte(wr * 64 + fr, fcol), boff = lds_byte(wc * 32 + fr, fcol);
#define PG8_SA(b, h) (((b) * 2 + (h)) * HTB)
#define PG8_SB(b, h) ((4 + (b) * 2 + (h)) * HTB)
#define PG8_STAGE(bufoff, gbase, voff) do { _Pragma("unroll") for (int _i = 0; _i < 2; ++_i) \
        __builtin_amdgcn_global_load_lds((const unsigned*)((const char*)(gbase) + (voff)[_i]), (PG8_LAS unsigned*)(lds + (bufoff) + ldsw + _i * 8192), 16, 0, 0); } while (0)
#define PG8_LDA(dst, b, h) do { if constexpr (FP8) { _Pragma("unroll") for (int m = 0; m < 4; ++m) dst##8[m] = cat8(*(const PG8_LAS bf16x8*)(lds + PG8_SA(b, h) + aoff + m * 2048), *(const PG8_LAS bf16x8*)(lds + PG8_SA(b, h) + aoff + m * 2048 + 1024)); } else { \
        _Pragma("unroll") for (int m = 0; m < 4; ++m) _Pragma("unroll") for (int k = 0; k < 2; ++k) dst[m][k] = *(const PG8_LAS bf16x8*)(lds + PG8_SA(b, h) + aoff + m * 2048 + k * 1024); } } while (0)
#define PG8_LDB(dst, b, h) do { if constexpr (FP8) { _Pragma("unroll") for (int n = 0; n < 2; ++n) dst##8[n] = cat8(*(const PG8_LAS bf16x8*)(lds + PG8_SB(b, h) + boff + n * 2048), *(const PG8_LAS bf16x8*)(lds + PG8_SB(b, h) + boff + n * 2048 + 1024)); } else { \
        _Pragma("unroll") for (int n = 0; n < 2; ++n) _Pragma("unroll") for (int k = 0; k < 2; ++k) dst[n][k] = *(const PG8_LAS bf16x8*)(lds + PG8_SB(b, h) + boff + n * 2048 + k * 1024); } } while (0)
#define PG8_MMA(ai, bj, At, Bt) do { __builtin_amdgcn_s_setprio(1); if constexpr (FP8) { _Pragma("unroll") for (int m = 0; m < 4; ++m) _Pragma("unroll") for (int n = 0; n < 2; ++n) \
        asm volatile("v_mfma_f32_16x16x128_f8f6f4 %0, %1, %2, %0" : "+v"(acc[ai][bj][m][n]) : "v"(Bt##8[n]), "v"(At##8[m])); } else { \
        _Pragma("unroll") for (int m = 0; m < 4; ++m) _Pragma("unroll") for (int n = 0; n < 2; ++n) _Pragma("unroll") for (int k = 0; k < 2; ++k) \
        acc[ai][bj][m][n] = __builtin_amdgcn_mfma_f32_16x16x32_bf16(Bt[n][k], At[m][k], acc[ai][bj][m][n], 0, 0, 0); } __builtin_amdgcn_s_setprio(0); } while (0)
#define PG8_WAIT_V(n) asm volatile("s_waitcnt vmcnt(" #n ")" ::: "memory")
#define PG8_WAIT_VF(f) do { if constexpr (Epi::NS > 0) asm volatile("s_cmp_lg_u32 %0, 0\n\ts_cbranch_scc1 .Lwf%=\n\ts_waitcnt vmcnt(8)\n\ts_branch .Lwe%=\n.Lwf%=:\n\ts_waitcnt vmcnt(%1)\n.Lwe%=:" :: "s"(f), "n"(8 + Epi::NS) : "memory", "scc"); else PG8_WAIT_V(8); } while (0)
#define PG8_WAIT_L(n) asm volatile("s_waitcnt lgkmcnt(" #n ")" ::: "memory")
#define PG8_BAR __builtin_amdgcn_s_barrier()
#define PG8_SCHED __builtin_amdgcn_sched_barrier(0)
    Unit cur, nxt; int ui = 0;
    if (!S.next(0, cur)) return;
    f32x4 acc[2][2][4][2];
#pragma unroll
    for (int a = 0; a < 2; ++a)
#pragma unroll
        for (int b = 0; b < 2; ++b)
#pragma unroll
            for (int m = 0; m < 4; ++m)
#pragma unroll
                for (int n = 0; n < 2; ++n) acc[a][b][m][n] = (f32x4){0.f, 0.f, 0.f, 0.f};
    bf16x8 At[4][2], B0[2][2], B1[2][2]; v8i32 At8[4], B08[2], B18[2];
    const char* cA = cur.A; const char* cB = cur.B;
    if constexpr (Epi::BIAS_DMA) { if (wid == 0) E.bias_dma(cur, 0, lane, lds); }
    if constexpr (SP2) {
        PG8_STAGE(PG8_SB(0, 0), cB, voffB); PG8_STAGE(PG8_SB(0, 1), cB + hB, voffB); PG8_STAGE(PG8_SA(0, 0), cA, voffA); PG8_STAGE(PG8_SA(0, 1), cA + hA, voffA);
        if (wr == 1) PG8_BAR;
        PG8_WAIT_V(2); PG8_BAR;
        PG8_STAGE(PG8_SB(1, 0), cB + kstep, voffB); PG8_STAGE(PG8_SA(1, 0), cA + kstepA, voffA); PG8_STAGE(PG8_SB(1, 1), cB + hB + kstep, voffB);
        PG8_WAIT_V(6); PG8_BAR;
    } else {
        PG8_STAGE(PG8_SB(0, 0), cB, voffB); PG8_STAGE(PG8_SA(0, 0), cA, voffA); PG8_STAGE(PG8_SB(0, 1), cB + hB, voffB); PG8_STAGE(PG8_SA(0, 1), cA + hA, voffA);
        if (wr == 1) PG8_BAR;
        PG8_WAIT_V(4); PG8_BAR;
        PG8_STAGE(PG8_SB(1, 0), cB + kstep, voffB); PG8_STAGE(PG8_SA(1, 0), cA + kstepA, voffA); PG8_STAGE(PG8_SB(1, 1), cB + hB + kstep, voffB);
        PG8_WAIT_V(6); PG8_BAR;
    }
    for (;;) {
        const bool has_next = S.next(ui + 1, nxt);
        if constexpr (Epi::BIAS_DMA) { if (has_next && wid == 0) E.bias_dma(nxt, (ui + 1) % 3, lane, lds); }
        const char* nA = has_next ? nxt.A : cA; const char* nB = has_next ? nxt.B : cB;
        const int nt = cur.nt;
        for (int t = 0; t < nt; t += 2) {
            const bool last = (t == nt - 2); const int fst = __builtin_amdgcn_readfirstlane((t == 0 && ui > 0) ? 1 : 0);
            const char* a1 = cA + (size_t)(t + 1) * kstepA;
            const char* a2 = last ? nA : cA + (size_t)(t + 2) * kstepA; const char* b2 = last ? nB : cB + (size_t)(t + 2) * kstep;
            const char* a3 = a2 + kstepA; const char* b3 = b2 + kstep;
            if constexpr (SP2) {
            PG8_LDB(B0, 0, 0); PG8_LDB(B1, 0, 1); PG8_SCHED; PG8_LDA(At, 0, 0); PG8_STAGE(PG8_SA(1, 1), a1 + hA, voffA);
            PG8_WAIT_VF(fst); PG8_WAIT_L(0); PG8_BAR; PG8_MMA(0, 0, At, B0); PG8_MMA(0, 1, At, B1); PG8_BAR; PG8_SCHED;
            PG8_LDA(At, 0, 1); PG8_STAGE(PG8_SB(0, 0), b2, voffB); PG8_STAGE(PG8_SB(0, 1), b2 + hB, voffB); PG8_STAGE(PG8_SA(0, 0), a2, voffA);
            PG8_WAIT_VF(fst); PG8_WAIT_L(0); PG8_BAR; PG8_MMA(1, 0, At, B0); PG8_MMA(1, 1, At, B1); PG8_BAR; PG8_SCHED;
            PG8_LDB(B0, 1, 0); PG8_LDB(B1, 1, 1); PG8_SCHED; PG8_LDA(At, 1, 0); PG8_STAGE(PG8_SA(0, 1), a2 + hA, voffA);
            PG8_WAIT_V(8); PG8_WAIT_L(0); PG8_BAR; PG8_MMA(0, 0, At, B0); PG8_MMA(0, 1, At, B1); PG8_BAR; PG8_SCHED;
            PG8_LDA(At, 1, 1); PG8_STAGE(PG8_SB(1, 0), b3, voffB); PG8_STAGE(PG8_SB(1, 1), b3 + hB, voffB); PG8_STAGE(PG8_SA(1, 0), a3, voffA);
            PG8_WAIT_V(8); PG8_WAIT_L(0); PG8_BAR; PG8_MMA(1, 0, At, B0); PG8_MMA(1, 1, At, B1); PG8_BAR; PG8_SCHED;
            } else {
            PG8_LDB(B0, 0, 0); PG8_SCHED; PG8_LDA(At, 0, 0); PG8_STAGE(PG8_SA(1, 1), a1 + hA, voffA);
            PG8_WAIT_L(8); PG8_BAR; PG8_WAIT_L(0); PG8_MMA(0, 0, At, B0); PG8_BAR; PG8_SCHED;
            PG8_LDB(B1, 0, 1); PG8_STAGE(PG8_SB(0, 0), b2, voffB);
            PG8_BAR; PG8_WAIT_L(0); PG8_MMA(0, 1, At, B1); PG8_BAR;
            PG8_LDA(At, 0, 1); PG8_STAGE(PG8_SA(0, 0), a2, voffA);
            PG8_BAR; PG8_WAIT_L(0); PG8_MMA(1, 0, At, B0); PG8_BAR; PG8_SCHED;
            PG8_STAGE(PG8_SB(0, 1), b2 + hB, voffB);
            PG8_WAIT_V(6); PG8_BAR; PG8_MMA(1, 1, At, B1); PG8_BAR;
            PG8_LDB(B0, 1, 0); PG8_SCHED; PG8_LDA(At, 1, 0); PG8_STAGE(PG8_SA(0, 1), a2 + hA, voffA);
            PG8_WAIT_L(8); PG8_BAR; PG8_WAIT_L(0); PG8_MMA(0, 0, At, B0); PG8_BAR; PG8_SCHED;
            PG8_LDB(B1, 1, 1); PG8_STAGE(PG8_SB(1, 0), b3, voffB);
            PG8_BAR; PG8_WAIT_L(0); PG8_MMA(0, 1, At, B1); PG8_BAR;
            PG8_LDA(At, 1, 1); PG8_STAGE(PG8_SA(1, 0), a3, voffA);
            PG8_BAR; PG8_WAIT_L(0); PG8_MMA(1, 0, At, B0); PG8_BAR; PG8_SCHED;
            PG8_STAGE(PG8_SB(1, 1), b3 + hB, voffB);
            PG8_WAIT_V(6); PG8_BAR; PG8_MMA(1, 1, At, B1); PG8_BAR;
            }
        }
        if constexpr (ALIGN_EPI) { if (wr == 0) PG8_BAR; }
        if constexpr (FP8) asm volatile("s_nop 15\n\ts_nop 15\n\ts_nop 15" ::: "memory");
        cur.bs = ui % 3;
        E(acc, cur, wr, wc, fr, fq);
        if (!has_next) break;
        if (!(Epi::KEEP && cur.aux != 2)) {
#pragma unroll
        for (int a = 0; a < 2; ++a)
#pragma unroll
            for (int b = 0; b < 2; ++b)
#pragma unroll
                for (int m = 0; m < 4; ++m)
#pragma unroll
                    for (int n = 0; n < 2; ++n) acc[a][b][m][n] = (f32x4){0.f, 0.f, 0.f, 0.f};
        }
        cur = nxt; cA = nA; cB = nB; ++ui;
        if constexpr (ALIGN_EPI) { if (wr == 1) PG8_BAR; }
    }
    PG8_WAIT_V(0);
    if constexpr (!ALIGN_EPI) { if (wr == 0) PG8_BAR; }
    PG8_BAR;
#undef PG8_SA
#undef PG8_SB
#undef PG8_STAGE
#undef PG8_LDA
#undef PG8_LDB
#undef PG8_MMA
#undef PG8_WAIT_V
#undef PG8_WAIT_VF
#undef PG8_WAIT_L
#undef PG8_BAR
#undef PG8_SCHED
}

template <class Epi, class Sched, bool FP8 = false>
__device__ __forceinline__ void gemm_phase_gather(PG8_LAS unsigned char* lds, const char* Abase, const int lda, const int ldb, const Sched& S, const Epi& E, const int wv) {
    constexpr int EB = FP8 ? 1 : 2;
    const int tid = opaque_tid(wv), wid = wv, lane = tid & 63, wr = wid >> 2, wc = wid & 3, fr = lane & 15, fq = lane >> 4;
    unsigned voffB[2]; int Rr[2]; unsigned Cc[2];
#pragma unroll
    for (int i = 0; i < 2; ++i) { int R, C; stage_rc(tid * 16 + i * 8192, R, C); const int Rb = Epi::PERM ? ((R & ~31) + perm32(R & 31)) : R;
        Rr[i] = R; Cc[i] = (unsigned)C * 2u; voffB[i] = (unsigned)(Rb * ldb * EB + C * 2); }
    const size_t kstep = (size_t)(BK * 2);
    const size_t hB = (size_t)HALF * ldb * EB;
    const unsigned ldsw = (unsigned)wid * 1024u;
    const int fcol = fq * 8;
    const int aoff = lds_byte(wr * 64 + fr, fcol), boff = lds_byte(wc * 32 + fr, fcol);
#define PG8_SA(b, h) (((b) * 2 + (h)) * HTB)
#define PG8_SB(b, h) ((4 + (b) * 2 + (h)) * HTB)
#define PG8_STAGE(bufoff, gbase, voff) do { _Pragma("unroll") for (int _i = 0; _i < 2; ++_i) \
        __builtin_amdgcn_global_load_lds((const unsigned*)((const char*)(gbase) + (voff)[_i]), (PG8_LAS unsigned*)(lds + (bufoff) + ldsw + _i * 8192), 16, 0, 0); } while (0)
#define PG8_LDA(dst, b, h) do { if constexpr (FP8) { _Pragma("unroll") for (int m = 0; m < 4; ++m) dst##8[m] = cat8(*(const PG8_LAS bf16x8*)(lds + PG8_SA(b, h) + aoff + m * 2048), *(const PG8_LAS bf16x8*)(lds + PG8_SA(b, h) + aoff + m * 2048 + 1024)); } else { \
        _Pragma("unroll") for (int m = 0; m < 4; ++m) _Pragma("unroll") for (int k = 0; k < 2; ++k) dst[m][k] = *(const PG8_LAS bf16x8*)(lds + PG8_SA(b, h) + aoff + m * 2048 + k * 1024); } } while (0)
#define PG8_LDB(dst, b, h) do { if constexpr (FP8) { _Pragma("unroll") for (int n = 0; n < 2; ++n) dst##8[n] = cat8(*(const PG8_LAS bf16x8*)(lds + PG8_SB(b, h) + boff + n * 2048), *(const PG8_LAS bf16x8*)(lds + PG8_SB(b, h) + boff + n * 2048 + 1024)); } else { \
        _Pragma("unroll") for (int n = 0; n < 2; ++n) _Pragma("unroll") for (int k = 0; k < 2; ++k) dst[n][k] = *(const PG8_LAS bf16x8*)(lds + PG8_SB(b, h) + boff + n * 2048 + k * 1024); } } while (0)
#define PG8_MMA(ai, bj, At, Bt) do { __builtin_amdgcn_s_setprio(1); if constexpr (FP8) { _Pragma("unroll") for (int m = 0; m < 4; ++m) _Pragma("unroll") for (int n = 0; n < 2; ++n) \
        asm volatile("v_mfma_f32_16x16x128_f8f6f4 %0, %1, %2, %0" : "+v"(acc[ai][bj][m][n]) : "v"(Bt##8[n]), "v"(At##8[m])); } else { \
        _Pragma("unroll") for (int m = 0; m < 4; ++m) _Pragma("unroll") for (int n = 0; n < 2; ++n) _Pragma("unroll") for (int k = 0; k < 2; ++k) \
        acc[ai][bj][m][n] = __builtin_amdgcn_mfma_f32_16x16x32_bf16(Bt[n][k], At[m][k], acc[ai][bj][m][n], 0, 0, 0); } __builtin_amdgcn_s_setprio(0); } while (0)
#define PG8_WAIT_V(n) asm volatile("s_waitcnt vmcnt(" #n ")" ::: "memory")
#define PG8_WAIT_VF(f) do { if constexpr (Epi::NS > 0) asm volatile("s_cmp_lg_u32 %0, 0\n\ts_cbranch_scc1 .Lwf%=\n\ts_waitcnt vmcnt(8)\n\ts_branch .Lwe%=\n.Lwf%=:\n\ts_waitcnt vmcnt(%1)\n.Lwe%=:" :: "s"(f), "n"(8 + Epi::NS) : "memory", "scc"); else PG8_WAIT_V(8); } while (0)
#define PG8_WAIT_L(n) asm volatile("s_waitcnt lgkmcnt(" #n ")" ::: "memory")
#define PG8_BAR __builtin_amdgcn_s_barrier()
#define PG8_SCHED __builtin_amdgcn_sched_barrier(0)
#define PG8_ROWOFF(u, vo) do { _Pragma("unroll") for (int _h = 0; _h < 2; ++_h) _Pragma("unroll") for (int _i = 0; _i < 2; ++_i) \
        (vo)[_h][_i] = (unsigned)S.rowtok((u), 128 * _h + Rr[_i]) * (unsigned)(lda * EB) + Cc[_i]; } while (0)
    Unit cur, nxt, nn; int ui = 0;
    if (!S.next(0, cur)) return;
    bool has_next = S.next(1, nxt);
    unsigned cv[2][2], nv[2][2], tv[2][2];
    PG8_ROWOFF(cur, cv);
    if (has_next) PG8_ROWOFF(nxt, nv); else { _Pragma("unroll") for (int h = 0; h < 2; ++h) _Pragma("unroll") for (int i = 0; i < 2; ++i) nv[h][i] = cv[h][i]; }
    f32x4 acc[2][2][4][2];
#pragma unroll
    for (int a = 0; a < 2; ++a)
#pragma unroll
        for (int b = 0; b < 2; ++b)
#pragma unroll
            for (int m = 0; m < 4; ++m)
#pragma unroll
                for (int n = 0; n < 2; ++n) acc[a][b][m][n] = (f32x4){0.f, 0.f, 0.f, 0.f};
    bf16x8 At[4][2], B0[2][2], B1[2][2]; v8i32 At8[4], B08[2], B18[2];
    const char* cB = cur.B;
    if constexpr (Epi::BIAS_DMA) { if (wid == 0) E.bias_dma(cur, 0, lane, lds); }
    PG8_STAGE(PG8_SB(0, 0), cB, voffB); PG8_STAGE(PG8_SB(0, 1), cB + hB, voffB); PG8_STAGE(PG8_SA(0, 0), Abase, cv[0]); PG8_STAGE(PG8_SA(0, 1), Abase, cv[1]);
    if (wr == 1) PG8_BAR;
    PG8_WAIT_V(2); PG8_BAR;
    PG8_STAGE(PG8_SB(1, 0), cB + kstep, voffB); PG8_STAGE(PG8_SA(1, 0), Abase + kstep, cv[0]); PG8_STAGE(PG8_SB(1, 1), cB + hB + kstep, voffB);
    PG8_WAIT_V(6); PG8_BAR;
    for (;;) {
        const char* nB = has_next ? nxt.B : cB;
        if constexpr (Epi::BIAS_DMA) { if (has_next && wid == 0) E.bias_dma(nxt, (ui + 1) % 3, lane, lds); }
        const int nt = cur.nt;
        for (int t = 0; t < nt; t += 2) {
            const bool last = (t == nt - 2); const int fst = __builtin_amdgcn_readfirstlane((t == 0 && ui > 0) ? 1 : 0);
            const char* a1 = Abase + (size_t)(t + 1) * kstep;
            const char* a2 = last ? Abase : Abase + (size_t)(t + 2) * kstep; const char* b2 = last ? nB : cB + (size_t)(t + 2) * kstep;
            const char* a3 = a2 + kstep; const char* b3 = b2 + kstep;
            unsigned s0[2], s1[2];
#pragma unroll
            for (int i = 0; i < 2; ++i) { s0[i] = last ? nv[0][i] : cv[0][i]; s1[i] = last ? nv[1][i] : cv[1][i]; }
            PG8_LDB(B0, 0, 0); PG8_LDB(B1, 0, 1); PG8_SCHED; PG8_LDA(At, 0, 0); PG8_STAGE(PG8_SA(1, 1), a1, cv[1]);
            PG8_WAIT_VF(fst); PG8_WAIT_L(0); PG8_BAR; PG8_MMA(0, 0, At, B0); PG8_MMA(0, 1, At, B1); PG8_BAR; PG8_SCHED;
            PG8_LDA(At, 0, 1); PG8_STAGE(PG8_SB(0, 0), b2, voffB); PG8_STAGE(PG8_SB(0, 1), b2 + hB, voffB); PG8_STAGE(PG8_SA(0, 0), a2, s0);
            PG8_WAIT_VF(fst); PG8_WAIT_L(0); PG8_BAR; PG8_MMA(1, 0, At, B0); PG8_MMA(1, 1, At, B1); PG8_BAR; PG8_SCHED;
            PG8_LDB(B0, 1, 0); PG8_LDB(B1, 1, 1); PG8_SCHED; PG8_LDA(At, 1, 0); PG8_STAGE(PG8_SA(0, 1), a2, s1);
            PG8_WAIT_V(8); PG8_WAIT_L(0); PG8_BAR; PG8_MMA(0, 0, At, B0); PG8_MMA(0, 1, At, B1); PG8_BAR; PG8_SCHED;
            PG8_LDA(At, 1, 1); PG8_STAGE(PG8_SB(1, 0), b3, voffB); PG8_STAGE(PG8_SB(1, 1), b3 + hB, voffB); PG8_STAGE(PG8_SA(1, 0), a3, s0);
            PG8_WAIT_V(8); PG8_WAIT_L(0); PG8_BAR; PG8_MMA(1, 0, At, B0); PG8_MMA(1, 1, At, B1); PG8_BAR; PG8_SCHED;
        }
        if (wr == 0) PG8_BAR;
        if constexpr (FP8) asm volatile("s_nop 15\n\ts_nop 15\n\ts_nop 15" ::: "memory");
        const bool has_nn = has_next && S.next(ui + 2, nn);
        if (has_nn) PG8_ROWOFF(nn, tv);
        cur.bs = ui % 3;
        E(acc, cur, wr, wc, fr, fq);
        if (!has_next) break;
#pragma unroll
        for (int a = 0; a < 2; ++a)
#pragma unroll
            for (int b = 0; b < 2; ++b)
#pragma unroll
                for (int m = 0; m < 4; ++m)
#pragma unroll
                    for (int n = 0; n < 2; ++n) acc[a][b][m][n] = (f32x4){0.f, 0.f, 0.f, 0.f};
        cur = nxt; cB = nB; ++ui;
#pragma unroll
        for (int h = 0; h < 2; ++h)
#pragma unroll
            for (int i = 0; i < 2; ++i) { cv[h][i] = nv[h][i]; if (has_nn) nv[h][i] = tv[h][i]; }
        asm volatile("" : "+v"(nv[0][0]), "+v"(nv[0][1]), "+v"(nv[1][0]), "+v"(nv[1][1]));
        nxt = nn; has_next = has_nn;
        if (wr == 1) PG8_BAR;
    }
    PG8_WAIT_V(0);
    PG8_BAR;
#undef PG8_SA
#undef PG8_SB
#undef PG8_STAGE
#undef PG8_LDA
#undef PG8_LDB
#undef PG8_MMA
#undef PG8_WAIT_V
#undef PG8_WAIT_VF
#undef PG8_WAIT_L
#undef PG8_BAR
#undef PG8_SCHED
#undef PG8_ROWOFF
}

struct DenseOrder {
    const char* A; const char* B; size_t a_tile, b_tile; int nt, nM, nN, G, c; int pn_off = 0;
    __device__ __forceinline__ bool next(int i, Unit& u) const {
        const long L = (long)i * G + c; if (L >= (long)nM * nN) return false;
        int pm, pn; tile_of((int)L, nM, nN, pm, pn);
        u.pm = pm; u.pn = pn + pn_off; u.aux = 0; u.nt = nt; u.A = A + (size_t)pm * a_tile; u.B = B + (size_t)pn * b_tile; return true;
    }
};
struct ProjOrder {
    const char* Y; const char* W; int nM, nN, G, c;
    __device__ __forceinline__ bool next(int i, Unit& u) const {
        const int ti = i / 3, br = i - 3 * ti;
        const long L = (long)ti * G + c; if (L >= (long)nM * nN) return false;
        int pm, pn; tile_of((int)L, nM, nN, pm, pn);
        u.pm = pm; u.pn = pn; u.aux = br; u.nt = (br == 2) ? 6 : 4;
        const int acol = (br == 0) ? 0 : (br == 1 ? 256 : 384), bcol = (br == 0) ? 0 : (br == 1 ? 256 : 512);
        u.A = Y + ((size_t)pm * 256 * YLD + acol) * 2; u.B = W + ((size_t)pn * 256 * WPK + bcol) * 2; return true;
    }
};
struct MoeOrder {
    const char* A; const char* W; size_t estride, atile, btile; int nt; const LAS int* tile_e; const LAS int* offT; const LAS int* cnt; const int* SRC; int T, nN, G, c;
    __device__ __forceinline__ bool next(int i, Unit& u) const {
        const long L = (long)i * G + c; if (L >= (long)T * nN) return false;
        int pm, pn; tile_of((int)L, T, nN, pm, pn);
        const int e = __builtin_amdgcn_readfirstlane(tile_e[pm]);
        u.pm = pm; u.pn = pn; u.aux = e; u.nt = nt; u.A = A + (size_t)pm * atile; u.B = W + (size_t)e * estride + (size_t)pn * btile; return true;
    }
    __device__ __forceinline__ int rowtok(const Unit& u, int r) const {
        const int e = u.aux, rank = (u.pm - offT[e]) * 256 + r, last = cnt[e] - 1;
        return SRC[e * NTOK + (rank < last ? rank : last)];
    }
};

struct EpiInProj {
    static constexpr bool PERM2 = false; static constexpr bool PERM = true, KEEP = false, BIAS_DMA = true; static constexpr int NS = 16;
    bf16_t* H; const float* bg; const f32x2* r64; const f32x2* r48; float gscale; unsigned char* G8; PG8_LAS unsigned char* ldsb;
    __device__ __forceinline__ void bias_dma(const Unit& u, int s, int lane, PG8_LAS unsigned char* lds) const {
        const int o = u.pn >= 12 ? (u.pn - 12) * BM : 0;
        glds16_s(bg + o, (unsigned)lane * 16u, (unsigned)__builtin_amdgcn_readfirstlane((int)(unsigned)(size_t)(lds + L_BIAS_OFF + s * 1024))); }
    __device__ __forceinline__ void operator()(f32x4 (&acc)[2][2][4][2], const Unit& u, int wr, int wc, int fr, int fq) const {
        const int row0 = u.pm * BM + wr * 64 + fr, pn = u.pn, t0 = wc * 32 + 8 * fq;
        const float gs = gscale; unsigned char* const g8 = G8;
        if (pn >= 3 && pn < 9) {
            int dst, hstep, tw, dd0; const f32x2* tab;
            if (pn < 6) { dst = 768 + (4 * (pn - 3) + wc) * 64 + 8 * fq; hstep = 32; tw = 32; dd0 = 8 * fq; tab = r64; }
            else { const int p0 = 128 * (pn - 6) + t0, slot = p0 / 24; dd0 = p0 - slot * 24; dst = 1920 + slot * 48 + dd0; hstep = 24; tw = 24; tab = r48; }
            f32x4 cb[2][2], s16[2][2], s128[2][2];
            { const f32x2* tp = tab + (size_t)(row0 & (SEQ - 1)) * tw + dd0; const f32x2* t16 = tab + (size_t)16 * tw + dd0; const f32x2* t128 = tab + (size_t)128 * tw + dd0;
#pragma unroll
              for (int n = 0; n < 2; ++n)
#pragma unroll
                  for (int h = 0; h < 2; ++h) { cb[n][h] = *(const f32x4*)(tp + 4 * n + 2 * h); s16[n][h] = *(const f32x4*)(t16 + 4 * n + 2 * h); s128[n][h] = *(const f32x4*)(t128 + 4 * n + 2 * h); } }
#pragma unroll
            for (int ai = 0; ai < 2; ++ai) {
                f32x4 cs[2][2];
#pragma unroll
                for (int n = 0; n < 2; ++n)
#pragma unroll
                    for (int h = 0; h < 2; ++h) { const f32x4 b = cb[n][h], r = s128[n][h];
                        cs[n][h] = ai == 0 ? b : (f32x4){b[0] * r[0] - b[1] * r[1], b[1] * r[0] + b[0] * r[1], b[2] * r[2] - b[3] * r[3], b[3] * r[2] + b[2] * r[3]}; }
#pragma unroll
                for (int m = 0; m < 4; ++m) { const int row = row0 + ai * HALF + m * 16;
                    f32x4 y1[2], y2[2];
#pragma unroll
                    for (int n = 0; n < 2; ++n) { const f32x4 cs0 = cs[n][0], cs1 = cs[n][1];
                        const f32x4 x1 = acc[ai][0][m][n], x2 = acc[ai][1][m][n];
                        y1[n][0] = x1[0] * cs0[0] - x2[0] * cs0[1]; y2[n][0] = x2[0] * cs0[0] + x1[0] * cs0[1];
                        y1[n][1] = x1[1] * cs0[2] - x2[1] * cs0[3]; y2[n][1] = x2[1] * cs0[2] + x1[1] * cs0[3];
                        y1[n][2] = x1[2] * cs1[0] - x2[2] * cs1[1]; y2[n][2] = x2[2] * cs1[0] + x1[2] * cs1[1];
                        y1[n][3] = x1[3] * cs1[2] - x2[3] * cs1[3]; y2[n][3] = x2[3] * cs1[2] + x1[3] * cs1[3]; }
                    bf16_t* rowp = H + (size_t)row * INC + dst;
                    u32x4 w; w.x = cvt_pk_bf16(y1[0][0], y1[0][1]); w.y = cvt_pk_bf16(y1[0][2], y1[0][3]); w.z = cvt_pk_bf16(y1[1][0], y1[1][1]); w.w = cvt_pk_bf16(y1[1][2], y1[1][3]);
                    *(u32x4*)rowp = w;
                    w.x = cvt_pk_bf16(y2[0][0], y2[0][1]); w.y = cvt_pk_bf16(y2[0][2], y2[0][3]); w.z = cvt_pk_bf16(y2[1][0], y2[1][1]); w.w = cvt_pk_bf16(y2[1][2], y2[1][3]);
                    *(u32x4*)(rowp + hstep) = w;
                    if (m < 3) {
#pragma unroll
                        for (int n = 0; n < 2; ++n)
#pragma unroll
                            for (int h = 0; h < 2; ++h) { const f32x4 b = cs[n][h], r = s16[n][h];
                                cs[n][h] = (f32x4){b[0] * r[0] - b[1] * r[1], b[1] * r[0] + b[0] * r[1], b[2] * r[2] - b[3] * r[3], b[3] * r[2] + b[2] * r[3]}; } } } }
            return;
        }
        const bool gate = pn >= 12;
        if (gate) {
            const int gb = pn - 12, gbr = gb >> 2, pno = gb & 3;
            v4u* gimg = (v4u*)g8 + (size_t)((u.pm * 3 + gbr) * 4 + pno) * 4096 + (wr * 4 + wc) * 64 + fq * 16 + fr;
            f32x4 bv[2][2];
#pragma unroll
            for (int bj = 0; bj < 2; ++bj)
#pragma unroll
                for (int n = 0; n < 2; ++n) bv[bj][n] = *(const PG8_LAS f32x4*)((const PG8_LAS float*)(ldsb + L_BIAS_OFF + u.bs * 1024) + bj * HALF + t0 + 4 * n) * (-1.4426950408889634f);
            const float gsn = gs * (-1.4426950408889634f);
#pragma unroll
            for (int ai = 0; ai < 2; ++ai)
#pragma unroll
                for (int m = 0; m < 4; ++m) { v4u w;
#pragma unroll
                    for (int bj = 0; bj < 2; ++bj)
#pragma unroll
                        for (int n = 0; n < 2; ++n) { const f32x4 z = acc[ai][bj][m][n] * gsn + bv[bj][n]; unsigned d = 0;
#pragma unroll
                            for (int q = 0; q < 4; ++q) d |= (unsigned)fmaxf(__builtin_amdgcn_rcpf(__builtin_amdgcn_exp2f(z[q]) * (1.0f / 255.0f) + (1.0f / 255.0f)) + 0.5f, 1.0f) << (8 * q);
                            w[bj * 2 + n] = d; }
                    gimg[(ai * 4 + m) * 512] = w; }
            return;
        }
        int dcol[2];
#pragma unroll
        for (int bj = 0; bj < 2; ++bj) { const int x = pn * BM + bj * HALF + t0;
            if (pn >= 9 && pn < 12) { const int xx = x - 2304; dcol[bj] = xx < 384 ? 1536 + xx : 2688 + (xx - 384); } else dcol[bj] = x; }
#pragma unroll
        for (int ai = 0; ai < 2; ++ai)
#pragma unroll
            for (int m = 0; m < 4; ++m) { bf16_t* rowp = H + (size_t)(row0 + ai * HALF + m * 16) * INC;
#pragma unroll
                for (int bj = 0; bj < 2; ++bj) { const f32x4 v0 = acc[ai][bj][m][0], v1 = acc[ai][bj][m][1];
                    u32x4 w; w.x = cvt_pk_bf16(v0[0], v0[1]); w.y = cvt_pk_bf16(v0[2], v0[3]); w.z = cvt_pk_bf16(v1[0], v1[1]); w.w = cvt_pk_bf16(v1[2], v1[3]);
                    *(u32x4*)(rowp + dcol[bj]) = w; } }
    }
};
struct EpiProj {
    static constexpr bool PERM2 = false; static constexpr bool PERM = true, KEEP = true, BIAS_DMA = false; static constexpr int NS = 0;
    const unsigned char* G8; bf16_t* Mg;
    __device__ __forceinline__ void operator()(f32x4 (&acc)[2][2][4][2], const Unit& u, int wr, int wc, int fr, int fq) const {
        const int row0 = u.pm * BM + wr * 64 + fr, col0 = u.pn * BM + wc * 32 + 8 * fq, br = u.aux;
        const v4u* gp = (const v4u*)G8 + (size_t)((u.pm * 3 + br) * 4 + u.pn) * 4096 + (wr * 4 + wc) * 64 + fq * 16 + fr;
        bf16_t* const mg = Mg;
#pragma unroll
        for (int ai = 0; ai < 2; ++ai)
#pragma unroll
            for (int m = 0; m < 4; ++m) { const v4u gq = gp[(ai * 4 + m) * 512];
                if (br < 2) { const v4u gn = gp[(ai * 4 + m) * 512 + 4 * 4096];
#pragma unroll
                    for (int bj = 0; bj < 2; ++bj)
#pragma unroll
                        for (int n = 0; n < 2; ++n) { const unsigned a = gq[bj * 2 + n], b = gn[bj * 2 + n];
                            const f32x4 r = (f32x4){(float)(a & 255u) * __builtin_amdgcn_rcpf((float)(b & 255u)), (float)((a >> 8) & 255u) * __builtin_amdgcn_rcpf((float)((b >> 8) & 255u)),
                                                    (float)((a >> 16) & 255u) * __builtin_amdgcn_rcpf((float)((b >> 16) & 255u)), (float)(a >> 24) * __builtin_amdgcn_rcpf((float)(b >> 24))};
                            acc[ai][bj][m][n] = acc[ai][bj][m][n] * r; } }
                else { bf16_t* rowp = mg + (size_t)(row0 + ai * HALF + m * 16) * 1024 + col0;
#pragma unroll
                    for (int bj = 0; bj < 2; ++bj) { f32x4 t[2];
#pragma unroll
                        for (int n = 0; n < 2; ++n) { const unsigned a = gq[bj * 2 + n];
                            t[n] = acc[ai][bj][m][n] * ((f32x4){(float)(a & 255u), (float)((a >> 8) & 255u), (float)((a >> 16) & 255u), (float)(a >> 24)} * (1.0f / 255.0f)); }
                        u32x4 o; o.x = cvt_pk_bf16(t[0][0], t[0][1]); o.y = cvt_pk_bf16(t[0][2], t[0][3]); o.z = cvt_pk_bf16(t[1][0], t[1][1]); o.w = cvt_pk_bf16(t[1][2], t[1][3]);
                        *(u32x4*)(rowp + bj * HALF) = o; } } }
    }
};
struct EpiOut {
    static constexpr bool PERM2 = false; static constexpr bool PERM = true, KEEP = false, BIAS_DMA = false; static constexpr int NS = 16;
    const float* X; const bf16_t* XBr; bf16_t* P;
    __device__ __forceinline__ void operator()(f32x4 (&acc)[2][2][4][2], const Unit& u, int wr, int wc, int fr, int fq) const {
        const int row0 = u.pm * BM + wr * 64 + fr, col0 = u.pn * BM + wc * 32 + 8 * fq;
        const float* const Xf = X; const bf16_t* const Xh = XBr; bf16_t* const Pp = P;
#pragma unroll
        for (int ai = 0; ai < 2; ++ai)
#pragma unroll
            for (int m = 0; m < 4; ++m) { const size_t ro = (size_t)(row0 + ai * HALF + m * 16) * 1024 + col0;
#pragma unroll
                for (int bj = 0; bj < 2; ++bj) { f32x4 x0, x1;
                    if (Xf) { x0 = *(const f32x4*)(Xf + ro + bj * HALF); x1 = *(const f32x4*)(Xf + ro + bj * HALF + 4); }
                    else { const u32x4 xw = *(const u32x4*)(Xh + ro + bj * HALF); x0 = (f32x4){bflo(xw.x), bfhi(xw.x), bflo(xw.y), bfhi(xw.y)}; x1 = (f32x4){bflo(xw.z), bfhi(xw.z), bflo(xw.w), bfhi(xw.w)}; }
                    const f32x4 p0 = x0 * DN_ALPHA + acc[ai][bj][m][0], p1 = x1 * DN_ALPHA + acc[ai][bj][m][1];
                    u32x4 o; o.x = cvt_pk_bf16(p0[0], p0[1]); o.y = cvt_pk_bf16(p0[2], p0[3]); o.z = cvt_pk_bf16(p1[0], p1[1]); o.w = cvt_pk_bf16(p1[2], p1[3]);
                    *(u32x4*)(Pp + ro + bj * HALF) = o; } }
    }
};
struct EpiSwiglu {
    static constexpr bool PERM2 = false; static constexpr bool PERM = true, KEEP = false, BIAS_DMA = true; static constexpr int NS = 8;
    unsigned char* HH; const float* bgate; const float* bup; float ascale; PG8_LAS unsigned char* ldsb;
    __device__ __forceinline__ void bias_dma(const Unit& u, int s, int lane, PG8_LAS unsigned char* lds) const {
        const unsigned dst = (unsigned)__builtin_amdgcn_readfirstlane((int)(unsigned)(size_t)(lds + L_BIAS_OFF + s * 1024)); const int o = u.aux * 1024 + u.pn * HALF;
        if (lane < 32) glds16_s(bgate + o, (unsigned)lane * 16u, dst); else glds16_s(bup + o, (unsigned)(lane - 32) * 16u, dst); }
    __device__ __forceinline__ void operator()(f32x4 (&acc)[2][2][4][2], const Unit& u, int wr, int wc, int fr, int fq) const {
        const int row0 = u.pm * BM + wr * 64 + fr, j0 = u.pn * HALF + wc * 32 + 8 * fq, e = u.aux;
        f32x4 bg[2], bu4[2];
#pragma unroll
        for (int n = 0; n < 2; ++n) { const PG8_LAS float* bl = (const PG8_LAS float*)(ldsb + L_BIAS_OFF + u.bs * 1024) + wc * 32 + 8 * fq + 4 * n; bg[n] = *(const PG8_LAS f32x4*)bl; bu4[n] = *(const PG8_LAS f32x4*)(bl + HALF) * 4.0f + 4.0f; }
        const float as4 = ascale * 4.0f;
#pragma unroll
        for (int ai = 0; ai < 2; ++ai)
#pragma unroll
            for (int m = 0; m < 4; ++m) { unsigned char* rowp = HH + (size_t)u.pm * (256 * 1024) + (size_t)(u.pn * 4 + wc) * 8192 + (wr * 64 + fr + ai * HALF + m * 16) * 32 + 8 * fq;
                f32x4 o[2];
#pragma unroll
                for (int n = 0; n < 2; ++n) { const f32x4 g = acc[ai][0][m][n] * ascale + bg[n], u4 = acc[ai][1][m][n] * as4 + bu4[n];
#pragma unroll
                    for (int q = 0; q < 4; ++q) { const float hg = fminf(g[q], 7.0f), hu4 = __builtin_amdgcn_fmed3f(u4[q], -24.0f, 32.0f);
                        o[n][q] = hg * __builtin_amdgcn_rcpf(1.0f + __builtin_amdgcn_exp2f((-1.702f * 1.4426950408889634f) * hg)) * hu4; } }
                v2u w; w.x = pk4_fp8_nc(o[0][0], o[0][1], o[0][2], o[0][3]); w.y = pk4_fp8_nc(o[1][0], o[1][1], o[1][2], o[1][3]);
                *(v2u*)rowp = w; }
    }
};
struct EpiDown {
    static constexpr bool PERM2 = true; static constexpr bool PERM = true, KEEP = false, BIAS_DMA = true; static constexpr int NS = 8;
    unsigned char* YS; const float* bd; float ascale; PG8_LAS unsigned char* ldsb;
    __device__ __forceinline__ void bias_dma(const Unit& u, int s, int lane, PG8_LAS unsigned char* lds) const {
        glds16_s(bd + u.aux * 1024 + u.pn * BM, (unsigned)lane * 16u, (unsigned)__builtin_amdgcn_readfirstlane((int)(unsigned)(size_t)(lds + L_BIAS_OFF + s * 1024))); }
    __device__ __forceinline__ void operator()(f32x4 (&acc)[2][2][4][2], const Unit& u, int wr, int wc, int fr, int fq) const {
        const int row0 = u.pm * BM + wr * 64 + fr, cl = wc * 64 + 16 * fq;
        f32x4 bv[2][2];
#pragma unroll
        for (int bj = 0; bj < 2; ++bj)
#pragma unroll
            for (int n = 0; n < 2; ++n) bv[bj][n] = *(const PG8_LAS f32x4*)((const PG8_LAS float*)(ldsb + L_BIAS_OFF + u.bs * 1024) + cl + 8 * bj + 4 * n) * 16.0f;
        const float as16 = ascale * 16.0f;
#pragma unroll
        for (int ai = 0; ai < 2; ++ai)
#pragma unroll
            for (int m = 0; m < 4; ++m) { u32x4 w;
#pragma unroll
                for (int bj = 0; bj < 2; ++bj)
#pragma unroll
                    for (int n = 0; n < 2; ++n) { f32x4 v = acc[ai][bj][m][n] * as16 + bv[bj][n];
#pragma unroll
                        for (int q = 0; q < 4; ++q) v[q] = __builtin_amdgcn_fmed3f(v[q], -448.0f, 448.0f);
                        w[bj * 2 + n] = pk4_fp8_nc(v[0], v[1], v[2], v[3]); }
                *(u32x4*)(YS + (size_t)(row0 + ai * HALF + m * 16) * 1024 + u.pn * BM + cl) = w; }
    }
};
}

#define XB_TMO      128
#define XB_XCNT(j)  (256  + 64 * (j))
#define XB_XSUB(j)  (1280 + 64 * (j))
#define XB_XGEN(j)  (2304 + 64 * (j))
#define XB_TOP      3328
#define XB_TOPGEN   3392
#define XCD_BAR_WORDS 3456
#define XB_SPIN_CAP (1u << 18)

__device__ __forceinline__ unsigned xb_ld(unsigned* p)              { return __hip_atomic_load(p, __ATOMIC_RELAXED, __HIP_MEMORY_SCOPE_AGENT); }
__device__ __forceinline__ unsigned xb_add(unsigned* p, unsigned v) { return __hip_atomic_fetch_add(p, v, __ATOMIC_RELAXED, __HIP_MEMORY_SCOPE_AGENT); }
__device__ __forceinline__ unsigned xb_xcc_id() { return (unsigned)__builtin_amdgcn_s_getreg((3 << 11) | 20) & 0xFu; }
#define XB_SPIN(cond, bar) do { unsigned _sp = 0; while (cond) { __builtin_amdgcn_s_sleep(1); \
    if ((++_sp & 255u) == 0u) { if (xb_ld(&(bar)[XB_TMO])) break; if (_sp > XB_SPIN_CAP) { atomicAdd(&(bar)[XB_TMO], 1u); break; } } } } while (0)

struct XcdBarrier { unsigned* bar; unsigned x; volatile LAS unsigned* st; };

__device__ __forceinline__ XcdBarrier xcd_barrier_post(unsigned* bar, volatile LAS unsigned* st) {
    XcdBarrier b; b.bar = bar; b.x = xb_xcc_id(); b.st = st;
    if (threadIdx.x == 0) (void)xb_add(&bar[XB_XCNT(b.x)], 1u);
    return b;
}
__device__ __forceinline__ void xcd_barrier_complete(unsigned* bar, unsigned x, unsigned& nloc, unsigned& nx) {
    const unsigned G = gridDim.x * gridDim.y * gridDim.z;
    unsigned sum, cnt, mine, sp = 0u;
    for (;;) {
        sum = 0u; cnt = 0u; mine = 0u;
#pragma unroll
        for (unsigned j = 0; j < 16; ++j) { const unsigned c = xb_ld(&bar[XB_XCNT(j)]); sum += c; cnt += (c > 0u) ? 1u : 0u; mine = (j == x) ? c : mine; }
        if (sum == G) break;
        __builtin_amdgcn_s_sleep(1);
        if ((++sp & 255u) == 0u) { if (xb_ld(&bar[XB_TMO])) break; if (sp > XB_SPIN_CAP) { atomicAdd(&bar[XB_TMO], 1u); break; } }
    }
    nloc = mine > 0u ? mine : 1u; nx = cnt > 0u ? cnt : 1u;
}
__device__ __forceinline__ void xcd_barrier(const XcdBarrier& b) {
    asm volatile("s_waitcnt vmcnt(0)" ::: "memory");
    __syncthreads();
    if (threadIdx.x == 0) {
        unsigned* bar = b.bar;
        __builtin_amdgcn_s_waitcnt(0);
        unsigned nloc = b.st[0], nx = b.st[1];
        if (nloc == 0u) { xcd_barrier_complete(bar, b.x, nloc, nx); b.st[0] = nloc; b.st[1] = nx; }
        const unsigned old = xb_add(&bar[XB_XSUB(b.x)], 1u);
        const unsigned gen = old / nloc;
        if (old + 1u == (gen + 1u) * nloc) {
            __builtin_amdgcn_fence(__ATOMIC_RELEASE, "agent");
            asm volatile("s_waitcnt vmcnt(0)" ::: "memory");
            const unsigned og = xb_add(&bar[XB_TOP], 1u);
            const unsigned tg = og / nx;
            if (og + 1u == (tg + 1u) * nx) xb_add(&bar[XB_TOPGEN], 1u);
            else XB_SPIN(xb_ld(&bar[XB_TOPGEN]) == tg, bar);
            __builtin_amdgcn_fence(__ATOMIC_ACQUIRE, "agent");
            xb_add(&bar[XB_XGEN(b.x)], 1u);
            asm volatile("s_waitcnt vmcnt(0)" ::: "memory");
        } else {
            XB_SPIN(xb_ld(&bar[XB_XGEN(b.x)]) == gen, bar);
            __builtin_amdgcn_fence(__ATOMIC_ACQUIRE, "agent");
            asm volatile("s_waitcnt vmcnt(0)" ::: "memory");
        }
    }
    __syncthreads();
}

struct Frame {
    LAS unsigned char* lds;
    unsigned* ctl;
    unsigned char* ws;
    int tid, lane, wave, G, bid, wv;
};

__host__ __device__ __forceinline__ int inproj_phys(int nl) {
    if (nl < 768) return nl;
    if (nl < 1536) { const int x = nl - 768, slot = x >> 6, d = x & 63; return 768 + (slot >> 2) * 256 + (d >> 5) * 128 + (slot & 3) * 32 + (d & 31); }
    if (nl < 1920) return 2304 + (nl - 1536);
    if (nl < 2688) { const int x = nl - 1920, slot = x / 48, d = x - slot * 48, hf = d >= 24 ? 1 : 0, p = slot * 24 + d - 24 * hf; return 1536 + (p >> 7) * 256 + hf * 128 + (p & 127); }
    if (nl < 3072) return 2304 + 384 + (nl - 2688);
    return nl;
}
template <class RowMap>
__device__ __forceinline__ void transpose_item(const float* W, int N, bf16* dst, int ldd, int k0, int n0, const RowMap rowmap, LAS float* scr, int lane) {
#pragma unroll 8
    for (int i = 0; i < 32; ++i) { const int kk = 2 * i + (lane >> 5); scr[kk * 33 + (lane & 31)] = W[(size_t)(k0 + kk) * N + n0 + (lane & 31)]; }
    LDS_WAIT(); asm volatile("" ::: "memory");
    const int c = lane & 7;
#pragma unroll
    for (int j = 0; j < 4; ++j) { const int n = (lane >> 3) + 8 * j; const LAS float* sp = scr + (8 * c) * 33 + n;
        v4u o; o.x = pk2(sp[0 * 33], sp[1 * 33]); o.y = pk2(sp[2 * 33], sp[3 * 33]); o.z = pk2(sp[4 * 33], sp[5 * 33]); o.w = pk2(sp[6 * 33], sp[7 * 33]);
        *(v4u*)(dst + (size_t)rowmap(n0 + n) * ldd + k0 + 8 * c) = o; }
    LDS_WAIT(); asm volatile("" ::: "memory");
}

template <class RowMap>
__device__ __forceinline__ void transpose_item_fp8(const float* W, int N, unsigned char* dst, int ldd, int k0, int n0, const RowMap rowmap, LAS float* scr, int lane, float qs) {
#pragma unroll 8
    for (int i = 0; i < 32; ++i) { const int kk = 2 * i + (lane >> 5); scr[kk * 33 + (lane & 31)] = W[(size_t)(k0 + kk) * N + n0 + (lane & 31)]; }
    LDS_WAIT(); asm volatile("" ::: "memory");
    const int c = lane & 7;
#pragma unroll
    for (int j = 0; j < 4; ++j) { const int n = (lane >> 3) + 8 * j; const LAS float* sp = scr + (8 * c) * 33 + n;
        v2u o; o.x = pk4_fp8(sp[0 * 33], sp[1 * 33], sp[2 * 33], sp[3 * 33], qs); o.y = pk4_fp8(sp[4 * 33], sp[5 * 33], sp[6 * 33], sp[7 * 33], qs);
        *(v2u*)(dst + (size_t)rowmap(n0 + n) * ldd + k0 + 8 * c) = o; }
    LDS_WAIT(); asm volatile("" ::: "memory");
}

struct Args { const float* in[22]; float* out; unsigned char* ws; int ph_lo, ph_hi; float lam_init[4]; };

__device__ __forceinline__ void p_prologue(Frame& F, const Args& a) {
    LAS float* scr = (LAS float*)(F.lds + F.wave * 16384);
    const int gw = F.bid * 8 + F.wave, NGW = F.G * 8;
    constexpr int PER_LAYER = 3072 + 128 + 64 + 192 + 512 + 32 * 1536;
    for (int it = gw; it < DEPTH * PER_LAYER; it += NGW) {
        const int l = it / PER_LAYER; int r = it - l * PER_LAYER;
        if (r < 3072) { const int kb = r / 192, nb = r % 192;
            if (nb < 96) transpose_item(a.in[1] + (size_t)l * 1024 * INC, INC, (bf16*)(F.ws + WS_WIN) + (size_t)l * INC * 1024, 1024, kb * 64, nb * 32, [](int n) { return inproj_phys(n); }, scr, F.lane);
            else transpose_item_fp8(a.in[1] + (size_t)l * 1024 * INC, INC, (unsigned char*)(F.ws + WS_WIN8) + (size_t)l * 3072 * 1024, 1024, kb * 64, nb * 32, [](int n) { return n - 3072; }, scr, F.lane, 32.f);
            continue; }
        r -= 3072;
        if (r < 128) { const int kb = r / 32, nb = r % 32;
            transpose_item(a.in[3] + (size_t)l * 256 * 1024, 1024, (bf16*)(F.ws + WS_WPROJ) + (size_t)l * 1024 * WPK + 0, WPK, kb * 64, nb * 32, [](int n) { return n; }, scr, F.lane); continue; }
        r -= 128;
        if (r < 64) { const int kb = r / 32, nb = r % 32;
            transpose_item(a.in[4] + (size_t)l * 128 * 1024, 1024, (bf16*)(F.ws + WS_WPROJ) + (size_t)l * 1024 * WPK + 256, WPK, kb * 64, nb * 32, [](int n) { return n; }, scr, F.lane); continue; }
        r -= 64;
        if (r < 192) { const int kb = r / 32, nb = r % 32;
            transpose_item(a.in[5] + (size_t)l * 384 * 1024, 1024, (bf16*)(F.ws + WS_WPROJ) + (size_t)l * 1024 * WPK + 512, WPK, kb * 64, nb * 32, [](int n) { return n; }, scr, F.lane); continue; }
        r -= 192;
        if (r < 512) { const int kb = r / 32, nb = r % 32;
            transpose_item(a.in[6] + (size_t)l * 1024 * 1024, 1024, (bf16*)(F.ws + WS_WOUT) + (size_t)l * 1024 * 1024, 1024, kb * 64, nb * 32, [](int n) { return n; }, scr, F.lane); continue; }
        r -= 512;
        { const int e = r / 1536, r2 = r % 1536, mtx = r2 / 512, r3 = r2 % 512, kb = r3 / 32, nb = r3 % 32;
          const size_t eoff = ((size_t)l * NEXP + e) * 1024 * 1024;
          if (mtx == 0) transpose_item_fp8(a.in[14] + eoff, 1024, (unsigned char*)(F.ws + WS_WGU) + 2 * eoff, 1024, kb * 64, nb * 32, [](int n) { return (n >> 7) * 256 + (n & 127); }, scr, F.lane, 32.f);
          else if (mtx == 1) transpose_item_fp8(a.in[16] + eoff, 1024, (unsigned char*)(F.ws + WS_WGU) + 2 * eoff, 1024, kb * 64, nb * 32, [](int n) { return (n >> 7) * 256 + 128 + (n & 127); }, scr, F.lane, 32.f);
          else transpose_item_fp8(a.in[18] + eoff, 1024, (unsigned char*)(F.ws + WS_WDN) + eoff, 1024, kb * 64, nb * 32, [](int n) { return n; }, scr, F.lane, 64.f); }
    }
    { const int gt = F.bid * 512 + F.tid, NT = F.G * 512;
      for (int i = gt; i < DEPTH * 1024 * 16; i += NT) { const int row = i >> 4, ch = i & 15;
          *(v4u*)((bf16*)(F.ws + WS_WPROJ) + (size_t)row * WPK + 384 + ch * 8) = (v4u){0u, 0u, 0u, 0u}; }
      for (int i = gt; i < SEQ * 32; i += NT) { const int pos = i >> 5, j = i & 31;
          const float inv = 1.0f / powf(10000.0f, (float)(2 * j) / 64.0f); const float ang = (float)pos * inv; float s, c; sincosf(ang, &s, &c);
          ((f32x2*)(F.ws + WS_ROPE64))[i] = (f32x2){c, s}; }
      for (int i = gt; i < SEQ * 24; i += NT) { const int pos = i / 24, j = i - pos * 24;
          const float inv = 1.0f / powf(10000.0f, (float)(2 * j) / 48.0f); const float ang = (float)pos * inv; float s, c; sincosf(ang, &s, &c);
          ((f32x2*)(F.ws + WS_ROPE48))[i] = (f32x2){c, s}; }
      for (int i = gt; i < DEPTH * 32 * 1024; i += NT) { const int l = i >> 15, e = (i >> 10) & 31, k = i & 1023;
          const float wv = a.in[12][((size_t)l * 1024 + k) * 32 + e] * a.in[10][l * 1024 + k]; const unsigned hi = f2bf(wv); const unsigned lo = f2bf(wv - __uint_as_float(hi << 16));
          bf16* wt = (bf16*)(F.ws + WS_WRT) + (size_t)l * WRT_LAYER; wt[e * 1024 + k] = (bf16)hi; wt[32 * 1024 + e * 1024 + k] = (bf16)lo; }
      { const int gwv = F.bid * 8 + F.wave;
        if (gwv < DEPTH * 32) { const int l = gwv >> 5, e = gwv & 31; float su = 0.f, sv = 0.f;
            for (int j = 0; j < 16; ++j) { const int k = F.lane + 64 * j; const float w0 = a.in[12][((size_t)l * 1024 + k) * 32 + e], wv = w0 * a.in[10][l * 1024 + k];
                const unsigned hi = f2bf(wv); const unsigned lo = f2bf(wv - __uint_as_float(hi << 16));
                su += __uint_as_float(hi << 16) + __uint_as_float(lo << 16); sv += a.in[11][l * 1024 + k] * w0; }
            su = wave_sum(su, F.lane); sv = wave_sum(sv, F.lane);
            if (F.lane == 0) { float* ru = (float*)((bf16*)(F.ws + WS_WRT) + (size_t)l * WRT_LAYER + 2 * 32 * 1024); ru[e] = su; ru[32 + e] = sv + a.in[13][gwv]; } } }
      const f32x4* x4 = (const f32x4*)a.in[0]; v2u* xb = (v2u*)(F.ws + WS_XB);
      unsigned* xb8 = (unsigned*)(F.ws + WS_XB8);
      for (int i = gt; i < NTOK * 256; i += NT) { const f32x4 v = x4[i]; xb[i] = (v2u){pk2(v[0], v[1]), pk2(v[2], v[3])}; xb8[i] = pk4_fp8(v[0], v[1], v[2], v[3], 1.0f); }
    }
}

typedef float f32x16 __attribute__((ext_vector_type(16)));
typedef short s16x4 __attribute__((ext_vector_type(4)));
typedef float f32x2_t __attribute__((ext_vector_type(2)));
typedef __bf16 bf16x2_t __attribute__((ext_vector_type(2)));
__device__ __forceinline__ unsigned cvtpk(float lo, float hi) { const f32x2_t v = {lo, hi}; const bf16x2_t b = __builtin_convertvector(v, bf16x2_t); return __builtin_bit_cast(unsigned, b); }
__device__ __forceinline__ int kperm(int r) { return (r & ~12) | ((r & 4) << 1) | ((r & 8) >> 1); }
__device__ __forceinline__ s16x4 ds_tr16(const LAS unsigned char* p) { return __builtin_bit_cast(s16x4, __builtin_amdgcn_ds_read_tr16_b64_v4i16((LAS s16x4*)p)); }

__device__ __forceinline__ float fmax_nc(float a, float b) { return __builtin_amdgcn_fmed3f(a, b, __builtin_inff()); }
__device__ __forceinline__ void glds16(const void* gsrc, unsigned lds_dst) { unsigned keep;
    asm volatile("s_mov_b32 %0, m0\n\ts_mov_b32 m0, %2\n\ts_nop 0\n\tglobal_load_lds_dwordx4 %1, off\n\ts_mov_b32 m0, %0" : "=&s"(keep) : "v"(gsrc), "s"(lds_dst) : "memory"); }
__device__ __forceinline__ void attnC_pipe(Frame& F, const float* lamv, const float* ng, float lam_init) {
    const bf16* H = (const bf16*)(F.ws + WS_H); bf16* Y = (bf16*)(F.ws + WS_Y);
    const int lane = F.lane, w = F.wave, n = lane & 31, hh = lane >> 5;
    float l01 = 0.f, l23 = 0.f;
    if (lane < 48) { l01 = lamv[lane] * lamv[48 + lane]; l23 = lamv[96 + lane] * lamv[144 + lane]; }
    l01 = wave_sum(l01, lane); l23 = wave_sum(l23, lane);
    const float lam = expf(l01) - expf(l23) + lam_init;
    const float post = 1.0f - lam_init;
    constexpr int KST = 192, VST = 192, KBYTES = 64 * KST, STAGE = KBYTES + 64 * VST, NT = SEQ / 64;
    constexpr float CS = 0.14433756729740643f * 1.4426950408889634f;
    constexpr float PMAX = 256.0f;
    unsigned goff[3], loff[3];
#pragma unroll
    for (int j = 0; j < 3; ++j) { const int I = w + 8 * j;
        if (I < 12) { const int cid = I * 64 + lane, row = cid / 12, cl = cid - row * 12, col = (cl & ~3) | ((cl & 3) ^ ((row >> 2) & 3));
            goff[j] = (unsigned)(row * INC + C_KC + col * 8) * 2u; loff[j] = (unsigned)(I * 1024); }
        else { const int cid = (I - 12) * 64 + lane, row = cid / 12, col = cid - row * 12;
            goff[j] = (unsigned)(row * INC + C_VC + col * 8) * 2u; loff[j] = (unsigned)(KBYTES + (I - 12) * 1024); } }
    const int krow_ = kperm(n), kg_ = (krow_ >> 2) & 3;
    const int koffA = krow_ * KST + ((hh ^ kg_) * 16), koffB = krow_ * KST + (((hh + 2) ^ kg_) * 16);
#define C_KOFF(t) ((((t) & 1) ? koffB : koffA) + ((t) >> 1) * 64)
    const int g = lane >> 4, i16 = lane & 15;
    const int voff = KBYTES + (8 * (g >> 1) + (i16 >> 2)) * VST + (16 * (g & 1) + 4 * (i16 & 3)) * 2;
#define C_ISSUE(tt) do { const char* gb_ = gbase + (size_t)(tt) * (64 * INC * 2); const int so_ = ((tt) & 3) * STAGE; _Pragma("unroll") for (int j_ = 0; j_ < 3; ++j_) \
        glds16(gb_ + goff[j_], (unsigned)__builtin_amdgcn_readfirstlane((int)(unsigned)(size_t)(F.lds + so_ + loff[j_]))); } while (0)
#define C_RDV(slotV, kbV, s2v) do { _Pragma("unroll") for (int d_ = 0; d_ < 3; ++d_) { const LAS unsigned char* vp_ = (slotV) + voff + ((kbV) * 32 + 16 * (s2v)) * VST + d_ * 64; \
            const s16x4 v0_ = ds_tr16(vp_), v1_ = ds_tr16(vp_ + 4 * VST); vf[d_] = (bf16x8){v0_[0], v0_[1], v0_[2], v0_[3], v1_[0], v1_[1], v1_[2], v1_[3]}; } } while (0)
#define C_FENCE __builtin_amdgcn_sched_barrier(0)
#define C_QK0(dst, slotbase) do { { const bf16x8 kf_ = *(const LAS bf16x8*)((slotbase) + C_KOFF(0)); dst = __builtin_amdgcn_mfma_f32_32x32x16_bf16(kf_, qf[0][0], NEGR[0], 0, 0, 0); } \
        _Pragma("unroll") for (int s_ = 1; s_ < 3; ++s_) { const bf16x8 kf_ = *(const LAS bf16x8*)((slotbase) + C_KOFF(s_)); dst = __builtin_amdgcn_mfma_f32_32x32x16_bf16(kf_, qf[0][s_], dst, 0, 0, 0); } } while (0)
#define C_ITEM(Sx, c, pout, pin, cp, slotVp, kbVp, slotKc, kbKc, slotKn, kbKn, cn) do { \
        _Pragma("unroll") for (int s2_ = 0; s2_ < 2; ++s2_) _Pragma("unroll") for (int d_ = 0; d_ < 3; ++d_) { const LAS unsigned char* vp_ = (slotVp) + voff + ((kbVp) * 32 + 16 * s2_) * VST + d_ * 64; \
            const s16x4 v0_ = ds_tr16(vp_), v1_ = ds_tr16(vp_ + 4 * VST); vf[s2_ * 3 + d_] = (bf16x8){v0_[0], v0_[1], v0_[2], v0_[3], v1_[0], v1_[1], v1_[2], v1_[3]}; } \
        _Pragma("unroll") for (int s_ = 0; s_ < 3; ++s_) kf[s_] = *(const LAS bf16x8*)((slotKn) + (kbKn) * 32 * KST + C_KOFF((cn) * 3 + s_)); \
        C_FENCE; __builtin_amdgcn_s_setprio(1); \
        const float lold_ = l[c]; \
        _Pragma("unroll") for (int r_ = 0; r_ < 16; ++r_) Sx[r_] = __builtin_amdgcn_exp2f(Sx[r_]); \
        float pm_ = fmaxf(fmaxf(Sx[0], Sx[1]), Sx[2]); _Pragma("unroll") for (int r_ = 3; r_ < 15; r_ += 2) pm_ = fmaxf(fmaxf(pm_, Sx[r_]), Sx[r_ + 1]); pm_ = fmaxf(pm_, Sx[15]); \
        _Pragma("unroll") for (int r_ = 0; r_ < 16; ++r_) l[c] += Sx[r_]; \
        _Pragma("unroll") for (int s2_ = 0; s2_ < 2; ++s2_) { v4u pw_; pw_.x = cvtpk(Sx[8 * s2_ + 0], Sx[8 * s2_ + 1]); pw_.y = cvtpk(Sx[8 * s2_ + 2], Sx[8 * s2_ + 3]); \
            pw_.z = cvtpk(Sx[8 * s2_ + 4], Sx[8 * s2_ + 5]); pw_.w = cvtpk(Sx[8 * s2_ + 6], Sx[8 * s2_ + 7]); pout[s2_] = __builtin_bit_cast(bf16x8, pw_); } \
        _Pragma("unroll") for (int s2_ = 0; s2_ < 2; ++s2_) _Pragma("unroll") for (int d_ = 0; d_ < 3; ++d_) O[cp][d_] = __builtin_amdgcn_mfma_f32_32x32x16_bf16(vf[s2_ * 3 + d_], pin[s2_], O[cp][d_], 0, 0, 0); \
        _Pragma("unroll") for (int g_ = 0; g_ < 6; ++g_) { __builtin_amdgcn_sched_group_barrier(0x008, 1, 0); __builtin_amdgcn_sched_group_barrier(0x400, 3, 0); __builtin_amdgcn_sched_group_barrier(0x002, 7, 0); } \
        C_FENCE; \
        Sx = __builtin_amdgcn_mfma_f32_32x32x16_bf16(kf[0], qf[cn][0], NEGR[cn], 0, 0, 0); Sx = __builtin_amdgcn_mfma_f32_32x32x16_bf16(kf[1], qf[cn][1], Sx, 0, 0, 0); Sx = __builtin_amdgcn_mfma_f32_32x32x16_bf16(kf[2], qf[cn][2], Sx, 0, 0, 0); \
        __builtin_amdgcn_s_setprio(0); C_FENCE; \
        if (__any(pm_ > PMAX) || first) { f32x16 Sr_; pm_ = fmaxf(pm_, shx(pm_, 32, lane));     \
            { const bf16x8 k0_ = *(const LAS bf16x8*)((slotKc) + (kbKc) * 32 * KST + C_KOFF((c) * 3 + 0)), k1_ = *(const LAS bf16x8*)((slotKc) + (kbKc) * 32 * KST + C_KOFF((c) * 3 + 1)), k2_ = *(const LAS bf16x8*)((slotKc) + (kbKc) * 32 * KST + C_KOFF((c) * 3 + 2)); \
              Sr_ = __builtin_amdgcn_mfma_f32_32x32x16_bf16(k0_, qf[c][0], NEGR[c], 0, 0, 0); Sr_ = __builtin_amdgcn_mfma_f32_32x32x16_bf16(k1_, qf[c][1], Sr_, 0, 0, 0); Sr_ = __builtin_amdgcn_mfma_f32_32x32x16_bf16(k2_, qf[c][2], Sr_, 0, 0, 0); } \
            float mx_ = fmax_nc(Sr_[0], Sr_[1]); _Pragma("unroll") for (int r_ = 2; r_ < 16; ++r_) mx_ = fmax_nc(mx_, Sr_[r_]); mx_ = fmaxf(mx_, shx(mx_, 32, lane)); \
            const float dl_ = (pm_ > PMAX || first) ? mx_ : 0.0f, al_ = __builtin_amdgcn_exp2f(-dl_); \
            _Pragma("unroll") for (int d_ = 0; d_ < 3; ++d_) _Pragma("unroll") for (int r_ = 0; r_ < 16; ++r_) O[c][d_][r_] *= al_; \
            float ls_ = lold_ * al_; \
            _Pragma("unroll") for (int r_ = 0; r_ < 16; ++r_) { NEGR[c][r_] -= dl_; Sr_[r_] = __builtin_amdgcn_exp2f(Sr_[r_] - dl_); ls_ += Sr_[r_]; } \
            l[c] = ls_; \
            _Pragma("unroll") for (int s2_ = 0; s2_ < 2; ++s2_) { v4u pw_; pw_.x = cvtpk(Sr_[8 * s2_ + 0], Sr_[8 * s2_ + 1]); pw_.y = cvtpk(Sr_[8 * s2_ + 2], Sr_[8 * s2_ + 3]); \
                pw_.z = cvtpk(Sr_[8 * s2_ + 4], Sr_[8 * s2_ + 5]); pw_.w = cvtpk(Sr_[8 * s2_ + 6], Sr_[8 * s2_ + 7]); pout[s2_] = __builtin_bit_cast(bf16x8, pw_); } } \
        C_FENCE; } while (0)
    for (int unit = F.bid; unit < 512; unit += F.G) {
        const int b = unit >> 6, h = (unit >> 4) & 3, qb = unit & 15;
        const int tok = b * SEQ + qb * 256 + w * 32 + n;
        const char* gbase = (const char*)(H + (size_t)(b * SEQ) * INC + h * 96);
        C_ISSUE(0); C_ISSUE(1);
        bf16x8 qf[2][3];
        { const bf16* qp = H + (size_t)tok * INC + C_QC + h * 96 + 8 * hh;
#pragma unroll
          for (int c = 0; c < 2; ++c)
#pragma unroll
              for (int s = 0; s < 3; ++s) { const v4u qw = *(const v4u*)(qp + c * 48 + 16 * s);
                  v4u qs; qs.x = cvtpk(bflo(qw.x) * CS, bfhi(qw.x) * CS); qs.y = cvtpk(bflo(qw.y) * CS, bfhi(qw.y) * CS); qs.z = cvtpk(bflo(qw.z) * CS, bfhi(qw.z) * CS); qs.w = cvtpk(bflo(qw.w) * CS, bfhi(qw.w) * CS);
                  qf[c][s] = __builtin_bit_cast(bf16x8, qs); } }
        f32x16 O[2][3];
#pragma unroll
        for (int c = 0; c < 2; ++c)
#pragma unroll
            for (int d = 0; d < 3; ++d)
#pragma unroll
                for (int r = 0; r < 16; ++r) O[c][d][r] = 0.f;
        float l[2] = {0.f, 0.f};
        f32x16 NEGR[2];
#pragma unroll
        for (int c = 0; c < 2; ++c)
#pragma unroll
            for (int r = 0; r < 16; ++r) NEGR[c][r] = 0.f;
        f32x16 S; bf16x8 pa[2], pb[2], kf[3], vf[6];
        pb[0] = (bf16x8){0, 0, 0, 0, 0, 0, 0, 0}; pb[1] = pb[0];
        for (int t = 0; t < NT; ++t) {
            asm volatile("s_waitcnt vmcnt(0)" ::: "memory"); __builtin_amdgcn_s_barrier(); asm volatile("" ::: "memory");
            if (t + 2 < NT) C_ISSUE(t + 2);
            const LAS unsigned char* cur = F.lds + (t & 3) * STAGE;
            const LAS unsigned char* prv = F.lds + ((t > 0 ? t - 1 : 0) & 3) * STAGE;
            const LAS unsigned char* nxt = F.lds + ((t + 1 < NT ? t + 1 : t) & 3) * STAGE;
            if (t == 0) C_QK0(S, cur);
            { const bool first = (t == 0);
            C_ITEM(S, 0, pa, pb, 1, prv, 1, cur, 0, cur, 0, 1);
            C_ITEM(S, 1, pb, pa, 0, cur, 0, cur, 0, cur, 1, 0); }
            { const bool first = false;
            C_ITEM(S, 0, pa, pb, 1, cur, 0, cur, 1, cur, 1, 1);
            C_ITEM(S, 1, pb, pa, 0, cur, 1, cur, 1, nxt, 0, 0); }
        }
        { const LAS unsigned char* lastb = F.lds + ((NT - 1) & 3) * STAGE;
#pragma unroll
          for (int s2 = 0; s2 < 2; ++s2)
#pragma unroll
              for (int d = 0; d < 3; ++d) { const LAS unsigned char* vp = lastb + voff + (32 + 16 * s2) * VST + d * 64; const s16x4 v0 = ds_tr16(vp), v1 = ds_tr16(vp + 4 * VST);
                  const bf16x8 vfl = (bf16x8){v0[0], v0[1], v0[2], v0[3], v1[0], v1[1], v1[2], v1[3]}; O[1][d] = __builtin_amdgcn_mfma_f32_32x32x16_bf16(vfl, pb[s2], O[1][d], 0, 0, 0); } }
        const float l0 = l[0] + shx(l[0], 32, lane), l1 = l[1] + shx(l[1], 32, lane);
        const float i0 = 1.0f / l0, i1 = lam / l1;
        float ss = 0.f;
#pragma unroll
        for (int d = 0; d < 3; ++d)
#pragma unroll
            for (int r = 0; r < 16; ++r) { const float o = O[0][d][r] * i0 - O[1][d][r] * i1; O[0][d][r] = o; ss += o * o; }
        ss += shx(ss, 32, lane);
        const float rs = rsqrtf(ss * (1.0f / 96.0f) + LN_EPS) * post;
        bf16* yp = Y + (size_t)tok * YLD + Y_C + h * 96 + 4 * hh;
#pragma unroll
        for (int d = 0; d < 3; ++d)
#pragma unroll
            for (int rg = 0; rg < 4; ++rg) { const f32x4 gv = *(const f32x4*)(ng + d * 32 + 8 * rg + 4 * hh);
                v2u o; o.x = pk2(O[0][d][4 * rg + 0] * rs * gv[0], O[0][d][4 * rg + 1] * rs * gv[1]); o.y = pk2(O[0][d][4 * rg + 2] * rs * gv[2], O[0][d][4 * rg + 3] * rs * gv[3]);
                *(v2u*)(yp + d * 32 + 8 * rg) = o; }
    }
    asm volatile("" ::: "memory"); __builtin_amdgcn_s_barrier(); asm volatile("" ::: "memory");
#undef C_ISSUE
#undef C_KOFF
#undef C_RDV
#undef C_ITEM
#undef C_QK0
#undef C_FENCE
}

constexpr int AB_VST = 192, AB_VREG = 32 * AB_VST;
constexpr int L_RPB = 51200;

__device__ __forceinline__ void sm_block64(f32x16& t, float& m, float& l, f32x16 (&O)[2], bf16x8 (&pf)[2], const int lane) {
    float mx = fmaxf(t[0], t[1]);
#pragma unroll
    for (int r = 2; r < 16; ++r) mx = fmaxf(mx, t[r]);
    if (__any(mx > m)) {
        mx = fmaxf(mx, shx(mx, 32, lane));
        const float mn = fmaxf(m, mx), alpha = __builtin_amdgcn_exp2f(m - mn);
#pragma unroll
        for (int d = 0; d < 2; ++d)
#pragma unroll
            for (int r = 0; r < 16; ++r) O[d][r] *= alpha;
        l *= alpha; m = mn;
    }
#pragma unroll
    for (int r = 0; r < 16; ++r) { t[r] = __builtin_amdgcn_exp2f(t[r] - m); l += t[r]; }
#pragma unroll
    for (int s2 = 0; s2 < 2; ++s2) { v4u pw; pw.x = cvtpk(t[8 * s2 + 0], t[8 * s2 + 1]); pw.y = cvtpk(t[8 * s2 + 2], t[8 * s2 + 3]);
        pw.z = cvtpk(t[8 * s2 + 4], t[8 * s2 + 5]); pw.w = cvtpk(t[8 * s2 + 6], t[8 * s2 + 7]); pf[s2] = __builtin_bit_cast(bf16x8, pw); }
}
template <class TokOf, class MaskT>
__device__ __forceinline__ void attn_run_blocks(const bf16* H, const int kcol, const int vcol, const int nb, const TokOf tok_of, const MaskT mask,
                                                const bf16x8 (&qf)[4], LAS unsigned char* vl, const int lane, f32x16 (&O)[2], float& m, float& l) {
    const int n = lane & 31, hh = lane >> 5, krow = kperm(n), g = lane >> 4, i16 = lane & 15;
    const int vrd = (8 * (g >> 1) + (i16 >> 2)) * AB_VST + (16 * (g & 1) + 4 * (i16 & 3)) * 2;
    bf16x8 kf[4]; v4u vc[4];
    { const bf16* kp = H + (size_t)tok_of(0, krow) * INC + kcol + 8 * hh;
#pragma unroll
      for (int s = 0; s < 4; ++s) kf[s] = *(const bf16x8*)(kp + 16 * s);
#pragma unroll
      for (int i = 0; i < 4; ++i) vc[i] = *(const v4u*)(H + (size_t)tok_of(0, (lane >> 3) + 8 * i) * INC + vcol + (lane & 7) * 8); }
#pragma unroll
    for (int i = 0; i < 4; ++i) *(LAS v4u*)(vl + ((lane >> 3) + 8 * i) * AB_VST + (lane & 7) * 16) = vc[i];
    for (int j = 0; j < nb; ++j) {
        const int jn = (j + 1 < nb) ? j + 1 : j;
        bf16x8 kn[4];
        { const bf16* kp = H + (size_t)tok_of(jn, krow) * INC + kcol + 8 * hh;
#pragma unroll
          for (int s = 0; s < 4; ++s) kn[s] = *(const bf16x8*)(kp + 16 * s);
#pragma unroll
          for (int i = 0; i < 4; ++i) vc[i] = *(const v4u*)(H + (size_t)tok_of(jn, (lane >> 3) + 8 * i) * INC + vcol + (lane & 7) * 8); }
        f32x16 S;
#pragma unroll
        for (int r = 0; r < 16; ++r) S[r] = 0.f;
#pragma unroll
        for (int s = 0; s < 4; ++s) S = __builtin_amdgcn_mfma_f32_32x32x16_bf16(kf[s], qf[s], S, 0, 0, 0);
        mask(j, S);
        bf16x8 pf[2];
        sm_block64(S, m, l, O, pf, lane);
        LDS_WAIT();
#pragma unroll
        for (int s2 = 0; s2 < 2; ++s2)
#pragma unroll
            for (int d = 0; d < 2; ++d) { const LAS unsigned char* vp = vl + vrd + 16 * s2 * AB_VST + d * 64;
                const s16x4 v0 = ds_tr16(vp), v1 = ds_tr16(vp + 4 * AB_VST);
                const bf16x8 vf = (bf16x8){v0[0], v0[1], v0[2], v0[3], v1[0], v1[1], v1[2], v1[3]};
                O[d] = __builtin_amdgcn_mfma_f32_32x32x16_bf16(vf, pf[s2], O[d], 0, 0, 0); }
        LDS_WAIT(); asm volatile("" ::: "memory");
#pragma unroll
        for (int i = 0; i < 4; ++i) *(LAS v4u*)(vl + ((lane >> 3) + 8 * i) * AB_VST + (lane & 7) * 16) = vc[i];
#pragma unroll
        for (int s = 0; s < 4; ++s) kf[s] = kn[s];
    }
    LDS_WAIT(); asm volatile("" ::: "memory");
}
__device__ __forceinline__ void attn_store64(bf16* yrow, const f32x16 (&O)[2], float l, int hh, const int lane) {
    const float lt = l + shx(l, 32, lane), inv = 1.0f / lt;
#pragma unroll
    for (int d = 0; d < 2; ++d)
#pragma unroll
        for (int rg = 0; rg < 4; ++rg) { v2u o; o.x = pk2(O[d][4 * rg + 0] * inv, O[d][4 * rg + 1] * inv); o.y = pk2(O[d][4 * rg + 2] * inv, O[d][4 * rg + 3] * inv);
            *(v2u*)(yrow + d * 32 + 8 * rg + 4 * hh) = o; }
}

__device__ __forceinline__ void attnA_mfma(Frame& F, const float* rpb  ) {
    const bf16* H = (const bf16*)(F.ws + WS_H); bf16* Y = (bf16*)(F.ws + WS_Y);
    LAS float* T = (LAS float*)(F.lds + L_RPB);
    for (int i = F.tid; i < 4 * 17 * 64; i += 512) { const int h = i / (17 * 64), rem = i - h * 17 * 64, ro = rem >> 6, co = rem & 63;
        const int rr = ro - 1, cc = co - 16; T[i] = (rr >= 0 && rr < 15 && cc >= 0 && cc < 31) ? rpb[(h * 15 + rr) * 31 + cc] * 1.4426950408889634f : 0.f; }
    __syncthreads();
    const int lane = F.lane, n = lane & 31, hh = lane >> 5;
    LAS unsigned char* vl = F.lds + F.wave * AB_VREG;
    const int gw = F.bid * 8 + F.wave, NGW = F.G * 8;
    for (int item = gw; item < 4096; item += NGW) {
        const int cb = item & 3, rp = (item >> 2) & 31, h = (item >> 7) & 3, b = item >> 9;
        const int r = 2 * rp + (n >> 4), c = 16 * cb + (n & 15);
        const int r0 = min(max(r - 4, 0), 56), c0 = min(max(c - 8, 0), 48);
        const int cw = min(max(16 * cb - 8, 0), 32);
        const int kr_lo = min(max(2 * rp - 4, 0), 56), kr_hi = min(max(2 * rp + 1 - 4, 0), 56) + 7;
        const int tokq = b * SEQ + r * 64 + c;
        bf16x8 qf[4];
        { const bf16* qp = H + (size_t)tokq * INC + C_QA + h * 64 + 8 * hh;
#pragma unroll
          for (int s = 0; s < 4; ++s) qf[s] = *(const bf16x8*)(qp + 16 * s); }
        f32x16 O[2];
#pragma unroll
        for (int d = 0; d < 2; ++d)
#pragma unroll
            for (int rr = 0; rr < 16; ++rr) O[d][rr] = 0.f;
        float m = -1e30f, l = 0.f;
        const int tok0 = b * SEQ + kr_lo * 64 + cw;
        auto tok_of = [=](int j, int kk) { return tok0 + j * 64 + kk; };
        const int colb = cw - c0 + 8 * hh;
        const int tb0 = (h * 17 + (kr_lo - r + 8)) * 64 + (cw - c + 31) + 8 * hh;
        const int rb = kr_lo - r0;
        auto mask = [=](int j, f32x16& S) {
            const bool rowok = (unsigned)(rb + j) < 8u; const LAS float* tp = T + tb0 + j * 64;
#pragma unroll
            for (int rr = 0; rr < 16; ++rr) { const int e = (rr & 7) + 16 * (rr >> 3);
                const bool ok = rowok && ((unsigned)(colb + e) < 16u);
                S[rr] = ok ? (S[rr] * (0.125f * 1.4426950408889634f) + tp[e]) : -INFINITY; }
        };
        attn_run_blocks(H, C_KA + h * 64, C_VA + h * 64, kr_hi - kr_lo + 1, tok_of, mask, qf, vl, lane, O, m, l);
        attn_store64(Y + (size_t)tokq * YLD + Y_A + h * 64, O, l, hh, lane);
    }
}
__device__ __forceinline__ void attnB_mfma(Frame& F) {
    const bf16* H = (const bf16*)(F.ws + WS_H); bf16* Y = (bf16*)(F.ws + WS_Y);
    const int lane = F.lane, n = lane & 31, hh = lane >> 5;
    LAS unsigned char* vl = F.lds + F.wave * AB_VREG;
    const int gw = F.bid * 8 + F.wave, NGW = F.G * 8;
    for (int item = gw; item < 2048; item += NGW) {
        const int mblk = item & 7, r = (item >> 3) & 15, hg = (item >> 7) & 1, b = item >> 8;
        const int sq = r + 16 * (mblk * 32 + n), tokq = b * SEQ + sq;
        f32x16 O[2];
#pragma unroll
        for (int d = 0; d < 2; ++d)
#pragma unroll
            for (int rr = 0; rr < 16; ++rr) O[d][rr] = 0.f;
        float m = -1e30f, l = 0.f;
#pragma unroll 1
        for (int g = 0; g < 3; ++g) {
            const int sh = 2 * g, dil = 1 << sh, head = 2 * g + hg, L = SEQ >> sh, a = 16 >> sh, cls = r & (dil - 1);
            const int pq0 = (r >> sh) + a * (mblk * 32), pq = pq0 + a * n;
            const int pks = pq0 - 64, nb = (31 * a + 129 + 31) >> 5;
            bf16x8 qf[4];
            { const bf16* qp = H + (size_t)tokq * INC + C_QB + head * 64 + 8 * hh;
#pragma unroll
              for (int s = 0; s < 4; ++s) { const v4u qw = *(const v4u*)(qp + 16 * s); constexpr float QS = 0.125f * 1.4426950408889634f;
                  v4u qs; qs.x = cvtpk(bflo(qw.x) * QS, bfhi(qw.x) * QS); qs.y = cvtpk(bflo(qw.y) * QS, bfhi(qw.y) * QS); qs.z = cvtpk(bflo(qw.z) * QS, bfhi(qw.z) * QS); qs.w = cvtpk(bflo(qw.w) * QS, bfhi(qw.w) * QS);
                  qf[s] = __builtin_bit_cast(bf16x8, qs); } }
            const int tokb = b * SEQ + cls;
            auto tok_of = [=](int j, int kk) { const int pk = min(max(pks + 32 * j + kk, 0), L - 1); return tokb + (pk << sh); };
            const int b1 = pks - pq + 64 + 8 * hh, b2 = pks + 8 * hh;
            int elo = max(-b1, -b2); int ew = min(128 - b1, L - 1 - b2) - elo; if (ew < 0) { elo = 1 << 29; ew = 0; }
            auto mask = [=](int j, f32x16& S) { const int base = 32 * j - elo;
#pragma unroll
                for (int rr = 0; rr < 16; ++rr) { const int ec = (rr & 7) + 16 * (rr >> 3);
                    S[rr] = ((unsigned)(base + ec) <= (unsigned)ew) ? S[rr] : -INFINITY; }
            };
            attn_run_blocks(H, C_KB + head * 64, C_VB + head * 64, nb, tok_of, mask, qf, vl, lane, O, m, l);
        }
        attn_store64(Y + (size_t)tokq * YLD + Y_B + hg * 64, O, l, hh, lane);
    }
}

__device__ __forceinline__ void p_ln_router(Frame& F, const Args& a, int layer, bool dry = false) {
    const bf16* PRE = (const bf16*)(F.ws + WS_HH); bf16* XB1 = (bf16*)(F.ws + (dry ? WS_H + 210 * MiB : WS_M)); unsigned* XB8 = dry ? (unsigned*)(F.ws + WS_H + 160 * MiB) : (unsigned*)(F.ws + WS_XB8);
    const float* g1 = a.in[10] + layer * 1024; const float* b1 = a.in[11] + layer * 1024;
    LAS float* stat = (LAS float*)(F.lds + 65536 + F.wave * 128);
    const bf16* WT = (const bf16*)(F.ws + WS_WRT) + (size_t)layer * WRT_LAYER;
    int* TOPE = (int*)(F.ws + (dry ? WS_H + 200 * MiB : WS_TOPE)); float* TOPW = (float*)(F.ws + (dry ? WS_H + 201 * MiB : WS_TOPW)); int* RANK = (int*)(F.ws + (dry ? WS_H + 202 * MiB : WS_RANK));
    const int cnt_off = dry ? CW_CUR : CW_CNT; int* SRCp = (int*)(F.ws + (dry ? WS_H + 204 * MiB : WS_SRC));
    LAS int* hist = (LAS int*)(F.lds + L_HIST); LAS int* base = (LAS int*)(F.lds + L_BASE);
    const int lane = F.lane;
    for (int chunk = F.bid; chunk < NTOK / 128; chunk += F.G) {
        if (F.tid < 32) hist[F.tid] = 0;
        __syncthreads();
        const int tok0 = chunk * 128 + F.wave * 16;
        {   f32x4 gv[4], bv[4];
#pragma unroll
            for (int j = 0; j < 4; ++j) { gv[j] = *(const f32x4*)(g1 + 4 * lane + 256 * j); bv[j] = *(const f32x4*)(b1 + 4 * lane + 256 * j); }
#pragma unroll 1
            for (int q = 0; q < 4; ++q) {
                f32x4 v[4][4]; float s[4], s2[4];
#pragma unroll
                for (int t = 0; t < 4; ++t) { const v2u* pr = (const v2u*)(PRE + (size_t)(tok0 + 4 * q + t) * 1024) + lane;
#pragma unroll
                    for (int j = 0; j < 4; ++j) { const v2u pw = pr[64 * j]; v[t][j] = (f32x4){bflo(pw.x), bfhi(pw.x), bflo(pw.y), bfhi(pw.y)}; } }
#pragma unroll
                for (int t = 0; t < 4; ++t) { s[t] = 0.f;
#pragma unroll
                    for (int j = 0; j < 4; ++j) s[t] += (v[t][j][0] + v[t][j][1]) + (v[t][j][2] + v[t][j][3]); }
#pragma unroll
                for (int o = 1; o < 64; o <<= 1) {
#pragma unroll
                    for (int t = 0; t < 4; ++t) s[t] += shx(s[t], o, lane); }
#pragma unroll
                for (int t = 0; t < 4; ++t) { const float mean = s[t] * (1.f / 1024.f); s2[t] = 0.f;
#pragma unroll
                    for (int j = 0; j < 4; ++j) { v[t][j] = v[t][j] - mean; s2[t] += (v[t][j][0] * v[t][j][0] + v[t][j][1] * v[t][j][1]) + (v[t][j][2] * v[t][j][2] + v[t][j][3] * v[t][j][3]); } }
#pragma unroll
                for (int o = 1; o < 64; o <<= 1) {
#pragma unroll
                    for (int t = 0; t < 4; ++t) s2[t] += shx(s2[t], o, lane); }
#pragma unroll
                for (int t = 0; t < 4; ++t) { const float rstd = rsqrtf(s2[t] * (1.f / 1024.f) + LN_EPS);
                    if (lane == 0) { stat[2 * (4 * q + t)] = s[t] * (1.f / 1024.f); stat[2 * (4 * q + t) + 1] = rstd; }
                    v2u* x1 = (v2u*)(XB1 + (size_t)(tok0 + 4 * q + t) * 1024) + lane; unsigned* xb = XB8 + (size_t)(tok0 + 4 * q + t) * 256 + lane;
#pragma unroll
                    for (int j = 0; j < 4; ++j) { const f32x4 y = v[t][j] * rstd * gv[j] + bv[j]; x1[64 * j] = (v2u){pk2(y[0], y[1]), pk2(y[2], y[3])}; xb[64 * j] = pk4_fp8(y[0], y[1], y[2], y[3], 1.0f); } }
            }
        }
        const int tk = lane & 15, kq = lane >> 4;
        f32x4 acc[2] = {(f32x4){0.f, 0.f, 0.f, 0.f}, (f32x4){0.f, 0.f, 0.f, 0.f}};
        {   const bf16* xp = PRE + (size_t)(tok0 + tk) * 1024 + 8 * kq;
            const bf16* w0 = WT + (size_t)tk * 1024 + 8 * kq;
#pragma unroll 4
            for (int st = 0; st < 32; ++st) {
                const bf16x8 xh = *(const bf16x8*)(xp + 32 * st);
#pragma unroll
                for (int mb = 0; mb < 2; ++mb) { const bf16x8 wh = *(const bf16x8*)(w0 + (size_t)mb * 16 * 1024 + 32 * st), wl = *(const bf16x8*)(w0 + (size_t)(32 + mb * 16) * 1024 + 32 * st);
                    acc[mb] = __builtin_amdgcn_mfma_f32_16x16x32_bf16(wh, xh, acc[mb], 0, 0, 0);
                    acc[mb] = __builtin_amdgcn_mfma_f32_16x16x32_bf16(wl, xh, acc[mb], 0, 0, 0); }
            }
        }
        LDS_WAIT();
        const float mu = stat[2 * tk], rsd = stat[2 * tk + 1];
        float v8[8];
#pragma unroll
        for (int mb = 0; mb < 2; ++mb)
#pragma unroll
            for (int i = 0; i < 4; ++i) { const float* ru = (const float*)(WT + 2 * 32 * 1024) + 16 * mb + 4 * kq + i; v8[mb * 4 + i] = rsd * (acc[mb][i] - mu * ru[0]) + ru[32]; }
        int se[4]; float sv[4];
#pragma unroll
        for (int r = 0; r < 4; ++r) {
            float bvv = v8[0]; int bi = 4 * kq;
#pragma unroll
            for (int sl = 1; sl < 8; ++sl) { const int eid = 16 * (sl >> 2) + 4 * kq + (sl & 3); if (v8[sl] > bvv) { bvv = v8[sl]; bi = eid; } }
#pragma unroll
            for (int o = 16; o < 64; o <<= 1) { const float ov = shx(bvv, o, lane); const int oi = shxi(bi, o, lane);
                if (ov > bvv || (ov == bvv && oi < bi)) { bvv = ov; bi = oi; } }
            se[r] = bi; sv[r] = bvv;
#pragma unroll
            for (int sl = 0; sl < 8; ++sl) { const int eid = 16 * (sl >> 2) + 4 * kq + (sl & 3); if (eid == bi) v8[sl] = -3.0e38f; }
        }
        const float p1 = __expf(sv[1] - sv[0]), p2 = __expf(sv[2] - sv[0]), p3 = __expf(sv[3] - sv[0]);
        const float inv = 1.0f / (1.0f + p1 + p2 + p3);
        int lr[4] = {0, 0, 0, 0};
        if (lane < 16) { const int tok = tok0 + tk;
            *(int4*)(TOPE + tok * 4) = make_int4(se[0], se[1], se[2], se[3]);
            *(f32x4*)(TOPW + tok * 4) = (f32x4){inv, p1 * inv, p2 * inv, p3 * inv};
#pragma unroll
            for (int k = 0; k < 4; ++k) lr[k] = __hip_atomic_fetch_add(&hist[se[k]], 1, __ATOMIC_RELAXED, __HIP_MEMORY_SCOPE_WORKGROUP); }
        __syncthreads();
        if (F.tid < 32) { const int c = hist[F.tid]; base[F.tid] = c ? (int)__hip_atomic_fetch_add(F.ctl + cnt_off + layer * 64 + F.tid, (unsigned)c, RLX_AGENT) : 0; }
        __syncthreads();
        if (lane < 16) { const int tok = tok0 + tk;
            const int r0 = base[se[0]] + lr[0], r1 = base[se[1]] + lr[1], r2 = base[se[2]] + lr[2], r3 = base[se[3]] + lr[3];
            *(int4*)(RANK + tok * 4) = make_int4(r0, r1, r2, r3);
            int* SRC = SRCp; SRC[se[0] * NTOK + r0] = tok; SRC[se[1] * NTOK + r1] = tok; SRC[se[2] * NTOK + r2] = tok; SRC[se[3] * NTOK + r3] = tok; }
        __syncthreads();
    }
}

__device__ __forceinline__ int moe_build(Frame& F, int layer) {
    LAS int* offT = (LAS int*)(F.lds + L_OFFT); LAS int* tile_e = (LAS int*)(F.lds + L_TILE);
    __syncthreads();
    if (F.tid < 64) {
        const int c = (F.lane < 32) ? (int)__hip_atomic_load(F.ctl + CW_CNT + layer * 64 + F.lane, RLX_AGENT) : 0;
        const int ntile = (c + 255) >> 8; int x = ntile;
#pragma unroll
        for (int d = 1; d < 32; d <<= 1) { const int v = __builtin_amdgcn_ds_bpermute((F.lane - d) << 2, x); if (F.lane >= d) x += v; }
        if (F.lane < 32) { offT[F.lane] = x - ntile; ((LAS int*)(F.lds + L_CNT))[F.lane] = c; }
        if (F.lane == 31) offT[32] = x;
    }
    __syncthreads();
    int T = __builtin_amdgcn_readfirstlane(offT[32]); if (T > MAXT) T = MAXT;
    for (int mt = F.tid; mt < T; mt += 512) { int e = 0;
#pragma unroll 1
        for (int j = 1; j < 32; ++j) if (offT[j] <= mt) e = j;
        tile_e[mt] = e; }
    __syncthreads();
    return T;
}

__device__ __forceinline__ void p_combine_ln(Frame& F, const Args& a, int layer, bool dry = false) {
    constexpr int TPI = 4;
    const bool last_layer = (layer == DEPTH - 1) || dry, feeds_next = (layer != DEPTH - 1) || dry;
    const bf16* XB1 = (const bf16*)(F.ws + WS_M); float* XFo = dry ? (float*)(F.ws + WS_HH) : a.out; bf16* XB = (bf16*)(F.ws + (dry ? WS_H + 280 * MiB : WS_XB)); const unsigned char* YS = (const unsigned char*)(F.ws + WS_H);
    const int* TOPE = (const int*)(F.ws + WS_TOPE); const int* RANK = (const int*)(F.ws + WS_RANK); const float* TOPW = (const float*)(F.ws + WS_TOPW);
    const LAS int* offT = (const LAS int*)(F.lds + L_OFFT);
    const float* g2 = a.in[20] + layer * 1024; const float* b2 = a.in[21] + layer * 1024;
    const int gw = F.bid * 8 + F.wave, NGW = F.G * 8, lane = F.lane;
    f32x4 gv[4], bv[4];
#pragma unroll
    for (int j = 0; j < 4; ++j) { gv[j] = *(const f32x4*)(g2 + 4 * lane + 256 * j); bv[j] = *(const f32x4*)(b2 + 4 * lane + 256 * j); }
    for (int tp = gw; tp < NTOK / TPI; tp += NGW) {
        f32x4 v[TPI][4]; unsigned yw[TPI][4][4]; f32x4 tw[TPI]; int pk[TPI][4];
#pragma unroll
        for (int u = 0; u < TPI; ++u) { const int tok = tp * TPI + u;
            const int4 te = *(const int4*)(TOPE + tok * 4), rk = *(const int4*)(RANK + tok * 4); tw[u] = *(const f32x4*)(TOPW + tok * 4);
            const v2u* xr = (const v2u*)(XB1 + (size_t)tok * 1024) + lane;
#pragma unroll
            for (int j = 0; j < 4; ++j) { const v2u pw = xr[64 * j]; v[u][j] = (f32x4){bflo(pw.x), bfhi(pw.x), bflo(pw.y), bfhi(pw.y)}; }
            pk[u][0] = offT[te.x] * 256 + rk.x; pk[u][1] = offT[te.y] * 256 + rk.y; pk[u][2] = offT[te.z] * 256 + rk.z; pk[u][3] = offT[te.w] * 256 + rk.w; }
#pragma unroll
        for (int u = 0; u < TPI; ++u)
#pragma unroll
            for (int k = 0; k < 4; ++k) { const unsigned* yr = (const unsigned*)(YS + (size_t)pk[u][k] * 1024) + lane;
#pragma unroll
                for (int j = 0; j < 4; ++j) yw[u][k][j] = yr[64 * j]; }
        float s[TPI], s2[TPI];
#pragma unroll
        for (int u = 0; u < TPI; ++u) {
#pragma unroll
            for (int j = 0; j < 4; ++j) { v[u][j] = v[u][j] * DN_ALPHA;
#pragma unroll
                for (int k = 0; k < 4; ++k) { const int y = (int)yw[u][k][j]; v[u][j] = v[u][j] + (tw[u][k] * (1.0f / 16.0f)) * (f32x4){__builtin_amdgcn_cvt_f32_fp8(y, 0), __builtin_amdgcn_cvt_f32_fp8(y, 1), __builtin_amdgcn_cvt_f32_fp8(y, 2), __builtin_amdgcn_cvt_f32_fp8(y, 3)}; } }
            s[u] = 0.f;
#pragma unroll
            for (int j = 0; j < 4; ++j) s[u] += (v[u][j][0] + v[u][j][1]) + (v[u][j][2] + v[u][j][3]); }
#pragma unroll
        for (int o = 1; o < 64; o <<= 1) {
#pragma unroll
            for (int u = 0; u < TPI; ++u) s[u] += shx(s[u], o, lane); }
#pragma unroll
        for (int u = 0; u < TPI; ++u) { const float mean = s[u] * (1.f / 1024.f); s2[u] = 0.f;
#pragma unroll
            for (int j = 0; j < 4; ++j) { v[u][j] = v[u][j] - mean; s2[u] += (v[u][j][0] * v[u][j][0] + v[u][j][1] * v[u][j][1]) + (v[u][j][2] * v[u][j][2] + v[u][j][3] * v[u][j][3]); } }
#pragma unroll
        for (int o = 1; o < 64; o <<= 1) {
#pragma unroll
            for (int u = 0; u < TPI; ++u) s2[u] += shx(s2[u], o, lane); }
#pragma unroll
        for (int u = 0; u < TPI; ++u) { const int tok = tp * TPI + u; const float rstd = rsqrtf(s2[u] * (1.f / 1024.f) + LN_EPS);
            f32x4* xo = (f32x4*)(XFo + (size_t)tok * 1024) + lane; v2u* xb = (v2u*)(XB + (size_t)tok * 1024) + lane; unsigned* x8 = (unsigned*)(F.ws + (dry ? WS_H + 344 * MiB : WS_XB8)) + (size_t)tok * 256 + lane;
#pragma unroll
            for (int j = 0; j < 4; ++j) { const f32x4 y = v[u][j] * rstd * gv[j] + bv[j]; if (last_layer) xo[64 * j] = y;
                if (feeds_next) { xb[64 * j] = (v2u){pk2(y[0], y[1]), pk2(y[2], y[3])}; x8[64 * j] = pk4_fp8(y[0], y[1], y[2], y[3], 1.0f); } } }
    }
}

__device__ __forceinline__ const Args* fresh_args() { unsigned long long p = (unsigned long long)__builtin_amdgcn_kernarg_segment_ptr(); asm volatile("" : "+s"(p)); return (const Args*)(const __attribute__((address_space(4))) void*)p; }
constexpr int PH_PER_LAYER = 10, N_PHASES = 1 + DEPTH * PH_PER_LAYER;
__global__ void __launch_bounds__(512, 2) mk_fwd(Args args) {
    extern __shared__ __attribute__((aligned(16))) unsigned char lds[];
    Frame F;
    F.lds = (LAS unsigned char*)lds; F.tid = threadIdx.x; F.lane = F.tid & 63; F.wave = __builtin_amdgcn_readfirstlane(F.tid >> 6); F.wv = F.wave;
    F.G = gridDim.x; F.bid = blockIdx.x; F.ws = fresh_args()->ws; F.ctl = (unsigned*)(F.ws + WS_CTL);
    for (int u = F.tid; u < (LDS_BYTES - LDSCTL_OFF) / 4; u += 512) ((LAS unsigned*)(F.lds + LDSCTL_OFF))[u] = 0u;
    __syncthreads();
    const int lo = fresh_args()->ph_lo, hi = fresh_args()->ph_hi;
    XcdBarrier bar; bar.bar = F.ctl + CW_BAR; bar.x = 0; bar.st = nullptr;
    if (hi - lo > 1) bar = xcd_barrier_post(F.ctl + CW_BAR, (volatile LAS unsigned*)(F.lds + L_MISC) + 8);
#define IN(k) (lo <= (k) && (k) < hi)
#define REFRESH() do { F.tid = opaque_tid(F.wv); F.lane = F.tid & 63; F.wave = __builtin_amdgcn_readfirstlane(F.tid >> 6); asm volatile("" : "+s"(F.bid), "+s"(F.G)); } while (0)
#define SEAM(k) do { if ((k) + 1 < hi) xcd_barrier(bar); } while (0)

#ifndef NO_P0
    if (IN(0)) { _Pragma("unroll") for (int rep = 0; rep < REP_T; ++rep) p_prologue(F, *fresh_args()); SEAM(0); }
#endif

    for (int l = 0; l < DEPTH; ++l) {
        const int pb = 1 + l * PH_PER_LAYER;
#ifndef NO_P1
        if (IN(pb + 0)) {
            REFRESH();
            {
                pg8::DenseOrder S{(const char*)(F.ws + WS_XB), (const char*)(F.ws + WS_WIN) + (size_t)l * INC * 1024 * 2, (size_t)256 * 1024 * 2, (size_t)256 * 1024 * 2, 16, NTOK / 256, 12, F.G, F.bid};
                pg8::EpiInProj E{(bf16*)(F.ws + WS_H), fresh_args()->in[2] + l * 3072, (const f32x2*)(F.ws + WS_ROPE64), (const f32x2*)(F.ws + WS_ROPE48), 1.0f, (unsigned char*)(F.ws + WS_G8), F.lds};
                _Pragma("unroll") for (int rep = 0; rep < REP_G1; ++rep) pg8::gemm_phase<pg8::EpiInProj, pg8::DenseOrder, true, true>(F.lds, 1024, 1024, S, E, F.wv);
            }
            {
                REFRESH();
                pg8::DenseOrder S{(const char*)(F.ws + WS_XB8), (const char*)(F.ws + WS_WIN8) + (size_t)l * 3072 * 1024, (size_t)256 * 1024, (size_t)256 * 1024, 8, NTOK / 256, 12, F.G, F.bid, 12};
                pg8::EpiInProj E{(bf16*)(F.ws + WS_H), fresh_args()->in[2] + l * 3072, (const f32x2*)(F.ws + WS_ROPE64), (const f32x2*)(F.ws + WS_ROPE48), 1.0f / 32.0f, (unsigned char*)(F.ws + WS_G8), F.lds};
                _Pragma("unroll") for (int rep = 0; rep < REP_G1; ++rep) pg8::gemm_phase<pg8::EpiInProj, pg8::DenseOrder, true, true, true>(F.lds, 1024, 1024, S, E, F.wv);
            }
            if (pb + 2 < hi) xcd_barrier(bar);
        }
#endif
#ifndef NO_P1B
#endif
        if (IN(pb + 2)) {
            REFRESH();
#ifndef NO_PC
            _Pragma("unroll") for (int rep = 0; rep < REP_C; ++rep) attnC_pipe(F, fresh_args()->in[8] + l * 4 * 48, fresh_args()->in[9] + l * 96, fresh_args()->lam_init[l]);
#endif
#ifndef NO_PA
            REFRESH();
            _Pragma("unroll") for (int rep = 0; rep < REP_AB; ++rep) attnA_mfma(F, fresh_args()->in[7] + l * 4 * 15 * 31);
#endif
#ifndef NO_PB
            REFRESH();
            _Pragma("unroll") for (int rep = 0; rep < REP_AB; ++rep) attnB_mfma(F);
#endif
            SEAM(pb + 2);
        }
#ifndef NO_P3
        if (IN(pb + 3)) {
            REFRESH();
            pg8::ProjOrder S{(const char*)(F.ws + WS_Y), (const char*)(F.ws + WS_WPROJ) + (size_t)l * 1024 * WPK * 2, NTOK / 256, 4, F.G, F.bid};
            pg8::EpiProj E{(const unsigned char*)(F.ws + WS_G8), (bf16*)(F.ws + WS_M)};
            _Pragma("unroll") for (int rep = 0; rep < REP_G3; ++rep) pg8::gemm_phase<pg8::EpiProj, pg8::ProjOrder, true, true>(F.lds, YLD, WPK, S, E, F.wv);
            SEAM(pb + 3);
        }
#endif
#ifndef NO_P4
        if (IN(pb + 4)) {
            REFRESH();
            pg8::DenseOrder S{(const char*)(F.ws + WS_M), (const char*)(F.ws + WS_WOUT) + (size_t)l * 1024 * 1024 * 2, (size_t)256 * 1024 * 2, (size_t)256 * 1024 * 2, 16, NTOK / 256, 4, F.G, F.bid};
            pg8::EpiOut E{l == 0 ? fresh_args()->in[0] : (const float*)nullptr, (const bf16*)(F.ws + WS_XB), (bf16*)(F.ws + WS_HH)};
            _Pragma("unroll") for (int rep = 0; rep < REP_G4; ++rep) pg8::gemm_phase<pg8::EpiOut, pg8::DenseOrder, true, true>(F.lds, 1024, 1024, S, E, F.wv);
            SEAM(pb + 4);
        }
#endif
#ifndef NO_P5
        if (IN(pb + 5)) { REFRESH(); if (DRY_P5) p_ln_router(F, *fresh_args(), l, true); p_ln_router(F, *fresh_args(), l); if (pb + 7 < hi) xcd_barrier(bar); }
#endif
#ifndef NO_P5B
#endif
#ifndef NO_P6
        if (IN(pb + 7)) {
            REFRESH(); const int T = moe_build(F, l);
            pg8::MoeOrder S{(const char*)(F.ws + WS_XB8), (const char*)(F.ws + WS_WGU) + (size_t)l * NEXP * 2048 * 1024, (size_t)2048 * 1024, (size_t)256 * 1024, (size_t)256 * 1024, 8,
                            (const LAS int*)(F.lds + L_TILE), (const LAS int*)(F.lds + L_OFFT), (const LAS int*)(F.lds + L_CNT), (const int*)(F.ws + WS_SRC), T, 8, F.G, F.bid};
            pg8::EpiSwiglu E{(unsigned char*)(F.ws + WS_HH), fresh_args()->in[15] + (size_t)l * NEXP * 1024, fresh_args()->in[17] + (size_t)l * NEXP * 1024, 1.0f / 32.0f, F.lds};
            _Pragma("unroll") for (int rep = 0; rep < REP_G6; ++rep) pg8::gemm_phase_gather<pg8::EpiSwiglu, pg8::MoeOrder, true>(F.lds, (const char*)(F.ws + WS_XB8), 1024, 1024, S, E, F.wv);
            SEAM(pb + 7);
        }
#endif
#ifndef NO_P7
        if (IN(pb + 8)) {
            REFRESH();
#if MK_ONE_LAUNCH
            int T = __builtin_amdgcn_readfirstlane(((const LAS int*)(F.lds + L_OFFT))[32]); if (T > MAXT) T = MAXT;
#else
            const int T = moe_build(F, l);
#endif
            pg8::MoeOrder S{(const char*)(F.ws + WS_HH), (const char*)(F.ws + WS_WDN) + (size_t)l * NEXP * 1024 * 1024, (size_t)1024 * 1024, (size_t)256 * 1024, (size_t)256 * 1024, 8,
                            (const LAS int*)(F.lds + L_TILE), (const LAS int*)(F.lds + L_OFFT), (const LAS int*)(F.lds + L_CNT), (const int*)(F.ws + WS_SRC), T, 4, F.G, F.bid};
            pg8::EpiDown E{(unsigned char*)(F.ws + WS_H), fresh_args()->in[19] + (size_t)l * NEXP * 1024, 1.0f / 256.0f, F.lds};
            _Pragma("unroll") for (int rep = 0; rep < REP_G7; ++rep) pg8::gemm_phase<pg8::EpiDown, pg8::MoeOrder, true, true, true, 32>(F.lds, 1024, 1024, S, E, F.wv);
            SEAM(pb + 8);
        }
#endif
#ifndef NO_P8
        if (IN(pb + 9)) { REFRESH(); if (!MK_ONE_LAUNCH) (void)moe_build(F, l); if (DRY_P8) p_combine_ln(F, *fresh_args(), l, true); p_combine_ln(F, *fresh_args(), l); SEAM(pb + 9); }
#endif
    }
#undef IN
#undef SEAM
}

extern "C" void kernel_launch(void* const* d_in, const int* in_sizes, int n_in, void* d_out, int out_size, void* d_ws, size_t ws_size, hipStream_t stream) {
    static int grid = 0;
    if (grid == 0) {
        if (n_in != 22 || in_sizes[0] != NTOK * D || out_size != NTOK * D || ws_size < WS_END) {
            fprintf(stderr, "kernel_launch: unexpected shapes (n_in %d, in0 %d, out %d, ws %zu); nothing launched\n", n_in, n_in > 0 ? in_sizes[0] : -1, out_size, ws_size); grid = -1; return; }
        int dev = 0, cus = 0, per_cu = 0;
        if (hipGetDevice(&dev) != hipSuccess || hipDeviceGetAttribute(&cus, hipDeviceAttributeMultiprocessorCount, dev) != hipSuccess) { grid = -1; return; }
        if (hipFuncSetAttribute((const void*)mk_fwd, hipFuncAttributeMaxDynamicSharedMemorySize, LDS_BYTES) != hipSuccess) { fprintf(stderr, "kernel_launch: hipFuncSetAttribute failed\n"); grid = -1; return; }
        if (hipOccupancyMaxActiveBlocksPerMultiprocessor(&per_cu, (const void*)mk_fwd, 512, LDS_BYTES) != hipSuccess || per_cu < 1)
            fprintf(stderr, "kernel_launch: note: occupancy query reports %d workgroups per CU\n", per_cu);
        (void)hipGetLastError();
        grid = cus;
    }
    if (grid < 0) return;
    if (hipMemsetAsync((char*)d_ws + WS_CTL, 0, CTL_ZERO_BYTES, stream) != hipSuccess) { fprintf(stderr, "kernel_launch: memset failed\n"); return; }
    Args a{};
    for (int i = 0; i < 22; ++i) a.in[i] = (const float*)d_in[i];
    a.out = (float*)d_out; a.ws = (unsigned char*)d_ws;
    for (int l = 0; l < DEPTH; ++l) a.lam_init[l] = (float)(0.8 - 0.6 * exp(-0.3 * (double)l));
#if MK_ONE_LAUNCH
    a.ph_lo = 0; a.ph_hi = N_PHASES;
    hipLaunchKernelGGL(mk_fwd, dim3(grid), dim3(512), LDS_BYTES, stream, a);
#else
    for (int p = 0; p < N_PHASES; ++p) {
        a.ph_lo = p; a.ph_hi = p + 1;
        hipLaunchKernelGGL(mk_fwd, dim3(grid), dim3(512), LDS_BYTES, stream, a);
    }
#endif
    const hipError_t le = hipPeekAtLastError();
    if (le != hipSuccess) fprintf(stderr, "kernel_launch: launch failed: %s\n", hipGetErrorName(le));
}
```
